# Optimizing an MI355X kernel written in HIP

```python
import math
import jax, jax.numpy as jnp
from jax import lax
import numpy as np

D_MODEL = 1024
BATCH = 2
SEQ = 8192
DEPTH = 4

GRID_W = 64
CTX_LEN = 256
EPS = 1e-6
NEG_INF = -1e30
ROPE_BASE = 10000.0

HY_WIDTH = D_MODEL // 2
HY_SHORT = 3
HY_BANDS = 16
HY_EMB = 1 + 2 * HY_BANDS
HY_FILTER_HIDDEN = 64
HY_SHIFT = 0.05
HY_FAST_DECAY = math.log(1e-2) / 0.3
HY_SLOW_DECAY = math.log(1e-2) / 1.5

S5_WIDTH = D_MODEL - HY_WIDTH
S5_GROUP = 16
S5_GROUPS = S5_WIDTH // S5_GROUP
S5_STATE = 64

RET_HEADS = 4
RET_DK = D_MODEL // 16
RET_DV = 2 * RET_DK
RET_CHUNK = 128
RET_WIDTH = RET_HEADS * (2 * RET_DK + 2 * RET_DV)

SWA_Q_HEADS = 8
SWA_KV_HEADS = 2
SWA_HD = D_MODEL // 16
SWA_WINDOW = 128
SWA_BLOCK = 128

AB_IN = 3 * HY_WIDTH + S5_WIDTH
CD_IN = RET_WIDTH + (SWA_Q_HEADS + 2 * SWA_KV_HEADS) * SWA_HD
MIX_OUT = HY_WIDTH + S5_WIDTH

N_EXPERTS = 32
TOP_K = 4
D_FF = D_MODEL
SWIGLU_LIMIT = 7.0
SWIGLU_ALPHA = 1.702
MOE_BLOCK = 128

kernel_name = 'hyena_s5_retention_swa_moe_hybrid'

F32 = jnp.float32


def rmsnorm(x, g):
    xf = x.astype(F32)
    y = xf * lax.rsqrt(jnp.mean(xf * xf, axis=-1, keepdims=True) + EPS)
    return (y * g.astype(F32)).astype(x.dtype)


def rope_1d(x, pos, base):
    half = x.shape[-1] // 2
    inv = base ** (-jnp.arange(half, dtype=F32) / half)
    ang = pos[:, None] * inv[None]
    cos = jnp.cos(ang)[:, None, :].astype(x.dtype)
    sin = jnp.sin(ang)[:, None, :].astype(x.dtype)
    x1, x2 = x[..., :half], x[..., half:]
    return jnp.concatenate([x1 * cos - x2 * sin, x1 * sin + x2 * cos], axis=-1)


def grid_positions(L):
    n_rows = L // GRID_W
    row = jnp.repeat(jnp.arange(n_rows, dtype=F32), GRID_W)
    col = jnp.tile(jnp.arange(GRID_W, dtype=F32), n_rows)
    return row, col


def rope_2d(x, row, col):
    h = x.shape[-1] // 2
    return jnp.concatenate([rope_1d(x[..., :h], row, ROPE_BASE), rope_1d(x[..., h:], col, ROPE_BASE)], axis=-1)


def hyena_filter(L, w1, b1, w2, b2, w3):
    pos = jnp.arange(L, dtype=F32)
    t = (pos / L)[:, None]
    bands = jnp.linspace(1e-4, HY_BANDS - 1, HY_BANDS, dtype=F32)[None]
    w = (2.0 * math.pi * pos / L)[:, None]
    feats = jnp.concatenate([t, jnp.cos(bands * w), -jnp.sin(bands * w)], axis=-1)
    h = jnp.sin(feats @ w1.astype(F32) + b1.astype(F32))
    h = jnp.sin(h @ w2.astype(F32) + b2.astype(F32))
    h = h @ w3.astype(F32)
    lag = jnp.abs(pos - L // 2) / (L / 2)
    deltas = jnp.abs(jnp.linspace(HY_FAST_DECAY, HY_SLOW_DECAY, HY_WIDTH, dtype=F32))
    h = h * (jnp.exp(-lag[:, None] * deltas[None]) + HY_SHIFT)
    return h / jnp.sum(jnp.abs(h), axis=0, keepdims=True)


def short_conv(u, w, b):
    ch = u.shape[-1]
    y = lax.conv_general_dilated(u, w[:, None, :].astype(u.dtype), window_strides=(1,),
                                 padding=[(HY_SHORT // 2, HY_SHORT // 2)],
                                 dimension_numbers=('NWC', 'WIO', 'NWC'), feature_group_count=ch)
    return y + b


def long_conv_centred(z, h):
    L = z.shape[1]
    n = 2 * L
    zf = jnp.fft.rfft(z.astype(F32), n=n, axis=1)
    hf = jnp.fft.rfft(h, n=n, axis=0)
    y = jnp.fft.irfft(zf * hf[None], n=n, axis=1)
    return y[:, L // 2: L // 2 + L]


def hyena(p, short_w, short_b, w1, b1, w2, b2, w3, hy_bias):
    L = p.shape[1]
    u = short_conv(p, short_w, short_b)
    x0, x1, v = jnp.split(u, 3, axis=-1)
    z = v * x1
    h = hyena_filter(L, w1, b1, w2, b2, w3)
    y = long_conv_centred(z, h).astype(z.dtype) + hy_bias * z
    return x0 * y


def s5_discretize(lam_re, lam_im, log_dt, b_re, b_im, c_re, c_im):
    lam = lax.complex(jnp.minimum(lam_re.astype(F32), -1e-4), lam_im.astype(F32))
    dt = jnp.exp(log_dt.astype(F32))[:, None]
    lam_bar = jnp.exp(lam * dt)
    b = lax.complex(b_re.astype(F32), b_im.astype(F32))
    b_bar = ((lam_bar - 1.0) / lam)[..., None] * b
    cm = lax.complex(c_re.astype(F32), c_im.astype(F32))
    return lam_bar, b_bar, cm


def diag_scan(bu, lam_bar, s0):
    bu = bu.at[:, 0].add(lam_bar[None] * s0)
    a = jnp.broadcast_to(lam_bar, bu.shape)

    def combine(e1, e2):
        a1, b1 = e1
        a2, b2 = e2
        return a1 * a2, a2 * b1 + b2

    return lax.associative_scan(combine, (a, bu), axis=1)[1]


def s5_mixer(u_lat, u_ctx, lam_re, lam_im, log_dt, b_re, b_im, c_re, c_im, d_skip, glu_w, glu_b, with_ctx):
    bsz, L, W = u_lat.shape
    Lc = u_ctx.shape[1]
    ul = u_lat.astype(F32).reshape(bsz, L, S5_GROUPS, S5_GROUP).astype(jnp.complex64)
    uc = u_ctx.astype(F32).reshape(bsz, Lc, S5_GROUPS, S5_GROUP).astype(jnp.complex64)
    y_lat = d_skip.astype(F32) * u_lat.astype(F32)
    y_ctx = d_skip.astype(F32) * u_ctx.astype(F32)
    s_zero = jnp.zeros((bsz, S5_GROUPS, S5_STATE), jnp.complex64)
    for d in range(2):
        lam_bar, b_bar, cm = s5_discretize(lam_re[d], lam_im[d], log_dt[d], b_re[d], b_im[d], c_re[d], c_im[d])
        uc_d = uc[:, ::-1] if d == 1 else uc
        ul_d = ul[:, ::-1] if d == 1 else ul
        s_ctx = diag_scan(jnp.einsum('blgh,gph->blgp', uc_d, b_bar), lam_bar, s_zero)
        s_lat = diag_scan(jnp.einsum('blgh,gph->blgp', ul_d, b_bar), lam_bar, s_ctx[:, -1])
        r_lat = jnp.real(jnp.einsum('blgp,ghp->blgh', s_lat, cm)).reshape(bsz, L, W)
        y_lat = y_lat + (r_lat[:, ::-1] if d == 1 else r_lat)
        if with_ctx:
            r_ctx = jnp.real(jnp.einsum('blgp,ghp->blgh', s_ctx, cm)).reshape(bsz, Lc, W)
            y_ctx = y_ctx + (r_ctx[:, ::-1] if d == 1 else r_ctx)

    def glu(y):
        y = jax.nn.gelu(y)
        return y * jax.nn.sigmoid(y @ glu_w.astype(F32) + glu_b.astype(F32))

    out_lat = glu(y_lat).astype(u_lat.dtype)
    out_ctx = glu(y_ctx).astype(u_ctx.dtype) if with_ctx else None
    return out_lat, out_ctx


def mixer_ab(hx, hc, w_in, w_out, short_w, short_b, f_w1, f_b1, f_w2, f_b2, f_w3, hy_bias,
             lam_re, lam_im, log_dt, b_re, b_im, c_re, c_im, s5_d, glu_w, glu_b, with_ctx):
    px = hx @ w_in
    pc = hc @ w_in
    hw3 = 3 * HY_WIDTH
    hy_args = (short_w, short_b, f_w1, f_b1, f_w2, f_b2, f_w3, hy_bias)
    ya_lat = hyena(px[..., :hw3], *hy_args)
    yb_lat, yb_ctx = s5_mixer(px[..., hw3:], pc[..., hw3:], lam_re, lam_im, log_dt, b_re, b_im,
                              c_re, c_im, s5_d, glu_w, glu_b, with_ctx)
    out_lat = jnp.concatenate([ya_lat, yb_lat], axis=-1) @ w_out
    out_ctx = None
    if with_ctx:
        ya_ctx = hyena(pc[..., :hw3], *hy_args)
        out_ctx = jnp.concatenate([ya_ctx, yb_ctx], axis=-1) @ w_out
    return out_lat, out_ctx


def ret_chunkwise(q, k, v, log_g, s0):
    bsz, L, H, dk = q.shape
    dv = v.shape[-1]
    C = RET_CHUNK
    n = L // C
    qc = q.reshape(bsz, n, C, H, dk)
    kc = k.reshape(bsz, n, C, H, dk)
    vc = v.reshape(bsz, n, C, H, dv)
    idx = jnp.arange(C, dtype=F32)
    diff = idx[:, None] - idx[None, :]
    mask = jnp.where(diff[None] >= 0, jnp.exp(jnp.maximum(diff, 0.0)[None] * log_g[:, None, None]), 0.0)
    scores = jnp.einsum('bnihd,bnjhd->bnhij', qc, kc) * mask
    inner = jnp.einsum('bnhij,bnjhe->bnihe', scores, vc)
    k_dec = kc * jnp.exp((C - 1 - idx)[:, None] * log_g[None])[None, None, :, :, None]
    chunk_kv = jnp.einsum('bnjhd,bnjhe->nbhde', k_dec, vc)
    g_chunk = jnp.exp(C * log_g)[None, :, None, None]

    def step(s, kv):
        return g_chunk * s + kv, s

    s_final, s_prev = lax.scan(step, s0, chunk_kv)
    q_dec = qc * jnp.exp((idx + 1.0)[:, None] * log_g[None])[None, None, :, :, None]
    cross = jnp.einsum('bnihd,nbhde->bnihe', q_dec, s_prev)
    return (inner + cross).reshape(bsz, L, H, dv), s_final


def ret_final_state(k, v, log_g):
    L = k.shape[1]
    w = jnp.exp((L - 1 - jnp.arange(L, dtype=F32))[:, None] * log_g[None])
    return jnp.einsum('blhd,blhe->bhde', k * w[None, :, :, None], v)


def retention(p_lat, p_ctx, decay_logit, with_ctx):
    qk = RET_HEADS * RET_DK
    vw = RET_HEADS * RET_DV

    def heads(p):
        bsz, L, _ = p.shape
        q = p[..., :qk].reshape(bsz, L, RET_HEADS, RET_DK)
        k = p[..., qk:2 * qk].reshape(bsz, L, RET_HEADS, RET_DK)
        v = p[..., 2 * qk:2 * qk + vw].reshape(bsz, L, RET_HEADS, RET_DV)
        g = p[..., 2 * qk + vw:]
        return q, k, v, g

    ql, kl, vl, gl = heads(p_lat)
    qc, kc, vc, gc = heads(p_ctx)
    bsz, L, _ = p_lat.shape
    pos = jnp.arange(L, dtype=F32)
    scale = RET_DK ** -0.5
    ql = rope_1d(ql, pos, ROPE_BASE).astype(F32) * scale
    kl = rope_1d(kl, pos, ROPE_BASE).astype(F32)
    vl = vl.astype(F32)
    qc = qc.astype(F32) * scale
    kc = kc.astype(F32)
    vc = vc.astype(F32)
    log_g = jax.nn.log_sigmoid(decay_logit.astype(F32))
    s_zero = jnp.zeros((bsz, RET_HEADS, RET_DK, RET_DV), F32)
    o_lat = jnp.zeros(vl.shape, F32)
    o_ctx = jnp.zeros(vc.shape, F32)
    for d in range(2):
        flip = (lambda a: a[:, ::-1]) if d == 1 else (lambda a: a)
        if with_ctx:
            oc, s_c = ret_chunkwise(flip(qc), flip(kc), flip(vc), log_g[d], s_zero)
            o_ctx = o_ctx + flip(oc)
        else:
            s_c = ret_final_state(flip(kc), flip(vc), log_g[d])
        ol, _ = ret_chunkwise(flip(ql), flip(kl), flip(vl), log_g[d], s_c)
        o_lat = o_lat + flip(ol)

    def readout(o, g):
        o = o * lax.rsqrt(jnp.mean(o * o, axis=-1, keepdims=True) + EPS)
        o = o.reshape(o.shape[0], o.shape[1], vw)
        return (o * jax.nn.silu(g.astype(F32))).astype(g.dtype)

    return readout(o_lat, gl), (readout(o_ctx, gc) if with_ctx else None)


def swa(p_lat, p_ctx, sink, with_ctx):
    qw = SWA_Q_HEADS * SWA_HD
    kw = SWA_KV_HEADS * SWA_HD
    G = SWA_Q_HEADS // SWA_KV_HEADS

    def heads(p):
        bsz, L, _ = p.shape
        q = p[..., :qw].reshape(bsz, L, SWA_Q_HEADS, SWA_HD)
        k = p[..., qw:qw + kw].reshape(bsz, L, SWA_KV_HEADS, SWA_HD)
        v = p[..., qw + kw:].reshape(bsz, L, SWA_KV_HEADS, SWA_HD)
        return q, k, v

    ql, kl, vl = heads(p_lat)
    qc, kc, vc = heads(p_ctx)
    bsz, L, _ = p_lat.shape
    Lc = p_ctx.shape[1]
    row, col = grid_positions(L)
    ql = rope_2d(ql, row, col).reshape(bsz, L, SWA_KV_HEADS, G, SWA_HD)
    kl = rope_2d(kl, row, col)
    qc = qc.reshape(bsz, Lc, SWA_KV_HEADS, G, SWA_HD)
    scale = SWA_HD ** -0.5
    sink_b = sink.astype(F32).reshape(SWA_KV_HEADS, G)

    bk = SWA_BLOCK
    nb = L // bk
    qb = ql.reshape(bsz, nb, bk, SWA_KV_HEADS, G, SWA_HD)

    def band(t):
        tp = jnp.pad(t, ((0, 0), (bk, bk), (0, 0), (0, 0))).reshape(bsz, nb + 2, bk, SWA_KV_HEADS, SWA_HD)
        return jnp.concatenate([tp[:, :-2], tp[:, 1:-1], tp[:, 2:]], axis=2)

    kb, vb = band(kl), band(vl)
    s_loc = jnp.einsum('bnikgd,bnjkd->bnkgij', qb, kb, preferred_element_type=F32) * scale
    s_ctx = jnp.einsum('bnikgd,bjkd->bnkgij', qb, kc, preferred_element_type=F32) * scale
    qi = jnp.arange(bk)[:, None] + bk
    kj = jnp.arange(3 * bk)[None, :]
    in_window = jnp.abs(kj - qi) <= SWA_WINDOW
    key_pos = (jnp.arange(nb)[:, None] - 1) * bk + jnp.arange(3 * bk)[None, :]
    in_range = (key_pos >= 0) & (key_pos < L)
    mask = in_window[None] & in_range[:, None, :]
    s_loc = jnp.where(mask[None, :, None, None], s_loc, NEG_INF)
    sink_col = jnp.broadcast_to(sink_b[None, None, :, :, None, None], s_loc.shape[:-1] + (1,))
    probs = jax.nn.softmax(jnp.concatenate([s_loc, s_ctx, sink_col], axis=-1), axis=-1)
    p_loc = probs[..., :3 * bk]
    p_cx = probs[..., 3 * bk:3 * bk + Lc]
    o = (jnp.einsum('bnkgij,bnjkd->bnikgd', p_loc, vb.astype(F32))
         + jnp.einsum('bnkgij,bjkd->bnikgd', p_cx, vc.astype(F32)))
    o_lat = o.reshape(bsz, L, qw).astype(p_lat.dtype)

    o_ctx = None
    if with_ctx:
        s_cc = jnp.einsum('bikgd,bjkd->bkgij', qc, kc, preferred_element_type=F32) * scale
        sink_c = jnp.broadcast_to(sink_b[None, :, :, None, None], s_cc.shape[:-1] + (1,))
        pc = jax.nn.softmax(jnp.concatenate([s_cc, sink_c], axis=-1), axis=-1)[..., :Lc]
        o_ctx = jnp.einsum('bkgij,bjkd->bikgd', pc, vc.astype(F32)).reshape(bsz, Lc, qw).astype(p_ctx.dtype)
    return o_lat, o_ctx


def mixer_cd(hx, hc, w_in, w_out, decay_logit, sink, with_ctx):
    px = hx @ w_in
    pc = hc @ w_in
    rl, rc = retention(px[..., :RET_WIDTH], pc[..., :RET_WIDTH], decay_logit, with_ctx)
    sl, sc = swa(px[..., RET_WIDTH:], pc[..., RET_WIDTH:], sink, with_ctx)
    out_lat = jnp.concatenate([rl, sl], axis=-1) @ w_out
    out_ctx = jnp.concatenate([rc, sc], axis=-1) @ w_out if with_ctx else None
    return out_lat, out_ctx


def moe(h2, router_w, router_b, w_gu, b_gu, w_dn, b_dn):
    N, dm = h2.shape
    logits = (h2 @ router_w).astype(F32) + router_b.astype(F32)
    top_v, top_i = lax.top_k(logits, TOP_K)
    gates = jax.nn.softmax(top_v, axis=-1).astype(h2.dtype)
    M = N * TOP_K
    flat_e = top_i.reshape(M)
    flat_t = jnp.repeat(jnp.arange(N, dtype=jnp.int32), TOP_K)
    flat_g = gates.reshape(M)
    order = jnp.argsort(flat_e)
    se, st, sg = flat_e[order], flat_t[order], flat_g[order]
    counts = jnp.bincount(flat_e, length=N_EXPERTS)
    padded = (counts + MOE_BLOCK - 1) // MOE_BLOCK * MOE_BLOCK
    pad_end = jnp.cumsum(padded)
    pad_start = pad_end - padded
    start = jnp.cumsum(counts) - counts
    dest = pad_start[se] + jnp.arange(M, dtype=jnp.int32) - start[se]
    n_blocks = -(-M // MOE_BLOCK) + N_EXPERTS
    n_slots = n_blocks * MOE_BLOCK
    slot_tok = jnp.full((n_slots,), N, jnp.int32).at[dest].set(st)
    slot_gate = jnp.zeros((n_slots,), h2.dtype).at[dest].set(sg)
    block_exp = jnp.minimum(jnp.searchsorted(pad_end, jnp.arange(n_blocks, dtype=jnp.int32) * MOE_BLOCK, side='right'),
                            N_EXPERTS - 1)
    h_pad = jnp.concatenate([h2, jnp.zeros((1, dm), h2.dtype)], axis=0)
    xb = h_pad[slot_tok].reshape(n_blocks, MOE_BLOCK, dm)

    def expert_block(args):
        xblk, e = args
        gu = xblk @ w_gu[e] + b_gu[e]
        gate = jnp.minimum(gu[:, :D_FF], SWIGLU_LIMIT)
        up = jnp.clip(gu[:, D_FF:], -SWIGLU_LIMIT, SWIGLU_LIMIT)
        act = gate * jax.nn.sigmoid(SWIGLU_ALPHA * gate) * (up + 1.0)
        return act @ w_dn[e] + b_dn[e]

    yb = lax.map(expert_block, (xb, block_exp))
    y = jnp.zeros((N + 1, dm), h2.dtype).at[slot_tok].add(yb.reshape(n_slots, dm) * slot_gate[:, None])
    return y[:N]


def setup_inputs(seed: int = 0) -> dict:
    key = jax.random.key(seed)
    keys = iter(jax.random.split(key, 48))
    D = D_MODEL
    ne = (DEPTH + 1) // 2
    no = DEPTH // 2
    G, P, H = S5_GROUPS, S5_STATE, S5_GROUP

    def normal(shape, scale):
        return jax.random.normal(next(keys), shape, F32) * scale

    inp = {}
    inp['x'] = normal((BATCH, SEQ, D), 1.0)
    inp['c'] = normal((BATCH, D), 1.0)
    inp['ctx'] = normal((BATCH, CTX_LEN, D), 1.0)
    inp['c_ctx'] = normal((D,), 1.0)
    inp['mod_w'] = normal((DEPTH, D, 6 * D), 0.5 * D ** -0.5)
    inp['mod_b'] = normal((DEPTH, 6 * D), 0.01)
    inp['norm1_g'] = 1.0 + normal((DEPTH, D), 0.01)
    inp['norm2_g'] = 1.0 + normal((DEPTH, D), 0.01)
    inp['ab_w_in'] = normal((ne, D, AB_IN), D ** -0.5)
    inp['ab_w_out'] = normal((ne, MIX_OUT, D), MIX_OUT ** -0.5)
    inp['hy_short_w'] = normal((ne, HY_SHORT, 3 * HY_WIDTH), HY_SHORT ** -0.5)
    inp['hy_short_b'] = normal((ne, 3 * HY_WIDTH), 0.01)
    inp['hy_f_w1'] = normal((ne, HY_EMB, HY_FILTER_HIDDEN), HY_EMB ** -0.5)
    inp['hy_f_b1'] = normal((ne, HY_FILTER_HIDDEN), 0.01)
    inp['hy_f_w2'] = normal((ne, HY_FILTER_HIDDEN, HY_FILTER_HIDDEN), HY_FILTER_HIDDEN ** -0.5)
    inp['hy_f_b2'] = normal((ne, HY_FILTER_HIDDEN), 0.01)
    inp['hy_f_w3'] = normal((ne, HY_FILTER_HIDDEN, HY_WIDTH), HY_FILTER_HIDDEN ** -0.5)
    inp['hy_bias'] = normal((ne, HY_WIDTH), 0.5)
    inp['s5_lambda_re'] = -0.5 + normal((ne, 2, G, P), 0.01)
    inp['s5_lambda_im'] = math.pi * jnp.arange(P, dtype=F32) + normal((ne, 2, G, P), 0.01)
    inp['s5_log_dt'] = jax.random.uniform(next(keys), (ne, 2, G), F32, math.log(1e-3), math.log(1e-1))
    inp['s5_b_re'] = normal((ne, 2, G, P, H), (2 * H) ** -0.5)
    inp['s5_b_im'] = normal((ne, 2, G, P, H), (2 * H) ** -0.5)
    inp['s5_c_re'] = normal((ne, 2, G, H, P), (2 * P) ** -0.5)
    inp['s5_c_im'] = normal((ne, 2, G, H, P), (2 * P) ** -0.5)
    inp['s5_d'] = normal((ne, S5_WIDTH), 1.0)
    inp['s5_glu_w'] = normal((ne, S5_WIDTH, S5_WIDTH), S5_WIDTH ** -0.5)
    inp['s5_glu_b'] = normal((ne, S5_WIDTH), 0.01)
    inp['cd_w_in'] = normal((no, D, CD_IN), D ** -0.5)
    inp['cd_w_out'] = normal((no, MIX_OUT, D), MIX_OUT ** -0.5)
    ret_logit = jnp.log(2.0 ** (5.0 + jnp.arange(RET_HEADS, dtype=F32)) - 1.0)
    inp['ret_decay_logit'] = ret_logit + normal((no, 2, RET_HEADS), 0.05)
    inp['swa_sink'] = normal((no, SWA_Q_HEADS), 1.0)
    inp['router_w'] = normal((DEPTH, D, N_EXPERTS), D ** -0.5)
    inp['router_b'] = normal((DEPTH, N_EXPERTS), 0.01)
    inp['exp_w_gu'] = normal((DEPTH, N_EXPERTS, D, 2 * D_FF), D ** -0.5)
    inp['exp_b_gu'] = normal((DEPTH, N_EXPERTS, 2 * D_FF), 0.01)
    inp['exp_w_down'] = normal((DEPTH, N_EXPERTS, D_FF, D), D_FF ** -0.5)
    inp['exp_b_down'] = normal((DEPTH, N_EXPERTS, D), 0.01)
    inp['final_g'] = 1.0 + normal((D,), 0.01)
    return inp


def reference(x, c, ctx, c_ctx, mod_w, mod_b, norm1_g, norm2_g, ab_w_in, ab_w_out, hy_short_w, hy_short_b,
              hy_f_w1, hy_f_b1, hy_f_w2, hy_f_b2, hy_f_w3, hy_bias, s5_lambda_re, s5_lambda_im, s5_log_dt,
              s5_b_re, s5_b_im, s5_c_re, s5_c_im, s5_d, s5_glu_w, s5_glu_b, cd_w_in, cd_w_out,
              ret_decay_logit, swa_sink, router_w, router_b, exp_w_gu, exp_b_gu, exp_w_down, exp_b_down, final_g):
    bsz, L, dm = x.shape
    Lc = ctx.shape[1]
    h_ctx = ctx
    for layer in range(DEPTH):
        with_ctx = layer < DEPTH - 1
        m_lat = (jax.nn.silu(c) @ mod_w[layer] + mod_b[layer])[:, None, :]
        m_ctx = (jax.nn.silu(c_ctx) @ mod_w[layer] + mod_b[layer])[None, None, :]
        sh1, sc1, g1, sh2, sc2, g2 = jnp.split(m_lat, 6, axis=-1)
        csh1, csc1, cg1, csh2, csc2, cg2 = jnp.split(m_ctx, 6, axis=-1)
        hx = rmsnorm(x, norm1_g[layer]) * (1.0 + sc1) + sh1
        hc = rmsnorm(h_ctx, norm1_g[layer]) * (1.0 + csc1) + csh1
        if layer % 2 == 0:
            i = layer // 2
            mx, mc = mixer_ab(hx, hc, ab_w_in[i], ab_w_out[i], hy_short_w[i], hy_short_b[i],
                              hy_f_w1[i], hy_f_b1[i], hy_f_w2[i], hy_f_b2[i], hy_f_w3[i], hy_bias[i],
                              s5_lambda_re[i], s5_lambda_im[i], s5_log_dt[i], s5_b_re[i], s5_b_im[i],
                              s5_c_re[i], s5_c_im[i], s5_d[i], s5_glu_w[i], s5_glu_b[i], with_ctx)
        else:
            i = layer // 2
            mx, mc = mixer_cd(hx, hc, cd_w_in[i], cd_w_out[i], ret_decay_logit[i], swa_sink[i], with_ctx)
        moe_args = (router_w[layer], router_b[layer], exp_w_gu[layer], exp_b_gu[layer],
                    exp_w_down[layer], exp_b_down[layer])
        x = x + g1 * mx
        hx = rmsnorm(x, norm2_g[layer]) * (1.0 + sc2) + sh2
        x = x + g2 * moe(hx.reshape(bsz * L, dm), *moe_args).reshape(bsz, L, dm)
        if with_ctx:
            h_ctx = h_ctx + cg1 * mc
            hc = rmsnorm(h_ctx, norm2_g[layer]) * (1.0 + csc2) + csh2
            h_ctx = h_ctx + cg2 * moe(hc.reshape(bsz * Lc, dm), *moe_args).reshape(bsz, Lc, dm)
    return rmsnorm(x, final_g)
```

```cpp
#ifndef CPU_SHIM
#include <hip/hip_runtime.h>
#include <cstring>
#include <cstdio>
#include <cstdint>
#define DEV __device__ __forceinline__
#else
#include <cmath>
#include <cstdio>
#include <cstdint>
#include <cstring>
#include <cstdlib>
#define DEV static inline
static inline float rsqrtf(float x) { return 1.0f / sqrtf(x); }
#endif

#ifndef SEQ
#define SEQ 8192
#endif
#ifndef CTXL
#define CTXL 256
#endif
#ifndef N_LAUNCH_MODE
#define N_LAUNCH_MODE 1
#endif
#ifdef CPU_SHIM
#define MFMA_DENSE 0
#define MFMA_MOE 0
#endif
#ifndef R3
#define R3 1
#endif
#ifndef R4
#define R4 1
#endif
#ifndef R5
#define R5 1
#endif
#ifndef R6
#define R6 1
#endif
#ifndef R7
#define R7 1
#endif
#ifndef RG
#define RG 1
#endif
#ifndef RN
#define RN 1
#endif
#ifndef REP_SETUP
#define REP_SETUP 1
#endif
#ifndef REP_MOE
#define REP_MOE 1
#endif
#ifndef REP_MOE2
#define REP_MOE2 1
#endif
#ifndef REP_IN
#define REP_IN 1
#endif
#ifndef REP_RET
#define REP_RET 1
#endif
#ifndef REP_SWA
#define REP_SWA 1
#endif
#ifndef REP_S5
#define REP_S5 1
#endif
#ifndef MFMA_DENSE
#define MFMA_DENSE 1
#endif
#ifndef MFMA_MOE
#define MFMA_MOE 1
#endif
typedef unsigned short bf16_t;

constexpr int D = 1024, NLAT = 2 * SEQ, NCTX = 2 * CTXL, NTOK = NLAT + NCTX;
constexpr int HYW = 512, S5W = 512, NG = 32, NP = 64, GH = 16;
constexpr int AB_IN = 2048, CD_IN = 2304, PXLD = 2304;
constexpr int NE = 32, DFF = 1024;
constexpr float EPS = 1e-6f;
constexpr int NSLOT = ((NTOK * 4 + 255) / 256 + NE) * 256;
#ifdef CPU_SHIM
DEV bf16_t f2bf(float f) { unsigned u; memcpy(&u, &f, 4); return (bf16_t)((u + 0x7fffu + ((u >> 16) & 1u)) >> 16); }
DEV float fexp(float x) { return expf(x); }
DEV float frcp(float x) { return 1.0f / x; }
#else
DEV bf16_t f2bf(float f) { const __bf16 b = (__bf16)f; return __builtin_bit_cast(unsigned short, b); }
DEV float fexp(float x) { return __builtin_amdgcn_exp2f(1.4426950408889634f * x); }
DEV float frcp(float x) { return __builtin_amdgcn_rcpf(x); }
#endif
DEV float bf2f(bf16_t b) { const unsigned u = (unsigned)b << 16; float f; memcpy(&f, &u, 4); return f; }

struct P {
    const float *x, *c, *ctx, *c_ctx, *mod_w, *mod_b, *norm1_g, *norm2_g, *ab_w_in, *ab_w_out, *hy_short_w, *hy_short_b,
        *hy_f_w1, *hy_f_b1, *hy_f_w2, *hy_f_b2, *hy_f_w3, *hy_bias, *s5_lre, *s5_lim, *s5_ldt, *s5_bre, *s5_bim, *s5_cre, *s5_cim,
        *s5_d, *s5_glu_w, *s5_glu_b, *cd_w_in, *cd_w_out, *ret_decay, *swa_sink, *router_w, *router_b, *w_gu, *b_gu, *w_dn, *b_dn, *final_g;
    float* out;
    unsigned* bar;
    float *xa, *modv, *f1, *f2, *hraw, *hsum, *rstd, *hx, *px, *zb, *x0c, *mixin, *s5s, *ys5, *qr, *kr, *oret, *qs, *ks, *topg, *act;
    int* topi;
    bf16_t *hxb, *mixb, *ys5b, *xb, *actb, *abin_t, *cdin_t, *about_t, *cdout_t, *glu_t, *wgu_t, *wdn_t;
    bf16_t* yb;
    float *zT, *hT, *modp;
    float *slot_gate, *s5c, *rkv, *rsc, *hpart, *zf, *convT, *yd;
    int *cnt, *pos, *slot_of, *slot_tok;
};

struct RowInfo { int base, len, t, m, kind; };
DEV RowInfo row_info(int r) {
    RowInfo ri;
    if (r < NLAT) { const int b = r / SEQ; ri.base = b * SEQ; ri.len = SEQ; ri.t = r - ri.base; ri.m = b; ri.kind = 0; }
    else { const int rc = r - NLAT, b = rc / CTXL; ri.base = NLAT + b * CTXL; ri.len = CTXL; ri.t = rc - b * CTXL; ri.m = 2; ri.kind = 1; }
    return ri;
}
DEV float sigmoidf_(float x) { return frcp(1.0f + fexp(-x)); }
DEV float siluf_(float x) { return x * sigmoidf_(x); }
DEV float gelu_tanhf_(float x) { const float u = 0.7978845608028654f * (x + 0.044715f * x * x * x); return x * frcp(1.0f + fexp(-2.0f * u)); }

#ifdef CPU_SHIM
#define GSL(i, n) const long _n_##i = (long)(n); for (long i = _n_##i * gt / gs, _hi_##i = _n_##i * (gt + 1) / gs; i < _hi_##i; ++i)
#else
#define GSL(i, n) for (long i = gt; i < (long)(n); i += gs)
#endif

#if MFMA_DENSE
#define MIXST(idx, v) p.mixb[idx] = f2bf(v)
#else
#define MIXST(idx, v) p.mixin[idx] = (v)
#endif
DEV long filt_row0(int i, int kind) { return (long)i * (SEQ + CTXL) + (kind ? SEQ : 0); }

#ifdef CPU_SHIM
#define ROPE_COS(a) cosf(a)
#define ROPE_SIN(a) sinf(a)
#else
#define ROPE_COS(a) __builtin_amdgcn_cosf(__builtin_amdgcn_fractf((a) * 0.15915494309189535f))
#define ROPE_SIN(a) __builtin_amdgcn_sinf(__builtin_amdgcn_fractf((a) * 0.15915494309189535f))
#endif
DEV void ph_init(const P& p, long gt, long gs) {
    GSL(i, (long)NTOK * D) { p.xa[i] = i < (long)NLAT * D ? p.x[i] : p.ctx[i - (long)NLAT * D]; }
    GSL(j, 4 * NE) { p.cnt[j] = 0; }
    GSL(z, D) { p.hxb[(long)NTOK * D + z] = 0; }
}
DEV void ph_mod(const P& p, long gt, long gs) {
    GSL(i, 4L * 6 * D * 8) {
        const int j = (int)(i % (6 * D)), kq = (int)((i / (6 * D)) % 8), l = (int)(i / (6 * D * 8));
        const float* w = p.mod_w + (long)l * D * 6 * D + j;
        float a0 = 0.f, a1 = 0.f, a2 = 0.f;
        for (int k = kq * (D / 8); k < (kq + 1) * (D / 8); ++k) { const float wv = w[(long)k * 6 * D]; a0 += siluf_(p.c[k]) * wv; a1 += siluf_(p.c[D + k]) * wv; a2 += siluf_(p.c_ctx[k]) * wv; }
        float* o = p.modp + ((long)kq * 4 + l) * 3 * 6 * D + j;
        o[0] = a0; o[6 * D] = a1; o[12 * D] = a2;
    }
}
DEV void ph_mod2(const P& p, long gt, long gs) {
    GSL(i, 4L * 3 * 6 * D) {
        const int j = (int)(i % (6 * D)), l = (int)(i / (18 * D));
        float a = p.mod_b[l * 6 * D + j];
#pragma unroll
        for (int kq = 0; kq < 8; ++kq) a += p.modp[(long)kq * 4 * 3 * 6 * D + i];
        p.modv[i] = a;
    }
}
DEV void ph_filt1(const P& p, long gt, long gs) {
    GSL(idx, 2L * (SEQ + CTXL) * 64) {
        const int j = (int)(idx % 64); const long rr = idx / 64; const int i = (int)(rr / (SEQ + CTXL)); const int q = (int)(rr % (SEQ + CTXL));
        const int kind = q >= SEQ, pos = kind ? q - SEQ : q, L = kind ? CTXL : SEQ;
        const float* w1 = p.hy_f_w1 + i * 33 * 64;
        const float t = (float)pos / (float)L, w = 6.283185307179586f * (float)pos / (float)L;
        float acc = t * w1[j];
        for (int bi = 0; bi < 16; ++bi) {
            const float band = 1e-4f + (float)bi * ((15.0f - 1e-4f) / 15.0f);
            acc += ROPE_COS(band * w) * w1[(1 + bi) * 64 + j] - ROPE_SIN(band * w) * w1[(17 + bi) * 64 + j];
        }
        p.f1[idx] = ROPE_SIN(acc + p.hy_f_b1[i * 64 + j]);
    }
}
DEV void ph_filt2(const P& p, long gt, long gs) {
    GSL(idx, 2L * (SEQ + CTXL) * 64) {
        const int j = (int)(idx % 64); const long rr = idx / 64; const int i = (int)(rr / (SEQ + CTXL));
        const float* w2 = p.hy_f_w2 + i * 64 * 64; const float* h1 = p.f1 + rr * 64;
        float acc = 0.f;
        for (int k = 0; k < 64; ++k) acc += h1[k] * w2[k * 64 + j];
        p.f2[idx] = ROPE_SIN(acc + p.hy_f_b2[i * 64 + j]);
    }
}
DEV void ph_filt3(const P& p, long gt, long gs) {
    GSL(idx, 2L * (SEQ + CTXL) * HYW) {
        const int c = (int)(idx % HYW); const long rr = idx / HYW; const int i = (int)(rr / (SEQ + CTXL)); const int q = (int)(rr % (SEQ + CTXL));
        const int kind = q >= SEQ, pos = kind ? q - SEQ : q, L = kind ? CTXL : SEQ;
        const float* w3 = p.hy_f_w3 + (long)i * 64 * HYW; const float* h2 = p.f2 + rr * 64;
        float acc = 0.f;
        for (int k = 0; k < 64; ++k) acc += h2[k] * w3[k * HYW + c];
        const float lag = fabsf((float)(pos - L / 2)) / (float)(L / 2);
        const float fast = -15.350567286626973f, slow = -3.0701134573253946f;
        const float delta = fabsf(fast + (slow - fast) * (float)c / 511.0f);
        const float hv = acc * (expf(-lag * delta) + 0.05f);
        p.hraw[idx] = hv; if (!kind) p.hT[((long)i * HYW + c) * SEQ + pos] = hv;
    }
}
constexpr int FSEG = 64, FNSEG = (SEQ + CTXL) / FSEG;
DEV void ph_filt4a(const P& p, long gt, long gs) {
    GSL(idx, 2L * FNSEG * HYW) {
        const int c = (int)(idx % HYW); const long sg = idx / HYW; const float* h = p.hraw + sg * FSEG * HYW + c;
        float s = 0.f;
        for (int q = 0; q < FSEG; ++q) s += fabsf(h[(long)q * HYW]);
        p.hpart[idx] = s;
    }
}
DEV void ph_filt4(const P& p, long gt, long gs) {
    GSL(idx, 2 * 2 * HYW) {
        const int c = (int)(idx % HYW), kind = (int)((idx / HYW) % 2), i = (int)(idx / (2 * HYW));
        const int s0 = (int)(filt_row0(i, kind) / FSEG), ns = (kind ? CTXL : SEQ) / FSEG;
        float s = 0.f;
        for (int q = 0; q < ns; ++q) s += p.hpart[(long)(s0 + q) * HYW + c];
        p.hsum[idx] = s;
    }
}
DEV void ph_rstd(const P& p, int nrows, long gt, long gs) {
    GSL(r, nrows) {
        const float* xr = p.xa + r * D; float s = 0.f;
        for (int k = 0; k < D; ++k) s += xr[k] * xr[k];
        p.rstd[r] = rsqrtf(s * (1.0f / D) + EPS);
    }
}
DEV void ph_hx(const P& p, int layer, int which, int nrows, long gt, long gs) {
    const float* g = (which ? p.norm2_g : p.norm1_g) + layer * D;
    GSL(i, (long)nrows * D) {
        const int k = (int)(i % D), r = (int)(i / D); const RowInfo ri = row_info(r);
        const float* mv = p.modv + ((long)layer * 3 + ri.m) * 6 * D + which * 3 * D;
        const float v = p.xa[i] * p.rstd[r] * g[k] * (1.0f + mv[D + k]) + mv[k];
        p.hx[i] = v; p.hxb[i] = f2bf(v);
    }
}
DEV void ph_inproj(const P& p, const float* w, int nin, long gt, long gs) {
    GSL(i, (long)NTOK * nin) {
        const int n = (int)(i % nin), r = (int)(i / nin); const float* a = p.hx + (long)r * D; const float* b = w + n;
        float acc = 0.f;
        for (int k = 0; k < D; ++k) acc += a[k] * b[(long)k * nin];
        p.px[(long)r * PXLD + n] = acc;
    }
}
DEV void ph_sconv(const P& p, int il, long gt, long gs) {
    const float* sw = p.hy_short_w + il * 3 * 1536; const float* sb = p.hy_short_b + il * 1536;
    GSL(i, (long)NTOK * HYW) {
        const int c = (int)(i % HYW), r = (int)(i / HYW); const RowInfo ri = row_info(r);
        float u[3];
#pragma unroll
        for (int s = 0; s < 3; ++s) {
            const int col = s * HYW + c; float acc = sb[col];
#pragma unroll
            for (int j = 0; j < 3; ++j) { const int tt = ri.t + j - 1; if (tt >= 0 && tt < ri.len) acc += sw[j * 1536 + col] * p.px[(long)(ri.base + tt) * PXLD + col]; }
            u[s] = acc;
        }
        p.x0c[i] = u[0]; p.zb[i] = u[2] * u[1]; if (r < NLAT) p.zT[(long)c * NLAT + r] = u[2] * u[1];
    }
}
DEV void ph_lconv(const P& p, int il, int r0, int r1, long gt, long gs) {
    GSL(i0, (long)(r1 - r0) * HYW) {
        const long i = i0 + (long)r0 * HYW;
        const int c = (int)(i % HYW), r = (int)(i / HYW); const RowInfo ri = row_info(r);
        const int L = ri.len, t = ri.t;
        const float* h = p.hraw + filt_row0(il, ri.kind) * HYW + c; const float* z = p.zb + (long)ri.base * HYW + c;
        int s0 = t + L / 2 - (L - 1); if (s0 < 0) s0 = 0; int s1 = t + L / 2; if (s1 > L - 1) s1 = L - 1;
        float acc = 0.f;
#pragma unroll 8
        for (int s = s0; s <= s1; ++s) acc += h[(long)(t - s + L / 2) * HYW] * z[(long)s * HYW];
        const float y = acc / p.hsum[(il * 2 + ri.kind) * HYW + c] + p.hy_bias[il * HYW + c] * p.zb[i];
        MIXST((long)r * D + c, p.x0c[i] * y);
    }
}
constexpr int FFTN = 2 * SEQ, FFT_NS = (SEQ == 8192 ? 7 : SEQ == 2048 ? 6 : SEQ == 512 ? 5 : SEQ == 128 ? 4 : -1);
static_assert(FFT_NS > 0 && (1 << (2 * FFT_NS)) == FFTN, "2*SEQ must be a power of 4");
struct CX { float x, y; };
#define PADX(n) ((n) + ((n) >> 5))
constexpr int FFT_ELEMS = FFTN + (FFTN >> 5);
#ifdef CPU_SHIM
#define COS2PI(f) cosf(6.283185307179586f * (f))
#define SIN2PI(f) sinf(6.283185307179586f * (f))
#define FFT_SYNC()
#else
#define COS2PI(f) __builtin_amdgcn_cosf(f)
#define SIN2PI(f) __builtin_amdgcn_sinf(f)
#define FFT_SYNC() __syncthreads()
#endif
template <class XP> DEV CX cx_ld(XP x, int i) { CX r; r.x = x[i].x; r.y = x[i].y; return r; }
template <class XP> DEV void cx_st(XP x, int i, CX v) { x[i].x = v.x; x[i].y = v.y; }
DEV CX cx_add(CX a, CX b) { return CX{a.x + b.x, a.y + b.y}; }
DEV CX cx_sub(CX a, CX b) { return CX{a.x - b.x, a.y - b.y}; }
DEV CX cx_mul(CX a, CX b) { return CX{a.x * b.x - a.y * b.y, a.x * b.y + a.y * b.x}; }
template <class XP> DEV void fft_pass(XP x, int s, bool inv, int tid, int nthr) {
    const int lq = 2 * (FFT_NS - 1 - s), Q = 1 << lq;
    const float invB = 1.0f / (float)(4 * Q);
    for (int t = tid; t < FFTN / 4; t += nthr) {
        const int i = t & (Q - 1), base = ((t >> lq) << (lq + 2)) + i;
        const float f = (float)i * invB, cs = COS2PI(f), sn = SIN2PI(f);
        const CX w1 = CX{cs, inv ? sn : -sn}, w2 = cx_mul(w1, w1), w3 = cx_mul(w2, w1);
        const int i0 = PADX(base), i1 = PADX(base + Q), i2 = PADX(base + 2 * Q), i3 = PADX(base + 3 * Q);
        const CX a = cx_ld(x, i0), b = cx_ld(x, i1), c = cx_ld(x, i2), d = cx_ld(x, i3);
        if (!inv) {
            const CX t0 = cx_add(a, c), t1 = cx_sub(a, c), t2 = cx_add(b, d), bd = cx_sub(b, d), t3 = CX{bd.y, -bd.x};
            cx_st(x, i0, cx_add(t0, t2)); cx_st(x, i1, cx_mul(cx_add(t1, t3), w1)); cx_st(x, i2, cx_mul(cx_sub(t0, t2), w2)); cx_st(x, i3, cx_mul(cx_sub(t1, t3), w3));
        } else {
            const CX y0 = a, y1 = cx_mul(b, w1), y2 = cx_mul(c, w2), y3 = cx_mul(d, w3);
            const CX u0 = cx_add(y0, y2), u1 = cx_sub(y0, y2), u2 = cx_add(y1, y3), yd = cx_sub(y1, y3), u3 = CX{-yd.y, yd.x};
            cx_st(x, i0, cx_add(u0, u2)); cx_st(x, i1, cx_add(u1, u3)); cx_st(x, i2, cx_sub(u0, u2)); cx_st(x, i3, cx_sub(u1, u3));
        }
    }
}
DEV void bfly4(CX& a, CX& b, CX& c, CX& d, CX w1, bool inv, bool tw) {
    const CX w2 = cx_mul(w1, w1), w3 = cx_mul(w2, w1);
    if (!inv) {
        const CX t0 = cx_add(a, c), t1 = cx_sub(a, c), t2 = cx_add(b, d), bd = cx_sub(b, d), t3 = CX{bd.y, -bd.x};
        a = cx_add(t0, t2); b = cx_add(t1, t3); c = cx_sub(t0, t2); d = cx_sub(t1, t3);
        if (tw) { b = cx_mul(b, w1); c = cx_mul(c, w2); d = cx_mul(d, w3); }
    } else {
        CX y1 = b, y2 = c, y3 = d;
        if (tw) { y1 = cx_mul(b, w1); y2 = cx_mul(c, w2); y3 = cx_mul(d, w3); }
        const CX u0 = cx_add(a, y2), u1 = cx_sub(a, y2), u2 = cx_add(y1, y3), yd = cx_sub(y1, y3), u3 = CX{-yd.y, yd.x};
        a = cx_add(u0, u2); b = cx_add(u1, u3); c = cx_sub(u0, u2); d = cx_sub(u1, u3);
    }
}
template <class XP> DEV void fft_pass16(XP x, int s, bool inv, int tid, int nthr) {
    const int lq2 = 2 * (FFT_NS - 2 - s), Q2 = 1 << lq2, Q = 4 * Q2;
    const float invB = 1.0f / (float)(16 * Q2);
    const float sg = inv ? 1.0f : -1.0f;
    const CX c1 = CX{0.9238795325112867f, sg * 0.3826834323650898f}, c2 = CX{0.7071067811865476f, sg * 0.7071067811865476f}, c3 = CX{0.3826834323650898f, sg * 0.9238795325112867f};
    for (int t = tid; t < FFTN / 16; t += nthr) {
        const int i = t & (Q2 - 1), base = ((t >> lq2) << (lq2 + 4)) + i;
        const float f = (float)i * invB, cs = COS2PI(f), sn = SIN2PI(f);
        const CX wA = CX{cs, sg * sn};
        CX wB = cx_mul(wA, wA); wB = cx_mul(wB, wB);
        CX v[4][4];
#pragma unroll
        for (int a = 0; a < 4; ++a)
#pragma unroll
            for (int b = 0; b < 4; ++b) v[a][b] = cx_ld(x, PADX(base + a * Q + b * Q2));
        if (!inv) {
            bfly4(v[0][0], v[1][0], v[2][0], v[3][0], wA, false, true);
            bfly4(v[0][1], v[1][1], v[2][1], v[3][1], cx_mul(wA, c1), false, true);
            bfly4(v[0][2], v[1][2], v[2][2], v[3][2], cx_mul(wA, c2), false, true);
            bfly4(v[0][3], v[1][3], v[2][3], v[3][3], cx_mul(wA, c3), false, true);
#pragma unroll
            for (int r = 0; r < 4; ++r) bfly4(v[r][0], v[r][1], v[r][2], v[r][3], wB, false, true);
        } else {
#pragma unroll
            for (int r = 0; r < 4; ++r) bfly4(v[r][0], v[r][1], v[r][2], v[r][3], wB, true, true);
            bfly4(v[0][0], v[1][0], v[2][0], v[3][0], wA, true, true);
            bfly4(v[0][1], v[1][1], v[2][1], v[3][1], cx_mul(wA, c1), true, true);
            bfly4(v[0][2], v[1][2], v[2][2], v[3][2], cx_mul(wA, c2), true, true);
            bfly4(v[0][3], v[1][3], v[2][3], v[3][3], cx_mul(wA, c3), true, true);
        }
#pragma unroll
        for (int a = 0; a < 4; ++a)
#pragma unroll
            for (int b = 0; b < 4; ++b) cx_st(x, PADX(base + a * Q + b * Q2), v[a][b]);
    }
}
template <class XP> DEV void fft_pass_last(XP x, bool inv, int tid, int nthr) {
    for (int t = tid; t < FFTN / 4; t += nthr) {
        const int base = 4 * t; CX a = cx_ld(x, PADX(base)), b = cx_ld(x, PADX(base + 1)), c = cx_ld(x, PADX(base + 2)), d = cx_ld(x, PADX(base + 3));
        bfly4(a, b, c, d, CX{1.f, 0.f}, inv, false);
        cx_st(x, PADX(base), a); cx_st(x, PADX(base + 1), b); cx_st(x, PADX(base + 2), c); cx_st(x, PADX(base + 3), d);
    }
}
static_assert(FFT_NS % 2 == 1, "pass schedule: (FFT_NS - 1) / 2 radix-16 passes + one radix-4 pass");
template <class XP> DEV void fft_forward(XP x, int tid, int nthr) {
    for (int s = 0; s + 1 < FFT_NS; s += 2) { fft_pass16(x, s, false, tid, nthr); FFT_SYNC(); }
    fft_pass_last(x, false, tid, nthr); FFT_SYNC();
}
template <class XP> DEV void fft_inverse(XP x, int tid, int nthr) {
    fft_pass_last(x, true, tid, nthr); FFT_SYNC();
    for (int s = FFT_NS - 3; s >= 0; s -= 2) { fft_pass16(x, s, true, tid, nthr); FFT_SYNC(); }
}
template <class XP> DEV void lconv_unit(const P& p, int il, int c, XP x, float* zf, int tid, int nthr) {
    constexpr int L = SEQ, N = FFTN;
    const float* zc = p.zT + (long)c * NLAT;
#pragma unroll 8
    for (int n = tid; n < L; n += nthr) { CX v; v.x = zc[n]; v.y = zc[SEQ + n]; cx_st(x, PADX(n), v); }
#pragma unroll 8
    for (int n = L + tid; n < N; n += nthr) cx_st(x, PADX(n), CX{0.f, 0.f});
    FFT_SYNC();
    fft_forward(x, tid, nthr);
    const float* h = p.hT + ((long)il * HYW + c) * SEQ;
#pragma unroll 8
    for (int n = tid; n < L; n += nthr) { const float hv = h[n]; const CX v = cx_ld(x, PADX(n)); zf[2 * n] = v.x; zf[2 * n + 1] = v.y; cx_st(x, PADX(n), CX{hv, 0.f}); }
#pragma unroll 8
    for (int n = L + tid; n < N; n += nthr) { const CX v = cx_ld(x, PADX(n)); zf[2 * n] = v.x; zf[2 * n + 1] = v.y; cx_st(x, PADX(n), CX{0.f, 0.f}); }
    FFT_SYNC();
    fft_forward(x, tid, nthr);
#ifndef CPU_SHIM
    asm volatile("s_waitcnt vmcnt(0)" ::: "memory");
#endif
#pragma unroll 8
    for (int n = tid; n < N; n += nthr) { const CX zv{zf[2 * n], zf[2 * n + 1]}; const CX hv = cx_ld(x, PADX(n)); cx_st(x, PADX(n), cx_mul(hv, zv)); }
    FFT_SYNC();
    fft_inverse(x, tid, nthr);
    const float scale = 1.0f / ((float)N * p.hsum[(il * 2 + 0) * HYW + c]);
    float* o = p.convT + (long)c * NLAT;
#pragma unroll 8
    for (int t = tid; t < L; t += nthr) { const CX v = cx_ld(x, PADX(t + L / 2)); o[t] = v.x * scale; o[L + t] = v.y * scale; }
    FFT_SYNC();
}
#ifdef CPU_SHIM
DEV void ph_lconv_fft(const P& p, int il, long gt, long gs) {
    CX* x = (CX*)malloc(sizeof(CX) * FFT_ELEMS);
    GSL(c, HYW) { lconv_unit(p, il, (int)c, x, p.zf + gt * 2 * FFTN, 0, 1); }
    free(x);
}
#endif
DEV void ph_hymix(const P& p, int il, long gt, long gs) {
    GSL(i, (long)NLAT * HYW) {
        const int c = (int)(i % HYW), r = (int)(i / HYW);
        const float y = p.convT[(long)c * NLAT + r] + p.hy_bias[il * HYW + c] * p.zb[i];
        MIXST((long)r * D + c, p.x0c[i] * y);
    }
}
DEV int scan_row(int dir, int b, int n) {
    if (n < CTXL) return NLAT + b * CTXL + (dir ? CTXL - 1 - n : n);
    const int m = n - CTXL; return b * SEQ + (dir ? SEQ - 1 - m : m);
}
constexpr int S5C = 64, S5NCH = (CTXL + SEQ) / S5C;
struct S5Par { float lbr, lbi; float bbr[GH], bbi[GH]; };
DEV void s5_par(const P& p, int il, int dir, int g, int pp, S5Par& q) {
    const int gi = (il * 2 + dir) * NG + g;
    const float lre = fminf(p.s5_lre[gi * NP + pp], -1e-4f), lim = p.s5_lim[gi * NP + pp], dt = expf(p.s5_ldt[gi]);
    const float mag = expf(lre * dt); q.lbr = mag * cosf(lim * dt); q.lbi = mag * sinf(lim * dt);
    const float nr = q.lbr - 1.0f, ni = q.lbi, den = lre * lre + lim * lim;
    const float fr = (nr * lre + ni * lim) / den, fi = (ni * lre - nr * lim) / den;
#pragma unroll
    for (int h = 0; h < GH; ++h) { const float br = p.s5_bre[((long)gi * NP + pp) * GH + h], bi = p.s5_bim[((long)gi * NP + pp) * GH + h]; q.bbr[h] = fr * br - fi * bi; q.bbi[h] = fr * bi + fi * br; }
}
DEV void ph_s5chunk(const P& p, int il, int fill, long gt, long gs) {
    GSL(i, 2L * 2 * S5NCH * NG * NP) {
        const int pp = (int)(i % NP), g = (int)((i / NP) % NG), ch = (int)((i / (NP * NG)) % S5NCH), b = (int)((i / ((long)NP * NG * S5NCH)) % 2), dir = (int)(i / ((long)NP * NG * S5NCH * 2));
        S5Par q; s5_par(p, il, dir, g, pp, q);
        float* ce = p.s5c + ((((long)dir * 2 + b) * S5NCH + ch) * NG + g) * NP * 2 + pp * 2;
        float sr = 0.f, si = 0.f;
        if (fill) { sr = ce[0]; si = ce[1]; }
        for (int k = 0; k < S5C; ++k) {
            const int row = scan_row(dir, b, ch * S5C + k); const float* u = p.px + (long)row * PXLD + 1536 + g * GH;
            float ar = 0.f, ai = 0.f;
#pragma unroll
            for (int h = 0; h < GH; ++h) { ar += q.bbr[h] * u[h]; ai += q.bbi[h] * u[h]; }
            const float tr = q.lbr * sr - q.lbi * si + ar, ti = q.lbr * si + q.lbi * sr + ai; sr = tr; si = ti;
            if (fill) { float* o = p.s5s + (((long)dir * NTOK + row) * NG + g) * NP * 2 + pp * 2; o[0] = sr; o[1] = si; }
        }
        if (!fill) { ce[0] = sr; ce[1] = si; }
    }
}
DEV void ph_s5carry(const P& p, int il, long gt, long gs) {
    GSL(i, 2 * 2 * NG * NP) {
        const int pp = (int)(i % NP), g = (int)((i / NP) % NG), b = (int)((i / (NP * NG)) % 2), dir = (int)(i / (NP * NG * 2));
        S5Par q; s5_par(p, il, dir, g, pp, q);
        float pr = q.lbr, pi = q.lbi;
#pragma unroll
        for (int t = 0; t < 6; ++t) { const float nr = pr * pr - pi * pi, ni = 2.0f * pr * pi; pr = nr; pi = ni; }
        float cr = 0.f, ci = 0.f;
        float* ce0 = p.s5c + ((((long)dir * 2 + b) * S5NCH) * NG + g) * NP * 2 + pp * 2;
        constexpr int CB = 12;
        for (int c0 = 0; c0 < S5NCH; c0 += CB) {
            float er[CB], ei[CB];
#pragma unroll
            for (int j = 0; j < CB; ++j) if (c0 + j < S5NCH) { const float* ce = ce0 + (long)(c0 + j) * NG * NP * 2; er[j] = ce[0]; ei[j] = ce[1]; }
#pragma unroll
            for (int j = 0; j < CB; ++j) if (c0 + j < S5NCH) { float* ce = ce0 + (long)(c0 + j) * NG * NP * 2; ce[0] = cr; ce[1] = ci;
                const float tr = pr * cr - pi * ci + er[j], ti = pr * ci + pi * cr + ei[j]; cr = tr; ci = ti; }
        }
    }
}
DEV void ph_s5out(const P& p, int il, long gt, long gs) {
    GSL(i, (long)NTOK * S5W) {
        const int ch = (int)(i % S5W), r = (int)(i / S5W), g = ch / GH, h = ch % GH;
        float y = p.s5_d[il * S5W + ch] * p.px[(long)r * PXLD + 1536 + ch];
        for (int dir = 0; dir < 2; ++dir) {
            const long ci = (((long)(il * 2 + dir) * NG + g) * GH + h) * NP;
            const float* s = p.s5s + (((long)dir * NTOK + r) * NG + g) * NP * 2;
            for (int pp = 0; pp < NP; ++pp) y += p.s5_cre[ci + pp] * s[pp * 2] - p.s5_cim[ci + pp] * s[pp * 2 + 1];
        }
        { const float gy = gelu_tanhf_(y); p.ys5[i] = gy; p.ys5b[i] = f2bf(gy); }
    }
}
DEV void ph_s5fin(const P& p, int il, long gt, long gs) {
    GSL(i, (long)NTOK * S5W) {
        const int ch = (int)(i % S5W), r = (int)(i / S5W);
        const float y = p.s5_d[il * S5W + ch] * p.px[(long)r * PXLD + 1536 + ch] + p.yd[i] + p.yd[(long)NTOK * S5W + i];
        const float gy = gelu_tanhf_(y); p.ys5b[i] = f2bf(gy);
#ifdef CPU_SHIM
        p.ys5[i] = gy;
#endif
    }
}
DEV void ph_glu(const P& p, int il, long gt, long gs) {
    const float* w = p.s5_glu_w + (long)il * S5W * S5W;
    GSL(i, (long)NTOK * S5W) {
        const int ch = (int)(i % S5W), r = (int)(i / S5W); const float* a = p.ys5 + (long)r * S5W;
        float acc = p.s5_glu_b[il * S5W + ch];
        for (int k = 0; k < S5W; ++k) acc += a[k] * w[(long)k * S5W + ch];
        MIXST((long)r * D + HYW + ch, a[ch] * sigmoidf_(acc));
    }
}
DEV void ph_rope(const P& p, long gt, long gs) {
    GSL(i, (long)NTOK * 576) {
        const int it = (int)(i % 576), r = (int)(i / 576); const RowInfo ri = row_info(r); const float* pr = p.px + (long)r * PXLD;
        if (it < 256) {
            const int isk = it >= 128, hd = it & 127, h = hd >> 5, d = hd & 31;
            const float* src = pr + (isk ? 256 : 0) + h * 64; float x1 = src[d], x2 = src[d + 32];
            if (ri.kind == 0) { const float inv = exp2f(-(float)d * (13.287712379549449f / 32.0f)), ang = (float)ri.t * inv, cs = ROPE_COS(ang), sn = ROPE_SIN(ang);
                const float y1 = x1 * cs - x2 * sn, y2 = x1 * sn + x2 * cs; x1 = y1; x2 = y2; }
            const float sc = isk ? 1.0f : 0.125f;
            float* dst = (isk ? p.kr : p.qr) + (long)r * 256 + h * 64; dst[d] = x1 * sc; dst[d + 32] = x2 * sc;
        } else {
            const int j = it - 256, isk = j >= 256, hd = isk ? j - 256 : j, h = hd >> 5, e = hd & 31, half = e >> 4, d = e & 15;
            const float* src = pr + (isk ? 2048 : 1536) + h * 64 + half * 32; float x1 = src[d], x2 = src[d + 16];
            if (ri.kind == 0) { const float pos = (float)(half ? (ri.t % 64) : (ri.t / 64)); const float inv = exp2f(-(float)d * (13.287712379549449f / 16.0f)), ang = pos * inv, cs = ROPE_COS(ang), sn = ROPE_SIN(ang);
                const float y1 = x1 * cs - x2 * sn, y2 = x1 * sn + x2 * cs; x1 = y1; x2 = y2; }
            const float sc = isk ? 1.0f : 0.125f;
            float* dst = (isk ? p.ks + (long)r * 128 : p.qs + (long)r * 512) + h * 64 + half * 32; dst[d] = x1 * sc; dst[d + 16] = x2 * sc;
        }
    }
}
constexpr int RC = 128, RNCH = (CTXL + SEQ) / RC;
DEV float ret_logg(const P& p, int il, int dir, int h) { const float dl = p.ret_decay[(il * 2 + dir) * 4 + h]; return -log1pf(expf(-dl)); }
DEV void ph_retkv(const P& p, int il, long gt, long gs) {
    GSL(i, 2L * 2 * RNCH * 4 * 64 * 128) {
        const int e = (int)(i % 128), d = (int)((i / 128) % 64), h = (int)((i / 8192) % 4), n = (int)((i / 32768) % RNCH), b = (int)((i / (32768L * RNCH)) % 2), dir = (int)(i / (32768L * RNCH * 2));
        const float lg = ret_logg(p, il, dir, h);
        float acc = 0.f;
        for (int j = 0; j < RC; ++j) { const int row = scan_row(dir, b, n * RC + j);
            acc += expf((float)(RC - 1 - j) * lg) * p.kr[(long)row * 256 + h * 64 + d] * p.px[(long)row * PXLD + 512 + h * 128 + e]; }
        p.rkv[i] = acc;
    }
}
DEV void ph_retcarry(const P& p, int il, long gt, long gs) {
    GSL(i, 2L * 2 * 4 * 64 * 128) {
        const int de = (int)(i % 8192), h = (int)((i / 8192) % 4), b = (int)((i / 32768) % 2), dir = (int)(i / 65536);
        const float gc = expf((float)RC * ret_logg(p, il, dir, h));
        float S = 0.f;
        float* q0 = p.rkv + ((((long)dir * 2 + b) * RNCH) * 4 + h) * 8192 + de;
        constexpr int CB = 11;
        for (int n0 = 0; n0 < RNCH; n0 += CB) {
            float kv[CB];
#pragma unroll
            for (int j = 0; j < CB; ++j) if (n0 + j < RNCH) kv[j] = q0[(long)(n0 + j) * 4 * 8192];
#pragma unroll
            for (int j = 0; j < CB; ++j) if (n0 + j < RNCH) { q0[(long)(n0 + j) * 4 * 8192] = S; S = gc * S + kv[j]; }
        }
    }
}
DEV void ph_retsc(const P& p, int il, long gt, long gs) {
    GSL(i, 2L * NTOK * 4 * RC) {
        const int j = (int)(i % RC), h = (int)((i / RC) % 4), r = (int)((i / (RC * 4)) % NTOK), dir = (int)(i / ((long)RC * 4 * NTOK)); const RowInfo ri = row_info(r);
        const int b = ri.kind ? (ri.base - NLAT) / CTXL : ri.base / SEQ;
        const int step = ri.kind ? (dir ? CTXL - 1 - ri.t : ri.t) : CTXL + (dir ? SEQ - 1 - ri.t : ri.t), ii = step % RC, n = step / RC;
        float sc = 0.f;
        if (j <= ii) { const int rj = scan_row(dir, b, n * RC + j); const float* q = p.qr + (long)r * 256 + h * 64; const float* k = p.kr + (long)rj * 256 + h * 64;
            float dot = 0.f;
            for (int d = 0; d < 64; ++d) dot += q[d] * k[d];
            sc = dot * expf((float)(ii - j) * ret_logg(p, il, dir, h)); }
        p.rsc[i] = sc;
    }
}
DEV void ph_reto(const P& p, int il, long gt, long gs) {
    GSL(i, 2L * NTOK * 512) {
        const int e = (int)(i % 128), h = (int)((i / 128) % 4), r = (int)((i / 512) % NTOK), dir = (int)(i / (512L * NTOK)); const RowInfo ri = row_info(r);
        const int b = ri.kind ? (ri.base - NLAT) / CTXL : ri.base / SEQ;
        const int step = ri.kind ? (dir ? CTXL - 1 - ri.t : ri.t) : CTXL + (dir ? SEQ - 1 - ri.t : ri.t), ii = step % RC, n = step / RC;
        const float* sc = p.rsc + (((long)dir * NTOK + r) * 4 + h) * RC;
        float acc = 0.f;
        for (int j = 0; j <= ii; ++j) { const int rj = scan_row(dir, b, n * RC + j); acc += sc[j] * p.px[(long)rj * PXLD + 512 + h * 128 + e]; }
        const float* S = p.rkv + ((((long)dir * 2 + b) * RNCH + n) * 4 + h) * 8192 + e; const float* q = p.qr + (long)r * 256 + h * 64;
        float cr = 0.f;
        for (int d = 0; d < 64; ++d) cr += q[d] * S[d * 128];
        p.oret[((long)dir * NTOK + r) * 512 + h * 128 + e] = acc + cr * expf((float)(ii + 1) * ret_logg(p, il, dir, h));
    }
}
DEV void ph_retout(const P& p, int nrows, long gt, long gs) {
    GSL(i, (long)nrows * 4) {
        const int h = (int)(i % 4), r = (int)(i / 4);
        const float* o0 = p.oret + (long)r * 512 + h * 128; const float* o1 = p.oret + ((long)NTOK + r) * 512 + h * 128;
        float ss = 0.f;
        for (int e = 0; e < 128; ++e) { const float o = o0[e] + o1[e]; ss += o * o; }
        const float rs = rsqrtf(ss * (1.0f / 128.0f) + EPS);
        for (int e = 0; e < 128; ++e) MIXST((long)r * D + h * 128 + e, (o0[e] + o1[e]) * rs * siluf_(p.px[(long)r * PXLD + 1024 + h * 128 + e]));
    }
}
DEV void ph_swa(const P& p, int il, int nrows, long gt, long gs) {
    GSL(i, (long)nrows * 8) {
        const int hq = (int)(i % 8), r = (int)(i / 8), kv = hq >> 2; const RowInfo ri = row_info(r);
        const int b = ri.kind ? (ri.base - NLAT) / CTXL : ri.base / SEQ;
        float q[64], acc[64];
#pragma unroll
        for (int d = 0; d < 64; ++d) { q[d] = p.qs[(long)r * 512 + hq * 64 + d]; acc[d] = 0.f; }
        float m = p.swa_sink[il * 8 + hq], l = 1.0f;
        for (int part = 0; part < 2; ++part) {
            int k0, k1;
            if (part == 0) { if (ri.kind) continue; k0 = ri.base + (ri.t - 128 < 0 ? 0 : ri.t - 128); k1 = ri.base + (ri.t + 128 > SEQ - 1 ? SEQ - 1 : ri.t + 128); }
            else { k0 = NLAT + b * CTXL; k1 = k0 + CTXL - 1; }
            for (int kr = k0; kr <= k1; ++kr) {
                const float* kk = p.ks + (long)kr * 128 + kv * 64; const float* vv = p.px + (long)kr * PXLD + 2176 + kv * 64;
                float s = 0.f;
#pragma unroll
                for (int d = 0; d < 64; ++d) s += q[d] * kk[d];
                const float mn = fmaxf(m, s), corr = expf(m - mn), pe = expf(s - mn);
                l = l * corr + pe; m = mn;
#pragma unroll
                for (int d = 0; d < 64; ++d) acc[d] = acc[d] * corr + pe * vv[d];
            }
        }
        const float il_ = 1.0f / l;
#pragma unroll
        for (int d = 0; d < 64; ++d) MIXST((long)r * D + 512 + hq * 64 + d, acc[d] * il_);
    }
}
DEV void ph_outproj(const P& p, int layer, const float* w, int nrows, long gt, long gs) {
    GSL(i, (long)nrows * D) {
        const int n = (int)(i % D), r = (int)(i / D); const RowInfo ri = row_info(r);
        const float* a = p.mixin + (long)r * D; const float* b = w + n;
        float acc = 0.f;
        for (int k = 0; k < D; ++k) acc += a[k] * b[(long)k * D];
        p.xa[i] += p.modv[((long)layer * 3 + ri.m) * 6 * D + 2 * D + n] * acc;
    }
}
DEV int atomic_inc(int* q) {
#ifdef CPU_SHIM
    return __atomic_fetch_add(q, 1, __ATOMIC_RELAXED);
#else
    return atomicAdd(q, 1);
#endif
}
DEV void ph_router(const P& p, int layer, int nrows, long gt, long gs) {
    const float* rw = p.router_w + (long)layer * D * NE;
    GSL(j, NSLOT) { p.slot_tok[j] = -1; p.slot_gate[j] = 0.f; }
    GSL(r, nrows) {
        float lg[NE];
#pragma unroll
        for (int e = 0; e < NE; ++e) lg[e] = p.router_b[layer * NE + e];
        const float* a = p.hx + (long)r * D;
        for (int k = 0; k < D; ++k) { const float av = a[k];
#pragma unroll
            for (int e = 0; e < NE; ++e) lg[e] += av * rw[k * NE + e]; }
        int ti[4]; float tv[4];
#pragma unroll
        for (int s = 0; s < 4; ++s) { int best = 0; float bv = -3.0e38f;
#pragma unroll
            for (int e = 0; e < NE; ++e) { if (lg[e] > bv) { bv = lg[e]; best = e; } }
            ti[s] = best; tv[s] = bv;
#pragma unroll
            for (int e = 0; e < NE; ++e) if (e == best) lg[e] = -3.0e38f; }
        const float e1 = expf(tv[1] - tv[0]), e2 = expf(tv[2] - tv[0]), e3 = expf(tv[3] - tv[0]), inv = 1.0f / (1.0f + e1 + e2 + e3);
        p.topi[r * 4 + 0] = ti[0]; p.topi[r * 4 + 1] = ti[1]; p.topi[r * 4 + 2] = ti[2]; p.topi[r * 4 + 3] = ti[3];
        p.topg[r * 4 + 0] = inv; p.topg[r * 4 + 1] = e1 * inv; p.topg[r * 4 + 2] = e2 * inv; p.topg[r * 4 + 3] = e3 * inv;
#pragma unroll
        for (int s = 0; s < 4; ++s) p.pos[r * 4 + s] = atomic_inc(p.cnt + layer * NE + ti[s]);
    }
}
DEV int moe_tiles(const int* cnt) { int t = 0; for (int e = 0; e < NE; ++e) t += (cnt[e] + 255) >> 8; return t; }
DEV int tile_expert(const int* cnt, int pm) { int t = 0; for (int e = 0; e < NE; ++e) { t += (cnt[e] + 255) >> 8; if (pm < t) return e; } return NE - 1; }
DEV void ph_assign(const P& p, int layer, int nrows, long gt, long gs) {
    const int* cnt = p.cnt + layer * NE;
    GSL(i, (long)nrows * 4) {
        const int e = p.topi[i]; int off = 0;
        for (int q = 0; q < e; ++q) off += ((cnt[q] + 255) >> 8) << 8;
        const int slot = off + p.pos[i];
        p.slot_of[i] = slot; p.slot_tok[slot] = (int)(i >> 2); p.slot_gate[slot] = p.topg[i];
    }
}
DEV void ph_gather(const P& p, int layer, long gt, long gs) {
    const long used = (long)moe_tiles(p.cnt + layer * NE) * 256;
    GSL(i, used * D) { const int k = (int)(i % D); const long slot = i / D; const int tok = p.slot_tok[slot]; p.xb[i] = tok >= 0 ? p.hxb[(long)tok * D + k] : (bf16_t)0; }
}
DEV void ph_moe1s(const P& p, int layer, long gt, long gs) {
    const int* cnt = p.cnt + layer * NE; const long used = (long)moe_tiles(cnt) * 256;
    GSL(i, used * DFF) {
        const int j = (int)(i % DFF); const long slot = i / DFF; const int e = tile_expert(cnt, (int)(slot >> 8));
        const float* w = p.w_gu + ((long)layer * NE + e) * D * 2 * DFF + j; const bf16_t* a = p.xb + slot * D;
        const float* bb = p.b_gu + ((long)layer * NE + e) * 2 * DFF;
        float ga = bb[j], up = bb[DFF + j];
        for (int k = 0; k < D; ++k) { const float av = bf2f(a[k]); ga += av * w[(long)k * 2 * DFF]; up += av * w[(long)k * 2 * DFF + DFF]; }
        ga = fminf(ga, 7.0f); up = fminf(fmaxf(up, -7.0f), 7.0f);
        p.actb[i] = f2bf(ga * sigmoidf_(1.702f * ga) * (up + 1.0f));
    }
}
DEV void ph_moe2s(const P& p, int layer, long gt, long gs) {
    const int* cnt = p.cnt + layer * NE; const long used = (long)moe_tiles(cnt) * 256;
    GSL(i, used * D) {
        const int n = (int)(i % D); const long slot = i / D; const int e = tile_expert(cnt, (int)(slot >> 8));
        const float* w = p.w_dn + ((long)layer * NE + e) * DFF * D + n; const bf16_t* a = p.actb + slot * DFF;
        float acc = p.b_dn[((long)layer * NE + e) * D + n];
        for (int k = 0; k < DFF; ++k) acc += bf2f(a[k]) * w[(long)k * D];
        p.yb[i] = f2bf(acc * p.slot_gate[slot]);
    }
}
DEV void ph_combine(const P& p, int layer, int nrows, long gt, long gs) {
    GSL(i, (long)nrows * D) {
        const int n = (int)(i % D), r = (int)(i / D); const RowInfo ri = row_info(r);
        float y = 0.f;
#pragma unroll
        for (int s = 0; s < 4; ++s) y += bf2f(p.yb[(long)p.slot_of[r * 4 + s] * D + n]);
        p.xa[i] += p.modv[((long)layer * 3 + ri.m) * 6 * D + 5 * D + n] * y;
    }
}
DEV void ph_final(const P& p, long gt, long gs) {
    GSL(i, (long)NLAT * D) { const int k = (int)(i % D), r = (int)(i / D); p.out[i] = p.xa[i] * p.rstd[r] * p.final_g[k]; }
}

constexpr int N_SETUP = 6, N_SLOT = 18;
#ifdef CPU_SHIM
#define SWA_NAIVE ph_swa(p, il, nrows, gt, gs);
#define S5_NAIVE(x) x
#define S5_FIN ph_s5out(p, il, gt, gs);
#define RET_NAIVE_A ph_retkv(p, il, gt, gs); ph_retsc(p, il, gt, gs);
#define RET_NAIVE_C ph_reto(p, il, gt, gs);
#else
#define SWA_NAIVE
#define S5_NAIVE(x)
#define S5_FIN ph_s5fin(p, il, gt, gs);
#define RET_NAIVE_A
#define RET_NAIVE_C
#endif
#ifdef CPU_SHIM
#define LCONV_LAT(p, il, gt, gs) ph_lconv_fft(p, il, gt, gs)
#else
#define LCONV_LAT(p, il, gt, gs)
#endif
template <int S> DEV void setup_slot(const P& p, long gt, long gs) {
    if constexpr (S == 0) { ph_init(p, gt, gs); ph_mod(p, gt, gs); }
    if constexpr (S == 1) { ph_mod2(p, gt, gs); ph_filt1(p, gt, gs); }
    if constexpr (S == 2) ph_filt2(p, gt, gs);
    if constexpr (S == 3) ph_filt3(p, gt, gs);
    if constexpr (S == 4) ph_filt4a(p, gt, gs);
    if constexpr (S == 5) ph_filt4(p, gt, gs);
}
template <int S> DEV void layer_slot(const P& p, int layer, long gt, long gs) {
    const int il = layer >> 1; const bool ab = !(layer & 1);
    const int nrows = layer < 3 ? NTOK : NLAT;
    if constexpr (S == 0) ph_rstd(p, NTOK, gt, gs);
    if constexpr (S == 1) ph_hx(p, layer, 0, NTOK, gt, gs);
    if constexpr (S == 2) { if (ab) ph_inproj(p, p.ab_w_in + (long)il * D * AB_IN, AB_IN, gt, gs); else ph_inproj(p, p.cd_w_in + (long)il * D * CD_IN, CD_IN, gt, gs); }
    if constexpr (S == 3) { if (ab) { ph_sconv(p, il, gt, gs); S5_NAIVE(ph_s5chunk(p, il, 0, gt, gs);) } else ph_rope(p, gt, gs); }
    if constexpr (S == 4) { if (ab) { LCONV_LAT(p, il, gt, gs); ph_lconv(p, il, NLAT, NTOK, gt, gs); ph_s5carry(p, il, gt, gs); } else { RET_NAIVE_A } }
    if constexpr (S == 5) { if (ab) { ph_hymix(p, il, gt, gs); S5_NAIVE(ph_s5chunk(p, il, 1, gt, gs);) } else { ph_retcarry(p, il, gt, gs); SWA_NAIVE } }
    if constexpr (S == 6) { if (ab) { S5_FIN } else { RET_NAIVE_C } }
    if constexpr (S == 7) { if (ab) ph_glu(p, il, gt, gs); else ph_retout(p, nrows, gt, gs); }
    if constexpr (S == 8) ph_outproj(p, layer, (ab ? p.ab_w_out : p.cd_w_out) + (long)il * D * D, nrows, gt, gs);
    if constexpr (S == 9) ph_rstd(p, nrows, gt, gs);
    if constexpr (S == 10) ph_hx(p, layer, 1, nrows, gt, gs);
    if constexpr (S == 11) ph_router(p, layer, nrows, gt, gs);
    if constexpr (S == 12) ph_assign(p, layer, nrows, gt, gs);
    if constexpr (S == 13) ph_gather(p, layer, gt, gs);
    if constexpr (S == 14) ph_moe1s(p, layer, gt, gs);
    if constexpr (S == 15) ph_moe2s(p, layer, gt, gs);
    if constexpr (S == 16) ph_combine(p, layer, nrows, gt, gs);
}
template <int S> DEV void final_slot(const P& p, long gt, long gs) {
    if constexpr (S == 0) ph_rstd(p, NLAT, gt, gs);
    if constexpr (S == 1) ph_final(p, gt, gs);
}

struct WsMap { size_t off[56]; size_t total; };
static inline WsMap ws_map() {
    WsMap m; size_t o = 0; int n = 0;
    auto take = [&](size_t bytes) { m.off[n++] = o; o += (bytes + 255) & ~(size_t)255; };
    take(16384);
    take((size_t)NTOK * D * 4);
    take((size_t)4 * 3 * 6 * D * 4);
    take((size_t)2 * (SEQ + CTXL) * 64 * 4);
    take((size_t)2 * (SEQ + CTXL) * 64 * 4);
    take((size_t)2 * (SEQ + CTXL) * HYW * 4);
    take((size_t)2 * 2 * HYW * 4);
    take((size_t)NTOK * 4);
    take((size_t)NTOK * D * 4);
    take((size_t)NTOK * PXLD * 4);
    take((size_t)NTOK * HYW * 4);
    take((size_t)NTOK * HYW * 4);
    take((size_t)NTOK * D * 4);
    take((size_t)2 * NTOK * NG * NP * 2 * 4);
    take((size_t)NTOK * S5W * 4);
    take((size_t)NTOK * 256 * 4);
    take((size_t)NTOK * 256 * 4);
    take((size_t)2 * NTOK * 512 * 4);
    take((size_t)NTOK * 512 * 4);
    take((size_t)NTOK * 128 * 4);
    take((size_t)NTOK * 4 * 4);
    take((size_t)NTOK * 4 * 4);
    take(256);
    take((size_t)(NTOK + 1) * D * 2);
    take((size_t)NTOK * D * 2);
    take((size_t)NTOK * S5W * 2);
    take((size_t)NSLOT * D * 2);
    take((size_t)NSLOT * DFF * 2);
    take((size_t)NSLOT * D * 4);
    take((size_t)NSLOT * 4);
    take((size_t)4 * NE * 4);
    take((size_t)NTOK * 4 * 4);
    take((size_t)NTOK * 4 * 4);
    take((size_t)NSLOT * 4);
    take((size_t)2 * AB_IN * D * 2);
    take((size_t)2 * CD_IN * D * 2);
    take((size_t)2 * D * D * 2);
    take((size_t)2 * D * D * 2);
    take((size_t)2 * S5W * S5W * 2);
    take((size_t)4 * NE * 2 * DFF * D * 2);
    take((size_t)4 * NE * D * DFF * 2);
    take((size_t)2 * 2 * S5NCH * NG * NP * 2 * 4);
    take((size_t)2 * 2 * RNCH * 4 * 8192 * 4);
    take((size_t)2 * NTOK * 4 * RC * 4);
    take((size_t)2 * FNSEG * HYW * 4);
    take((size_t)256 * 2 * FFTN * 4);
    take((size_t)HYW * NLAT * 4);
    take((size_t)2 * NTOK * S5W * 4);
    take((size_t)HYW * NLAT * 4);
    take((size_t)2 * HYW * SEQ * 4);
    take((size_t)8 * 4 * 3 * 6 * D * 4);
    m.total = o; return m;
}
static inline void fill_params(P& p, void* const* d_in, void* d_out, void* d_ws) {
    const float* const* in = (const float* const*)d_in;
    p.x = in[0]; p.c = in[1]; p.ctx = in[2]; p.c_ctx = in[3]; p.mod_w = in[4]; p.mod_b = in[5]; p.norm1_g = in[6]; p.norm2_g = in[7];
    p.ab_w_in = in[8]; p.ab_w_out = in[9]; p.hy_short_w = in[10]; p.hy_short_b = in[11]; p.hy_f_w1 = in[12]; p.hy_f_b1 = in[13];
    p.hy_f_w2 = in[14]; p.hy_f_b2 = in[15]; p.hy_f_w3 = in[16]; p.hy_bias = in[17]; p.s5_lre = in[18]; p.s5_lim = in[19]; p.s5_ldt = in[20];
    p.s5_bre = in[21]; p.s5_bim = in[22]; p.s5_cre = in[23]; p.s5_cim = in[24]; p.s5_d = in[25]; p.s5_glu_w = in[26]; p.s5_glu_b = in[27];
    p.cd_w_in = in[28]; p.cd_w_out = in[29]; p.ret_decay = in[30]; p.swa_sink = in[31]; p.router_w = in[32]; p.router_b = in[33];
    p.w_gu = in[34]; p.b_gu = in[35]; p.w_dn = in[36]; p.b_dn = in[37]; p.final_g = in[38];
    p.out = (float*)d_out;
    const WsMap m = ws_map(); char* w = (char*)d_ws;
    p.bar = (unsigned*)(w + m.off[0]); p.xa = (float*)(w + m.off[1]); p.modv = (float*)(w + m.off[2]); p.f1 = (float*)(w + m.off[3]); p.f2 = (float*)(w + m.off[4]);
    p.hraw = (float*)(w + m.off[5]); p.hsum = (float*)(w + m.off[6]); p.rstd = (float*)(w + m.off[7]); p.hx = (float*)(w + m.off[8]); p.px = (float*)(w + m.off[9]);
    p.zb = (float*)(w + m.off[10]); p.x0c = (float*)(w + m.off[11]); p.mixin = (float*)(w + m.off[12]); p.s5s = (float*)(w + m.off[13]); p.ys5 = (float*)(w + m.off[14]);
    p.qr = (float*)(w + m.off[15]); p.kr = (float*)(w + m.off[16]); p.oret = (float*)(w + m.off[17]); p.qs = (float*)(w + m.off[18]); p.ks = (float*)(w + m.off[19]);
    p.topg = (float*)(w + m.off[20]); p.topi = (int*)(w + m.off[21]); p.act = nullptr;
    p.hxb = (bf16_t*)(w + m.off[23]); p.mixb = (bf16_t*)(w + m.off[24]); p.ys5b = (bf16_t*)(w + m.off[25]); p.xb = (bf16_t*)(w + m.off[26]); p.actb = (bf16_t*)(w + m.off[27]);
    p.yb = (bf16_t*)(w + m.off[28]); p.slot_gate = (float*)(w + m.off[29]); p.cnt = (int*)(w + m.off[30]); p.pos = (int*)(w + m.off[31]); p.slot_of = (int*)(w + m.off[32]);
    p.slot_tok = (int*)(w + m.off[33]); p.abin_t = (bf16_t*)(w + m.off[34]); p.cdin_t = (bf16_t*)(w + m.off[35]); p.about_t = (bf16_t*)(w + m.off[36]);
    p.cdout_t = (bf16_t*)(w + m.off[37]); p.glu_t = (bf16_t*)(w + m.off[38]); p.wgu_t = (bf16_t*)(w + m.off[39]); p.wdn_t = (bf16_t*)(w + m.off[40]);
    p.s5c = (float*)(w + m.off[41]); p.rkv = (float*)(w + m.off[42]); p.rsc = (float*)(w + m.off[43]); p.hpart = (float*)(w + m.off[44]);
    p.zf = (float*)(w + m.off[45]); p.convT = (float*)(w + m.off[46]); p.yd = (float*)(w + m.off[47]); p.zT = (float*)(w + m.off[48]); p.hT = (float*)(w + m.off[49]); p.modp = (float*)(w + m.off[50]);
}

#ifndef CPU_SHIM
namespace pg8 {
#define PG8_LAS __attribute__((address_space(3)))
typedef short bf16x8 __attribute__((ext_vector_type(8)));
typedef float f32x4 __attribute__((ext_vector_type(4)));
constexpr int BM = 256, BK = 64, HALF = 128, HTB = HALF * BK * 2, STAGE_BYTES = 8 * HTB, NXCD = 8, WGM = 8;
__host__ __device__ __forceinline__ int lds_byte(int r, int c) { const int st = (r >> 4) * 2 + (c >> 5), rr = r & 15, cc = c & 31, ob = rr * 64 + cc * 2; return st * 1024 + (ob ^ (((ob >> 9) & 1) << 5)); }
__host__ __device__ __forceinline__ void stage_rc(int b, int& R, int& C) { const int st = b / 1024, sb = b % 1024, swz = sb ^ (((sb >> 9) & 1) << 5); R = (st >> 1) * 16 + swz / 64; C = (st & 1) * 32 + (swz % 64) / 2; }
struct Unit { int pm, pn, e; };
struct Gemm { const bf16_t* A; const bf16_t* Bt; int M, N, K; size_t ebytes; };
struct StaticOrder {
    int nM, nN, nwg, G, c;
    __device__ void init(int M, int N, int G_, int c_) { nM = M / BM; nN = N / BM; nwg = nM * nN; G = G_; c = c_; }
    __device__ bool next(int i, Unit& u) const {
        const long L = (long)i * G + c; if (L >= nwg) return false;
        int wgid = (int)L; { const int q = nwg / NXCD, r = nwg % NXCD, xcd = wgid % NXCD, off = wgid / NXCD; wgid = (xcd < r ? xcd * (q + 1) : r * (q + 1) + (xcd - r) * q) + off; }
        const int nig = WGM * nN, gid = wgid / nig, fm = gid * WGM, gsz = (nM - fm) < WGM ? (nM - fm) : WGM;
        u.pm = fm + ((wgid % nig) % gsz); u.pn = (wgid % nig) / gsz; u.e = 0; return true;
    }
    __device__ int tok(int, int) const { return 0; }
};
struct MoeOrder {
    int nwg, nN, G, c; const volatile PG8_LAS unsigned char* ue; const volatile PG8_LAS int* tokt;
    __device__ int tok(int ui, int row) const { return tokt[ui * 256 + row]; }
    __device__ bool unit(int i, int& pm, int& pn) const {
        const int S = G >> 3;
        if ((G & 7) == 0 && S % nN == 0) { const int x = c & 7, slot = c >> 3, pmx = S / nN, T = nwg / nN, tpx = (T + 7) >> 3, lp = i * pmx + slot / nN;
            pm = x * tpx + lp; pn = slot % nN; return lp < tpx && pm < T; }
        const long L = (long)i * G + c; pm = (int)(L / nN); pn = (int)(L % nN); return L < nwg;
    }
    __device__ bool next(int i, Unit& u) const {
        int pm, pn; if (!unit(i, pm, pn)) return false;
        u.pm = pm; u.pn = pn; u.e = __builtin_amdgcn_readfirstlane((int)ue[pm]); return true;
    }
};
template <class Epi, class Sched, bool GATHER = false>
__device__ __forceinline__ void gemm_phase(PG8_LAS unsigned char* lds, const Gemm g, const Sched& S, const Epi& E) {
    int tid = threadIdx.x; asm volatile("" : "+v"(tid));
    const int wid = __builtin_amdgcn_readfirstlane(tid >> 6), lane = tid & 63, wr = wid >> 2, wc = wid & 3, fr = lane & 15, fq = lane >> 4;
    const int K = g.K, nt = K / BK;
    unsigned va[2][2], vn[2][2], voffB[2]; int Rr[2]; unsigned Cb[2];
#pragma unroll
    for (int i = 0; i < 2; ++i) { int R, C; stage_rc(tid * 16 + i * 8192, R, C); Rr[i] = R; Cb[i] = (unsigned)C * 2u; voffB[i] = (unsigned)(R * K + C) * 2u; }
    const size_t kstep = (size_t)(BK * 2);
    const size_t hstep = (size_t)HALF * K * 2;
    const size_t tstep = 2 * hstep;
#define PG8_SETOFF(v, ui_) do { _Pragma("unroll") for (int h_ = 0; h_ < 2; ++h_) _Pragma("unroll") for (int i_ = 0; i_ < 2; ++i_) \
        v[h_][i_] = GATHER ? (unsigned)S.tok(ui_, h_ * HALF + Rr[i_]) * (unsigned)(K * 2) + Cb[i_] : voffB[i_] + (unsigned)(h_ * hstep); } while (0)
    const unsigned ldsw = (unsigned)wid * 1024u;
    const int aoff = lds_byte(wr * 64 + fr, fq * 8), boff = lds_byte(wc * 32 + fr, fq * 8);
#define PG8_SA(b, h) (((b) * 2 + (h)) * HTB)
#define PG8_SB(b, h) ((4 + (b) * 2 + (h)) * HTB)
#define PG8_STAGE(bufoff, gbase, voff) do { _Pragma("unroll") for (int _i = 0; _i < 2; ++_i) \
        __builtin_amdgcn_global_load_lds((const unsigned*)((const char*)(gbase) + (voff)[_i]), (PG8_LAS unsigned*)(lds + (bufoff) + ldsw + _i * 8192), 16, 0, 0); } while (0)
#define PG8_LDA(dst, b, h) do { _Pragma("unroll") for (int m = 0; m < 4; ++m) _Pragma("unroll") for (int k = 0; k < 2; ++k) dst[m][k] = *(const PG8_LAS bf16x8*)(lds + PG8_SA(b, h) + aoff + m * 2048 + k * 1024); } while (0)
#define PG8_LDB(dst, b, h) do { _Pragma("unroll") for (int n = 0; n < 2; ++n) _Pragma("unroll") for (int k = 0; k < 2; ++k) dst[n][k] = *(const PG8_LAS bf16x8*)(lds + PG8_SB(b, h) + boff + n * 2048 + k * 1024); } while (0)
#define PG8_MMA(ai, bj, At, Bt) do { __builtin_amdgcn_s_setprio(1); _Pragma("unroll") for (int m = 0; m < 4; ++m) _Pragma("unroll") for (int n = 0; n < 2; ++n) _Pragma("unroll") for (int k = 0; k < 2; ++k) \
        acc[ai][bj][m][n] = __builtin_amdgcn_mfma_f32_16x16x32_bf16(Bt[n][k], At[m][k], acc[ai][bj][m][n], 0, 0, 0); __builtin_amdgcn_s_setprio(0); } while (0)
#define PG8_WAIT_V(n) asm volatile("s_waitcnt vmcnt(" #n ")" ::: "memory")
#define PG8_WAIT_L(n) asm volatile("s_waitcnt lgkmcnt(" #n ")" ::: "memory")
#define PG8_BAR __builtin_amdgcn_s_barrier()
#define PG8_SCHED __builtin_amdgcn_sched_barrier(0)
    Unit cur, nxt; int ui = 0;
    if (!S.next(0, cur)) return;
    f32x4 acc[2][2][4][2];
#pragma unroll
    for (int a = 0; a < 2; ++a)
#pragma unroll
        for (int b = 0; b < 2; ++b)
#pragma unroll
            for (int m = 0; m < 4; ++m)
#pragma unroll
                for (int n = 0; n < 2; ++n) acc[a][b][m][n] = (f32x4){0.f, 0.f, 0.f, 0.f};
    bf16x8 At[4][2], B0[2][2], B1[2][2];
    const char* cA = (const char*)g.A + (GATHER ? (size_t)0 : (size_t)cur.pm * tstep); const char* cB = (const char*)g.Bt + (size_t)cur.e * g.ebytes + (size_t)cur.pn * tstep;
    PG8_SETOFF(va, 0);
    PG8_STAGE(PG8_SB(0, 0), cB, voffB); PG8_STAGE(PG8_SB(0, 1), cB + hstep, voffB); PG8_STAGE(PG8_SA(0, 0), cA, va[0]); PG8_STAGE(PG8_SA(0, 1), cA, va[1]);
    if (wr == 1) PG8_BAR;
    PG8_WAIT_V(2); PG8_BAR;
    PG8_STAGE(PG8_SB(1, 0), cB + kstep, voffB); PG8_STAGE(PG8_SA(1, 0), cA + kstep, va[0]); PG8_STAGE(PG8_SB(1, 1), cB + hstep + kstep, voffB);
    PG8_WAIT_V(6); PG8_BAR;
    for (;;) {
        const bool has_next = S.next(ui + 1, nxt);
        const char* nA = has_next ? (const char*)g.A + (GATHER ? (size_t)0 : (size_t)nxt.pm * tstep) : cA; const char* nB = has_next ? (const char*)g.Bt + (size_t)nxt.e * g.ebytes + (size_t)nxt.pn * tstep : cB;
        if (GATHER && has_next) PG8_SETOFF(vn, ui + 1); else { _Pragma("unroll") for (int h_ = 0; h_ < 2; ++h_) _Pragma("unroll") for (int i_ = 0; i_ < 2; ++i_) vn[h_][i_] = va[h_][i_]; }
        for (int t = 0; t < nt; t += 2) {
            const bool last = (t == nt - 2);
            const char* a1 = cA + (size_t)(t + 1) * kstep;
            const char* a2 = last ? nA : cA + (size_t)(t + 2) * kstep; const char* b2 = last ? nB : cB + (size_t)(t + 2) * kstep;
            const char* a3 = a2 + kstep; const char* b3 = b2 + kstep;
            unsigned s0[2], s1[2];
#pragma unroll
            for (int i_ = 0; i_ < 2; ++i_) { s0[i_] = last ? vn[0][i_] : va[0][i_]; s1[i_] = last ? vn[1][i_] : va[1][i_]; }
            PG8_LDB(B0, 0, 0); PG8_LDB(B1, 0, 1); PG8_SCHED; PG8_LDA(At, 0, 0); PG8_STAGE(PG8_SA(1, 1), a1, va[1]);
            PG8_WAIT_V(8); PG8_WAIT_L(0); PG8_BAR; PG8_MMA(0, 0, At, B0); PG8_MMA(0, 1, At, B1); PG8_BAR; PG8_SCHED;
            PG8_LDA(At, 0, 1); PG8_STAGE(PG8_SB(0, 0), b2, voffB); PG8_STAGE(PG8_SB(0, 1), b2 + hstep, voffB); PG8_STAGE(PG8_SA(0, 0), a2, s0);
            PG8_WAIT_V(8); PG8_WAIT_L(0); PG8_BAR; PG8_MMA(1, 0, At, B0); PG8_MMA(1, 1, At, B1); PG8_BAR; PG8_SCHED;
            PG8_LDB(B0, 1, 0); PG8_LDB(B1, 1, 1); PG8_SCHED; PG8_LDA(At, 1, 0); PG8_STAGE(PG8_SA(0, 1), a2, s1);
            PG8_WAIT_V(8); PG8_WAIT_L(0); PG8_BAR; PG8_MMA(0, 0, At, B0); PG8_MMA(0, 1, At, B1); PG8_BAR; PG8_SCHED;
            PG8_LDA(At, 1, 1); PG8_STAGE(PG8_SB(1, 0), b3, voffB); PG8_STAGE(PG8_SB(1, 1), b3 + hstep, voffB); PG8_STAGE(PG8_SA(1, 0), a3, s0);
            PG8_WAIT_V(8); PG8_WAIT_L(0); PG8_BAR; PG8_MMA(1, 0, At, B0); PG8_MMA(1, 1, At, B1); PG8_BAR; PG8_SCHED;
        }
        if (wr == 0) PG8_BAR;
        E(acc, cur, wr, wc, fr, fq);
        if (!has_next) break;
#pragma unroll
        for (int a = 0; a < 2; ++a)
#pragma unroll
            for (int b = 0; b < 2; ++b)
#pragma unroll
                for (int m = 0; m < 4; ++m)
#pragma unroll
                    for (int n = 0; n < 2; ++n) acc[a][b][m][n] = (f32x4){0.f, 0.f, 0.f, 0.f};
        cur = nxt; cA = nA; cB = nB; ++ui;
#pragma unroll
        for (int h_ = 0; h_ < 2; ++h_)
#pragma unroll
            for (int i_ = 0; i_ < 2; ++i_) va[h_][i_] = vn[h_][i_];
        if (wr == 1) PG8_BAR;
    }
    PG8_WAIT_V(0);
    PG8_BAR;
#undef PG8_SA
#undef PG8_SB
#undef PG8_STAGE
#undef PG8_SETOFF
#undef PG8_LDA
#undef PG8_LDB
#undef PG8_MMA
#undef PG8_WAIT_V
#undef PG8_WAIT_L
#undef PG8_BAR
#undef PG8_SCHED
}
typedef float f32x2v __attribute__((ext_vector_type(2)));
typedef __bf16 bf16x2v __attribute__((ext_vector_type(2)));
__device__ __forceinline__ unsigned cvt_pk_bf16(float lo, float hi) { const bf16x2v r = __builtin_convertvector((f32x2v){lo, hi}, bf16x2v); return __builtin_bit_cast(unsigned, r); }
__device__ __forceinline__ float fast_sigmoid(float x) { return __builtin_amdgcn_rcpf(1.0f + __builtin_amdgcn_exp2f(-1.4426950408889634f * x)); }
#define EPI_LOOP(body) _Pragma("unroll") for (int ai = 0; ai < 2; ++ai) _Pragma("unroll") for (int m = 0; m < 4; ++m) { const int row = row0 + ai * HALF + m * 16; \
    _Pragma("unroll") for (int bj = 0; bj < 2; ++bj) _Pragma("unroll") for (int n = 0; n < 2; ++n) { const int col = col0 + bj * HALF + n * 16; const f32x4 a = acc[ai][bj][m][n]; body } }
struct EpiStoreF32 {
    float* C; int ldc;
    __device__ __forceinline__ void operator()(const f32x4 (&acc)[2][2][4][2], const Unit& u, int wr, int wc, int fr, int fq) const {
        const int row0 = u.pm * BM + wr * 64 + fr, col0 = u.pn * BM + wc * 32 + 4 * fq;
        EPI_LOOP( *(f32x4*)(C + (size_t)row * ldc + col) = a; )
    }
};
struct EpiResid {
    float* X; const float* gv;
    __device__ __forceinline__ void operator()(const f32x4 (&acc)[2][2][4][2], const Unit& u, int wr, int wc, int fr, int fq) const {
        const int row0 = u.pm * BM + wr * 64 + fr, col0 = u.pn * BM + wc * 32 + 4 * fq;
        const int r0 = u.pm * BM, mrow = r0 < SEQ ? 0 : (r0 < NLAT ? 1 : 2); const float* g = gv + (size_t)mrow * 6 * D;
        EPI_LOOP( const f32x4 gg = *(const f32x4*)(g + col); f32x4* q = (f32x4*)(X + (size_t)row * D + col); *q = *q + gg * a; )
    }
};
struct EpiGlu {
    bf16_t* O; const bf16_t* Y; const float* bias;
    __device__ __forceinline__ void operator()(const f32x4 (&acc)[2][2][4][2], const Unit& u, int wr, int wc, int fr, int fq) const {
        const int row0 = u.pm * BM + wr * 64 + fr, col0 = u.pn * BM + wc * 32 + 4 * fq;
        EPI_LOOP( const f32x4 bb = *(const f32x4*)(bias + col); const ushort4 yv = *(const ushort4*)(Y + (size_t)row * S5W + col);
            uint2 o; o.x = cvt_pk_bf16(bf2f(yv.x) * fast_sigmoid(a[0] + bb[0]), bf2f(yv.y) * fast_sigmoid(a[1] + bb[1])); o.y = cvt_pk_bf16(bf2f(yv.z) * fast_sigmoid(a[2] + bb[2]), bf2f(yv.w) * fast_sigmoid(a[3] + bb[3]));
            *(uint2*)(O + (size_t)row * D + HYW + col) = o; )
    }
};
struct EpiSwiglu {
    bf16_t* O; const float* bgu;
    __device__ __forceinline__ void operator()(const f32x4 (&acc)[2][2][4][2], const Unit& u, int wr, int wc, int fr, int fq) const {
        const int row0 = u.pm * BM + wr * 64 + fr, colb = wc * 32 + 4 * fq; const float* bb = bgu + (size_t)u.e * 2 * DFF + u.pn * 128;
#pragma unroll
        for (int ai = 0; ai < 2; ++ai)
#pragma unroll
            for (int m = 0; m < 4; ++m) { const int row = row0 + ai * HALF + m * 16;
#pragma unroll
                for (int n = 0; n < 2; ++n) { const int cc = colb + n * 16; const f32x4 bg = *(const f32x4*)(bb + cc), bu = *(const f32x4*)(bb + DFF + cc);
                    const f32x4 ga = acc[ai][0][m][n] + bg, up = acc[ai][1][m][n] + bu; float av[4];
#pragma unroll
                    for (int j = 0; j < 4; ++j) { const float gg = fminf(ga[j], 7.0f), uu = fminf(fmaxf(up[j], -7.0f), 7.0f); av[j] = gg * fast_sigmoid(1.702f * gg) * (uu + 1.0f); }
                    uint2 o; o.x = cvt_pk_bf16(av[0], av[1]); o.y = cvt_pk_bf16(av[2], av[3]);
                    *(uint2*)(O + (size_t)row * DFF + u.pn * 128 + cc) = o; } }
    }
};
struct EpiDown {
    bf16_t* Y; const float* bdn; const float* gate;
    __device__ __forceinline__ void operator()(const f32x4 (&acc)[2][2][4][2], const Unit& u, int wr, int wc, int fr, int fq) const {
        const int row0 = u.pm * BM + wr * 64 + fr, col0 = u.pn * BM + wc * 32 + 4 * fq; const float* bb = bdn + (size_t)u.e * D;
        EPI_LOOP( const f32x4 bv = *(const f32x4*)(bb + col); const float gt_ = gate[row]; const f32x4 o = (a + bv) * gt_; uint2 ob; ob.x = cvt_pk_bf16(o[0], o[1]); ob.y = cvt_pk_bf16(o[2], o[3]); *(uint2*)(Y + (size_t)row * D + col) = ob; )
    }
};
}

constexpr int RING_BYTES = 131072, SCRATCH_BYTES = 135168, MISC_OFF = SCRATCH_BYTES, UE_OFF = MISC_OFF + 64, TOK_OFF = UE_OFF + 320, TOK_UNITS = 11, LDS_BYTES = 147456;
static_assert(FFT_ELEMS * 8 <= SCRATCH_BYTES && TOK_OFF + TOK_UNITS * 1024 <= LDS_BYTES && ((NSLOT / 256 + 7) / 8 + 3) / 4 <= TOK_UNITS, "LDS map");
#define LAS __attribute__((address_space(3)))

__device__ __forceinline__ void transpose_item(const float* W, int K, int N, bf16_t* WT, int gu_perm, LAS float* scr, int item, int lane) {
    const int nblk = N / 32, kb = item / nblk, nb = item % nblk, k0 = 64 * kb, n0 = 32 * nb;
    const int r0 = gu_perm ? (n0 < DFF ? (n0 / 128) * 256 + (n0 % 128) : ((n0 - DFF) / 128) * 256 + 128 + ((n0 - DFF) % 128)) : n0;
#pragma unroll 8
    for (int i = 0; i < 32; ++i) { const int kk = 2 * i + (lane >> 5); scr[kk * 33 + (lane & 31)] = W[(size_t)(k0 + kk) * N + n0 + (lane & 31)]; }
    asm volatile("s_waitcnt lgkmcnt(0)" ::: "memory");
    const int c = lane & 7;
#pragma unroll
    for (int j = 0; j < 4; ++j) { const int n = (lane >> 3) + 8 * j; const LAS float* s = scr + (8 * c) * 33 + n;
        uint4 o; o.x = f2bf(s[0 * 33]) | ((unsigned)f2bf(s[1 * 33]) << 16); o.y = f2bf(s[2 * 33]) | ((unsigned)f2bf(s[3 * 33]) << 16);
        o.z = f2bf(s[4 * 33]) | ((unsigned)f2bf(s[5 * 33]) << 16); o.w = f2bf(s[6 * 33]) | ((unsigned)f2bf(s[7 * 33]) << 16);
        *(uint4*)(WT + (size_t)(r0 + n) * K + k0 + 8 * c) = o; }
    asm volatile("s_waitcnt lgkmcnt(0)" ::: "memory");
}
constexpr int I_GU = (D / 64) * (2 * DFF / 32), I_DN = (DFF / 64) * (D / 32), EXP_ITEMS = NE * (I_GU + I_DN);
__device__ __forceinline__ void convert_expert_item(const P& p, int l, int q, LAS float* scr, int lane) {
    if (q < NE * I_GU) { const int e = q / I_GU; const size_t i = (size_t)l * NE + e; transpose_item(p.w_gu + i * D * 2 * DFF, D, 2 * DFF, p.wgu_t + i * 2 * DFF * D, 1, scr, q % I_GU, lane); }
    else { const int q2 = q - NE * I_GU, e = q2 / I_DN; const size_t i = (size_t)l * NE + e; transpose_item(p.w_dn + i * DFF * D, DFF, D, p.wdn_t + i * D * DFF, 0, scr, q2 % I_DN, lane); }
}
constexpr int DEFER_Q1 = 104, DEFER_Q2 = 104;
__device__ __forceinline__ int defer_idle(int units, int G) { const int rem = units % G; return rem ? G - rem : 0; }
__device__ __forceinline__ int defer_in_units(int layer) { return (NTOK / 256) * ((layer & 1) ? CD_IN / 256 : AB_IN / 256); }
__device__ __forceinline__ int defer_d1(int layer, int G) { const int n = defer_idle(defer_in_units(layer), G) * DEFER_Q1; return n < EXP_ITEMS ? n : EXP_ITEMS; }
__device__ __forceinline__ int defer_d2(int layer, int G) { const int d1 = defer_d1(layer, G), n = d1 + defer_idle((NTOK / 256) * (D / 256), G) * DEFER_Q2; return n < EXP_ITEMS ? n : EXP_ITEMS; }
__device__ __forceinline__ void convert_deferred(const P& p, LAS unsigned char* lds, int layer, int which) {
    int tid = threadIdx.x; asm volatile("" : "+v"(tid));
    int bx_ = (int)blockIdx.x, gx_ = (int)gridDim.x; asm volatile("" : "+s"(bx_), "+s"(gx_));
    const int units = which ? (NTOK / 256) * (D / 256) : defer_in_units(layer), rem = units % gx_;
    if (rem == 0 || bx_ < rem) return;
    const int lane = tid & 63, wave = tid >> 6; LAS float* scr = (LAS float*)(lds + wave * 16384);
    const int qn = which ? DEFER_Q2 : DEFER_Q1, q0 = (which ? defer_d1(layer, gx_) : 0) + (bx_ - rem) * qn, qend = which ? defer_d2(layer, gx_) : defer_d1(layer, gx_);
    for (int q = q0 + wave; q < q0 + qn && q < qend; q += 8) convert_expert_item(p, layer + 1, q, scr, lane);
}
__device__ __forceinline__ void ph_convert_weights(const P& p, LAS unsigned char* lds) {
    int tid = threadIdx.x; asm volatile("" : "+v"(tid));
    const int lane = tid & 63, wave = tid >> 6;
    LAS float* scr = (LAS float*)(lds + wave * 16384);
    const long gw = (long)blockIdx.x * 8 + wave, NGW = (long)gridDim.x * 8; const int G = (int)gridDim.x;
    constexpr long I_ABIN = (D / 64) * (AB_IN / 32), I_CDIN = (D / 64) * (CD_IN / 32), I_OUT = (D / 64) * (D / 32), I_GLU = (S5W / 64) * (S5W / 32);
    constexpr long T0 = 2 * I_ABIN, T1 = T0 + 2 * I_CDIN, T2 = T1 + 2 * I_OUT, T3 = T2 + 2 * I_OUT, T4 = T3 + 2 * I_GLU;
    for (long it = gw; it < T4; it += NGW) {
        if (it < T0) { const int i = (int)(it / I_ABIN); transpose_item(p.ab_w_in + (size_t)i * D * AB_IN, D, AB_IN, p.abin_t + (size_t)i * AB_IN * D, 0, scr, (int)(it % I_ABIN), lane); }
        else if (it < T1) { const long r = it - T0; const int i = (int)(r / I_CDIN); transpose_item(p.cd_w_in + (size_t)i * D * CD_IN, D, CD_IN, p.cdin_t + (size_t)i * CD_IN * D, 0, scr, (int)(r % I_CDIN), lane); }
        else if (it < T2) { const long r = it - T1; const int i = (int)(r / I_OUT); transpose_item(p.ab_w_out + (size_t)i * D * D, D, D, p.about_t + (size_t)i * D * D, 0, scr, (int)(r % I_OUT), lane); }
        else if (it < T3) { const long r = it - T2; const int i = (int)(r / I_OUT); transpose_item(p.cd_w_out + (size_t)i * D * D, D, D, p.cdout_t + (size_t)i * D * D, 0, scr, (int)(r % I_OUT), lane); }
        else { const long r = it - T3; const int i = (int)(r / I_GLU); transpose_item(p.s5_glu_w + (size_t)i * S5W * S5W, S5W, S5W, p.glu_t + (size_t)i * S5W * S5W, 0, scr, (int)(r % I_GLU), lane); }
    }
    for (int l = 0; l < 4; ++l) { const int qs = l ? defer_d2(l - 1, G) : 0;
        for (long q = qs + gw; q < EXP_ITEMS; q += NGW) convert_expert_item(p, l, (int)q, scr, lane); }
}
constexpr int NTHREADS = 512;
__device__ __forceinline__ float wave_sum(float v) {
#pragma unroll
    for (int o = 1; o < 64; o <<= 1) v += __shfl_xor(v, o);
    return v;
}
template <int MODE> __device__ __forceinline__ void mf_rownorm(const P& p, LAS unsigned char* lds, int layer, int nrows, int comb_layer) {
    constexpr bool ROUTE = MODE == 1; constexpr int which = MODE == 1 ? 1 : 0;
    int tid = threadIdx.x; asm volatile("" : "+v"(tid));
    int bx_ = (int)blockIdx.x, gx_ = (int)gridDim.x; asm volatile("" : "+s"(bx_), "+s"(gx_));
    const int lane = tid & 63, wave = tid >> 6;
    if (ROUTE) { for (int j = bx_ * NTHREADS + tid; j < NSLOT; j += gx_ * NTHREADS) { p.slot_tok[j] = -1; p.slot_gate[j] = 0.f; } }
    const float* gn = MODE == 2 ? p.final_g : (which ? p.norm2_g : p.norm1_g) + layer * D;
    LAS float* Wl = (LAS float*)lds;
    if (ROUTE) { const float* rw = p.router_w + (size_t)layer * D * NE;
        for (int i = tid; i < D * NE / 4; i += NTHREADS) { const float4 w4 = *(const float4*)(rw + 4 * i); *(LAS pg8::f32x4*)(Wl + 4 * i) = (pg8::f32x4){w4.x, w4.y, w4.z, w4.w}; }
        __syncthreads(); }
    volatile LAS int* lcnt = (volatile LAS int*)(lds + RING_BYTES);
    volatile LAS int* lbase = lcnt + NE; volatile LAS int* lrank = lcnt + 2 * NE;
    if (ROUTE) { if (tid < NE) lcnt[tid] = 0; __syncthreads(); }
    for (int r = bx_ * 8 + wave; r < nrows; r += gx_ * 8) {
        const int m = r < SEQ ? 0 : (r < NLAT ? 1 : 2);
        const float* mv = p.modv + ((size_t)layer * 3 + m) * 6 * D + which * 3 * D;
        float* xr = p.xa + (size_t)r * D;
        float4 v[4]; float ss = 0.f;
#pragma unroll
        for (int j = 0; j < 4; ++j) v[j] = *(const float4*)(xr + 256 * j + 4 * lane);
        if (comb_layer >= 0) {
            const float* g2 = p.modv + ((size_t)comb_layer * 3 + m) * 6 * D + 5 * D;
            const int4 so = *(const int4*)(p.slot_of + r * 4);
            const bf16_t* y0 = p.yb + (size_t)so.x * D; const bf16_t* y1 = p.yb + (size_t)so.y * D; const bf16_t* y2 = p.yb + (size_t)so.z * D; const bf16_t* y3 = p.yb + (size_t)so.w * D;
#pragma unroll
            for (int j = 0; j < 4; ++j) { const int k = 256 * j + 4 * lane; const ushort4 a = *(const ushort4*)(y0 + k), b = *(const ushort4*)(y1 + k), c = *(const ushort4*)(y2 + k), d = *(const ushort4*)(y3 + k); const float4 gg = *(const float4*)(g2 + k);
                v[j].x += gg.x * (bf2f(a.x) + bf2f(b.x) + bf2f(c.x) + bf2f(d.x)); v[j].y += gg.y * (bf2f(a.y) + bf2f(b.y) + bf2f(c.y) + bf2f(d.y));
                v[j].z += gg.z * (bf2f(a.z) + bf2f(b.z) + bf2f(c.z) + bf2f(d.z)); v[j].w += gg.w * (bf2f(a.w) + bf2f(b.w) + bf2f(c.w) + bf2f(d.w));
                if (MODE != 2) *(float4*)(xr + k) = v[j]; }
        }
#pragma unroll
        for (int j = 0; j < 4; ++j) ss += v[j].x * v[j].x + v[j].y * v[j].y + v[j].z * v[j].z + v[j].w * v[j].w;
        const float rstd = rsqrtf(wave_sum(ss) * (1.0f / D) + EPS);
        if (MODE == 2) {
#pragma unroll
            for (int j = 0; j < 4; ++j) { const int k = 256 * j + 4 * lane; const float4 g4 = *(const float4*)(gn + k);
                float4 o; o.x = v[j].x * rstd * g4.x; o.y = v[j].y * rstd * g4.y; o.z = v[j].z * rstd * g4.z; o.w = v[j].w * rstd * g4.w;
                *(float4*)(p.out + (size_t)r * D + k) = o; }
            continue;
        }
#pragma unroll
        for (int j = 0; j < 4; ++j) { const int k = 256 * j + 4 * lane; const float4 g4 = *(const float4*)(gn + k), sc = *(const float4*)(mv + D + k), sh = *(const float4*)(mv + k);
            v[j].x = v[j].x * rstd * g4.x * (1.0f + sc.x) + sh.x; v[j].y = v[j].y * rstd * g4.y * (1.0f + sc.y) + sh.y;
            v[j].z = v[j].z * rstd * g4.z * (1.0f + sc.z) + sh.z; v[j].w = v[j].w * rstd * g4.w * (1.0f + sc.w) + sh.w;
            ushort4 o; o.x = f2bf(v[j].x); o.y = f2bf(v[j].y); o.z = f2bf(v[j].z); o.w = f2bf(v[j].w);
            *(ushort4*)(p.hxb + (size_t)r * D + k) = o; }
        if (ROUTE) {
            const int eh = lane & 31, half = lane >> 5;
            const LAS float* wb = Wl + (size_t)(128 * half) * NE + eh;
            float acc = 0.f;
#pragma unroll
            for (int j = 0; j < 4; ++j) { const float vq[4] = {v[j].x, v[j].y, v[j].z, v[j].w};
#pragma unroll
                for (int q = 0; q < 4; ++q) { const int vi = __builtin_bit_cast(int, vq[q]);
#pragma unroll 8
                    for (int l = 0; l < 32; ++l) { const float s0 = __builtin_bit_cast(float, __builtin_amdgcn_readlane(vi, l)), s1 = __builtin_bit_cast(float, __builtin_amdgcn_readlane(vi, l + 32));
                        acc += (half ? s1 : s0) * wb[(256 * j + 4 * l + q) * NE]; } } }
            acc += __shfl_xor(acc, 32);
            acc += p.router_b[layer * NE + eh];
            float lg[NE];
#pragma unroll
            for (int e = 0; e < NE; ++e) lg[e] = __shfl(acc, e);
            int ti[4]; float tv[4];
#pragma unroll
            for (int s = 0; s < 4; ++s) { int best = 0; float bv = -3.0e38f;
#pragma unroll
                for (int e = 0; e < NE; ++e) { if (lg[e] > bv) { bv = lg[e]; best = e; } }
                ti[s] = best; tv[s] = bv;
#pragma unroll
                for (int e = 0; e < NE; ++e) if (e == best) lg[e] = -3.0e38f; }
            if (lane == 0) {
                const float e1 = expf(tv[1] - tv[0]), e2 = expf(tv[2] - tv[0]), e3 = expf(tv[3] - tv[0]), inv = 1.0f / (1.0f + e1 + e2 + e3);
                p.topi[r * 4 + 0] = ti[0]; p.topi[r * 4 + 1] = ti[1]; p.topi[r * 4 + 2] = ti[2]; p.topi[r * 4 + 3] = ti[3];
                p.topg[r * 4 + 0] = inv; p.topg[r * 4 + 1] = e1 * inv; p.topg[r * 4 + 2] = e2 * inv; p.topg[r * 4 + 3] = e3 * inv;
                const int li = ((r - (bx_ * 8 + wave)) / (gx_ * 8)) * 8 + wave;
#pragma unroll
                for (int s = 0; s < 4; ++s) lrank[li * 4 + s] = __hip_atomic_fetch_add((LAS int*)(lcnt + ti[s]), 1, __ATOMIC_RELAXED, __HIP_MEMORY_SCOPE_WORKGROUP);
            }
        }
    }
    if (ROUTE) {
        __syncthreads();
        if (tid < NE) lbase[tid] = atomicAdd(p.cnt + layer * NE + tid, lcnt[tid]);
        __syncthreads();
        const int nmine = (nrows - bx_ * 8 + gx_ * 8 - 1) / (gx_ * 8) * 8;
        for (int i = tid; i < nmine * 4; i += NTHREADS) { const int li = i >> 2, r = bx_ * 8 + (li & 7) + (li >> 3) * gx_ * 8;
            if (r < nrows) p.pos[r * 4 + (i & 3)] = lbase[p.topi[i - li * 4 + r * 4]] + lrank[i]; }
    }
}
typedef unsigned short us4v __attribute__((ext_vector_type(4)));
__device__ __forceinline__ us4v pack4(float4 v) { return (us4v){f2bf(v.x), f2bf(v.y), f2bf(v.z), f2bf(v.w)}; }
template <int K> __device__ __forceinline__ pg8::f32x4 mma16(const LAS bf16_t* A, int lda, const LAS bf16_t* Bt, int ldb, pg8::f32x4 acc, int lane) {
    const int r = lane & 15, q = lane >> 4;
    const LAS bf16_t* ap = A + r * lda + 8 * q; const LAS bf16_t* bp = Bt + r * ldb + 8 * q;
#pragma unroll
    for (int k0 = 0; k0 < K; k0 += 32) acc = __builtin_amdgcn_mfma_f32_16x16x32_bf16(*(const LAS pg8::bf16x8*)(ap + k0), *(const LAS pg8::bf16x8*)(bp + k0), acc, 0, 0, 0);
    return acc;
}
constexpr int RLD = 136, RLQ = 72;
__device__ __forceinline__ void mf_retkv(const P& p, LAS unsigned char* lds, int il) {
    int tid = threadIdx.x; asm volatile("" : "+v"(tid));
    int bx_ = (int)blockIdx.x, gx_ = (int)gridDim.x; asm volatile("" : "+s"(bx_), "+s"(gx_));
    const int lane = tid & 63, wave = tid >> 6, r = lane & 15, q = lane >> 4;
    LAS bf16_t* KdT = (LAS bf16_t*)lds; LAS bf16_t* VT = KdT + 64 * RLD;
    for (int u = bx_; u < 16 * RNCH; u += gx_) {
        const int n = u % RNCH, h = (u / RNCH) & 3, b = (u / (RNCH * 4)) & 1, dir = u / (RNCH * 8);
        const float lg = ret_logg(p, il, dir, h);
        __syncthreads();
        for (int idx = tid; idx < 128 * 16; idx += NTHREADS) { const int j = idx >> 4, d4 = idx & 15, row = scan_row(dir, b, n * RC + j);
            const float4 kv = *(const float4*)(p.kr + (size_t)row * 256 + h * 64 + 4 * d4); const float dk = fexp((float)(RC - 1 - j) * lg);
            KdT[(4 * d4 + 0) * RLD + j] = f2bf(kv.x * dk); KdT[(4 * d4 + 1) * RLD + j] = f2bf(kv.y * dk); KdT[(4 * d4 + 2) * RLD + j] = f2bf(kv.z * dk); KdT[(4 * d4 + 3) * RLD + j] = f2bf(kv.w * dk); }
        for (int idx = tid; idx < 128 * 32; idx += NTHREADS) { const int j = idx >> 5, e4 = idx & 31, row = scan_row(dir, b, n * RC + j);
            const float4 vv = *(const float4*)(p.px + (size_t)row * PXLD + 512 + h * 128 + 4 * e4);
            VT[(4 * e4 + 0) * RLD + j] = f2bf(vv.x); VT[(4 * e4 + 1) * RLD + j] = f2bf(vv.y); VT[(4 * e4 + 2) * RLD + j] = f2bf(vv.z); VT[(4 * e4 + 3) * RLD + j] = f2bf(vv.w); }
        __syncthreads();
        float* o = p.rkv + ((((size_t)dir * 2 + b) * RNCH + n) * 4 + h) * 8192;
#pragma unroll
        for (int td = 0; td < 4; ++td) { pg8::f32x4 acc = {0.f, 0.f, 0.f, 0.f};
            acc = mma16<128>(VT + (16 * wave) * RLD, RLD, KdT + (16 * td) * RLD, RLD, acc, lane);
#pragma unroll
            for (int g = 0; g < 4; ++g) o[(size_t)(16 * wave + 4 * q + g) * 64 + 16 * td + r] = acc[g]; }
    }
}
__device__ __forceinline__ void mf_reto(const P& p, LAS unsigned char* lds, int il) {
    int tid = threadIdx.x; asm volatile("" : "+v"(tid));
    int bx_ = (int)blockIdx.x, gx_ = (int)gridDim.x; asm volatile("" : "+s"(bx_), "+s"(gx_));
    const int lane = tid & 63, wave = tid >> 6, r = lane & 15, q = lane >> 4;
    LAS bf16_t* Qs = (LAS bf16_t*)lds; LAS bf16_t* Ks = Qs + 128 * RLQ; LAS bf16_t* ST = Ks + 128 * RLQ; LAS bf16_t* VT = ST + 128 * RLQ; LAS bf16_t* Ps = VT + 128 * RLD;
    for (int u = bx_; u < 16 * RNCH; u += gx_) {
        const int n = u % RNCH, h = (u / RNCH) & 3, b = (u / (RNCH * 4)) & 1, dir = u / (RNCH * 8);
        const float lg = ret_logg(p, il, dir, h);
        const float* Sg = p.rkv + ((((size_t)dir * 2 + b) * RNCH + n) * 4 + h) * 8192;
        __syncthreads();
        for (int idx = tid; idx < 128 * 16; idx += NTHREADS) { const int j = idx >> 4, d4 = idx & 15, row = scan_row(dir, b, n * RC + j);
            const float4 qv = *(const float4*)(p.qr + (size_t)row * 256 + h * 64 + 4 * d4), kv = *(const float4*)(p.kr + (size_t)row * 256 + h * 64 + 4 * d4), sv = *(const float4*)(Sg + (size_t)j * 64 + 4 * d4);
            *(LAS us4v*)(Qs + j * RLQ + 4 * d4) = pack4(qv); *(LAS us4v*)(Ks + j * RLQ + 4 * d4) = pack4(kv); *(LAS us4v*)(ST + j * RLQ + 4 * d4) = pack4(sv); }
        for (int idx = tid; idx < 128 * 32; idx += NTHREADS) { const int j = idx >> 5, e4 = idx & 31, row = scan_row(dir, b, n * RC + j);
            const float4 vv = *(const float4*)(p.px + (size_t)row * PXLD + 512 + h * 128 + 4 * e4);
            VT[(4 * e4 + 0) * RLD + j] = f2bf(vv.x); VT[(4 * e4 + 1) * RLD + j] = f2bf(vv.y); VT[(4 * e4 + 2) * RLD + j] = f2bf(vv.z); VT[(4 * e4 + 3) * RLD + j] = f2bf(vv.w); }
        __syncthreads();
#pragma unroll
        for (int tj = 0; tj < 8; ++tj) { pg8::f32x4 acc = {0.f, 0.f, 0.f, 0.f};
            acc = mma16<64>(Qs + (16 * wave) * RLQ, RLQ, Ks + (16 * tj) * RLQ, RLQ, acc, lane);
            const int j = 16 * tj + r;
#pragma unroll
            for (int g = 0; g < 4; ++g) { const int i = 16 * wave + 4 * q + g; Ps[i * RLD + j] = f2bf(j <= i ? acc[g] * fexp((float)(i - j) * lg) : 0.f); } }
        __syncthreads();
        float dq[4];
#pragma unroll
        for (int g = 0; g < 4; ++g) dq[g] = fexp((float)(16 * wave + 4 * q + g + 1) * lg);
#pragma unroll
        for (int te = 0; te < 8; ++te) { pg8::f32x4 acc = {0.f, 0.f, 0.f, 0.f}, cr = {0.f, 0.f, 0.f, 0.f};
            acc = mma16<128>(Ps + (16 * wave) * RLD, RLD, VT + (16 * te) * RLD, RLD, acc, lane);
            cr = mma16<64>(Qs + (16 * wave) * RLQ, RLQ, ST + (16 * te) * RLQ, RLQ, cr, lane);
#pragma unroll
            for (int g = 0; g < 4; ++g) { const int i = 16 * wave + 4 * q + g, row = scan_row(dir, b, n * RC + i);
                p.oret[((size_t)dir * NTOK + row) * 512 + h * 128 + 16 * te + r] = acc[g] + dq[g] * cr[g]; } }
    }
}
template <bool FILL> __device__ __forceinline__ void mf_s5(const P& p, LAS unsigned char* lds, int il) {
    int tid = threadIdx.x; asm volatile("" : "+v"(tid));
    int bx_ = (int)blockIdx.x, gx_ = (int)gridDim.x; asm volatile("" : "+s"(bx_), "+s"(gx_));
    const int lane = tid & 63, wave = tid >> 6, r = lane & 15, q = lane >> 4;
    constexpr int LDU = 40, LDS_ = 132, LDB = 136;
    LAS bf16_t* Bt = (LAS bf16_t*)lds;
    LAS bf16_t* Ct = Bt + 128 * LDU;
    LAS unsigned char* wb = lds + 16384 + wave * 14336;
    LAS bf16_t* U = (LAS bf16_t*)wb;
    LAS float* SL = (LAS float*)(wb + 1280);
    LAS bf16_t* Sb = (LAS bf16_t*)(wb + 1280 + 8448);
    constexpr int GRP = (2 * S5NCH) / 8;
    static_assert((2 * S5NCH) % 8 == 0, "chunk count");
    for (int bu = bx_; bu < 64 * GRP; bu += gx_) {
        const int dg = bu / GRP, grp = bu % GRP, dir = dg >> 5, g = dg & 31;
        __syncthreads();
        if (tid < 64) { S5Par sp; s5_par(p, il, dir, g, tid, sp);
#pragma unroll
            for (int h = 0; h < 16; ++h) { Bt[(2 * tid) * LDU + h] = f2bf(sp.bbr[h]); Bt[(2 * tid + 1) * LDU + h] = f2bf(sp.bbi[h]); Bt[(2 * tid) * LDU + 16 + h] = 0; Bt[(2 * tid + 1) * LDU + 16 + h] = 0;
                const long ci = (((long)(il * 2 + dir) * NG + g) * GH + h) * NP + tid; Ct[h * LDB + 2 * tid] = f2bf(p.s5_cre[ci]); Ct[h * LDB + 2 * tid + 1] = f2bf(-p.s5_cim[ci]); } }
        float lbr, lbi; { const int gi = (il * 2 + dir) * NG + g; const float lre = fminf(p.s5_lre[gi * NP + lane], -1e-4f), lim = p.s5_lim[gi * NP + lane], dt = expf(p.s5_ldt[gi]);
            const float mag = expf(lre * dt); lbr = mag * cosf(lim * dt); lbi = mag * sinf(lim * dt); }
        __syncthreads();
        const int bc = grp * 8 + wave, b = bc / S5NCH, ch = bc % S5NCH;
        float* ce = p.s5c + ((((size_t)dir * 2 + b) * S5NCH + ch) * NG + g) * NP * 2 + lane * 2;
        float sr = 0.f, si = 0.f;
        if (FILL) { sr = ce[0]; si = ce[1]; }
        float4 uvs[S5C / 16];
#pragma unroll
        for (int sb = 0; sb < S5C / 16; ++sb) { const int k = lane >> 2, h4 = (lane & 3) * 4, row = scan_row(dir, b, ch * S5C + sb * 16 + k);
            uvs[sb] = *(const float4*)(p.px + (size_t)row * PXLD + 1536 + g * GH + h4); }
#pragma unroll
        for (int sb = 0; sb < S5C / 16; ++sb) {
            { const int k = lane >> 2, h4 = (lane & 3) * 4;
              *(LAS us4v*)(U + k * LDU + h4) = pack4(uvs[sb]); *(LAS us4v*)(U + k * LDU + 16 + h4) = (us4v){0, 0, 0, 0}; }
            asm volatile("s_waitcnt lgkmcnt(0)" ::: "memory");
#pragma unroll
            for (int tc = 0; tc < 8; ++tc) { pg8::f32x4 acc = {0.f, 0.f, 0.f, 0.f};
                acc = mma16<32>(U, LDU, Bt + (16 * tc) * LDU, LDU, acc, lane);
#pragma unroll
                for (int gq = 0; gq < 4; ++gq) SL[(4 * q + gq) * LDS_ + 16 * tc + r] = acc[gq]; }
            asm volatile("s_waitcnt lgkmcnt(0)" ::: "memory");
#pragma unroll
            for (int k = 0; k < 16; ++k) { const float br = SL[k * LDS_ + 2 * lane], bi = SL[k * LDS_ + 2 * lane + 1];
                const float tr = lbr * sr - lbi * si + br, ti = lbr * si + lbi * sr + bi; sr = tr; si = ti;
                if (FILL) { Sb[k * LDB + 2 * lane] = f2bf(sr); Sb[k * LDB + 2 * lane + 1] = f2bf(si); } }
            if (FILL) {
                asm volatile("s_waitcnt lgkmcnt(0)" ::: "memory");
                pg8::f32x4 acc = {0.f, 0.f, 0.f, 0.f};
                acc = mma16<128>(Sb, LDB, Ct, LDB, acc, lane);
#pragma unroll
                for (int gq = 0; gq < 4; ++gq) { const int row = scan_row(dir, b, ch * S5C + sb * 16 + 4 * q + gq); p.yd[((size_t)dir * NTOK + row) * S5W + g * GH + r] = acc[gq]; }
            }
            asm volatile("s_waitcnt lgkmcnt(0)" ::: "memory");
        }
        if (!FILL) { ce[0] = sr; ce[1] = si; }
    }
}
__device__ __forceinline__ void mf_swa(const P& p, LAS unsigned char* lds, int il, bool with_ctx) {
    int tid = threadIdx.x; asm volatile("" : "+v"(tid));
    int bx_ = (int)blockIdx.x, gx_ = (int)gridDim.x; asm volatile("" : "+s"(bx_), "+s"(gx_));
    const int lane = tid & 63, wave = tid >> 6, r = lane & 15, q = lane >> 4;
    constexpr int LDK = 72;
    LAS bf16_t* Ks = (LAS bf16_t*)lds;
    LAS bf16_t* VT = Ks + 64 * LDK;
    LAS bf16_t* Pw = VT + 64 * LDK + wave * 64 * LDK;
    constexpr int NQB = SEQ / 128, NLATU = 4 * NQB, NCTXU = 4 * (CTXL / 128);
    const int nunits = NLATU + (with_ctx ? NCTXU : 0);
    for (int u = bx_; u < nunits; u += gx_) {
        int b, kv, qb, isctx;
        if (u < NLATU) { isctx = 0; qb = u % NQB; kv = (u / NQB) & 1; b = u / (NQB * 2); }
        else { const int v = u - NLATU; isctx = 1; qb = v % (CTXL / 128); kv = (v / (CTXL / 128)) & 1; b = v / ((CTXL / 128) * 2); }
        const int g = wave >> 1, hq = kv * 4 + g, i0 = (wave & 1) * 64;
        const int qrow0 = (isctx ? NLAT + b * CTXL : b * SEQ) + qb * 128 + i0;
        pg8::bf16x8 qf[4][2];
#pragma unroll
        for (int tq = 0; tq < 4; ++tq)
#pragma unroll
            for (int ks = 0; ks < 2; ++ks) { const float* src = p.qs + (size_t)(qrow0 + 16 * tq + r) * 512 + hq * 64 + 32 * ks + 8 * q;
                const float4 a = *(const float4*)src, c = *(const float4*)(src + 4);
                qf[tq][ks] = (pg8::bf16x8){(short)f2bf(a.x), (short)f2bf(a.y), (short)f2bf(a.z), (short)f2bf(a.w), (short)f2bf(c.x), (short)f2bf(c.y), (short)f2bf(c.z), (short)f2bf(c.w)}; }
        pg8::f32x4 oacc[4][4];
        float mrow[4][4], lrow[4][4];
        const float sink = p.swa_sink[il * 8 + hq];
#pragma unroll
        for (int tq = 0; tq < 4; ++tq)
#pragma unroll
            for (int x = 0; x < 4; ++x) { oacc[tq][x] = (pg8::f32x4){0.f, 0.f, 0.f, 0.f}; mrow[tq][x] = sink; lrow[tq][x] = 1.0f; }
        const int ntile = isctx ? 4 : 10;
        for (int t = 0; t < ntile; ++t) {
            const bool loc = !isctx && t < 6;
            const int kpos0 = loc ? 128 * (qb - 1) + 64 * t : 0;
            if (loc && (kpos0 < 0 || kpos0 >= SEQ)) continue;
            const int krow0 = loc ? b * SEQ + kpos0 : NLAT + b * CTXL + 64 * (isctx ? t : t - 6);
            __syncthreads();
            for (int idx = tid; idx < 64 * 16; idx += NTHREADS) { const int key = idx >> 4, d4 = idx & 15;
                const float4 kk = *(const float4*)(p.ks + (size_t)(krow0 + key) * 128 + kv * 64 + 4 * d4), vv = *(const float4*)(p.px + (size_t)(krow0 + key) * PXLD + 2176 + kv * 64 + 4 * d4);
                *(LAS us4v*)(Ks + key * LDK + 4 * d4) = pack4(kk);
                VT[(4 * d4 + 0) * LDK + key] = f2bf(vv.x); VT[(4 * d4 + 1) * LDK + key] = f2bf(vv.y); VT[(4 * d4 + 2) * LDK + key] = f2bf(vv.z); VT[(4 * d4 + 3) * LDK + key] = f2bf(vv.w); }
            __syncthreads();
            pg8::f32x4 sc[4][4];
#pragma unroll
            for (int tk = 0; tk < 4; ++tk) { const LAS bf16_t* kp = Ks + (16 * tk + r) * LDK + 8 * q;
                const pg8::bf16x8 k0 = *(const LAS pg8::bf16x8*)kp, k1 = *(const LAS pg8::bf16x8*)(kp + 32);
#pragma unroll
                for (int tq = 0; tq < 4; ++tq) { pg8::f32x4 a = {0.f, 0.f, 0.f, 0.f};
                    a = __builtin_amdgcn_mfma_f32_16x16x32_bf16(qf[tq][0], k0, a, 0, 0, 0); a = __builtin_amdgcn_mfma_f32_16x16x32_bf16(qf[tq][1], k1, a, 0, 0, 0); sc[tq][tk] = a; } }
            if (loc) {
#pragma unroll
                for (int tq = 0; tq < 4; ++tq)
#pragma unroll
                    for (int tk = 0; tk < 4; ++tk)
#pragma unroll
                        for (int x = 0; x < 4; ++x) { const int dlt = (kpos0 + 16 * tk + r) - (128 * qb + i0 + 16 * tq + 4 * q + x); if (dlt > 128 || dlt < -128) sc[tq][tk][x] = -1e30f; }
            }
#pragma unroll
            for (int tq = 0; tq < 4; ++tq)
#pragma unroll
                for (int x = 0; x < 4; ++x) {
                    float mx = fmaxf(fmaxf(sc[tq][0][x], sc[tq][1][x]), fmaxf(sc[tq][2][x], sc[tq][3][x]));
                    mx = fmaxf(mx, __shfl_xor(mx, 1)); mx = fmaxf(mx, __shfl_xor(mx, 2)); mx = fmaxf(mx, __shfl_xor(mx, 4)); mx = fmaxf(mx, __shfl_xor(mx, 8));
                    const float mn = fmaxf(mrow[tq][x], mx), corr = __expf(mrow[tq][x] - mn);
                    float sum = 0.f;
#pragma unroll
                    for (int tk = 0; tk < 4; ++tk) { const float pe = __expf(sc[tq][tk][x] - mn); sum += pe; Pw[(16 * tq + 4 * q + x) * LDK + 16 * tk + r] = f2bf(pe); }
                    sum += __shfl_xor(sum, 1); sum += __shfl_xor(sum, 2); sum += __shfl_xor(sum, 4); sum += __shfl_xor(sum, 8);
                    lrow[tq][x] = lrow[tq][x] * corr + sum; mrow[tq][x] = mn;
#pragma unroll
                    for (int td = 0; td < 4; ++td) oacc[tq][td][x] *= corr;
                }
            asm volatile("s_waitcnt lgkmcnt(0)" ::: "memory");
#pragma unroll
            for (int td = 0; td < 4; ++td) { const LAS bf16_t* vp = VT + (16 * td + r) * LDK + 8 * q;
                const pg8::bf16x8 v0 = *(const LAS pg8::bf16x8*)vp, v1 = *(const LAS pg8::bf16x8*)(vp + 32);
#pragma unroll
                for (int tq = 0; tq < 4; ++tq) { const LAS bf16_t* pp = Pw + (16 * tq + r) * LDK + 8 * q;
                    oacc[tq][td] = __builtin_amdgcn_mfma_f32_16x16x32_bf16(*(const LAS pg8::bf16x8*)pp, v0, oacc[tq][td], 0, 0, 0);
                    oacc[tq][td] = __builtin_amdgcn_mfma_f32_16x16x32_bf16(*(const LAS pg8::bf16x8*)(pp + 32), v1, oacc[tq][td], 0, 0, 0); } }
        }
#pragma unroll
        for (int tq = 0; tq < 4; ++tq)
#pragma unroll
            for (int x = 0; x < 4; ++x) { const float inv = 1.0f / lrow[tq][x]; bf16_t* o = p.mixb + (size_t)(qrow0 + 16 * tq + 4 * q + x) * D + 512 + hq * 64 + r;
#pragma unroll
                for (int td = 0; td < 4; ++td) o[16 * td] = f2bf(oacc[tq][td][x] * inv); }
    }
}
__device__ __forceinline__ void mf_sconv(const P& p, LAS unsigned char* lds, int il) {
    int tid = threadIdx.x; asm volatile("" : "+v"(tid));
    int bx_ = (int)blockIdx.x, gx_ = (int)gridDim.x; asm volatile("" : "+s"(bx_), "+s"(gx_));
    LAS float* T = (LAS float*)lds;
    const float* sw = p.hy_short_w + il * 3 * 1536; const float* sb = p.hy_short_b + il * 1536;
    constexpr int NT = (NTOK / 64) * (HYW / 64);
    for (int t = bx_; t < NT; t += gx_) {
        const int r0 = (t / (HYW / 64)) * 64, c0 = (t % (HYW / 64)) * 64;
        const int rl = tid >> 3, cs = (tid & 7) * 8, r = r0 + rl; const RowInfo ri = row_info(r);
        float u[3][8];
#pragma unroll
        for (int g = 0; g < 3; ++g) { const int col = g * HYW + c0 + cs; const float4 b0 = *(const float4*)(sb + col), b1 = *(const float4*)(sb + col + 4);
            u[g][0] = b0.x; u[g][1] = b0.y; u[g][2] = b0.z; u[g][3] = b0.w; u[g][4] = b1.x; u[g][5] = b1.y; u[g][6] = b1.z; u[g][7] = b1.w;
#pragma unroll
            for (int j = 0; j < 3; ++j) { const int tt = ri.t + j - 1; if (tt >= 0 && tt < ri.len) { const float* px = p.px + (size_t)(ri.base + tt) * PXLD + col; const float* wj = sw + j * 1536 + col;
                const float4 x0 = *(const float4*)px, x1 = *(const float4*)(px + 4), w0 = *(const float4*)wj, w1 = *(const float4*)(wj + 4);
                u[g][0] += w0.x * x0.x; u[g][1] += w0.y * x0.y; u[g][2] += w0.z * x0.z; u[g][3] += w0.w * x0.w; u[g][4] += w1.x * x1.x; u[g][5] += w1.y * x1.y; u[g][6] += w1.z * x1.z; u[g][7] += w1.w * x1.w; } } }
        float z[8];
#pragma unroll
        for (int k = 0; k < 8; ++k) z[k] = u[2][k] * u[1][k];
        const size_t i = (size_t)r * HYW + c0 + cs;
        *(float4*)(p.x0c + i) = make_float4(u[0][0], u[0][1], u[0][2], u[0][3]); *(float4*)(p.x0c + i + 4) = make_float4(u[0][4], u[0][5], u[0][6], u[0][7]);
        *(float4*)(p.zb + i) = make_float4(z[0], z[1], z[2], z[3]); *(float4*)(p.zb + i + 4) = make_float4(z[4], z[5], z[6], z[7]);
        if (r0 < NLAT) {
            __syncthreads();
#pragma unroll
            for (int k = 0; k < 8; ++k) T[(cs + k) * 65 + rl] = z[k];
            __syncthreads();
            const int cl = tid >> 3, rs = (tid & 7) * 8; const LAS float* src = T + cl * 65 + rs; float* dst = p.zT + (size_t)(c0 + cl) * NLAT + r0 + rs;
            *(float4*)dst = make_float4(src[0], src[1], src[2], src[3]); *(float4*)(dst + 4) = make_float4(src[4], src[5], src[6], src[7]);
        }
    }
}
__device__ __forceinline__ void mf_filter_tiles(const P& p, LAS unsigned char* lds) {
    int tid = threadIdx.x; asm volatile("" : "+v"(tid));
    int bx_ = (int)blockIdx.x, gx_ = (int)gridDim.x; asm volatile("" : "+s"(bx_), "+s"(gx_));
    LAS float* A1 = (LAS float*)lds; LAS float* A2 = A1 + 64 * 65; LAS float* T = A2 + 64 * 65;
    constexpr int RT = (SEQ + CTXL) / 64;
    const int rl = tid >> 3, cs = (tid & 7) * 8;
    constexpr int NLT = 2 * (SEQ / 64), NCT = 2 * (CTXL / 64), NITEM = NLT + NCT * (HYW / 64);
    for (int it = bx_; it < NITEM; it += gx_) {
        int t, ct0, ct1;
        if (it < NLT) { t = (it / (SEQ / 64)) * RT + it % (SEQ / 64); ct0 = 0; ct1 = HYW / 64; }
        else { const int v = it - NLT, tc = v / (HYW / 64); t = (tc / (CTXL / 64)) * RT + SEQ / 64 + tc % (CTXL / 64); ct0 = v % (HYW / 64); ct1 = ct0 + 1; }
        const int i = t / RT, rt = t % RT, q0 = rt * 64, kind = q0 >= SEQ, L = kind ? CTXL : SEQ, q = q0 + rl, pos = kind ? q - SEQ : q;
        const long rr = (long)i * (SEQ + CTXL) + q;
        __syncthreads();
        {
            const float* w1 = p.hy_f_w1 + i * 33 * 64 + cs; const float tt = (float)pos / (float)L, w = 6.283185307179586f * (float)pos / (float)L;
            float acc[8];
#pragma unroll
            for (int k = 0; k < 8; ++k) acc[k] = tt * w1[k];
            for (int bi = 0; bi < 16; ++bi) { const float band = 1e-4f + (float)bi * ((15.0f - 1e-4f) / 15.0f), cc = ROPE_COS(band * w), sn = ROPE_SIN(band * w);
                const float* wc = w1 + (1 + bi) * 64; const float* ws = w1 + (17 + bi) * 64;
#pragma unroll
                for (int k = 0; k < 8; ++k) acc[k] += cc * wc[k] - sn * ws[k]; }
#pragma unroll
            for (int k = 0; k < 8; ++k) A1[rl * 65 + cs + k] = ROPE_SIN(acc[k] + p.hy_f_b1[i * 64 + cs + k]);
        }
        __syncthreads();
        {
            const float* w2 = p.hy_f_w2 + i * 64 * 64 + cs; float acc[8];
#pragma unroll
            for (int k = 0; k < 8; ++k) acc[k] = 0.f;
            for (int kk = 0; kk < 64; ++kk) { const float hv = A1[rl * 65 + kk]; const float4 a = *(const float4*)(w2 + kk * 64), b4 = *(const float4*)(w2 + kk * 64 + 4);
                acc[0] += hv * a.x; acc[1] += hv * a.y; acc[2] += hv * a.z; acc[3] += hv * a.w; acc[4] += hv * b4.x; acc[5] += hv * b4.y; acc[6] += hv * b4.z; acc[7] += hv * b4.w; }
#pragma unroll
            for (int k = 0; k < 8; ++k) A2[rl * 65 + cs + k] = ROPE_SIN(acc[k] + p.hy_f_b2[i * 64 + cs + k]);
        }
        __syncthreads();
        const float lag = fabsf((float)(pos - L / 2)) / (float)(L / 2);
        for (int ct = ct0; ct < ct1; ++ct) {
            const int c0 = ct * 64; const float* w3 = p.hy_f_w3 + (size_t)i * 64 * HYW + c0 + cs;
            float acc[8];
#pragma unroll
            for (int k = 0; k < 8; ++k) acc[k] = 0.f;
            for (int kk = 0; kk < 64; ++kk) { const float hv = A2[rl * 65 + kk]; const float4 a = *(const float4*)(w3 + (size_t)kk * HYW), b4 = *(const float4*)(w3 + (size_t)kk * HYW + 4);
                acc[0] += hv * a.x; acc[1] += hv * a.y; acc[2] += hv * a.z; acc[3] += hv * a.w; acc[4] += hv * b4.x; acc[5] += hv * b4.y; acc[6] += hv * b4.z; acc[7] += hv * b4.w; }
            const float fast = -15.350567286626973f, slow = -3.0701134573253946f;
#pragma unroll
            for (int k = 0; k < 8; ++k) { const float delta = fabsf(fast + (slow - fast) * (float)(c0 + cs + k) / 511.0f); acc[k] *= fexp(-lag * delta) + 0.05f; }
            float* o = p.hraw + rr * HYW + c0 + cs;
            *(float4*)o = make_float4(acc[0], acc[1], acc[2], acc[3]); *(float4*)(o + 4) = make_float4(acc[4], acc[5], acc[6], acc[7]);
            __syncthreads();
#pragma unroll
            for (int k = 0; k < 8; ++k) T[(cs + k) * 65 + rl] = acc[k];
            __syncthreads();
            const int cl = tid >> 3, rs = (tid & 7) * 8; const LAS float* src = T + cl * 65 + rs;
            float v8[8];
#pragma unroll
            for (int k = 0; k < 8; ++k) v8[k] = src[k];
            if (!kind) { float* dst = p.hT + ((size_t)i * HYW + c0 + cl) * SEQ + q0 + rs;
                *(float4*)dst = make_float4(v8[0], v8[1], v8[2], v8[3]); *(float4*)(dst + 4) = make_float4(v8[4], v8[5], v8[6], v8[7]); }
            float sa = 0.f;
#pragma unroll
            for (int k = 0; k < 8; ++k) sa += fabsf(v8[k]);
            sa += __shfl_xor(sa, 1); sa += __shfl_xor(sa, 2); sa += __shfl_xor(sa, 4);
            if ((tid & 7) == 0) p.hpart[(size_t)t * HYW + c0 + cl] = sa;
        }
    }
}
__device__ __forceinline__ void mf_hymix(const P& p, LAS unsigned char* lds, int il) {
    int tid = threadIdx.x; asm volatile("" : "+v"(tid));
    int bx_ = (int)blockIdx.x, gx_ = (int)gridDim.x; asm volatile("" : "+s"(bx_), "+s"(gx_));
    LAS float* T = (LAS float*)lds;
    constexpr int NT = (NLAT / 64) * (HYW / 64);
    for (int t = bx_; t < NT; t += gx_) {
        const int r0 = (t / (HYW / 64)) * 64, c0 = (t % (HYW / 64)) * 64;
        __syncthreads();
        { const int cl = tid >> 3, rs = (tid & 7) * 8; const float* src = p.convT + (size_t)(c0 + cl) * NLAT + r0 + rs; const float4 a = *(const float4*)src, b = *(const float4*)(src + 4);
          LAS float* d = T + cl * 65 + rs; d[0] = a.x; d[1] = a.y; d[2] = a.z; d[3] = a.w; d[4] = b.x; d[5] = b.y; d[6] = b.z; d[7] = b.w; }
        __syncthreads();
        { const int rl = tid >> 3, cs = (tid & 7) * 8; const size_t i = (size_t)(r0 + rl) * HYW + c0 + cs;
          const float4 z0 = *(const float4*)(p.zb + i), z1 = *(const float4*)(p.zb + i + 4), x0 = *(const float4*)(p.x0c + i), x1 = *(const float4*)(p.x0c + i + 4);
          const float4 b0 = *(const float4*)(p.hy_bias + il * HYW + c0 + cs), b1 = *(const float4*)(p.hy_bias + il * HYW + c0 + cs + 4);
          const float zz[8] = {z0.x, z0.y, z0.z, z0.w, z1.x, z1.y, z1.z, z1.w}, xx[8] = {x0.x, x0.y, x0.z, x0.w, x1.x, x1.y, x1.z, x1.w}, bb[8] = {b0.x, b0.y, b0.z, b0.w, b1.x, b1.y, b1.z, b1.w};
          unsigned short o[8];
#pragma unroll
          for (int k = 0; k < 8; ++k) o[k] = f2bf(xx[k] * (T[(cs + k) * 65 + rl] + bb[k] * zz[k]));
          uint4 ov; ov.x = o[0] | ((unsigned)o[1] << 16); ov.y = o[2] | ((unsigned)o[3] << 16); ov.z = o[4] | ((unsigned)o[5] << 16); ov.w = o[6] | ((unsigned)o[7] << 16);
          *(uint4*)(p.mixb + (size_t)(r0 + rl) * D + c0 + cs) = ov; }
    }
}
__device__ __forceinline__ void mf_retout(const P& p, int nrows) {
    int tid = threadIdx.x; asm volatile("" : "+v"(tid));
    int bx_ = (int)blockIdx.x, gx_ = (int)gridDim.x; asm volatile("" : "+s"(bx_), "+s"(gx_));
    const int lane = tid & 63, wave = tid >> 6;
    for (int r = bx_ * 8 + wave; r < nrows; r += gx_ * 8) {
        const float* o0 = p.oret + (size_t)r * 512 + 8 * lane; const float* o1 = p.oret + ((size_t)NTOK + r) * 512 + 8 * lane; const float* gp = p.px + (size_t)r * PXLD + 1024 + 8 * lane;
        const float4 a0 = *(const float4*)o0, a1 = *(const float4*)(o0 + 4), b0 = *(const float4*)o1, b1 = *(const float4*)(o1 + 4), g0 = *(const float4*)gp, g1 = *(const float4*)(gp + 4);
        const float o[8] = {a0.x + b0.x, a0.y + b0.y, a0.z + b0.z, a0.w + b0.w, a1.x + b1.x, a1.y + b1.y, a1.z + b1.z, a1.w + b1.w}, gg[8] = {g0.x, g0.y, g0.z, g0.w, g1.x, g1.y, g1.z, g1.w};
        float ss = 0.f;
#pragma unroll
        for (int k = 0; k < 8; ++k) ss += o[k] * o[k];
        ss += __shfl_xor(ss, 1); ss += __shfl_xor(ss, 2); ss += __shfl_xor(ss, 4); ss += __shfl_xor(ss, 8);
        const float rs = rsqrtf(ss * (1.0f / 128.0f) + EPS);
        unsigned short ob[8];
#pragma unroll
        for (int k = 0; k < 8; ++k) ob[k] = f2bf(o[k] * rs * siluf_(gg[k]));
        uint4 ov; ov.x = ob[0] | ((unsigned)ob[1] << 16); ov.y = ob[2] | ((unsigned)ob[3] << 16); ov.z = ob[4] | ((unsigned)ob[5] << 16); ov.w = ob[6] | ((unsigned)ob[7] << 16);
        *(uint4*)(p.mixb + (size_t)r * D + 8 * lane) = ov;
    }
}
__device__ __forceinline__ void mf_lconv(const P& p, LAS unsigned char* lds, int il) {
    int tid = threadIdx.x; asm volatile("" : "+v"(tid));
    int bx_ = (int)blockIdx.x, gx_ = (int)gridDim.x; asm volatile("" : "+s"(bx_), "+s"(gx_));
    for (int c = bx_; c < HYW; c += gx_) lconv_unit(p, il, c, (LAS CX*)lds, p.zf + (size_t)bx_ * 2 * FFTN, tid, NTHREADS);
}
__device__ __forceinline__ void mf_inproj(const P& p, LAS unsigned char* lds, int layer) {
    const int il = layer >> 1; const bool ab = !(layer & 1);
    pg8::Gemm g{p.hxb, ab ? p.abin_t + (size_t)il * AB_IN * D : p.cdin_t + (size_t)il * CD_IN * D, NTOK, ab ? AB_IN : CD_IN, D, 0};
    int gx_ = (int)gridDim.x, bx_ = (int)blockIdx.x; asm volatile("" : "+s"(gx_), "+s"(bx_));
    pg8::StaticOrder S; S.init(g.M, g.N, gx_, bx_);
    pg8::EpiStoreF32 E{p.px, PXLD};
    pg8::gemm_phase(lds, g, S, E);
}
__device__ __forceinline__ void mf_outproj(const P& p, LAS unsigned char* lds, int layer, int nrows) {
    const int il = layer >> 1; const bool ab = !(layer & 1);
    pg8::Gemm g{p.mixb, (ab ? p.about_t : p.cdout_t) + (size_t)il * D * D, nrows, D, D, 0};
    int gx_ = (int)gridDim.x, bx_ = (int)blockIdx.x; asm volatile("" : "+s"(gx_), "+s"(bx_));
    pg8::StaticOrder S; S.init(g.M, g.N, gx_, bx_);
    pg8::EpiResid E{p.xa, p.modv + (size_t)layer * 3 * 6 * D + 2 * D};
    pg8::gemm_phase(lds, g, S, E);
}
__device__ __forceinline__ void mf_glu(const P& p, LAS unsigned char* lds, int il) {
    pg8::Gemm g{p.ys5b, p.glu_t + (size_t)il * S5W * S5W, NTOK, S5W, S5W, 0};
    int gx_ = (int)gridDim.x, bx_ = (int)blockIdx.x; asm volatile("" : "+s"(gx_), "+s"(bx_));
    pg8::StaticOrder S; S.init(g.M, g.N, gx_, bx_);
    pg8::EpiGlu E{p.mixb, p.ys5b, p.s5_glu_b + il * S5W};
    pg8::gemm_phase(lds, g, S, E);
}
__device__ __forceinline__ int build_ue(const P& p, LAS unsigned char* lds, int layer) {
    volatile LAS unsigned char* ue = (volatile LAS unsigned char*)(lds + UE_OFF); volatile LAS int* tot = (volatile LAS int*)(lds + MISC_OFF + 16);
    __syncthreads();
    if (threadIdx.x == 0) { const int* cnt = p.cnt + layer * NE; int t = 0;
        for (int e = 0; e < NE; ++e) { const int nt = (cnt[e] + 255) >> 8; for (int q = 0; q < nt; ++q) ue[t + q] = (unsigned char)e; t += nt; }
        *tot = t; }
    __syncthreads();
    return *tot;
}
__device__ __forceinline__ void mf_moe1(const P& p, LAS unsigned char* lds, int layer) {
    const int tiles = build_ue(p, lds, layer);
    int gx_ = (int)gridDim.x, bx_ = (int)blockIdx.x; asm volatile("" : "+s"(gx_), "+s"(bx_));
    pg8::MoeOrder S{tiles * 8, 8, gx_, bx_, (const volatile LAS unsigned char*)(lds + UE_OFF), (const volatile LAS int*)(lds + TOK_OFF)};
    volatile LAS int* tokt = (volatile LAS int*)(lds + TOK_OFF);
    { int tid = threadIdx.x; asm volatile("" : "+v"(tid));
      for (int i = 0; i < TOK_UNITS; ++i) { int pm, pn; if (!S.unit(i, pm, pn)) break;
          for (int t = tid; t < 256; t += NTHREADS) { const int tk = p.slot_tok[pm * 256 + t]; tokt[i * 256 + t] = tk < 0 ? NTOK : tk; } }
      __syncthreads(); }
    pg8::Gemm g{p.hxb, p.wgu_t + (size_t)layer * NE * 2 * DFF * D, tiles * 256, 2 * DFF, D, (size_t)2 * DFF * D * 2};
    pg8::EpiSwiglu E{p.actb, p.b_gu + (size_t)layer * NE * 2 * DFF};
    pg8::gemm_phase<pg8::EpiSwiglu, pg8::MoeOrder, true>(lds, g, S, E);
}
__device__ __forceinline__ void mf_moe2(const P& p, LAS unsigned char* lds, int layer) {
    const int tiles = build_ue(p, lds, layer);
    pg8::Gemm g{p.actb, p.wdn_t + (size_t)layer * NE * D * DFF, tiles * 256, D, DFF, (size_t)D * DFF * 2};
    int gx_ = (int)gridDim.x, bx_ = (int)blockIdx.x; asm volatile("" : "+s"(gx_), "+s"(bx_));
    pg8::MoeOrder S{tiles * 4, 4, gx_, bx_, (const volatile LAS unsigned char*)(lds + UE_OFF), nullptr};
    pg8::EpiDown E{p.yb, p.b_dn + (size_t)layer * NE * D, p.slot_gate};
    pg8::gemm_phase(lds, g, S, E);
}

#define XB_TMO      128
#define XB_XCNT(j)  (256  + 64 * (j))
#define XB_XSUB(j)  (1280 + 64 * (j))
#define XB_XGEN(j)  (2304 + 64 * (j))
#define XB_TOP      3328
#define XB_TOPGEN   3392
#define XCD_BAR_WORDS 3456
#define XB_SPIN_CAP (1u << 18)

__device__ __forceinline__ unsigned xb_ld(unsigned* p)              { return __hip_atomic_load(p, __ATOMIC_RELAXED, __HIP_MEMORY_SCOPE_AGENT); }
__device__ __forceinline__ unsigned xb_add(unsigned* p, unsigned v) { return __hip_atomic_fetch_add(p, v, __ATOMIC_RELAXED, __HIP_MEMORY_SCOPE_AGENT); }
__device__ __forceinline__ unsigned xb_xcc_id() { return (unsigned)__builtin_amdgcn_s_getreg((3 << 11) | 20) & 0xFu; }
#define XB_SPIN(cond, bar) do { unsigned _sp = 0; while (cond) { __builtin_amdgcn_s_sleep(1); \
    if ((++_sp & 255u) == 0u) { if (xb_ld(&(bar)[XB_TMO])) break; if (_sp > XB_SPIN_CAP) { atomicAdd(&(bar)[XB_TMO], 1u); break; } } } } while (0)

struct XcdBarrier { unsigned* bar; unsigned x; volatile LAS unsigned* st; };

__device__ __forceinline__ XcdBarrier xcd_barrier_post(unsigned* bar, volatile LAS unsigned* st) {
    XcdBarrier b; b.bar = bar; b.x = xb_xcc_id(); b.st = st;
    if (threadIdx.x == 0) (void)xb_add(&bar[XB_XCNT(b.x)], 1u);
    return b;
}
__device__ __forceinline__ void xcd_barrier_complete(unsigned* bar, unsigned x, unsigned& nloc, unsigned& nx) {
    const unsigned G = gridDim.x * gridDim.y * gridDim.z;
    unsigned sum, cnt, mine, sp = 0u;
    asm volatile("" : "+s"(x));
    for (;;) {
        sum = 0u; cnt = 0u; mine = 0u;
#pragma unroll
        for (unsigned j = 0; j < 16; ++j) { const unsigned c = xb_ld(&bar[XB_XCNT(j)]); sum += c; cnt += (c > 0u) ? 1u : 0u; mine = (j == x) ? c : mine; }
        if (sum == G) break;
        __builtin_amdgcn_s_sleep(1);
        if ((++sp & 255u) == 0u) { if (xb_ld(&bar[XB_TMO])) break; if (sp > XB_SPIN_CAP) { atomicAdd(&bar[XB_TMO], 1u); break; } }
    }
    nloc = mine > 0u ? mine : 1u; nx = cnt > 0u ? cnt : 1u;
}
__device__ __forceinline__ void xcd_barrier(const XcdBarrier& b) {
    asm volatile("s_waitcnt vmcnt(0)" ::: "memory");
    __syncthreads();
    if (threadIdx.x == 0) {
        unsigned* bar = b.bar; unsigned bx = b.x;
        asm volatile("" : "+s"(bar), "+s"(bx));
        __builtin_amdgcn_s_waitcnt(0);
        unsigned nloc = b.st[0], nx = b.st[1];
        if (nloc == 0u) { xcd_barrier_complete(bar, bx, nloc, nx); b.st[0] = nloc; b.st[1] = nx; }
        const unsigned old = xb_add(&bar[XB_XSUB(bx)], 1u);
        const unsigned gen = old / nloc;
        if (old + 1u == (gen + 1u) * nloc) {
            __builtin_amdgcn_fence(__ATOMIC_RELEASE, "agent");
            asm volatile("s_waitcnt vmcnt(0)" ::: "memory");
            const unsigned og = xb_add(&bar[XB_TOP], 1u);
            const unsigned tg = og / nx;
            if (og + 1u == (tg + 1u) * nx) xb_add(&bar[XB_TOPGEN], 1u);
            else XB_SPIN(xb_ld(&bar[XB_TOPGEN]) == tg, bar);
            __builtin_amdgcn_fence(__ATOMIC_ACQUIRE, "agent");
            xb_add(&bar[XB_XGEN(bx)], 1u);
            asm volatile("s_waitcnt vmcnt(0)" ::: "memory");
        } else {
            XB_SPIN(xb_ld(&bar[XB_XGEN(bx)]) == gen, bar);
            __builtin_amdgcn_fence(__ATOMIC_ACQUIRE, "agent");
            asm volatile("s_waitcnt vmcnt(0)" ::: "memory");
        }
    }
    __syncthreads();
}

typedef const __attribute__((address_space(4))) P* KP;
__global__ void __launch_bounds__(NTHREADS, 2) fwd_kernel(P p_arg) {
    (void)p_arg;
    const KP kp0 = (KP)__builtin_amdgcn_kernarg_segment_ptr();
#define p (*(const P*)({ KP q_ = kp0; asm volatile("" : "+s"(q_)); q_; }))
    extern __shared__ __attribute__((aligned(16))) unsigned char lds_raw[];
    LAS unsigned char* lds = (LAS unsigned char*)lds_raw;
    for (int u = threadIdx.x; u < (LDS_BYTES - MISC_OFF) / 4; u += NTHREADS) ((LAS unsigned*)(lds + MISC_OFF))[u] = 0u;
    __syncthreads();
    XcdBarrier bar = xcd_barrier_post(p.bar, (volatile LAS unsigned*)(lds + MISC_OFF));
    const long gs = (long)gridDim.x * NTHREADS;
#define gt ({ int b_ = (int)blockIdx.x; asm volatile("" : "+s"(b_)); long g_ = (long)b_ * NTHREADS + threadIdx.x; asm volatile("" : "+v"(g_)); g_; })
#define SETUP(S) setup_slot<S>(p, gt, gs); xcd_barrier(bar);
    for (int rep = 0; rep < REP_SETUP; ++rep) {
    setup_slot<0>(p, gt, gs); mf_filter_tiles(p, lds); __syncthreads(); ph_convert_weights(p, lds); xcd_barrier(bar);
    ph_mod2(p, gt, gs); ph_filt4(p, gt, gs); xcd_barrier(bar);
    }
#define SLOT(S) layer_slot<S>(p, layer, gt, gs); xcd_barrier(bar);
#if MFMA_DENSE
#define DENSE_IN  for (int rep = 0; rep < REP_IN; ++rep) { mf_inproj(p, lds, layer); if (layer < 3) convert_deferred(p, lds, layer, 0); xcd_barrier(bar); }
#define DENSE_OUT if (!(layer & 1)) mf_glu(p, lds, layer >> 1); else ph_retout(p, layer < 3 ? NTOK : NLAT, gt, gs); xcd_barrier(bar); \
                  mf_outproj(p, lds, layer, layer < 3 ? NTOK : NLAT); xcd_barrier(bar);
#else
#define DENSE_IN  SLOT(2)
#define DENSE_OUT SLOT(7) SLOT(8)
#endif
#if MFMA_MOE
#define MOE_GEMMS for (int rep = 0; rep < REP_MOE; ++rep) { mf_moe1(p, lds, layer); xcd_barrier(bar); } for (int rep = 0; rep < REP_MOE2; ++rep) { mf_moe2(p, lds, layer); xcd_barrier(bar); }
#else
#define MOE_GEMMS SLOT(14) SLOT(15)
#endif
#define REPF(n) for (int rep_ = 0; rep_ < (n); ++rep_)
#define LAYER(L) { constexpr int layer = L; constexpr bool AB = !(layer & 1); constexpr int il = layer >> 1; constexpr int nrows = layer < 3 ? NTOK : NLAT; \
    REPF(RN) mf_rownorm<0>(p, lds, layer, NTOK, layer - 1); xcd_barrier(bar); DENSE_IN \
    REPF(R3) { if (AB) { mf_s5<false>(p, lds, il); mf_sconv(p, lds, il); } else ph_rope(p, gt, gs); } xcd_barrier(bar); \
    REPF(R4) { if (AB) { mf_lconv(p, lds, il); ph_lconv(p, il, NLAT, NTOK, gt, gs); } else mf_retkv(p, lds, il); } if (AB) ph_s5carry(p, il, gt, gs); xcd_barrier(bar); \
    REPF(R5) { if (AB) { mf_s5<true>(p, lds, il); mf_hymix(p, lds, il); } else mf_swa(p, lds, il, layer < 3); } if (!AB) ph_retcarry(p, il, gt, gs); xcd_barrier(bar); \
    REPF(R6) { if (AB) ph_s5fin(p, il, gt, gs); else mf_reto(p, lds, il); } xcd_barrier(bar); \
    REPF(R7) { if (AB) mf_glu(p, lds, il); else mf_retout(p, nrows); } xcd_barrier(bar); \
    mf_outproj(p, lds, layer, nrows); if (layer < 3) convert_deferred(p, lds, layer, 1); xcd_barrier(bar); \
    mf_rownorm<1>(p, lds, layer, nrows, -1); xcd_barrier(bar); SLOT(12) MOE_GEMMS }
    LAYER(0) LAYER(1) LAYER(2) LAYER(3)
    mf_rownorm<2>(p, lds, 3, NLAT, 3);
#undef gt
#undef p
}

extern "C" void kernel_launch(void* const* d_in, const int* in_sizes, int n_in, void* d_out, int out_size, void* d_ws, size_t ws_size, hipStream_t stream) {
    (void)in_sizes; (void)n_in; (void)out_size;
    const WsMap m = ws_map();
    if (ws_size < m.total) { fprintf(stderr, "workspace too small: %zu < %zu\n", ws_size, m.total); return; }
    P p; memset(&p, 0, sizeof(p)); fill_params(p, d_in, d_out, d_ws);
    static int grid = 0;
    if (!grid) {
        int dev = 0, cus = 0, per_cu = 0;
        (void)hipGetDevice(&dev); (void)hipDeviceGetAttribute(&cus, hipDeviceAttributeMultiprocessorCount, dev);
        if (hipFuncSetAttribute((const void*)fwd_kernel, hipFuncAttributeMaxDynamicSharedMemorySize, LDS_BYTES) != hipSuccess) { fprintf(stderr, "hipFuncSetAttribute failed\n"); grid = -1; return; }
        (void)hipOccupancyMaxActiveBlocksPerMultiprocessor(&per_cu, (const void*)fwd_kernel, NTHREADS, LDS_BYTES);
        if (per_cu < 1) fprintf(stderr, "occupancy query reports %d blocks per CU\n", per_cu);
        grid = cus;
    }
    if (grid <= 0) return;
    (void)hipMemsetAsync(p.bar, 0, XCD_BAR_WORDS * sizeof(unsigned), stream);
    fwd_kernel<<<dim3(grid), dim3(NTHREADS), LDS_BYTES, stream>>>(p);
}
#endif
```

```cpp
#ifndef CPU_SHIM
#include <hip/hip_runtime.h>
#include <cstring>
#include <cstdio>
#include <cstdint>
#define DEV __device__ __forceinline__
#else
#include <cmath>
#include <cstdio>
#include <cstdint>
#include <cstring>
#include <cstdlib>
#define DEV static inline
static inline float rsqrtf(float x) { return 1.0f / sqrtf(x); }
#endif

#ifndef SEQ
#define SEQ 8192
#endif
#ifndef CTXL
#define CTXL 256
#endif
#ifndef N_LAUNCH_MODE
#define N_LAUNCH_MODE 1
#endif
#ifdef CPU_SHIM
#define MFMA_DENSE 0
#define MFMA_MOE 0
#endif
#ifndef R3
#define R3 1
#endif
#ifndef R4
#define R4 1
#endif
#ifndef R5
#define R5 1
#endif
#ifndef R6
#define R6 1
#endif
#ifndef R7
#define R7 1
#endif
#ifndef RG
#define RG 1
#endif
#ifndef RN
#define RN 1
#endif
#ifndef REP_SETUP
#define REP_SETUP 1
#endif
#ifndef REP_MOE
#define REP_MOE 1
#endif
#ifndef REP_MOE2
#define REP_MOE2 1
#endif
#ifndef REP_IN
#define REP_IN 1
#endif
#ifndef REP_RET
#define REP_RET 1
#endif
#ifndef REP_SWA
#define REP_SWA 1
#endif
#ifndef REP_S5
#define REP_S5 1
#endif
#ifndef MFMA_DENSE
#define MFMA_DENSE 1
#endif
#ifndef MFMA_MOE
#define MFMA_MOE 1
#endif
typedef unsigned short bf16_t;
#if MFMA_DENSE
typedef unsigned short px_t;
#else
typedef float px_t;
#endif

constexpr int D = 1024, NLAT = 2 * SEQ, NCTX = 2 * CTXL, NTOK = NLAT + NCTX;
constexpr int HYW = 512, S5W = 512, NG = 32, NP = 64, GH = 16;
constexpr int AB_IN = 2048, CD_IN = 2304, PXLD = 2304;
constexpr int NE = 32, DFF = 1024;
constexpr float EPS = 1e-6f;
constexpr int NSLOT = ((NTOK * 4 + 255) / 256 + NE) * 256;
#ifdef CPU_SHIM
DEV bf16_t f2bf(float f) { unsigned u; memcpy(&u, &f, 4); return (bf16_t)((u + 0x7fffu + ((u >> 16) & 1u)) >> 16); }
DEV float fexp(float x) { return expf(x); }
DEV float frcp(float x) { return 1.0f / x; }
#else
DEV bf16_t f2bf(float f) { const __bf16 b = (__bf16)f; return __builtin_bit_cast(unsigned short, b); }
DEV float fexp(float x) { return __builtin_amdgcn_exp2f(1.4426950408889634f * x); }
DEV float frcp(float x) { return __builtin_amdgcn_rcpf(x); }
#endif
DEV float bf2f(bf16_t b) { const unsigned u = (unsigned)b << 16; float f; memcpy(&f, &u, 4); return f; }
DEV float pxf(float v) { return v; }
DEV float pxf(bf16_t v) { return bf2f(v); }
DEV void pxstore(float* q, float v) { *q = v; }
DEV void pxstore(bf16_t* q, float v) { *q = f2bf(v); }

struct P {
    const float *x, *c, *ctx, *c_ctx, *mod_w, *mod_b, *norm1_g, *norm2_g, *ab_w_in, *ab_w_out, *hy_short_w, *hy_short_b,
        *hy_f_w1, *hy_f_b1, *hy_f_w2, *hy_f_b2, *hy_f_w3, *hy_bias, *s5_lre, *s5_lim, *s5_ldt, *s5_bre, *s5_bim, *s5_cre, *s5_cim,
        *s5_d, *s5_glu_w, *s5_glu_b, *cd_w_in, *cd_w_out, *ret_decay, *swa_sink, *router_w, *router_b, *w_gu, *b_gu, *w_dn, *b_dn, *final_g;
    float* out;
    unsigned* bar;
    float *xa, *modv, *f1, *f2, *hraw, *hsum, *rstd, *hx, *zb, *x0c, *mixin, *s5s, *ys5, *qr, *kr, *oret, *qs, *ks, *topg, *act;
    int* topi;
    px_t* px;
    bf16_t *hxb, *mixb, *ys5b, *xb, *actb, *abin_t, *cdin_t, *about_t, *cdout_t, *glu_t, *wgu_t, *wdn_t;
    bf16_t* yb;
    float *zT, *hT, *modp;
    float *slot_gate, *s5c, *rkv, *rsc, *hpart, *zf, *convT, *yd;
    int *cnt, *pos, *slot_of, *slot_tok;
};

struct RowInfo { int base, len, t, m, kind; };
DEV RowInfo row_info(int r) {
    RowInfo ri;
    if (r < NLAT) { const int b = r / SEQ; ri.base = b * SEQ; ri.len = SEQ; ri.t = r - ri.base; ri.m = b; ri.kind = 0; }
    else { const int rc = r - NLAT, b = rc / CTXL; ri.base = NLAT + b * CTXL; ri.len = CTXL; ri.t = rc - b * CTXL; ri.m = 2; ri.kind = 1; }
    return ri;
}
DEV float sigmoidf_(float x) { return frcp(1.0f + fexp(-x)); }
DEV float siluf_(float x) { return x * sigmoidf_(x); }
DEV float gelu_tanhf_(float x) { const float u = 0.7978845608028654f * (x + 0.044715f * x * x * x); return x * frcp(1.0f + fexp(-2.0f * u)); }

#ifdef CPU_SHIM
#define GSL(i, n) const long _n_##i = (long)(n); for (long i = _n_##i * gt / gs, _hi_##i = _n_##i * (gt + 1) / gs; i < _hi_##i; ++i)
#else
#define GSL(i, n) for (long i = gt; i < (long)(n); i += gs)
#endif

#if MFMA_DENSE
#define MIXST(idx, v) p.mixb[idx] = f2bf(v)
#else
#define MIXST(idx, v) p.mixin[idx] = (v)
#endif
DEV long filt_row0(int i, int kind) { return (long)i * (SEQ + CTXL) + (kind ? SEQ : 0); }

#ifdef CPU_SHIM
#define ROPE_COS(a) cosf(a)
#define ROPE_SIN(a) sinf(a)
#else
#define ROPE_COS(a) __builtin_amdgcn_cosf(__builtin_amdgcn_fractf((a) * 0.15915494309189535f))
#define ROPE_SIN(a) __builtin_amdgcn_sinf(__builtin_amdgcn_fractf((a) * 0.15915494309189535f))
#endif
DEV void ph_init(const P& p, long gt, long gs) {
    GSL(i, (long)NTOK * D) { p.xa[i] = i < (long)NLAT * D ? p.x[i] : p.ctx[i - (long)NLAT * D]; }
    GSL(j, 4 * NE) { p.cnt[j] = 0; }
    GSL(z, D) { p.hxb[(long)NTOK * D + z] = 0; }
}
DEV void ph_mod(const P& p, long gt, long gs) {
    GSL(i, 4L * 6 * D * 8) {
        const int j = (int)(i % (6 * D)), kq = (int)((i / (6 * D)) % 8), l = (int)(i / (6 * D * 8));
        const float* w = p.mod_w + (long)l * D * 6 * D + j;
        float a0 = 0.f, a1 = 0.f, a2 = 0.f;
        for (int k = kq * (D / 8); k < (kq + 1) * (D / 8); ++k) { const float wv = w[(long)k * 6 * D]; a0 += siluf_(p.c[k]) * wv; a1 += siluf_(p.c[D + k]) * wv; a2 += siluf_(p.c_ctx[k]) * wv; }
        float* o = p.modp + ((long)kq * 4 + l) * 3 * 6 * D + j;
        o[0] = a0; o[6 * D] = a1; o[12 * D] = a2;
    }
}
DEV void ph_mod2(const P& p, long gt, long gs) {
    GSL(i, 4L * 3 * 6 * D) {
        const int j = (int)(i % (6 * D)), l = (int)(i / (18 * D));
        float a = p.mod_b[l * 6 * D + j];
#pragma unroll
        for (int kq = 0; kq < 8; ++kq) a += p.modp[(long)kq * 4 * 3 * 6 * D + i];
        p.modv[i] = a;
    }
}
DEV void ph_filt1(const P& p, long gt, long gs) {
    GSL(idx, 2L * (SEQ + CTXL) * 64) {
        const int j = (int)(idx % 64); const long rr = idx / 64; const int i = (int)(rr / (SEQ + CTXL)); const int q = (int)(rr % (SEQ + CTXL));
        const int kind = q >= SEQ, pos = kind ? q - SEQ : q, L = kind ? CTXL : SEQ;
        const float* w1 = p.hy_f_w1 + i * 33 * 64;
        const float t = (float)pos / (float)L, w = 6.283185307179586f * (float)pos / (float)L;
        float acc = t * w1[j];
        for (int bi = 0; bi < 16; ++bi) {
            const float band = 1e-4f + (float)bi * ((15.0f - 1e-4f) / 15.0f);
            acc += ROPE_COS(band * w) * w1[(1 + bi) * 64 + j] - ROPE_SIN(band * w) * w1[(17 + bi) * 64 + j];
        }
        p.f1[idx] = ROPE_SIN(acc + p.hy_f_b1[i * 64 + j]);
    }
}
DEV void ph_filt2(const P& p, long gt, long gs) {
    GSL(idx, 2L * (SEQ + CTXL) * 64) {
        const int j = (int)(idx % 64); const long rr = idx / 64; const int i = (int)(rr / (SEQ + CTXL));
        const float* w2 = p.hy_f_w2 + i * 64 * 64; const float* h1 = p.f1 + rr * 64;
        float acc = 0.f;
        for (int k = 0; k < 64; ++k) acc += h1[k] * w2[k * 64 + j];
        p.f2[idx] = ROPE_SIN(acc + p.hy_f_b2[i * 64 + j]);
    }
}
DEV void ph_filt3(const P& p, long gt, long gs) {
    GSL(idx, 2L * (SEQ + CTXL) * HYW) {
        const int c = (int)(idx % HYW); const long rr = idx / HYW; const int i = (int)(rr / (SEQ + CTXL)); const int q = (int)(rr % (SEQ + CTXL));
        const int kind = q >= SEQ, pos = kind ? q - SEQ : q, L = kind ? CTXL : SEQ;
        const float* w3 = p.hy_f_w3 + (long)i * 64 * HYW; const float* h2 = p.f2 + rr * 64;
        float acc = 0.f;
        for (int k = 0; k < 64; ++k) acc += h2[k] * w3[k * HYW + c];
        const float lag = fabsf((float)(pos - L / 2)) / (float)(L / 2);
        const float fast = -15.350567286626973f, slow = -3.0701134573253946f;
        const float delta = fabsf(fast + (slow - fast) * (float)c / 511.0f);
        const float hv = acc * (expf(-lag * delta) + 0.05f);
        p.hraw[idx] = hv; if (!kind) p.hT[((long)i * HYW + c) * SEQ + pos] = hv;
    }
}
constexpr int FSEG = 64, FNSEG = (SEQ + CTXL) / FSEG;
DEV void ph_filt4a(const P& p, long gt, long gs) {
    GSL(idx, 2L * FNSEG * HYW) {
        const int c = (int)(idx % HYW); const long sg = idx / HYW; const float* h = p.hraw + sg * FSEG * HYW + c;
        float s = 0.f;
        for (int q = 0; q < FSEG; ++q) s += fabsf(h[(long)q * HYW]);
        p.hpart[idx] = s;
    }
}
DEV void ph_filt4(const P& p, long gt, long gs) {
    GSL(idx, 2 * 2 * HYW) {
        const int c = (int)(idx % HYW), kind = (int)((idx / HYW) % 2), i = (int)(idx / (2 * HYW));
        const int s0 = (int)(filt_row0(i, kind) / FSEG), ns = (kind ? CTXL : SEQ) / FSEG;
        float s = 0.f;
        for (int q = 0; q < ns; ++q) s += p.hpart[(long)(s0 + q) * HYW + c];
        p.hsum[idx] = s;
    }
}
DEV void ph_rstd(const P& p, int nrows, long gt, long gs) {
    GSL(r, nrows) {
        const float* xr = p.xa + r * D; float s = 0.f;
        for (int k = 0; k < D; ++k) s += xr[k] * xr[k];
        p.rstd[r] = rsqrtf(s * (1.0f / D) + EPS);
    }
}
DEV void ph_hx(const P& p, int layer, int which, int nrows, long gt, long gs) {
    const float* g = (which ? p.norm2_g : p.norm1_g) + layer * D;
    GSL(i, (long)nrows * D) {
        const int k = (int)(i % D), r = (int)(i / D); const RowInfo ri = row_info(r);
        const float* mv = p.modv + ((long)layer * 3 + ri.m) * 6 * D + which * 3 * D;
        const float v = p.xa[i] * p.rstd[r] * g[k] * (1.0f + mv[D + k]) + mv[k];
        p.hx[i] = v; p.hxb[i] = f2bf(v);
    }
}
DEV void ph_inproj(const P& p, const float* w, int nin, long gt, long gs) {
    GSL(i, (long)NTOK * nin) {
        const int n = (int)(i % nin), r = (int)(i / nin); const float* a = p.hx + (long)r * D; const float* b = w + n;
        float acc = 0.f;
        for (int k = 0; k < D; ++k) acc += a[k] * b[(long)k * nin];
        pxstore(&p.px[(long)r * PXLD + n], acc);
    }
}
DEV void ph_sconv(const P& p, int il, long gt, long gs) {
    const float* sw = p.hy_short_w + il * 3 * 1536; const float* sb = p.hy_short_b + il * 1536;
    GSL(i, (long)NTOK * HYW) {
        const int c = (int)(i % HYW), r = (int)(i / HYW); const RowInfo ri = row_info(r);
        float u[3];
#pragma unroll
        for (int s = 0; s < 3; ++s) {
            const int col = s * HYW + c; float acc = sb[col];
#pragma unroll
            for (int j = 0; j < 3; ++j) { const int tt = ri.t + j - 1; if (tt >= 0 && tt < ri.len) acc += sw[j * 1536 + col] * pxf(p.px[(long)(ri.base + tt) * PXLD + col]); }
            u[s] = acc;
        }
        p.x0c[i] = u[0]; p.zb[i] = u[2] * u[1]; if (r < NLAT) p.zT[(long)c * NLAT + r] = u[2] * u[1];
    }
}
DEV void ph_lconv(const P& p, int il, int r0, int r1, long gt, long gs) {
    GSL(i0, (long)(r1 - r0) * HYW) {
        const long i = i0 + (long)r0 * HYW;
        const int c = (int)(i % HYW), r = (int)(i / HYW); const RowInfo ri = row_info(r);
        const int L = ri.len, t = ri.t;
        const float* h = p.hraw + filt_row0(il, ri.kind) * HYW + c; const float* z = p.zb + (long)ri.base * HYW + c;
        int s0 = t + L / 2 - (L - 1); if (s0 < 0) s0 = 0; int s1 = t + L / 2; if (s1 > L - 1) s1 = L - 1;
        float acc = 0.f;
#pragma unroll 8
        for (int s = s0; s <= s1; ++s) acc += h[(long)(t - s + L / 2) * HYW] * z[(long)s * HYW];
        const float y = acc / p.hsum[(il * 2 + ri.kind) * HYW + c] + p.hy_bias[il * HYW + c] * p.zb[i];
        MIXST((long)r * D + c, p.x0c[i] * y);
    }
}
constexpr int FFTN = 2 * SEQ, FFT_NS = (SEQ == 8192 ? 7 : SEQ == 2048 ? 6 : SEQ == 512 ? 5 : SEQ == 128 ? 4 : -1);
static_assert(FFT_NS > 0 && (1 << (2 * FFT_NS)) == FFTN, "2*SEQ must be a power of 4");
struct CX { float x, y; };
#define PADX(n) ((n) + ((n) >> 5))
constexpr int FFT_ELEMS = FFTN + (FFTN >> 5);
#ifdef CPU_SHIM
#define COS2PI(f) cosf(6.283185307179586f * (f))
#define SIN2PI(f) sinf(6.283185307179586f * (f))
#define FFT_SYNC()
#else
#define COS2PI(f) __builtin_amdgcn_cosf(f)
#define SIN2PI(f) __builtin_amdgcn_sinf(f)
#define FFT_SYNC() __syncthreads()
#endif
template <class XP> DEV CX cx_ld(XP x, int i) { CX r; r.x = x[i].x; r.y = x[i].y; return r; }
template <class XP> DEV void cx_st(XP x, int i, CX v) { x[i].x = v.x; x[i].y = v.y; }
DEV CX cx_add(CX a, CX b) { return CX{a.x + b.x, a.y + b.y}; }
DEV CX cx_sub(CX a, CX b) { return CX{a.x - b.x, a.y - b.y}; }
DEV CX cx_mul(CX a, CX b) { return CX{a.x * b.x - a.y * b.y, a.x * b.y + a.y * b.x}; }
template <class XP> DEV void fft_pass(XP x, int s, bool inv, int tid, int nthr) {
    const int lq = 2 * (FFT_NS - 1 - s), Q = 1 << lq;
    const float invB = 1.0f / (float)(4 * Q);
    for (int t = tid; t < FFTN / 4; t += nthr) {
        const int i = t & (Q - 1), base = ((t >> lq) << (lq + 2)) + i;
        const float f = (float)i * invB, cs = COS2PI(f), sn = SIN2PI(f);
        const CX w1 = CX{cs, inv ? sn : -sn}, w2 = cx_mul(w1, w1), w3 = cx_mul(w2, w1);
        const int i0 = PADX(base), i1 = PADX(base + Q), i2 = PADX(base + 2 * Q), i3 = PADX(base + 3 * Q);
        const CX a = cx_ld(x, i0), b = cx_ld(x, i1), c = cx_ld(x, i2), d = cx_ld(x, i3);
        if (!inv) {
            const CX t0 = cx_add(a, c), t1 = cx_sub(a, c), t2 = cx_add(b, d), bd = cx_sub(b, d), t3 = CX{bd.y, -bd.x};
            cx_st(x, i0, cx_add(t0, t2)); cx_st(x, i1, cx_mul(cx_add(t1, t3), w1)); cx_st(x, i2, cx_mul(cx_sub(t0, t2), w2)); cx_st(x, i3, cx_mul(cx_sub(t1, t3), w3));
        } else {
            const CX y0 = a, y1 = cx_mul(b, w1), y2 = cx_mul(c, w2), y3 = cx_mul(d, w3);
            const CX u0 = cx_add(y0, y2), u1 = cx_sub(y0, y2), u2 = cx_add(y1, y3), yd = cx_sub(y1, y3), u3 = CX{-yd.y, yd.x};
            cx_st(x, i0, cx_add(u0, u2)); cx_st(x, i1, cx_add(u1, u3)); cx_st(x, i2, cx_sub(u0, u2)); cx_st(x, i3, cx_sub(u1, u3));
        }
    }
}
DEV void bfly4(CX& a, CX& b, CX& c, CX& d, CX w1, bool inv, bool tw) {
    const CX w2 = cx_mul(w1, w1), w3 = cx_mul(w2, w1);
    if (!inv) {
        const CX t0 = cx_add(a, c), t1 = cx_sub(a, c), t2 = cx_add(b, d), bd = cx_sub(b, d), t3 = CX{bd.y, -bd.x};
        a = cx_add(t0, t2); b = cx_add(t1, t3); c = cx_sub(t0, t2); d = cx_sub(t1, t3);
        if (tw) { b = cx_mul(b, w1); c = cx_mul(c, w2); d = cx_mul(d, w3); }
    } else {
        CX y1 = b, y2 = c, y3 = d;
        if (tw) { y1 = cx_mul(b, w1); y2 = cx_mul(c, w2); y3 = cx_mul(d, w3); }
        const CX u0 = cx_add(a, y2), u1 = cx_sub(a, y2), u2 = cx_add(y1, y3), yd = cx_sub(y1, y3), u3 = CX{-yd.y, yd.x};
        a = cx_add(u0, u2); b = cx_add(u1, u3); c = cx_sub(u0, u2); d = cx_sub(u1, u3);
    }
}
template <class XP> DEV void fft_pass16(XP x, int s, bool inv, int tid, int nthr) {
    const int lq2 = 2 * (FFT_NS - 2 - s), Q2 = 1 << lq2, Q = 4 * Q2;
    const float invB = 1.0f / (float)(16 * Q2);
    const float sg = inv ? 1.0f : -1.0f;
    const CX c1 = CX{0.9238795325112867f, sg * 0.3826834323650898f}, c2 = CX{0.7071067811865476f, sg * 0.7071067811865476f}, c3 = CX{0.3826834323650898f, sg * 0.9238795325112867f};
    for (int t = tid; t < FFTN / 16; t += nthr) {
        const int i = t & (Q2 - 1), base = ((t >> lq2) << (lq2 + 4)) + i;
        const float f = (float)i * invB, cs = COS2PI(f), sn = SIN2PI(f);
        const CX wA = CX{cs, sg * sn};
        CX wB = cx_mul(wA, wA); wB = cx_mul(wB, wB);
        CX v[4][4];
#pragma unroll
        for (int a = 0; a < 4; ++a)
#pragma unroll
            for (int b = 0; b < 4; ++b) v[a][b] = cx_ld(x, PADX(base + a * Q + b * Q2));
        if (!inv) {
            bfly4(v[0][0], v[1][0], v[2][0], v[3][0], wA, false, true);
            bfly4(v[0][1], v[1][1], v[2][1], v[3][1], cx_mul(wA, c1), false, true);
            bfly4(v[0][2], v[1][2], v[2][2], v[3][2], cx_mul(wA, c2), false, true);
            bfly4(v[0][3], v[1][3], v[2][3], v[3][3], cx_mul(wA, c3), false, true);
#pragma unroll
            for (int r = 0; r < 4; ++r) bfly4(v[r][0], v[r][1], v[r][2], v[r][3], wB, false, true);
        } else {
#pragma unroll
            for (int r = 0; r < 4; ++r) bfly4(v[r][0], v[r][1], v[r][2], v[r][3], wB, true, true);
            bfly4(v[0][0], v[1][0], v[2][0], v[3][0], wA, true, true);
            bfly4(v[0][1], v[1][1], v[2][1], v[3][1], cx_mul(wA, c1), true, true);
            bfly4(v[0][2], v[1][2], v[2][2], v[3][2], cx_mul(wA, c2), true, true);
            bfly4(v[0][3], v[1][3], v[2][3], v[3][3], cx_mul(wA, c3), true, true);
        }
#pragma unroll
        for (int a = 0; a < 4; ++a)
#pragma unroll
            for (int b = 0; b < 4; ++b) cx_st(x, PADX(base + a * Q + b * Q2), v[a][b]);
    }
}
template <class XP> DEV void fft_pass_last(XP x, bool inv, int tid, int nthr) {
    for (int t = tid; t < FFTN / 4; t += nthr) {
        const int base = 4 * t; CX a = cx_ld(x, PADX(base)), b = cx_ld(x, PADX(base + 1)), c = cx_ld(x, PADX(base + 2)), d = cx_ld(x, PADX(base + 3));
        bfly4(a, b, c, d, CX{1.f, 0.f}, inv, false);
        cx_st(x, PADX(base), a); cx_st(x, PADX(base + 1), b); cx_st(x, PADX(base + 2), c); cx_st(x, PADX(base + 3), d);
    }
}
static_assert(FFT_NS % 2 == 1, "pass schedule: (FFT_NS - 1) / 2 radix-16 passes + one radix-4 pass");
template <class XP> DEV void fft_forward(XP x, int tid, int nthr) {
    for (int s = 0; s + 1 < FFT_NS; s += 2) { fft_pass16(x, s, false, tid, nthr); FFT_SYNC(); }
    fft_pass_last(x, false, tid, nthr); FFT_SYNC();
}
template <class XP> DEV void fft_inverse(XP x, int tid, int nthr) {
    fft_pass_last(x, true, tid, nthr); FFT_SYNC();
    for (int s = FFT_NS - 3; s >= 0; s -= 2) { fft_pass16(x, s, true, tid, nthr); FFT_SYNC(); }
}
template <class XP> DEV void lconv_unit(const P& p, int il, int c, XP x, float* zf, int tid, int nthr) {
    constexpr int L = SEQ, N = FFTN;
    const float* zc = p.zT + (long)c * NLAT;
#pragma unroll 8
    for (int n = tid; n < L; n += nthr) { CX v; v.x = zc[n]; v.y = zc[SEQ + n]; cx_st(x, PADX(n), v); }
#pragma unroll 8
    for (int n = L + tid; n < N; n += nthr) cx_st(x, PADX(n), CX{0.f, 0.f});
    FFT_SYNC();
    fft_forward(x, tid, nthr);
    const float* h = p.hT + ((long)il * HYW + c) * SEQ;
#pragma unroll 8
    for (int n = tid; n < L; n += nthr) { const float hv = h[n]; const CX v = cx_ld(x, PADX(n)); zf[2 * n] = v.x; zf[2 * n + 1] = v.y; cx_st(x, PADX(n), CX{hv, 0.f}); }
#pragma unroll 8
    for (int n = L + tid; n < N; n += nthr) { const CX v = cx_ld(x, PADX(n)); zf[2 * n] = v.x; zf[2 * n + 1] = v.y; cx_st(x, PADX(n), CX{0.f, 0.f}); }
    FFT_SYNC();
    fft_forward(x, tid, nthr);
#ifndef CPU_SHIM
    asm volatile("s_waitcnt vmcnt(0)" ::: "memory");
#endif
#pragma unroll 8
    for (int n = tid; n < N; n += nthr) { const CX zv{zf[2 * n], zf[2 * n + 1]}; const CX hv = cx_ld(x, PADX(n)); cx_st(x, PADX(n), cx_mul(hv, zv)); }
    FFT_SYNC();
    fft_inverse(x, tid, nthr);
    const float scale = 1.0f / ((float)N * p.hsum[(il * 2 + 0) * HYW + c]);
    float* o = p.convT + (long)c * NLAT;
#pragma unroll 8
    for (int t = tid; t < L; t += nthr) { const CX v = cx_ld(x, PADX(t + L / 2)); o[t] = v.x * scale; o[L + t] = v.y * scale; }
    FFT_SYNC();
}
#ifdef CPU_SHIM
DEV void ph_lconv_fft(const P& p, int il, long gt, long gs) {
    CX* x = (CX*)malloc(sizeof(CX) * FFT_ELEMS);
    GSL(c, HYW) { lconv_unit(p, il, (int)c, x, p.zf + gt * 2 * FFTN, 0, 1); }
    free(x);
}
#endif
DEV void ph_hymix(const P& p, int il, long gt, long gs) {
    GSL(i, (long)NLAT * HYW) {
        const int c = (int)(i % HYW), r = (int)(i / HYW);
        const float y = p.convT[(long)c * NLAT + r] + p.hy_bias[il * HYW + c] * p.zb[i];
        MIXST((long)r * D + c, p.x0c[i] * y);
    }
}
DEV int scan_row(int dir, int b, int n) {
    if (n < CTXL) return NLAT + b * CTXL + (dir ? CTXL - 1 - n : n);
    const int m = n - CTXL; return b * SEQ + (dir ? SEQ - 1 - m : m);
}
constexpr int S5C = 64, S5NCH = (CTXL + SEQ) / S5C;
struct S5Par { float lbr, lbi; float bbr[GH], bbi[GH]; };
DEV void s5_par(const P& p, int il, int dir, int g, int pp, S5Par& q) {
    const int gi = (il * 2 + dir) * NG + g;
    const float lre = fminf(p.s5_lre[gi * NP + pp], -1e-4f), lim = p.s5_lim[gi * NP + pp], dt = expf(p.s5_ldt[gi]);
    const float mag = expf(lre * dt); q.lbr = mag * cosf(lim * dt); q.lbi = mag * sinf(lim * dt);
    const float nr = q.lbr - 1.0f, ni = q.lbi, den = lre * lre + lim * lim;
    const float fr = (nr * lre + ni * lim) / den, fi = (ni * lre - nr * lim) / den;
#pragma unroll
    for (int h = 0; h < GH; ++h) { const float br = p.s5_bre[((long)gi * NP + pp) * GH + h], bi = p.s5_bim[((long)gi * NP + pp) * GH + h]; q.bbr[h] = fr * br - fi * bi; q.bbi[h] = fr * bi + fi * br; }
}
DEV void ph_s5chunk(const P& p, int il, int fill, long gt, long gs) {
    GSL(i, 2L * 2 * S5NCH * NG * NP) {
        const int pp = (int)(i % NP), g = (int)((i / NP) % NG), ch = (int)((i / (NP * NG)) % S5NCH), b = (int)((i / ((long)NP * NG * S5NCH)) % 2), dir = (int)(i / ((long)NP * NG * S5NCH * 2));
        S5Par q; s5_par(p, il, dir, g, pp, q);
        float* ce = p.s5c + ((((long)dir * 2 + b) * S5NCH + ch) * NG + g) * NP * 2 + pp * 2;
        float sr = 0.f, si = 0.f;
        if (fill) { sr = ce[0]; si = ce[1]; }
        for (int k = 0; k < S5C; ++k) {
            const int row = scan_row(dir, b, ch * S5C + k); const px_t* u = p.px + (long)row * PXLD + 1536 + g * GH;
            float ar = 0.f, ai = 0.f;
#pragma unroll
            for (int h = 0; h < GH; ++h) { ar += q.bbr[h] * pxf(u[h]); ai += q.bbi[h] * pxf(u[h]); }
            const float tr = q.lbr * sr - q.lbi * si + ar, ti = q.lbr * si + q.lbi * sr + ai; sr = tr; si = ti;
            if (fill) { float* o = p.s5s + (((long)dir * NTOK + row) * NG + g) * NP * 2 + pp * 2; o[0] = sr; o[1] = si; }
        }
        if (!fill) { ce[0] = sr; ce[1] = si; }
    }
}
DEV void ph_s5carry(const P& p, int il, long gt, long gs) {
    GSL(i, 2 * 2 * NG * NP) {
        const int pp = (int)(i % NP), g = (int)((i / NP) % NG), b = (int)((i / (NP * NG)) % 2), dir = (int)(i / (NP * NG * 2));
        S5Par q; s5_par(p, il, dir, g, pp, q);
        float pr = q.lbr, pi = q.lbi;
#pragma unroll
        for (int t = 0; t < 6; ++t) { const float nr = pr * pr - pi * pi, ni = 2.0f * pr * pi; pr = nr; pi = ni; }
        float cr = 0.f, ci = 0.f;
        float* ce0 = p.s5c + ((((long)dir * 2 + b) * S5NCH) * NG + g) * NP * 2 + pp * 2;
        constexpr int CB = 12;
        for (int c0 = 0; c0 < S5NCH; c0 += CB) {
            float er[CB], ei[CB];
#pragma unroll
            for (int j = 0; j < CB; ++j) if (c0 + j < S5NCH) { const float* ce = ce0 + (long)(c0 + j) * NG * NP * 2; er[j] = ce[0]; ei[j] = ce[1]; }
#pragma unroll
            for (int j = 0; j < CB; ++j) if (c0 + j < S5NCH) { float* ce = ce0 + (long)(c0 + j) * NG * NP * 2; ce[0] = cr; ce[1] = ci;
                const float tr = pr * cr - pi * ci + er[j], ti = pr * ci + pi * cr + ei[j]; cr = tr; ci = ti; }
        }
    }
}
DEV void ph_s5out(const P& p, int il, long gt, long gs) {
    GSL(i, (long)NTOK * S5W) {
        const int ch = (int)(i % S5W), r = (int)(i / S5W), g = ch / GH, h = ch % GH;
        float y = p.s5_d[il * S5W + ch] * pxf(p.px[(long)r * PXLD + 1536 + ch]);
        for (int dir = 0; dir < 2; ++dir) {
            const long ci = (((long)(il * 2 + dir) * NG + g) * GH + h) * NP;
            const float* s = p.s5s + (((long)dir * NTOK + r) * NG + g) * NP * 2;
            for (int pp = 0; pp < NP; ++pp) y += p.s5_cre[ci + pp] * s[pp * 2] - p.s5_cim[ci + pp] * s[pp * 2 + 1];
        }
        { const float gy = gelu_tanhf_(y); p.ys5[i] = gy; p.ys5b[i] = f2bf(gy); }
    }
}
DEV void ph_s5fin(const P& p, int il, long gt, long gs) {
    GSL(i, (long)NTOK * S5W) {
        const int ch = (int)(i % S5W), r = (int)(i / S5W);
        const float y = p.s5_d[il * S5W + ch] * pxf(p.px[(long)r * PXLD + 1536 + ch]) + p.yd[i] + p.yd[(long)NTOK * S5W + i];
        const float gy = gelu_tanhf_(y); p.ys5b[i] = f2bf(gy);
#ifdef CPU_SHIM
        p.ys5[i] = gy;
#endif
    }
}
DEV void ph_glu(const P& p, int il, long gt, long gs) {
    const float* w = p.s5_glu_w + (long)il * S5W * S5W;
    GSL(i, (long)NTOK * S5W) {
        const int ch = (int)(i % S5W), r = (int)(i / S5W); const float* a = p.ys5 + (long)r * S5W;
        float acc = p.s5_glu_b[il * S5W + ch];
        for (int k = 0; k < S5W; ++k) acc += a[k] * w[(long)k * S5W + ch];
        MIXST((long)r * D + HYW + ch, a[ch] * sigmoidf_(acc));
    }
}
DEV void ph_rope(const P& p, long gt, long gs) {
    GSL(i, (long)NTOK * 576) {
        const int it = (int)(i % 576), r = (int)(i / 576); const RowInfo ri = row_info(r); const px_t* pr = p.px + (long)r * PXLD;
        if (it < 256) {
            const int isk = it >= 128, hd = it & 127, h = hd >> 5, d = hd & 31;
            const px_t* src = pr + (isk ? 256 : 0) + h * 64; float x1 = pxf(src[d]), x2 = pxf(src[d + 32]);
            if (ri.kind == 0) { const float inv = exp2f(-(float)d * (13.287712379549449f / 32.0f)), ang = (float)ri.t * inv, cs = ROPE_COS(ang), sn = ROPE_SIN(ang);
                const float y1 = x1 * cs - x2 * sn, y2 = x1 * sn + x2 * cs; x1 = y1; x2 = y2; }
            const float sc = isk ? 1.0f : 0.125f;
            float* dst = (isk ? p.kr : p.qr) + (long)r * 256 + h * 64; dst[d] = x1 * sc; dst[d + 32] = x2 * sc;
        } else {
            const int j = it - 256, isk = j >= 256, hd = isk ? j - 256 : j, h = hd >> 5, e = hd & 31, half = e >> 4, d = e & 15;
            const px_t* src = pr + (isk ? 2048 : 1536) + h * 64 + half * 32; float x1 = pxf(src[d]), x2 = pxf(src[d + 16]);
            if (ri.kind == 0) { const float pos = (float)(half ? (ri.t % 64) : (ri.t / 64)); const float inv = exp2f(-(float)d * (13.287712379549449f / 16.0f)), ang = pos * inv, cs = ROPE_COS(ang), sn = ROPE_SIN(ang);
                const float y1 = x1 * cs - x2 * sn, y2 = x1 * sn + x2 * cs; x1 = y1; x2 = y2; }
            const float sc = isk ? 1.0f : 0.125f;
            float* dst = (isk ? p.ks + (long)r * 128 : p.qs + (long)r * 512) + h * 64 + half * 32; dst[d] = x1 * sc; dst[d + 16] = x2 * sc;
        }
    }
}
constexpr int RC = 128, RNCH = (CTXL + SEQ) / RC;
DEV float ret_logg(const P& p, int il, int dir, int h) { const float dl = p.ret_decay[(il * 2 + dir) * 4 + h]; return -log1pf(expf(-dl)); }
DEV void ph_retkv(const P& p, int il, long gt, long gs) {
    GSL(i, 2L * 2 * RNCH * 4 * 64 * 128) {
        const int e = (int)(i % 128), d = (int)((i / 128) % 64), h = (int)((i / 8192) % 4), n = (int)((i / 32768) % RNCH), b = (int)((i / (32768L * RNCH)) % 2), dir = (int)(i / (32768L * RNCH * 2));
        const float lg = ret_logg(p, il, dir, h);
        float acc = 0.f;
        for (int j = 0; j < RC; ++j) { const int row = scan_row(dir, b, n * RC + j);
            acc += expf((float)(RC - 1 - j) * lg) * p.kr[(long)row * 256 + h * 64 + d] * pxf(p.px[(long)row * PXLD + 512 + h * 128 + e]); }
        p.rkv[i] = acc;
    }
}
DEV void ph_retcarry(const P& p, int il, long gt, long gs) {
    GSL(i, 2L * 2 * 4 * 64 * 128) {
        const int de = (int)(i % 8192), h = (int)((i / 8192) % 4), b = (int)((i / 32768) % 2), dir = (int)(i / 65536);
        const float gc = expf((float)RC * ret_logg(p, il, dir, h));
        float S = 0.f;
        float* q0 = p.rkv + ((((long)dir * 2 + b) * RNCH) * 4 + h) * 8192 + de;
        constexpr int CB = 11;
        for (int n0 = 0; n0 < RNCH; n0 += CB) {
            float kv[CB];
#pragma unroll
            for (int j = 0; j < CB; ++j) if (n0 + j < RNCH) kv[j] = q0[(long)(n0 + j) * 4 * 8192];
#pragma unroll
            for (int j = 0; j < CB; ++j) if (n0 + j < RNCH) { q0[(long)(n0 + j) * 4 * 8192] = S; S = gc * S + kv[j]; }
        }
    }
}
DEV void ph_retsc(const P& p, int il, long gt, long gs) {
    GSL(i, 2L * NTOK * 4 * RC) {
        const int j = (int)(i % RC), h = (int)((i / RC) % 4), r = (int)((i / (RC * 4)) % NTOK), dir = (int)(i / ((long)RC * 4 * NTOK)); const RowInfo ri = row_info(r);
        const int b = ri.kind ? (ri.base - NLAT) / CTXL : ri.base / SEQ;
        const int step = ri.kind ? (dir ? CTXL - 1 - ri.t : ri.t) : CTXL + (dir ? SEQ - 1 - ri.t : ri.t), ii = step % RC, n = step / RC;
        float sc = 0.f;
        if (j <= ii) { const int rj = scan_row(dir, b, n * RC + j); const float* q = p.qr + (long)r * 256 + h * 64; const float* k = p.kr + (long)rj * 256 + h * 64;
            float dot = 0.f;
            for (int d = 0; d < 64; ++d) dot += q[d] * k[d];
            sc = dot * expf((float)(ii - j) * ret_logg(p, il, dir, h)); }
        p.rsc[i] = sc;
    }
}
DEV void ph_reto(const P& p, int il, long gt, long gs) {
    GSL(i, 2L * NTOK * 512) {
        const int e = (int)(i % 128), h = (int)((i / 128) % 4), r = (int)((i / 512) % NTOK), dir = (int)(i / (512L * NTOK)); const RowInfo ri = row_info(r);
        const int b = ri.kind ? (ri.base - NLAT) / CTXL : ri.base / SEQ;
        const int step = ri.kind ? (dir ? CTXL - 1 - ri.t : ri.t) : CTXL + (dir ? SEQ - 1 - ri.t : ri.t), ii = step % RC, n = step / RC;
        const float* sc = p.rsc + (((long)dir * NTOK + r) * 4 + h) * RC;
        float acc = 0.f;
        for (int j = 0; j <= ii; ++j) { const int rj = scan_row(dir, b, n * RC + j); acc += sc[j] * pxf(p.px[(long)rj * PXLD + 512 + h * 128 + e]); }
        const float* S = p.rkv + ((((long)dir * 2 + b) * RNCH + n) * 4 + h) * 8192 + e; const float* q = p.qr + (long)r * 256 + h * 64;
        float cr = 0.f;
        for (int d = 0; d < 64; ++d) cr += q[d] * S[d * 128];
        p.oret[((long)dir * NTOK + r) * 512 + h * 128 + e] = acc + cr * expf((float)(ii + 1) * ret_logg(p, il, dir, h));
    }
}
DEV void ph_retout(const P& p, int nrows, long gt, long gs) {
    GSL(i, (long)nrows * 4) {
        const int h = (int)(i % 4), r = (int)(i / 4);
        const float* o0 = p.oret + (long)r * 512 + h * 128; const float* o1 = p.oret + ((long)NTOK + r) * 512 + h * 128;
        float ss = 0.f;
        for (int e = 0; e < 128; ++e) { const float o = o0[e] + o1[e]; ss += o * o; }
        const float rs = rsqrtf(ss * (1.0f / 128.0f) + EPS);
        for (int e = 0; e < 128; ++e) MIXST((long)r * D + h * 128 + e, (o0[e] + o1[e]) * rs * siluf_(pxf(p.px[(long)r * PXLD + 1024 + h * 128 + e])));
    }
}
DEV void ph_swa(const P& p, int il, int nrows, long gt, long gs) {
    GSL(i, (long)nrows * 8) {
        const int hq = (int)(i % 8), r = (int)(i / 8), kv = hq >> 2; const RowInfo ri = row_info(r);
        const int b = ri.kind ? (ri.base - NLAT) / CTXL : ri.base / SEQ;
        float q[64], acc[64];
#pragma unroll
        for (int d = 0; d < 64; ++d) { q[d] = p.qs[(long)r * 512 + hq * 64 + d]; acc[d] = 0.f; }
        float m = p.swa_sink[il * 8 + hq], l = 1.0f;
        for (int part = 0; part < 2; ++part) {
            int k0, k1;
            if (part == 0) { if (ri.kind) continue; k0 = ri.base + (ri.t - 128 < 0 ? 0 : ri.t - 128); k1 = ri.base + (ri.t + 128 > SEQ - 1 ? SEQ - 1 : ri.t + 128); }
            else { k0 = NLAT + b * CTXL; k1 = k0 + CTXL - 1; }
            for (int kr = k0; kr <= k1; ++kr) {
                const float* kk = p.ks + (long)kr * 128 + kv * 64; const px_t* vv = p.px + (long)kr * PXLD + 2176 + kv * 64;
                float s = 0.f;
#pragma unroll
                for (int d = 0; d < 64; ++d) s += q[d] * kk[d];
                const float mn = fmaxf(m, s), corr = expf(m - mn), pe = expf(s - mn);
                l = l * corr + pe; m = mn;
#pragma unroll
                for (int d = 0; d < 64; ++d) acc[d] = acc[d] * corr + pe * pxf(vv[d]);
            }
        }
        const float il_ = 1.0f / l;
#pragma unroll
        for (int d = 0; d < 64; ++d) MIXST((long)r * D + 512 + hq * 64 + d, acc[d] * il_);
    }
}
DEV void ph_outproj(const P& p, int layer, const float* w, int nrows, long gt, long gs) {
    GSL(i, (long)nrows * D) {
        const int n = (int)(i % D), r = (int)(i / D); const RowInfo ri = row_info(r);
        const float* a = p.mixin + (long)r * D; const float* b = w + n;
        float acc = 0.f;
        for (int k = 0; k < D; ++k) acc += a[k] * b[(long)k * D];
        p.xa[i] += p.modv[((long)layer * 3 + ri.m) * 6 * D + 2 * D + n] * acc;
    }
}
DEV int atomic_inc(int* q) {
#ifdef CPU_SHIM
    return __atomic_fetch_add(q, 1, __ATOMIC_RELAXED);
#else
    return atomicAdd(q, 1);
#endif
}
DEV void ph_router(const P& p, int layer, int nrows, long gt, long gs) {
    const float* rw = p.router_w + (long)layer * D * NE;
    GSL(j, NSLOT) { p.slot_tok[j] = -1; p.slot_gate[j] = 0.f; }
    GSL(r, nrows) {
        float lg[NE];
#pragma unroll
        for (int e = 0; e < NE; ++e) lg[e] = p.router_b[layer * NE + e];
        const float* a = p.hx + (long)r * D;
        for (int k = 0; k < D; ++k) { const float av = a[k];
#pragma unroll
            for (int e = 0; e < NE; ++e) lg[e] += av * rw[k * NE + e]; }
        int ti[4]; float tv[4];
#pragma unroll
        for (int s = 0; s < 4; ++s) { int best = 0; float bv = -3.0e38f;
#pragma unroll
            for (int e = 0; e < NE; ++e) { if (lg[e] > bv) { bv = lg[e]; best = e; } }
            ti[s] = best; tv[s] = bv;
#pragma unroll
            for (int e = 0; e < NE; ++e) if (e == best) lg[e] = -3.0e38f; }
        const float e1 = expf(tv[1] - tv[0]), e2 = expf(tv[2] - tv[0]), e3 = expf(tv[3] - tv[0]), inv = 1.0f / (1.0f + e1 + e2 + e3);
        p.topi[r * 4 + 0] = ti[0]; p.topi[r * 4 + 1] = ti[1]; p.topi[r * 4 + 2] = ti[2]; p.topi[r * 4 + 3] = ti[3];
        p.topg[r * 4 + 0] = inv; p.topg[r * 4 + 1] = e1 * inv; p.topg[r * 4 + 2] = e2 * inv; p.topg[r * 4 + 3] = e3 * inv;
#pragma unroll
        for (int s = 0; s < 4; ++s) p.pos[r * 4 + s] = atomic_inc(p.cnt + layer * NE + ti[s]);
    }
}
DEV int moe_tiles(const int* cnt) { int t = 0; for (int e = 0; e < NE; ++e) t += (cnt[e] + 255) >> 8; return t; }
DEV int tile_expert(const int* cnt, int pm) { int t = 0; for (int e = 0; e < NE; ++e) { t += (cnt[e] + 255) >> 8; if (pm < t) return e; } return NE - 1; }
DEV void ph_assign(const P& p, int layer, int nrows, long gt, long gs) {
    const int* cnt = p.cnt + layer * NE;
    GSL(i, (long)nrows * 4) {
        const int e = p.topi[i]; int off = 0;
        for (int q = 0; q < e; ++q) off += ((cnt[q] + 255) >> 8) << 8;
        const int slot = off + p.pos[i];
        p.slot_of[i] = slot; p.slot_tok[slot] = (int)(i >> 2); p.slot_gate[slot] = p.topg[i];
    }
}
DEV void ph_gather(const P& p, int layer, long gt, long gs) {
    const long used = (long)moe_tiles(p.cnt + layer * NE) * 256;
    GSL(i, used * D) { const int k = (int)(i % D); const long slot = i / D; const int tok = p.slot_tok[slot]; p.xb[i] = tok >= 0 ? p.hxb[(long)tok * D + k] : (bf16_t)0; }
}
DEV void ph_moe1s(const P& p, int layer, long gt, long gs) {
    const int* cnt = p.cnt + layer * NE; const long used = (long)moe_tiles(cnt) * 256;
    GSL(i, used * DFF) {
        const int j = (int)(i % DFF); const long slot = i / DFF; const int e = tile_expert(cnt, (int)(slot >> 8));
        const float* w = p.w_gu + ((long)layer * NE + e) * D * 2 * DFF + j; const bf16_t* a = p.xb + slot * D;
        const float* bb = p.b_gu + ((long)layer * NE + e) * 2 * DFF;
        float ga = bb[j], up = bb[DFF + j];
        for (int k = 0; k < D; ++k) { const float av = bf2f(a[k]); ga += av * w[(long)k * 2 * DFF]; up += av * w[(long)k * 2 * DFF + DFF]; }
        ga = fminf(ga, 7.0f); up = fminf(fmaxf(up, -7.0f), 7.0f);
        p.actb[i] = f2bf(ga * sigmoidf_(1.702f * ga) * (up + 1.0f));
    }
}
DEV void ph_moe2s(const P& p, int layer, long gt, long gs) {
    const int* cnt = p.cnt + layer * NE; const long used = (long)moe_tiles(cnt) * 256;
    GSL(i, used * D) {
        const int n = (int)(i % D); const long slot = i / D; const int e = tile_expert(cnt, (int)(slot >> 8));
        const float* w = p.w_dn + ((long)layer * NE + e) * DFF * D + n; const bf16_t* a = p.actb + slot * DFF;
        float acc = p.b_dn[((long)layer * NE + e) * D + n];
        for (int k = 0; k < DFF; ++k) acc += bf2f(a[k]) * w[(long)k * D];
        p.yb[i] = f2bf(acc * p.slot_gate[slot]);
    }
}
DEV void ph_combine(const P& p, int layer, int nrows, long gt, long gs) {
    GSL(i, (long)nrows * D) {
        const int n = (int)(i % D), r = (int)(i / D); const RowInfo ri = row_info(r);
        float y = 0.f;
#pragma unroll
        for (int s = 0; s < 4; ++s) y += bf2f(p.yb[(long)p.slot_of[r * 4 + s] * D + n]);
        p.xa[i] += p.modv[((long)layer * 3 + ri.m) * 6 * D + 5 * D + n] * y;
    }
}
DEV void ph_final(const P& p, long gt, long gs) {
    GSL(i, (long)NLAT * D) { const int k = (int)(i % D), r = (int)(i / D); p.out[i] = p.xa[i] * p.rstd[r] * p.final_g[k]; }
}

constexpr int N_SETUP = 6, N_SLOT = 18;
#ifdef CPU_SHIM
#define SWA_NAIVE ph_swa(p, il, nrows, gt, gs);
#define S5_NAIVE(x) x
#define S5_FIN ph_s5out(p, il, gt, gs);
#define RET_NAIVE_A ph_retkv(p, il, gt, gs); ph_retsc(p, il, gt, gs);
#define RET_NAIVE_C ph_reto(p, il, gt, gs);
#else
#define SWA_NAIVE
#define S5_NAIVE(x)
#define S5_FIN ph_s5fin(p, il, gt, gs);
#define RET_NAIVE_A
#define RET_NAIVE_C
#endif
#ifdef CPU_SHIM
#define LCONV_LAT(p, il, gt, gs) ph_lconv_fft(p, il, gt, gs)
#else
#define LCONV_LAT(p, il, gt, gs)
#endif
template <int S> DEV void setup_slot(const P& p, long gt, long gs) {
    if constexpr (S == 0) { ph_init(p, gt, gs); ph_mod(p, gt, gs); }
    if constexpr (S == 1) { ph_mod2(p, gt, gs); ph_filt1(p, gt, gs); }
    if constexpr (S == 2) ph_filt2(p, gt, gs);
    if constexpr (S == 3) ph_filt3(p, gt, gs);
    if constexpr (S == 4) ph_filt4a(p, gt, gs);
    if constexpr (S == 5) ph_filt4(p, gt, gs);
}
template <int S> DEV void layer_slot(const P& p, int layer, long gt, long gs) {
    const int il = layer >> 1; const bool ab = !(layer & 1);
    const int nrows = layer < 3 ? NTOK : NLAT;
    if constexpr (S == 0) ph_rstd(p, NTOK, gt, gs);
    if constexpr (S == 1) ph_hx(p, layer, 0, NTOK, gt, gs);
    if constexpr (S == 2) { if (ab) ph_inproj(p, p.ab_w_in + (long)il * D * AB_IN, AB_IN, gt, gs); else ph_inproj(p, p.cd_w_in + (long)il * D * CD_IN, CD_IN, gt, gs); }
    if constexpr (S == 3) { if (ab) { ph_sconv(p, il, gt, gs); S5_NAIVE(ph_s5chunk(p, il, 0, gt, gs);) } else ph_rope(p, gt, gs); }
    if constexpr (S == 4) { if (ab) { LCONV_LAT(p, il, gt, gs); ph_lconv(p, il, NLAT, NTOK, gt, gs); ph_s5carry(p, il, gt, gs); } else { RET_NAIVE_A } }
    if constexpr (S == 5) { if (ab) { ph_hymix(p, il, gt, gs); S5_NAIVE(ph_s5chunk(p, il, 1, gt, gs);) } else { ph_retcarry(p, il, gt, gs); SWA_NAIVE } }
    if constexpr (S == 6) { if (ab) { S5_FIN } else { RET_NAIVE_C } }
    if constexpr (S == 7) { if (ab) ph_glu(p, il, gt, gs); else ph_retout(p, nrows, gt, gs); }
    if constexpr (S == 8) ph_outproj(p, layer, (ab ? p.ab_w_out : p.cd_w_out) + (long)il * D * D, nrows, gt, gs);
    if constexpr (S == 9) ph_rstd(p, nrows, gt, gs);
    if constexpr (S == 10) ph_hx(p, layer, 1, nrows, gt, gs);
    if constexpr (S == 11) ph_router(p, layer, nrows, gt, gs);
    if constexpr (S == 12) ph_assign(p, layer, nrows, gt, gs);
    if constexpr (S == 13) ph_gather(p, layer, gt, gs);
    if constexpr (S == 14) ph_moe1s(p, layer, gt, gs);
    if constexpr (S == 15) ph_moe2s(p, layer, gt, gs);
    if constexpr (S == 16) ph_combine(p, layer, nrows, gt, gs);
}
template <int S> DEV void final_slot(const P& p, long gt, long gs) {
    if constexpr (S == 0) ph_rstd(p, NLAT, gt, gs);
    if constexpr (S == 1) ph_final(p, gt, gs);
}

struct WsMap { size_t off[56]; size_t total; };
static inline WsMap ws_map() {
    WsMap m; size_t o = 0; int n = 0;
    auto take = [&](size_t bytes) { m.off[n++] = o; o += (bytes + 255) & ~(size_t)255; };
    take(16384);
    take((size_t)NTOK * D * 4);
    take((size_t)4 * 3 * 6 * D * 4);
    take((size_t)2 * (SEQ + CTXL) * 64 * 4);
    take((size_t)2 * (SEQ + CTXL) * 64 * 4);
    take((size_t)2 * (SEQ + CTXL) * HYW * 4);
    take((size_t)2 * 2 * HYW * 4);
    take((size_t)NTOK * 4);
    take((size_t)NTOK * D * 4);
    take((size_t)NTOK * PXLD * 4);
    take((size_t)NTOK * HYW * 4);
    take((size_t)NTOK * HYW * 4);
    take((size_t)NTOK * D * 4);
    take((size_t)2 * NTOK * NG * NP * 2 * 4);
    take((size_t)NTOK * S5W * 4);
    take((size_t)NTOK * 256 * 4);
    take((size_t)NTOK * 256 * 4);
    take((size_t)2 * NTOK * 512 * 4);
    take((size_t)NTOK * 512 * 4);
    take((size_t)NTOK * 128 * 4);
    take((size_t)NTOK * 4 * 4);
    take((size_t)NTOK * 4 * 4);
    take(256);
    take((size_t)(NTOK + 1) * D * 2);
    take((size_t)NTOK * D * 2);
    take((size_t)NTOK * S5W * 2);
    take((size_t)NSLOT * D * 2);
    take((size_t)NSLOT * DFF * 2);
    take((size_t)NSLOT * D * 4);
    take((size_t)NSLOT * 4);
    take((size_t)4 * NE * 4);
    take((size_t)NTOK * 4 * 4);
    take((size_t)NTOK * 4 * 4);
    take((size_t)NSLOT * 4);
    take((size_t)2 * AB_IN * D * 2);
    take((size_t)2 * CD_IN * D * 2);
    take((size_t)2 * D * D * 2);
    take((size_t)2 * D * D * 2);
    take((size_t)2 * S5W * S5W * 2);
    take((size_t)4 * NE * 2 * DFF * D * 2);
    take((size_t)4 * NE * D * DFF * 2);
    take((size_t)2 * 2 * S5NCH * NG * NP * 2 * 4);
    take((size_t)2 * 2 * RNCH * 4 * 8192 * 4);
    take((size_t)2 * NTOK * 4 * RC * 4);
    take((size_t)2 * FNSEG * HYW * 4);
    take((size_t)256 * 2 * FFTN * 4);
    take((size_t)HYW * NLAT * 4);
    take((size_t)2 * NTOK * S5W * 4);
    take((size_t)HYW * NLAT * 4);
    take((size_t)2 * HYW * SEQ * 4);
    take((size_t)8 * 4 * 3 * 6 * D * 4);
    m.total = o; return m;
}
static inline void fill_params(P& p, void* const* d_in, void* d_out, void* d_ws) {
    const float* const* in = (const float* const*)d_in;
    p.x = in[0]; p.c = in[1]; p.ctx = in[2]; p.c_ctx = in[3]; p.mod_w = in[4]; p.mod_b = in[5]; p.norm1_g = in[6]; p.norm2_g = in[7];
    p.ab_w_in = in[8]; p.ab_w_out = in[9]; p.hy_short_w = in[10]; p.hy_short_b = in[11]; p.hy_f_w1 = in[12]; p.hy_f_b1 = in[13];
    p.hy_f_w2 = in[14]; p.hy_f_b2 = in[15]; p.hy_f_w3 = in[16]; p.hy_bias = in[17]; p.s5_lre = in[18]; p.s5_lim = in[19]; p.s5_ldt = in[20];
    p.s5_bre = in[21]; p.s5_bim = in[22]; p.s5_cre = in[23]; p.s5_cim = in[24]; p.s5_d = in[25]; p.s5_glu_w = in[26]; p.s5_glu_b = in[27];
    p.cd_w_in = in[28]; p.cd_w_out = in[29]; p.ret_decay = in[30]; p.swa_sink = in[31]; p.router_w = in[32]; p.router_b = in[33];
    p.w_gu = in[34]; p.b_gu = in[35]; p.w_dn = in[36]; p.b_dn = in[37]; p.final_g = in[38];
    p.out = (float*)d_out;
    const WsMap m = ws_map(); char* w = (char*)d_ws;
    p.bar = (unsigned*)(w + m.off[0]); p.xa = (float*)(w + m.off[1]); p.modv = (float*)(w + m.off[2]); p.f1 = (float*)(w + m.off[3]); p.f2 = (float*)(w + m.off[4]);
    p.hraw = (float*)(w + m.off[5]); p.hsum = (float*)(w + m.off[6]); p.rstd = (float*)(w + m.off[7]); p.hx = (float*)(w + m.off[8]); p.px = (px_t*)(w + m.off[9]);
    p.zb = (float*)(w + m.off[10]); p.x0c = (float*)(w + m.off[11]); p.mixin = (float*)(w + m.off[12]); p.s5s = (float*)(w + m.off[13]); p.ys5 = (float*)(w + m.off[14]);
    p.qr = (float*)(w + m.off[15]); p.kr = (float*)(w + m.off[16]); p.oret = (float*)(w + m.off[17]); p.qs = (float*)(w + m.off[18]); p.ks = (float*)(w + m.off[19]);
    p.topg = (float*)(w + m.off[20]); p.topi = (int*)(w + m.off[21]); p.act = nullptr;
    p.hxb = (bf16_t*)(w + m.off[23]); p.mixb = (bf16_t*)(w + m.off[24]); p.ys5b = (bf16_t*)(w + m.off[25]); p.xb = (bf16_t*)(w + m.off[26]); p.actb = (bf16_t*)(w + m.off[27]);
    p.yb = (bf16_t*)(w + m.off[28]); p.slot_gate = (float*)(w + m.off[29]); p.cnt = (int*)(w + m.off[30]); p.pos = (int*)(w + m.off[31]); p.slot_of = (int*)(w + m.off[32]);
    p.slot_tok = (int*)(w + m.off[33]); p.abin_t = (bf16_t*)(w + m.off[34]); p.cdin_t = (bf16_t*)(w + m.off[35]); p.about_t = (bf16_t*)(w + m.off[36]);
    p.cdout_t = (bf16_t*)(w + m.off[37]); p.glu_t = (bf16_t*)(w + m.off[38]); p.wgu_t = (bf16_t*)(w + m.off[39]); p.wdn_t = (bf16_t*)(w + m.off[40]);
    p.s5c = (float*)(w + m.off[41]); p.rkv = (float*)(w + m.off[42]); p.rsc = (float*)(w + m.off[43]); p.hpart = (float*)(w + m.off[44]);
    p.zf = (float*)(w + m.off[45]); p.convT = (float*)(w + m.off[46]); p.yd = (float*)(w + m.off[47]); p.zT = (float*)(w + m.off[48]); p.hT = (float*)(w + m.off[49]); p.modp = (float*)(w + m.off[50]);
}

#ifndef CPU_SHIM
namespace pg8 {
#define PG8_LAS __attribute__((address_space(3)))
typedef short bf16x8 __attribute__((ext_vector_type(8)));
typedef float f32x4 __attribute__((ext_vector_type(4)));
constexpr int BM = 256, BK = 64, HALF = 128, HTB = HALF * BK * 2, STAGE_BYTES = 8 * HTB, NXCD = 8, WGM = 8;
__host__ __device__ __forceinline__ int lds_byte(int r, int c) { const int st = (r >> 4) * 2 + (c >> 5), rr = r & 15, cc = c & 31, ob = rr * 64 + cc * 2; return st * 1024 + (ob ^ (((ob >> 9) & 1) << 5)); }
__host__ __device__ __forceinline__ void stage_rc(int b, int& R, int& C) { const int st = b / 1024, sb = b % 1024, swz = sb ^ (((sb >> 9) & 1) << 5); R = (st >> 1) * 16 + swz / 64; C = (st & 1) * 32 + (swz % 64) / 2; }
struct Unit { int pm, pn, e; };
struct Gemm { const bf16_t* A; const bf16_t* Bt; int M, N, K; size_t ebytes; };
struct StaticOrder {
    int nM, nN, nwg, G, c;
    __device__ void init(int M, int N, int G_, int c_) { nM = M / BM; nN = N / BM; nwg = nM * nN; G = G_; c = c_; }
    __device__ bool next(int i, Unit& u) const {
        const long L = (long)i * G + c; if (L >= nwg) return false;
        int wgid = (int)L; { const int q = nwg / NXCD, r = nwg % NXCD, xcd = wgid % NXCD, off = wgid / NXCD; wgid = (xcd < r ? xcd * (q + 1) : r * (q + 1) + (xcd - r) * q) + off; }
        const int nig = WGM * nN, gid = wgid / nig, fm = gid * WGM, gsz = (nM - fm) < WGM ? (nM - fm) : WGM;
        u.pm = fm + ((wgid % nig) % gsz); u.pn = (wgid % nig) / gsz; u.e = 0; return true;
    }
    __device__ int tok(int, int) const { return 0; }
};
struct MoeOrder {
    int nwg, nN, G, c; const volatile PG8_LAS unsigned char* ue; const volatile PG8_LAS int* tokt;
    __device__ int tok(int ui, int row) const { return tokt[ui * 256 + row]; }
    __device__ bool unit(int i, int& pm, int& pn) const {
        const int S = G >> 3;
        if ((G & 7) == 0 && S % nN == 0) { const int x = c & 7, slot = c >> 3, pmx = S / nN, T = nwg / nN, tpx = (T + 7) >> 3, lp = i * pmx + slot / nN;
            pm = x * tpx + lp; pn = slot % nN; return lp < tpx && pm < T; }
        const long L = (long)i * G + c; pm = (int)(L / nN); pn = (int)(L % nN); return L < nwg;
    }
    __device__ bool next(int i, Unit& u) const {
        int pm, pn; if (!unit(i, pm, pn)) return false;
        u.pm = pm; u.pn = pn; u.e = __builtin_amdgcn_readfirstlane((int)ue[pm]); return true;
    }
};
template <class Epi, class Sched, bool GATHER = false>
__device__ __forceinline__ void gemm_phase(PG8_LAS unsigned char* lds, const Gemm g, const Sched& S, const Epi& E) {
    int tid = threadIdx.x; asm volatile("" : "+v"(tid));
    const int wid = __builtin_amdgcn_readfirstlane(tid >> 6), lane = tid & 63, wr = wid >> 2, wc = wid & 3, fr = lane & 15, fq = lane >> 4;
    const int K = g.K, nt = K / BK;
    unsigned va[2][2], vn[2][2], voffB[2]; int Rr[2]; unsigned Cb[2];
#pragma unroll
    for (int i = 0; i < 2; ++i) { int R, C; stage_rc(tid * 16 + i * 8192, R, C); Rr[i] = R; Cb[i] = (unsigned)C * 2u; voffB[i] = (unsigned)(R * K + C) * 2u; }
    const size_t kstep = (size_t)(BK * 2);
    const size_t hstep = (size_t)HALF * K * 2;
    const size_t tstep = 2 * hstep;
#define PG8_SETOFF(v, ui_) do { _Pragma("unroll") for (int h_ = 0; h_ < 2; ++h_) _Pragma("unroll") for (int i_ = 0; i_ < 2; ++i_) \
        v[h_][i_] = GATHER ? (unsigned)S.tok(ui_, h_ * HALF + Rr[i_]) * (unsigned)(K * 2) + Cb[i_] : voffB[i_] + (unsigned)(h_ * hstep); } while (0)
    const unsigned ldsw = (unsigned)wid * 1024u;
    const int aoff = lds_byte(wr * 64 + fr, fq * 8), boff = lds_byte(wc * 32 + fr, fq * 8);
#define PG8_SA(b, h) (((b) * 2 + (h)) * HTB)
#define PG8_SB(b, h) ((4 + (b) * 2 + (h)) * HTB)
#define PG8_STAGE(bufoff, gbase, voff) do { _Pragma("unroll") for (int _i = 0; _i < 2; ++_i) \
        __builtin_amdgcn_global_load_lds((const unsigned*)((const char*)(gbase) + (voff)[_i]), (PG8_LAS unsigned*)(lds + (bufoff) + ldsw + _i * 8192), 16, 0, 0); } while (0)
#define PG8_LDA(dst, b, h) do { _Pragma("unroll") for (int m = 0; m < 4; ++m) _Pragma("unroll") for (int k = 0; k < 2; ++k) dst[m][k] = *(const PG8_LAS bf16x8*)(lds + PG8_SA(b, h) + aoff + m * 2048 + k * 1024); } while (0)
#define PG8_LDB(dst, b, h) do { _Pragma("unroll") for (int n = 0; n < 2; ++n) _Pragma("unroll") for (int k = 0; k < 2; ++k) dst[n][k] = *(const PG8_LAS bf16x8*)(lds + PG8_SB(b, h) + boff + n * 2048 + k * 1024); } while (0)
#define PG8_MMA(ai, bj, At, Bt) do { __builtin_amdgcn_s_setprio(1); _Pragma("unroll") for (int m = 0; m < 4; ++m) _Pragma("unroll") for (int n = 0; n < 2; ++n) _Pragma("unroll") for (int k = 0; k < 2; ++k) \
        acc[ai][bj][m][n] = __builtin_amdgcn_mfma_f32_16x16x32_bf16(Bt[n][k], At[m][k], acc[ai][bj][m][n], 0, 0, 0); __builtin_amdgcn_s_setprio(0); } while (0)
#define PG8_WAIT_V(n) asm volatile("s_waitcnt vmcnt(" #n ")" ::: "memory")
#define PG8_WAIT_L(n) asm volatile("s_waitcnt lgkmcnt(" #n ")" ::: "memory")
#define PG8_BAR __builtin_amdgcn_s_barrier()
#define PG8_SCHED __builtin_amdgcn_sched_barrier(0)
    Unit cur, nxt; int ui = 0;
    if (!S.next(0, cur)) return;
    f32x4 acc[2][2][4][2];
#pragma unroll
    for (int a = 0; a < 2; ++a)
#pragma unroll
        for (int b = 0; b < 2; ++b)
#pragma unroll
            for (int m = 0; m < 4; ++m)
#pragma unroll
                for (int n = 0; n < 2; ++n) acc[a][b][m][n] = (f32x4){0.f, 0.f, 0.f, 0.f};
    bf16x8 At[4][2], B0[2][2], B1[2][2];
    const char* cA = (const char*)g.A + (GATHER ? (size_t)0 : (size_t)cur.pm * tstep); const char* cB = (const char*)g.Bt + (size_t)cur.e * g.ebytes + (size_t)cur.pn * tstep;
    PG8_SETOFF(va, 0);
    PG8_STAGE(PG8_SB(0, 0), cB, voffB); PG8_STAGE(PG8_SB(0, 1), cB + hstep, voffB); PG8_STAGE(PG8_SA(0, 0), cA, va[0]); PG8_STAGE(PG8_SA(0, 1), cA, va[1]);
    if (wr == 1) PG8_BAR;
    PG8_WAIT_V(2); PG8_BAR;
    PG8_STAGE(PG8_SB(1, 0), cB + kstep, voffB); PG8_STAGE(PG8_SA(1, 0), cA + kstep, va[0]); PG8_STAGE(PG8_SB(1, 1), cB + hstep + kstep, voffB);
    PG8_WAIT_V(6); PG8_BAR;
    for (;;) {
        const bool has_next = S.next(ui + 1, nxt);
        const char* nA = has_next ? (const char*)g.A + (GATHER ? (size_t)0 : (size_t)nxt.pm * tstep) : cA; const char* nB = has_next ? (const char*)g.Bt + (size_t)nxt.e * g.ebytes + (size_t)nxt.pn * tstep : cB;
        if (GATHER && has_next) PG8_SETOFF(vn, ui + 1); else { _Pragma("unroll") for (int h_ = 0; h_ < 2; ++h_) _Pragma("unroll") for (int i_ = 0; i_ < 2; ++i_) vn[h_][i_] = va[h_][i_]; }
        for (int t = 0; t < nt; t += 2) {
            const bool last = (t == nt - 2);
            const char* a1 = cA + (size_t)(t + 1) * kstep;
            const char* a2 = last ? nA : cA + (size_t)(t + 2) * kstep; const char* b2 = last ? nB : cB + (size_t)(t + 2) * kstep;
            const char* a3 = a2 + kstep; const char* b3 = b2 + kstep;
            unsigned s0[2], s1[2];
#pragma unroll
            for (int i_ = 0; i_ < 2; ++i_) { s0[i_] = last ? vn[0][i_] : va[0][i_]; s1[i_] = last ? vn[1][i_] : va[1][i_]; }
            PG8_LDB(B0, 0, 0); PG8_LDB(B1, 0, 1); PG8_SCHED; PG8_LDA(At, 0, 0); PG8_STAGE(PG8_SA(1, 1), a1, va[1]);
            PG8_WAIT_V(8); PG8_WAIT_L(0); PG8_BAR; PG8_MMA(0, 0, At, B0); PG8_MMA(0, 1, At, B1); PG8_BAR; PG8_SCHED;
            PG8_LDA(At, 0, 1); PG8_STAGE(PG8_SB(0, 0), b2, voffB); PG8_STAGE(PG8_SB(0, 1), b2 + hstep, voffB); PG8_STAGE(PG8_SA(0, 0), a2, s0);
            PG8_WAIT_V(8); PG8_WAIT_L(0); PG8_BAR; PG8_MMA(1, 0, At, B0); PG8_MMA(1, 1, At, B1); PG8_BAR; PG8_SCHED;
            PG8_LDB(B0, 1, 0); PG8_LDB(B1, 1, 1); PG8_SCHED; PG8_LDA(At, 1, 0); PG8_STAGE(PG8_SA(0, 1), a2, s1);
            PG8_WAIT_V(8); PG8_WAIT_L(0); PG8_BAR; PG8_MMA(0, 0, At, B0); PG8_MMA(0, 1, At, B1); PG8_BAR; PG8_SCHED;
            PG8_LDA(At, 1, 1); PG8_STAGE(PG8_SB(1, 0), b3, voffB); PG8_STAGE(PG8_SB(1, 1), b3 + hstep, voffB); PG8_STAGE(PG8_SA(1, 0), a3, s0);
            PG8_WAIT_V(8); PG8_WAIT_L(0); PG8_BAR; PG8_MMA(1, 0, At, B0); PG8_MMA(1, 1, At, B1); PG8_BAR; PG8_SCHED;
        }
        if (wr == 0) PG8_BAR;
        E(acc, cur, wr, wc, fr, fq);
        if (!has_next) break;
#pragma unroll
        for (int a = 0; a < 2; ++a)
#pragma unroll
            for (int b = 0; b < 2; ++b)
#pragma unroll
                for (int m = 0; m < 4; ++m)
#pragma unroll
                    for (int n = 0; n < 2; ++n) acc[a][b][m][n] = (f32x4){0.f, 0.f, 0.f, 0.f};
        cur = nxt; cA = nA; cB = nB; ++ui;
#pragma unroll
        for (int h_ = 0; h_ < 2; ++h_)
#pragma unroll
            for (int i_ = 0; i_ < 2; ++i_) va[h_][i_] = vn[h_][i_];
        if (wr == 1) PG8_BAR;
    }
    PG8_WAIT_V(0);
    PG8_BAR;
#undef PG8_SA
#undef PG8_SB
#undef PG8_STAGE
#undef PG8_SETOFF
#undef PG8_LDA
#undef PG8_LDB
#undef PG8_MMA
#undef PG8_WAIT_V
#undef PG8_WAIT_L
#undef PG8_BAR
#undef PG8_SCHED
}
typedef float f32x2v __attribute__((ext_vector_type(2)));
typedef __bf16 bf16x2v __attribute__((ext_vector_type(2)));
__device__ __forceinline__ unsigned cvt_pk_bf16(float lo, float hi) { const bf16x2v r = __builtin_convertvector((f32x2v){lo, hi}, bf16x2v); return __builtin_bit_cast(unsigned, r); }
__device__ __forceinline__ float fast_sigmoid(float x) { return __builtin_amdgcn_rcpf(1.0f + __builtin_amdgcn_exp2f(-1.4426950408889634f * x)); }
#define EPI_LOOP(body) _Pragma("unroll") for (int ai = 0; ai < 2; ++ai) _Pragma("unroll") for (int m = 0; m < 4; ++m) { const int row = row0 + ai * HALF + m * 16; \
    _Pragma("unroll") for (int bj = 0; bj < 2; ++bj) _Pragma("unroll") for (int n = 0; n < 2; ++n) { const int col = col0 + bj * HALF + n * 16; const f32x4 a = acc[ai][bj][m][n]; body } }
struct EpiStoreF32 {
    float* C; int ldc;
    __device__ __forceinline__ void operator()(const f32x4 (&acc)[2][2][4][2], const Unit& u, int wr, int wc, int fr, int fq) const {
        const int row0 = u.pm * BM + wr * 64 + fr, col0 = u.pn * BM + wc * 32 + 4 * fq;
        EPI_LOOP( *(f32x4*)(C + (size_t)row * ldc + col) = a; )
    }
};
struct EpiStoreBf16 {
    bf16_t* C; int ldc;
    __device__ __forceinline__ void operator()(const f32x4 (&acc)[2][2][4][2], const Unit& u, int wr, int wc, int fr, int fq) const {
        const int row0 = u.pm * BM + wr * 64 + fr, col0 = u.pn * BM + wc * 32 + 4 * fq;
        EPI_LOOP( uint2 o; o.x = cvt_pk_bf16(a[0], a[1]); o.y = cvt_pk_bf16(a[2], a[3]); *(uint2*)(C + (size_t)row * ldc + col) = o; )
    }
};
struct EpiResid {
    float* X; const float* gv;
    __device__ __forceinline__ void operator()(const f32x4 (&acc)[2][2][4][2], const Unit& u, int wr, int wc, int fr, int fq) const {
        const int row0 = u.pm * BM + wr * 64 + fr, col0 = u.pn * BM + wc * 32 + 4 * fq;
        const int r0 = u.pm * BM, mrow = r0 < SEQ ? 0 : (r0 < NLAT ? 1 : 2); const float* g = gv + (size_t)mrow * 6 * D;
        EPI_LOOP( const f32x4 gg = *(const f32x4*)(g + col); f32x4* q = (f32x4*)(X + (size_t)row * D + col); *q = *q + gg * a; )
    }
};
struct EpiGlu {
    bf16_t* O; const bf16_t* Y; const float* bias;
    __device__ __forceinline__ void operator()(const f32x4 (&acc)[2][2][4][2], const Unit& u, int wr, int wc, int fr, int fq) const {
        const int row0 = u.pm * BM + wr * 64 + fr, col0 = u.pn * BM + wc * 32 + 4 * fq;
        EPI_LOOP( const f32x4 bb = *(const f32x4*)(bias + col); const ushort4 yv = *(const ushort4*)(Y + (size_t)row * S5W + col);
            uint2 o; o.x = cvt_pk_bf16(bf2f(yv.x) * fast_sigmoid(a[0] + bb[0]), bf2f(yv.y) * fast_sigmoid(a[1] + bb[1])); o.y = cvt_pk_bf16(bf2f(yv.z) * fast_sigmoid(a[2] + bb[2]), bf2f(yv.w) * fast_sigmoid(a[3] + bb[3]));
            *(uint2*)(O + (size_t)row * D + HYW + col) = o; )
    }
};
struct EpiSwiglu {
    bf16_t* O; const float* bgu;
    __device__ __forceinline__ void operator()(const f32x4 (&acc)[2][2][4][2], const Unit& u, int wr, int wc, int fr, int fq) const {
        const int row0 = u.pm * BM + wr * 64 + fr, colb = wc * 32 + 4 * fq; const float* bb = bgu + (size_t)u.e * 2 * DFF + u.pn * 128;
#pragma unroll
        for (int ai = 0; ai < 2; ++ai)
#pragma unroll
            for (int m = 0; m < 4; ++m) { const int row = row0 + ai * HALF + m * 16;
#pragma unroll
                for (int n = 0; n < 2; ++n) { const int cc = colb + n * 16; const f32x4 bg = *(const f32x4*)(bb + cc), bu = *(const f32x4*)(bb + DFF + cc);
                    const f32x4 ga = acc[ai][0][m][n] + bg, up = acc[ai][1][m][n] + bu; float av[4];
#pragma unroll
                    for (int j = 0; j < 4; ++j) { const float gg = fminf(ga[j], 7.0f), uu = fminf(fmaxf(up[j], -7.0f), 7.0f); av[j] = gg * fast_sigmoid(1.702f * gg) * (uu + 1.0f); }
                    uint2 o; o.x = cvt_pk_bf16(av[0], av[1]); o.y = cvt_pk_bf16(av[2], av[3]);
                    *(uint2*)(O + (size_t)row * DFF + u.pn * 128 + cc) = o; } }
    }
};
struct EpiDown {
    bf16_t* Y; const float* bdn; const float* gate;
    __device__ __forceinline__ void operator()(const f32x4 (&acc)[2][2][4][2], const Unit& u, int wr, int wc, int fr, int fq) const {
        const int row0 = u.pm * BM + wr * 64 + fr, col0 = u.pn * BM + wc * 32 + 4 * fq; const float* bb = bdn + (size_t)u.e * D;
        EPI_LOOP( const f32x4 bv = *(const f32x4*)(bb + col); const float gt_ = gate[row]; const f32x4 o = (a + bv) * gt_; uint2 ob; ob.x = cvt_pk_bf16(o[0], o[1]); ob.y = cvt_pk_bf16(o[2], o[3]); *(uint2*)(Y + (size_t)row * D + col) = ob; )
    }
};
}

constexpr int RING_BYTES = 131072, SCRATCH_BYTES = 135168, MISC_OFF = SCRATCH_BYTES, UE_OFF = MISC_OFF + 64, TOK_OFF = UE_OFF + 320, TOK_UNITS = 11, LDS_BYTES = 147456;
static_assert(FFT_ELEMS * 8 <= SCRATCH_BYTES && TOK_OFF + TOK_UNITS * 1024 <= LDS_BYTES && ((NSLOT / 256 + 7) / 8 + 3) / 4 <= TOK_UNITS, "LDS map");
#define LAS __attribute__((address_space(3)))

__device__ __forceinline__ void transpose_item(const float* W, int K, int N, bf16_t* WT, int gu_perm, LAS float* scr, int item, int lane) {
    const int nblk = N / 32, kb = item / nblk, nb = item % nblk, k0 = 64 * kb, n0 = 32 * nb;
    const int r0 = gu_perm ? (n0 < DFF ? (n0 / 128) * 256 + (n0 % 128) : ((n0 - DFF) / 128) * 256 + 128 + ((n0 - DFF) % 128)) : n0;
#pragma unroll 8
    for (int i = 0; i < 32; ++i) { const int kk = 2 * i + (lane >> 5); scr[kk * 33 + (lane & 31)] = W[(size_t)(k0 + kk) * N + n0 + (lane & 31)]; }
    asm volatile("s_waitcnt lgkmcnt(0)" ::: "memory");
    const int c = lane & 7;
#pragma unroll
    for (int j = 0; j < 4; ++j) { const int n = (lane >> 3) + 8 * j; const LAS float* s = scr + (8 * c) * 33 + n;
        uint4 o; o.x = f2bf(s[0 * 33]) | ((unsigned)f2bf(s[1 * 33]) << 16); o.y = f2bf(s[2 * 33]) | ((unsigned)f2bf(s[3 * 33]) << 16);
        o.z = f2bf(s[4 * 33]) | ((unsigned)f2bf(s[5 * 33]) << 16); o.w = f2bf(s[6 * 33]) | ((unsigned)f2bf(s[7 * 33]) << 16);
        *(uint4*)(WT + (size_t)(r0 + n) * K + k0 + 8 * c) = o; }
    asm volatile("s_waitcnt lgkmcnt(0)" ::: "memory");
}
constexpr int I_GU = (D / 64) * (2 * DFF / 32), I_DN = (DFF / 64) * (D / 32), EXP_ITEMS = NE * (I_GU + I_DN);
__device__ __forceinline__ void convert_expert_item(const P& p, int l, int q, LAS float* scr, int lane) {
    if (q < NE * I_GU) { const int e = q / I_GU; const size_t i = (size_t)l * NE + e; transpose_item(p.w_gu + i * D * 2 * DFF, D, 2 * DFF, p.wgu_t + i * 2 * DFF * D, 1, scr, q % I_GU, lane); }
    else { const int q2 = q - NE * I_GU, e = q2 / I_DN; const size_t i = (size_t)l * NE + e; transpose_item(p.w_dn + i * DFF * D, DFF, D, p.wdn_t + i * D * DFF, 0, scr, q2 % I_DN, lane); }
}
constexpr int DEFER_Q1 = 104, DEFER_Q2 = 104;
__device__ __forceinline__ int defer_idle(int units, int G) { const int rem = units % G; return rem ? G - rem : 0; }
__device__ __forceinline__ int defer_in_units(int layer) { return (NTOK / 256) * ((layer & 1) ? CD_IN / 256 : AB_IN / 256); }
__device__ __forceinline__ int defer_d1(int layer, int G) { const int n = defer_idle(defer_in_units(layer), G) * DEFER_Q1; return n < EXP_ITEMS ? n : EXP_ITEMS; }
__device__ __forceinline__ int defer_d2(int layer, int G) { const int d1 = defer_d1(layer, G), n = d1 + defer_idle((NTOK / 256) * (D / 256), G) * DEFER_Q2; return n < EXP_ITEMS ? n : EXP_ITEMS; }
__device__ __forceinline__ void convert_deferred(const P& p, LAS unsigned char* lds, int layer, int which) {
    int tid = threadIdx.x; asm volatile("" : "+v"(tid));
    int bx_ = (int)blockIdx.x, gx_ = (int)gridDim.x; asm volatile("" : "+s"(bx_), "+s"(gx_));
    const int units = which ? (NTOK / 256) * (D / 256) : defer_in_units(layer), rem = units % gx_;
    if (rem == 0 || bx_ < rem) return;
    const int lane = tid & 63, wave = tid >> 6; LAS float* scr = (LAS float*)(lds + wave * 16384);
    const int qn = which ? DEFER_Q2 : DEFER_Q1, q0 = (which ? defer_d1(layer, gx_) : 0) + (bx_ - rem) * qn, qend = which ? defer_d2(layer, gx_) : defer_d1(layer, gx_);
    for (int q = q0 + wave; q < q0 + qn && q < qend; q += 8) convert_expert_item(p, layer + 1, q, scr, lane);
}
__device__ __forceinline__ void ph_convert_weights(const P& p, LAS unsigned char* lds) {
    int tid = threadIdx.x; asm volatile("" : "+v"(tid));
    const int lane = tid & 63, wave = tid >> 6;
    LAS float* scr = (LAS float*)(lds + wave * 16384);
    const long gw = (long)blockIdx.x * 8 + wave, NGW = (long)gridDim.x * 8; const int G = (int)gridDim.x;
    constexpr long I_ABIN = (D / 64) * (AB_IN / 32), I_CDIN = (D / 64) * (CD_IN / 32), I_OUT = (D / 64) * (D / 32), I_GLU = (S5W / 64) * (S5W / 32);
    constexpr long T0 = 2 * I_ABIN, T1 = T0 + 2 * I_CDIN, T2 = T1 + 2 * I_OUT, T3 = T2 + 2 * I_OUT, T4 = T3 + 2 * I_GLU;
    for (long it = gw; it < T4; it += NGW) {
        if (it < T0) { const int i = (int)(it / I_ABIN); transpose_item(p.ab_w_in + (size_t)i * D * AB_IN, D, AB_IN, p.abin_t + (size_t)i * AB_IN * D, 0, scr, (int)(it % I_ABIN), lane); }
        else if (it < T1) { const long r = it - T0; const int i = (int)(r / I_CDIN); transpose_item(p.cd_w_in + (size_t)i * D * CD_IN, D, CD_IN, p.cdin_t + (size_t)i * CD_IN * D, 0, scr, (int)(r % I_CDIN), lane); }
        else if (it < T2) { const long r = it - T1; const int i = (int)(r / I_OUT); transpose_item(p.ab_w_out + (size_t)i * D * D, D, D, p.about_t + (size_t)i * D * D, 0, scr, (int)(r % I_OUT), lane); }
        else if (it < T3) { const long r = it - T2; const int i = (int)(r / I_OUT); transpose_item(p.cd_w_out + (size_t)i * D * D, D, D, p.cdout_t + (size_t)i * D * D, 0, scr, (int)(r % I_OUT), lane); }
        else { const long r = it - T3; const int i = (int)(r / I_GLU); transpose_item(p.s5_glu_w + (size_t)i * S5W * S5W, S5W, S5W, p.glu_t + (size_t)i * S5W * S5W, 0, scr, (int)(r % I_GLU), lane); }
    }
    for (int l = 0; l < 4; ++l) { const int qs = l ? defer_d2(l - 1, G) : 0;
        for (long q = qs + gw; q < EXP_ITEMS; q += NGW) convert_expert_item(p, l, (int)q, scr, lane); }
}
constexpr int NTHREADS = 512;
__device__ __forceinline__ float wave_sum(float v) {
#pragma unroll
    for (int o = 1; o < 64; o <<= 1) v += __shfl_xor(v, o);
    return v;
}
template <int MODE> __device__ __forceinline__ void mf_rownorm(const P& p, LAS unsigned char* lds, int layer, int nrows, int comb_layer) {
    constexpr bool ROUTE = MODE == 1; constexpr int which = MODE == 1 ? 1 : 0;
    int tid = threadIdx.x; asm volatile("" : "+v"(tid));
    int bx_ = (int)blockIdx.x, gx_ = (int)gridDim.x; asm volatile("" : "+s"(bx_), "+s"(gx_));
    const int lane = tid & 63, wave = tid >> 6;
    if (ROUTE) { for (int j = bx_ * NTHREADS + tid; j < NSLOT; j += gx_ * NTHREADS) { p.slot_tok[j] = -1; p.slot_gate[j] = 0.f; } }
    const float* gn = MODE == 2 ? p.final_g : (which ? p.norm2_g : p.norm1_g) + layer * D;
    LAS float* Wl = (LAS float*)lds;
    if (ROUTE) { const float* rw = p.router_w + (size_t)layer * D * NE;
        for (int i = tid; i < D * NE / 4; i += NTHREADS) { const float4 w4 = *(const float4*)(rw + 4 * i); *(LAS pg8::f32x4*)(Wl + 4 * i) = (pg8::f32x4){w4.x, w4.y, w4.z, w4.w}; }
        __syncthreads(); }
    volatile LAS int* lcnt = (volatile LAS int*)(lds + RING_BYTES);
    volatile LAS int* lbase = lcnt + NE; volatile LAS int* lrank = lcnt + 2 * NE;
    if (ROUTE) { if (tid < NE) lcnt[tid] = 0; __syncthreads(); }
    for (int r = bx_ * 8 + wave; r < nrows; r += gx_ * 8) {
        const int m = r < SEQ ? 0 : (r < NLAT ? 1 : 2);
        const float* mv = p.modv + ((size_t)layer * 3 + m) * 6 * D + which * 3 * D;
        float* xr = p.xa + (size_t)r * D;
        float4 v[4]; float ss = 0.f;
#pragma unroll
        for (int j = 0; j < 4; ++j) v[j] = *(const float4*)(xr + 256 * j + 4 * lane);
        if (comb_layer >= 0) {
            const float* g2 = p.modv + ((size_t)comb_layer * 3 + m) * 6 * D + 5 * D;
            const int4 so = *(const int4*)(p.slot_of + r * 4);
            const bf16_t* y0 = p.yb + (size_t)so.x * D; const bf16_t* y1 = p.yb + (size_t)so.y * D; const bf16_t* y2 = p.yb + (size_t)so.z * D; const bf16_t* y3 = p.yb + (size_t)so.w * D;
#pragma unroll
            for (int j = 0; j < 4; ++j) { const int k = 256 * j + 4 * lane; const ushort4 a = *(const ushort4*)(y0 + k), b = *(const ushort4*)(y1 + k), c = *(const ushort4*)(y2 + k), d = *(const ushort4*)(y3 + k); const float4 gg = *(const float4*)(g2 + k);
                v[j].x += gg.x * (bf2f(a.x) + bf2f(b.x) + bf2f(c.x) + bf2f(d.x)); v[j].y += gg.y * (bf2f(a.y) + bf2f(b.y) + bf2f(c.y) + bf2f(d.y));
                v[j].z += gg.z * (bf2f(a.z) + bf2f(b.z) + bf2f(c.z) + bf2f(d.z)); v[j].w += gg.w * (bf2f(a.w) + bf2f(b.w) + bf2f(c.w) + bf2f(d.w));
                if (MODE != 2) *(float4*)(xr + k) = v[j]; }
        }
#pragma unroll
        for (int j = 0; j < 4; ++j) ss += v[j].x * v[j].x + v[j].y * v[j].y + v[j].z * v[j].z + v[j].w * v[j].w;
        const float rstd = rsqrtf(wave_sum(ss) * (1.0f / D) + EPS);
        if (MODE == 2) {
#pragma unroll
            for (int j = 0; j < 4; ++j) { const int k = 256 * j + 4 * lane; const float4 g4 = *(const float4*)(gn + k);
                float4 o; o.x = v[j].x * rstd * g4.x; o.y = v[j].y * rstd * g4.y; o.z = v[j].z * rstd * g4.z; o.w = v[j].w * rstd * g4.w;
                *(float4*)(p.out + (size_t)r * D + k) = o; }
            continue;
        }
#pragma unroll
        for (int j = 0; j < 4; ++j) { const int k = 256 * j + 4 * lane; const float4 g4 = *(const float4*)(gn + k), sc = *(const float4*)(mv + D + k), sh = *(const float4*)(mv + k);
            v[j].x = v[j].x * rstd * g4.x * (1.0f + sc.x) + sh.x; v[j].y = v[j].y * rstd * g4.y * (1.0f + sc.y) + sh.y;
            v[j].z = v[j].z * rstd * g4.z * (1.0f + sc.z) + sh.z; v[j].w = v[j].w * rstd * g4.w * (1.0f + sc.w) + sh.w;
            ushort4 o; o.x = f2bf(v[j].x); o.y = f2bf(v[j].y); o.z = f2bf(v[j].z); o.w = f2bf(v[j].w);
            *(ushort4*)(p.hxb + (size_t)r * D + k) = o; }
        if (ROUTE) {
            const int eh = lane & 31, half = lane >> 5;
            const LAS float* wb = Wl + (size_t)(128 * half) * NE + eh;
            float acc = 0.f;
#pragma unroll
            for (int j = 0; j < 4; ++j) { const float vq[4] = {v[j].x, v[j].y, v[j].z, v[j].w};
#pragma unroll
                for (int q = 0; q < 4; ++q) { const int vi = __builtin_bit_cast(int, vq[q]);
#pragma unroll 8
                    for (int l = 0; l < 32; ++l) { const float s0 = __builtin_bit_cast(float, __builtin_amdgcn_readlane(vi, l)), s1 = __builtin_bit_cast(float, __builtin_amdgcn_readlane(vi, l + 32));
                        acc += (half ? s1 : s0) * wb[(256 * j + 4 * l + q) * NE]; } } }
            acc += __shfl_xor(acc, 32);
            acc += p.router_b[layer * NE + eh];
            float lg[NE];
#pragma unroll
            for (int e = 0; e < NE; ++e) lg[e] = __shfl(acc, e);
            int ti[4]; float tv[4];
#pragma unroll
            for (int s = 0; s < 4; ++s) { int best = 0; float bv = -3.0e38f;
#pragma unroll
                for (int e = 0; e < NE; ++e) { if (lg[e] > bv) { bv = lg[e]; best = e; } }
                ti[s] = best; tv[s] = bv;
#pragma unroll
                for (int e = 0; e < NE; ++e) if (e == best) lg[e] = -3.0e38f; }
            if (lane == 0) {
                const float e1 = expf(tv[1] - tv[0]), e2 = expf(tv[2] - tv[0]), e3 = expf(tv[3] - tv[0]), inv = 1.0f / (1.0f + e1 + e2 + e3);
                p.topi[r * 4 + 0] = ti[0]; p.topi[r * 4 + 1] = ti[1]; p.topi[r * 4 + 2] = ti[2]; p.topi[r * 4 + 3] = ti[3];
                p.topg[r * 4 + 0] = inv; p.topg[r * 4 + 1] = e1 * inv; p.topg[r * 4 + 2] = e2 * inv; p.topg[r * 4 + 3] = e3 * inv;
                const int li = ((r - (bx_ * 8 + wave)) / (gx_ * 8)) * 8 + wave;
#pragma unroll
                for (int s = 0; s < 4; ++s) lrank[li * 4 + s] = __hip_atomic_fetch_add((LAS int*)(lcnt + ti[s]), 1, __ATOMIC_RELAXED, __HIP_MEMORY_SCOPE_WORKGROUP);
            }
        }
    }
    if (ROUTE) {
        __syncthreads();
        if (tid < NE) lbase[tid] = atomicAdd(p.cnt + layer * NE + tid, lcnt[tid]);
        __syncthreads();
        const int nmine = (nrows - bx_ * 8 + gx_ * 8 - 1) / (gx_ * 8) * 8;
        for (int i = tid; i < nmine * 4; i += NTHREADS) { const int li = i >> 2, r = bx_ * 8 + (li & 7) + (li >> 3) * gx_ * 8;
            if (r < nrows) p.pos[r * 4 + (i & 3)] = lbase[p.topi[i - li * 4 + r * 4]] + lrank[i]; }
    }
}
__device__ __forceinline__ float4 ld4px(const float* q) { return *(const float4*)q; }
__device__ __forceinline__ float4 ld4px(const bf16_t* q) { const ushort4 v = *(const ushort4*)q; return make_float4(bf2f(v.x), bf2f(v.y), bf2f(v.z), bf2f(v.w)); }
typedef unsigned short us4v __attribute__((ext_vector_type(4)));
__device__ __forceinline__ us4v pack4(float4 v) { return (us4v){f2bf(v.x), f2bf(v.y), f2bf(v.z), f2bf(v.w)}; }
template <int K> __device__ __forceinline__ pg8::f32x4 mma16(const LAS bf16_t* A, int lda, const LAS bf16_t* Bt, int ldb, pg8::f32x4 acc, int lane) {
    const int r = lane & 15, q = lane >> 4;
    const LAS bf16_t* ap = A + r * lda + 8 * q; const LAS bf16_t* bp = Bt + r * ldb + 8 * q;
#pragma unroll
    for (int k0 = 0; k0 < K; k0 += 32) acc = __builtin_amdgcn_mfma_f32_16x16x32_bf16(*(const LAS pg8::bf16x8*)(ap + k0), *(const LAS pg8::bf16x8*)(bp + k0), acc, 0, 0, 0);
    return acc;
}
constexpr int RLD = 136, RLQ = 72;
__device__ __forceinline__ void mf_retkv(const P& p, LAS unsigned char* lds, int il) {
    int tid = threadIdx.x; asm volatile("" : "+v"(tid));
    int bx_ = (int)blockIdx.x, gx_ = (int)gridDim.x; asm volatile("" : "+s"(bx_), "+s"(gx_));
    const int lane = tid & 63, wave = tid >> 6, r = lane & 15, q = lane >> 4;
    LAS bf16_t* KdT = (LAS bf16_t*)lds; LAS bf16_t* VT = KdT + 64 * RLD;
    for (int u = bx_; u < 16 * RNCH; u += gx_) {
        const int n = u % RNCH, h = (u / RNCH) & 3, b = (u / (RNCH * 4)) & 1, dir = u / (RNCH * 8);
        const float lg = ret_logg(p, il, dir, h);
        __syncthreads();
        for (int idx = tid; idx < 128 * 16; idx += NTHREADS) { const int j = idx >> 4, d4 = idx & 15, row = scan_row(dir, b, n * RC + j);
            const float4 kv = *(const float4*)(p.kr + (size_t)row * 256 + h * 64 + 4 * d4); const float dk = fexp((float)(RC - 1 - j) * lg);
            KdT[(4 * d4 + 0) * RLD + j] = f2bf(kv.x * dk); KdT[(4 * d4 + 1) * RLD + j] = f2bf(kv.y * dk); KdT[(4 * d4 + 2) * RLD + j] = f2bf(kv.z * dk); KdT[(4 * d4 + 3) * RLD + j] = f2bf(kv.w * dk); }
        for (int idx = tid; idx < 128 * 32; idx += NTHREADS) { const int j = idx >> 5, e4 = idx & 31, row = scan_row(dir, b, n * RC + j);
            const float4 vv = ld4px(p.px + (size_t)row * PXLD + 512 + h * 128 + 4 * e4);
            VT[(4 * e4 + 0) * RLD + j] = f2bf(vv.x); VT[(4 * e4 + 1) * RLD + j] = f2bf(vv.y); VT[(4 * e4 + 2) * RLD + j] = f2bf(vv.z); VT[(4 * e4 + 3) * RLD + j] = f2bf(vv.w); }
        __syncthreads();
        float* o = p.rkv + ((((size_t)dir * 2 + b) * RNCH + n) * 4 + h) * 8192;
#pragma unroll
        for (int td = 0; td < 4; ++td) { pg8::f32x4 acc = {0.f, 0.f, 0.f, 0.f};
            acc = mma16<128>(VT + (16 * wave) * RLD, RLD, KdT + (16 * td) * RLD, RLD, acc, lane);
#pragma unroll
            for (int g = 0; g < 4; ++g) o[(size_t)(16 * wave + 4 * q + g) * 64 + 16 * td + r] = acc[g]; }
    }
}
__device__ __forceinline__ void mf_reto(const P& p, LAS unsigned char* lds, int il) {
    int tid = threadIdx.x; asm volatile("" : "+v"(tid));
    int bx_ = (int)blockIdx.x, gx_ = (int)gridDim.x; asm volatile("" : "+s"(bx_), "+s"(gx_));
    const int lane = tid & 63, wave = tid >> 6, r = lane & 15, q = lane >> 4;
    LAS bf16_t* Qs = (LAS bf16_t*)lds; LAS bf16_t* Ks = Qs + 128 * RLQ; LAS bf16_t* ST = Ks + 128 * RLQ; LAS bf16_t* VT = ST + 128 * RLQ; LAS bf16_t* Ps = VT + 128 * RLD;
    for (int u = bx_; u < 16 * RNCH; u += gx_) {
        const int n = u % RNCH, h = (u / RNCH) & 3, b = (u / (RNCH * 4)) & 1, dir = u / (RNCH * 8);
        const float lg = ret_logg(p, il, dir, h);
        const float* Sg = p.rkv + ((((size_t)dir * 2 + b) * RNCH + n) * 4 + h) * 8192;
        __syncthreads();
        for (int idx = tid; idx < 128 * 16; idx += NTHREADS) { const int j = idx >> 4, d4 = idx & 15, row = scan_row(dir, b, n * RC + j);
            const float4 qv = *(const float4*)(p.qr + (size_t)row * 256 + h * 64 + 4 * d4), kv = *(const float4*)(p.kr + (size_t)row * 256 + h * 64 + 4 * d4), sv = *(const float4*)(Sg + (size_t)j * 64 + 4 * d4);
            *(LAS us4v*)(Qs + j * RLQ + 4 * d4) = pack4(qv); *(LAS us4v*)(Ks + j * RLQ + 4 * d4) = pack4(kv); *(LAS us4v*)(ST + j * RLQ + 4 * d4) = pack4(sv); }
        for (int idx = tid; idx < 128 * 32; idx += NTHREADS) { const int j = idx >> 5, e4 = idx & 31, row = scan_row(dir, b, n * RC + j);
            const float4 vv = ld4px(p.px + (size_t)row * PXLD + 512 + h * 128 + 4 * e4);
            VT[(4 * e4 + 0) * RLD + j] = f2bf(vv.x); VT[(4 * e4 + 1) * RLD + j] = f2bf(vv.y); VT[(4 * e4 + 2) * RLD + j] = f2bf(vv.z); VT[(4 * e4 + 3) * RLD + j] = f2bf(vv.w); }
        __syncthreads();
#pragma unroll
        for (int tj = 0; tj < 8; ++tj) { pg8::f32x4 acc = {0.f, 0.f, 0.f, 0.f};
            acc = mma16<64>(Qs + (16 * wave) * RLQ, RLQ, Ks + (16 * tj) * RLQ, RLQ, acc, lane);
            const int j = 16 * tj + r;
#pragma unroll
            for (int g = 0; g < 4; ++g) { const int i = 16 * wave + 4 * q + g; Ps[i * RLD + j] = f2bf(j <= i ? acc[g] * fexp((float)(i - j) * lg) : 0.f); } }
        __syncthreads();
        float dq[4];
#pragma unroll
        for (int g = 0; g < 4; ++g) dq[g] = fexp((float)(16 * wave + 4 * q + g + 1) * lg);
#pragma unroll
        for (int te = 0; te < 8; ++te) { pg8::f32x4 acc = {0.f, 0.f, 0.f, 0.f}, cr = {0.f, 0.f, 0.f, 0.f};
            acc = mma16<128>(Ps + (16 * wave) * RLD, RLD, VT + (16 * te) * RLD, RLD, acc, lane);
            cr = mma16<64>(Qs + (16 * wave) * RLQ, RLQ, ST + (16 * te) * RLQ, RLQ, cr, lane);
#pragma unroll
            for (int g = 0; g < 4; ++g) { const int i = 16 * wave + 4 * q + g, row = scan_row(dir, b, n * RC + i);
                p.oret[((size_t)dir * NTOK + row) * 512 + h * 128 + 16 * te + r] = acc[g] + dq[g] * cr[g]; } }
    }
}
template <bool FILL> __device__ __forceinline__ void mf_s5(const P& p, LAS unsigned char* lds, int il) {
    int tid = threadIdx.x; asm volatile("" : "+v"(tid));
    int bx_ = (int)blockIdx.x, gx_ = (int)gridDim.x; asm volatile("" : "+s"(bx_), "+s"(gx_));
    const int lane = tid & 63, wave = tid >> 6, r = lane & 15, q = lane >> 4;
    constexpr int LDU = 40, LDS_ = 132, LDB = 136;
    LAS bf16_t* Bt = (LAS bf16_t*)lds;
    LAS bf16_t* Ct = Bt + 128 * LDU;
    LAS unsigned char* wb = lds + 16384 + wave * 14336;
    LAS bf16_t* U = (LAS bf16_t*)wb;
    LAS float* SL = (LAS float*)(wb + 1280);
    LAS bf16_t* Sb = (LAS bf16_t*)(wb + 1280 + 8448);
    constexpr int GRP = (2 * S5NCH) / 8;
    static_assert((2 * S5NCH) % 8 == 0, "chunk count");
    for (int bu = bx_; bu < 64 * GRP; bu += gx_) {
        const int dg = bu / GRP, grp = bu % GRP, dir = dg >> 5, g = dg & 31;
        __syncthreads();
        if (tid < 64) { S5Par sp; s5_par(p, il, dir, g, tid, sp);
#pragma unroll
            for (int h = 0; h < 16; ++h) { Bt[(2 * tid) * LDU + h] = f2bf(sp.bbr[h]); Bt[(2 * tid + 1) * LDU + h] = f2bf(sp.bbi[h]); Bt[(2 * tid) * LDU + 16 + h] = 0; Bt[(2 * tid + 1) * LDU + 16 + h] = 0;
                const long ci = (((long)(il * 2 + dir) * NG + g) * GH + h) * NP + tid; Ct[h * LDB + 2 * tid] = f2bf(p.s5_cre[ci]); Ct[h * LDB + 2 * tid + 1] = f2bf(-p.s5_cim[ci]); } }
        float lbr, lbi; { const int gi = (il * 2 + dir) * NG + g; const float lre = fminf(p.s5_lre[gi * NP + lane], -1e-4f), lim = p.s5_lim[gi * NP + lane], dt = expf(p.s5_ldt[gi]);
            const float mag = expf(lre * dt); lbr = mag * cosf(lim * dt); lbi = mag * sinf(lim * dt); }
        __syncthreads();
        const int bc = grp * 8 + wave, b = bc / S5NCH, ch = bc % S5NCH;
        float* ce = p.s5c + ((((size_t)dir * 2 + b) * S5NCH + ch) * NG + g) * NP * 2 + lane * 2;
        float sr = 0.f, si = 0.f;
        if (FILL) { sr = ce[0]; si = ce[1]; }
        float4 uvs[S5C / 16];
#pragma unroll
        for (int sb = 0; sb < S5C / 16; ++sb) { const int k = lane >> 2, h4 = (lane & 3) * 4, row = scan_row(dir, b, ch * S5C + sb * 16 + k);
            uvs[sb] = ld4px(p.px + (size_t)row * PXLD + 1536 + g * GH + h4); }
#pragma unroll
        for (int sb = 0; sb < S5C / 16; ++sb) {
            { const int k = lane >> 2, h4 = (lane & 3) * 4;
              *(LAS us4v*)(U + k * LDU + h4) = pack4(uvs[sb]); *(LAS us4v*)(U + k * LDU + 16 + h4) = (us4v){0, 0, 0, 0}; }
            asm volatile("s_waitcnt lgkmcnt(0)" ::: "memory");
#pragma unroll
            for (int tc = 0; tc < 8; ++tc) { pg8::f32x4 acc = {0.f, 0.f, 0.f, 0.f};
                acc = mma16<32>(U, LDU, Bt + (16 * tc) * LDU, LDU, acc, lane);
#pragma unroll
                for (int gq = 0; gq < 4; ++gq) SL[(4 * q + gq) * LDS_ + 16 * tc + r] = acc[gq]; }
            asm volatile("s_waitcnt lgkmcnt(0)" ::: "memory");
#pragma unroll
            for (int k = 0; k < 16; ++k) { const float br = SL[k * LDS_ + 2 * lane], bi = SL[k * LDS_ + 2 * lane + 1];
                const float tr = lbr * sr - lbi * si + br, ti = lbr * si + lbi * sr + bi; sr = tr; si = ti;
                if (FILL) { Sb[k * LDB + 2 * lane] = f2bf(sr); Sb[k * LDB + 2 * lane + 1] = f2bf(si); } }
            if (FILL) {
                asm volatile("s_waitcnt lgkmcnt(0)" ::: "memory");
                pg8::f32x4 acc = {0.f, 0.f, 0.f, 0.f};
                acc = mma16<128>(Sb, LDB, Ct, LDB, acc, lane);
#pragma unroll
                for (int gq = 0; gq < 4; ++gq) { const int row = scan_row(dir, b, ch * S5C + sb * 16 + 4 * q + gq); p.yd[((size_t)dir * NTOK + row) * S5W + g * GH + r] = acc[gq]; }
            }
            asm volatile("s_waitcnt lgkmcnt(0)" ::: "memory");
        }
        if (!FILL) { ce[0] = sr; ce[1] = si; }
    }
}
__device__ __forceinline__ void mf_swa(const P& p, LAS unsigned char* lds, int il, bool with_ctx) {
    int tid = threadIdx.x; asm volatile("" : "+v"(tid));
    int bx_ = (int)blockIdx.x, gx_ = (int)gridDim.x; asm volatile("" : "+s"(bx_), "+s"(gx_));
    const int lane = tid & 63, wave = tid >> 6, r = lane & 15, q = lane >> 4;
    constexpr int LDK = 72;
    LAS bf16_t* Ks = (LAS bf16_t*)lds;
    LAS bf16_t* VT = Ks + 64 * LDK;
    LAS bf16_t* Pw = VT + 64 * LDK + wave * 64 * LDK;
    constexpr int NQB = SEQ / 128, NLATU = 4 * NQB, NCTXU = 4 * (CTXL / 128);
    const int nunits = NLATU + (with_ctx ? NCTXU : 0);
    for (int u = bx_; u < nunits; u += gx_) {
        int b, kv, qb, isctx;
        if (u < NLATU) { isctx = 0; qb = u % NQB; kv = (u / NQB) & 1; b = u / (NQB * 2); }
        else { const int v = u - NLATU; isctx = 1; qb = v % (CTXL / 128); kv = (v / (CTXL / 128)) & 1; b = v / ((CTXL / 128) * 2); }
        const int g = wave >> 1, hq = kv * 4 + g, i0 = (wave & 1) * 64;
        const int qrow0 = (isctx ? NLAT + b * CTXL : b * SEQ) + qb * 128 + i0;
        pg8::bf16x8 qf[4][2];
#pragma unroll
        for (int tq = 0; tq < 4; ++tq)
#pragma unroll
            for (int ks = 0; ks < 2; ++ks) { const float* src = p.qs + (size_t)(qrow0 + 16 * tq + r) * 512 + hq * 64 + 32 * ks + 8 * q;
                const float4 a = *(const float4*)src, c = *(const float4*)(src + 4);
                qf[tq][ks] = (pg8::bf16x8){(short)f2bf(a.x), (short)f2bf(a.y), (short)f2bf(a.z), (short)f2bf(a.w), (short)f2bf(c.x), (short)f2bf(c.y), (short)f2bf(c.z), (short)f2bf(c.w)}; }
        pg8::f32x4 oacc[4][4];
        float mrow[4][4], lrow[4][4];
        const float sink = p.swa_sink[il * 8 + hq];
#pragma unroll
        for (int tq = 0; tq < 4; ++tq)
#pragma unroll
            for (int x = 0; x < 4; ++x) { oacc[tq][x] = (pg8::f32x4){0.f, 0.f, 0.f, 0.f}; mrow[tq][x] = sink; lrow[tq][x] = 1.0f; }
        const int ntile = isctx ? 4 : 10;
        for (int t = 0; t < ntile; ++t) {
            const bool loc = !isctx && t < 6;
            const int kpos0 = loc ? 128 * (qb - 1) + 64 * t : 0;
            if (loc && (kpos0 < 0 || kpos0 >= SEQ)) continue;
            const int krow0 = loc ? b * SEQ + kpos0 : NLAT + b * CTXL + 64 * (isctx ? t : t - 6);
            __syncthreads();
            for (int idx = tid; idx < 64 * 16; idx += NTHREADS) { const int key = idx >> 4, d4 = idx & 15;
                const float4 kk = *(const float4*)(p.ks + (size_t)(krow0 + key) * 128 + kv * 64 + 4 * d4), vv = ld4px(p.px + (size_t)(krow0 + key) * PXLD + 2176 + kv * 64 + 4 * d4);
                *(LAS us4v*)(Ks + key * LDK + 4 * d4) = pack4(kk);
                VT[(4 * d4 + 0) * LDK + key] = f2bf(vv.x); VT[(4 * d4 + 1) * LDK + key] = f2bf(vv.y); VT[(4 * d4 + 2) * LDK + key] = f2bf(vv.z); VT[(4 * d4 + 3) * LDK + key] = f2bf(vv.w); }
            __syncthreads();
            pg8::f32x4 sc[4][4];
#pragma unroll
            for (int tk = 0; tk < 4; ++tk) { const LAS bf16_t* kp = Ks + (16 * tk + r) * LDK + 8 * q;
                const pg8::bf16x8 k0 = *(const LAS pg8::bf16x8*)kp, k1 = *(const LAS pg8::bf16x8*)(kp + 32);
#pragma unroll
                for (int tq = 0; tq < 4; ++tq) { pg8::f32x4 a = {0.f, 0.f, 0.f, 0.f};
                    a = __builtin_amdgcn_mfma_f32_16x16x32_bf16(qf[tq][0], k0, a, 0, 0, 0); a = __builtin_amdgcn_mfma_f32_16x16x32_bf16(qf[tq][1], k1, a, 0, 0, 0); sc[tq][tk] = a; } }
            if (loc) {
#pragma unroll
                for (int tq = 0; tq < 4; ++tq)
#pragma unroll
                    for (int tk = 0; tk < 4; ++tk)
#pragma unroll
                        for (int x = 0; x < 4; ++x) { const int dlt = (kpos0 + 16 * tk + r) - (128 * qb + i0 + 16 * tq + 4 * q + x); if (dlt > 128 || dlt < -128) sc[tq][tk][x] = -1e30f; }
            }
#pragma unroll
            for (int tq = 0; tq < 4; ++tq)
#pragma unroll
                for (int x = 0; x < 4; ++x) {
                    float mx = fmaxf(fmaxf(sc[tq][0][x], sc[tq][1][x]), fmaxf(sc[tq][2][x], sc[tq][3][x]));
                    mx = fmaxf(mx, __shfl_xor(mx, 1)); mx = fmaxf(mx, __shfl_xor(mx, 2)); mx = fmaxf(mx, __shfl_xor(mx, 4)); mx = fmaxf(mx, __shfl_xor(mx, 8));
                    const float mn = fmaxf(mrow[tq][x], mx), corr = __expf(mrow[tq][x] - mn);
                    float sum = 0.f;
#pragma unroll
                    for (int tk = 0; tk < 4; ++tk) { const float pe = __expf(sc[tq][tk][x] - mn); sum += pe; Pw[(16 * tq + 4 * q + x) * LDK + 16 * tk + r] = f2bf(pe); }
                    sum += __shfl_xor(sum, 1); sum += __shfl_xor(sum, 2); sum += __shfl_xor(sum, 4); sum += __shfl_xor(sum, 8);
                    lrow[tq][x] = lrow[tq][x] * corr + sum; mrow[tq][x] = mn;
#pragma unroll
                    for (int td = 0; td < 4; ++td) oacc[tq][td][x] *= corr;
                }
            asm volatile("s_waitcnt lgkmcnt(0)" ::: "memory");
#pragma unroll
            for (int td = 0; td < 4; ++td) { const LAS bf16_t* vp = VT + (16 * td + r) * LDK + 8 * q;
                const pg8::bf16x8 v0 = *(const LAS pg8::bf16x8*)vp, v1 = *(const LAS pg8::bf16x8*)(vp + 32);
#pragma unroll
                for (int tq = 0; tq < 4; ++tq) { const LAS bf16_t* pp = Pw + (16 * tq + r) * LDK + 8 * q;
                    oacc[tq][td] = __builtin_amdgcn_mfma_f32_16x16x32_bf16(*(const LAS pg8::bf16x8*)pp, v0, oacc[tq][td], 0, 0, 0);
                    oacc[tq][td] = __builtin_amdgcn_mfma_f32_16x16x32_bf16(*(const LAS pg8::bf16x8*)(pp + 32), v1, oacc[tq][td], 0, 0, 0); } }
        }
#pragma unroll
        for (int tq = 0; tq < 4; ++tq)
#pragma unroll
            for (int x = 0; x < 4; ++x) { const float inv = 1.0f / lrow[tq][x]; bf16_t* o = p.mixb + (size_t)(qrow0 + 16 * tq + 4 * q + x) * D + 512 + hq * 64 + r;
#pragma unroll
                for (int td = 0; td < 4; ++td) o[16 * td] = f2bf(oacc[tq][td][x] * inv); }
    }
}
__device__ __forceinline__ void mf_sconv(const P& p, LAS unsigned char* lds, int il) {
    int tid = threadIdx.x; asm volatile("" : "+v"(tid));
    int bx_ = (int)blockIdx.x, gx_ = (int)gridDim.x; asm volatile("" : "+s"(bx_), "+s"(gx_));
    LAS float* T = (LAS float*)lds;
    const float* sw = p.hy_short_w + il * 3 * 1536; const float* sb = p.hy_short_b + il * 1536;
    constexpr int NT = (NTOK / 64) * (HYW / 64);
    for (int t = bx_; t < NT; t += gx_) {
        const int r0 = (t / (HYW / 64)) * 64, c0 = (t % (HYW / 64)) * 64;
        const int rl = tid >> 3, cs = (tid & 7) * 8, r = r0 + rl; const RowInfo ri = row_info(r);
        float u[3][8];
#pragma unroll
        for (int g = 0; g < 3; ++g) { const int col = g * HYW + c0 + cs; const float4 b0 = *(const float4*)(sb + col), b1 = *(const float4*)(sb + col + 4);
            u[g][0] = b0.x; u[g][1] = b0.y; u[g][2] = b0.z; u[g][3] = b0.w; u[g][4] = b1.x; u[g][5] = b1.y; u[g][6] = b1.z; u[g][7] = b1.w;
#pragma unroll
            for (int j = 0; j < 3; ++j) { const int tt = ri.t + j - 1; if (tt >= 0 && tt < ri.len) { const px_t* px = p.px + (size_t)(ri.base + tt) * PXLD + col; const float* wj = sw + j * 1536 + col;
                const float4 x0 = ld4px(px), x1 = ld4px(px + 4), w0 = *(const float4*)wj, w1 = *(const float4*)(wj + 4);
                u[g][0] += w0.x * x0.x; u[g][1] += w0.y * x0.y; u[g][2] += w0.z * x0.z; u[g][3] += w0.w * x0.w; u[g][4] += w1.x * x1.x; u[g][5] += w1.y * x1.y; u[g][6] += w1.z * x1.z; u[g][7] += w1.w * x1.w; } } }
        float z[8];
#pragma unroll
        for (int k = 0; k < 8; ++k) z[k] = u[2][k] * u[1][k];
        const size_t i = (size_t)r * HYW + c0 + cs;
        *(float4*)(p.x0c + i) = make_float4(u[0][0], u[0][1], u[0][2], u[0][3]); *(float4*)(p.x0c + i + 4) = make_float4(u[0][4], u[0][5], u[0][6], u[0][7]);
        *(float4*)(p.zb + i) = make_float4(z[0], z[1], z[2], z[3]); *(float4*)(p.zb + i + 4) = make_float4(z[4], z[5], z[6], z[7]);
        if (r0 < NLAT) {
            __syncthreads();
#pragma unroll
            for (int k = 0; k < 8; ++k) T[(cs + k) * 65 + rl] = z[k];
            __syncthreads();
            const int cl = tid >> 3, rs = (tid & 7) * 8; const LAS float* src = T + cl * 65 + rs; float* dst = p.zT + (size_t)(c0 + cl) * NLAT + r0 + rs;
            *(float4*)dst = make_float4(src[0], src[1], src[2], src[3]); *(float4*)(dst + 4) = make_float4(src[4], src[5], src[6], src[7]);
        }
    }
}
__device__ __forceinline__ void mf_filter_tiles(const P& p, LAS unsigned char* lds) {
    int tid = threadIdx.x; asm volatile("" : "+v"(tid));
    int bx_ = (int)blockIdx.x, gx_ = (int)gridDim.x; asm volatile("" : "+s"(bx_), "+s"(gx_));
    LAS float* A1 = (LAS float*)lds; LAS float* A2 = A1 + 64 * 65; LAS float* T = A2 + 64 * 65;
    constexpr int RT = (SEQ + CTXL) / 64;
    const int rl = tid >> 3, cs = (tid & 7) * 8;
    constexpr int NLT = 2 * (SEQ / 64), NCT = 2 * (CTXL / 64), NITEM = NLT + NCT * (HYW / 64);
    for (int it = bx_; it < NITEM; it += gx_) {
        int t, ct0, ct1;
        if (it < NLT) { t = (it / (SEQ / 64)) * RT + it % (SEQ / 64); ct0 = 0; ct1 = HYW / 64; }
        else { const int v = it - NLT, tc = v / (HYW / 64); t = (tc / (CTXL / 64)) * RT + SEQ / 64 + tc % (CTXL / 64); ct0 = v % (HYW / 64); ct1 = ct0 + 1; }
        const int i = t / RT, rt = t % RT, q0 = rt * 64, kind = q0 >= SEQ, L = kind ? CTXL : SEQ, q = q0 + rl, pos = kind ? q - SEQ : q;
        const long rr = (long)i * (SEQ + CTXL) + q;
        __syncthreads();
        {
            const float* w1 = p.hy_f_w1 + i * 33 * 64 + cs; const float tt = (float)pos / (float)L, w = 6.283185307179586f * (float)pos / (float)L;
            float acc[8];
#pragma unroll
            for (int k = 0; k < 8; ++k) acc[k] = tt * w1[k];
            for (int bi = 0; bi < 16; ++bi) { const float band = 1e-4f + (float)bi * ((15.0f - 1e-4f) / 15.0f), cc = ROPE_COS(band * w), sn = ROPE_SIN(band * w);
                const float* wc = w1 + (1 + bi) * 64; const float* ws = w1 + (17 + bi) * 64;
#pragma unroll
                for (int k = 0; k < 8; ++k) acc[k] += cc * wc[k] - sn * ws[k]; }
#pragma unroll
            for (int k = 0; k < 8; ++k) A1[rl * 65 + cs + k] = ROPE_SIN(acc[k] + p.hy_f_b1[i * 64 + cs + k]);
        }
        __syncthreads();
        {
            const float* w2 = p.hy_f_w2 + i * 64 * 64 + cs; float acc[8];
#pragma unroll
            for (int k = 0; k < 8; ++k) acc[k] = 0.f;
            for (int kk = 0; kk < 64; ++kk) { const float hv = A1[rl * 65 + kk]; const float4 a = *(const float4*)(w2 + kk * 64), b4 = *(const float4*)(w2 + kk * 64 + 4);
                acc[0] += hv * a.x; acc[1] += hv * a.y; acc[2] += hv * a.z; acc[3] += hv * a.w; acc[4] += hv * b4.x; acc[5] += hv * b4.y; acc[6] += hv * b4.z; acc[7] += hv * b4.w; }
#pragma unroll
            for (int k = 0; k < 8; ++k) A2[rl * 65 + cs + k] = ROPE_SIN(acc[k] + p.hy_f_b2[i * 64 + cs + k]);
        }
        __syncthreads();
        const float lag = fabsf((float)(pos - L / 2)) / (float)(L / 2);
        for (int ct = ct0; ct < ct1; ++ct) {
            const int c0 = ct * 64; const float* w3 = p.hy_f_w3 + (size_t)i * 64 * HYW + c0 + cs;
            float acc[8];
#pragma unroll
            for (int k = 0; k < 8; ++k) acc[k] = 0.f;
            for (int kk = 0; kk < 64; ++kk) { const float hv = A2[rl * 65 + kk]; const float4 a = *(const float4*)(w3 + (size_t)kk * HYW), b4 = *(const float4*)(w3 + (size_t)kk * HYW + 4);
                acc[0] += hv * a.x; acc[1] += hv * a.y; acc[2] += hv * a.z; acc[3] += hv * a.w; acc[4] += hv * b4.x; acc[5] += hv * b4.y; acc[6] += hv * b4.z; acc[7] += hv * b4.w; }
            const float fast = -15.350567286626973f, slow = -3.0701134573253946f;
#pragma unroll
            for (int k = 0; k < 8; ++k) { const float delta = fabsf(fast + (slow - fast) * (float)(c0 + cs + k) / 511.0f); acc[k] *= fexp(-lag * delta) + 0.05f; }
            float* o = p.hraw + rr * HYW + c0 + cs;
            *(float4*)o = make_float4(acc[0], acc[1], acc[2], acc[3]); *(float4*)(o + 4) = make_float4(acc[4], acc[5], acc[6], acc[7]);
            __syncthreads();
#pragma unroll
            for (int k = 0; k < 8; ++k) T[(cs + k) * 65 + rl] = acc[k];
            __syncthreads();
            const int cl = tid >> 3, rs = (tid & 7) * 8; const LAS float* src = T + cl * 65 + rs;
            float v8[8];
#pragma unroll
            for (int k = 0; k < 8; ++k) v8[k] = src[k];
            if (!kind) { float* dst = p.hT + ((size_t)i * HYW + c0 + cl) * SEQ + q0 + rs;
                *(float4*)dst = make_float4(v8[0], v8[1], v8[2], v8[3]); *(float4*)(dst + 4) = make_float4(v8[4], v8[5], v8[6], v8[7]); }
            float sa = 0.f;
#pragma unroll
            for (int k = 0; k < 8; ++k) sa += fabsf(v8[k]);
            sa += __shfl_xor(sa, 1); sa += __shfl_xor(sa, 2); sa += __shfl_xor(sa, 4);
            if ((tid & 7) == 0) p.hpart[(size_t)t * HYW + c0 + cl] = sa;
        }
    }
}
__device__ __forceinline__ void mf_hymix(const P& p, LAS unsigned char* lds, int il) {
    int tid = threadIdx.x; asm volatile("" : "+v"(tid));
    int bx_ = (int)blockIdx.x, gx_ = (int)gridDim.x; asm volatile("" : "+s"(bx_), "+s"(gx_));
    LAS float* T = (LAS float*)lds;
    constexpr int NT = (NLAT / 64) * (HYW / 64);
    for (int t = bx_; t < NT; t += gx_) {
        const int r0 = (t / (HYW / 64)) * 64, c0 = (t % (HYW / 64)) * 64;
        __syncthreads();
        { const int cl = tid >> 3, rs = (tid & 7) * 8; const float* src = p.convT + (size_t)(c0 + cl) * NLAT + r0 + rs; const float4 a = *(const float4*)src, b = *(const float4*)(src + 4);
          LAS float* d = T + cl * 65 + rs; d[0] = a.x; d[1] = a.y; d[2] = a.z; d[3] = a.w; d[4] = b.x; d[5] = b.y; d[6] = b.z; d[7] = b.w; }
        __syncthreads();
        { const int rl = tid >> 3, cs = (tid & 7) * 8; const size_t i = (size_t)(r0 + rl) * HYW + c0 + cs;
          const float4 z0 = *(const float4*)(p.zb + i), z1 = *(const float4*)(p.zb + i + 4), x0 = *(const float4*)(p.x0c + i), x1 = *(const float4*)(p.x0c + i + 4);
          const float4 b0 = *(const float4*)(p.hy_bias + il * HYW + c0 + cs), b1 = *(const float4*)(p.hy_bias + il * HYW + c0 + cs + 4);
          const float zz[8] = {z0.x, z0.y, z0.z, z0.w, z1.x, z1.y, z1.z, z1.w}, xx[8] = {x0.x, x0.y, x0.z, x0.w, x1.x, x1.y, x1.z, x1.w}, bb[8] = {b0.x, b0.y, b0.z, b0.w, b1.x, b1.y, b1.z, b1.w};
          unsigned short o[8];
#pragma unroll
          for (int k = 0; k < 8; ++k) o[k] = f2bf(xx[k] * (T[(cs + k) * 65 + rl] + bb[k] * zz[k]));
          uint4 ov; ov.x = o[0] | ((unsigned)o[1] << 16); ov.y = o[2] | ((unsigned)o[3] << 16); ov.z = o[4] | ((unsigned)o[5] << 16); ov.w = o[6] | ((unsigned)o[7] << 16);
          *(uint4*)(p.mixb + (size_t)(r0 + rl) * D + c0 + cs) = ov; }
    }
}
__device__ __forceinline__ void mf_retout(const P& p, int nrows) {
    int tid = threadIdx.x; asm volatile("" : "+v"(tid));
    int bx_ = (int)blockIdx.x, gx_ = (int)gridDim.x; asm volatile("" : "+s"(bx_), "+s"(gx_));
    const int lane = tid & 63, wave = tid >> 6;
    for (int r = bx_ * 8 + wave; r < nrows; r += gx_ * 8) {
        const float* o0 = p.oret + (size_t)r * 512 + 8 * lane; const float* o1 = p.oret + ((size_t)NTOK + r) * 512 + 8 * lane; const px_t* gp = p.px + (size_t)r * PXLD + 1024 + 8 * lane;
        const float4 a0 = *(const float4*)o0, a1 = *(const float4*)(o0 + 4), b0 = *(const float4*)o1, b1 = *(const float4*)(o1 + 4), g0 = ld4px(gp), g1 = ld4px(gp + 4);
        const float o[8] = {a0.x + b0.x, a0.y + b0.y, a0.z + b0.z, a0.w + b0.w, a1.x + b1.x, a1.y + b1.y, a1.z + b1.z, a1.w + b1.w}, gg[8] = {g0.x, g0.y, g0.z, g0.w, g1.x, g1.y, g1.z, g1.w};
        float ss = 0.f;
#pragma unroll
        for (int k = 0; k < 8; ++k) ss += o[k] * o[k];
        ss += __shfl_xor(ss, 1); ss += __shfl_xor(ss, 2); ss += __shfl_xor(ss, 4); ss += __shfl_xor(ss, 8);
        const float rs = rsqrtf(ss * (1.0f / 128.0f) + EPS);
        unsigned short ob[8];
#pragma unroll
        for (int k = 0; k < 8; ++k) ob[k] = f2bf(o[k] * rs * siluf_(gg[k]));
        uint4 ov; ov.x = ob[0] | ((unsigned)ob[1] << 16); ov.y = ob[2] | ((unsigned)ob[3] << 16); ov.z = ob[4] | ((unsigned)ob[5] << 16); ov.w = ob[6] | ((unsigned)ob[7] << 16);
        *(uint4*)(p.mixb + (size_t)r * D + 8 * lane) = ov;
    }
}
__device__ __forceinline__ void mf_lconv(const P& p, LAS unsigned char* lds, int il) {
    int tid = threadIdx.x; asm volatile("" : "+v"(tid));
    int bx_ = (int)blockIdx.x, gx_ = (int)gridDim.x; asm volatile("" : "+s"(bx_), "+s"(gx_));
    for (int c = bx_; c < HYW; c += gx_) lconv_unit(p, il, c, (LAS CX*)lds, p.zf + (size_t)bx_ * 2 * FFTN, tid, NTHREADS);
}
__device__ __forceinline__ void mf_inproj(const P& p, LAS unsigned char* lds, int layer) {
    const int il = layer >> 1; const bool ab = !(layer & 1);
    pg8::Gemm g{p.hxb, ab ? p.abin_t + (size_t)il * AB_IN * D : p.cdin_t + (size_t)il * CD_IN * D, NTOK, ab ? AB_IN : CD_IN, D, 0};
    int gx_ = (int)gridDim.x, bx_ = (int)blockIdx.x; asm volatile("" : "+s"(gx_), "+s"(bx_));
    pg8::StaticOrder S; S.init(g.M, g.N, gx_, bx_);
    pg8::EpiStoreBf16 E{p.px, PXLD};
    pg8::gemm_phase(lds, g, S, E);
}
__device__ __forceinline__ void mf_outproj(const P& p, LAS unsigned char* lds, int layer, int nrows) {
    const int il = layer >> 1; const bool ab = !(layer & 1);
    pg8::Gemm g{p.mixb, (ab ? p.about_t : p.cdout_t) + (size_t)il * D * D, nrows, D, D, 0};
    int gx_ = (int)gridDim.x, bx_ = (int)blockIdx.x; asm volatile("" : "+s"(gx_), "+s"(bx_));
    pg8::StaticOrder S; S.init(g.M, g.N, gx_, bx_);
    pg8::EpiResid E{p.xa, p.modv + (size_t)layer * 3 * 6 * D + 2 * D};
    pg8::gemm_phase(lds, g, S, E);
}
__device__ __forceinline__ void mf_glu(const P& p, LAS unsigned char* lds, int il) {
    pg8::Gemm g{p.ys5b, p.glu_t + (size_t)il * S5W * S5W, NTOK, S5W, S5W, 0};
    int gx_ = (int)gridDim.x, bx_ = (int)blockIdx.x; asm volatile("" : "+s"(gx_), "+s"(bx_));
    pg8::StaticOrder S; S.init(g.M, g.N, gx_, bx_);
    pg8::EpiGlu E{p.mixb, p.ys5b, p.s5_glu_b + il * S5W};
    pg8::gemm_phase(lds, g, S, E);
}
__device__ __forceinline__ int build_ue(const P& p, LAS unsigned char* lds, int layer) {
    volatile LAS unsigned char* ue = (volatile LAS unsigned char*)(lds + UE_OFF); volatile LAS int* tot = (volatile LAS int*)(lds + MISC_OFF + 16);
    __syncthreads();
    if (threadIdx.x == 0) { const int* cnt = p.cnt + layer * NE; int t = 0;
        for (int e = 0; e < NE; ++e) { const int nt = (cnt[e] + 255) >> 8; for (int q = 0; q < nt; ++q) ue[t + q] = (unsigned char)e; t += nt; }
        *tot = t; }
    __syncthreads();
    return *tot;
}
__device__ __forceinline__ void mf_moe1(const P& p, LAS unsigned char* lds, int layer) {
    const int tiles = build_ue(p, lds, layer);
    int gx_ = (int)gridDim.x, bx_ = (int)blockIdx.x; asm volatile("" : "+s"(gx_), "+s"(bx_));
    pg8::MoeOrder S{tiles * 8, 8, gx_, bx_, (const volatile LAS unsigned char*)(lds + UE_OFF), (const volatile LAS int*)(lds + TOK_OFF)};
    volatile LAS int* tokt = (volatile LAS int*)(lds + TOK_OFF);
    { int tid = threadIdx.x; asm volatile("" : "+v"(tid));
      for (int i = 0; i < TOK_UNITS; ++i) { int pm, pn; if (!S.unit(i, pm, pn)) break;
          for (int t = tid; t < 256; t += NTHREADS) { const int tk = p.slot_tok[pm * 256 + t]; tokt[i * 256 + t] = tk < 0 ? NTOK : tk; } }
      __syncthreads(); }
    pg8::Gemm g{p.hxb, p.wgu_t + (size_t)layer * NE * 2 * DFF * D, tiles * 256, 2 * DFF, D, (size_t)2 * DFF * D * 2};
    pg8::EpiSwiglu E{p.actb, p.b_gu + (size_t)layer * NE * 2 * DFF};
    pg8::gemm_phase<pg8::EpiSwiglu, pg8::MoeOrder, true>(lds, g, S, E);
}
__device__ __forceinline__ void mf_moe2(const P& p, LAS unsigned char* lds, int layer) {
    const int tiles = build_ue(p, lds, layer);
    pg8::Gemm g{p.actb, p.wdn_t + (size_t)layer * NE * D * DFF, tiles * 256, D, DFF, (size_t)D * DFF * 2};
    int gx_ = (int)gridDim.x, bx_ = (int)blockIdx.x; asm volatile("" : "+s"(gx_), "+s"(bx_));
    pg8::MoeOrder S{tiles * 4, 4, gx_, bx_, (const volatile LAS unsigned char*)(lds + UE_OFF), nullptr};
    pg8::EpiDown E{p.yb, p.b_dn + (size_t)layer * NE * D, p.slot_gate};
    pg8::gemm_phase(lds, g, S, E);
}

#define XB_TMO      128
#define XB_XCNT(j)  (256  + 64 * (j))
#define XB_XSUB(j)  (1280 + 64 * (j))
#define XB_XGEN(j)  (2304 + 64 * (j))
#define XB_TOP      3328
#define XB_TOPGEN   3392
#define XCD_BAR_WORDS 3456
#define XB_SPIN_CAP (1u << 18)

__device__ __forceinline__ unsigned xb_ld(unsigned* p)              { return __hip_atomic_load(p, __ATOMIC_RELAXED, __HIP_MEMORY_SCOPE_AGENT); }
__device__ __forceinline__ unsigned xb_add(unsigned* p, unsigned v) { return __hip_atomic_fetch_add(p, v, __ATOMIC_RELAXED, __HIP_MEMORY_SCOPE_AGENT); }
__device__ __forceinline__ unsigned xb_xcc_id() { return (unsigned)__builtin_amdgcn_s_getreg((3 << 11) | 20) & 0xFu; }
#define XB_SPIN(cond, bar) do { unsigned _sp = 0; while (cond) { __builtin_amdgcn_s_sleep(1); \
    if ((++_sp & 255u) == 0u) { if (xb_ld(&(bar)[XB_TMO])) break; if (_sp > XB_SPIN_CAP) { atomicAdd(&(bar)[XB_TMO], 1u); break; } } } } while (0)

struct XcdBarrier { unsigned* bar; unsigned x; volatile LAS unsigned* st; };

__device__ __forceinline__ XcdBarrier xcd_barrier_post(unsigned* bar, volatile LAS unsigned* st) {
    XcdBarrier b; b.bar = bar; b.x = xb_xcc_id(); b.st = st;
    if (threadIdx.x == 0) (void)xb_add(&bar[XB_XCNT(b.x)], 1u);
    return b;
}
__device__ __forceinline__ void xcd_barrier_complete(unsigned* bar, unsigned x, unsigned& nloc, unsigned& nx) {
    const unsigned G = gridDim.x * gridDim.y * gridDim.z;
    unsigned sum, cnt, mine, sp = 0u;
    asm volatile("" : "+s"(x));
    for (;;) {
        sum = 0u; cnt = 0u; mine = 0u;
#pragma unroll
        for (unsigned j = 0; j < 16; ++j) { const unsigned c = xb_ld(&bar[XB_XCNT(j)]); sum += c; cnt += (c > 0u) ? 1u : 0u; mine = (j == x) ? c : mine; }
        if (sum == G) break;
        __builtin_amdgcn_s_sleep(1);
        if ((++sp & 255u) == 0u) { if (xb_ld(&bar[XB_TMO])) break; if (sp > XB_SPIN_CAP) { atomicAdd(&bar[XB_TMO], 1u); break; } }
    }
    nloc = mine > 0u ? mine : 1u; nx = cnt > 0u ? cnt : 1u;
}
__device__ __forceinline__ void xcd_barrier(const XcdBarrier& b) {
    asm volatile("s_waitcnt vmcnt(0)" ::: "memory");
    __syncthreads();
    if (threadIdx.x == 0) {
        unsigned* bar = b.bar; unsigned bx = b.x;
        asm volatile("" : "+s"(bar), "+s"(bx));
        __builtin_amdgcn_s_waitcnt(0);
        unsigned nloc = b.st[0], nx = b.st[1];
        if (nloc == 0u) { xcd_barrier_complete(bar, bx, nloc, nx); b.st[0] = nloc; b.st[1] = nx; }
        const unsigned old = xb_add(&bar[XB_XSUB(bx)], 1u);
        const unsigned gen = old / nloc;
        if (old + 1u == (gen + 1u) * nloc) {
            __builtin_amdgcn_fence(__ATOMIC_RELEASE, "agent");
            asm volatile("s_waitcnt vmcnt(0)" ::: "memory");
            const unsigned og = xb_add(&bar[XB_TOP], 1u);
            const unsigned tg = og / nx;
            if (og + 1u == (tg + 1u) * nx) xb_add(&bar[XB_TOPGEN], 1u);
            else XB_SPIN(xb_ld(&bar[XB_TOPGEN]) == tg, bar);
            __builtin_amdgcn_fence(__ATOMIC_ACQUIRE, "agent");
            xb_add(&bar[XB_XGEN(bx)], 1u);
            asm volatile("s_waitcnt vmcnt(0)" ::: "memory");
        } else {
            XB_SPIN(xb_ld(&bar[XB_XGEN(bx)]) == gen, bar);
            __builtin_amdgcn_fence(__ATOMIC_ACQUIRE, "agent");
            asm volatile("s_waitcnt vmcnt(0)" ::: "memory");
        }
    }
    __syncthreads();
}

typedef const __attribute__((address_space(4))) P* KP;
__global__ void __launch_bounds__(NTHREADS, 2) fwd_kernel(P p_arg) {
    (void)p_arg;
    const KP kp0 = (KP)__builtin_amdgcn_kernarg_segment_ptr();
#define p (*(const P*)({ KP q_ = kp0; asm volatile("" : "+s"(q_)); q_; }))
    extern __shared__ __attribute__((aligned(16))) unsigned char lds_raw[];
    LAS unsigned char* lds = (LAS unsigned char*)lds_raw;
    for (int u = threadIdx.x; u < (LDS_BYTES - MISC_OFF) / 4; u += NTHREADS) ((LAS unsigned*)(lds + MISC_OFF))[u] = 0u;
    __syncthreads();
    XcdBarrier bar = xcd_barrier_post(p.bar, (volatile LAS unsigned*)(lds + MISC_OFF));
    const long gs = (long)gridDim.x * NTHREADS;
#define gt ({ int b_ = (int)blockIdx.x; asm volatile("" : "+s"(b_)); long g_ = (long)b_ * NTHREADS + threadIdx.x; asm volatile("" : "+v"(g_)); g_; })
#define SETUP(S) setup_slot<S>(p, gt, gs); xcd_barrier(bar);
    for (int rep = 0; rep < REP_SETUP; ++rep) {
    setup_slot<0>(p, gt, gs); mf_filter_tiles(p, lds); __syncthreads(); ph_convert_weights(p, lds); xcd_barrier(bar);
    ph_mod2(p, gt, gs); ph_filt4(p, gt, gs); xcd_barrier(bar);
    }
#define SLOT(S) layer_slot<S>(p, layer, gt, gs); xcd_barrier(bar);
#if MFMA_DENSE
#define DENSE_IN  for (int rep = 0; rep < REP_IN; ++rep) { mf_inproj(p, lds, layer); if (layer < 3) convert_deferred(p, lds, layer, 0); xcd_barrier(bar); }
#define DENSE_OUT if (!(layer & 1)) mf_glu(p, lds, layer >> 1); else ph_retout(p, layer < 3 ? NTOK : NLAT, gt, gs); xcd_barrier(bar); \
                  mf_outproj(p, lds, layer, layer < 3 ? NTOK : NLAT); xcd_barrier(bar);
#else
#define DENSE_IN  SLOT(2)
#define DENSE_OUT SLOT(7) SLOT(8)
#endif
#if MFMA_MOE
#define MOE_GEMMS for (int rep = 0; rep < REP_MOE; ++rep) { mf_moe1(p, lds, layer); xcd_barrier(bar); } for (int rep = 0; rep < REP_MOE2; ++rep) { mf_moe2(p, lds, layer); xcd_barrier(bar); }
#else
#define MOE_GEMMS SLOT(14) SLOT(15)
#endif
#define REPF(n) for (int rep_ = 0; rep_ < (n); ++rep_)
#define LAYER(L) { constexpr int layer = L; constexpr bool AB = !(layer & 1); constexpr int il = layer >> 1; constexpr int nrows = layer < 3 ? NTOK : NLAT; \
    REPF(RN) mf_rownorm<0>(p, lds, layer, NTOK, layer - 1); xcd_barrier(bar); DENSE_IN \
    REPF(R3) { if (AB) { mf_s5<false>(p, lds, il); mf_sconv(p, lds, il); } else ph_rope(p, gt, gs); } xcd_barrier(bar); \
    REPF(R4) { if (AB) { mf_lconv(p, lds, il); ph_lconv(p, il, NLAT, NTOK, gt, gs); } else mf_retkv(p, lds, il); } if (AB) ph_s5carry(p, il, gt, gs); xcd_barrier(bar); \
    REPF(R5) { if (AB) { mf_s5<true>(p, lds, il); mf_hymix(p, lds, il); } else mf_swa(p, lds, il, layer < 3); } if (!AB) ph_retcarry(p, il, gt, gs); xcd_barrier(bar); \
    REPF(R6) { if (AB) ph_s5fin(p, il, gt, gs); else mf_reto(p, lds, il); } xcd_barrier(bar); \
    REPF(R7) { if (AB) mf_glu(p, lds, il); else mf_retout(p, nrows); } xcd_barrier(bar); \
    mf_outproj(p, lds, layer, nrows); if (layer < 3) convert_deferred(p, lds, layer, 1); xcd_barrier(bar); \
    mf_rownorm<1>(p, lds, layer, nrows, -1); xcd_barrier(bar); SLOT(12) MOE_GEMMS }
    LAYER(0) LAYER(1) LAYER(2) LAYER(3)
    mf_rownorm<2>(p, lds, 3, NLAT, 3);
#undef gt
#undef p
}

extern "C" void kernel_launch(void* const* d_in, const int* in_sizes, int n_in, void* d_out, int out_size, void* d_ws, size_t ws_size, hipStream_t stream) {
    (void)in_sizes; (void)n_in; (void)out_size;
    const WsMap m = ws_map();
    if (ws_size < m.total) { fprintf(stderr, "workspace too small: %zu < %zu\n", ws_size, m.total); return; }
    P p; memset(&p, 0, sizeof(p)); fill_params(p, d_in, d_out, d_ws);
    static int grid = 0;
    if (!grid) {
        int dev = 0, cus = 0, per_cu = 0;
        (void)hipGetDevice(&dev); (void)hipDeviceGetAttribute(&cus, hipDeviceAttributeMultiprocessorCount, dev);
        if (hipFuncSetAttribute((const void*)fwd_kernel, hipFuncAttributeMaxDynamicSharedMemorySize, LDS_BYTES) != hipSuccess) { fprintf(stderr, "hipFuncSetAttribute failed\n"); grid = -1; return; }
        (void)hipOccupancyMaxActiveBlocksPerMultiprocessor(&per_cu, (const void*)fwd_kernel, NTHREADS, LDS_BYTES);
        if (per_cu < 1) fprintf(stderr, "occupancy query reports %d blocks per CU\n", per_cu);
        grid = cus;
    }
    if (grid <= 0) return;
    (void)hipMemsetAsync(p.bar, 0, XCD_BAR_WORDS * sizeof(unsigned), stream);
    fwd_kernel<<<dim3(grid), dim3(NTHREADS), LDS_BYTES, stream>>>(p);
}
#endif
```

```cpp
#ifndef CPU_SHIM
#include <hip/hip_runtime.h>
#include <cstring>
#include <cstdio>
#include <cstdint>
#define DEV __device__ __forceinline__
#else
#include <cmath>
#include <cstdio>
#include <cstdint>
#include <cstring>
#include <cstdlib>
#define DEV static inline
static inline float rsqrtf(float x) { return 1.0f / sqrtf(x); }
#endif

#ifndef SEQ
#define SEQ 8192
#endif
#ifndef CTXL
#define CTXL 256
#endif
#ifndef N_LAUNCH_MODE
#define N_LAUNCH_MODE 1
#endif
#ifdef CPU_SHIM
#define MFMA_DENSE 0
#define MFMA_MOE 0
#endif
#ifndef R3
#define R3 1
#endif
#ifndef R4
#define R4 1
#endif
#ifndef R5
#define R5 1
#endif
#ifndef R6
#define R6 1
#endif
#ifndef R7
#define R7 1
#endif
#ifndef RG
#define RG 1
#endif
#ifndef RN
#define RN 1
#endif
#ifndef REP_SETUP
#define REP_SETUP 1
#endif
#ifndef REP_MOE
#define REP_MOE 1
#endif
#ifndef REP_MOE2
#define REP_MOE2 1
#endif
#ifndef REP_IN
#define REP_IN 1
#endif
#ifndef REP_RET
#define REP_RET 1
#endif
#ifndef REP_SWA
#define REP_SWA 1
#endif
#ifndef REP_S5
#define REP_S5 1
#endif
#ifndef MFMA_DENSE
#define MFMA_DENSE 1
#endif
#ifndef MFMA_MOE
#define MFMA_MOE 1
#endif
typedef unsigned short bf16_t;
#if MFMA_DENSE
typedef unsigned short px_t;
#else
typedef float px_t;
#endif

constexpr int D = 1024, NLAT = 2 * SEQ, NCTX = 2 * CTXL, NTOK = NLAT + NCTX;
constexpr int HYW = 512, S5W = 512, NG = 32, NP = 64, GH = 16;
constexpr int AB_IN = 2048, CD_IN = 2304, PXLD = 2304;
constexpr int NE = 32, DFF = 1024;
constexpr float EPS = 1e-6f;
constexpr int NSLOT = ((NTOK * 4 + 255) / 256 + NE) * 256;
#ifdef CPU_SHIM
DEV bf16_t f2bf(float f) { unsigned u; memcpy(&u, &f, 4); return (bf16_t)((u + 0x7fffu + ((u >> 16) & 1u)) >> 16); }
DEV float fexp(float x) { return expf(x); }
DEV float frcp(float x) { return 1.0f / x; }
#else
DEV bf16_t f2bf(float f) { const __bf16 b = (__bf16)f; return __builtin_bit_cast(unsigned short, b); }
DEV float fexp(float x) { return __builtin_amdgcn_exp2f(1.4426950408889634f * x); }
DEV float frcp(float x) { return __builtin_amdgcn_rcpf(x); }
#endif
DEV float bf2f(bf16_t b) { const unsigned u = (unsigned)b << 16; float f; memcpy(&f, &u, 4); return f; }
DEV float pxf(float v) { return v; }
DEV float pxf(bf16_t v) { return bf2f(v); }
DEV void pxstore(float* q, float v) { *q = v; }
DEV void pxstore(bf16_t* q, float v) { *q = f2bf(v); }

struct P {
    const float *x, *c, *ctx, *c_ctx, *mod_w, *mod_b, *norm1_g, *norm2_g, *ab_w_in, *ab_w_out, *hy_short_w, *hy_short_b,
        *hy_f_w1, *hy_f_b1, *hy_f_w2, *hy_f_b2, *hy_f_w3, *hy_bias, *s5_lre, *s5_lim, *s5_ldt, *s5_bre, *s5_bim, *s5_cre, *s5_cim,
        *s5_d, *s5_glu_w, *s5_glu_b, *cd_w_in, *cd_w_out, *ret_decay, *swa_sink, *router_w, *router_b, *w_gu, *b_gu, *w_dn, *b_dn, *final_g;
    float* out;
    unsigned* bar;
    float *xa, *modv, *f1, *f2, *hraw, *hsum, *rstd, *hx, *zb, *x0c, *mixin, *s5s, *ys5, *qr, *kr, *oret, *qs, *ks, *topg, *act;
    int* topi;
    px_t* px;
    bf16_t *hxb, *mixb, *ys5b, *xb, *actb, *abin_t, *cdin_t, *about_t, *cdout_t, *glu_t, *wgu_t, *wdn_t;
    bf16_t* yb;
    float *zT, *hT, *modp;
    float *slot_gate, *s5c, *rkv, *rsc, *hpart, *zf, *convT, *yd;
    int *cnt, *pos, *slot_of, *slot_tok;
};

struct RowInfo { int base, len, t, m, kind; };
DEV RowInfo row_info(int r) {
    RowInfo ri;
    if (r < NLAT) { const int b = r / SEQ; ri.base = b * SEQ; ri.len = SEQ; ri.t = r - ri.base; ri.m = b; ri.kind = 0; }
    else { const int rc = r - NLAT, b = rc / CTXL; ri.base = NLAT + b * CTXL; ri.len = CTXL; ri.t = rc - b * CTXL; ri.m = 2; ri.kind = 1; }
    return ri;
}
DEV float sigmoidf_(float x) { return frcp(1.0f + fexp(-x)); }
DEV float siluf_(float x) { return x * sigmoidf_(x); }
DEV float gelu_tanhf_(float x) { const float u = 0.7978845608028654f * (x + 0.044715f * x * x * x); return x * frcp(1.0f + fexp(-2.0f * u)); }

#ifdef CPU_SHIM
#define GSL(i, n) const long _n_##i = (long)(n); for (long i = _n_##i * gt / gs, _hi_##i = _n_##i * (gt + 1) / gs; i < _hi_##i; ++i)
#else
#define GSL(i, n) for (long i = gt; i < (long)(n); i += gs)
#endif

#if MFMA_DENSE
#define MIXST(idx, v) p.mixb[idx] = f2bf(v)
#else
#define MIXST(idx, v) p.mixin[idx] = (v)
#endif
DEV long filt_row0(int i, int kind) { return (long)i * (SEQ + CTXL) + (kind ? SEQ : 0); }

#ifdef CPU_SHIM
#define ROPE_COS(a) cosf(a)
#define ROPE_SIN(a) sinf(a)
#else
#define ROPE_COS(a) __builtin_amdgcn_cosf(__builtin_amdgcn_fractf((a) * 0.15915494309189535f))
#define ROPE_SIN(a) __builtin_amdgcn_sinf(__builtin_amdgcn_fractf((a) * 0.15915494309189535f))
#endif
DEV void ph_init(const P& p, long gt, long gs) {
    GSL(i, (long)NTOK * D) { p.xa[i] = i < (long)NLAT * D ? p.x[i] : p.ctx[i - (long)NLAT * D]; }
    GSL(j, 4 * NE) { p.cnt[j] = 0; }
    GSL(z, D) { p.hxb[(long)NTOK * D + z] = 0; }
}
DEV void ph_mod(const P& p, long gt, long gs) {
    GSL(i, 4L * 6 * D * 8) {
        const int j = (int)(i % (6 * D)), kq = (int)((i / (6 * D)) % 8), l = (int)(i / (6 * D * 8));
        const float* w = p.mod_w + (long)l * D * 6 * D + j;
        float a0 = 0.f, a1 = 0.f, a2 = 0.f;
        for (int k = kq * (D / 8); k < (kq + 1) * (D / 8); ++k) { const float wv = w[(long)k * 6 * D]; a0 += siluf_(p.c[k]) * wv; a1 += siluf_(p.c[D + k]) * wv; a2 += siluf_(p.c_ctx[k]) * wv; }
        float* o = p.modp + ((long)kq * 4 + l) * 3 * 6 * D + j;
        o[0] = a0; o[6 * D] = a1; o[12 * D] = a2;
    }
}
DEV void ph_mod2(const P& p, long gt, long gs) {
    GSL(i, 4L * 3 * 6 * D) {
        const int j = (int)(i % (6 * D)), l = (int)(i / (18 * D));
        float a = p.mod_b[l * 6 * D + j];
#pragma unroll
        for (int kq = 0; kq < 8; ++kq) a += p.modp[(long)kq * 4 * 3 * 6 * D + i];
        p.modv[i] = a;
    }
}
DEV void ph_filt1(const P& p, long gt, long gs) {
    GSL(idx, 2L * (SEQ + CTXL) * 64) {
        const int j = (int)(idx % 64); const long rr = idx / 64; const int i = (int)(rr / (SEQ + CTXL)); const int q = (int)(rr % (SEQ + CTXL));
        const int kind = q >= SEQ, pos = kind ? q - SEQ : q, L = kind ? CTXL : SEQ;
        const float* w1 = p.hy_f_w1 + i * 33 * 64;
        const float t = (float)pos / (float)L, w = 6.283185307179586f * (float)pos / (float)L;
        float acc = t * w1[j];
        for (int bi = 0; bi < 16; ++bi) {
            const float band = 1e-4f + (float)bi * ((15.0f - 1e-4f) / 15.0f);
            acc += ROPE_COS(band * w) * w1[(1 + bi) * 64 + j] - ROPE_SIN(band * w) * w1[(17 + bi) * 64 + j];
        }
        p.f1[idx] = ROPE_SIN(acc + p.hy_f_b1[i * 64 + j]);
    }
}
DEV void ph_filt2(const P& p, long gt, long gs) {
    GSL(idx, 2L * (SEQ + CTXL) * 64) {
        const int j = (int)(idx % 64); const long rr = idx / 64; const int i = (int)(rr / (SEQ + CTXL));
        const float* w2 = p.hy_f_w2 + i * 64 * 64; const float* h1 = p.f1 + rr * 64;
        float acc = 0.f;
        for (int k = 0; k < 64; ++k) acc += h1[k] * w2[k * 64 + j];
        p.f2[idx] = ROPE_SIN(acc + p.hy_f_b2[i * 64 + j]);
    }
}
DEV void ph_filt3(const P& p, long gt, long gs) {
    GSL(idx, 2L * (SEQ + CTXL) * HYW) {
        const int c = (int)(idx % HYW); const long rr = idx / HYW; const int i = (int)(rr / (SEQ + CTXL)); const int q = (int)(rr % (SEQ + CTXL));
        const int kind = q >= SEQ, pos = kind ? q - SEQ : q, L = kind ? CTXL : SEQ;
        const float* w3 = p.hy_f_w3 + (long)i * 64 * HYW; const float* h2 = p.f2 + rr * 64;
        float acc = 0.f;
        for (int k = 0; k < 64; ++k) acc += h2[k] * w3[k * HYW + c];
        const float lag = fabsf((float)(pos - L / 2)) / (float)(L / 2);
        const float fast = -15.350567286626973f, slow = -3.0701134573253946f;
        const float delta = fabsf(fast + (slow - fast) * (float)c / 511.0f);
        const float hv = acc * (expf(-lag * delta) + 0.05f);
        p.hraw[idx] = hv; if (!kind) p.hT[((long)i * HYW + c) * SEQ + pos] = hv;
    }
}
constexpr int FSEG = 64, FNSEG = (SEQ + CTXL) / FSEG;
DEV void ph_filt4a(const P& p, long gt, long gs) {
    GSL(idx, 2L * FNSEG * HYW) {
        const int c = (int)(idx % HYW); const long sg = idx / HYW; const float* h = p.hraw + sg * FSEG * HYW + c;
        float s = 0.f;
        for (int q = 0; q < FSEG; ++q) s += fabsf(h[(long)q * HYW]);
        p.hpart[idx] = s;
    }
}
DEV void ph_filt4(const P& p, long gt, long gs) {
    GSL(idx, 2 * 2 * HYW) {
        const int c = (int)(idx % HYW), kind = (int)((idx / HYW) % 2), i = (int)(idx / (2 * HYW));
        const int s0 = (int)(filt_row0(i, kind) / FSEG), ns = (kind ? CTXL : SEQ) / FSEG;
        float s = 0.f;
        for (int q = 0; q < ns; ++q) s += p.hpart[(long)(s0 + q) * HYW + c];
        p.hsum[idx] = s;
    }
}
DEV void ph_rstd(const P& p, int nrows, long gt, long gs) {
    GSL(r, nrows) {
        const float* xr = p.xa + r * D; float s = 0.f;
        for (int k = 0; k < D; ++k) s += xr[k] * xr[k];
        p.rstd[r] = rsqrtf(s * (1.0f / D) + EPS);
    }
}
DEV void ph_hx(const P& p, int layer, int which, int nrows, long gt, long gs) {
    const float* g = (which ? p.norm2_g : p.norm1_g) + layer * D;
    GSL(i, (long)nrows * D) {
        const int k = (int)(i % D), r = (int)(i / D); const RowInfo ri = row_info(r);
        const float* mv = p.modv + ((long)layer * 3 + ri.m) * 6 * D + which * 3 * D;
        const float v = p.xa[i] * p.rstd[r] * g[k] * (1.0f + mv[D + k]) + mv[k];
        p.hx[i] = v; p.hxb[i] = f2bf(v);
    }
}
DEV void ph_inproj(const P& p, const float* w, int nin, long gt, long gs) {
    GSL(i, (long)NTOK * nin) {
        const int n = (int)(i % nin), r = (int)(i / nin); const float* a = p.hx + (long)r * D; const float* b = w + n;
        float acc = 0.f;
        for (int k = 0; k < D; ++k) acc += a[k] * b[(long)k * nin];
        pxstore(&p.px[(long)r * PXLD + n], acc);
    }
}
DEV void ph_sconv(const P& p, int il, long gt, long gs) {
    const float* sw = p.hy_short_w + il * 3 * 1536; const float* sb = p.hy_short_b + il * 1536;
    GSL(i, (long)NTOK * HYW) {
        const int c = (int)(i % HYW), r = (int)(i / HYW); const RowInfo ri = row_info(r);
        float u[3];
#pragma unroll
        for (int s = 0; s < 3; ++s) {
            const int col = s * HYW + c; float acc = sb[col];
#pragma unroll
            for (int j = 0; j < 3; ++j) { const int tt = ri.t + j - 1; if (tt >= 0 && tt < ri.len) acc += sw[j * 1536 + col] * pxf(p.px[(long)(ri.base + tt) * PXLD + col]); }
            u[s] = acc;
        }
        p.x0c[i] = u[0]; p.zb[i] = u[2] * u[1]; if (r < NLAT) p.zT[(long)c * NLAT + r] = u[2] * u[1];
    }
}
DEV void ph_lconv(const P& p, int il, int r0, int r1, long gt, long gs) {
    GSL(i0, (long)(r1 - r0) * HYW) {
        const long i = i0 + (long)r0 * HYW;
        const int c = (int)(i % HYW), r = (int)(i / HYW); const RowInfo ri = row_info(r);
        const int L = ri.len, t = ri.t;
        const float* h = p.hraw + filt_row0(il, ri.kind) * HYW + c; const float* z = p.zb + (long)ri.base * HYW + c;
        int s0 = t + L / 2 - (L - 1); if (s0 < 0) s0 = 0; int s1 = t + L / 2; if (s1 > L - 1) s1 = L - 1;
        float acc = 0.f;
#pragma unroll 8
        for (int s = s0; s <= s1; ++s) acc += h[(long)(t - s + L / 2) * HYW] * z[(long)s * HYW];
        const float y = acc / p.hsum[(il * 2 + ri.kind) * HYW + c] + p.hy_bias[il * HYW + c] * p.zb[i];
        MIXST((long)r * D + c, p.x0c[i] * y);
    }
}
constexpr int FFTN = 2 * SEQ, FFT_NS = (SEQ == 8192 ? 7 : SEQ == 2048 ? 6 : SEQ == 512 ? 5 : SEQ == 128 ? 4 : -1);
static_assert(FFT_NS > 0 && (1 << (2 * FFT_NS)) == FFTN, "2*SEQ must be a power of 4");
struct CX { float x, y; };
#define PADX(n) ((n) + ((n) >> 5))
constexpr int FFT_ELEMS = FFTN + (FFTN >> 5);
#ifdef CPU_SHIM
#define COS2PI(f) cosf(6.283185307179586f * (f))
#define SIN2PI(f) sinf(6.283185307179586f * (f))
#define FFT_SYNC()
#else
#define COS2PI(f) __builtin_amdgcn_cosf(f)
#define SIN2PI(f) __builtin_amdgcn_sinf(f)
#define FFT_SYNC() __syncthreads()
#endif
template <class XP> DEV CX cx_ld(XP x, int i) { CX r; r.x = x[i].x; r.y = x[i].y; return r; }
template <class XP> DEV void cx_st(XP x, int i, CX v) { x[i].x = v.x; x[i].y = v.y; }
DEV CX cx_add(CX a, CX b) { return CX{a.x + b.x, a.y + b.y}; }
DEV CX cx_sub(CX a, CX b) { return CX{a.x - b.x, a.y - b.y}; }
DEV CX cx_mul(CX a, CX b) { return CX{a.x * b.x - a.y * b.y, a.x * b.y + a.y * b.x}; }
template <class XP> DEV void fft_pass(XP x, int s, bool inv, int tid, int nthr) {
    const int lq = 2 * (FFT_NS - 1 - s), Q = 1 << lq;
    const float invB = 1.0f / (float)(4 * Q);
    for (int t = tid; t < FFTN / 4; t += nthr) {
        const int i = t & (Q - 1), base = ((t >> lq) << (lq + 2)) + i;
        const float f = (float)i * invB, cs = COS2PI(f), sn = SIN2PI(f);
        const CX w1 = CX{cs, inv ? sn : -sn}, w2 = cx_mul(w1, w1), w3 = cx_mul(w2, w1);
        const int i0 = PADX(base), i1 = PADX(base + Q), i2 = PADX(base + 2 * Q), i3 = PADX(base + 3 * Q);
        const CX a = cx_ld(x, i0), b = cx_ld(x, i1), c = cx_ld(x, i2), d = cx_ld(x, i3);
        if (!inv) {
            const CX t0 = cx_add(a, c), t1 = cx_sub(a, c), t2 = cx_add(b, d), bd = cx_sub(b, d), t3 = CX{bd.y, -bd.x};
            cx_st(x, i0, cx_add(t0, t2)); cx_st(x, i1, cx_mul(cx_add(t1, t3), w1)); cx_st(x, i2, cx_mul(cx_sub(t0, t2), w2)); cx_st(x, i3, cx_mul(cx_sub(t1, t3), w3));
        } else {
            const CX y0 = a, y1 = cx_mul(b, w1), y2 = cx_mul(c, w2), y3 = cx_mul(d, w3);
            const CX u0 = cx_add(y0, y2), u1 = cx_sub(y0, y2), u2 = cx_add(y1, y3), yd = cx_sub(y1, y3), u3 = CX{-yd.y, yd.x};
            cx_st(x, i0, cx_add(u0, u2)); cx_st(x, i1, cx_add(u1, u3)); cx_st(x, i2, cx_sub(u0, u2)); cx_st(x, i3, cx_sub(u1, u3));
        }
    }
}
DEV void bfly4(CX& a, CX& b, CX& c, CX& d, CX w1, bool inv, bool tw) {
    const CX w2 = cx_mul(w1, w1), w3 = cx_mul(w2, w1);
    if (!inv) {
        const CX t0 = cx_add(a, c), t1 = cx_sub(a, c), t2 = cx_add(b, d), bd = cx_sub(b, d), t3 = CX{bd.y, -bd.x};
        a = cx_add(t0, t2); b = cx_add(t1, t3); c = cx_sub(t0, t2); d = cx_sub(t1, t3);
        if (tw) { b = cx_mul(b, w1); c = cx_mul(c, w2); d = cx_mul(d, w3); }
    } else {
        CX y1 = b, y2 = c, y3 = d;
        if (tw) { y1 = cx_mul(b, w1); y2 = cx_mul(c, w2); y3 = cx_mul(d, w3); }
        const CX u0 = cx_add(a, y2), u1 = cx_sub(a, y2), u2 = cx_add(y1, y3), yd = cx_sub(y1, y3), u3 = CX{-yd.y, yd.x};
        a = cx_add(u0, u2); b = cx_add(u1, u3); c = cx_sub(u0, u2); d = cx_sub(u1, u3);
    }
}
template <class XP> DEV void fft_pass16(XP x, int s, bool inv, int tid, int nthr) {
    const int lq2 = 2 * (FFT_NS - 2 - s), Q2 = 1 << lq2, Q = 4 * Q2;
    const float invB = 1.0f / (float)(16 * Q2);
    const float sg = inv ? 1.0f : -1.0f;
    const CX c1 = CX{0.9238795325112867f, sg * 0.3826834323650898f}, c2 = CX{0.7071067811865476f, sg * 0.7071067811865476f}, c3 = CX{0.3826834323650898f, sg * 0.9238795325112867f};
    for (int t = tid; t < FFTN / 16; t += nthr) {
        const int i = t & (Q2 - 1), base = ((t >> lq2) << (lq2 + 4)) + i;
        const float f = (float)i * invB, cs = COS2PI(f), sn = SIN2PI(f);
        const CX wA = CX{cs, sg * sn};
        CX wB = cx_mul(wA, wA); wB = cx_mul(wB, wB);
        CX v[4][4];
#pragma unroll
        for (int a = 0; a < 4; ++a)
#pragma unroll
            for (int b = 0; b < 4; ++b) v[a][b] = cx_ld(x, PADX(base + a * Q + b * Q2));
        if (!inv) {
            bfly4(v[0][0], v[1][0], v[2][0], v[3][0], wA, false, true);
            bfly4(v[0][1], v[1][1], v[2][1], v[3][1], cx_mul(wA, c1), false, true);
            bfly4(v[0][2], v[1][2], v[2][2], v[3][2], cx_mul(wA, c2), false, true);
            bfly4(v[0][3], v[1][3], v[2][3], v[3][3], cx_mul(wA, c3), false, true);
#pragma unroll
            for (int r = 0; r < 4; ++r) bfly4(v[r][0], v[r][1], v[r][2], v[r][3], wB, false, true);
        } else {
#pragma unroll
            for (int r = 0; r < 4; ++r) bfly4(v[r][0], v[r][1], v[r][2], v[r][3], wB, true, true);
            bfly4(v[0][0], v[1][0], v[2][0], v[3][0], wA, true, true);
            bfly4(v[0][1], v[1][1], v[2][1], v[3][1], cx_mul(wA, c1), true, true);
            bfly4(v[0][2], v[1][2], v[2][2], v[3][2], cx_mul(wA, c2), true, true);
            bfly4(v[0][3], v[1][3], v[2][3], v[3][3], cx_mul(wA, c3), true, true);
        }
#pragma unroll
        for (int a = 0; a < 4; ++a)
#pragma unroll
            for (int b = 0; b < 4; ++b) cx_st(x, PADX(base + a * Q + b * Q2), v[a][b]);
    }
}
template <class XP> DEV void fft_pass_last(XP x, bool inv, int tid, int nthr) {
    for (int t = tid; t < FFTN / 4; t += nthr) {
        const int base = 4 * t; CX a = cx_ld(x, PADX(base)), b = cx_ld(x, PADX(base + 1)), c = cx_ld(x, PADX(base + 2)), d = cx_ld(x, PADX(base + 3));
        bfly4(a, b, c, d, CX{1.f, 0.f}, inv, false);
        cx_st(x, PADX(base), a); cx_st(x, PADX(base + 1), b); cx_st(x, PADX(base + 2), c); cx_st(x, PADX(base + 3), d);
    }
}
static_assert(FFT_NS % 2 == 1, "pass schedule: (FFT_NS - 1) / 2 radix-16 passes + one radix-4 pass");
template <class XP> DEV void fft_forward(XP x, int tid, int nthr) {
    for (int s = 0; s + 1 < FFT_NS; s += 2) { fft_pass16(x, s, false, tid, nthr); FFT_SYNC(); }
    fft_pass_last(x, false, tid, nthr); FFT_SYNC();
}
template <class XP> DEV void fft_inverse(XP x, int tid, int nthr) {
    fft_pass_last(x, true, tid, nthr); FFT_SYNC();
    for (int s = FFT_NS - 3; s >= 0; s -= 2) { fft_pass16(x, s, true, tid, nthr); FFT_SYNC(); }
}
template <class XP> DEV void lconv_unit(const P& p, int il, int c, XP x, float* zf, int tid, int nthr) {
    constexpr int L = SEQ, N = FFTN;
    const float* zc = p.zT + (long)c * NLAT;
#pragma unroll 8
    for (int n = tid; n < L; n += nthr) { CX v; v.x = zc[n]; v.y = zc[SEQ + n]; cx_st(x, PADX(n), v); }
#pragma unroll 8
    for (int n = L + tid; n < N; n += nthr) cx_st(x, PADX(n), CX{0.f, 0.f});
    FFT_SYNC();
    fft_forward(x, tid, nthr);
    const float* h = p.hT + ((long)il * HYW + c) * SEQ;
#pragma unroll 8
    for (int n = tid; n < L; n += nthr) { const float hv = h[n]; const CX v = cx_ld(x, PADX(n)); zf[2 * n] = v.x; zf[2 * n + 1] = v.y; cx_st(x, PADX(n), CX{hv, 0.f}); }
#pragma unroll 8
    for (int n = L + tid; n < N; n += nthr) { const CX v = cx_ld(x, PADX(n)); zf[2 * n] = v.x; zf[2 * n + 1] = v.y; cx_st(x, PADX(n), CX{0.f, 0.f}); }
    FFT_SYNC();
    fft_forward(x, tid, nthr);
#ifndef CPU_SHIM
    asm volatile("s_waitcnt vmcnt(0)" ::: "memory");
#endif
#pragma unroll 8
    for (int n = tid; n < N; n += nthr) { const CX zv{zf[2 * n], zf[2 * n + 1]}; const CX hv = cx_ld(x, PADX(n)); cx_st(x, PADX(n), cx_mul(hv, zv)); }
    FFT_SYNC();
    fft_inverse(x, tid, nthr);
    const float scale = 1.0f / ((float)N * p.hsum[(il * 2 + 0) * HYW + c]);
    float* o = p.convT + (long)c * NLAT;
#pragma unroll 8
    for (int t = tid; t < L; t += nthr) { const CX v = cx_ld(x, PADX(t + L / 2)); o[t] = v.x * scale; o[L + t] = v.y * scale; }
    FFT_SYNC();
}
#ifdef CPU_SHIM
DEV void ph_lconv_fft(const P& p, int il, long gt, long gs) {
    CX* x = (CX*)malloc(sizeof(CX) * FFT_ELEMS);
    GSL(c, HYW) { lconv_unit(p, il, (int)c, x, p.zf + gt * 2 * FFTN, 0, 1); }
    free(x);
}
#endif
DEV void ph_hymix(const P& p, int il, long gt, long gs) {
    GSL(i, (long)NLAT * HYW) {
        const int c = (int)(i % HYW), r = (int)(i / HYW);
        const float y = p.convT[(long)c * NLAT + r] + p.hy_bias[il * HYW + c] * p.zb[i];
        MIXST((long)r * D + c, p.x0c[i] * y);
    }
}
DEV int scan_row(int dir, int b, int n) {
    if (n < CTXL) return NLAT + b * CTXL + (dir ? CTXL - 1 - n : n);
    const int m = n - CTXL; return b * SEQ + (dir ? SEQ - 1 - m : m);
}
constexpr int S5C = 64, S5NCH = (CTXL + SEQ) / S5C;
struct S5Par { float lbr, lbi; float bbr[GH], bbi[GH]; };
DEV void s5_par(const P& p, int il, int dir, int g, int pp, S5Par& q) {
    const int gi = (il * 2 + dir) * NG + g;
    const float lre = fminf(p.s5_lre[gi * NP + pp], -1e-4f), lim = p.s5_lim[gi * NP + pp], dt = expf(p.s5_ldt[gi]);
    const float mag = expf(lre * dt); q.lbr = mag * cosf(lim * dt); q.lbi = mag * sinf(lim * dt);
    const float nr = q.lbr - 1.0f, ni = q.lbi, den = lre * lre + lim * lim;
    const float fr = (nr * lre + ni * lim) / den, fi = (ni * lre - nr * lim) / den;
#pragma unroll
    for (int h = 0; h < GH; ++h) { const float br = p.s5_bre[((long)gi * NP + pp) * GH + h], bi = p.s5_bim[((long)gi * NP + pp) * GH + h]; q.bbr[h] = fr * br - fi * bi; q.bbi[h] = fr * bi + fi * br; }
}
DEV void ph_s5chunk(const P& p, int il, int fill, long gt, long gs) {
    GSL(i, 2L * 2 * S5NCH * NG * NP) {
        const int pp = (int)(i % NP), g = (int)((i / NP) % NG), ch = (int)((i / (NP * NG)) % S5NCH), b = (int)((i / ((long)NP * NG * S5NCH)) % 2), dir = (int)(i / ((long)NP * NG * S5NCH * 2));
        S5Par q; s5_par(p, il, dir, g, pp, q);
        float* ce = p.s5c + ((((long)dir * 2 + b) * S5NCH + ch) * NG + g) * NP * 2 + pp * 2;
        float sr = 0.f, si = 0.f;
        if (fill) { sr = ce[0]; si = ce[1]; }
        for (int k = 0; k < S5C; ++k) {
            const int row = scan_row(dir, b, ch * S5C + k); const px_t* u = p.px + (long)row * PXLD + 1536 + g * GH;
            float ar = 0.f, ai = 0.f;
#pragma unroll
            for (int h = 0; h < GH; ++h) { ar += q.bbr[h] * pxf(u[h]); ai += q.bbi[h] * pxf(u[h]); }
            const float tr = q.lbr * sr - q.lbi * si + ar, ti = q.lbr * si + q.lbi * sr + ai; sr = tr; si = ti;
            if (fill) { float* o = p.s5s + (((long)dir * NTOK + row) * NG + g) * NP * 2 + pp * 2; o[0] = sr; o[1] = si; }
        }
        if (!fill) { ce[0] = sr; ce[1] = si; }
    }
}
DEV void ph_s5carry(const P& p, int il, long gt, long gs) {
    GSL(i, 2 * 2 * NG * NP) {
        const int pp = (int)(i % NP), g = (int)((i / NP) % NG), b = (int)((i / (NP * NG)) % 2), dir = (int)(i / (NP * NG * 2));
        S5Par q; s5_par(p, il, dir, g, pp, q);
        float pr = q.lbr, pi = q.lbi;
#pragma unroll
        for (int t = 0; t < 6; ++t) { const float nr = pr * pr - pi * pi, ni = 2.0f * pr * pi; pr = nr; pi = ni; }
        float cr = 0.f, ci = 0.f;
        float* ce0 = p.s5c + ((((long)dir * 2 + b) * S5NCH) * NG + g) * NP * 2 + pp * 2;
        constexpr int CB = 12;
        for (int c0 = 0; c0 < S5NCH; c0 += CB) {
            float er[CB], ei[CB];
#pragma unroll
            for (int j = 0; j < CB; ++j) if (c0 + j < S5NCH) { const float* ce = ce0 + (long)(c0 + j) * NG * NP * 2; er[j] = ce[0]; ei[j] = ce[1]; }
#pragma unroll
            for (int j = 0; j < CB; ++j) if (c0 + j < S5NCH) { float* ce = ce0 + (long)(c0 + j) * NG * NP * 2; ce[0] = cr; ce[1] = ci;
                const float tr = pr * cr - pi * ci + er[j], ti = pr * ci + pi * cr + ei[j]; cr = tr; ci = ti; }
        }
    }
}
DEV void ph_s5out(const P& p, int il, long gt, long gs) {
    GSL(i, (long)NTOK * S5W) {
        const int ch = (int)(i % S5W), r = (int)(i / S5W), g = ch / GH, h = ch % GH;
        float y = p.s5_d[il * S5W + ch] * pxf(p.px[(long)r * PXLD + 1536 + ch]);
        for (int dir = 0; dir < 2; ++dir) {
            const long ci = (((long)(il * 2 + dir) * NG + g) * GH + h) * NP;
            const float* s = p.s5s + (((long)dir * NTOK + r) * NG + g) * NP * 2;
            for (int pp = 0; pp < NP; ++pp) y += p.s5_cre[ci + pp] * s[pp * 2] - p.s5_cim[ci + pp] * s[pp * 2 + 1];
        }
        { const float gy = gelu_tanhf_(y); p.ys5[i] = gy; p.ys5b[i] = f2bf(gy); }
    }
}
DEV void ph_s5fin(const P& p, int il, long gt, long gs) {
    GSL(i, (long)NTOK * S5W) {
        const int ch = (int)(i % S5W), r = (int)(i / S5W);
        const float y = p.s5_d[il * S5W + ch] * pxf(p.px[(long)r * PXLD + 1536 + ch]) + p.yd[i] + p.yd[(long)NTOK * S5W + i];
        const float gy = gelu_tanhf_(y); p.ys5b[i] = f2bf(gy);
#ifdef CPU_SHIM
        p.ys5[i] = gy;
#endif
    }
}
DEV void ph_glu(const P& p, int il, long gt, long gs) {
    const float* w = p.s5_glu_w + (long)il * S5W * S5W;
    GSL(i, (long)NTOK * S5W) {
        const int ch = (int)(i % S5W), r = (int)(i / S5W); const float* a = p.ys5 + (long)r * S5W;
        float acc = p.s5_glu_b[il * S5W + ch];
        for (int k = 0; k < S5W; ++k) acc += a[k] * w[(long)k * S5W + ch];
        MIXST((long)r * D + HYW + ch, a[ch] * sigmoidf_(acc));
    }
}
DEV void ph_rope(const P& p, long gt, long gs) {
    GSL(i, (long)NTOK * 576) {
        const int it = (int)(i % 576), r = (int)(i / 576); const RowInfo ri = row_info(r); const px_t* pr = p.px + (long)r * PXLD;
        if (it < 256) {
            const int isk = it >= 128, hd = it & 127, h = hd >> 5, d = hd & 31;
            const px_t* src = pr + (isk ? 256 : 0) + h * 64; float x1 = pxf(src[d]), x2 = pxf(src[d + 32]);
            if (ri.kind == 0) { const float inv = exp2f(-(float)d * (13.287712379549449f / 32.0f)), ang = (float)ri.t * inv, cs = ROPE_COS(ang), sn = ROPE_SIN(ang);
                const float y1 = x1 * cs - x2 * sn, y2 = x1 * sn + x2 * cs; x1 = y1; x2 = y2; }
            const float sc = isk ? 1.0f : 0.125f;
            float* dst = (isk ? p.kr : p.qr) + (long)r * 256 + h * 64; dst[d] = x1 * sc; dst[d + 32] = x2 * sc;
        } else {
            const int j = it - 256, isk = j >= 256, hd = isk ? j - 256 : j, h = hd >> 5, e = hd & 31, half = e >> 4, d = e & 15;
            const px_t* src = pr + (isk ? 2048 : 1536) + h * 64 + half * 32; float x1 = pxf(src[d]), x2 = pxf(src[d + 16]);
            if (ri.kind == 0) { const float pos = (float)(half ? (ri.t % 64) : (ri.t / 64)); const float inv = exp2f(-(float)d * (13.287712379549449f / 16.0f)), ang = pos * inv, cs = ROPE_COS(ang), sn = ROPE_SIN(ang);
                const float y1 = x1 * cs - x2 * sn, y2 = x1 * sn + x2 * cs; x1 = y1; x2 = y2; }
            const float sc = isk ? 1.0f : 0.125f;
            float* dst = (isk ? p.ks + (long)r * 128 : p.qs + (long)r * 512) + h * 64 + half * 32; dst[d] = x1 * sc; dst[d + 16] = x2 * sc;
        }
    }
}
constexpr int RC = 128, RNCH = (CTXL + SEQ) / RC;
DEV float ret_logg(const P& p, int il, int dir, int h) { const float dl = p.ret_decay[(il * 2 + dir) * 4 + h]; return -log1pf(expf(-dl)); }
DEV void ph_retkv(const P& p, int il, long gt, long gs) {
    GSL(i, 2L * 2 * RNCH * 4 * 64 * 128) {
        const int e = (int)(i % 128), d = (int)((i / 128) % 64), h = (int)((i / 8192) % 4), n = (int)((i / 32768) % RNCH), b = (int)((i / (32768L * RNCH)) % 2), dir = (int)(i / (32768L * RNCH * 2));
        const float lg = ret_logg(p, il, dir, h);
        float acc = 0.f;
        for (int j = 0; j < RC; ++j) { const int row = scan_row(dir, b, n * RC + j);
            acc += expf((float)(RC - 1 - j) * lg) * p.kr[(long)row * 256 + h * 64 + d] * pxf(p.px[(long)row * PXLD + 512 + h * 128 + e]); }
        p.rkv[i] = acc;
    }
}
DEV void ph_retcarry(const P& p, int il, long gt, long gs) {
    GSL(i, 2L * 2 * 4 * 64 * 128) {
        const int de = (int)(i % 8192), h = (int)((i / 8192) % 4), b = (int)((i / 32768) % 2), dir = (int)(i / 65536);
        const float gc = expf((float)RC * ret_logg(p, il, dir, h));
        float S = 0.f;
        float* q0 = p.rkv + ((((long)dir * 2 + b) * RNCH) * 4 + h) * 8192 + de;
        constexpr int CB = 11;
        for (int n0 = 0; n0 < RNCH; n0 += CB) {
            float kv[CB];
#pragma unroll
            for (int j = 0; j < CB; ++j) if (n0 + j < RNCH) kv[j] = q0[(long)(n0 + j) * 4 * 8192];
#pragma unroll
            for (int j = 0; j < CB; ++j) if (n0 + j < RNCH) { q0[(long)(n0 + j) * 4 * 8192] = S; S = gc * S + kv[j]; }
        }
    }
}
DEV void ph_retsc(const P& p, int il, long gt, long gs) {
    GSL(i, 2L * NTOK * 4 * RC) {
        const int j = (int)(i % RC), h = (int)((i / RC) % 4), r = (int)((i / (RC * 4)) % NTOK), dir = (int)(i / ((long)RC * 4 * NTOK)); const RowInfo ri = row_info(r);
        const int b = ri.kind ? (ri.base - NLAT) / CTXL : ri.base / SEQ;
        const int step = ri.kind ? (dir ? CTXL - 1 - ri.t : ri.t) : CTXL + (dir ? SEQ - 1 - ri.t : ri.t), ii = step % RC, n = step / RC;
        float sc = 0.f;
        if (j <= ii) { const int rj = scan_row(dir, b, n * RC + j); const float* q = p.qr + (long)r * 256 + h * 64; const float* k = p.kr + (long)rj * 256 + h * 64;
            float dot = 0.f;
            for (int d = 0; d < 64; ++d) dot += q[d] * k[d];
            sc = dot * expf((float)(ii - j) * ret_logg(p, il, dir, h)); }
        p.rsc[i] = sc;
    }
}
DEV void ph_reto(const P& p, int il, long gt, long gs) {
    GSL(i, 2L * NTOK * 512) {
        const int e = (int)(i % 128), h = (int)((i / 128) % 4), r = (int)((i / 512) % NTOK), dir = (int)(i / (512L * NTOK)); const RowInfo ri = row_info(r);
        const int b = ri.kind ? (ri.base - NLAT) / CTXL : ri.base / SEQ;
        const int step = ri.kind ? (dir ? CTXL - 1 - ri.t : ri.t) : CTXL + (dir ? SEQ - 1 - ri.t : ri.t), ii = step % RC, n = step / RC;
        const float* sc = p.rsc + (((long)dir * NTOK + r) * 4 + h) * RC;
        float acc = 0.f;
        for (int j = 0; j <= ii; ++j) { const int rj = scan_row(dir, b, n * RC + j); acc += sc[j] * pxf(p.px[(long)rj * PXLD + 512 + h * 128 + e]); }
        const float* S = p.rkv + ((((long)dir * 2 + b) * RNCH + n) * 4 + h) * 8192 + e; const float* q = p.qr + (long)r * 256 + h * 64;
        float cr = 0.f;
        for (int d = 0; d < 64; ++d) cr += q[d] * S[d * 128];
        p.oret[((long)dir * NTOK + r) * 512 + h * 128 + e] = acc + cr * expf((float)(ii + 1) * ret_logg(p, il, dir, h));
    }
}
DEV void ph_retout(const P& p, int nrows, long gt, long gs) {
    GSL(i, (long)nrows * 4) {
        const int h = (int)(i % 4), r = (int)(i / 4);
        const float* o0 = p.oret + (long)r * 512 + h * 128; const float* o1 = p.oret + ((long)NTOK + r) * 512 + h * 128;
        float ss = 0.f;
        for (int e = 0; e < 128; ++e) { const float o = o0[e] + o1[e]; ss += o * o; }
        const float rs = rsqrtf(ss * (1.0f / 128.0f) + EPS);
        for (int e = 0; e < 128; ++e) MIXST((long)r * D + h * 128 + e, (o0[e] + o1[e]) * rs * siluf_(pxf(p.px[(long)r * PXLD + 1024 + h * 128 + e])));
    }
}
DEV void ph_swa(const P& p, int il, int nrows, long gt, long gs) {
    GSL(i, (long)nrows * 8) {
        const int hq = (int)(i % 8), r = (int)(i / 8), kv = hq >> 2; const RowInfo ri = row_info(r);
        const int b = ri.kind ? (ri.base - NLAT) / CTXL : ri.base / SEQ;
        float q[64], acc[64];
#pragma unroll
        for (int d = 0; d < 64; ++d) { q[d] = p.qs[(long)r * 512 + hq * 64 + d]; acc[d] = 0.f; }
        float m = p.swa_sink[il * 8 + hq], l = 1.0f;
        for (int part = 0; part < 2; ++part) {
            int k0, k1;
            if (part == 0) { if (ri.kind) continue; k0 = ri.base + (ri.t - 128 < 0 ? 0 : ri.t - 128); k1 = ri.base + (ri.t + 128 > SEQ - 1 ? SEQ - 1 : ri.t + 128); }
            else { k0 = NLAT + b * CTXL; k1 = k0 + CTXL - 1; }
            for (int kr = k0; kr <= k1; ++kr) {
                const float* kk = p.ks + (long)kr * 128 + kv * 64; const px_t* vv = p.px + (long)kr * PXLD + 2176 + kv * 64;
                float s = 0.f;
#pragma unroll
                for (int d = 0; d < 64; ++d) s += q[d] * kk[d];
                const float mn = fmaxf(m, s), corr = expf(m - mn), pe = expf(s - mn);
                l = l * corr + pe; m = mn;
#pragma unroll
                for (int d = 0; d < 64; ++d) acc[d] = acc[d] * corr + pe * pxf(vv[d]);
            }
        }
        const float il_ = 1.0f / l;
#pragma unroll
        for (int d = 0; d < 64; ++d) MIXST((long)r * D + 512 + hq * 64 + d, acc[d] * il_);
    }
}
DEV void ph_outproj(const P& p, int layer, const float* w, int nrows, long gt, long gs) {
    GSL(i, (long)nrows * D) {
        const int n = (int)(i % D), r = (int)(i / D); const RowInfo ri = row_info(r);
        const float* a = p.mixin + (long)r * D; const float* b = w + n;
        float acc = 0.f;
        for (int k = 0; k < D; ++k) acc += a[k] * b[(long)k * D];
        p.xa[i] += p.modv[((long)layer * 3 + ri.m) * 6 * D + 2 * D + n] * acc;
    }
}
DEV int atomic_inc(int* q) {
#ifdef CPU_SHIM
    return __atomic_fetch_add(q, 1, __ATOMIC_RELAXED);
#else
    return atomicAdd(q, 1);
#endif
}
DEV void ph_router(const P& p, int layer, int nrows, long gt, long gs) {
    const float* rw = p.router_w + (long)layer * D * NE;
    GSL(j, NSLOT) { p.slot_tok[j] = -1; p.slot_gate[j] = 0.f; }
    GSL(r, nrows) {
        float lg[NE];
#pragma unroll
        for (int e = 0; e < NE; ++e) lg[e] = p.router_b[layer * NE + e];
        const float* a = p.hx + (long)r * D;
        for (int k = 0; k < D; ++k) { const float av = a[k];
#pragma unroll
            for (int e = 0; e < NE; ++e) lg[e] += av * rw[k * NE + e]; }
        int ti[4]; float tv[4];
#pragma unroll
        for (int s = 0; s < 4; ++s) { int best = 0; float bv = -3.0e38f;
#pragma unroll
            for (int e = 0; e < NE; ++e) { if (lg[e] > bv) { bv = lg[e]; best = e; } }
            ti[s] = best; tv[s] = bv;
#pragma unroll
            for (int e = 0; e < NE; ++e) if (e == best) lg[e] = -3.0e38f; }
        const float e1 = expf(tv[1] - tv[0]), e2 = expf(tv[2] - tv[0]), e3 = expf(tv[3] - tv[0]), inv = 1.0f / (1.0f + e1 + e2 + e3);
        p.topi[r * 4 + 0] = ti[0]; p.topi[r * 4 + 1] = ti[1]; p.topi[r * 4 + 2] = ti[2]; p.topi[r * 4 + 3] = ti[3];
        p.topg[r * 4 + 0] = inv; p.topg[r * 4 + 1] = e1 * inv; p.topg[r * 4 + 2] = e2 * inv; p.topg[r * 4 + 3] = e3 * inv;
#pragma unroll
        for (int s = 0; s < 4; ++s) p.pos[r * 4 + s] = atomic_inc(p.cnt + layer * NE + ti[s]);
    }
}
DEV int moe_tiles(const int* cnt) { int t = 0; for (int e = 0; e < NE; ++e) t += (cnt[e] + 255) >> 8; return t; }
DEV int tile_expert(const int* cnt, int pm) { int t = 0; for (int e = 0; e < NE; ++e) { t += (cnt[e] + 255) >> 8; if (pm < t) return e; } return NE - 1; }
DEV void ph_assign(const P& p, int layer, int nrows, long gt, long gs) {
    const int* cnt = p.cnt + layer * NE;
    GSL(i, (long)nrows * 4) {
        const int e = p.topi[i]; int off = 0;
        for (int q = 0; q < e; ++q) off += ((cnt[q] + 255) >> 8) << 8;
        const int slot = off + p.pos[i];
        p.slot_of[i] = slot; p.slot_tok[slot] = (int)(i >> 2); p.slot_gate[slot] = p.topg[i];
    }
}
DEV void ph_gather(const P& p, int layer, long gt, long gs) {
    const long used = (long)moe_tiles(p.cnt + layer * NE) * 256;
    GSL(i, used * D) { const int k = (int)(i % D); const long slot = i / D; const int tok = p.slot_tok[slot]; p.xb[i] = tok >= 0 ? p.hxb[(long)tok * D + k] : (bf16_t)0; }
}
DEV void ph_moe1s(const P& p, int layer, long gt, long gs) {
    const int* cnt = p.cnt + layer * NE; const long used = (long)moe_tiles(cnt) * 256;
    GSL(i, used * DFF) {
        const int j = (int)(i % DFF); const long slot = i / DFF; const int e = tile_expert(cnt, (int)(slot >> 8));
        const float* w = p.w_gu + ((long)layer * NE + e) * D * 2 * DFF + j; const bf16_t* a = p.xb + slot * D;
        const float* bb = p.b_gu + ((long)layer * NE + e) * 2 * DFF;
        float ga = bb[j], up = bb[DFF + j];
        for (int k = 0; k < D; ++k) { const float av = bf2f(a[k]); ga += av * w[(long)k * 2 * DFF]; up += av * w[(long)k * 2 * DFF + DFF]; }
        ga = fminf(ga, 7.0f); up = fminf(fmaxf(up, -7.0f), 7.0f);
        p.actb[i] = f2bf(ga * sigmoidf_(1.702f * ga) * (up + 1.0f));
    }
}
DEV void ph_moe2s(const P& p, int layer, long gt, long gs) {
    const int* cnt = p.cnt + layer * NE; const long used = (long)moe_tiles(cnt) * 256;
    GSL(i, used * D) {
        const int n = (int)(i % D); const long slot = i / D; const int e = tile_expert(cnt, (int)(slot >> 8));
        const float* w = p.w_dn + ((long)layer * NE + e) * DFF * D + n; const bf16_t* a = p.actb + slot * DFF;
        float acc = p.b_dn[((long)layer * NE + e) * D + n];
        for (int k = 0; k < DFF; ++k) acc += bf2f(a[k]) * w[(long)k * D];
        p.yb[i] = f2bf(acc * p.slot_gate[slot]);
    }
}
DEV void ph_combine(const P& p, int layer, int nrows, long gt, long gs) {
    GSL(i, (long)nrows * D) {
        const int n = (int)(i % D), r = (int)(i / D); const RowInfo ri = row_info(r);
        float y = 0.f;
#pragma unroll
        for (int s = 0; s < 4; ++s) y += bf2f(p.yb[(long)p.slot_of[r * 4 + s] * D + n]);
        p.xa[i] += p.modv[((long)layer * 3 + ri.m) * 6 * D + 5 * D + n] * y;
    }
}
DEV void ph_final(const P& p, long gt, long gs) {
    GSL(i, (long)NLAT * D) { const int k = (int)(i % D), r = (int)(i / D); p.out[i] = p.xa[i] * p.rstd[r] * p.final_g[k]; }
}

constexpr int N_SETUP = 6, N_SLOT = 18;
#ifdef CPU_SHIM
#define SWA_NAIVE ph_swa(p, il, nrows, gt, gs);
#define S5_NAIVE(x) x
#define S5_FIN ph_s5out(p, il, gt, gs);
#define RET_NAIVE_A ph_retkv(p, il, gt, gs); ph_retsc(p, il, gt, gs);
#define RET_NAIVE_C ph_reto(p, il, gt, gs);
#else
#define SWA_NAIVE
#define S5_NAIVE(x)
#define S5_FIN ph_s5fin(p, il, gt, gs);
#define RET_NAIVE_A
#define RET_NAIVE_C
#endif
#ifdef CPU_SHIM
#define LCONV_LAT(p, il, gt, gs) ph_lconv_fft(p, il, gt, gs)
#else
#define LCONV_LAT(p, il, gt, gs)
#endif
template <int S> DEV void setup_slot(const P& p, long gt, long gs) {
    if constexpr (S == 0) { ph_init(p, gt, gs); ph_mod(p, gt, gs); }
    if constexpr (S == 1) { ph_mod2(p, gt, gs); ph_filt1(p, gt, gs); }
    if constexpr (S == 2) ph_filt2(p, gt, gs);
    if constexpr (S == 3) ph_filt3(p, gt, gs);
    if constexpr (S == 4) ph_filt4a(p, gt, gs);
    if constexpr (S == 5) ph_filt4(p, gt, gs);
}
template <int S> DEV void layer_slot(const P& p, int layer, long gt, long gs) {
    const int il = layer >> 1; const bool ab = !(layer & 1);
    const int nrows = layer < 3 ? NTOK : NLAT;
    if constexpr (S == 0) ph_rstd(p, NTOK, gt, gs);
    if constexpr (S == 1) ph_hx(p, layer, 0, NTOK, gt, gs);
    if constexpr (S == 2) { if (ab) ph_inproj(p, p.ab_w_in + (long)il * D * AB_IN, AB_IN, gt, gs); else ph_inproj(p, p.cd_w_in + (long)il * D * CD_IN, CD_IN, gt, gs); }
    if constexpr (S == 3) { if (ab) { ph_sconv(p, il, gt, gs); S5_NAIVE(ph_s5chunk(p, il, 0, gt, gs);) } else ph_rope(p, gt, gs); }
    if constexpr (S == 4) { if (ab) { LCONV_LAT(p, il, gt, gs); ph_lconv(p, il, NLAT, NTOK, gt, gs); ph_s5carry(p, il, gt, gs); } else { RET_NAIVE_A } }
    if constexpr (S == 5) { if (ab) { ph_hymix(p, il, gt, gs); S5_NAIVE(ph_s5chunk(p, il, 1, gt, gs);) } else { ph_retcarry(p, il, gt, gs); SWA_NAIVE } }
    if constexpr (S == 6) { if (ab) { S5_FIN } else { RET_NAIVE_C } }
    if constexpr (S == 7) { if (ab) ph_glu(p, il, gt, gs); else ph_retout(p, nrows, gt, gs); }
    if constexpr (S == 8) ph_outproj(p, layer, (ab ? p.ab_w_out : p.cd_w_out) + (long)il * D * D, nrows, gt, gs);
    if constexpr (S == 9) ph_rstd(p, nrows, gt, gs);
    if constexpr (S == 10) ph_hx(p, layer, 1, nrows, gt, gs);
    if constexpr (S == 11) ph_router(p, layer, nrows, gt, gs);
    if constexpr (S == 12) ph_assign(p, layer, nrows, gt, gs);
    if constexpr (S == 13) ph_gather(p, layer, gt, gs);
    if constexpr (S == 14) ph_moe1s(p, layer, gt, gs);
    if constexpr (S == 15) ph_moe2s(p, layer, gt, gs);
    if constexpr (S == 16) ph_combine(p, layer, nrows, gt, gs);
}
template <int S> DEV void final_slot(const P& p, long gt, long gs) {
    if constexpr (S == 0) ph_rstd(p, NLAT, gt, gs);
    if constexpr (S == 1) ph_final(p, gt, gs);
}

struct WsMap { size_t off[56]; size_t total; };
static inline WsMap ws_map() {
    WsMap m; size_t o = 0; int n = 0;
    auto take = [&](size_t bytes) { m.off[n++] = o; o += (bytes + 255) & ~(size_t)255; };
    take(16384);
    take((size_t)NTOK * D * 4);
    take((size_t)4 * 3 * 6 * D * 4);
    take((size_t)2 * (SEQ + CTXL) * 64 * 4);
    take((size_t)2 * (SEQ + CTXL) * 64 * 4);
    take((size_t)2 * (SEQ + CTXL) * HYW * 4);
    take((size_t)2 * 2 * HYW * 4);
    take((size_t)NTOK * 4);
    take((size_t)NTOK * D * 4);
    take((size_t)NTOK * PXLD * 4);
    take((size_t)NTOK * HYW * 4);
    take((size_t)NTOK * HYW * 4);
    take((size_t)NTOK * D * 4);
    take((size_t)2 * NTOK * NG * NP * 2 * 4);
    take((size_t)NTOK * S5W * 4);
    take((size_t)NTOK * 256 * 4);
    take((size_t)NTOK * 256 * 4);
    take((size_t)2 * NTOK * 512 * 4);
    take((size_t)NTOK * 512 * 4);
    take((size_t)NTOK * 128 * 4);
    take((size_t)NTOK * 4 * 4);
    take((size_t)NTOK * 4 * 4);
    take(256);
    take((size_t)(NTOK + 1) * D * 2);
    take((size_t)NTOK * D * 2);
    take((size_t)NTOK * S5W * 2);
    take((size_t)NSLOT * D * 2);
    take((size_t)NSLOT * DFF * 2);
    take((size_t)NSLOT * D * 4);
    take((size_t)NSLOT * 4);
    take((size_t)4 * NE * 4);
    take((size_t)NTOK * 4 * 4);
    take((size_t)NTOK * 4 * 4);
    take((size_t)NSLOT * 4);
    take((size_t)2 * AB_IN * D * 2);
    take((size_t)2 * CD_IN * D * 2);
    take((size_t)2 * D * D * 2);
    take((size_t)2 * D * D * 2);
    take((size_t)2 * S5W * S5W * 2);
    take((size_t)4 * NE * 2 * DFF * D * 2);
    take((size_t)4 * NE * D * DFF * 2);
    take((size_t)2 * 2 * S5NCH * NG * NP * 2 * 4);
    take((size_t)2 * 2 * RNCH * 4 * 8192 * 4);
    take((size_t)2 * NTOK * 4 * RC * 4);
    take((size_t)2 * FNSEG * HYW * 4);
    take((size_t)256 * 2 * FFTN * 4);
    take((size_t)HYW * NLAT * 4);
    take((size_t)2 * NTOK * S5W * 4);
    take((size_t)HYW * NLAT * 4);
    take((size_t)2 * HYW * SEQ * 4);
    take((size_t)8 * 4 * 3 * 6 * D * 4);
    m.total = o; return m;
}
static inline void fill_params(P& p, void* const* d_in, void* d_out, void* d_ws) {
    const float* const* in = (const float* const*)d_in;
    p.x = in[0]; p.c = in[1]; p.ctx = in[2]; p.c_ctx = in[3]; p.mod_w = in[4]; p.mod_b = in[5]; p.norm1_g = in[6]; p.norm2_g = in[7];
    p.ab_w_in = in[8]; p.ab_w_out = in[9]; p.hy_short_w = in[10]; p.hy_short_b = in[11]; p.hy_f_w1 = in[12]; p.hy_f_b1 = in[13];
    p.hy_f_w2 = in[14]; p.hy_f_b2 = in[15]; p.hy_f_w3 = in[16]; p.hy_bias = in[17]; p.s5_lre = in[18]; p.s5_lim = in[19]; p.s5_ldt = in[20];
    p.s5_bre = in[21]; p.s5_bim = in[22]; p.s5_cre = in[23]; p.s5_cim = in[24]; p.s5_d = in[25]; p.s5_glu_w = in[26]; p.s5_glu_b = in[27];
    p.cd_w_in = in[28]; p.cd_w_out = in[29]; p.ret_decay = in[30]; p.swa_sink = in[31]; p.router_w = in[32]; p.router_b = in[33];
    p.w_gu = in[34]; p.b_gu = in[35]; p.w_dn = in[36]; p.b_dn = in[37]; p.final_g = in[38];
    p.out = (float*)d_out;
    const WsMap m = ws_map(); char* w = (char*)d_ws;
    p.bar = (unsigned*)(w + m.off[0]); p.xa = (float*)(w + m.off[1]); p.modv = (float*)(w + m.off[2]); p.f1 = (float*)(w + m.off[3]); p.f2 = (float*)(w + m.off[4]);
    p.hraw = (float*)(w + m.off[5]); p.hsum = (float*)(w + m.off[6]); p.rstd = (float*)(w + m.off[7]); p.hx = (float*)(w + m.off[8]); p.px = (px_t*)(w + m.off[9]);
    p.zb = (float*)(w + m.off[10]); p.x0c = (float*)(w + m.off[11]); p.mixin = (float*)(w + m.off[12]); p.s5s = (float*)(w + m.off[13]); p.ys5 = (float*)(w + m.off[14]);
    p.qr = (float*)(w + m.off[15]); p.kr = (float*)(w + m.off[16]); p.oret = (float*)(w + m.off[17]); p.qs = (float*)(w + m.off[18]); p.ks = (float*)(w + m.off[19]);
    p.topg = (float*)(w + m.off[20]); p.topi = (int*)(w + m.off[21]); p.act = nullptr;
    p.hxb = (bf16_t*)(w + m.off[23]); p.mixb = (bf16_t*)(w + m.off[24]); p.ys5b = (bf16_t*)(w + m.off[25]); p.xb = (bf16_t*)(w + m.off[26]); p.actb = (bf16_t*)(w + m.off[27]);
    p.yb = (bf16_t*)(w + m.off[28]); p.slot_gate = (float*)(w + m.off[29]); p.cnt = (int*)(w + m.off[30]); p.pos = (int*)(w + m.off[31]); p.slot_of = (int*)(w + m.off[32]);
    p.slot_tok = (int*)(w + m.off[33]); p.abin_t = (bf16_t*)(w + m.off[34]); p.cdin_t = (bf16_t*)(w + m.off[35]); p.about_t = (bf16_t*)(w + m.off[36]);
    p.cdout_t = (bf16_t*)(w + m.off[37]); p.glu_t = (bf16_t*)(w + m.off[38]); p.wgu_t = (bf16_t*)(w + m.off[39]); p.wdn_t = (bf16_t*)(w + m.off[40]);
    p.s5c = (float*)(w + m.off[41]); p.rkv = (float*)(w + m.off[42]); p.rsc = (float*)(w + m.off[43]); p.hpart = (float*)(w + m.off[44]);
    p.zf = (float*)(w + m.off[45]); p.convT = (float*)(w + m.off[46]); p.yd = (float*)(w + m.off[47]); p.zT = (float*)(w + m.off[48]); p.hT = (float*)(w + m.off[49]); p.modp = (float*)(w + m.off[50]);
}

#ifndef CPU_SHIM
namespace pg8 {
#define PG8_LAS __attribute__((address_space(3)))
typedef short bf16x8 __attribute__((ext_vector_type(8)));
typedef float f32x4 __attribute__((ext_vector_type(4)));
constexpr int BM = 256, BK = 64, HALF = 128, HTB = HALF * BK * 2, STAGE_BYTES = 8 * HTB, NXCD = 8, WGM = 8;
__host__ __device__ __forceinline__ int lds_byte(int r, int c) { const int st = (r >> 4) * 2 + (c >> 5), rr = r & 15, cc = c & 31, ob = rr * 64 + cc * 2; return st * 1024 + (ob ^ (((ob >> 9) & 1) << 5)); }
__host__ __device__ __forceinline__ void stage_rc(int b, int& R, int& C) { const int st = b / 1024, sb = b % 1024, swz = sb ^ (((sb >> 9) & 1) << 5); R = (st >> 1) * 16 + swz / 64; C = (st & 1) * 32 + (swz % 64) / 2; }
struct Unit { int pm, pn, e; };
struct Gemm { const bf16_t* A; const bf16_t* Bt; int M, N, K; size_t ebytes; };
struct StaticOrder {
    int nM, nN, nwg, G, c;
    __device__ void init(int M, int N, int G_, int c_) { nM = M / BM; nN = N / BM; nwg = nM * nN; G = G_; c = c_; }
    __device__ bool next(int i, Unit& u) const {
        const long L = (long)i * G + c; if (L >= nwg) return false;
        int wgid = (int)L; { const int q = nwg / NXCD, r = nwg % NXCD, xcd = wgid % NXCD, off = wgid / NXCD; wgid = (xcd < r ? xcd * (q + 1) : r * (q + 1) + (xcd - r) * q) + off; }
        const int nig = WGM * nN, gid = wgid / nig, fm = gid * WGM, gsz = (nM - fm) < WGM ? (nM - fm) : WGM;
        u.pm = fm + ((wgid % nig) % gsz); u.pn = (wgid % nig) / gsz; u.e = 0; return true;
    }
    __device__ int tok(int, int) const { return 0; }
};
struct MoeOrder {
    int nwg, nN, G, c; const volatile PG8_LAS unsigned char* ue; const volatile PG8_LAS int* tokt;
    __device__ int tok(int ui, int row) const { return tokt[ui * 256 + row]; }
    __device__ bool unit(int i, int& pm, int& pn) const {
        const int S = G >> 3;
        if ((G & 7) == 0 && S % nN == 0) { const int x = c & 7, slot = c >> 3, pmx = S / nN, T = nwg / nN, tpx = (T + 7) >> 3, lp = i * pmx + slot / nN;
            pm = x * tpx + lp; pn = slot % nN; return lp < tpx && pm < T; }
        const long L = (long)i * G + c; pm = (int)(L / nN); pn = (int)(L % nN); return L < nwg;
    }
    __device__ bool next(int i, Unit& u) const {
        int pm, pn; if (!unit(i, pm, pn)) return false;
        u.pm = pm; u.pn = pn; u.e = __builtin_amdgcn_readfirstlane((int)ue[pm]); return true;
    }
};
template <class Epi, class Sched, bool GATHER = false>
__device__ __forceinline__ void gemm_phase(PG8_LAS unsigned char* lds, const Gemm g, const Sched& S, const Epi& E) {
    int tid = threadIdx.x; asm volatile("" : "+v"(tid));
    const int wid = __builtin_amdgcn_readfirstlane(tid >> 6), lane = tid & 63, wr = wid >> 2, wc = wid & 3, fr = lane & 15, fq = lane >> 4;
    const int K = g.K, nt = K / BK;
    unsigned va[2][2], vn[2][2], voffB[2]; int Rr[2]; unsigned Cb[2];
#pragma unroll
    for (int i = 0; i < 2; ++i) { int R, C; stage_rc(tid * 16 + i * 8192, R, C); Rr[i] = R; Cb[i] = (unsigned)C * 2u; voffB[i] = (unsigned)(R * K + C) * 2u; }
    const size_t kstep = (size_t)(BK * 2);
    const size_t hstep = (size_t)HALF * K * 2;
    const size_t tstep = 2 * hstep;
#define PG8_SETOFF(v, ui_) do { _Pragma("unroll") for (int h_ = 0; h_ < 2; ++h_) _Pragma("unroll") for (int i_ = 0; i_ < 2; ++i_) \
        v[h_][i_] = GATHER ? (unsigned)S.tok(ui_, h_ * HALF + Rr[i_]) * (unsigned)(K * 2) + Cb[i_] : voffB[i_] + (unsigned)(h_ * hstep); } while (0)
    const unsigned ldsw = (unsigned)wid * 1024u;
    const int aoff = lds_byte(wr * 64 + fr, fq * 8), boff = lds_byte(wc * 32 + fr, fq * 8);
#define PG8_SA(b, h) (((b) * 2 + (h)) * HTB)
#define PG8_SB(b, h) ((4 + (b) * 2 + (h)) * HTB)
#define PG8_STAGE(bufoff, gbase, voff) do { _Pragma("unroll") for (int _i = 0; _i < 2; ++_i) \
        __builtin_amdgcn_global_load_lds((const unsigned*)((const char*)(gbase) + (voff)[_i]), (PG8_LAS unsigned*)(lds + (bufoff) + ldsw + _i * 8192), 16, 0, 0); } while (0)
#define PG8_LDA(dst, b, h) do { _Pragma("unroll") for (int m = 0; m < 4; ++m) _Pragma("unroll") for (int k = 0; k < 2; ++k) dst[m][k] = *(const PG8_LAS bf16x8*)(lds + PG8_SA(b, h) + aoff + m * 2048 + k * 1024); } while (0)
#define PG8_LDB(dst, b, h) do { _Pragma("unroll") for (int n = 0; n < 2; ++n) _Pragma("unroll") for (int k = 0; k < 2; ++k) dst[n][k] = *(const PG8_LAS bf16x8*)(lds + PG8_SB(b, h) + boff + n * 2048 + k * 1024); } while (0)
#define PG8_MMA(ai, bj, At, Bt) do { __builtin_amdgcn_s_setprio(1); _Pragma("unroll") for (int m = 0; m < 4; ++m) _Pragma("unroll") for (int n = 0; n < 2; ++n) _Pragma("unroll") for (int k = 0; k < 2; ++k) \
        acc[ai][bj][m][n] = __builtin_amdgcn_mfma_f32_16x16x32_bf16(Bt[n][k], At[m][k], acc[ai][bj][m][n], 0, 0, 0); __builtin_amdgcn_s_setprio(0); } while (0)
#define PG8_WAIT_V(n) asm volatile("s_waitcnt vmcnt(" #n ")" ::: "memory")
#define PG8_WAIT_L(n) asm volatile("s_waitcnt lgkmcnt(" #n ")" ::: "memory")
#define PG8_BAR __builtin_amdgcn_s_barrier()
#define PG8_SCHED __builtin_amdgcn_sched_barrier(0)
    Unit cur, nxt; int ui = 0;
    if (!S.next(0, cur)) return;
    f32x4 acc[2][2][4][2];
#pragma unroll
    for (int a = 0; a < 2; ++a)
#pragma unroll
        for (int b = 0; b < 2; ++b)
#pragma unroll
            for (int m = 0; m < 4; ++m)
#pragma unroll
                for (int n = 0; n < 2; ++n) acc[a][b][m][n] = (f32x4){0.f, 0.f, 0.f, 0.f};
    bf16x8 At[4][2], B0[2][2], B1[2][2];
    const char* cA = (const char*)g.A + (GATHER ? (size_t)0 : (size_t)cur.pm * tstep); const char* cB = (const char*)g.Bt + (size_t)cur.e * g.ebytes + (size_t)cur.pn * tstep;
    PG8_SETOFF(va, 0);
    PG8_STAGE(PG8_SB(0, 0), cB, voffB); PG8_STAGE(PG8_SB(0, 1), cB + hstep, voffB); PG8_STAGE(PG8_SA(0, 0), cA, va[0]); PG8_STAGE(PG8_SA(0, 1), cA, va[1]);
    if (wr == 1) PG8_BAR;
    PG8_WAIT_V(2); PG8_BAR;
    PG8_STAGE(PG8_SB(1, 0), cB + kstep, voffB); PG8_STAGE(PG8_SA(1, 0), cA + kstep, va[0]); PG8_STAGE(PG8_SB(1, 1), cB + hstep + kstep, voffB);
    PG8_WAIT_V(6); PG8_BAR;
    for (;;) {
        const bool has_next = S.next(ui + 1, nxt);
        const char* nA = has_next ? (const char*)g.A + (GATHER ? (size_t)0 : (size_t)nxt.pm * tstep) : cA; const char* nB = has_next ? (const char*)g.Bt + (size_t)nxt.e * g.ebytes + (size_t)nxt.pn * tstep : cB;
        if (GATHER && has_next) PG8_SETOFF(vn, ui + 1); else { _Pragma("unroll") for (int h_ = 0; h_ < 2; ++h_) _Pragma("unroll") for (int i_ = 0; i_ < 2; ++i_) vn[h_][i_] = va[h_][i_]; }
        for (int t = 0; t < nt; t += 2) {
            const bool last = (t == nt - 2);
            const char* a1 = cA + (size_t)(t + 1) * kstep;
            const char* a2 = last ? nA : cA + (size_t)(t + 2) * kstep; const char* b2 = last ? nB : cB + (size_t)(t + 2) * kstep;
            const char* a3 = a2 + kstep; const char* b3 = b2 + kstep;
            unsigned s0[2], s1[2];
#pragma unroll
            for (int i_ = 0; i_ < 2; ++i_) { s0[i_] = last ? vn[0][i_] : va[0][i_]; s1[i_] = last ? vn[1][i_] : va[1][i_]; }
            PG8_LDB(B0, 0, 0); PG8_LDB(B1, 0, 1); PG8_SCHED; PG8_LDA(At, 0, 0); PG8_STAGE(PG8_SA(1, 1), a1, va[1]);
            PG8_WAIT_V(8); PG8_WAIT_L(0); PG8_BAR; PG8_MMA(0, 0, At, B0); PG8_MMA(0, 1, At, B1); PG8_BAR; PG8_SCHED;
            PG8_LDA(At, 0, 1); PG8_STAGE(PG8_SB(0, 0), b2, voffB); PG8_STAGE(PG8_SB(0, 1), b2 + hstep, voffB); PG8_STAGE(PG8_SA(0, 0), a2, s0);
            PG8_WAIT_V(8); PG8_WAIT_L(0); PG8_BAR; PG8_MMA(1, 0, At, B0); PG8_MMA(1, 1, At, B1); PG8_BAR; PG8_SCHED;
            PG8_LDB(B0, 1, 0); PG8_LDB(B1, 1, 1); PG8_SCHED; PG8_LDA(At, 1, 0); PG8_STAGE(PG8_SA(0, 1), a2, s1);
            PG8_WAIT_V(8); PG8_WAIT_L(0); PG8_BAR; PG8_MMA(0, 0, At, B0); PG8_MMA(0, 1, At, B1); PG8_BAR; PG8_SCHED;
            PG8_LDA(At, 1, 1); PG8_STAGE(PG8_SB(1, 0), b3, voffB); PG8_STAGE(PG8_SB(1, 1), b3 + hstep, voffB); PG8_STAGE(PG8_SA(1, 0), a3, s0);
            PG8_WAIT_V(8); PG8_WAIT_L(0); PG8_BAR; PG8_MMA(1, 0, At, B0); PG8_MMA(1, 1, At, B1); PG8_BAR; PG8_SCHED;
        }
        if (wr == 0) PG8_BAR;
        E(acc, cur, wr, wc, fr, fq);
        if (!has_next) break;
#pragma unroll
        for (int a = 0; a < 2; ++a)
#pragma unroll
            for (int b = 0; b < 2; ++b)
#pragma unroll
                for (int m = 0; m < 4; ++m)
#pragma unroll
                    for (int n = 0; n < 2; ++n) acc[a][b][m][n] = (f32x4){0.f, 0.f, 0.f, 0.f};
        cur = nxt; cA = nA; cB = nB; ++ui;
#pragma unroll
        for (int h_ = 0; h_ < 2; ++h_)
#pragma unroll
            for (int i_ = 0; i_ < 2; ++i_) va[h_][i_] = vn[h_][i_];
        if (wr == 1) PG8_BAR;
    }
    PG8_WAIT_V(0);
    PG8_BAR;
#undef PG8_SA
#undef PG8_SB
#undef PG8_STAGE
#undef PG8_SETOFF
#undef PG8_LDA
#undef PG8_LDB
#undef PG8_MMA
#undef PG8_WAIT_V
#undef PG8_WAIT_L
#undef PG8_BAR
#undef PG8_SCHED
}
typedef float f32x2v __attribute__((ext_vector_type(2)));
typedef __bf16 bf16x2v __attribute__((ext_vector_type(2)));
__device__ __forceinline__ unsigned cvt_pk_bf16(float lo, float hi) { const bf16x2v r = __builtin_convertvector((f32x2v){lo, hi}, bf16x2v); return __builtin_bit_cast(unsigned, r); }
__device__ __forceinline__ float fast_sigmoid(float x) { return __builtin_amdgcn_rcpf(1.0f + __builtin_amdgcn_exp2f(-1.4426950408889634f * x)); }
#define EPI_LOOP(body) _Pragma("unroll") for (int ai = 0; ai < 2; ++ai) _Pragma("unroll") for (int m = 0; m < 4; ++m) { const int row = row0 + ai * HALF + m * 16; \
    _Pragma("unroll") for (int bj = 0; bj < 2; ++bj) _Pragma("unroll") for (int n = 0; n < 2; ++n) { const int col = col0 + bj * HALF + n * 16; const f32x4 a = acc[ai][bj][m][n]; body } }
struct EpiStoreF32 {
    float* C; int ldc;
    __device__ __forceinline__ void operator()(const f32x4 (&acc)[2][2][4][2], const Unit& u, int wr, int wc, int fr, int fq) const {
        const int row0 = u.pm * BM + wr * 64 + fr, col0 = u.pn * BM + wc * 32 + 4 * fq;
        EPI_LOOP( *(f32x4*)(C + (size_t)row * ldc + col) = a; )
    }
};
struct EpiStoreBf16 {
    bf16_t* C; int ldc;
    __device__ __forceinline__ void operator()(const f32x4 (&acc)[2][2][4][2], const Unit& u, int wr, int wc, int fr, int fq) const {
        const int row0 = u.pm * BM + wr * 64 + fr, col0 = u.pn * BM + wc * 32 + 4 * fq;
        EPI_LOOP( uint2 o; o.x = cvt_pk_bf16(a[0], a[1]); o.y = cvt_pk_bf16(a[2], a[3]); *(uint2*)(C + (size_t)row * ldc + col) = o; )
    }
};
struct EpiResid {
    float* X; const float* gv;
    __device__ __forceinline__ void operator()(const f32x4 (&acc)[2][2][4][2], const Unit& u, int wr, int wc, int fr, int fq) const {
        const int row0 = u.pm * BM + wr * 64 + fr, col0 = u.pn * BM + wc * 32 + 4 * fq;
        const int r0 = u.pm * BM, mrow = r0 < SEQ ? 0 : (r0 < NLAT ? 1 : 2); const float* g = gv + (size_t)mrow * 6 * D;
        EPI_LOOP( const f32x4 gg = *(const f32x4*)(g + col); f32x4* q = (f32x4*)(X + (size_t)row * D + col); *q = *q + gg * a; )
    }
};
struct EpiGlu {
    bf16_t* O; const bf16_t* Y; const float* bias;
    __device__ __forceinline__ void operator()(const f32x4 (&acc)[2][2][4][2], const Unit& u, int wr, int wc, int fr, int fq) const {
        const int row0 = u.pm * BM + wr * 64 + fr, col0 = u.pn * BM + wc * 32 + 4 * fq;
        EPI_LOOP( const f32x4 bb = *(const f32x4*)(bias + col); const ushort4 yv = *(const ushort4*)(Y + (size_t)row * S5W + col);
            uint2 o; o.x = cvt_pk_bf16(bf2f(yv.x) * fast_sigmoid(a[0] + bb[0]), bf2f(yv.y) * fast_sigmoid(a[1] + bb[1])); o.y = cvt_pk_bf16(bf2f(yv.z) * fast_sigmoid(a[2] + bb[2]), bf2f(yv.w) * fast_sigmoid(a[3] + bb[3]));
            *(uint2*)(O + (size_t)row * D + HYW + col) = o; )
    }
};
struct EpiSwiglu {
    bf16_t* O; const float* bgu;
    __device__ __forceinline__ void operator()(const f32x4 (&acc)[2][2][4][2], const Unit& u, int wr, int wc, int fr, int fq) const {
        const int row0 = u.pm * BM + wr * 64 + fr, colb = wc * 32 + 4 * fq; const float* bb = bgu + (size_t)u.e * 2 * DFF + u.pn * 128;
#pragma unroll
        for (int ai = 0; ai < 2; ++ai)
#pragma unroll
            for (int m = 0; m < 4; ++m) { const int row = row0 + ai * HALF + m * 16;
#pragma unroll
                for (int n = 0; n < 2; ++n) { const int cc = colb + n * 16; const f32x4 bg = *(const f32x4*)(bb + cc), bu = *(const f32x4*)(bb + DFF + cc);
                    const f32x4 ga = acc[ai][0][m][n] + bg, up = acc[ai][1][m][n] + bu; float av[4];
#pragma unroll
                    for (int j = 0; j < 4; ++j) { const float gg = fminf(ga[j], 7.0f), uu = fminf(fmaxf(up[j], -7.0f), 7.0f); av[j] = gg * fast_sigmoid(1.702f * gg) * (uu + 1.0f); }
                    uint2 o; o.x = cvt_pk_bf16(av[0], av[1]); o.y = cvt_pk_bf16(av[2], av[3]);
                    *(uint2*)(O + (size_t)row * DFF + u.pn * 128 + cc) = o; } }
    }
};
struct EpiDown {
    bf16_t* Y; const float* bdn; const float* gate;
    __device__ __forceinline__ void operator()(const f32x4 (&acc)[2][2][4][2], const Unit& u, int wr, int wc, int fr, int fq) const {
        const int row0 = u.pm * BM + wr * 64 + fr, col0 = u.pn * BM + wc * 32 + 4 * fq; const float* bb = bdn + (size_t)u.e * D;
        EPI_LOOP( const f32x4 bv = *(const f32x4*)(bb + col); const float gt_ = gate[row]; const f32x4 o = (a + bv) * gt_; uint2 ob; ob.x = cvt_pk_bf16(o[0], o[1]); ob.y = cvt_pk_bf16(o[2], o[3]); *(uint2*)(Y + (size_t)row * D + col) = ob; )
    }
};
}

constexpr int RING_BYTES = 131072, SCRATCH_BYTES = 135168, MISC_OFF = SCRATCH_BYTES, UE_OFF = MISC_OFF + 64, TOK_OFF = UE_OFF + 320, TOK_UNITS = 11, LDS_BYTES = 147456;
static_assert(FFT_ELEMS * 8 <= SCRATCH_BYTES && TOK_OFF + TOK_UNITS * 1024 <= LDS_BYTES && ((NSLOT / 256 + 7) / 8 + 3) / 4 <= TOK_UNITS, "LDS map");
#define LAS __attribute__((address_space(3)))

__device__ __forceinline__ void transpose_item(const float* W, int K, int N, bf16_t* WT, int gu_perm, LAS float* scr, int item, int lane) {
    const int nblk = N / 32, kb = item / nblk, nb = item % nblk, k0 = 64 * kb, n0 = 32 * nb;
    const int r0 = gu_perm ? (n0 < DFF ? (n0 / 128) * 256 + (n0 % 128) : ((n0 - DFF) / 128) * 256 + 128 + ((n0 - DFF) % 128)) : n0;
#pragma unroll 8
    for (int i = 0; i < 32; ++i) { const int kk = 2 * i + (lane >> 5); scr[kk * 33 + (lane & 31)] = W[(size_t)(k0 + kk) * N + n0 + (lane & 31)]; }
    asm volatile("s_waitcnt lgkmcnt(0)" ::: "memory");
    const int c = lane & 7;
#pragma unroll
    for (int j = 0; j < 4; ++j) { const int n = (lane >> 3) + 8 * j; const LAS float* s = scr + (8 * c) * 33 + n;
        uint4 o; o.x = f2bf(s[0 * 33]) | ((unsigned)f2bf(s[1 * 33]) << 16); o.y = f2bf(s[2 * 33]) | ((unsigned)f2bf(s[3 * 33]) << 16);
        o.z = f2bf(s[4 * 33]) | ((unsigned)f2bf(s[5 * 33]) << 16); o.w = f2bf(s[6 * 33]) | ((unsigned)f2bf(s[7 * 33]) << 16);
        *(uint4*)(WT + (size_t)(r0 + n) * K + k0 + 8 * c) = o; }
    asm volatile("s_waitcnt lgkmcnt(0)" ::: "memory");
}
constexpr int I_GU = (D / 64) * (2 * DFF / 32), I_DN = (DFF / 64) * (D / 32), EXP_ITEMS = NE * (I_GU + I_DN);
__device__ __forceinline__ void convert_expert_item(const P& p, int l, int q, LAS float* scr, int lane) {
    if (q < NE * I_GU) { const int e = q / I_GU; const size_t i = (size_t)l * NE + e; transpose_item(p.w_gu + i * D * 2 * DFF, D, 2 * DFF, p.wgu_t + i * 2 * DFF * D, 1, scr, q % I_GU, lane); }
    else { const int q2 = q - NE * I_GU, e = q2 / I_DN; const size_t i = (size_t)l * NE + e; transpose_item(p.w_dn + i * DFF * D, DFF, D, p.wdn_t + i * D * DFF, 0, scr, q2 % I_DN, lane); }
}
constexpr int DEFER_Q1 = 64, DEFER_Q2 = 140;
__device__ __forceinline__ int defer_idle(int units, int G) { const int rem = units % G; return rem ? G - rem : 0; }
__device__ __forceinline__ int defer_in_units(int layer) { return (NTOK / 256) * ((layer & 1) ? CD_IN / 256 : AB_IN / 256); }
__device__ __forceinline__ int defer_d1(int layer, int G) { const int n = defer_idle(defer_in_units(layer), G) * DEFER_Q1; return n < EXP_ITEMS ? n : EXP_ITEMS; }
__device__ __forceinline__ int defer_d2(int layer, int G) { const int d1 = defer_d1(layer, G), n = d1 + defer_idle((NTOK / 256) * (D / 256), G) * DEFER_Q2; return n < EXP_ITEMS ? n : EXP_ITEMS; }
__device__ __forceinline__ void convert_deferred(const P& p, LAS unsigned char* lds, int layer, int which) {
    int tid = threadIdx.x; asm volatile("" : "+v"(tid));
    int bx_ = (int)blockIdx.x, gx_ = (int)gridDim.x; asm volatile("" : "+s"(bx_), "+s"(gx_));
    const int units = which ? (NTOK / 256) * (D / 256) : defer_in_units(layer), rem = units % gx_;
    if (rem == 0 || bx_ < rem) return;
    const int lane = tid & 63, wave = tid >> 6; LAS float* scr = (LAS float*)(lds + wave * 16384);
    const int qn = which ? DEFER_Q2 : DEFER_Q1, q0 = (which ? defer_d1(layer, gx_) : 0) + (bx_ - rem) * qn, qend = which ? defer_d2(layer, gx_) : defer_d1(layer, gx_);
    for (int q = q0 + wave; q < q0 + qn && q < qend; q += 8) convert_expert_item(p, layer + 1, q, scr, lane);
}
__device__ __forceinline__ void ph_convert_weights(const P& p, LAS unsigned char* lds) {
    int tid = threadIdx.x; asm volatile("" : "+v"(tid));
    const int lane = tid & 63, wave = tid >> 6;
    LAS float* scr = (LAS float*)(lds + wave * 16384);
    const long gw = (long)blockIdx.x * 8 + wave, NGW = (long)gridDim.x * 8; const int G = (int)gridDim.x;
    constexpr long I_ABIN = (D / 64) * (AB_IN / 32), I_CDIN = (D / 64) * (CD_IN / 32), I_OUT = (D / 64) * (D / 32), I_GLU = (S5W / 64) * (S5W / 32);
    constexpr long T0 = 2 * I_ABIN, T1 = T0 + 2 * I_CDIN, T2 = T1 + 2 * I_OUT, T3 = T2 + 2 * I_OUT, T4 = T3 + 2 * I_GLU;
    for (long it = gw; it < T4; it += NGW) {
        if (it < T0) { const int i = (int)(it / I_ABIN); transpose_item(p.ab_w_in + (size_t)i * D * AB_IN, D, AB_IN, p.abin_t + (size_t)i * AB_IN * D, 0, scr, (int)(it % I_ABIN), lane); }
        else if (it < T1) { const long r = it - T0; const int i = (int)(r / I_CDIN); transpose_item(p.cd_w_in + (size_t)i * D * CD_IN, D, CD_IN, p.cdin_t + (size_t)i * CD_IN * D, 0, scr, (int)(r % I_CDIN), lane); }
        else if (it < T2) { const long r = it - T1; const int i = (int)(r / I_OUT); transpose_item(p.ab_w_out + (size_t)i * D * D, D, D, p.about_t + (size_t)i * D * D, 0, scr, (int)(r % I_OUT), lane); }
        else if (it < T3) { const long r = it - T2; const int i = (int)(r / I_OUT); transpose_item(p.cd_w_out + (size_t)i * D * D, D, D, p.cdout_t + (size_t)i * D * D, 0, scr, (int)(r % I_OUT), lane); }
        else { const long r = it - T3; const int i = (int)(r / I_GLU); transpose_item(p.s5_glu_w + (size_t)i * S5W * S5W, S5W, S5W, p.glu_t + (size_t)i * S5W * S5W, 0, scr, (int)(r % I_GLU), lane); }
    }
    for (int l = 0; l < 4; ++l) { const int qs = l ? defer_d2(l - 1, G) : 0;
        for (long q = qs + gw; q < EXP_ITEMS; q += NGW) convert_expert_item(p, l, (int)q, scr, lane); }
}
constexpr int NTHREADS = 512;
__device__ __forceinline__ float wave_sum(float v) {
#pragma unroll
    for (int o = 1; o < 64; o <<= 1) v += __shfl_xor(v, o);
    return v;
}
template <int MODE> __device__ __forceinline__ void mf_rownorm(const P& p, LAS unsigned char* lds, int layer, int nrows, int comb_layer) {
    constexpr bool ROUTE = MODE == 1; constexpr int which = MODE == 1 ? 1 : 0;
    int tid = threadIdx.x; asm volatile("" : "+v"(tid));
    int bx_ = (int)blockIdx.x, gx_ = (int)gridDim.x; asm volatile("" : "+s"(bx_), "+s"(gx_));
    const int lane = tid & 63, wave = tid >> 6;
    if (ROUTE) { for (int j = bx_ * NTHREADS + tid; j < NSLOT; j += gx_ * NTHREADS) { p.slot_tok[j] = -1; p.slot_gate[j] = 0.f; } }
    const float* gn = MODE == 2 ? p.final_g : (which ? p.norm2_g : p.norm1_g) + layer * D;
    LAS float* Wl = (LAS float*)lds;
    if (ROUTE) { const float* rw = p.router_w + (size_t)layer * D * NE;
        for (int i = tid; i < D * NE / 4; i += NTHREADS) { const float4 w4 = *(const float4*)(rw + 4 * i); *(LAS pg8::f32x4*)(Wl + 4 * i) = (pg8::f32x4){w4.x, w4.y, w4.z, w4.w}; }
        __syncthreads(); }
    volatile LAS int* lcnt = (volatile LAS int*)(lds + RING_BYTES);
    volatile LAS int* lbase = lcnt + NE; volatile LAS int* lrank = lcnt + 2 * NE;
    if (ROUTE) { if (tid < NE) lcnt[tid] = 0; __syncthreads(); }
    for (int r = bx_ * 8 + wave; r < nrows; r += gx_ * 8) {
        const int m = r < SEQ ? 0 : (r < NLAT ? 1 : 2);
        const float* mv = p.modv + ((size_t)layer * 3 + m) * 6 * D + which * 3 * D;
        float* xr = p.xa + (size_t)r * D;
        float4 v[4]; float ss = 0.f;
#pragma unroll
        for (int j = 0; j < 4; ++j) v[j] = *(const float4*)(xr + 256 * j + 4 * lane);
        if (comb_layer >= 0) {
            const float* g2 = p.modv + ((size_t)comb_layer * 3 + m) * 6 * D + 5 * D;
            const int4 so = *(const int4*)(p.slot_of + r * 4);
            const bf16_t* y0 = p.yb + (size_t)so.x * D; const bf16_t* y1 = p.yb + (size_t)so.y * D; const bf16_t* y2 = p.yb + (size_t)so.z * D; const bf16_t* y3 = p.yb + (size_t)so.w * D;
#pragma unroll
            for (int j = 0; j < 4; ++j) { const int k = 256 * j + 4 * lane; const ushort4 a = *(const ushort4*)(y0 + k), b = *(const ushort4*)(y1 + k), c = *(const ushort4*)(y2 + k), d = *(const ushort4*)(y3 + k); const float4 gg = *(const float4*)(g2 + k);
                v[j].x += gg.x * (bf2f(a.x) + bf2f(b.x) + bf2f(c.x) + bf2f(d.x)); v[j].y += gg.y * (bf2f(a.y) + bf2f(b.y) + bf2f(c.y) + bf2f(d.y));
                v[j].z += gg.z * (bf2f(a.z) + bf2f(b.z) + bf2f(c.z) + bf2f(d.z)); v[j].w += gg.w * (bf2f(a.w) + bf2f(b.w) + bf2f(c.w) + bf2f(d.w));
                if (MODE != 2) *(float4*)(xr + k) = v[j]; }
        }
#pragma unroll
        for (int j = 0; j < 4; ++j) ss += v[j].x * v[j].x + v[j].y * v[j].y + v[j].z * v[j].z + v[j].w * v[j].w;
        const float rstd = rsqrtf(wave_sum(ss) * (1.0f / D) + EPS);
        if (MODE == 2) {
#pragma unroll
            for (int j = 0; j < 4; ++j) { const int k = 256 * j + 4 * lane; const float4 g4 = *(const float4*)(gn + k);
                float4 o; o.x = v[j].x * rstd * g4.x; o.y = v[j].y * rstd * g4.y; o.z = v[j].z * rstd * g4.z; o.w = v[j].w * rstd * g4.w;
                *(float4*)(p.out + (size_t)r * D + k) = o; }
            continue;
        }
#pragma unroll
        for (int j = 0; j < 4; ++j) { const int k = 256 * j + 4 * lane; const float4 g4 = *(const float4*)(gn + k), sc = *(const float4*)(mv + D + k), sh = *(const float4*)(mv + k);
            v[j].x = v[j].x * rstd * g4.x * (1.0f + sc.x) + sh.x; v[j].y = v[j].y * rstd * g4.y * (1.0f + sc.y) + sh.y;
            v[j].z = v[j].z * rstd * g4.z * (1.0f + sc.z) + sh.z; v[j].w = v[j].w * rstd * g4.w * (1.0f + sc.w) + sh.w;
            ushort4 o; o.x = f2bf(v[j].x); o.y = f2bf(v[j].y); o.z = f2bf(v[j].z); o.w = f2bf(v[j].w);
            *(ushort4*)(p.hxb + (size_t)r * D + k) = o; }
        if (ROUTE) {
            const int eh = lane & 31, half = lane >> 5;
            const LAS float* wb = Wl + (size_t)(128 * half) * NE + eh;
            float acc = 0.f;
#pragma unroll
            for (int j = 0; j < 4; ++j) { const float vq[4] = {v[j].x, v[j].y, v[j].z, v[j].w};
#pragma unroll
                for (int q = 0; q < 4; ++q) { const int vi = __builtin_bit_cast(int, vq[q]);
#pragma unroll 8
                    for (int l = 0; l < 32; ++l) { const float s0 = __builtin_bit_cast(float, __builtin_amdgcn_readlane(vi, l)), s1 = __builtin_bit_cast(float, __builtin_amdgcn_readlane(vi, l + 32));
                        acc += (half ? s1 : s0) * wb[(256 * j + 4 * l + q) * NE]; } } }
            acc += __shfl_xor(acc, 32);
            acc += p.router_b[layer * NE + eh];
            float lg[NE];
#pragma unroll
            for (int e = 0; e < NE; ++e) lg[e] = __shfl(acc, e);
            int ti[4]; float tv[4];
#pragma unroll
            for (int s = 0; s < 4; ++s) { int best = 0; float bv = -3.0e38f;
#pragma unroll
                for (int e = 0; e < NE; ++e) { if (lg[e] > bv) { bv = lg[e]; best = e; } }
                ti[s] = best; tv[s] = bv;
#pragma unroll
                for (int e = 0; e < NE; ++e) if (e == best) lg[e] = -3.0e38f; }
            if (lane == 0) {
                const float e1 = expf(tv[1] - tv[0]), e2 = expf(tv[2] - tv[0]), e3 = expf(tv[3] - tv[0]), inv = 1.0f / (1.0f + e1 + e2 + e3);
                p.topi[r * 4 + 0] = ti[0]; p.topi[r * 4 + 1] = ti[1]; p.topi[r * 4 + 2] = ti[2]; p.topi[r * 4 + 3] = ti[3];
                p.topg[r * 4 + 0] = inv; p.topg[r * 4 + 1] = e1 * inv; p.topg[r * 4 + 2] = e2 * inv; p.topg[r * 4 + 3] = e3 * inv;
                const int li = ((r - (bx_ * 8 + wave)) / (gx_ * 8)) * 8 + wave;
#pragma unroll
                for (int s = 0; s < 4; ++s) lrank[li * 4 + s] = __hip_atomic_fetch_add((LAS int*)(lcnt + ti[s]), 1, __ATOMIC_RELAXED, __HIP_MEMORY_SCOPE_WORKGROUP);
            }
        }
    }
    if (ROUTE) {
        __syncthreads();
        if (tid < NE) lbase[tid] = atomicAdd(p.cnt + layer * NE + tid, lcnt[tid]);
        __syncthreads();
        const int nmine = (nrows - bx_ * 8 + gx_ * 8 - 1) / (gx_ * 8) * 8;
        for (int i = tid; i < nmine * 4; i += NTHREADS) { const int li = i >> 2, r = bx_ * 8 + (li & 7) + (li >> 3) * gx_ * 8;
            if (r < nrows) p.pos[r * 4 + (i & 3)] = lbase[p.topi[i - li * 4 + r * 4]] + lrank[i]; }
    }
}
__device__ __forceinline__ float4 ld4px(const float* q) { return *(const float4*)q; }
__device__ __forceinline__ float4 ld4px(const bf16_t* q) { const ushort4 v = *(const ushort4*)q; return make_float4(bf2f(v.x), bf2f(v.y), bf2f(v.z), bf2f(v.w)); }
typedef unsigned short us4v __attribute__((ext_vector_type(4)));
__device__ __forceinline__ us4v pack4(float4 v) { return (us4v){f2bf(v.x), f2bf(v.y), f2bf(v.z), f2bf(v.w)}; }
template <int K> __device__ __forceinline__ pg8::f32x4 mma16(const LAS bf16_t* A, int lda, const LAS bf16_t* Bt, int ldb, pg8::f32x4 acc, int lane) {
    const int r = lane & 15, q = lane >> 4;
    const LAS bf16_t* ap = A + r * lda + 8 * q; const LAS bf16_t* bp = Bt + r * ldb + 8 * q;
#pragma unroll
    for (int k0 = 0; k0 < K; k0 += 32) acc = __builtin_amdgcn_mfma_f32_16x16x32_bf16(*(const LAS pg8::bf16x8*)(ap + k0), *(const LAS pg8::bf16x8*)(bp + k0), acc, 0, 0, 0);
    return acc;
}
constexpr int RLD = 136, RLQ = 72;
__device__ __forceinline__ void mf_retkv(const P& p, LAS unsigned char* lds, int il) {
    int tid = threadIdx.x; asm volatile("" : "+v"(tid));
    int bx_ = (int)blockIdx.x, gx_ = (int)gridDim.x; asm volatile("" : "+s"(bx_), "+s"(gx_));
    const int lane = tid & 63, wave = tid >> 6, r = lane & 15, q = lane >> 4;
    LAS bf16_t* KdT = (LAS bf16_t*)lds; LAS bf16_t* VT = KdT + 64 * RLD;
    for (int u = bx_; u < 16 * RNCH; u += gx_) {
        const int n = u % RNCH, h = (u / RNCH) & 3, b = (u / (RNCH * 4)) & 1, dir = u / (RNCH * 8);
        const float lg = ret_logg(p, il, dir, h);
        __syncthreads();
        for (int idx = tid; idx < 128 * 16; idx += NTHREADS) { const int j = idx >> 4, d4 = idx & 15, row = scan_row(dir, b, n * RC + j);
            const float4 kv = *(const float4*)(p.kr + (size_t)row * 256 + h * 64 + 4 * d4); const float dk = fexp((float)(RC - 1 - j) * lg);
            KdT[(4 * d4 + 0) * RLD + j] = f2bf(kv.x * dk); KdT[(4 * d4 + 1) * RLD + j] = f2bf(kv.y * dk); KdT[(4 * d4 + 2) * RLD + j] = f2bf(kv.z * dk); KdT[(4 * d4 + 3) * RLD + j] = f2bf(kv.w * dk); }
        for (int idx = tid; idx < 128 * 32; idx += NTHREADS) { const int j = idx >> 5, e4 = idx & 31, row = scan_row(dir, b, n * RC + j);
            const float4 vv = ld4px(p.px + (size_t)row * PXLD + 512 + h * 128 + 4 * e4);
            VT[(4 * e4 + 0) * RLD + j] = f2bf(vv.x); VT[(4 * e4 + 1) * RLD + j] = f2bf(vv.y); VT[(4 * e4 + 2) * RLD + j] = f2bf(vv.z); VT[(4 * e4 + 3) * RLD + j] = f2bf(vv.w); }
        __syncthreads();
        float* o = p.rkv + ((((size_t)dir * 2 + b) * RNCH + n) * 4 + h) * 8192;
#pragma unroll
        for (int td = 0; td < 4; ++td) { pg8::f32x4 acc = {0.f, 0.f, 0.f, 0.f};
            acc = mma16<128>(VT + (16 * wave) * RLD, RLD, KdT + (16 * td) * RLD, RLD, acc, lane);
#pragma unroll
            for (int g = 0; g < 4; ++g) o[(size_t)(16 * wave + 4 * q + g) * 64 + 16 * td + r] = acc[g]; }
    }
}
__device__ __forceinline__ void mf_reto(const P& p, LAS unsigned char* lds, int il) {
    int tid = threadIdx.x; asm volatile("" : "+v"(tid));
    int bx_ = (int)blockIdx.x, gx_ = (int)gridDim.x; asm volatile("" : "+s"(bx_), "+s"(gx_));
    const int lane = tid & 63, wave = tid >> 6, r = lane & 15, q = lane >> 4;
    LAS bf16_t* Qs = (LAS bf16_t*)lds; LAS bf16_t* Ks = Qs + 128 * RLQ; LAS bf16_t* ST = Ks + 128 * RLQ; LAS bf16_t* VT = ST + 128 * RLQ; LAS bf16_t* Ps = VT + 128 * RLD;
    for (int u = bx_; u < 16 * RNCH; u += gx_) {
        const int n = u % RNCH, h = (u / RNCH) & 3, b = (u / (RNCH * 4)) & 1, dir = u / (RNCH * 8);
        const float lg = ret_logg(p, il, dir, h);
        const float* Sg = p.rkv + ((((size_t)dir * 2 + b) * RNCH + n) * 4 + h) * 8192;
        __syncthreads();
        for (int idx = tid; idx < 128 * 16; idx += NTHREADS) { const int j = idx >> 4, d4 = idx & 15, row = scan_row(dir, b, n * RC + j);
            const float4 qv = *(const float4*)(p.qr + (size_t)row * 256 + h * 64 + 4 * d4), kv = *(const float4*)(p.kr + (size_t)row * 256 + h * 64 + 4 * d4), sv = *(const float4*)(Sg + (size_t)j * 64 + 4 * d4);
            *(LAS us4v*)(Qs + j * RLQ + 4 * d4) = pack4(qv); *(LAS us4v*)(Ks + j * RLQ + 4 * d4) = pack4(kv); *(LAS us4v*)(ST + j * RLQ + 4 * d4) = pack4(sv); }
        for (int idx = tid; idx < 128 * 32; idx += NTHREADS) { const int j = idx >> 5, e4 = idx & 31, row = scan_row(dir, b, n * RC + j);
            const float4 vv = ld4px(p.px + (size_t)row * PXLD + 512 + h * 128 + 4 * e4);
            VT[(4 * e4 + 0) * RLD + j] = f2bf(vv.x); VT[(4 * e4 + 1) * RLD + j] = f2bf(vv.y); VT[(4 * e4 + 2) * RLD + j] = f2bf(vv.z); VT[(4 * e4 + 3) * RLD + j] = f2bf(vv.w); }
        __syncthreads();
#pragma unroll
        for (int tj = 0; tj < 8; ++tj) { pg8::f32x4 acc = {0.f, 0.f, 0.f, 0.f};
            acc = mma16<64>(Qs + (16 * wave) * RLQ, RLQ, Ks + (16 * tj) * RLQ, RLQ, acc, lane);
            const int j = 16 * tj + r;
#pragma unroll
            for (int g = 0; g < 4; ++g) { const int i = 16 * wave + 4 * q + g; Ps[i * RLD + j] = f2bf(j <= i ? acc[g] * fexp((float)(i - j) * lg) : 0.f); } }
        __syncthreads();
        float dq[4];
#pragma unroll
        for (int g = 0; g < 4; ++g) dq[g] = fexp((float)(16 * wave + 4 * q + g + 1) * lg);
#pragma unroll
        for (int te = 0; te < 8; ++te) { pg8::f32x4 acc = {0.f, 0.f, 0.f, 0.f}, cr = {0.f, 0.f, 0.f, 0.f};
            acc = mma16<128>(Ps + (16 * wave) * RLD, RLD, VT + (16 * te) * RLD, RLD, acc, lane);
            cr = mma16<64>(Qs + (16 * wave) * RLQ, RLQ, ST + (16 * te) * RLQ, RLQ, cr, lane);
#pragma unroll
            for (int g = 0; g < 4; ++g) { const int i = 16 * wave + 4 * q + g, row = scan_row(dir, b, n * RC + i);
                p.oret[((size_t)dir * NTOK + row) * 512 + h * 128 + 16 * te + r] = acc[g] + dq[g] * cr[g]; } }
    }
}
template <bool FILL> __device__ __forceinline__ void mf_s5(const P& p, LAS unsigned char* lds, int il) {
    int tid = threadIdx.x; asm volatile("" : "+v"(tid));
    int bx_ = (int)blockIdx.x, gx_ = (int)gridDim.x; asm volatile("" : "+s"(bx_), "+s"(gx_));
    const int lane = tid & 63, wave = tid >> 6, r = lane & 15, q = lane >> 4;
    constexpr int LDU = 40, LDS_ = 132, LDB = 136;
    LAS bf16_t* Bt = (LAS bf16_t*)lds;
    LAS bf16_t* Ct = Bt + 128 * LDU;
    LAS unsigned char* wb = lds + 16384 + wave * 14336;
    LAS bf16_t* U = (LAS bf16_t*)wb;
    LAS float* SL = (LAS float*)(wb + 1280);
    LAS bf16_t* Sb = (LAS bf16_t*)(wb + 1280 + 8448);
    constexpr int GRP = (2 * S5NCH) / 8;
    static_assert((2 * S5NCH) % 8 == 0, "chunk count");
    for (int bu = bx_; bu < 64 * GRP; bu += gx_) {
        const int dg = bu / GRP, grp = bu % GRP, dir = dg >> 5, g = dg & 31;
        __syncthreads();
        if (tid < 64) { S5Par sp; s5_par(p, il, dir, g, tid, sp);
#pragma unroll
            for (int h = 0; h < 16; ++h) { Bt[(2 * tid) * LDU + h] = f2bf(sp.bbr[h]); Bt[(2 * tid + 1) * LDU + h] = f2bf(sp.bbi[h]); Bt[(2 * tid) * LDU + 16 + h] = 0; Bt[(2 * tid + 1) * LDU + 16 + h] = 0;
                const long ci = (((long)(il * 2 + dir) * NG + g) * GH + h) * NP + tid; Ct[h * LDB + 2 * tid] = f2bf(p.s5_cre[ci]); Ct[h * LDB + 2 * tid + 1] = f2bf(-p.s5_cim[ci]); } }
        float lbr, lbi; { const int gi = (il * 2 + dir) * NG + g; const float lre = fminf(p.s5_lre[gi * NP + lane], -1e-4f), lim = p.s5_lim[gi * NP + lane], dt = expf(p.s5_ldt[gi]);
            const float mag = expf(lre * dt); lbr = mag * cosf(lim * dt); lbi = mag * sinf(lim * dt); }
        __syncthreads();
        const int bc = grp * 8 + wave, b = bc / S5NCH, ch = bc % S5NCH;
        float* ce = p.s5c + ((((size_t)dir * 2 + b) * S5NCH + ch) * NG + g) * NP * 2 + lane * 2;
        float sr = 0.f, si = 0.f;
        if (FILL) { sr = ce[0]; si = ce[1]; }
        float4 uvs[S5C / 16];
#pragma unroll
        for (int sb = 0; sb < S5C / 16; ++sb) { const int k = lane >> 2, h4 = (lane & 3) * 4, row = scan_row(dir, b, ch * S5C + sb * 16 + k);
            uvs[sb] = ld4px(p.px + (size_t)row * PXLD + 1536 + g * GH + h4); }
#pragma unroll
        for (int sb = 0; sb < S5C / 16; ++sb) {
            { const int k = lane >> 2, h4 = (lane & 3) * 4;
              *(LAS us4v*)(U + k * LDU + h4) = pack4(uvs[sb]); *(LAS us4v*)(U + k * LDU + 16 + h4) = (us4v){0, 0, 0, 0}; }
            asm volatile("s_waitcnt lgkmcnt(0)" ::: "memory");
#pragma unroll
            for (int tc = 0; tc < 8; ++tc) { pg8::f32x4 acc = {0.f, 0.f, 0.f, 0.f};
                acc = mma16<32>(U, LDU, Bt + (16 * tc) * LDU, LDU, acc, lane);
#pragma unroll
                for (int gq = 0; gq < 4; ++gq) SL[(4 * q + gq) * LDS_ + 16 * tc + r] = acc[gq]; }
            asm volatile("s_waitcnt lgkmcnt(0)" ::: "memory");
#pragma unroll
            for (int k = 0; k < 16; ++k) { const float br = SL[k * LDS_ + 2 * lane], bi = SL[k * LDS_ + 2 * lane + 1];
                const float tr = lbr * sr - lbi * si + br, ti = lbr * si + lbi * sr + bi; sr = tr; si = ti;
                if (FILL) { Sb[k * LDB + 2 * lane] = f2bf(sr); Sb[k * LDB + 2 * lane + 1] = f2bf(si); } }
            if (FILL) {
                asm volatile("s_waitcnt lgkmcnt(0)" ::: "memory");
                pg8::f32x4 acc = {0.f, 0.f, 0.f, 0.f};
                acc = mma16<128>(Sb, LDB, Ct, LDB, acc, lane);
#pragma unroll
                for (int gq = 0; gq < 4; ++gq) { const int row = scan_row(dir, b, ch * S5C + sb * 16 + 4 * q + gq); p.yd[((size_t)dir * NTOK + row) * S5W + g * GH + r] = acc[gq]; }
            }
            asm volatile("s_waitcnt lgkmcnt(0)" ::: "memory");
        }
        if (!FILL) { ce[0] = sr; ce[1] = si; }
    }
}
__device__ __forceinline__ void mf_swa(const P& p, LAS unsigned char* lds, int il, bool with_ctx) {
    int tid = threadIdx.x; asm volatile("" : "+v"(tid));
    int bx_ = (int)blockIdx.x, gx_ = (int)gridDim.x; asm volatile("" : "+s"(bx_), "+s"(gx_));
    const int lane = tid & 63, wave = tid >> 6, r = lane & 15, q = lane >> 4;
    constexpr int LDK = 72;
    LAS bf16_t* Ks = (LAS bf16_t*)lds;
    LAS bf16_t* VT = Ks + 64 * LDK;
    LAS bf16_t* Pw = VT + 64 * LDK + wave * 64 * LDK;
    constexpr int NQB = SEQ / 128, NLATU = 4 * NQB, NCTXU = 4 * (CTXL / 128);
    const int nunits = NLATU + (with_ctx ? NCTXU : 0);
    for (int u = bx_; u < nunits; u += gx_) {
        int b, kv, qb, isctx;
        if (u < NLATU) { isctx = 0; qb = u % NQB; kv = (u / NQB) & 1; b = u / (NQB * 2); }
        else { const int v = u - NLATU; isctx = 1; qb = v % (CTXL / 128); kv = (v / (CTXL / 128)) & 1; b = v / ((CTXL / 128) * 2); }
        const int g = wave >> 1, hq = kv * 4 + g, i0 = (wave & 1) * 64;
        const int qrow0 = (isctx ? NLAT + b * CTXL : b * SEQ) + qb * 128 + i0;
        pg8::bf16x8 qf[4][2];
#pragma unroll
        for (int tq = 0; tq < 4; ++tq)
#pragma unroll
            for (int ks = 0; ks < 2; ++ks) { const float* src = p.qs + (size_t)(qrow0 + 16 * tq + r) * 512 + hq * 64 + 32 * ks + 8 * q;
                const float4 a = *(const float4*)src, c = *(const float4*)(src + 4);
                qf[tq][ks] = (pg8::bf16x8){(short)f2bf(a.x), (short)f2bf(a.y), (short)f2bf(a.z), (short)f2bf(a.w), (short)f2bf(c.x), (short)f2bf(c.y), (short)f2bf(c.z), (short)f2bf(c.w)}; }
        pg8::f32x4 oacc[4][4];
        float mrow[4][4], lrow[4][4];
        const float sink = p.swa_sink[il * 8 + hq];
#pragma unroll
        for (int tq = 0; tq < 4; ++tq)
#pragma unroll
            for (int x = 0; x < 4; ++x) { oacc[tq][x] = (pg8::f32x4){0.f, 0.f, 0.f, 0.f}; mrow[tq][x] = sink; lrow[tq][x] = 1.0f; }
        const int ntile = isctx ? 4 : 10;
        for (int t = 0; t < ntile; ++t) {
            const bool loc = !isctx && t < 6;
            const int kpos0 = loc ? 128 * (qb - 1) + 64 * t : 0;
            if (loc && (kpos0 < 0 || kpos0 >= SEQ)) continue;
            const int krow0 = loc ? b * SEQ + kpos0 : NLAT + b * CTXL + 64 * (isctx ? t : t - 6);
            __syncthreads();
            for (int idx = tid; idx < 64 * 16; idx += NTHREADS) { const int key = idx >> 4, d4 = idx & 15;
                const float4 kk = *(const float4*)(p.ks + (size_t)(krow0 + key) * 128 + kv * 64 + 4 * d4), vv = ld4px(p.px + (size_t)(krow0 + key) * PXLD + 2176 + kv * 64 + 4 * d4);
                *(LAS us4v*)(Ks + key * LDK + 4 * d4) = pack4(kk);
                VT[(4 * d4 + 0) * LDK + key] = f2bf(vv.x); VT[(4 * d4 + 1) * LDK + key] = f2bf(vv.y); VT[(4 * d4 + 2) * LDK + key] = f2bf(vv.z); VT[(4 * d4 + 3) * LDK + key] = f2bf(vv.w); }
            __syncthreads();
            pg8::f32x4 sc[4][4];
#pragma unroll
            for (int tk = 0; tk < 4; ++tk) { const LAS bf16_t* kp = Ks + (16 * tk + r) * LDK + 8 * q;
                const pg8::bf16x8 k0 = *(const LAS pg8::bf16x8*)kp, k1 = *(const LAS pg8::bf16x8*)(kp + 32);
#pragma unroll
                for (int tq = 0; tq < 4; ++tq) { pg8::f32x4 a = {0.f, 0.f, 0.f, 0.f};
                    a = __builtin_amdgcn_mfma_f32_16x16x32_bf16(qf[tq][0], k0, a, 0, 0, 0); a = __builtin_amdgcn_mfma_f32_16x16x32_bf16(qf[tq][1], k1, a, 0, 0, 0); sc[tq][tk] = a; } }
            if (loc) {
#pragma unroll
                for (int tq = 0; tq < 4; ++tq)
#pragma unroll
                    for (int tk = 0; tk < 4; ++tk)
#pragma unroll
                        for (int x = 0; x < 4; ++x) { const int dlt = (kpos0 + 16 * tk + r) - (128 * qb + i0 + 16 * tq + 4 * q + x); if (dlt > 128 || dlt < -128) sc[tq][tk][x] = -1e30f; }
            }
#pragma unroll
            for (int tq = 0; tq < 4; ++tq)
#pragma unroll
                for (int x = 0; x < 4; ++x) {
                    float mx = fmaxf(fmaxf(sc[tq][0][x], sc[tq][1][x]), fmaxf(sc[tq][2][x], sc[tq][3][x]));
                    mx = fmaxf(mx, __shfl_xor(mx, 1)); mx = fmaxf(mx, __shfl_xor(mx, 2)); mx = fmaxf(mx, __shfl_xor(mx, 4)); mx = fmaxf(mx, __shfl_xor(mx, 8));
                    const float mn = fmaxf(mrow[tq][x], mx), corr = __expf(mrow[tq][x] - mn);
                    float sum = 0.f;
#pragma unroll
                    for (int tk = 0; tk < 4; ++tk) { const float pe = __expf(sc[tq][tk][x] - mn); sum += pe; Pw[(16 * tq + 4 * q + x) * LDK + 16 * tk + r] = f2bf(pe); }
                    sum += __shfl_xor(sum, 1); sum += __shfl_xor(sum, 2); sum += __shfl_xor(sum, 4); sum += __shfl_xor(sum, 8);
                    lrow[tq][x] = lrow[tq][x] * corr + sum; mrow[tq][x] = mn;
#pragma unroll
                    for (int td = 0; td < 4; ++td) oacc[tq][td][x] *= corr;
                }
            asm volatile("s_waitcnt lgkmcnt(0)" ::: "memory");
#pragma unroll
            for (int td = 0; td < 4; ++td) { const LAS bf16_t* vp = VT + (16 * td + r) * LDK + 8 * q;
                const pg8::bf16x8 v0 = *(const LAS pg8::bf16x8*)vp, v1 = *(const LAS pg8::bf16x8*)(vp + 32);
#pragma unroll
                for (int tq = 0; tq < 4; ++tq) { const LAS bf16_t* pp = Pw + (16 * tq + r) * LDK + 8 * q;
                    oacc[tq][td] = __builtin_amdgcn_mfma_f32_16x16x32_bf16(*(const LAS pg8::bf16x8*)pp, v0, oacc[tq][td], 0, 0, 0);
                    oacc[tq][td] = __builtin_amdgcn_mfma_f32_16x16x32_bf16(*(const LAS pg8::bf16x8*)(pp + 32), v1, oacc[tq][td], 0, 0, 0); } }
        }
#pragma unroll
        for (int tq = 0; tq < 4; ++tq)
#pragma unroll
            for (int x = 0; x < 4; ++x) { const float inv = 1.0f / lrow[tq][x]; bf16_t* o = p.mixb + (size_t)(qrow0 + 16 * tq + 4 * q + x) * D + 512 + hq * 64 + r;
#pragma unroll
                for (int td = 0; td < 4; ++td) o[16 * td] = f2bf(oacc[tq][td][x] * inv); }
    }
}
__device__ __forceinline__ void mf_sconv(const P& p, LAS unsigned char* lds, int il) {
    int tid = threadIdx.x; asm volatile("" : "+v"(tid));
    int bx_ = (int)blockIdx.x, gx_ = (int)gridDim.x; asm volatile("" : "+s"(bx_), "+s"(gx_));
    LAS float* T = (LAS float*)lds;
    const float* sw = p.hy_short_w + il * 3 * 1536; const float* sb = p.hy_short_b + il * 1536;
    constexpr int NT = (NTOK / 64) * (HYW / 64);
    for (int t = bx_; t < NT; t += gx_) {
        const int r0 = (t / (HYW / 64)) * 64, c0 = (t % (HYW / 64)) * 64;
        const int rl = tid >> 3, cs = (tid & 7) * 8, r = r0 + rl; const RowInfo ri = row_info(r);
        float u[3][8];
#pragma unroll
        for (int g = 0; g < 3; ++g) { const int col = g * HYW + c0 + cs; const float4 b0 = *(const float4*)(sb + col), b1 = *(const float4*)(sb + col + 4);
            u[g][0] = b0.x; u[g][1] = b0.y; u[g][2] = b0.z; u[g][3] = b0.w; u[g][4] = b1.x; u[g][5] = b1.y; u[g][6] = b1.z; u[g][7] = b1.w;
#pragma unroll
            for (int j = 0; j < 3; ++j) { const int tt = ri.t + j - 1; if (tt >= 0 && tt < ri.len) { const px_t* px = p.px + (size_t)(ri.base + tt) * PXLD + col; const float* wj = sw + j * 1536 + col;
                const float4 x0 = ld4px(px), x1 = ld4px(px + 4), w0 = *(const float4*)wj, w1 = *(const float4*)(wj + 4);
                u[g][0] += w0.x * x0.x; u[g][1] += w0.y * x0.y; u[g][2] += w0.z * x0.z; u[g][3] += w0.w * x0.w; u[g][4] += w1.x * x1.x; u[g][5] += w1.y * x1.y; u[g][6] += w1.z * x1.z; u[g][7] += w1.w * x1.w; } } }
        float z[8];
#pragma unroll
        for (int k = 0; k < 8; ++k) z[k] = u[2][k] * u[1][k];
        const size_t i = (size_t)r * HYW + c0 + cs;
        *(float4*)(p.x0c + i) = make_float4(u[0][0], u[0][1], u[0][2], u[0][3]); *(float4*)(p.x0c + i + 4) = make_float4(u[0][4], u[0][5], u[0][6], u[0][7]);
        *(float4*)(p.zb + i) = make_float4(z[0], z[1], z[2], z[3]); *(float4*)(p.zb + i + 4) = make_float4(z[4], z[5], z[6], z[7]);
        if (r0 < NLAT) {
            __syncthreads();
#pragma unroll
            for (int k = 0; k < 8; ++k) T[(cs + k) * 65 + rl] = z[k];
            __syncthreads();
            const int cl = tid >> 3, rs = (tid & 7) * 8; const LAS float* src = T + cl * 65 + rs; float* dst = p.zT + (size_t)(c0 + cl) * NLAT + r0 + rs;
            *(float4*)dst = make_float4(src[0], src[1], src[2], src[3]); *(float4*)(dst + 4) = make_float4(src[4], src[5], src[6], src[7]);
        }
    }
}
__device__ __forceinline__ void mf_filter_tiles(const P& p, LAS unsigned char* lds) {
    int tid = threadIdx.x; asm volatile("" : "+v"(tid));
    int bx_ = (int)blockIdx.x, gx_ = (int)gridDim.x; asm volatile("" : "+s"(bx_), "+s"(gx_));
    LAS float* A1 = (LAS float*)lds; LAS float* A2 = A1 + 64 * 65; LAS float* T = A2 + 64 * 65;
    constexpr int RT = (SEQ + CTXL) / 64;
    const int rl = tid >> 3, cs = (tid & 7) * 8;
    constexpr int NLT = 2 * (SEQ / 64), NCT = 2 * (CTXL / 64), NITEM = NLT + NCT * (HYW / 64);
    for (int it = bx_; it < NITEM; it += gx_) {
        int t, ct0, ct1;
        if (it < NLT) { t = (it / (SEQ / 64)) * RT + it % (SEQ / 64); ct0 = 0; ct1 = HYW / 64; }
        else { const int v = it - NLT, tc = v / (HYW / 64); t = (tc / (CTXL / 64)) * RT + SEQ / 64 + tc % (CTXL / 64); ct0 = v % (HYW / 64); ct1 = ct0 + 1; }
        const int i = t / RT, rt = t % RT, q0 = rt * 64, kind = q0 >= SEQ, L = kind ? CTXL : SEQ, q = q0 + rl, pos = kind ? q - SEQ : q;
        const long rr = (long)i * (SEQ + CTXL) + q;
        __syncthreads();
        {
            const float* w1 = p.hy_f_w1 + i * 33 * 64 + cs; const float tt = (float)pos / (float)L, w = 6.283185307179586f * (float)pos / (float)L;
            float acc[8];
#pragma unroll
            for (int k = 0; k < 8; ++k) acc[k] = tt * w1[k];
            for (int bi = 0; bi < 16; ++bi) { const float band = 1e-4f + (float)bi * ((15.0f - 1e-4f) / 15.0f), cc = ROPE_COS(band * w), sn = ROPE_SIN(band * w);
                const float* wc = w1 + (1 + bi) * 64; const float* ws = w1 + (17 + bi) * 64;
#pragma unroll
                for (int k = 0; k < 8; ++k) acc[k] += cc * wc[k] - sn * ws[k]; }
#pragma unroll
            for (int k = 0; k < 8; ++k) A1[rl * 65 + cs + k] = ROPE_SIN(acc[k] + p.hy_f_b1[i * 64 + cs + k]);
        }
        __syncthreads();
        {
            const float* w2 = p.hy_f_w2 + i * 64 * 64 + cs; float acc[8];
#pragma unroll
            for (int k = 0; k < 8; ++k) acc[k] = 0.f;
            for (int kk = 0; kk < 64; ++kk) { const float hv = A1[rl * 65 + kk]; const float4 a = *(const float4*)(w2 + kk * 64), b4 = *(const float4*)(w2 + kk * 64 + 4);
                acc[0] += hv * a.x; acc[1] += hv * a.y; acc[2] += hv * a.z; acc[3] += hv * a.w; acc[4] += hv * b4.x; acc[5] += hv * b4.y; acc[6] += hv * b4.z; acc[7] += hv * b4.w; }
#pragma unroll
            for (int k = 0; k < 8; ++k) A2[rl * 65 + cs + k] = ROPE_SIN(acc[k] + p.hy_f_b2[i * 64 + cs + k]);
        }
        __syncthreads();
        const float lag = fabsf((float)(pos - L / 2)) / (float)(L / 2);
        for (int ct = ct0; ct < ct1; ++ct) {
            const int c0 = ct * 64; const float* w3 = p.hy_f_w3 + (size_t)i * 64 * HYW + c0 + cs;
            float acc[8];
#pragma unroll
            for (int k = 0; k < 8; ++k) acc[k] = 0.f;
            for (int kk = 0; kk < 64; ++kk) { const float hv = A2[rl * 65 + kk]; const float4 a = *(const float4*)(w3 + (size_t)kk * HYW), b4 = *(const float4*)(w3 + (size_t)kk * HYW + 4);
                acc[0] += hv * a.x; acc[1] += hv * a.y; acc[2] += hv * a.z; acc[3] += hv * a.w; acc[4] += hv * b4.x; acc[5] += hv * b4.y; acc[6] += hv * b4.z; acc[7] += hv * b4.w; }
            const float fast = -15.350567286626973f, slow = -3.0701134573253946f;
#pragma unroll
            for (int k = 0; k < 8; ++k) { const float delta = fabsf(fast + (slow - fast) * (float)(c0 + cs + k) / 511.0f); acc[k] *= fexp(-lag * delta) + 0.05f; }
            float* o = p.hraw + rr * HYW + c0 + cs;
            *(float4*)o = make_float4(acc[0], acc[1], acc[2], acc[3]); *(float4*)(o + 4) = make_float4(acc[4], acc[5], acc[6], acc[7]);
            __syncthreads();
#pragma unroll
            for (int k = 0; k < 8; ++k) T[(cs + k) * 65 + rl] = acc[k];
            __syncthreads();
            const int cl = tid >> 3, rs = (tid & 7) * 8; const LAS float* src = T + cl * 65 + rs;
            float v8[8];
#pragma unroll
            for (int k = 0; k < 8; ++k) v8[k] = src[k];
            if (!kind) { float* dst = p.hT + ((size_t)i * HYW + c0 + cl) * SEQ + q0 + rs;
                *(float4*)dst = make_float4(v8[0], v8[1], v8[2], v8[3]); *(float4*)(dst + 4) = make_float4(v8[4], v8[5], v8[6], v8[7]); }
            float sa = 0.f;
#pragma unroll
            for (int k = 0; k < 8; ++k) sa += fabsf(v8[k]);
            sa += __shfl_xor(sa, 1); sa += __shfl_xor(sa, 2); sa += __shfl_xor(sa, 4);
            if ((tid & 7) == 0) p.hpart[(size_t)t * HYW + c0 + cl] = sa;
        }
    }
}
__device__ __forceinline__ void mf_hymix(const P& p, LAS unsigned char* lds, int il) {
    int tid = threadIdx.x; asm volatile("" : "+v"(tid));
    int bx_ = (int)blockIdx.x, gx_ = (int)gridDim.x; asm volatile("" : "+s"(bx_), "+s"(gx_));
    LAS float* T = (LAS float*)lds;
    constexpr int NT = (NLAT / 64) * (HYW / 64);
    for (int t = bx_; t < NT; t += gx_) {
        const int r0 = (t / (HYW / 64)) * 64, c0 = (t % (HYW / 64)) * 64;
        __syncthreads();
        { const int cl = tid >> 3, rs = (tid & 7) * 8; const float* src = p.convT + (size_t)(c0 + cl) * NLAT + r0 + rs; const float4 a = *(const float4*)src, b = *(const float4*)(src + 4);
          LAS float* d = T + cl * 65 + rs; d[0] = a.x; d[1] = a.y; d[2] = a.z; d[3] = a.w; d[4] = b.x; d[5] = b.y; d[6] = b.z; d[7] = b.w; }
        __syncthreads();
        { const int rl = tid >> 3, cs = (tid & 7) * 8; const size_t i = (size_t)(r0 + rl) * HYW + c0 + cs;
          const float4 z0 = *(const float4*)(p.zb + i), z1 = *(const float4*)(p.zb + i + 4), x0 = *(const float4*)(p.x0c + i), x1 = *(const float4*)(p.x0c + i + 4);
          const float4 b0 = *(const float4*)(p.hy_bias + il * HYW + c0 + cs), b1 = *(const float4*)(p.hy_bias + il * HYW + c0 + cs + 4);
          const float zz[8] = {z0.x, z0.y, z0.z, z0.w, z1.x, z1.y, z1.z, z1.w}, xx[8] = {x0.x, x0.y, x0.z, x0.w, x1.x, x1.y, x1.z, x1.w}, bb[8] = {b0.x, b0.y, b0.z, b0.w, b1.x, b1.y, b1.z, b1.w};
          unsigned short o[8];
#pragma unroll
          for (int k = 0; k < 8; ++k) o[k] = f2bf(xx[k] * (T[(cs + k) * 65 + rl] + bb[k] * zz[k]));
          uint4 ov; ov.x = o[0] | ((unsigned)o[1] << 16); ov.y = o[2] | ((unsigned)o[3] << 16); ov.z = o[4] | ((unsigned)o[5] << 16); ov.w = o[6] | ((unsigned)o[7] << 16);
          *(uint4*)(p.mixb + (size_t)(r0 + rl) * D + c0 + cs) = ov; }
    }
}
__device__ __forceinline__ void mf_retout(const P& p, int nrows) {
    int tid = threadIdx.x; asm volatile("" : "+v"(tid));
    int bx_ = (int)blockIdx.x, gx_ = (int)gridDim.x; asm volatile("" : "+s"(bx_), "+s"(gx_));
    const int lane = tid & 63, wave = tid >> 6;
    for (int r = bx_ * 8 + wave; r < nrows; r += gx_ * 8) {
        const float* o0 = p.oret + (size_t)r * 512 + 8 * lane; const float* o1 = p.oret + ((size_t)NTOK + r) * 512 + 8 * lane; const px_t* gp = p.px + (size_t)r * PXLD + 1024 + 8 * lane;
        const float4 a0 = *(const float4*)o0, a1 = *(const float4*)(o0 + 4), b0 = *(const float4*)o1, b1 = *(const float4*)(o1 + 4), g0 = ld4px(gp), g1 = ld4px(gp + 4);
        const float o[8] = {a0.x + b0.x, a0.y + b0.y, a0.z + b0.z, a0.w + b0.w, a1.x + b1.x, a1.y + b1.y, a1.z + b1.z, a1.w + b1.w}, gg[8] = {g0.x, g0.y, g0.z, g0.w, g1.x, g1.y, g1.z, g1.w};
        float ss = 0.f;
#pragma unroll
        for (int k = 0; k < 8; ++k) ss += o[k] * o[k];
        ss += __shfl_xor(ss, 1); ss += __shfl_xor(ss, 2); ss += __shfl_xor(ss, 4); ss += __shfl_xor(ss, 8);
        const float rs = rsqrtf(ss * (1.0f / 128.0f) + EPS);
        unsigned short ob[8];
#pragma unroll
        for (int k = 0; k < 8; ++k) ob[k] = f2bf(o[k] * rs * siluf_(gg[k]));
        uint4 ov; ov.x = ob[0] | ((unsigned)ob[1] << 16); ov.y = ob[2] | ((unsigned)ob[3] << 16); ov.z = ob[4] | ((unsigned)ob[5] << 16); ov.w = ob[6] | ((unsigned)ob[7] << 16);
        *(uint4*)(p.mixb + (size_t)r * D + 8 * lane) = ov;
    }
}
__device__ __forceinline__ void mf_lconv(const P& p, LAS unsigned char* lds, int il) {
    int tid = threadIdx.x; asm volatile("" : "+v"(tid));
    int bx_ = (int)blockIdx.x, gx_ = (int)gridDim.x; asm volatile("" : "+s"(bx_), "+s"(gx_));
    for (int c = bx_; c < HYW; c += gx_) lconv_unit(p, il, c, (LAS CX*)lds, p.zf + (size_t)bx_ * 2 * FFTN, tid, NTHREADS);
}
__device__ __forceinline__ void mf_inproj(const P& p, LAS unsigned char* lds, int layer) {
    const int il = layer >> 1; const bool ab = !(layer & 1);
    pg8::Gemm g{p.hxb, ab ? p.abin_t + (size_t)il * AB_IN * D : p.cdin_t + (size_t)il * CD_IN * D, NTOK, ab ? AB_IN : CD_IN, D, 0};
    int gx_ = (int)gridDim.x, bx_ = (int)blockIdx.x; asm volatile("" : "+s"(gx_), "+s"(bx_));
    pg8::StaticOrder S; S.init(g.M, g.N, gx_, bx_);
    pg8::EpiStoreBf16 E{p.px, PXLD};
    pg8::gemm_phase(lds, g, S, E);
}
__device__ __forceinline__ void mf_outproj(const P& p, LAS unsigned char* lds, int layer, int nrows) {
    const int il = layer >> 1; const bool ab = !(layer & 1);
    pg8::Gemm g{p.mixb, (ab ? p.about_t : p.cdout_t) + (size_t)il * D * D, nrows, D, D, 0};
    int gx_ = (int)gridDim.x, bx_ = (int)blockIdx.x; asm volatile("" : "+s"(gx_), "+s"(bx_));
    pg8::StaticOrder S; S.init(g.M, g.N, gx_, bx_);
    pg8::EpiResid E{p.xa, p.modv + (size_t)layer * 3 * 6 * D + 2 * D};
    pg8::gemm_phase(lds, g, S, E);
}
__device__ __forceinline__ void mf_glu(const P& p, LAS unsigned char* lds, int il) {
    pg8::Gemm g{p.ys5b, p.glu_t + (size_t)il * S5W * S5W, NTOK, S5W, S5W, 0};
    int gx_ = (int)gridDim.x, bx_ = (int)blockIdx.x; asm volatile("" : "+s"(gx_), "+s"(bx_));
    pg8::StaticOrder S; S.init(g.M, g.N, gx_, bx_);
    pg8::EpiGlu E{p.mixb, p.ys5b, p.s5_glu_b + il * S5W};
    pg8::gemm_phase(lds, g, S, E);
}
__device__ __forceinline__ int build_ue(const P& p, LAS unsigned char* lds, int layer) {
    volatile LAS unsigned char* ue = (volatile LAS unsigned char*)(lds + UE_OFF); volatile LAS int* tot = (volatile LAS int*)(lds + MISC_OFF + 16);
    __syncthreads();
    if (threadIdx.x == 0) { const int* cnt = p.cnt + layer * NE; int t = 0;
        for (int e = 0; e < NE; ++e) { const int nt = (cnt[e] + 255) >> 8; for (int q = 0; q < nt; ++q) ue[t + q] = (unsigned char)e; t += nt; }
        *tot = t; }
    __syncthreads();
    return *tot;
}
__device__ __forceinline__ void mf_moe1(const P& p, LAS unsigned char* lds, int layer) {
    const int tiles = build_ue(p, lds, layer);
    int gx_ = (int)gridDim.x, bx_ = (int)blockIdx.x; asm volatile("" : "+s"(gx_), "+s"(bx_));
    pg8::MoeOrder S{tiles * 8, 8, gx_, bx_, (const volatile LAS unsigned char*)(lds + UE_OFF), (const volatile LAS int*)(lds + TOK_OFF)};
    volatile LAS int* tokt = (volatile LAS int*)(lds + TOK_OFF);
    { int tid = threadIdx.x; asm volatile("" : "+v"(tid));
      for (int i = 0; i < TOK_UNITS; ++i) { int pm, pn; if (!S.unit(i, pm, pn)) break;
          for (int t = tid; t < 256; t += NTHREADS) { const int tk = p.slot_tok[pm * 256 + t]; tokt[i * 256 + t] = tk < 0 ? NTOK : tk; } }
      __syncthreads(); }
    pg8::Gemm g{p.hxb, p.wgu_t + (size_t)layer * NE * 2 * DFF * D, tiles * 256, 2 * DFF, D, (size_t)2 * DFF * D * 2};
    pg8::EpiSwiglu E{p.actb, p.b_gu + (size_t)layer * NE * 2 * DFF};
    pg8::gemm_phase<pg8::EpiSwiglu, pg8::MoeOrder, true>(lds, g, S, E);
}
__device__ __forceinline__ void mf_moe2(const P& p, LAS unsigned char* lds, int layer) {
    const int tiles = build_ue(p, lds, layer);
    pg8::Gemm g{p.actb, p.wdn_t + (size_t)layer * NE * D * DFF, tiles * 256, D, DFF, (size_t)D * DFF * 2};
    int gx_ = (int)gridDim.x, bx_ = (int)blockIdx.x; asm volatile("" : "+s"(gx_), "+s"(bx_));
    pg8::MoeOrder S{tiles * 4, 4, gx_, bx_, (const volatile LAS unsigned char*)(lds + UE_OFF), nullptr};
    pg8::EpiDown E{p.yb, p.b_dn + (size_t)layer * NE * D, p.slot_gate};
    pg8::gemm_phase(lds, g, S, E);
}

#define XB_TMO      128
#define XB_XCNT(j)  (256  + 64 * (j))
#define XB_XSUB(j)  (1280 + 64 * (j))
#define XB_XGEN(j)  (2304 + 64 * (j))
#define XB_TOP      3328
#define XB_TOPGEN   3392
#define XCD_BAR_WORDS 3456
#define XB_SPIN_CAP (1u << 18)

__device__ __forceinline__ unsigned xb_ld(unsigned* p)              { return __hip_atomic_load(p, __ATOMIC_RELAXED, __HIP_MEMORY_SCOPE_AGENT); }
__device__ __forceinline__ unsigned xb_add(unsigned* p, unsigned v) { return __hip_atomic_fetch_add(p, v, __ATOMIC_RELAXED, __HIP_MEMORY_SCOPE_AGENT); }
__device__ __forceinline__ unsigned xb_xcc_id() { return (unsigned)__builtin_amdgcn_s_getreg((3 << 11) | 20) & 0xFu; }
#define XB_SPIN(cond, bar) do { unsigned _sp = 0; while (cond) { __builtin_amdgcn_s_sleep(1); \
    if ((++_sp & 255u) == 0u) { if (xb_ld(&(bar)[XB_TMO])) break; if (_sp > XB_SPIN_CAP) { atomicAdd(&(bar)[XB_TMO], 1u); break; } } } } while (0)

struct XcdBarrier { unsigned* bar; unsigned x; volatile LAS unsigned* st; };

__device__ __forceinline__ XcdBarrier xcd_barrier_post(unsigned* bar, volatile LAS unsigned* st) {
    XcdBarrier b; b.bar = bar; b.x = xb_xcc_id(); b.st = st;
    if (threadIdx.x == 0) (void)xb_add(&bar[XB_XCNT(b.x)], 1u);
    return b;
}
__device__ __forceinline__ void xcd_barrier_complete(unsigned* bar, unsigned x, unsigned& nloc, unsigned& nx) {
    const unsigned G = gridDim.x * gridDim.y * gridDim.z;
    unsigned sum, cnt, mine, sp = 0u;
    asm volatile("" : "+s"(x));
    for (;;) {
        sum = 0u; cnt = 0u; mine = 0u;
#pragma unroll
        for (unsigned j = 0; j < 16; ++j) { const unsigned c = xb_ld(&bar[XB_XCNT(j)]); sum += c; cnt += (c > 0u) ? 1u : 0u; mine = (j == x) ? c : mine; }
        if (sum == G) break;
        __builtin_amdgcn_s_sleep(1);
        if ((++sp & 255u) == 0u) { if (xb_ld(&bar[XB_TMO])) break; if (sp > XB_SPIN_CAP) { atomicAdd(&bar[XB_TMO], 1u); break; } }
    }
    nloc = mine > 0u ? mine : 1u; nx = cnt > 0u ? cnt : 1u;
}
__device__ __forceinline__ void xcd_barrier(const XcdBarrier& b) {
    asm volatile("s_waitcnt vmcnt(0)" ::: "memory");
    __syncthreads();
    if (threadIdx.x == 0) {
        unsigned* bar = b.bar; unsigned bx = b.x;
        asm volatile("" : "+s"(bar), "+s"(bx));
        __builtin_amdgcn_s_waitcnt(0);
        unsigned nloc = b.st[0], nx = b.st[1];
        if (nloc == 0u) { xcd_barrier_complete(bar, bx, nloc, nx); b.st[0] = nloc; b.st[1] = nx; }
        const unsigned old = xb_add(&bar[XB_XSUB(bx)], 1u);
        const unsigned gen = old / nloc;
        if (old + 1u == (gen + 1u) * nloc) {
            __builtin_amdgcn_fence(__ATOMIC_RELEASE, "agent");
            asm volatile("s_waitcnt vmcnt(0)" ::: "memory");
            const unsigned og = xb_add(&bar[XB_TOP], 1u);
            const unsigned tg = og / nx;
            if (og + 1u == (tg + 1u) * nx) xb_add(&bar[XB_TOPGEN], 1u);
            else XB_SPIN(xb_ld(&bar[XB_TOPGEN]) == tg, bar);
            __builtin_amdgcn_fence(__ATOMIC_ACQUIRE, "agent");
            xb_add(&bar[XB_XGEN(bx)], 1u);
            asm volatile("s_waitcnt vmcnt(0)" ::: "memory");
        } else {
            XB_SPIN(xb_ld(&bar[XB_XGEN(bx)]) == gen, bar);
            __builtin_amdgcn_fence(__ATOMIC_ACQUIRE, "agent");
            asm volatile("s_waitcnt vmcnt(0)" ::: "memory");
        }
    }
    __syncthreads();
}

typedef const __attribute__((address_space(4))) P* KP;
__global__ void __launch_bounds__(NTHREADS, 2) fwd_kernel(P p_arg) {
    (void)p_arg;
    const KP kp0 = (KP)__builtin_amdgcn_kernarg_segment_ptr();
#define p (*(const P*)({ KP q_ = kp0; asm volatile("" : "+s"(q_)); q_; }))
    extern __shared__ __attribute__((aligned(16))) unsigned char lds_raw[];
    LAS unsigned char* lds = (LAS unsigned char*)lds_raw;
    for (int u = threadIdx.x; u < (LDS_BYTES - MISC_OFF) / 4; u += NTHREADS) ((LAS unsigned*)(lds + MISC_OFF))[u] = 0u;
    __syncthreads();
    XcdBarrier bar = xcd_barrier_post(p.bar, (volatile LAS unsigned*)(lds + MISC_OFF));
    const long gs = (long)gridDim.x * NTHREADS;
#define gt ({ int b_ = (int)blockIdx.x; asm volatile("" : "+s"(b_)); long g_ = (long)b_ * NTHREADS + threadIdx.x; asm volatile("" : "+v"(g_)); g_; })
#define SETUP(S) setup_slot<S>(p, gt, gs); xcd_barrier(bar);
    for (int rep = 0; rep < REP_SETUP; ++rep) {
    setup_slot<0>(p, gt, gs); mf_filter_tiles(p, lds); __syncthreads(); ph_convert_weights(p, lds); xcd_barrier(bar);
    ph_mod2(p, gt, gs); ph_filt4(p, gt, gs); xcd_barrier(bar);
    }
#define SLOT(S) layer_slot<S>(p, layer, gt, gs); xcd_barrier(bar);
#if MFMA_DENSE
#define DENSE_IN  for (int rep = 0; rep < REP_IN; ++rep) { mf_inproj(p, lds, layer); if (layer < 3) convert_deferred(p, lds, layer, 0); xcd_barrier(bar); }
#define DENSE_OUT if (!(layer & 1)) mf_glu(p, lds, layer >> 1); else ph_retout(p, layer < 3 ? NTOK : NLAT, gt, gs); xcd_barrier(bar); \
                  mf_outproj(p, lds, layer, layer < 3 ? NTOK : NLAT); xcd_barrier(bar);
#else
#define DENSE_IN  SLOT(2)
#define DENSE_OUT SLOT(7) SLOT(8)
#endif
#if MFMA_MOE
#define MOE_GEMMS for (int rep = 0; rep < REP_MOE; ++rep) { mf_moe1(p, lds, layer); xcd_barrier(bar); } for (int rep = 0; rep < REP_MOE2; ++rep) { mf_moe2(p, lds, layer); xcd_barrier(bar); }
#else
#define MOE_GEMMS SLOT(14) SLOT(15)
#endif
#define REPF(n) for (int rep_ = 0; rep_ < (n); ++rep_)
#define LAYER(L) { constexpr int layer = L; constexpr bool AB = !(layer & 1); constexpr int il = layer >> 1; constexpr int nrows = layer < 3 ? NTOK : NLAT; \
    REPF(RN) mf_rownorm<0>(p, lds, layer, NTOK, layer - 1); xcd_barrier(bar); DENSE_IN \
    REPF(R3) { if (AB) { mf_s5<false>(p, lds, il); mf_sconv(p, lds, il); } else ph_rope(p, gt, gs); } xcd_barrier(bar); \
    REPF(R4) { if (AB) { mf_lconv(p, lds, il); ph_lconv(p, il, NLAT, NTOK, gt, gs); } else mf_retkv(p, lds, il); } if (AB) ph_s5carry(p, il, gt, gs); xcd_barrier(bar); \
    REPF(R5) { if (AB) { mf_s5<true>(p, lds, il); mf_hymix(p, lds, il); } else mf_swa(p, lds, il, layer < 3); } if (!AB) ph_retcarry(p, il, gt, gs); xcd_barrier(bar); \
    REPF(R6) { if (AB) ph_s5fin(p, il, gt, gs); else mf_reto(p, lds, il); } xcd_barrier(bar); \
    REPF(R7) { if (AB) mf_glu(p, lds, il); else mf_retout(p, nrows); } xcd_barrier(bar); \
    mf_outproj(p, lds, layer, nrows); if (layer < 3) convert_deferred(p, lds, layer, 1); xcd_barrier(bar); \
    mf_rownorm<1>(p, lds, layer, nrows, -1); xcd_barrier(bar); SLOT(12) MOE_GEMMS }
    LAYER(0) LAYER(1) LAYER(2) LAYER(3)
    mf_rownorm<2>(p, lds, 3, NLAT, 3);
#undef gt
#undef p
}

extern "C" void kernel_launch(void* const* d_in, const int* in_sizes, int n_in, void* d_out, int out_size, void* d_ws, size_t ws_size, hipStream_t stream) {
    (void)in_sizes; (void)n_in; (void)out_size;
    const WsMap m = ws_map();
    if (ws_size < m.total) { fprintf(stderr, "workspace too small: %zu < %zu\n", ws_size, m.total); return; }
    P p; memset(&p, 0, sizeof(p)); fill_params(p, d_in, d_out, d_ws);
    static int grid = 0;
    if (!grid) {
        int dev = 0, cus = 0, per_cu = 0;
        (void)hipGetDevice(&dev); (void)hipDeviceGetAttribute(&cus, hipDeviceAttributeMultiprocessorCount, dev);
        if (hipFuncSetAttribute((const void*)fwd_kernel, hipFuncAttributeMaxDynamicSharedMemorySize, LDS_BYTES) != hipSuccess) { fprintf(stderr, "hipFuncSetAttribute failed\n"); grid = -1; return; }
        (void)hipOccupancyMaxActiveBlocksPerMultiprocessor(&per_cu, (const void*)fwd_kernel, NTHREADS, LDS_BYTES);
        if (per_cu < 1) fprintf(stderr, "occupancy query reports %d blocks per CU\n", per_cu);
        grid = cus;
    }
    if (grid <= 0) return;
    (void)hipMemsetAsync(p.bar, 0, XCD_BAR_WORDS * sizeof(unsigned), stream);
    fwd_kernel<<<dim3(grid), dim3(NTHREADS), LDS_BYTES, stream>>>(p);
}
#endif
```

```cpp
#ifndef CPU_SHIM
#include <hip/hip_runtime.h>
#include <cstring>
#include <cstdio>
#include <cstdint>
#define DEV __device__ __forceinline__
#else
#include <cmath>
#include <cstdio>
#include <cstdint>
#include <cstring>
#include <cstdlib>
#define DEV static inline
static inline float rsqrtf(float x) { return 1.0f / sqrtf(x); }
#endif

#ifndef SEQ
#define SEQ 8192
#endif
#ifndef CTXL
#define CTXL 256
#endif
#ifndef N_LAUNCH_MODE
#define N_LAUNCH_MODE 1
#endif
#ifdef CPU_SHIM
#define MFMA_DENSE 0
#define MFMA_MOE 0
#endif
#ifndef R3
#define R3 1
#endif
#ifndef R4
#define R4 1
#endif
#ifndef R5
#define R5 1
#endif
#ifndef R6
#define R6 1
#endif
#ifndef R7
#define R7 1
#endif
#ifndef RG
#define RG 1
#endif
#ifndef RN
#define RN 1
#endif
#ifndef REP_SETUP
#define REP_SETUP 1
#endif
#ifndef REP_MOE
#define REP_MOE 1
#endif
#ifndef REP_MOE2
#define REP_MOE2 1
#endif
#ifndef REP_IN
#define REP_IN 1
#endif
#ifndef REP_RET
#define REP_RET 1
#endif
#ifndef REP_SWA
#define REP_SWA 1
#endif
#ifndef REP_S5
#define REP_S5 1
#endif
#ifndef MFMA_DENSE
#define MFMA_DENSE 1
#endif
#ifndef MFMA_MOE
#define MFMA_MOE 1
#endif
typedef unsigned short bf16_t;
#if MFMA_DENSE
typedef unsigned short px_t;
#else
typedef float px_t;
#endif

constexpr int D = 1024, NLAT = 2 * SEQ, NCTX = 2 * CTXL, NTOK = NLAT + NCTX;
constexpr int HYW = 512, S5W = 512, NG = 32, NP = 64, GH = 16;
constexpr int AB_IN = 2048, CD_IN = 2304, PXLD = 2304;
constexpr int NE = 32, DFF = 1024;
constexpr float EPS = 1e-6f;
constexpr int NSLOT = ((NTOK * 4 + 255) / 256 + NE) * 256;
#ifdef CPU_SHIM
DEV bf16_t f2bf(float f) { unsigned u; memcpy(&u, &f, 4); return (bf16_t)((u + 0x7fffu + ((u >> 16) & 1u)) >> 16); }
DEV float fexp(float x) { return expf(x); }
DEV float frcp(float x) { return 1.0f / x; }
#else
DEV bf16_t f2bf(float f) { const __bf16 b = (__bf16)f; return __builtin_bit_cast(unsigned short, b); }
DEV float fexp(float x) { return __builtin_amdgcn_exp2f(1.4426950408889634f * x); }
DEV float frcp(float x) { return __builtin_amdgcn_rcpf(x); }
#endif
DEV float bf2f(bf16_t b) { const unsigned u = (unsigned)b << 16; float f; memcpy(&f, &u, 4); return f; }
DEV float pxf(float v) { return v; }
DEV float pxf(bf16_t v) { return bf2f(v); }
DEV void pxstore(float* q, float v) { *q = v; }
DEV void pxstore(bf16_t* q, float v) { *q = f2bf(v); }

struct P {
    const float *x, *c, *ctx, *c_ctx, *mod_w, *mod_b, *norm1_g, *norm2_g, *ab_w_in, *ab_w_out, *hy_short_w, *hy_short_b,
        *hy_f_w1, *hy_f_b1, *hy_f_w2, *hy_f_b2, *hy_f_w3, *hy_bias, *s5_lre, *s5_lim, *s5_ldt, *s5_bre, *s5_bim, *s5_cre, *s5_cim,
        *s5_d, *s5_glu_w, *s5_glu_b, *cd_w_in, *cd_w_out, *ret_decay, *swa_sink, *router_w, *router_b, *w_gu, *b_gu, *w_dn, *b_dn, *final_g;
    float* out;
    unsigned* bar;
    float *xa, *modv, *f1, *f2, *hraw, *hsum, *rstd, *hx, *zb, *x0c, *mixin, *s5s, *ys5, *qr, *kr, *oret, *qs, *ks, *topg, *act;
    int* topi;
    px_t* px;
    bf16_t *hxb, *mixb, *ys5b, *xb, *actb, *abin_t, *cdin_t, *about_t, *cdout_t, *glu_t, *wgu_t, *wdn_t;
    bf16_t* yb;
    float *zT, *hT, *modp;
    float *slot_gate, *s5c, *rkv, *rsc, *hpart, *zf, *convT, *yd;
    int *cnt, *pos, *slot_of, *slot_tok;
};

struct RowInfo { int base, len, t, m, kind; };
DEV RowInfo row_info(int r) {
    RowInfo ri;
    if (r < NLAT) { const int b = r / SEQ; ri.base = b * SEQ; ri.len = SEQ; ri.t = r - ri.base; ri.m = b; ri.kind = 0; }
    else { const int rc = r - NLAT, b = rc / CTXL; ri.base = NLAT + b * CTXL; ri.len = CTXL; ri.t = rc - b * CTXL; ri.m = 2; ri.kind = 1; }
    return ri;
}
DEV float sigmoidf_(float x) { return frcp(1.0f + fexp(-x)); }
DEV float siluf_(float x) { return x * sigmoidf_(x); }
DEV float gelu_tanhf_(float x) { const float u = 0.7978845608028654f * (x + 0.044715f * x * x * x); return x * frcp(1.0f + fexp(-2.0f * u)); }

#ifdef CPU_SHIM
#define GSL(i, n) const long _n_##i = (long)(n); for (long i = _n_##i * gt / gs, _hi_##i = _n_##i * (gt + 1) / gs; i < _hi_##i; ++i)
#else
#define GSL(i, n) for (long i = gt; i < (long)(n); i += gs)
#endif

#if MFMA_DENSE
#define MIXST(idx, v) p.mixb[idx] = f2bf(v)
#else
#define MIXST(idx, v) p.mixin[idx] = (v)
#endif
DEV long filt_row0(int i, int kind) { return (long)i * (SEQ + CTXL) + (kind ? SEQ : 0); }

#ifdef CPU_SHIM
#define ROPE_COS(a) cosf(a)
#define ROPE_SIN(a) sinf(a)
#else
#define ROPE_COS(a) __builtin_amdgcn_cosf(__builtin_amdgcn_fractf((a) * 0.15915494309189535f))
#define ROPE_SIN(a) __builtin_amdgcn_sinf(__builtin_amdgcn_fractf((a) * 0.15915494309189535f))
#endif
DEV void ph_init(const P& p, long gt, long gs) {
    GSL(i, (long)NTOK * D) { p.xa[i] = i < (long)NLAT * D ? p.x[i] : p.ctx[i - (long)NLAT * D]; }
    GSL(j, 4 * NE) { p.cnt[j] = 0; }
    GSL(z, D) { p.hxb[(long)NTOK * D + z] = 0; }
}
DEV void ph_mod(const P& p, long gt, long gs) {
    GSL(i, 4L * 6 * D * 8) {
        const int j = (int)(i % (6 * D)), kq = (int)((i / (6 * D)) % 8), l = (int)(i / (6 * D * 8));
        const float* w = p.mod_w + (long)l * D * 6 * D + j;
        float a0 = 0.f, a1 = 0.f, a2 = 0.f;
        for (int k = kq * (D / 8); k < (kq + 1) * (D / 8); ++k) { const float wv = w[(long)k * 6 * D]; a0 += siluf_(p.c[k]) * wv; a1 += siluf_(p.c[D + k]) * wv; a2 += siluf_(p.c_ctx[k]) * wv; }
        float* o = p.modp + ((long)kq * 4 + l) * 3 * 6 * D + j;
        o[0] = a0; o[6 * D] = a1; o[12 * D] = a2;
    }
}
DEV void ph_mod2(const P& p, long gt, long gs) {
    GSL(i, 4L * 3 * 6 * D) {
        const int j = (int)(i % (6 * D)), l = (int)(i / (18 * D));
        float a = p.mod_b[l * 6 * D + j];
#pragma unroll
        for (int kq = 0; kq < 8; ++kq) a += p.modp[(long)kq * 4 * 3 * 6 * D + i];
        p.modv[i] = a;
    }
}
DEV void ph_filt1(const P& p, long gt, long gs) {
    GSL(idx, 2L * (SEQ + CTXL) * 64) {
        const int j = (int)(idx % 64); const long rr = idx / 64; const int i = (int)(rr / (SEQ + CTXL)); const int q = (int)(rr % (SEQ + CTXL));
        const int kind = q >= SEQ, pos = kind ? q - SEQ : q, L = kind ? CTXL : SEQ;
        const float* w1 = p.hy_f_w1 + i * 33 * 64;
        const float t = (float)pos / (float)L, w = 6.283185307179586f * (float)pos / (float)L;
        float acc = t * w1[j];
        for (int bi = 0; bi < 16; ++bi) {
            const float band = 1e-4f + (float)bi * ((15.0f - 1e-4f) / 15.0f);
            acc += ROPE_COS(band * w) * w1[(1 + bi) * 64 + j] - ROPE_SIN(band * w) * w1[(17 + bi) * 64 + j];
        }
        p.f1[idx] = ROPE_SIN(acc + p.hy_f_b1[i * 64 + j]);
    }
}
DEV void ph_filt2(const P& p, long gt, long gs) {
    GSL(idx, 2L * (SEQ + CTXL) * 64) {
        const int j = (int)(idx % 64); const long rr = idx / 64; const int i = (int)(rr / (SEQ + CTXL));
        const float* w2 = p.hy_f_w2 + i * 64 * 64; const float* h1 = p.f1 + rr * 64;
        float acc = 0.f;
        for (int k = 0; k < 64; ++k) acc += h1[k] * w2[k * 64 + j];
        p.f2[idx] = ROPE_SIN(acc + p.hy_f_b2[i * 64 + j]);
    }
}
DEV void ph_filt3(const P& p, long gt, long gs) {
    GSL(idx, 2L * (SEQ + CTXL) * HYW) {
        const int c = (int)(idx % HYW); const long rr = idx / HYW; const int i = (int)(rr / (SEQ + CTXL)); const int q = (int)(rr % (SEQ + CTXL));
        const int kind = q >= SEQ, pos = kind ? q - SEQ : q, L = kind ? CTXL : SEQ;
        const float* w3 = p.hy_f_w3 + (long)i * 64 * HYW; const float* h2 = p.f2 + rr * 64;
        float acc = 0.f;
        for (int k = 0; k < 64; ++k) acc += h2[k] * w3[k * HYW + c];
        const float lag = fabsf((float)(pos - L / 2)) / (float)(L / 2);
        const float fast = -15.350567286626973f, slow = -3.0701134573253946f;
        const float delta = fabsf(fast + (slow - fast) * (float)c / 511.0f);
        const float hv = acc * (expf(-lag * delta) + 0.05f);
        p.hraw[idx] = hv; if (!kind) p.hT[((long)i * HYW + c) * SEQ + pos] = hv;
    }
}
constexpr int FSEG = 64, FNSEG = (SEQ + CTXL) / FSEG;
DEV void ph_filt4a(const P& p, long gt, long gs) {
    GSL(idx, 2L * FNSEG * HYW) {
        const int c = (int)(idx % HYW); const long sg = idx / HYW; const float* h = p.hraw + sg * FSEG * HYW + c;
        float s = 0.f;
        for (int q = 0; q < FSEG; ++q) s += fabsf(h[(long)q * HYW]);
        p.hpart[idx] = s;
    }
}
DEV void ph_filt4(const P& p, long gt, long gs) {
    GSL(idx, 2 * 2 * HYW) {
        const int c = (int)(idx % HYW), kind = (int)((idx / HYW) % 2), i = (int)(idx / (2 * HYW));
        const int s0 = (int)(filt_row0(i, kind) / FSEG), ns = (kind ? CTXL : SEQ) / FSEG;
        float s = 0.f;
        for (int q = 0; q < ns; ++q) s += p.hpart[(long)(s0 + q) * HYW + c];
        p.hsum[idx] = s;
    }
}
DEV void ph_rstd(const P& p, int nrows, long gt, long gs) {
    GSL(r, nrows) {
        const float* xr = p.xa + r * D; float s = 0.f;
        for (int k = 0; k < D; ++k) s += xr[k] * xr[k];
        p.rstd[r] = rsqrtf(s * (1.0f / D) + EPS);
    }
}
DEV void ph_hx(const P& p, int layer, int which, int nrows, long gt, long gs) {
    const float* g = (which ? p.norm2_g : p.norm1_g) + layer * D;
    GSL(i, (long)nrows * D) {
        const int k = (int)(i % D), r = (int)(i / D); const RowInfo ri = row_info(r);
        const float* mv = p.modv + ((long)layer * 3 + ri.m) * 6 * D + which * 3 * D;
        const float v = p.xa[i] * p.rstd[r] * g[k] * (1.0f + mv[D + k]) + mv[k];
        p.hx[i] = v; p.hxb[i] = f2bf(v);
    }
}
DEV void ph_inproj(const P& p, const float* w, int nin, long gt, long gs) {
    GSL(i, (long)NTOK * nin) {
        const int n = (int)(i % nin), r = (int)(i / nin); const float* a = p.hx + (long)r * D; const float* b = w + n;
        float acc = 0.f;
        for (int k = 0; k < D; ++k) acc += a[k] * b[(long)k * nin];
        pxstore(&p.px[(long)r * PXLD + n], acc);
    }
}
DEV void ph_sconv(const P& p, int il, long gt, long gs) {
    const float* sw = p.hy_short_w + il * 3 * 1536; const float* sb = p.hy_short_b + il * 1536;
    GSL(i, (long)NTOK * HYW) {
        const int c = (int)(i % HYW), r = (int)(i / HYW); const RowInfo ri = row_info(r);
        float u[3];
#pragma unroll
        for (int s = 0; s < 3; ++s) {
            const int col = s * HYW + c; float acc = sb[col];
#pragma unroll
            for (int j = 0; j < 3; ++j) { const int tt = ri.t + j - 1; if (tt >= 0 && tt < ri.len) acc += sw[j * 1536 + col] * pxf(p.px[(long)(ri.base + tt) * PXLD + col]); }
            u[s] = acc;
        }
        p.x0c[i] = u[0]; p.zb[i] = u[2] * u[1]; if (r < NLAT) p.zT[(long)c * NLAT + r] = u[2] * u[1];
    }
}
DEV void ph_lconv(const P& p, int il, int r0, int r1, long gt, long gs) {
    GSL(i0, (long)(r1 - r0) * HYW) {
        const long i = i0 + (long)r0 * HYW;
        const int c = (int)(i % HYW), r = (int)(i / HYW); const RowInfo ri = row_info(r);
        const int L = ri.len, t = ri.t;
        const float* h = p.hraw + filt_row0(il, ri.kind) * HYW + c; const float* z = p.zb + (long)ri.base * HYW + c;
        int s0 = t + L / 2 - (L - 1); if (s0 < 0) s0 = 0; int s1 = t + L / 2; if (s1 > L - 1) s1 = L - 1;
        float acc = 0.f;
#pragma unroll 8
        for (int s = s0; s <= s1; ++s) acc += h[(long)(t - s + L / 2) * HYW] * z[(long)s * HYW];
        const float y = acc / p.hsum[(il * 2 + ri.kind) * HYW + c] + p.hy_bias[il * HYW + c] * p.zb[i];
        MIXST((long)r * D + c, p.x0c[i] * y);
    }
}
constexpr int FFTN = 2 * SEQ, FFT_NS = (SEQ == 8192 ? 7 : SEQ == 2048 ? 6 : SEQ == 512 ? 5 : SEQ == 128 ? 4 : -1);
static_assert(FFT_NS > 0 && (1 << (2 * FFT_NS)) == FFTN, "2*SEQ must be a power of 4");
struct CX { float x, y; };
#define PADX(n) ((n) + ((n) >> 5))
constexpr int FFT_ELEMS = FFTN + (FFTN >> 5);
#ifdef CPU_SHIM
#define COS2PI(f) cosf(6.283185307179586f * (f))
#define SIN2PI(f) sinf(6.283185307179586f * (f))
#define FFT_SYNC()
#else
#define COS2PI(f) __builtin_amdgcn_cosf(f)
#define SIN2PI(f) __builtin_amdgcn_sinf(f)
#define FFT_SYNC() __syncthreads()
#endif
template <class XP> DEV CX cx_ld(XP x, int i) { CX r; r.x = x[i].x; r.y = x[i].y; return r; }
template <class XP> DEV void cx_st(XP x, int i, CX v) { x[i].x = v.x; x[i].y = v.y; }
DEV CX cx_add(CX a, CX b) { return CX{a.x + b.x, a.y + b.y}; }
DEV CX cx_sub(CX a, CX b) { return CX{a.x - b.x, a.y - b.y}; }
DEV CX cx_mul(CX a, CX b) { return CX{a.x * b.x - a.y * b.y, a.x * b.y + a.y * b.x}; }
template <class XP> DEV void fft_pass(XP x, int s, bool inv, int tid, int nthr) {
    const int lq = 2 * (FFT_NS - 1 - s), Q = 1 << lq;
    const float invB = 1.0f / (float)(4 * Q);
    for (int t = tid; t < FFTN / 4; t += nthr) {
        const int i = t & (Q - 1), base = ((t >> lq) << (lq + 2)) + i;
        const float f = (float)i * invB, cs = COS2PI(f), sn = SIN2PI(f);
        const CX w1 = CX{cs, inv ? sn : -sn}, w2 = cx_mul(w1, w1), w3 = cx_mul(w2, w1);
        const int i0 = PADX(base), i1 = PADX(base + Q), i2 = PADX(base + 2 * Q), i3 = PADX(base + 3 * Q);
        const CX a = cx_ld(x, i0), b = cx_ld(x, i1), c = cx_ld(x, i2), d = cx_ld(x, i3);
        if (!inv) {
            const CX t0 = cx_add(a, c), t1 = cx_sub(a, c), t2 = cx_add(b, d), bd = cx_sub(b, d), t3 = CX{bd.y, -bd.x};
            cx_st(x, i0, cx_add(t0, t2)); cx_st(x, i1, cx_mul(cx_add(t1, t3), w1)); cx_st(x, i2, cx_mul(cx_sub(t0, t2), w2)); cx_st(x, i3, cx_mul(cx_sub(t1, t3), w3));
        } else {
            const CX y0 = a, y1 = cx_mul(b, w1), y2 = cx_mul(c, w2), y3 = cx_mul(d, w3);
            const CX u0 = cx_add(y0, y2), u1 = cx_sub(y0, y2), u2 = cx_add(y1, y3), yd = cx_sub(y1, y3), u3 = CX{-yd.y, yd.x};
            cx_st(x, i0, cx_add(u0, u2)); cx_st(x, i1, cx_add(u1, u3)); cx_st(x, i2, cx_sub(u0, u2)); cx_st(x, i3, cx_sub(u1, u3));
        }
    }
}
DEV void bfly4(CX& a, CX& b, CX& c, CX& d, CX w1, bool inv, bool tw) {
    const CX w2 = cx_mul(w1, w1), w3 = cx_mul(w2, w1);
    if (!inv) {
        const CX t0 = cx_add(a, c), t1 = cx_sub(a, c), t2 = cx_add(b, d), bd = cx_sub(b, d), t3 = CX{bd.y, -bd.x};
        a = cx_add(t0, t2); b = cx_add(t1, t3); c = cx_sub(t0, t2); d = cx_sub(t1, t3);
        if (tw) { b = cx_mul(b, w1); c = cx_mul(c, w2); d = cx_mul(d, w3); }
    } else {
        CX y1 = b, y2 = c, y3 = d;
        if (tw) { y1 = cx_mul(b, w1); y2 = cx_mul(c, w2); y3 = cx_mul(d, w3); }
        const CX u0 = cx_add(a, y2), u1 = cx_sub(a, y2), u2 = cx_add(y1, y3), yd = cx_sub(y1, y3), u3 = CX{-yd.y, yd.x};
        a = cx_add(u0, u2); b = cx_add(u1, u3); c = cx_sub(u0, u2); d = cx_sub(u1, u3);
    }
}
template <class XP> DEV void fft_pass16(XP x, int s, bool inv, int tid, int nthr) {
    const int lq2 = 2 * (FFT_NS - 2 - s), Q2 = 1 << lq2, Q = 4 * Q2;
    const float invB = 1.0f / (float)(16 * Q2);
    const float sg = inv ? 1.0f : -1.0f;
    const CX c1 = CX{0.9238795325112867f, sg * 0.3826834323650898f}, c2 = CX{0.7071067811865476f, sg * 0.7071067811865476f}, c3 = CX{0.3826834323650898f, sg * 0.9238795325112867f};
    for (int t = tid; t < FFTN / 16; t += nthr) {
        const int i = t & (Q2 - 1), base = ((t >> lq2) << (lq2 + 4)) + i;
        const float f = (float)i * invB, cs = COS2PI(f), sn = SIN2PI(f);
        const CX wA = CX{cs, sg * sn};
        CX wB = cx_mul(wA, wA); wB = cx_mul(wB, wB);
        CX v[4][4];
#pragma unroll
        for (int a = 0; a < 4; ++a)
#pragma unroll
            for (int b = 0; b < 4; ++b) v[a][b] = cx_ld(x, PADX(base + a * Q + b * Q2));
        if (!inv) {
            bfly4(v[0][0], v[1][0], v[2][0], v[3][0], wA, false, true);
            bfly4(v[0][1], v[1][1], v[2][1], v[3][1], cx_mul(wA, c1), false, true);
            bfly4(v[0][2], v[1][2], v[2][2], v[3][2], cx_mul(wA, c2), false, true);
            bfly4(v[0][3], v[1][3], v[2][3], v[3][3], cx_mul(wA, c3), false, true);
#pragma unroll
            for (int r = 0; r < 4; ++r) bfly4(v[r][0], v[r][1], v[r][2], v[r][3], wB, false, true);
        } else {
#pragma unroll
            for (int r = 0; r < 4; ++r) bfly4(v[r][0], v[r][1], v[r][2], v[r][3], wB, true, true);
            bfly4(v[0][0], v[1][0], v[2][0], v[3][0], wA, true, true);
            bfly4(v[0][1], v[1][1], v[2][1], v[3][1], cx_mul(wA, c1), true, true);
            bfly4(v[0][2], v[1][2], v[2][2], v[3][2], cx_mul(wA, c2), true, true);
            bfly4(v[0][3], v[1][3], v[2][3], v[3][3], cx_mul(wA, c3), true, true);
        }
#pragma unroll
        for (int a = 0; a < 4; ++a)
#pragma unroll
            for (int b = 0; b < 4; ++b) cx_st(x, PADX(base + a * Q + b * Q2), v[a][b]);
    }
}
template <class XP> DEV void fft_pass_last(XP x, bool inv, int tid, int nthr) {
    for (int t = tid; t < FFTN / 4; t += nthr) {
        const int base = 4 * t; CX a = cx_ld(x, PADX(base)), b = cx_ld(x, PADX(base + 1)), c = cx_ld(x, PADX(base + 2)), d = cx_ld(x, PADX(base + 3));
        bfly4(a, b, c, d, CX{1.f, 0.f}, inv, false);
        cx_st(x, PADX(base), a); cx_st(x, PADX(base + 1), b); cx_st(x, PADX(base + 2), c); cx_st(x, PADX(base + 3), d);
    }
}
static_assert(FFT_NS % 2 == 1, "pass schedule: (FFT_NS - 1) / 2 radix-16 passes + one radix-4 pass");
template <class XP> DEV void fft_forward(XP x, int tid, int nthr) {
    for (int s = 0; s + 1 < FFT_NS; s += 2) { fft_pass16(x, s, false, tid, nthr); FFT_SYNC(); }
    fft_pass_last(x, false, tid, nthr); FFT_SYNC();
}
template <class XP> DEV void fft_inverse(XP x, int tid, int nthr) {
    fft_pass_last(x, true, tid, nthr); FFT_SYNC();
    for (int s = FFT_NS - 3; s >= 0; s -= 2) { fft_pass16(x, s, true, tid, nthr); FFT_SYNC(); }
}
template <class XP> DEV void lconv_unit(const P& p, int il, int c, XP x, float* zf, int tid, int nthr) {
    constexpr int L = SEQ, N = FFTN;
    const float* zc = p.zT + (long)c * NLAT;
#pragma unroll 8
    for (int n = tid; n < L; n += nthr) { CX v; v.x = zc[n]; v.y = zc[SEQ + n]; cx_st(x, PADX(n), v); }
#pragma unroll 8
    for (int n = L + tid; n < N; n += nthr) cx_st(x, PADX(n), CX{0.f, 0.f});
    FFT_SYNC();
    fft_forward(x, tid, nthr);
    const float* h = p.hT + ((long)il * HYW + c) * SEQ;
#pragma unroll 8
    for (int n = tid; n < L; n += nthr) { const float hv = h[n]; const CX v = cx_ld(x, PADX(n)); zf[2 * n] = v.x; zf[2 * n + 1] = v.y; cx_st(x, PADX(n), CX{hv, 0.f}); }
#pragma unroll 8
    for (int n = L + tid; n < N; n += nthr) { const CX v = cx_ld(x, PADX(n)); zf[2 * n] = v.x; zf[2 * n + 1] = v.y; cx_st(x, PADX(n), CX{0.f, 0.f}); }
    FFT_SYNC();
    fft_forward(x, tid, nthr);
#ifndef CPU_SHIM
    asm volatile("s_waitcnt vmcnt(0)" ::: "memory");
#endif
#pragma unroll 8
    for (int n = tid; n < N; n += nthr) { const CX zv{zf[2 * n], zf[2 * n + 1]}; const CX hv = cx_ld(x, PADX(n)); cx_st(x, PADX(n), cx_mul(hv, zv)); }
    FFT_SYNC();
    fft_inverse(x, tid, nthr);
    const float scale = 1.0f / ((float)N * p.hsum[(il * 2 + 0) * HYW + c]);
    float* o = p.convT + (long)c * NLAT;
#pragma unroll 8
    for (int t = tid; t < L; t += nthr) { const CX v = cx_ld(x, PADX(t + L / 2)); o[t] = v.x * scale; o[L + t] = v.y * scale; }
    FFT_SYNC();
}
#ifdef CPU_SHIM
DEV void ph_lconv_fft(const P& p, int il, long gt, long gs) {
    CX* x = (CX*)malloc(sizeof(CX) * FFT_ELEMS);
    GSL(c, HYW) { lconv_unit(p, il, (int)c, x, p.zf + gt * 2 * FFTN, 0, 1); }
    free(x);
}
#endif
DEV void ph_hymix(const P& p, int il, long gt, long gs) {
    GSL(i, (long)NLAT * HYW) {
        const int c = (int)(i % HYW), r = (int)(i / HYW);
        const float y = p.convT[(long)c * NLAT + r] + p.hy_bias[il * HYW + c] * p.zb[i];
        MIXST((long)r * D + c, p.x0c[i] * y);
    }
}
DEV int scan_row(int dir, int b, int n) {
    if (n < CTXL) return NLAT + b * CTXL + (dir ? CTXL - 1 - n : n);
    const int m = n - CTXL; return b * SEQ + (dir ? SEQ - 1 - m : m);
}
constexpr int S5C = 64, S5NCH = (CTXL + SEQ) / S5C;
struct S5Par { float lbr, lbi; float bbr[GH], bbi[GH]; };
DEV void s5_par(const P& p, int il, int dir, int g, int pp, S5Par& q) {
    const int gi = (il * 2 + dir) * NG + g;
    const float lre = fminf(p.s5_lre[gi * NP + pp], -1e-4f), lim = p.s5_lim[gi * NP + pp], dt = expf(p.s5_ldt[gi]);
    const float mag = expf(lre * dt); q.lbr = mag * cosf(lim * dt); q.lbi = mag * sinf(lim * dt);
    const float nr = q.lbr - 1.0f, ni = q.lbi, den = lre * lre + lim * lim;
    const float fr = (nr * lre + ni * lim) / den, fi = (ni * lre - nr * lim) / den;
#pragma unroll
    for (int h = 0; h < GH; ++h) { const float br = p.s5_bre[((long)gi * NP + pp) * GH + h], bi = p.s5_bim[((long)gi * NP + pp) * GH + h]; q.bbr[h] = fr * br - fi * bi; q.bbi[h] = fr * bi + fi * br; }
}
DEV void ph_s5chunk(const P& p, int il, int fill, long gt, long gs) {
    GSL(i, 2L * 2 * S5NCH * NG * NP) {
        const int pp = (int)(i % NP), g = (int)((i / NP) % NG), ch = (int)((i / (NP * NG)) % S5NCH), b = (int)((i / ((long)NP * NG * S5NCH)) % 2), dir = (int)(i / ((long)NP * NG * S5NCH * 2));
        S5Par q; s5_par(p, il, dir, g, pp, q);
        float* ce = p.s5c + ((((long)dir * 2 + b) * S5NCH + ch) * NG + g) * NP * 2 + pp * 2;
        float sr = 0.f, si = 0.f;
        if (fill) { sr = ce[0]; si = ce[1]; }
        for (int k = 0; k < S5C; ++k) {
            const int row = scan_row(dir, b, ch * S5C + k); const px_t* u = p.px + (long)row * PXLD + 1536 + g * GH;
            float ar = 0.f, ai = 0.f;
#pragma unroll
            for (int h = 0; h < GH; ++h) { ar += q.bbr[h] * pxf(u[h]); ai += q.bbi[h] * pxf(u[h]); }
            const float tr = q.lbr * sr - q.lbi * si + ar, ti = q.lbr * si + q.lbi * sr + ai; sr = tr; si = ti;
            if (fill) { float* o = p.s5s + (((long)dir * NTOK + row) * NG + g) * NP * 2 + pp * 2; o[0] = sr; o[1] = si; }
        }
        if (!fill) { ce[0] = sr; ce[1] = si; }
    }
}
DEV void ph_s5carry(const P& p, int il, long gt, long gs) {
    GSL(i, 2 * 2 * NG * NP) {
        const int pp = (int)(i % NP), g = (int)((i / NP) % NG), b = (int)((i / (NP * NG)) % 2), dir = (int)(i / (NP * NG * 2));
        S5Par q; s5_par(p, il, dir, g, pp, q);
        float pr = q.lbr, pi = q.lbi;
#pragma unroll
        for (int t = 0; t < 6; ++t) { const float nr = pr * pr - pi * pi, ni = 2.0f * pr * pi; pr = nr; pi = ni; }
        float cr = 0.f, ci = 0.f;
        float* ce0 = p.s5c + ((((long)dir * 2 + b) * S5NCH) * NG + g) * NP * 2 + pp * 2;
        constexpr int CB = 12;
        for (int c0 = 0; c0 < S5NCH; c0 += CB) {
            float er[CB], ei[CB];
#pragma unroll
            for (int j = 0; j < CB; ++j) if (c0 + j < S5NCH) { const float* ce = ce0 + (long)(c0 + j) * NG * NP * 2; er[j] = ce[0]; ei[j] = ce[1]; }
#pragma unroll
            for (int j = 0; j < CB; ++j) if (c0 + j < S5NCH) { float* ce = ce0 + (long)(c0 + j) * NG * NP * 2; ce[0] = cr; ce[1] = ci;
                const float tr = pr * cr - pi * ci + er[j], ti = pr * ci + pi * cr + ei[j]; cr = tr; ci = ti; }
        }
    }
}
DEV void ph_s5out(const P& p, int il, long gt, long gs) {
    GSL(i, (long)NTOK * S5W) {
        const int ch = (int)(i % S5W), r = (int)(i / S5W), g = ch / GH, h = ch % GH;
        float y = p.s5_d[il * S5W + ch] * pxf(p.px[(long)r * PXLD + 1536 + ch]);
        for (int dir = 0; dir < 2; ++dir) {
            const long ci = (((long)(il * 2 + dir) * NG + g) * GH + h) * NP;
            const float* s = p.s5s + (((long)dir * NTOK + r) * NG + g) * NP * 2;
            for (int pp = 0; pp < NP; ++pp) y += p.s5_cre[ci + pp] * s[pp * 2] - p.s5_cim[ci + pp] * s[pp * 2 + 1];
        }
        { const float gy = gelu_tanhf_(y); p.ys5[i] = gy; p.ys5b[i] = f2bf(gy); }
    }
}
DEV void ph_s5fin(const P& p, int il, long gt, long gs) {
    GSL(i, (long)NTOK * S5W) {
        const int ch = (int)(i % S5W), r = (int)(i / S5W);
        const float y = p.s5_d[il * S5W + ch] * pxf(p.px[(long)r * PXLD + 1536 + ch]) + p.yd[i] + p.yd[(long)NTOK * S5W + i];
        const float gy = gelu_tanhf_(y); p.ys5b[i] = f2bf(gy);
#ifdef CPU_SHIM
        p.ys5[i] = gy;
#endif
    }
}
DEV void ph_glu(const P& p, int il, long gt, long gs) {
    const float* w = p.s5_glu_w + (long)il * S5W * S5W;
    GSL(i, (long)NTOK * S5W) {
        const int ch = (int)(i % S5W), r = (int)(i / S5W); const float* a = p.ys5 + (long)r * S5W;
        float acc = p.s5_glu_b[il * S5W + ch];
        for (int k = 0; k < S5W; ++k) acc += a[k] * w[(long)k * S5W + ch];
        MIXST((long)r * D + HYW + ch, a[ch] * sigmoidf_(acc));
    }
}
DEV void ph_rope(const P& p, long gt, long gs) {
    GSL(i, (long)NTOK * 576) {
        const int it = (int)(i % 576), r = (int)(i / 576); const RowInfo ri = row_info(r); const px_t* pr = p.px + (long)r * PXLD;
        if (it < 256) {
            const int isk = it >= 128, hd = it & 127, h = hd >> 5, d = hd & 31;
            const px_t* src = pr + (isk ? 256 : 0) + h * 64; float x1 = pxf(src[d]), x2 = pxf(src[d + 32]);
            if (ri.kind == 0) { const float inv = exp2f(-(float)d * (13.287712379549449f / 32.0f)), ang = (float)ri.t * inv, cs = ROPE_COS(ang), sn = ROPE_SIN(ang);
                const float y1 = x1 * cs - x2 * sn, y2 = x1 * sn + x2 * cs; x1 = y1; x2 = y2; }
            const float sc = isk ? 1.0f : 0.125f;
            float* dst = (isk ? p.kr : p.qr) + (long)r * 256 + h * 64; dst[d] = x1 * sc; dst[d + 32] = x2 * sc;
        } else {
            const int j = it - 256, isk = j >= 256, hd = isk ? j - 256 : j, h = hd >> 5, e = hd & 31, half = e >> 4, d = e & 15;
            const px_t* src = pr + (isk ? 2048 : 1536) + h * 64 + half * 32; float x1 = pxf(src[d]), x2 = pxf(src[d + 16]);
            if (ri.kind == 0) { const float pos = (float)(half ? (ri.t % 64) : (ri.t / 64)); const float inv = exp2f(-(float)d * (13.287712379549449f / 16.0f)), ang = pos * inv, cs = ROPE_COS(ang), sn = ROPE_SIN(ang);
                const float y1 = x1 * cs - x2 * sn, y2 = x1 * sn + x2 * cs; x1 = y1; x2 = y2; }
            const float sc = isk ? 1.0f : 0.125f;
            float* dst = (isk ? p.ks + (long)r * 128 : p.qs + (long)r * 512) + h * 64 + half * 32; dst[d] = x1 * sc; dst[d + 16] = x2 * sc;
        }
    }
}
constexpr int RC = 128, RNCH = (CTXL + SEQ) / RC;
DEV float ret_logg(const P& p, int il, int dir, int h) { const float dl = p.ret_decay[(il * 2 + dir) * 4 + h]; return -log1pf(expf(-dl)); }
DEV void ph_retkv(const P& p, int il, long gt, long gs) {
    GSL(i, 2L * 2 * RNCH * 4 * 64 * 128) {
        const int e = (int)(i % 128), d = (int)((i / 128) % 64), h = (int)((i / 8192) % 4), n = (int)((i / 32768) % RNCH), b = (int)((i / (32768L * RNCH)) % 2), dir = (int)(i / (32768L * RNCH * 2));
        const float lg = ret_logg(p, il, dir, h);
        float acc = 0.f;
        for (int j = 0; j < RC; ++j) { const int row = scan_row(dir, b, n * RC + j);
            acc += expf((float)(RC - 1 - j) * lg) * p.kr[(long)row * 256 + h * 64 + d] * pxf(p.px[(long)row * PXLD + 512 + h * 128 + e]); }
        p.rkv[i] = acc;
    }
}
DEV void ph_retcarry(const P& p, int il, long gt, long gs) {
    GSL(i, 2L * 2 * 4 * 64 * 128) {
        const int de = (int)(i % 8192), h = (int)((i / 8192) % 4), b = (int)((i / 32768) % 2), dir = (int)(i / 65536);
        const float gc = expf((float)RC * ret_logg(p, il, dir, h));
        float S = 0.f;
        float* q0 = p.rkv + ((((long)dir * 2 + b) * RNCH) * 4 + h) * 8192 + de;
        constexpr int CB = 11;
        for (int n0 = 0; n0 < RNCH; n0 += CB) {
            float kv[CB];
#pragma unroll
            for (int j = 0; j < CB; ++j) if (n0 + j < RNCH) kv[j] = q0[(long)(n0 + j) * 4 * 8192];
#pragma unroll
            for (int j = 0; j < CB; ++j) if (n0 + j < RNCH) { q0[(long)(n0 + j) * 4 * 8192] = S; S = gc * S + kv[j]; }
        }
    }
}
DEV void ph_retsc(const P& p, int il, long gt, long gs) {
    GSL(i, 2L * NTOK * 4 * RC) {
        const int j = (int)(i % RC), h = (int)((i / RC) % 4), r = (int)((i / (RC * 4)) % NTOK), dir = (int)(i / ((long)RC * 4 * NTOK)); const RowInfo ri = row_info(r);
        const int b = ri.kind ? (ri.base - NLAT) / CTXL : ri.base / SEQ;
        const int step = ri.kind ? (dir ? CTXL - 1 - ri.t : ri.t) : CTXL + (dir ? SEQ - 1 - ri.t : ri.t), ii = step % RC, n = step / RC;
        float sc = 0.f;
        if (j <= ii) { const int rj = scan_row(dir, b, n * RC + j); const float* q = p.qr + (long)r * 256 + h * 64; const float* k = p.kr + (long)rj * 256 + h * 64;
            float dot = 0.f;
            for (int d = 0; d < 64; ++d) dot += q[d] * k[d];
            sc = dot * expf((float)(ii - j) * ret_logg(p, il, dir, h)); }
        p.rsc[i] = sc;
    }
}
DEV void ph_reto(const P& p, int il, long gt, long gs) {
    GSL(i, 2L * NTOK * 512) {
        const int e = (int)(i % 128), h = (int)((i / 128) % 4), r = (int)((i / 512) % NTOK), dir = (int)(i / (512L * NTOK)); const RowInfo ri = row_info(r);
        const int b = ri.kind ? (ri.base - NLAT) / CTXL : ri.base / SEQ;
        const int step = ri.kind ? (dir ? CTXL - 1 - ri.t : ri.t) : CTXL + (dir ? SEQ - 1 - ri.t : ri.t), ii = step % RC, n = step / RC;
        const float* sc = p.rsc + (((long)dir * NTOK + r) * 4 + h) * RC;
        float acc = 0.f;
        for (int j = 0; j <= ii; ++j) { const int rj = scan_row(dir, b, n * RC + j); acc += sc[j] * pxf(p.px[(long)rj * PXLD + 512 + h * 128 + e]); }
        const float* S = p.rkv + ((((long)dir * 2 + b) * RNCH + n) * 4 + h) * 8192 + e; const float* q = p.qr + (long)r * 256 + h * 64;
        float cr = 0.f;
        for (int d = 0; d < 64; ++d) cr += q[d] * S[d * 128];
        p.oret[((long)dir * NTOK + r) * 512 + h * 128 + e] = acc + cr * expf((float)(ii + 1) * ret_logg(p, il, dir, h));
    }
}
DEV void ph_retout(const P& p, int nrows, long gt, long gs) {
    GSL(i, (long)nrows * 4) {
        const int h = (int)(i % 4), r = (int)(i / 4);
        const float* o0 = p.oret + (long)r * 512 + h * 128; const float* o1 = p.oret + ((long)NTOK + r) * 512 + h * 128;
        float ss = 0.f;
        for (int e = 0; e < 128; ++e) { const float o = o0[e] + o1[e]; ss += o * o; }
        const float rs = rsqrtf(ss * (1.0f / 128.0f) + EPS);
        for (int e = 0; e < 128; ++e) MIXST((long)r * D + h * 128 + e, (o0[e] + o1[e]) * rs * siluf_(pxf(p.px[(long)r * PXLD + 1024 + h * 128 + e])));
    }
}
DEV void ph_swa(const P& p, int il, int nrows, long gt, long gs) {
    GSL(i, (long)nrows * 8) {
        const int hq = (int)(i % 8), r = (int)(i / 8), kv = hq >> 2; const RowInfo ri = row_info(r);
        const int b = ri.kind ? (ri.base - NLAT) / CTXL : ri.base / SEQ;
        float q[64], acc[64];
#pragma unroll
        for (int d = 0; d < 64; ++d) { q[d] = p.qs[(long)r * 512 + hq * 64 + d]; acc[d] = 0.f; }
        float m = p.swa_sink[il * 8 + hq], l = 1.0f;
        for (int part = 0; part < 2; ++part) {
            int k0, k1;
            if (part == 0) { if (ri.kind) continue; k0 = ri.base + (ri.t - 128 < 0 ? 0 : ri.t - 128); k1 = ri.base + (ri.t + 128 > SEQ - 1 ? SEQ - 1 : ri.t + 128); }
            else { k0 = NLAT + b * CTXL; k1 = k0 + CTXL - 1; }
            for (int kr = k0; kr <= k1; ++kr) {
                const float* kk = p.ks + (long)kr * 128 + kv * 64; const px_t* vv = p.px + (long)kr * PXLD + 2176 + kv * 64;
                float s = 0.f;
#pragma unroll
                for (int d = 0; d < 64; ++d) s += q[d] * kk[d];
                const float mn = fmaxf(m, s), corr = expf(m - mn), pe = expf(s - mn);
                l = l * corr + pe; m = mn;
#pragma unroll
                for (int d = 0; d < 64; ++d) acc[d] = acc[d] * corr + pe * pxf(vv[d]);
            }
        }
        const float il_ = 1.0f / l;
#pragma unroll
        for (int d = 0; d < 64; ++d) MIXST((long)r * D + 512 + hq * 64 + d, acc[d] * il_);
    }
}
DEV void ph_outproj(const P& p, int layer, const float* w, int nrows, long gt, long gs) {
    GSL(i, (long)nrows * D) {
        const int n = (int)(i % D), r = (int)(i / D); const RowInfo ri = row_info(r);
        const float* a = p.mixin + (long)r * D; const float* b = w + n;
        float acc = 0.f;
        for (int k = 0; k < D; ++k) acc += a[k] * b[(long)k * D];
        p.xa[i] += p.modv[((long)layer * 3 + ri.m) * 6 * D + 2 * D + n] * acc;
    }
}
DEV int atomic_inc(int* q) {
#ifdef CPU_SHIM
    return __atomic_fetch_add(q, 1, __ATOMIC_RELAXED);
#else
    return atomicAdd(q, 1);
#endif
}
DEV void ph_router(const P& p, int layer, int nrows, long gt, long gs) {
    const float* rw = p.router_w + (long)layer * D * NE;
    GSL(j, NSLOT) { p.slot_tok[j] = -1; p.slot_gate[j] = 0.f; }
    GSL(r, nrows) {
        float lg[NE];
#pragma unroll
        for (int e = 0; e < NE; ++e) lg[e] = p.router_b[layer * NE + e];
        const float* a = p.hx + (long)r * D;
        for (int k = 0; k < D; ++k) { const float av = a[k];
#pragma unroll
            for (int e = 0; e < NE; ++e) lg[e] += av * rw[k * NE + e]; }
        int ti[4]; float tv[4];
#pragma unroll
        for (int s = 0; s < 4; ++s) { int best = 0; float bv = -3.0e38f;
#pragma unroll
            for (int e = 0; e < NE; ++e) { if (lg[e] > bv) { bv = lg[e]; best = e; } }
            ti[s] = best; tv[s] = bv;
#pragma unroll
            for (int e = 0; e < NE; ++e) if (e == best) lg[e] = -3.0e38f; }
        const float e1 = expf(tv[1] - tv[0]), e2 = expf(tv[2] - tv[0]), e3 = expf(tv[3] - tv[0]), inv = 1.0f / (1.0f + e1 + e2 + e3);
        p.topi[r * 4 + 0] = ti[0]; p.topi[r * 4 + 1] = ti[1]; p.topi[r * 4 + 2] = ti[2]; p.topi[r * 4 + 3] = ti[3];
        p.topg[r * 4 + 0] = inv; p.topg[r * 4 + 1] = e1 * inv; p.topg[r * 4 + 2] = e2 * inv; p.topg[r * 4 + 3] = e3 * inv;
#pragma unroll
        for (int s = 0; s < 4; ++s) p.pos[r * 4 + s] = atomic_inc(p.cnt + layer * NE + ti[s]);
    }
}
DEV int moe_tiles(const int* cnt) { int t = 0; for (int e = 0; e < NE; ++e) t += (cnt[e] + 255) >> 8; return t; }
DEV int tile_expert(const int* cnt, int pm) { int t = 0; for (int e = 0; e < NE; ++e) { t += (cnt[e] + 255) >> 8; if (pm < t) return e; } return NE - 1; }
DEV void ph_assign(const P& p, int layer, int nrows, long gt, long gs) {
    const int* cnt = p.cnt + layer * NE;
    GSL(i, (long)nrows * 4) {
        const int e = p.topi[i]; int off = 0;
        for (int q = 0; q < e; ++q) off += ((cnt[q] + 255) >> 8) << 8;
        const int slot = off + p.pos[i];
        p.slot_of[i] = slot; p.slot_tok[slot] = (int)(i >> 2); p.slot_gate[slot] = p.topg[i];
    }
}
DEV void ph_gather(const P& p, int layer, long gt, long gs) {
    const long used = (long)moe_tiles(p.cnt + layer * NE) * 256;
    GSL(i, used * D) { const int k = (int)(i % D); const long slot = i / D; const int tok = p.slot_tok[slot]; p.xb[i] = tok >= 0 ? p.hxb[(long)tok * D + k] : (bf16_t)0; }
}
DEV void ph_moe1s(const P& p, int layer, long gt, long gs) {
    const int* cnt = p.cnt + layer * NE; const long used = (long)moe_tiles(cnt) * 256;
    GSL(i, used * DFF) {
        const int j = (int)(i % DFF); const long slot = i / DFF; const int e = tile_expert(cnt, (int)(slot >> 8));
        const float* w = p.w_gu + ((long)layer * NE + e) * D * 2 * DFF + j; const bf16_t* a = p.xb + slot * D;
        const float* bb = p.b_gu + ((long)layer * NE + e) * 2 * DFF;
        float ga = bb[j], up = bb[DFF + j];
        for (int k = 0; k < D; ++k) { const float av = bf2f(a[k]); ga += av * w[(long)k * 2 * DFF]; up += av * w[(long)k * 2 * DFF + DFF]; }
        ga = fminf(ga, 7.0f); up = fminf(fmaxf(up, -7.0f), 7.0f);
        p.actb[i] = f2bf(ga * sigmoidf_(1.702f * ga) * (up + 1.0f));
    }
}
DEV void ph_moe2s(const P& p, int layer, long gt, long gs) {
    const int* cnt = p.cnt + layer * NE; const long used = (long)moe_tiles(cnt) * 256;
    GSL(i, used * D) {
        const int n = (int)(i % D); const long slot = i / D; const int e = tile_expert(cnt, (int)(slot >> 8));
        const float* w = p.w_dn + ((long)layer * NE + e) * DFF * D + n; const bf16_t* a = p.actb + slot * DFF;
        float acc = p.b_dn[((long)layer * NE + e) * D + n];
        for (int k = 0; k < DFF; ++k) acc += bf2f(a[k]) * w[(long)k * D];
        p.yb[i] = f2bf(acc * p.slot_gate[slot]);
    }
}
DEV void ph_combine(const P& p, int layer, int nrows, long gt, long gs) {
    GSL(i, (long)nrows * D) {
        const int n = (int)(i % D), r = (int)(i / D); const RowInfo ri = row_info(r);
        float y = 0.f;
#pragma unroll
        for (int s = 0; s < 4; ++s) y += bf2f(p.yb[(long)p.slot_of[r * 4 + s] * D + n]);
        p.xa[i] += p.modv[((long)layer * 3 + ri.m) * 6 * D + 5 * D + n] * y;
    }
}
DEV void ph_final(const P& p, long gt, long gs) {
    GSL(i, (long)NLAT * D) { const int k = (int)(i % D), r = (int)(i / D); p.out[i] = p.xa[i] * p.rstd[r] * p.final_g[k]; }
}

constexpr int N_SETUP = 6, N_SLOT = 18;
#ifdef CPU_SHIM
#define SWA_NAIVE ph_swa(p, il, nrows, gt, gs);
#define S5_NAIVE(x) x
#define S5_FIN ph_s5out(p, il, gt, gs);
#define RET_NAIVE_A ph_retkv(p, il, gt, gs); ph_retsc(p, il, gt, gs);
#define RET_NAIVE_C ph_reto(p, il, gt, gs);
#else
#define SWA_NAIVE
#define S5_NAIVE(x)
#define S5_FIN ph_s5fin(p, il, gt, gs);
#define RET_NAIVE_A
#define RET_NAIVE_C
#endif
#ifdef CPU_SHIM
#define LCONV_LAT(p, il, gt, gs) ph_lconv_fft(p, il, gt, gs)
#else
#define LCONV_LAT(p, il, gt, gs)
#endif
template <int S> DEV void setup_slot(const P& p, long gt, long gs) {
    if constexpr (S == 0) { ph_init(p, gt, gs); ph_mod(p, gt, gs); }
    if constexpr (S == 1) { ph_mod2(p, gt, gs); ph_filt1(p, gt, gs); }
    if constexpr (S == 2) ph_filt2(p, gt, gs);
    if constexpr (S == 3) ph_filt3(p, gt, gs);
    if constexpr (S == 4) ph_filt4a(p, gt, gs);
    if constexpr (S == 5) ph_filt4(p, gt, gs);
}
template <int S> DEV void layer_slot(const P& p, int layer, long gt, long gs) {
    const int il = layer >> 1; const bool ab = !(layer & 1);
    const int nrows = layer < 3 ? NTOK : NLAT;
    if constexpr (S == 0) ph_rstd(p, NTOK, gt, gs);
    if constexpr (S == 1) ph_hx(p, layer, 0, NTOK, gt, gs);
    if constexpr (S == 2) { if (ab) ph_inproj(p, p.ab_w_in + (long)il * D * AB_IN, AB_IN, gt, gs); else ph_inproj(p, p.cd_w_in + (long)il * D * CD_IN, CD_IN, gt, gs); }
    if constexpr (S == 3) { if (ab) { ph_sconv(p, il, gt, gs); S5_NAIVE(ph_s5chunk(p, il, 0, gt, gs);) } else ph_rope(p, gt, gs); }
    if constexpr (S == 4) { if (ab) { LCONV_LAT(p, il, gt, gs); ph_lconv(p, il, NLAT, NTOK, gt, gs); ph_s5carry(p, il, gt, gs); } else { RET_NAIVE_A } }
    if constexpr (S == 5) { if (ab) { ph_hymix(p, il, gt, gs); S5_NAIVE(ph_s5chunk(p, il, 1, gt, gs);) } else { ph_retcarry(p, il, gt, gs); SWA_NAIVE } }
    if constexpr (S == 6) { if (ab) { S5_FIN } else { RET_NAIVE_C } }
    if constexpr (S == 7) { if (ab) ph_glu(p, il, gt, gs); else ph_retout(p, nrows, gt, gs); }
    if constexpr (S == 8) ph_outproj(p, layer, (ab ? p.ab_w_out : p.cd_w_out) + (long)il * D * D, nrows, gt, gs);
    if constexpr (S == 9) ph_rstd(p, nrows, gt, gs);
    if constexpr (S == 10) ph_hx(p, layer, 1, nrows, gt, gs);
    if constexpr (S == 11) ph_router(p, layer, nrows, gt, gs);
    if constexpr (S == 12) ph_assign(p, layer, nrows, gt, gs);
    if constexpr (S == 13) ph_gather(p, layer, gt, gs);
    if constexpr (S == 14) ph_moe1s(p, layer, gt, gs);
    if constexpr (S == 15) ph_moe2s(p, layer, gt, gs);
    if constexpr (S == 16) ph_combine(p, layer, nrows, gt, gs);
}
template <int S> DEV void final_slot(const P& p, long gt, long gs) {
    if constexpr (S == 0) ph_rstd(p, NLAT, gt, gs);
    if constexpr (S == 1) ph_final(p, gt, gs);
}

struct WsMap { size_t off[56]; size_t total; };
static inline WsMap ws_map() {
    WsMap m; size_t o = 0; int n = 0;
    auto take = [&](size_t bytes) { m.off[n++] = o; o += (bytes + 255) & ~(size_t)255; };
    take(16384);
    take((size_t)NTOK * D * 4);
    take((size_t)4 * 3 * 6 * D * 4);
    take((size_t)2 * (SEQ + CTXL) * 64 * 4);
    take((size_t)2 * (SEQ + CTXL) * 64 * 4);
    take((size_t)2 * (SEQ + CTXL) * HYW * 4);
    take((size_t)2 * 2 * HYW * 4);
    take((size_t)NTOK * 4);
    take((size_t)NTOK * D * 4);
    take((size_t)NTOK * PXLD * 4);
    take((size_t)NTOK * HYW * 4);
    take((size_t)NTOK * HYW * 4);
    take((size_t)NTOK * D * 4);
    take((size_t)2 * NTOK * NG * NP * 2 * 4);
    take((size_t)NTOK * S5W * 4);
    take((size_t)NTOK * 256 * 4);
    take((size_t)NTOK * 256 * 4);
    take((size_t)2 * NTOK * 512 * 4);
    take((size_t)NTOK * 512 * 4);
    take((size_t)NTOK * 128 * 4);
    take((size_t)NTOK * 4 * 4);
    take((size_t)NTOK * 4 * 4);
    take(256);
    take((size_t)(NTOK + 1) * D * 2);
    take((size_t)NTOK * D * 2);
    take((size_t)NTOK * S5W * 2);
    take((size_t)NSLOT * D * 2);
    take((size_t)NSLOT * DFF * 2);
    take((size_t)NSLOT * D * 4);
    take((size_t)NSLOT * 4);
    take((size_t)4 * NE * 4);
    take((size_t)NTOK * 4 * 4);
    take((size_t)NTOK * 4 * 4);
    take((size_t)NSLOT * 4);
    take((size_t)2 * AB_IN * D * 2);
    take((size_t)2 * CD_IN * D * 2);
    take((size_t)2 * D * D * 2);
    take((size_t)2 * D * D * 2);
    take((size_t)2 * S5W * S5W * 2);
    take((size_t)4 * NE * 2 * DFF * D * 2);
    take((size_t)4 * NE * D * DFF * 2);
    take((size_t)2 * 2 * S5NCH * NG * NP * 2 * 4);
    take((size_t)2 * 2 * RNCH * 4 * 8192 * 4);
    take((size_t)2 * NTOK * 4 * RC * 4);
    take((size_t)2 * FNSEG * HYW * 4);
    take((size_t)256 * 2 * FFTN * 4);
    take((size_t)HYW * NLAT * 4);
    take((size_t)2 * NTOK * S5W * 4);
    take((size_t)HYW * NLAT * 4);
    take((size_t)2 * HYW * SEQ * 4);
    take((size_t)8 * 4 * 3 * 6 * D * 4);
    m.total = o; return m;
}
static inline void fill_params(P& p, void* const* d_in, void* d_out, void* d_ws) {
    const float* const* in = (const float* const*)d_in;
    p.x = in[0]; p.c = in[1]; p.ctx = in[2]; p.c_ctx = in[3]; p.mod_w = in[4]; p.mod_b = in[5]; p.norm1_g = in[6]; p.norm2_g = in[7];
    p.ab_w_in = in[8]; p.ab_w_out = in[9]; p.hy_short_w = in[10]; p.hy_short_b = in[11]; p.hy_f_w1 = in[12]; p.hy_f_b1 = in[13];
    p.hy_f_w2 = in[14]; p.hy_f_b2 = in[15]; p.hy_f_w3 = in[16]; p.hy_bias = in[17]; p.s5_lre = in[18]; p.s5_lim = in[19]; p.s5_ldt = in[20];
    p.s5_bre = in[21]; p.s5_bim = in[22]; p.s5_cre = in[23]; p.s5_cim = in[24]; p.s5_d = in[25]; p.s5_glu_w = in[26]; p.s5_glu_b = in[27];
    p.cd_w_in = in[28]; p.cd_w_out = in[29]; p.ret_decay = in[30]; p.swa_sink = in[31]; p.router_w = in[32]; p.router_b = in[33];
    p.w_gu = in[34]; p.b_gu = in[35]; p.w_dn = in[36]; p.b_dn = in[37]; p.final_g = in[38];
    p.out = (float*)d_out;
    const WsMap m = ws_map(); char* w = (char*)d_ws;
    p.bar = (unsigned*)(w + m.off[0]); p.xa = (float*)(w + m.off[1]); p.modv = (float*)(w + m.off[2]); p.f1 = (float*)(w + m.off[3]); p.f2 = (float*)(w + m.off[4]);
    p.hraw = (float*)(w + m.off[5]); p.hsum = (float*)(w + m.off[6]); p.rstd = (float*)(w + m.off[7]); p.hx = (float*)(w + m.off[8]); p.px = (px_t*)(w + m.off[9]);
    p.zb = (float*)(w + m.off[10]); p.x0c = (float*)(w + m.off[11]); p.mixin = (float*)(w + m.off[12]); p.s5s = (float*)(w + m.off[13]); p.ys5 = (float*)(w + m.off[14]);
    p.qr = (float*)(w + m.off[15]); p.kr = (float*)(w + m.off[16]); p.oret = (float*)(w + m.off[17]); p.qs = (float*)(w + m.off[18]); p.ks = (float*)(w + m.off[19]);
    p.topg = (float*)(w + m.off[20]); p.topi = (int*)(w + m.off[21]); p.act = nullptr;
    p.hxb = (bf16_t*)(w + m.off[23]); p.mixb = (bf16_t*)(w + m.off[24]); p.ys5b = (bf16_t*)(w + m.off[25]); p.xb = (bf16_t*)(w + m.off[26]); p.actb = (bf16_t*)(w + m.off[27]);
    p.yb = (bf16_t*)(w + m.off[28]); p.slot_gate = (float*)(w + m.off[29]); p.cnt = (int*)(w + m.off[30]); p.pos = (int*)(w + m.off[31]); p.slot_of = (int*)(w + m.off[32]);
    p.slot_tok = (int*)(w + m.off[33]); p.abin_t = (bf16_t*)(w + m.off[34]); p.cdin_t = (bf16_t*)(w + m.off[35]); p.about_t = (bf16_t*)(w + m.off[36]);
    p.cdout_t = (bf16_t*)(w + m.off[37]); p.glu_t = (bf16_t*)(w + m.off[38]); p.wgu_t = (bf16_t*)(w + m.off[39]); p.wdn_t = (bf16_t*)(w + m.off[40]);
    p.s5c = (float*)(w + m.off[41]); p.rkv = (float*)(w + m.off[42]); p.rsc = (float*)(w + m.off[43]); p.hpart = (float*)(w + m.off[44]);
    p.zf = (float*)(w + m.off[45]); p.convT = (float*)(w + m.off[46]); p.yd = (float*)(w + m.off[47]); p.zT = (float*)(w + m.off[48]); p.hT = (float*)(w + m.off[49]); p.modp = (float*)(w + m.off[50]);
}

#ifndef CPU_SHIM
namespace pg8 {
#define PG8_LAS __attribute__((address_space(3)))
typedef short bf16x8 __attribute__((ext_vector_type(8)));
typedef float f32x4 __attribute__((ext_vector_type(4)));
constexpr int BM = 256, BK = 64, HALF = 128, HTB = HALF * BK * 2, STAGE_BYTES = 8 * HTB, NXCD = 8, WGM = 8;
__host__ __device__ __forceinline__ int lds_byte(int r, int c) { const int st = (r >> 4) * 2 + (c >> 5), rr = r & 15, cc = c & 31, ob = rr * 64 + cc * 2; return st * 1024 + (ob ^ (((ob >> 9) & 1) << 5)); }
__host__ __device__ __forceinline__ void stage_rc(int b, int& R, int& C) { const int st = b / 1024, sb = b % 1024, swz = sb ^ (((sb >> 9) & 1) << 5); R = (st >> 1) * 16 + swz / 64; C = (st & 1) * 32 + (swz % 64) / 2; }
struct Unit { int pm, pn, e; };
struct Gemm { const bf16_t* A; const bf16_t* Bt; int M, N, K; size_t ebytes; };
struct StaticOrder {
    int nM, nN, nwg, G, c;
    __device__ void init(int M, int N, int G_, int c_) { nM = M / BM; nN = N / BM; nwg = nM * nN; G = G_; c = c_; }
    __device__ bool next(int i, Unit& u) const {
        const long L = (long)i * G + c; if (L >= nwg) return false;
        int wgid = (int)L; { const int q = nwg / NXCD, r = nwg % NXCD, xcd = wgid % NXCD, off = wgid / NXCD; wgid = (xcd < r ? xcd * (q + 1) : r * (q + 1) + (xcd - r) * q) + off; }
        const int nig = WGM * nN, gid = wgid / nig, fm = gid * WGM, gsz = (nM - fm) < WGM ? (nM - fm) : WGM;
        u.pm = fm + ((wgid % nig) % gsz); u.pn = (wgid % nig) / gsz; u.e = 0; return true;
    }
    __device__ int tok(int, int) const { return 0; }
};
struct MoeOrder {
    int nwg, nN, G, c; const volatile PG8_LAS unsigned char* ue; const volatile PG8_LAS int* tokt;
    __device__ int tok(int ui, int row) const { return tokt[ui * 256 + row]; }
    __device__ bool unit(int i, int& pm, int& pn) const {
        const int S = G >> 3;
        if ((G & 7) == 0 && S % nN == 0) { const int x = c & 7, slot = c >> 3, pmx = S / nN, T = nwg / nN, tpx = (T + 7) >> 3, lp = i * pmx + slot / nN;
            pm = x * tpx + lp; pn = slot % nN; return lp < tpx && pm < T; }
        const long L = (long)i * G + c; pm = (int)(L / nN); pn = (int)(L % nN); return L < nwg;
    }
    __device__ bool next(int i, Unit& u) const {
        int pm, pn; if (!unit(i, pm, pn)) return false;
        u.pm = pm; u.pn = pn; u.e = __builtin_amdgcn_readfirstlane((int)ue[pm]); return true;
    }
};
template <class Epi, class Sched, bool GATHER = false>
__device__ __forceinline__ void gemm_phase(PG8_LAS unsigned char* lds, const Gemm g, const Sched& S, const Epi& E) {
    int tid = threadIdx.x; asm volatile("" : "+v"(tid));
    const int wid = __builtin_amdgcn_readfirstlane(tid >> 6), lane = tid & 63, wr = wid >> 2, wc = wid & 3, fr = lane & 15, fq = lane >> 4;
    const int K = g.K, nt = K / BK;
    unsigned va[2][2], vn[2][2], voffB[2]; int Rr[2]; unsigned Cb[2];
#pragma unroll
    for (int i = 0; i < 2; ++i) { int R, C; stage_rc(tid * 16 + i * 8192, R, C); Rr[i] = R; Cb[i] = (unsigned)C * 2u; voffB[i] = (unsigned)(R * K + C) * 2u; }
    const size_t kstep = (size_t)(BK * 2);
    const size_t hstep = (size_t)HALF * K * 2;
    const size_t tstep = 2 * hstep;
#define PG8_SETOFF(v, ui_) do { _Pragma("unroll") for (int h_ = 0; h_ < 2; ++h_) _Pragma("unroll") for (int i_ = 0; i_ < 2; ++i_) \
        v[h_][i_] = GATHER ? (unsigned)S.tok(ui_, h_ * HALF + Rr[i_]) * (unsigned)(K * 2) + Cb[i_] : voffB[i_] + (unsigned)(h_ * hstep); } while (0)
    const unsigned ldsw = (unsigned)wid * 1024u;
    const int aoff = lds_byte(wr * 64 + fr, fq * 8), boff = lds_byte(wc * 32 + fr, fq * 8);
#define PG8_SA(b, h) (((b) * 2 + (h)) * HTB)
#define PG8_SB(b, h) ((4 + (b) * 2 + (h)) * HTB)
#define PG8_STAGE(bufoff, gbase, voff) do { _Pragma("unroll") for (int _i = 0; _i < 2; ++_i) \
        __builtin_amdgcn_global_load_lds((const unsigned*)((const char*)(gbase) + (voff)[_i]), (PG8_LAS unsigned*)(lds + (bufoff) + ldsw + _i * 8192), 16, 0, 0); } while (0)
#define PG8_LDA(dst, b, h) do { _Pragma("unroll") for (int m = 0; m < 4; ++m) _Pragma("unroll") for (int k = 0; k < 2; ++k) dst[m][k] = *(const PG8_LAS bf16x8*)(lds + PG8_SA(b, h) + aoff + m * 2048 + k * 1024); } while (0)
#define PG8_LDB(dst, b, h) do { _Pragma("unroll") for (int n = 0; n < 2; ++n) _Pragma("unroll") for (int k = 0; k < 2; ++k) dst[n][k] = *(const PG8_LAS bf16x8*)(lds + PG8_SB(b, h) + boff + n * 2048 + k * 1024); } while (0)
#define PG8_MMA(ai, bj, At, Bt) do { __builtin_amdgcn_s_setprio(1); _Pragma("unroll") for (int m = 0; m < 4; ++m) _Pragma("unroll") for (int n = 0; n < 2; ++n) _Pragma("unroll") for (int k = 0; k < 2; ++k) \
        acc[ai][bj][m][n] = __builtin_amdgcn_mfma_f32_16x16x32_bf16(Bt[n][k], At[m][k], acc[ai][bj][m][n], 0, 0, 0); __builtin_amdgcn_s_setprio(0); } while (0)
#define PG8_WAIT_V(n) asm volatile("s_waitcnt vmcnt(" #n ")" ::: "memory")
#define PG8_WAIT_L(n) asm volatile("s_waitcnt lgkmcnt(" #n ")" ::: "memory")
#define PG8_BAR __builtin_amdgcn_s_barrier()
#define PG8_SCHED __builtin_amdgcn_sched_barrier(0)
    Unit cur, nxt; int ui = 0;
    if (!S.next(0, cur)) return;
    f32x4 acc[2][2][4][2];
#pragma unroll
    for (int a = 0; a < 2; ++a)
#pragma unroll
        for (int b = 0; b < 2; ++b)
#pragma unroll
            for (int m = 0; m < 4; ++m)
#pragma unroll
                for (int n = 0; n < 2; ++n) acc[a][b][m][n] = (f32x4){0.f, 0.f, 0.f, 0.f};
    bf16x8 At[4][2], B0[2][2], B1[2][2];
    const char* cA = (const char*)g.A + (GATHER ? (size_t)0 : (size_t)cur.pm * tstep); const char* cB = (const char*)g.Bt + (size_t)cur.e * g.ebytes + (size_t)cur.pn * tstep;
    PG8_SETOFF(va, 0);
    PG8_STAGE(PG8_SB(0, 0), cB, voffB); PG8_STAGE(PG8_SB(0, 1), cB + hstep, voffB); PG8_STAGE(PG8_SA(0, 0), cA, va[0]); PG8_STAGE(PG8_SA(0, 1), cA, va[1]);
    if (wr == 1) PG8_BAR;
    PG8_WAIT_V(2); PG8_BAR;
    PG8_STAGE(PG8_SB(1, 0), cB + kstep, voffB); PG8_STAGE(PG8_SA(1, 0), cA + kstep, va[0]); PG8_STAGE(PG8_SB(1, 1), cB + hstep + kstep, voffB);
    PG8_WAIT_V(6); PG8_BAR;
    for (;;) {
        const bool has_next = S.next(ui + 1, nxt);
        const char* nA = has_next ? (const char*)g.A + (GATHER ? (size_t)0 : (size_t)nxt.pm * tstep) : cA; const char* nB = has_next ? (const char*)g.Bt + (size_t)nxt.e * g.ebytes + (size_t)nxt.pn * tstep : cB;
        if (GATHER && has_next) PG8_SETOFF(vn, ui + 1); else { _Pragma("unroll") for (int h_ = 0; h_ < 2; ++h_) _Pragma("unroll") for (int i_ = 0; i_ < 2; ++i_) vn[h_][i_] = va[h_][i_]; }
        for (int t = 0; t < nt; t += 2) {
            const bool last = (t == nt - 2);
            const char* a1 = cA + (size_t)(t + 1) * kstep;
            const char* a2 = last ? nA : cA + (size_t)(t + 2) * kstep; const char* b2 = last ? nB : cB + (size_t)(t + 2) * kstep;
            const char* a3 = a2 + kstep; const char* b3 = b2 + kstep;
            unsigned s0[2], s1[2];
#pragma unroll
            for (int i_ = 0; i_ < 2; ++i_) { s0[i_] = last ? vn[0][i_] : va[0][i_]; s1[i_] = last ? vn[1][i_] : va[1][i_]; }
            PG8_LDB(B0, 0, 0); PG8_LDB(B1, 0, 1); PG8_SCHED; PG8_LDA(At, 0, 0); PG8_STAGE(PG8_SA(1, 1), a1, va[1]);
            PG8_WAIT_V(8); PG8_WAIT_L(0); PG8_BAR; PG8_MMA(0, 0, At, B0); PG8_MMA(0, 1, At, B1); PG8_BAR; PG8_SCHED;
            PG8_LDA(At, 0, 1); PG8_STAGE(PG8_SB(0, 0), b2, voffB); PG8_STAGE(PG8_SB(0, 1), b2 + hstep, voffB); PG8_STAGE(PG8_SA(0, 0), a2, s0);
            PG8_WAIT_V(8); PG8_WAIT_L(0); PG8_BAR; PG8_MMA(1, 0, At, B0); PG8_MMA(1, 1, At, B1); PG8_BAR; PG8_SCHED;
            PG8_LDB(B0, 1, 0); PG8_LDB(B1, 1, 1); PG8_SCHED; PG8_LDA(At, 1, 0); PG8_STAGE(PG8_SA(0, 1), a2, s1);
            PG8_WAIT_V(8); PG8_WAIT_L(0); PG8_BAR; PG8_MMA(0, 0, At, B0); PG8_MMA(0, 1, At, B1); PG8_BAR; PG8_SCHED;
            PG8_LDA(At, 1, 1); PG8_STAGE(PG8_SB(1, 0), b3, voffB); PG8_STAGE(PG8_SB(1, 1), b3 + hstep, voffB); PG8_STAGE(PG8_SA(1, 0), a3, s0);
            PG8_WAIT_V(8); PG8_WAIT_L(0); PG8_BAR; PG8_MMA(1, 0, At, B0); PG8_MMA(1, 1, At, B1); PG8_BAR; PG8_SCHED;
        }
        if (wr == 0) PG8_BAR;
        E(acc, cur, wr, wc, fr, fq);
        if (!has_next) break;
#pragma unroll
        for (int a = 0; a < 2; ++a)
#pragma unroll
            for (int b = 0; b < 2; ++b)
#pragma unroll
                for (int m = 0; m < 4; ++m)
#pragma unroll
                    for (int n = 0; n < 2; ++n) acc[a][b][m][n] = (f32x4){0.f, 0.f, 0.f, 0.f};
        cur = nxt; cA = nA; cB = nB; ++ui;
#pragma unroll
        for (int h_ = 0; h_ < 2; ++h_)
#pragma unroll
            for (int i_ = 0; i_ < 2; ++i_) va[h_][i_] = vn[h_][i_];
        if (wr == 1) PG8_BAR;
    }
    PG8_WAIT_V(0);
    PG8_BAR;
#undef PG8_SA
#undef PG8_SB
#undef PG8_STAGE
#undef PG8_SETOFF
#undef PG8_LDA
#undef PG8_LDB
#undef PG8_MMA
#undef PG8_WAIT_V
#undef PG8_WAIT_L
#undef PG8_BAR
#undef PG8_SCHED
}
typedef float f32x2v __attribute__((ext_vector_type(2)));
typedef __bf16 bf16x2v __attribute__((ext_vector_type(2)));
__device__ __forceinline__ unsigned cvt_pk_bf16(float lo, float hi) { const bf16x2v r = __builtin_convertvector((f32x2v){lo, hi}, bf16x2v); return __builtin_bit_cast(unsigned, r); }
__device__ __forceinline__ float fast_sigmoid(float x) { return __builtin_amdgcn_rcpf(1.0f + __builtin_amdgcn_exp2f(-1.4426950408889634f * x)); }
#define EPI_LOOP(body) _Pragma("unroll") for (int ai = 0; ai < 2; ++ai) _Pragma("unroll") for (int m = 0; m < 4; ++m) { const int row = row0 + ai * HALF + m * 16; \
    _Pragma("unroll") for (int bj = 0; bj < 2; ++bj) _Pragma("unroll") for (int n = 0; n < 2; ++n) { const int col = col0 + bj * HALF + n * 16; const f32x4 a = acc[ai][bj][m][n]; body } }
struct EpiStoreF32 {
    float* C; int ldc;
    __device__ __forceinline__ void operator()(const f32x4 (&acc)[2][2][4][2], const Unit& u, int wr, int wc, int fr, int fq) const {
        const int row0 = u.pm * BM + wr * 64 + fr, col0 = u.pn * BM + wc * 32 + 4 * fq;
        EPI_LOOP( *(f32x4*)(C + (size_t)row * ldc + col) = a; )
    }
};
struct EpiStoreBf16 {
    bf16_t* C; int ldc;
    __device__ __forceinline__ void operator()(const f32x4 (&acc)[2][2][4][2], const Unit& u, int wr, int wc, int fr, int fq) const {
        const int row0 = u.pm * BM + wr * 64 + fr, col0 = u.pn * BM + wc * 32 + 4 * fq;
        EPI_LOOP( uint2 o; o.x = cvt_pk_bf16(a[0], a[1]); o.y = cvt_pk_bf16(a[2], a[3]); *(uint2*)(C + (size_t)row * ldc + col) = o; )
    }
};
struct EpiResid {
    float* X; const float* gv;
    __device__ __forceinline__ void operator()(const f32x4 (&acc)[2][2][4][2], const Unit& u, int wr, int wc, int fr, int fq) const {
        const int row0 = u.pm * BM + wr * 64 + fr, col0 = u.pn * BM + wc * 32 + 4 * fq;
        const int r0 = u.pm * BM, mrow = r0 < SEQ ? 0 : (r0 < NLAT ? 1 : 2); const float* g = gv + (size_t)mrow * 6 * D;
        EPI_LOOP( const f32x4 gg = *(const f32x4*)(g + col); f32x4* q = (f32x4*)(X + (size_t)row * D + col); *q = *q + gg * a; )
    }
};
struct EpiGlu {
    bf16_t* O; const bf16_t* Y; const float* bias;
    __device__ __forceinline__ void operator()(const f32x4 (&acc)[2][2][4][2], const Unit& u, int wr, int wc, int fr, int fq) const {
        const int row0 = u.pm * BM + wr * 64 + fr, col0 = u.pn * BM + wc * 32 + 4 * fq;
        EPI_LOOP( const f32x4 bb = *(const f32x4*)(bias + col); const ushort4 yv = *(const ushort4*)(Y + (size_t)row * S5W + col);
            uint2 o; o.x = cvt_pk_bf16(bf2f(yv.x) * fast_sigmoid(a[0] + bb[0]), bf2f(yv.y) * fast_sigmoid(a[1] + bb[1])); o.y = cvt_pk_bf16(bf2f(yv.z) * fast_sigmoid(a[2] + bb[2]), bf2f(yv.w) * fast_sigmoid(a[3] + bb[3]));
            *(uint2*)(O + (size_t)row * D + HYW + col) = o; )
    }
};
struct EpiSwiglu {
    bf16_t* O; const float* bgu;
    __device__ __forceinline__ void operator()(const f32x4 (&acc)[2][2][4][2], const Unit& u, int wr, int wc, int fr, int fq) const {
        const int row0 = u.pm * BM + wr * 64 + fr, colb = wc * 32 + 4 * fq; const float* bb = bgu + (size_t)u.e * 2 * DFF + u.pn * 128;
#pragma unroll
        for (int ai = 0; ai < 2; ++ai)
#pragma unroll
            for (int m = 0; m < 4; ++m) { const int row = row0 + ai * HALF + m * 16;
#pragma unroll
                for (int n = 0; n < 2; ++n) { const int cc = colb + n * 16; const f32x4 bg = *(const f32x4*)(bb + cc), bu = *(const f32x4*)(bb + DFF + cc);
                    const f32x4 ga = acc[ai][0][m][n] + bg, up = acc[ai][1][m][n] + bu; float av[4];
#pragma unroll
                    for (int j = 0; j < 4; ++j) { const float gg = fminf(ga[j], 7.0f), uu = fminf(fmaxf(up[j], -7.0f), 7.0f); av[j] = gg * fast_sigmoid(1.702f * gg) * (uu + 1.0f); }
                    uint2 o; o.x = cvt_pk_bf16(av[0], av[1]); o.y = cvt_pk_bf16(av[2], av[3]);
                    *(uint2*)(O + (size_t)row * DFF + u.pn * 128 + cc) = o; } }
    }
};
struct EpiDown {
    bf16_t* Y; const float* bdn; const float* gate;
    __device__ __forceinline__ void operator()(const f32x4 (&acc)[2][2][4][2], const Unit& u, int wr, int wc, int fr, int fq) const {
        const int row0 = u.pm * BM + wr * 64 + fr, col0 = u.pn * BM + wc * 32 + 4 * fq; const float* bb = bdn + (size_t)u.e * D;
        EPI_LOOP( const f32x4 bv = *(const f32x4*)(bb + col); const float gt_ = gate[row]; const f32x4 o = (a + bv) * gt_; uint2 ob; ob.x = cvt_pk_bf16(o[0], o[1]); ob.y = cvt_pk_bf16(o[2], o[3]); *(uint2*)(Y + (size_t)row * D + col) = ob; )
    }
};
}

constexpr int RING_BYTES = 131072, SCRATCH_BYTES = 135168, MISC_OFF = SCRATCH_BYTES, UE_OFF = MISC_OFF + 64, TOK_OFF = UE_OFF + 320, TOK_UNITS = 11, LDS_BYTES = 147456;
static_assert(FFT_ELEMS * 8 <= SCRATCH_BYTES && TOK_OFF + TOK_UNITS * 1024 <= LDS_BYTES && ((NSLOT / 256 + 7) / 8 + 3) / 4 <= TOK_UNITS, "LDS map");
#define LAS __attribute__((address_space(3)))

__device__ __forceinline__ void transpose_item(const float* W, int K, int N, bf16_t* WT, int gu_perm, LAS float* scr, int item, int lane) {
    const int nblk = N / 32, kb = item / nblk, nb = item % nblk, k0 = 64 * kb, n0 = 32 * nb;
    const int r0 = gu_perm ? (n0 < DFF ? (n0 / 128) * 256 + (n0 % 128) : ((n0 - DFF) / 128) * 256 + 128 + ((n0 - DFF) % 128)) : n0;
#pragma unroll 8
    for (int i = 0; i < 32; ++i) { const int kk = 2 * i + (lane >> 5); scr[kk * 33 + (lane & 31)] = W[(size_t)(k0 + kk) * N + n0 + (lane & 31)]; }
    asm volatile("s_waitcnt lgkmcnt(0)" ::: "memory");
    const int c = lane & 7;
#pragma unroll
    for (int j = 0; j < 4; ++j) { const int n = (lane >> 3) + 8 * j; const LAS float* s = scr + (8 * c) * 33 + n;
        uint4 o; o.x = f2bf(s[0 * 33]) | ((unsigned)f2bf(s[1 * 33]) << 16); o.y = f2bf(s[2 * 33]) | ((unsigned)f2bf(s[3 * 33]) << 16);
        o.z = f2bf(s[4 * 33]) | ((unsigned)f2bf(s[5 * 33]) << 16); o.w = f2bf(s[6 * 33]) | ((unsigned)f2bf(s[7 * 33]) << 16);
        *(uint4*)(WT + (size_t)(r0 + n) * K + k0 + 8 * c) = o; }
    asm volatile("s_waitcnt lgkmcnt(0)" ::: "memory");
}
constexpr int I_GU = (D / 64) * (2 * DFF / 32), I_DN = (DFF / 64) * (D / 32), EXP_ITEMS = NE * (I_GU + I_DN);
__device__ __forceinline__ void convert_expert_item(const P& p, int l, int q, LAS float* scr, int lane) {
    if (q < NE * I_GU) { const int e = q / I_GU; const size_t i = (size_t)l * NE + e; transpose_item(p.w_gu + i * D * 2 * DFF, D, 2 * DFF, p.wgu_t + i * 2 * DFF * D, 1, scr, q % I_GU, lane); }
    else { const int q2 = q - NE * I_GU, e = q2 / I_DN; const size_t i = (size_t)l * NE + e; transpose_item(p.w_dn + i * DFF * D, DFF, D, p.wdn_t + i * D * DFF, 0, scr, q2 % I_DN, lane); }
}
constexpr int DEFER_Q1 = 64, DEFER_Q2 = 140;
__device__ __forceinline__ int defer_idle(int units, int G) { const int rem = units % G; return rem ? G - rem : 0; }
__device__ __forceinline__ int defer_in_units(int layer) { return (NTOK / 256) * ((layer & 1) ? CD_IN / 256 : AB_IN / 256); }
__device__ __forceinline__ int defer_d1(int layer, int G) { const int n = defer_idle(defer_in_units(layer), G) * DEFER_Q1; return n < EXP_ITEMS ? n : EXP_ITEMS; }
__device__ __forceinline__ int defer_d2(int layer, int G) { const int d1 = defer_d1(layer, G), n = d1 + defer_idle((NTOK / 256) * (D / 256), G) * DEFER_Q2; return n < EXP_ITEMS ? n : EXP_ITEMS; }
__device__ __forceinline__ void convert_deferred(const P& p, LAS unsigned char* lds, int layer, int which) {
    int tid = threadIdx.x; asm volatile("" : "+v"(tid));
    int bx_ = (int)blockIdx.x, gx_ = (int)gridDim.x; asm volatile("" : "+s"(bx_), "+s"(gx_));
    const int units = which ? (NTOK / 256) * (D / 256) : defer_in_units(layer), rem = units % gx_;
    if (rem == 0 || bx_ < rem) return;
    const int lane = tid & 63, wave = tid >> 6; LAS float* scr = (LAS float*)(lds + wave * 16384);
    const int qn = which ? DEFER_Q2 : DEFER_Q1, q0 = (which ? defer_d1(layer, gx_) : 0) + (bx_ - rem) * qn, qend = which ? defer_d2(layer, gx_) : defer_d1(layer, gx_);
    for (int q = q0 + wave; q < q0 + qn && q < qend; q += 8) convert_expert_item(p, layer + 1, q, scr, lane);
}
__device__ __forceinline__ void ph_convert_weights(const P& p, LAS unsigned char* lds) {
    int tid = threadIdx.x; asm volatile("" : "+v"(tid));
    const int lane = tid & 63, wave = tid >> 6;
    LAS float* scr = (LAS float*)(lds + wave * 16384);
    const long gw = (long)blockIdx.x * 8 + wave, NGW = (long)gridDim.x * 8; const int G = (int)gridDim.x;
    constexpr long I_ABIN = (D / 64) * (AB_IN / 32), I_CDIN = (D / 64) * (CD_IN / 32), I_OUT = (D / 64) * (D / 32), I_GLU = (S5W / 64) * (S5W / 32);
    constexpr long T0 = 2 * I_ABIN, T1 = T0 + 2 * I_CDIN, T2 = T1 + 2 * I_OUT, T3 = T2 + 2 * I_OUT, T4 = T3 + 2 * I_GLU;
    for (long it = gw; it < T4; it += NGW) {
        if (it < T0) { const int i = (int)(it / I_ABIN); transpose_item(p.ab_w_in + (size_t)i * D * AB_IN, D, AB_IN, p.abin_t + (size_t)i * AB_IN * D, 0, scr, (int)(it % I_ABIN), lane); }
        else if (it < T1) { const long r = it - T0; const int i = (int)(r / I_CDIN); transpose_item(p.cd_w_in + (size_t)i * D * CD_IN, D, CD_IN, p.cdin_t + (size_t)i * CD_IN * D, 0, scr, (int)(r % I_CDIN), lane); }
        else if (it < T2) { const long r = it - T1; const int i = (int)(r / I_OUT); transpose_item(p.ab_w_out + (size_t)i * D * D, D, D, p.about_t + (size_t)i * D * D, 0, scr, (int)(r % I_OUT), lane); }
        else if (it < T3) { const long r = it - T2; const int i = (int)(r / I_OUT); transpose_item(p.cd_w_out + (size_t)i * D * D, D, D, p.cdout_t + (size_t)i * D * D, 0, scr, (int)(r % I_OUT), lane); }
        else { const long r = it - T3; const int i = (int)(r / I_GLU); transpose_item(p.s5_glu_w + (size_t)i * S5W * S5W, S5W, S5W, p.glu_t + (size_t)i * S5W * S5W, 0, scr, (int)(r % I_GLU), lane); }
    }
    for (int l = 0; l < 4; ++l) { const int qs = l ? defer_d2(l - 1, G) : 0;
        for (long q = qs + gw; q < EXP_ITEMS; q += NGW) convert_expert_item(p, l, (int)q, scr, lane); }
}
constexpr int NTHREADS = 512;
__device__ __forceinline__ float wave_sum(float v) {
#pragma unroll
    for (int o = 1; o < 64; o <<= 1) v += __shfl_xor(v, o);
    return v;
}
template <int L> __device__ __forceinline__ float rowb(float v) { return __builtin_bit_cast(float, __builtin_amdgcn_update_dpp(0, __builtin_bit_cast(int, v), 0x150 + L, 0xf, 0xf, false)); }
template <int L> __device__ __forceinline__ void route_steps(float val, const LAS float* wq, float& a0, float& a1) {
    const float xb = rowb<L>(val); const pg8::f32x2v w = *(const LAS pg8::f32x2v*)(wq + (4 * L) * 32);
    a0 += xb * w.x; a1 += xb * w.y;
    if constexpr (L + 1 < 16) route_steps<L + 1>(val, wq, a0, a1);
}
template <int MODE> __device__ __forceinline__ void mf_rownorm(const P& p, LAS unsigned char* lds, int layer, int nrows, int comb_layer) {
    constexpr bool ROUTE = MODE == 1; constexpr int which = MODE == 1 ? 1 : 0;
    int tid = threadIdx.x; asm volatile("" : "+v"(tid));
    int bx_ = (int)blockIdx.x, gx_ = (int)gridDim.x; asm volatile("" : "+s"(bx_), "+s"(gx_));
    const int lane = tid & 63, wave = tid >> 6;
    if (ROUTE) { for (int j = bx_ * NTHREADS + tid; j < NSLOT; j += gx_ * NTHREADS) { p.slot_tok[j] = -1; p.slot_gate[j] = 0.f; } }
    const float* gn = MODE == 2 ? p.final_g : (which ? p.norm2_g : p.norm1_g) + layer * D;
    LAS float* Wl = (LAS float*)lds;
    if (ROUTE) { const float* rw = p.router_w + (size_t)layer * D * NE;
        for (int i = tid; i < D * NE / 4; i += NTHREADS) { const float4 w4 = *(const float4*)(rw + 4 * i); const int k = i >> 3, e0 = (i & 7) * 4, kp = k ^ ((k >> 6) & 1);
            const float wv[4] = {w4.x, w4.y, w4.z, w4.w};
#pragma unroll
            for (int t = 0; t < 4; ++t) { const int e = e0 + t; Wl[kp * 32 + 2 * (e & 15) + (e >> 4)] = wv[t]; } }
        __syncthreads(); }
    volatile LAS int* lcnt = (volatile LAS int*)(lds + RING_BYTES);
    volatile LAS int* lbase = lcnt + NE; volatile LAS int* lrank = lcnt + 2 * NE;
    if (ROUTE) { if (tid < NE) lcnt[tid] = 0; __syncthreads(); }
    for (int r = bx_ * 8 + wave; r < nrows; r += gx_ * 8) {
        const int m = r < SEQ ? 0 : (r < NLAT ? 1 : 2);
        const float* mv = p.modv + ((size_t)layer * 3 + m) * 6 * D + which * 3 * D;
        float* xr = p.xa + (size_t)r * D;
        float4 v[4]; float ss = 0.f;
#pragma unroll
        for (int j = 0; j < 4; ++j) v[j] = *(const float4*)(xr + 256 * j + 4 * lane);
        if (comb_layer >= 0) {
            const float* g2 = p.modv + ((size_t)comb_layer * 3 + m) * 6 * D + 5 * D;
            const int4 so = *(const int4*)(p.slot_of + r * 4);
            const bf16_t* y0 = p.yb + (size_t)so.x * D; const bf16_t* y1 = p.yb + (size_t)so.y * D; const bf16_t* y2 = p.yb + (size_t)so.z * D; const bf16_t* y3 = p.yb + (size_t)so.w * D;
#pragma unroll
            for (int j = 0; j < 4; ++j) { const int k = 256 * j + 4 * lane; const ushort4 a = *(const ushort4*)(y0 + k), b = *(const ushort4*)(y1 + k), c = *(const ushort4*)(y2 + k), d = *(const ushort4*)(y3 + k); const float4 gg = *(const float4*)(g2 + k);
                v[j].x += gg.x * (bf2f(a.x) + bf2f(b.x) + bf2f(c.x) + bf2f(d.x)); v[j].y += gg.y * (bf2f(a.y) + bf2f(b.y) + bf2f(c.y) + bf2f(d.y));
                v[j].z += gg.z * (bf2f(a.z) + bf2f(b.z) + bf2f(c.z) + bf2f(d.z)); v[j].w += gg.w * (bf2f(a.w) + bf2f(b.w) + bf2f(c.w) + bf2f(d.w));
                if (MODE != 2) *(float4*)(xr + k) = v[j]; }
        }
#pragma unroll
        for (int j = 0; j < 4; ++j) ss += v[j].x * v[j].x + v[j].y * v[j].y + v[j].z * v[j].z + v[j].w * v[j].w;
        const float rstd = rsqrtf(wave_sum(ss) * (1.0f / D) + EPS);
        if (MODE == 2) {
#pragma unroll
            for (int j = 0; j < 4; ++j) { const int k = 256 * j + 4 * lane; const float4 g4 = *(const float4*)(gn + k);
                float4 o; o.x = v[j].x * rstd * g4.x; o.y = v[j].y * rstd * g4.y; o.z = v[j].z * rstd * g4.z; o.w = v[j].w * rstd * g4.w;
                *(float4*)(p.out + (size_t)r * D + k) = o; }
            continue;
        }
#pragma unroll
        for (int j = 0; j < 4; ++j) { const int k = 256 * j + 4 * lane; const float4 g4 = *(const float4*)(gn + k), sc = *(const float4*)(mv + D + k), sh = *(const float4*)(mv + k);
            v[j].x = v[j].x * rstd * g4.x * (1.0f + sc.x) + sh.x; v[j].y = v[j].y * rstd * g4.y * (1.0f + sc.y) + sh.y;
            v[j].z = v[j].z * rstd * g4.z * (1.0f + sc.z) + sh.z; v[j].w = v[j].w * rstd * g4.w * (1.0f + sc.w) + sh.w;
            ushort4 o; o.x = f2bf(v[j].x); o.y = f2bf(v[j].y); o.z = f2bf(v[j].z); o.w = f2bf(v[j].w);
            *(ushort4*)(p.hxb + (size_t)r * D + k) = o; }
        if (ROUTE) {
            const int cl = lane & 15, Rr = lane >> 4, r1 = Rr & 1;
            const LAS float* wbE = Wl + (64 * Rr) * 32 + 2 * cl + r1 * 32;
            const LAS float* wbO = Wl + (64 * Rr) * 32 + 2 * cl - r1 * 32;
            float acc0 = 0.f, acc1 = 0.f;
#pragma unroll
            for (int j = 0; j < 4; ++j) { const float vq[4] = {v[j].x, v[j].y, v[j].z, v[j].w};
#pragma unroll
                for (int q = 0; q < 4; ++q) { route_steps<0>(vq[q], ((q & 1) ? wbO : wbE) + (256 * j + q) * 32, acc0, acc1); __builtin_amdgcn_sched_barrier(0); } }
            acc0 += __shfl_xor(acc0, 16); acc0 += __shfl_xor(acc0, 32); acc1 += __shfl_xor(acc1, 16); acc1 += __shfl_xor(acc1, 32);
            acc0 += p.router_b[layer * NE + cl]; acc1 += p.router_b[layer * NE + 16 + cl];
            float lg[NE];
#pragma unroll
            for (int e = 0; e < 16; ++e) { lg[e] = __shfl(acc0, e); lg[16 + e] = __shfl(acc1, e); }
            int ti[4]; float tv[4];
#pragma unroll
            for (int s = 0; s < 4; ++s) { int best = 0; float bv = -3.0e38f;
#pragma unroll
                for (int e = 0; e < NE; ++e) { if (lg[e] > bv) { bv = lg[e]; best = e; } }
                ti[s] = best; tv[s] = bv;
#pragma unroll
                for (int e = 0; e < NE; ++e) if (e == best) lg[e] = -3.0e38f; }
            if (lane == 0) {
                const float e1 = expf(tv[1] - tv[0]), e2 = expf(tv[2] - tv[0]), e3 = expf(tv[3] - tv[0]), inv = 1.0f / (1.0f + e1 + e2 + e3);
                p.topi[r * 4 + 0] = ti[0]; p.topi[r * 4 + 1] = ti[1]; p.topi[r * 4 + 2] = ti[2]; p.topi[r * 4 + 3] = ti[3];
                p.topg[r * 4 + 0] = inv; p.topg[r * 4 + 1] = e1 * inv; p.topg[r * 4 + 2] = e2 * inv; p.topg[r * 4 + 3] = e3 * inv;
                const int li = ((r - (bx_ * 8 + wave)) / (gx_ * 8)) * 8 + wave;
#pragma unroll
                for (int s = 0; s < 4; ++s) lrank[li * 4 + s] = __hip_atomic_fetch_add((LAS int*)(lcnt + ti[s]), 1, __ATOMIC_RELAXED, __HIP_MEMORY_SCOPE_WORKGROUP);
            }
        }
    }
    if (ROUTE) {
        __syncthreads();
        if (tid < NE) lbase[tid] = atomicAdd(p.cnt + layer * NE + tid, lcnt[tid]);
        __syncthreads();
        const int nmine = (nrows - bx_ * 8 + gx_ * 8 - 1) / (gx_ * 8) * 8;
        for (int i = tid; i < nmine * 4; i += NTHREADS) { const int li = i >> 2, r = bx_ * 8 + (li & 7) + (li >> 3) * gx_ * 8;
            if (r < nrows) p.pos[r * 4 + (i & 3)] = lbase[p.topi[i - li * 4 + r * 4]] + lrank[i]; }
    }
}
__device__ __forceinline__ float4 ld4px(const float* q) { return *(const float4*)q; }
__device__ __forceinline__ float4 ld4px(const bf16_t* q) { const ushort4 v = *(const ushort4*)q; return make_float4(bf2f(v.x), bf2f(v.y), bf2f(v.z), bf2f(v.w)); }
typedef unsigned short us4v __attribute__((ext_vector_type(4)));
__device__ __forceinline__ us4v pack4(float4 v) { return (us4v){f2bf(v.x), f2bf(v.y), f2bf(v.z), f2bf(v.w)}; }
template <int K> __device__ __forceinline__ pg8::f32x4 mma16(const LAS bf16_t* A, int lda, const LAS bf16_t* Bt, int ldb, pg8::f32x4 acc, int lane) {
    const int r = lane & 15, q = lane >> 4;
    const LAS bf16_t* ap = A + r * lda + 8 * q; const LAS bf16_t* bp = Bt + r * ldb + 8 * q;
#pragma unroll
    for (int k0 = 0; k0 < K; k0 += 32) acc = __builtin_amdgcn_mfma_f32_16x16x32_bf16(*(const LAS pg8::bf16x8*)(ap + k0), *(const LAS pg8::bf16x8*)(bp + k0), acc, 0, 0, 0);
    return acc;
}
constexpr int RLD = 136, RLQ = 72;
__device__ __forceinline__ void mf_retkv(const P& p, LAS unsigned char* lds, int il) {
    int tid = threadIdx.x; asm volatile("" : "+v"(tid));
    int bx_ = (int)blockIdx.x, gx_ = (int)gridDim.x; asm volatile("" : "+s"(bx_), "+s"(gx_));
    const int lane = tid & 63, wave = tid >> 6, r = lane & 15, q = lane >> 4;
    LAS bf16_t* KdT = (LAS bf16_t*)lds; LAS bf16_t* VT = KdT + 64 * RLD;
    for (int u = bx_; u < 16 * RNCH; u += gx_) {
        const int n = u % RNCH, h = (u / RNCH) & 3, b = (u / (RNCH * 4)) & 1, dir = u / (RNCH * 8);
        const float lg = ret_logg(p, il, dir, h);
        __syncthreads();
        for (int idx = tid; idx < 128 * 16; idx += NTHREADS) { const int j = idx >> 4, d4 = idx & 15, row = scan_row(dir, b, n * RC + j);
            const float4 kv = *(const float4*)(p.kr + (size_t)row * 256 + h * 64 + 4 * d4); const float dk = fexp((float)(RC - 1 - j) * lg);
            KdT[(4 * d4 + 0) * RLD + j] = f2bf(kv.x * dk); KdT[(4 * d4 + 1) * RLD + j] = f2bf(kv.y * dk); KdT[(4 * d4 + 2) * RLD + j] = f2bf(kv.z * dk); KdT[(4 * d4 + 3) * RLD + j] = f2bf(kv.w * dk); }
        for (int idx = tid; idx < 128 * 32; idx += NTHREADS) { const int j = idx >> 5, e4 = idx & 31, row = scan_row(dir, b, n * RC + j);
            const float4 vv = ld4px(p.px + (size_t)row * PXLD + 512 + h * 128 + 4 * e4);
            VT[(4 * e4 + 0) * RLD + j] = f2bf(vv.x); VT[(4 * e4 + 1) * RLD + j] = f2bf(vv.y); VT[(4 * e4 + 2) * RLD + j] = f2bf(vv.z); VT[(4 * e4 + 3) * RLD + j] = f2bf(vv.w); }
        __syncthreads();
        float* o = p.rkv + ((((size_t)dir * 2 + b) * RNCH + n) * 4 + h) * 8192;
#pragma unroll
        for (int td = 0; td < 4; ++td) { pg8::f32x4 acc = {0.f, 0.f, 0.f, 0.f};
            acc = mma16<128>(VT + (16 * wave) * RLD, RLD, KdT + (16 * td) * RLD, RLD, acc, lane);
#pragma unroll
            for (int g = 0; g < 4; ++g) o[(size_t)(16 * wave + 4 * q + g) * 64 + 16 * td + r] = acc[g]; }
    }
}
__device__ __forceinline__ void mf_reto(const P& p, LAS unsigned char* lds, int il) {
    int tid = threadIdx.x; asm volatile("" : "+v"(tid));
    int bx_ = (int)blockIdx.x, gx_ = (int)gridDim.x; asm volatile("" : "+s"(bx_), "+s"(gx_));
    const int lane = tid & 63, wave = tid >> 6, r = lane & 15, q = lane >> 4;
    LAS bf16_t* Qs = (LAS bf16_t*)lds; LAS bf16_t* Ks = Qs + 128 * RLQ; LAS bf16_t* ST = Ks + 128 * RLQ; LAS bf16_t* VT = ST + 128 * RLQ; LAS bf16_t* Ps = VT + 128 * RLD;
    for (int u = bx_; u < 16 * RNCH; u += gx_) {
        const int n = u % RNCH, h = (u / RNCH) & 3, b = (u / (RNCH * 4)) & 1, dir = u / (RNCH * 8);
        const float lg = ret_logg(p, il, dir, h);
        const float* Sg = p.rkv + ((((size_t)dir * 2 + b) * RNCH + n) * 4 + h) * 8192;
        __syncthreads();
        for (int idx = tid; idx < 128 * 16; idx += NTHREADS) { const int j = idx >> 4, d4 = idx & 15, row = scan_row(dir, b, n * RC + j);
            const float4 qv = *(const float4*)(p.qr + (size_t)row * 256 + h * 64 + 4 * d4), kv = *(const float4*)(p.kr + (size_t)row * 256 + h * 64 + 4 * d4), sv = *(const float4*)(Sg + (size_t)j * 64 + 4 * d4);
            *(LAS us4v*)(Qs + j * RLQ + 4 * d4) = pack4(qv); *(LAS us4v*)(Ks + j * RLQ + 4 * d4) = pack4(kv); *(LAS us4v*)(ST + j * RLQ + 4 * d4) = pack4(sv); }
        for (int idx = tid; idx < 128 * 32; idx += NTHREADS) { const int j = idx >> 5, e4 = idx & 31, row = scan_row(dir, b, n * RC + j);
            const float4 vv = ld4px(p.px + (size_t)row * PXLD + 512 + h * 128 + 4 * e4);
            VT[(4 * e4 + 0) * RLD + j] = f2bf(vv.x); VT[(4 * e4 + 1) * RLD + j] = f2bf(vv.y); VT[(4 * e4 + 2) * RLD + j] = f2bf(vv.z); VT[(4 * e4 + 3) * RLD + j] = f2bf(vv.w); }
        __syncthreads();
#pragma unroll
        for (int tj = 0; tj < 8; ++tj) { pg8::f32x4 acc = {0.f, 0.f, 0.f, 0.f};
            acc = mma16<64>(Qs + (16 * wave) * RLQ, RLQ, Ks + (16 * tj) * RLQ, RLQ, acc, lane);
            const int j = 16 * tj + r;
#pragma unroll
            for (int g = 0; g < 4; ++g) { const int i = 16 * wave + 4 * q + g; Ps[i * RLD + j] = f2bf(j <= i ? acc[g] * fexp((float)(i - j) * lg) : 0.f); } }
        __syncthreads();
        float dq[4];
#pragma unroll
        for (int g = 0; g < 4; ++g) dq[g] = fexp((float)(16 * wave + 4 * q + g + 1) * lg);
#pragma unroll
        for (int te = 0; te < 8; ++te) { pg8::f32x4 acc = {0.f, 0.f, 0.f, 0.f}, cr = {0.f, 0.f, 0.f, 0.f};
            acc = mma16<128>(Ps + (16 * wave) * RLD, RLD, VT + (16 * te) * RLD, RLD, acc, lane);
            cr = mma16<64>(Qs + (16 * wave) * RLQ, RLQ, ST + (16 * te) * RLQ, RLQ, cr, lane);
#pragma unroll
            for (int g = 0; g < 4; ++g) { const int i = 16 * wave + 4 * q + g, row = scan_row(dir, b, n * RC + i);
                p.oret[((size_t)dir * NTOK + row) * 512 + h * 128 + 16 * te + r] = acc[g] + dq[g] * cr[g]; } }
    }
}
template <bool FILL> __device__ __forceinline__ void mf_s5(const P& p, LAS unsigned char* lds, int il) {
    int tid = threadIdx.x; asm volatile("" : "+v"(tid));
    int bx_ = (int)blockIdx.x, gx_ = (int)gridDim.x; asm volatile("" : "+s"(bx_), "+s"(gx_));
    const int lane = tid & 63, wave = tid >> 6, r = lane & 15, q = lane >> 4;
    constexpr int LDU = 40, LDS_ = 132, LDB = 136;
    LAS bf16_t* Bt = (LAS bf16_t*)lds;
    LAS bf16_t* Ct = Bt + 128 * LDU;
    LAS unsigned char* wb = lds + 16384 + wave * 14336;
    LAS bf16_t* U = (LAS bf16_t*)wb;
    LAS float* SL = (LAS float*)(wb + 1280);
    LAS bf16_t* Sb = (LAS bf16_t*)(wb + 1280 + 8448);
    constexpr int GRP = (2 * S5NCH) / 8;
    static_assert((2 * S5NCH) % 8 == 0, "chunk count");
    for (int bu = bx_; bu < 64 * GRP; bu += gx_) {
        const int dg = bu / GRP, grp = bu % GRP, dir = dg >> 5, g = dg & 31;
        __syncthreads();
        if (tid < 64) { S5Par sp; s5_par(p, il, dir, g, tid, sp);
#pragma unroll
            for (int h = 0; h < 16; ++h) { Bt[(2 * tid) * LDU + h] = f2bf(sp.bbr[h]); Bt[(2 * tid + 1) * LDU + h] = f2bf(sp.bbi[h]); Bt[(2 * tid) * LDU + 16 + h] = 0; Bt[(2 * tid + 1) * LDU + 16 + h] = 0;
                const long ci = (((long)(il * 2 + dir) * NG + g) * GH + h) * NP + tid; Ct[h * LDB + 2 * tid] = f2bf(p.s5_cre[ci]); Ct[h * LDB + 2 * tid + 1] = f2bf(-p.s5_cim[ci]); } }
        float lbr, lbi; { const int gi = (il * 2 + dir) * NG + g; const float lre = fminf(p.s5_lre[gi * NP + lane], -1e-4f), lim = p.s5_lim[gi * NP + lane], dt = expf(p.s5_ldt[gi]);
            const float mag = expf(lre * dt); lbr = mag * cosf(lim * dt); lbi = mag * sinf(lim * dt); }
        __syncthreads();
        const int bc = grp * 8 + wave, b = bc / S5NCH, ch = bc % S5NCH;
        float* ce = p.s5c + ((((size_t)dir * 2 + b) * S5NCH + ch) * NG + g) * NP * 2 + lane * 2;
        float sr = 0.f, si = 0.f;
        if (FILL) { sr = ce[0]; si = ce[1]; }
        float4 uvs[S5C / 16];
#pragma unroll
        for (int sb = 0; sb < S5C / 16; ++sb) { const int k = lane >> 2, h4 = (lane & 3) * 4, row = scan_row(dir, b, ch * S5C + sb * 16 + k);
            uvs[sb] = ld4px(p.px + (size_t)row * PXLD + 1536 + g * GH + h4); }
#pragma unroll
        for (int sb = 0; sb < S5C / 16; ++sb) {
            { const int k = lane >> 2, h4 = (lane & 3) * 4;
              *(LAS us4v*)(U + k * LDU + h4) = pack4(uvs[sb]); *(LAS us4v*)(U + k * LDU + 16 + h4) = (us4v){0, 0, 0, 0}; }
            asm volatile("s_waitcnt lgkmcnt(0)" ::: "memory");
#pragma unroll
            for (int tc = 0; tc < 8; ++tc) { pg8::f32x4 acc = {0.f, 0.f, 0.f, 0.f};
                acc = mma16<32>(U, LDU, Bt + (16 * tc) * LDU, LDU, acc, lane);
#pragma unroll
                for (int gq = 0; gq < 4; ++gq) SL[(4 * q + gq) * LDS_ + 16 * tc + r] = acc[gq]; }
            asm volatile("s_waitcnt lgkmcnt(0)" ::: "memory");
#pragma unroll
            for (int k = 0; k < 16; ++k) { const float br = SL[k * LDS_ + 2 * lane], bi = SL[k * LDS_ + 2 * lane + 1];
                const float tr = lbr * sr - lbi * si + br, ti = lbr * si + lbi * sr + bi; sr = tr; si = ti;
                if (FILL) { Sb[k * LDB + 2 * lane] = f2bf(sr); Sb[k * LDB + 2 * lane + 1] = f2bf(si); } }
            if (FILL) {
                asm volatile("s_waitcnt lgkmcnt(0)" ::: "memory");
                pg8::f32x4 acc = {0.f, 0.f, 0.f, 0.f};
                acc = mma16<128>(Sb, LDB, Ct, LDB, acc, lane);
#pragma unroll
                for (int gq = 0; gq < 4; ++gq) { const int row = scan_row(dir, b, ch * S5C + sb * 16 + 4 * q + gq); p.yd[((size_t)dir * NTOK + row) * S5W + g * GH + r] = acc[gq]; }
            }
            asm volatile("s_waitcnt lgkmcnt(0)" ::: "memory");
        }
        if (!FILL) { ce[0] = sr; ce[1] = si; }
    }
}
__device__ __forceinline__ void mf_swa(const P& p, LAS unsigned char* lds, int il, bool with_ctx) {
    int tid = threadIdx.x; asm volatile("" : "+v"(tid));
    int bx_ = (int)blockIdx.x, gx_ = (int)gridDim.x; asm volatile("" : "+s"(bx_), "+s"(gx_));
    const int lane = tid & 63, wave = tid >> 6, r = lane & 15, q = lane >> 4;
    constexpr int LDK = 72;
    LAS bf16_t* Ks = (LAS bf16_t*)lds;
    LAS bf16_t* VT = Ks + 64 * LDK;
    LAS bf16_t* Pw = VT + 64 * LDK + wave * 64 * LDK;
    constexpr int NQB = SEQ / 128, NLATU = 4 * NQB, NCTXU = 4 * (CTXL / 128);
    const int nunits = NLATU + (with_ctx ? NCTXU : 0);
    for (int u = bx_; u < nunits; u += gx_) {
        int b, kv, qb, isctx;
        if (u < NLATU) { isctx = 0; qb = u % NQB; kv = (u / NQB) & 1; b = u / (NQB * 2); }
        else { const int v = u - NLATU; isctx = 1; qb = v % (CTXL / 128); kv = (v / (CTXL / 128)) & 1; b = v / ((CTXL / 128) * 2); }
        const int g = wave >> 1, hq = kv * 4 + g, i0 = (wave & 1) * 64;
        const int qrow0 = (isctx ? NLAT + b * CTXL : b * SEQ) + qb * 128 + i0;
        pg8::bf16x8 qf[4][2];
#pragma unroll
        for (int tq = 0; tq < 4; ++tq)
#pragma unroll
            for (int ks = 0; ks < 2; ++ks) { const float* src = p.qs + (size_t)(qrow0 + 16 * tq + r) * 512 + hq * 64 + 32 * ks + 8 * q;
                const float4 a = *(const float4*)src, c = *(const float4*)(src + 4);
                qf[tq][ks] = (pg8::bf16x8){(short)f2bf(a.x), (short)f2bf(a.y), (short)f2bf(a.z), (short)f2bf(a.w), (short)f2bf(c.x), (short)f2bf(c.y), (short)f2bf(c.z), (short)f2bf(c.w)}; }
        pg8::f32x4 oacc[4][4];
        float mrow[4][4], lrow[4][4];
        const float sink = p.swa_sink[il * 8 + hq];
#pragma unroll
        for (int tq = 0; tq < 4; ++tq)
#pragma unroll
            for (int x = 0; x < 4; ++x) { oacc[tq][x] = (pg8::f32x4){0.f, 0.f, 0.f, 0.f}; mrow[tq][x] = sink; lrow[tq][x] = 1.0f; }
        const int ntile = isctx ? 4 : 10;
        for (int t = 0; t < ntile; ++t) {
            const bool loc = !isctx && t < 6;
            const int kpos0 = loc ? 128 * (qb - 1) + 64 * t : 0;
            if (loc && (kpos0 < 0 || kpos0 >= SEQ)) continue;
            const int krow0 = loc ? b * SEQ + kpos0 : NLAT + b * CTXL + 64 * (isctx ? t : t - 6);
            __syncthreads();
            for (int idx = tid; idx < 64 * 16; idx += NTHREADS) { const int key = idx >> 4, d4 = idx & 15;
                const float4 kk = *(const float4*)(p.ks + (size_t)(krow0 + key) * 128 + kv * 64 + 4 * d4), vv = ld4px(p.px + (size_t)(krow0 + key) * PXLD + 2176 + kv * 64 + 4 * d4);
                *(LAS us4v*)(Ks + key * LDK + 4 * d4) = pack4(kk);
                VT[(4 * d4 + 0) * LDK + key] = f2bf(vv.x); VT[(4 * d4 + 1) * LDK + key] = f2bf(vv.y); VT[(4 * d4 + 2) * LDK + key] = f2bf(vv.z); VT[(4 * d4 + 3) * LDK + key] = f2bf(vv.w); }
            __syncthreads();
            pg8::f32x4 sc[4][4];
#pragma unroll
            for (int tk = 0; tk < 4; ++tk) { const LAS bf16_t* kp = Ks + (16 * tk + r) * LDK + 8 * q;
                const pg8::bf16x8 k0 = *(const LAS pg8::bf16x8*)kp, k1 = *(const LAS pg8::bf16x8*)(kp + 32);
#pragma unroll
                for (int tq = 0; tq < 4; ++tq) { pg8::f32x4 a = {0.f, 0.f, 0.f, 0.f};
                    a = __builtin_amdgcn_mfma_f32_16x16x32_bf16(qf[tq][0], k0, a, 0, 0, 0); a = __builtin_amdgcn_mfma_f32_16x16x32_bf16(qf[tq][1], k1, a, 0, 0, 0); sc[tq][tk] = a; } }
            if (loc) {
#pragma unroll
                for (int tq = 0; tq < 4; ++tq)
#pragma unroll
                    for (int tk = 0; tk < 4; ++tk)
#pragma unroll
                        for (int x = 0; x < 4; ++x) { const int dlt = (kpos0 + 16 * tk + r) - (128 * qb + i0 + 16 * tq + 4 * q + x); if (dlt > 128 || dlt < -128) sc[tq][tk][x] = -1e30f; }
            }
#pragma unroll
            for (int tq = 0; tq < 4; ++tq)
#pragma unroll
                for (int x = 0; x < 4; ++x) {
                    float mx = fmaxf(fmaxf(sc[tq][0][x], sc[tq][1][x]), fmaxf(sc[tq][2][x], sc[tq][3][x]));
                    mx = fmaxf(mx, __shfl_xor(mx, 1)); mx = fmaxf(mx, __shfl_xor(mx, 2)); mx = fmaxf(mx, __shfl_xor(mx, 4)); mx = fmaxf(mx, __shfl_xor(mx, 8));
                    const float mn = fmaxf(mrow[tq][x], mx), corr = __expf(mrow[tq][x] - mn);
                    float sum = 0.f;
#pragma unroll
                    for (int tk = 0; tk < 4; ++tk) { const float pe = __expf(sc[tq][tk][x] - mn); sum += pe; Pw[(16 * tq + 4 * q + x) * LDK + 16 * tk + r] = f2bf(pe); }
                    sum += __shfl_xor(sum, 1); sum += __shfl_xor(sum, 2); sum += __shfl_xor(sum, 4); sum += __shfl_xor(sum, 8);
                    lrow[tq][x] = lrow[tq][x] * corr + sum; mrow[tq][x] = mn;
#pragma unroll
                    for (int td = 0; td < 4; ++td) oacc[tq][td][x] *= corr;
                }
            asm volatile("s_waitcnt lgkmcnt(0)" ::: "memory");
#pragma unroll
            for (int td = 0; td < 4; ++td) { const LAS bf16_t* vp = VT + (16 * td + r) * LDK + 8 * q;
                const pg8::bf16x8 v0 = *(const LAS pg8::bf16x8*)vp, v1 = *(const LAS pg8::bf16x8*)(vp + 32);
#pragma unroll
                for (int tq = 0; tq < 4; ++tq) { const LAS bf16_t* pp = Pw + (16 * tq + r) * LDK + 8 * q;
                    oacc[tq][td] = __builtin_amdgcn_mfma_f32_16x16x32_bf16(*(const LAS pg8::bf16x8*)pp, v0, oacc[tq][td], 0, 0, 0);
                    oacc[tq][td] = __builtin_amdgcn_mfma_f32_16x16x32_bf16(*(const LAS pg8::bf16x8*)(pp + 32), v1, oacc[tq][td], 0, 0, 0); } }
        }
#pragma unroll
        for (int tq = 0; tq < 4; ++tq)
#pragma unroll
            for (int x = 0; x < 4; ++x) { const float inv = 1.0f / lrow[tq][x]; bf16_t* o = p.mixb + (size_t)(qrow0 + 16 * tq + 4 * q + x) * D + 512 + hq * 64 + r;
#pragma unroll
                for (int td = 0; td < 4; ++td) o[16 * td] = f2bf(oacc[tq][td][x] * inv); }
    }
}
__device__ __forceinline__ void mf_sconv(const P& p, LAS unsigned char* lds, int il) {
    int tid = threadIdx.x; asm volatile("" : "+v"(tid));
    int bx_ = (int)blockIdx.x, gx_ = (int)gridDim.x; asm volatile("" : "+s"(bx_), "+s"(gx_));
    LAS float* T = (LAS float*)lds;
    const float* sw = p.hy_short_w + il * 3 * 1536; const float* sb = p.hy_short_b + il * 1536;
    constexpr int NT = (NTOK / 64) * (HYW / 64);
    for (int t = bx_; t < NT; t += gx_) {
        const int r0 = (t / (HYW / 64)) * 64, c0 = (t % (HYW / 64)) * 64;
        const int rl = tid >> 3, cs = (tid & 7) * 8, r = r0 + rl; const RowInfo ri = row_info(r);
        float u[3][8];
#pragma unroll
        for (int g = 0; g < 3; ++g) { const int col = g * HYW + c0 + cs; const float4 b0 = *(const float4*)(sb + col), b1 = *(const float4*)(sb + col + 4);
            u[g][0] = b0.x; u[g][1] = b0.y; u[g][2] = b0.z; u[g][3] = b0.w; u[g][4] = b1.x; u[g][5] = b1.y; u[g][6] = b1.z; u[g][7] = b1.w;
#pragma unroll
            for (int j = 0; j < 3; ++j) { const int tt = ri.t + j - 1; if (tt >= 0 && tt < ri.len) { const px_t* px = p.px + (size_t)(ri.base + tt) * PXLD + col; const float* wj = sw + j * 1536 + col;
                const float4 x0 = ld4px(px), x1 = ld4px(px + 4), w0 = *(const float4*)wj, w1 = *(const float4*)(wj + 4);
                u[g][0] += w0.x * x0.x; u[g][1] += w0.y * x0.y; u[g][2] += w0.z * x0.z; u[g][3] += w0.w * x0.w; u[g][4] += w1.x * x1.x; u[g][5] += w1.y * x1.y; u[g][6] += w1.z * x1.z; u[g][7] += w1.w * x1.w; } } }
        float z[8];
#pragma unroll
        for (int k = 0; k < 8; ++k) z[k] = u[2][k] * u[1][k];
        const size_t i = (size_t)r * HYW + c0 + cs;
        *(float4*)(p.x0c + i) = make_float4(u[0][0], u[0][1], u[0][2], u[0][3]); *(float4*)(p.x0c + i + 4) = make_float4(u[0][4], u[0][5], u[0][6], u[0][7]);
        *(float4*)(p.zb + i) = make_float4(z[0], z[1], z[2], z[3]); *(float4*)(p.zb + i + 4) = make_float4(z[4], z[5], z[6], z[7]);
        if (r0 < NLAT) {
            __syncthreads();
#pragma unroll
            for (int k = 0; k < 8; ++k) T[(cs + k) * 65 + rl] = z[k];
            __syncthreads();
            const int cl = tid >> 3, rs = (tid & 7) * 8; const LAS float* src = T + cl * 65 + rs; float* dst = p.zT + (size_t)(c0 + cl) * NLAT + r0 + rs;
            *(float4*)dst = make_float4(src[0], src[1], src[2], src[3]); *(float4*)(dst + 4) = make_float4(src[4], src[5], src[6], src[7]);
        }
    }
}
__device__ __forceinline__ void mf_filter_tiles(const P& p, LAS unsigned char* lds) {
    int tid = threadIdx.x; asm volatile("" : "+v"(tid));
    int bx_ = (int)blockIdx.x, gx_ = (int)gridDim.x; asm volatile("" : "+s"(bx_), "+s"(gx_));
    LAS float* A1 = (LAS float*)lds; LAS float* A2 = A1 + 64 * 65; LAS float* T = A2 + 64 * 65;
    constexpr int RT = (SEQ + CTXL) / 64;
    const int rl = tid >> 3, cs = (tid & 7) * 8;
    constexpr int NLT = 2 * (SEQ / 64), NCT = 2 * (CTXL / 64), NITEM = NLT + NCT * (HYW / 64);
    for (int it = bx_; it < NITEM; it += gx_) {
        int t, ct0, ct1;
        if (it < NLT) { t = (it / (SEQ / 64)) * RT + it % (SEQ / 64); ct0 = 0; ct1 = HYW / 64; }
        else { const int v = it - NLT, tc = v / (HYW / 64); t = (tc / (CTXL / 64)) * RT + SEQ / 64 + tc % (CTXL / 64); ct0 = v % (HYW / 64); ct1 = ct0 + 1; }
        const int i = t / RT, rt = t % RT, q0 = rt * 64, kind = q0 >= SEQ, L = kind ? CTXL : SEQ, q = q0 + rl, pos = kind ? q - SEQ : q;
        const long rr = (long)i * (SEQ + CTXL) + q;
        __syncthreads();
        {
            const float* w1 = p.hy_f_w1 + i * 33 * 64 + cs; const float tt = (float)pos / (float)L, w = 6.283185307179586f * (float)pos / (float)L;
            float acc[8];
#pragma unroll
            for (int k = 0; k < 8; ++k) acc[k] = tt * w1[k];
            for (int bi = 0; bi < 16; ++bi) { const float band = 1e-4f + (float)bi * ((15.0f - 1e-4f) / 15.0f), cc = ROPE_COS(band * w), sn = ROPE_SIN(band * w);
                const float* wc = w1 + (1 + bi) * 64; const float* ws = w1 + (17 + bi) * 64;
#pragma unroll
                for (int k = 0; k < 8; ++k) acc[k] += cc * wc[k] - sn * ws[k]; }
#pragma unroll
            for (int k = 0; k < 8; ++k) A1[rl * 65 + cs + k] = ROPE_SIN(acc[k] + p.hy_f_b1[i * 64 + cs + k]);
        }
        __syncthreads();
        {
            const float* w2 = p.hy_f_w2 + i * 64 * 64 + cs; float acc[8];
#pragma unroll
            for (int k = 0; k < 8; ++k) acc[k] = 0.f;
            for (int kk = 0; kk < 64; ++kk) { const float hv = A1[rl * 65 + kk]; const float4 a = *(const float4*)(w2 + kk * 64), b4 = *(const float4*)(w2 + kk * 64 + 4);
                acc[0] += hv * a.x; acc[1] += hv * a.y; acc[2] += hv * a.z; acc[3] += hv * a.w; acc[4] += hv * b4.x; acc[5] += hv * b4.y; acc[6] += hv * b4.z; acc[7] += hv * b4.w; }
#pragma unroll
            for (int k = 0; k < 8; ++k) A2[rl * 65 + cs + k] = ROPE_SIN(acc[k] + p.hy_f_b2[i * 64 + cs + k]);
        }
        __syncthreads();
        const float lag = fabsf((float)(pos - L / 2)) / (float)(L / 2);
        for (int ct = ct0; ct < ct1; ++ct) {
            const int c0 = ct * 64; const float* w3 = p.hy_f_w3 + (size_t)i * 64 * HYW + c0 + cs;
            float acc[8];
#pragma unroll
            for (int k = 0; k < 8; ++k) acc[k] = 0.f;
            for (int kk = 0; kk < 64; ++kk) { const float hv = A2[rl * 65 + kk]; const float4 a = *(const float4*)(w3 + (size_t)kk * HYW), b4 = *(const float4*)(w3 + (size_t)kk * HYW + 4);
                acc[0] += hv * a.x; acc[1] += hv * a.y; acc[2] += hv * a.z; acc[3] += hv * a.w; acc[4] += hv * b4.x; acc[5] += hv * b4.y; acc[6] += hv * b4.z; acc[7] += hv * b4.w; }
            const float fast = -15.350567286626973f, slow = -3.0701134573253946f;
#pragma unroll
            for (int k = 0; k < 8; ++k) { const float delta = fabsf(fast + (slow - fast) * (float)(c0 + cs + k) / 511.0f); acc[k] *= fexp(-lag * delta) + 0.05f; }
            float* o = p.hraw + rr * HYW + c0 + cs;
            *(float4*)o = make_float4(acc[0], acc[1], acc[2], acc[3]); *(float4*)(o + 4) = make_float4(acc[4], acc[5], acc[6], acc[7]);
            __syncthreads();
#pragma unroll
            for (int k = 0; k < 8; ++k) T[(cs + k) * 65 + rl] = acc[k];
            __syncthreads();
            const int cl = tid >> 3, rs = (tid & 7) * 8; const LAS float* src = T + cl * 65 + rs;
            float v8[8];
#pragma unroll
            for (int k = 0; k < 8; ++k) v8[k] = src[k];
            if (!kind) { float* dst = p.hT + ((size_t)i * HYW + c0 + cl) * SEQ + q0 + rs;
                *(float4*)dst = make_float4(v8[0], v8[1], v8[2], v8[3]); *(float4*)(dst + 4) = make_float4(v8[4], v8[5], v8[6], v8[7]); }
            float sa = 0.f;
#pragma unroll
            for (int k = 0; k < 8; ++k) sa += fabsf(v8[k]);
            sa += __shfl_xor(sa, 1); sa += __shfl_xor(sa, 2); sa += __shfl_xor(sa, 4);
            if ((tid & 7) == 0) p.hpart[(size_t)t * HYW + c0 + cl] = sa;
        }
    }
}
__device__ __forceinline__ void mf_hymix(const P& p, LAS unsigned char* lds, int il) {
    int tid = threadIdx.x; asm volatile("" : "+v"(tid));
    int bx_ = (int)blockIdx.x, gx_ = (int)gridDim.x; asm volatile("" : "+s"(bx_), "+s"(gx_));
    LAS float* T = (LAS float*)lds;
    constexpr int NT = (NLAT / 64) * (HYW / 64);
    for (int t = bx_; t < NT; t += gx_) {
        const int r0 = (t / (HYW / 64)) * 64, c0 = (t % (HYW / 64)) * 64;
        __syncthreads();
        { const int cl = tid >> 3, rs = (tid & 7) * 8; const float* src = p.convT + (size_t)(c0 + cl) * NLAT + r0 + rs; const float4 a = *(const float4*)src, b = *(const float4*)(src + 4);
          LAS float* d = T + cl * 65 + rs; d[0] = a.x; d[1] = a.y; d[2] = a.z; d[3] = a.w; d[4] = b.x; d[5] = b.y; d[6] = b.z; d[7] = b.w; }
        __syncthreads();
        { const int rl = tid >> 3, cs = (tid & 7) * 8; const size_t i = (size_t)(r0 + rl) * HYW + c0 + cs;
          const float4 z0 = *(const float4*)(p.zb + i), z1 = *(const float4*)(p.zb + i + 4), x0 = *(const float4*)(p.x0c + i), x1 = *(const float4*)(p.x0c + i + 4);
          const float4 b0 = *(const float4*)(p.hy_bias + il * HYW + c0 + cs), b1 = *(const float4*)(p.hy_bias + il * HYW + c0 + cs + 4);
          const float zz[8] = {z0.x, z0.y, z0.z, z0.w, z1.x, z1.y, z1.z, z1.w}, xx[8] = {x0.x, x0.y, x0.z, x0.w, x1.x, x1.y, x1.z, x1.w}, bb[8] = {b0.x, b0.y, b0.z, b0.w, b1.x, b1.y, b1.z, b1.w};
          unsigned short o[8];
#pragma unroll
          for (int k = 0; k < 8; ++k) o[k] = f2bf(xx[k] * (T[(cs + k) * 65 + rl] + bb[k] * zz[k]));
          uint4 ov; ov.x = o[0] | ((unsigned)o[1] << 16); ov.y = o[2] | ((unsigned)o[3] << 16); ov.z = o[4] | ((unsigned)o[5] << 16); ov.w = o[6] | ((unsigned)o[7] << 16);
          *(uint4*)(p.mixb + (size_t)(r0 + rl) * D + c0 + cs) = ov; }
    }
}
__device__ __forceinline__ void mf_retout(const P& p, int nrows) {
    int tid = threadIdx.x; asm volatile("" : "+v"(tid));
    int bx_ = (int)blockIdx.x, gx_ = (int)gridDim.x; asm volatile("" : "+s"(bx_), "+s"(gx_));
    const int lane = tid & 63, wave = tid >> 6;
    for (int r = bx_ * 8 + wave; r < nrows; r += gx_ * 8) {
        const float* o0 = p.oret + (size_t)r * 512 + 8 * lane; const float* o1 = p.oret + ((size_t)NTOK + r) * 512 + 8 * lane; const px_t* gp = p.px + (size_t)r * PXLD + 1024 + 8 * lane;
        const float4 a0 = *(const float4*)o0, a1 = *(const float4*)(o0 + 4), b0 = *(const float4*)o1, b1 = *(const float4*)(o1 + 4), g0 = ld4px(gp), g1 = ld4px(gp + 4);
        const float o[8] = {a0.x + b0.x, a0.y + b0.y, a0.z + b0.z, a0.w + b0.w, a1.x + b1.x, a1.y + b1.y, a1.z + b1.z, a1.w + b1.w}, gg[8] = {g0.x, g0.y, g0.z, g0.w, g1.x, g1.y, g1.z, g1.w};
        float ss = 0.f;
#pragma unroll
        for (int k = 0; k < 8; ++k) ss += o[k] * o[k];
        ss += __shfl_xor(ss, 1); ss += __shfl_xor(ss, 2); ss += __shfl_xor(ss, 4); ss += __shfl_xor(ss, 8);
        const float rs = rsqrtf(ss * (1.0f / 128.0f) + EPS);
        unsigned short ob[8];
#pragma unroll
        for (int k = 0; k < 8; ++k) ob[k] = f2bf(o[k] * rs * siluf_(gg[k]));
        uint4 ov; ov.x = ob[0] | ((unsigned)ob[1] << 16); ov.y = ob[2] | ((unsigned)ob[3] << 16); ov.z = ob[4] | ((unsigned)ob[5] << 16); ov.w = ob[6] | ((unsigned)ob[7] << 16);
        *(uint4*)(p.mixb + (size_t)r * D + 8 * lane) = ov;
    }
}
__device__ __forceinline__ void mf_lconv(const P& p, LAS unsigned char* lds, int il) {
    int tid = threadIdx.x; asm volatile("" : "+v"(tid));
    int bx_ = (int)blockIdx.x, gx_ = (int)gridDim.x; asm volatile("" : "+s"(bx_), "+s"(gx_));
    for (int c = bx_; c < HYW; c += gx_) lconv_unit(p, il, c, (LAS CX*)lds, p.zf + (size_t)bx_ * 2 * FFTN, tid, NTHREADS);
}
__device__ __forceinline__ void mf_inproj(const P& p, LAS unsigned char* lds, int layer) {
    const int il = layer >> 1; const bool ab = !(layer & 1);
    pg8::Gemm g{p.hxb, ab ? p.abin_t + (size_t)il * AB_IN * D : p.cdin_t + (size_t)il * CD_IN * D, NTOK, ab ? AB_IN : CD_IN, D, 0};
    int gx_ = (int)gridDim.x, bx_ = (int)blockIdx.x; asm volatile("" : "+s"(gx_), "+s"(bx_));
    pg8::StaticOrder S; S.init(g.M, g.N, gx_, bx_);
    pg8::EpiStoreBf16 E{p.px, PXLD};
    pg8::gemm_phase(lds, g, S, E);
}
__device__ __forceinline__ void mf_outproj(const P& p, LAS unsigned char* lds, int layer, int nrows) {
    const int il = layer >> 1; const bool ab = !(layer & 1);
    pg8::Gemm g{p.mixb, (ab ? p.about_t : p.cdout_t) + (size_t)il * D * D, nrows, D, D, 0};
    int gx_ = (int)gridDim.x, bx_ = (int)blockIdx.x; asm volatile("" : "+s"(gx_), "+s"(bx_));
    pg8::StaticOrder S; S.init(g.M, g.N, gx_, bx_);
    pg8::EpiResid E{p.xa, p.modv + (size_t)layer * 3 * 6 * D + 2 * D};
    pg8::gemm_phase(lds, g, S, E);
}
__device__ __forceinline__ void mf_glu(const P& p, LAS unsigned char* lds, int il) {
    pg8::Gemm g{p.ys5b, p.glu_t + (size_t)il * S5W * S5W, NTOK, S5W, S5W, 0};
    int gx_ = (int)gridDim.x, bx_ = (int)blockIdx.x; asm volatile("" : "+s"(gx_), "+s"(bx_));
    pg8::StaticOrder S; S.init(g.M, g.N, gx_, bx_);
    pg8::EpiGlu E{p.mixb, p.ys5b, p.s5_glu_b + il * S5W};
    pg8::gemm_phase(lds, g, S, E);
}
__device__ __forceinline__ int build_ue(const P& p, LAS unsigned char* lds, int layer) {
    volatile LAS unsigned char* ue = (volatile LAS unsigned char*)(lds + UE_OFF); volatile LAS int* tot = (volatile LAS int*)(lds + MISC_OFF + 16);
    __syncthreads();
    if (threadIdx.x == 0) { const int* cnt = p.cnt + layer * NE; int t = 0;
        for (int e = 0; e < NE; ++e) { const int nt = (cnt[e] + 255) >> 8; for (int q = 0; q < nt; ++q) ue[t + q] = (unsigned char)e; t += nt; }
        *tot = t; }
    __syncthreads();
    return *tot;
}
__device__ __forceinline__ void mf_moe1(const P& p, LAS unsigned char* lds, int layer) {
    const int tiles = build_ue(p, lds, layer);
    int gx_ = (int)gridDim.x, bx_ = (int)blockIdx.x; asm volatile("" : "+s"(gx_), "+s"(bx_));
    pg8::MoeOrder S{tiles * 8, 8, gx_, bx_, (const volatile LAS unsigned char*)(lds + UE_OFF), (const volatile LAS int*)(lds + TOK_OFF)};
    volatile LAS int* tokt = (volatile LAS int*)(lds + TOK_OFF);
    { int tid = threadIdx.x; asm volatile("" : "+v"(tid));
      for (int i = 0; i < TOK_UNITS; ++i) { int pm, pn; if (!S.unit(i, pm, pn)) break;
          for (int t = tid; t < 256; t += NTHREADS) { const int tk = p.slot_tok[pm * 256 + t]; tokt[i * 256 + t] = tk < 0 ? NTOK : tk; } }
      __syncthreads(); }
    pg8::Gemm g{p.hxb, p.wgu_t + (size_t)layer * NE * 2 * DFF * D, tiles * 256, 2 * DFF, D, (size_t)2 * DFF * D * 2};
    pg8::EpiSwiglu E{p.actb, p.b_gu + (size_t)layer * NE * 2 * DFF};
    pg8::gemm_phase<pg8::EpiSwiglu, pg8::MoeOrder, true>(lds, g, S, E);
}
__device__ __forceinline__ void mf_moe2(const P& p, LAS unsigned char* lds, int layer) {
    const int tiles = build_ue(p, lds, layer);
    pg8::Gemm g{p.actb, p.wdn_t + (size_t)layer * NE * D * DFF, tiles * 256, D, DFF, (size_t)D * DFF * 2};
    int gx_ = (int)gridDim.x, bx_ = (int)blockIdx.x; asm volatile("" : "+s"(gx_), "+s"(bx_));
    pg8::MoeOrder S{tiles * 4, 4, gx_, bx_, (const volatile LAS unsigned char*)(lds + UE_OFF), nullptr};
    pg8::EpiDown E{p.yb, p.b_dn + (size_t)layer * NE * D, p.slot_gate};
    pg8::gemm_phase(lds, g, S, E);
}

#define XB_TMO      128
#define XB_XCNT(j)  (256  + 64 * (j))
#define XB_XSUB(j)  (1280 + 64 * (j))
#define XB_XGEN(j)  (2304 + 64 * (j))
#define XB_TOP      3328
#define XB_TOPGEN   3392
#define XCD_BAR_WORDS 3456
#define XB_SPIN_CAP (1u << 18)

__device__ __forceinline__ unsigned xb_ld(unsigned* p)              { return __hip_atomic_load(p, __ATOMIC_RELAXED, __HIP_MEMORY_SCOPE_AGENT); }
__device__ __forceinline__ unsigned xb_add(unsigned* p, unsigned v) { return __hip_atomic_fetch_add(p, v, __ATOMIC_RELAXED, __HIP_MEMORY_SCOPE_AGENT); }
__device__ __forceinline__ unsigned xb_xcc_id() { return (unsigned)__builtin_amdgcn_s_getreg((3 << 11) | 20) & 0xFu; }
#define XB_SPIN(cond, bar) do { unsigned _sp = 0; while (cond) { __builtin_amdgcn_s_sleep(1); \
    if ((++_sp & 255u) == 0u) { if (xb_ld(&(bar)[XB_TMO])) break; if (_sp > XB_SPIN_CAP) { atomicAdd(&(bar)[XB_TMO], 1u); break; } } } } while (0)

struct XcdBarrier { unsigned* bar; unsigned x; volatile LAS unsigned* st; };

__device__ __forceinline__ XcdBarrier xcd_barrier_post(unsigned* bar, volatile LAS unsigned* st) {
    XcdBarrier b; b.bar = bar; b.x = xb_xcc_id(); b.st = st;
    if (threadIdx.x == 0) (void)xb_add(&bar[XB_XCNT(b.x)], 1u);
    return b;
}
__device__ __forceinline__ void xcd_barrier_complete(unsigned* bar, unsigned x, unsigned& nloc, unsigned& nx) {
    const unsigned G = gridDim.x * gridDim.y * gridDim.z;
    unsigned sum, cnt, mine, sp = 0u;
    asm volatile("" : "+s"(x));
    for (;;) {
        sum = 0u; cnt = 0u; mine = 0u;
#pragma unroll
        for (unsigned j = 0; j < 16; ++j) { const unsigned c = xb_ld(&bar[XB_XCNT(j)]); sum += c; cnt += (c > 0u) ? 1u : 0u; mine = (j == x) ? c : mine; }
        if (sum == G) break;
        __builtin_amdgcn_s_sleep(1);
        if ((++sp & 255u) == 0u) { if (xb_ld(&bar[XB_TMO])) break; if (sp > XB_SPIN_CAP) { atomicAdd(&bar[XB_TMO], 1u); break; } }
    }
    nloc = mine > 0u ? mine : 1u; nx = cnt > 0u ? cnt : 1u;
}
__device__ __forceinline__ void xcd_barrier(const XcdBarrier& b) {
    asm volatile("s_waitcnt vmcnt(0)" ::: "memory");
    __syncthreads();
    if (threadIdx.x == 0) {
        unsigned* bar = b.bar; unsigned bx = b.x;
        asm volatile("" : "+s"(bar), "+s"(bx));
        __builtin_amdgcn_s_waitcnt(0);
        unsigned nloc = b.st[0], nx = b.st[1];
        if (nloc == 0u) { xcd_barrier_complete(bar, bx, nloc, nx); b.st[0] = nloc; b.st[1] = nx; }
        const unsigned old = xb_add(&bar[XB_XSUB(bx)], 1u);
        const unsigned gen = old / nloc;
        if (old + 1u == (gen + 1u) * nloc) {
            __builtin_amdgcn_fence(__ATOMIC_RELEASE, "agent");
            asm volatile("s_waitcnt vmcnt(0)" ::: "memory");
            const unsigned og = xb_add(&bar[XB_TOP], 1u);
            const unsigned tg = og / nx;
            if (og + 1u == (tg + 1u) * nx) xb_add(&bar[XB_TOPGEN], 1u);
            else XB_SPIN(xb_ld(&bar[XB_TOPGEN]) == tg, bar);
            __builtin_amdgcn_fence(__ATOMIC_ACQUIRE, "agent");
            xb_add(&bar[XB_XGEN(bx)], 1u);
            asm volatile("s_waitcnt vmcnt(0)" ::: "memory");
        } else {
            XB_SPIN(xb_ld(&bar[XB_XGEN(bx)]) == gen, bar);
            __builtin_amdgcn_fence(__ATOMIC_ACQUIRE, "agent");
            asm volatile("s_waitcnt vmcnt(0)" ::: "memory");
        }
    }
    __syncthreads();
}

typedef const __attribute__((address_space(4))) P* KP;
__global__ void __launch_bounds__(NTHREADS, 2) fwd_kernel(P p_arg) {
    (void)p_arg;
    const KP kp0 = (KP)__builtin_amdgcn_kernarg_segment_ptr();
#define p (*(const P*)({ KP q_ = kp0; asm volatile("" : "+s"(q_)); q_; }))
    extern __shared__ __attribute__((aligned(16))) unsigned char lds_raw[];
    LAS unsigned char* lds = (LAS unsigned char*)lds_raw;
    for (int u = threadIdx.x; u < (LDS_BYTES - MISC_OFF) / 4; u += NTHREADS) ((LAS unsigned*)(lds + MISC_OFF))[u] = 0u;
    __syncthreads();
    XcdBarrier bar = xcd_barrier_post(p.bar, (volatile LAS unsigned*)(lds + MISC_OFF));
    const long gs = (long)gridDim.x * NTHREADS;
#define gt ({ int b_ = (int)blockIdx.x; asm volatile("" : "+s"(b_)); long g_ = (long)b_ * NTHREADS + threadIdx.x; asm volatile("" : "+v"(g_)); g_; })
#define SETUP(S) setup_slot<S>(p, gt, gs); xcd_barrier(bar);
    for (int rep = 0; rep < REP_SETUP; ++rep) {
    setup_slot<0>(p, gt, gs); mf_filter_tiles(p, lds); __syncthreads(); ph_convert_weights(p, lds); xcd_barrier(bar);
    ph_mod2(p, gt, gs); ph_filt4(p, gt, gs); xcd_barrier(bar);
    }
#define SLOT(S) layer_slot<S>(p, layer, gt, gs); xcd_barrier(bar);
#if MFMA_DENSE
#define DENSE_IN  for (int rep = 0; rep < REP_IN; ++rep) { mf_inproj(p, lds, layer); if (layer < 3) convert_deferred(p, lds, layer, 0); xcd_barrier(bar); }
#define DENSE_OUT if (!(layer & 1)) mf_glu(p, lds, layer >> 1); else ph_retout(p, layer < 3 ? NTOK : NLAT, gt, gs); xcd_barrier(bar); \
                  mf_outproj(p, lds, layer, layer < 3 ? NTOK : NLAT); xcd_barrier(bar);
#else
#define DENSE_IN  SLOT(2)
#define DENSE_OUT SLOT(7) SLOT(8)
#endif
#if MFMA_MOE
#define MOE_GEMMS for (int rep = 0; rep < REP_MOE; ++rep) { mf_moe1(p, lds, layer); xcd_barrier(bar); } for (int rep = 0; rep < REP_MOE2; ++rep) { mf_moe2(p, lds, layer); xcd_barrier(bar); }
#else
#define MOE_GEMMS SLOT(14) SLOT(15)
#endif
#define REPF(n) for (int rep_ = 0; rep_ < (n); ++rep_)
#define LAYER(L) { constexpr int layer = L; constexpr bool AB = !(layer & 1); constexpr int il = layer >> 1; constexpr int nrows = layer < 3 ? NTOK : NLAT; \
    REPF(RN) mf_rownorm<0>(p, lds, layer, NTOK, layer - 1); xcd_barrier(bar); DENSE_IN \
    REPF(R3) { if (AB) { mf_s5<false>(p, lds, il); mf_sconv(p, lds, il); } else ph_rope(p, gt, gs); } xcd_barrier(bar); \
    REPF(R4) { if (AB) { mf_lconv(p, lds, il); ph_lconv(p, il, NLAT, NTOK, gt, gs); } else mf_retkv(p, lds, il); } if (AB) ph_s5carry(p, il, gt, gs); xcd_barrier(bar); \
    REPF(R5) { if (AB) { mf_s5<true>(p, lds, il); mf_hymix(p, lds, il); } else mf_swa(p, lds, il, layer < 3); } if (!AB) ph_retcarry(p, il, gt, gs); xcd_barrier(bar); \
    REPF(R6) { if (AB) ph_s5fin(p, il, gt, gs); else mf_reto(p, lds, il); } xcd_barrier(bar); \
    REPF(R7) { if (AB) mf_glu(p, lds, il); else mf_retout(p, nrows); } xcd_barrier(bar); \
    mf_outproj(p, lds, layer, nrows); if (layer < 3) convert_deferred(p, lds, layer, 1); xcd_barrier(bar); \
    mf_rownorm<1>(p, lds, layer, nrows, -1); xcd_barrier(bar); SLOT(12) MOE_GEMMS }
    LAYER(0) LAYER(1) LAYER(2) LAYER(3)
    mf_rownorm<2>(p, lds, 3, NLAT, 3);
#undef gt
#undef p
}

extern "C" void kernel_launch(void* const* d_in, const int* in_sizes, int n_in, void* d_out, int out_size, void* d_ws, size_t ws_size, hipStream_t stream) {
    (void)in_sizes; (void)n_in; (void)out_size;
    const WsMap m = ws_map();
    if (ws_size < m.total) { fprintf(stderr, "workspace too small: %zu < %zu\n", ws_size, m.total); return; }
    P p; memset(&p, 0, sizeof(p)); fill_params(p, d_in, d_out, d_ws);
    static int grid = 0;
    if (!grid) {
        int dev = 0, cus = 0, per_cu = 0;
        (void)hipGetDevice(&dev); (void)hipDeviceGetAttribute(&cus, hipDeviceAttributeMultiprocessorCount, dev);
        if (hipFuncSetAttribute((const void*)fwd_kernel, hipFuncAttributeMaxDynamicSharedMemorySize, LDS_BYTES) != hipSuccess) { fprintf(stderr, "hipFuncSetAttribute failed\n"); grid = -1; return; }
        (void)hipOccupancyMaxActiveBlocksPerMultiprocessor(&per_cu, (const void*)fwd_kernel, NTHREADS, LDS_BYTES);
        if (per_cu < 1) fprintf(stderr, "occupancy query reports %d blocks per CU\n", per_cu);
        grid = cus;
    }
    if (grid <= 0) return;
    (void)hipMemsetAsync(p.bar, 0, XCD_BAR_WORDS * sizeof(unsigned), stream);
    fwd_kernel<<<dim3(grid), dim3(NTHREADS), LDS_BYTES, stream>>>(p);
}
#endif
```

```cpp
#ifndef CPU_SHIM
#include <hip/hip_runtime.h>
#include <cstring>
#include <cstdio>
#include <cstdint>
#define DEV __device__ __forceinline__
#else
#include <cmath>
#include <cstdio>
#include <cstdint>
#include <cstring>
#include <cstdlib>
#define DEV static inline
static inline float rsqrtf(float x) { return 1.0f / sqrtf(x); }
#endif

#ifndef SEQ
#define SEQ 8192
#endif
#ifndef CTXL
#define CTXL 256
#endif
#ifndef N_LAUNCH_MODE
#define N_LAUNCH_MODE 1
#endif
#ifdef CPU_SHIM
#define MFMA_DENSE 0
#define MFMA_MOE 0
#endif
#ifndef R3
#define R3 1
#endif
#ifndef R4
#define R4 1
#endif
#ifndef R5
#define R5 1
#endif
#ifndef R6
#define R6 1
#endif
#ifndef R7
#define R7 1
#endif
#ifndef RG
#define RG 1
#endif
#ifndef RN
#define RN 1
#endif
#ifndef REP_SETUP
#define REP_SETUP 1
#endif
#ifndef REP_MOE
#define REP_MOE 1
#endif
#ifndef REP_MOE2
#define REP_MOE2 1
#endif
#ifndef REP_IN
#define REP_IN 1
#endif
#ifndef REP_RET
#define REP_RET 1
#endif
#ifndef REP_SWA
#define REP_SWA 1
#endif
#ifndef REP_S5
#define REP_S5 1
#endif
#ifndef MFMA_DENSE
#define MFMA_DENSE 1
#endif
#ifndef MFMA_MOE
#define MFMA_MOE 1
#endif
typedef unsigned short bf16_t;
#if MFMA_DENSE
typedef unsigned short px_t;
#else
typedef float px_t;
#endif

constexpr int D = 1024, NLAT = 2 * SEQ, NCTX = 2 * CTXL, NTOK = NLAT + NCTX;
constexpr int HYW = 512, S5W = 512, NG = 32, NP = 64, GH = 16;
constexpr int AB_IN = 2048, CD_IN = 2304, PXLD = 2304;
constexpr int NE = 32, DFF = 1024;
constexpr float EPS = 1e-6f;
constexpr int NSLOT = ((NTOK * 4 + 255) / 256 + NE) * 256;
#ifdef CPU_SHIM
DEV bf16_t f2bf(float f) { unsigned u; memcpy(&u, &f, 4); return (bf16_t)((u + 0x7fffu + ((u >> 16) & 1u)) >> 16); }
DEV float fexp(float x) { return expf(x); }
DEV float frcp(float x) { return 1.0f / x; }
#else
DEV bf16_t f2bf(float f) { const __bf16 b = (__bf16)f; return __builtin_bit_cast(unsigned short, b); }
DEV float fexp(float x) { return __builtin_amdgcn_exp2f(1.4426950408889634f * x); }
DEV float frcp(float x) { return __builtin_amdgcn_rcpf(x); }
#endif
DEV float bf2f(bf16_t b) { const unsigned u = (unsigned)b << 16; float f; memcpy(&f, &u, 4); return f; }
DEV float pxf(float v) { return v; }
DEV float pxf(bf16_t v) { return bf2f(v); }
DEV void pxstore(float* q, float v) { *q = v; }
DEV void pxstore(bf16_t* q, float v) { *q = f2bf(v); }

struct P {
    const float *x, *c, *ctx, *c_ctx, *mod_w, *mod_b, *norm1_g, *norm2_g, *ab_w_in, *ab_w_out, *hy_short_w, *hy_short_b,
        *hy_f_w1, *hy_f_b1, *hy_f_w2, *hy_f_b2, *hy_f_w3, *hy_bias, *s5_lre, *s5_lim, *s5_ldt, *s5_bre, *s5_bim, *s5_cre, *s5_cim,
        *s5_d, *s5_glu_w, *s5_glu_b, *cd_w_in, *cd_w_out, *ret_decay, *swa_sink, *router_w, *router_b, *w_gu, *b_gu, *w_dn, *b_dn, *final_g;
    float* out;
    unsigned* bar;
    float *xa, *modv, *f1, *f2, *hraw, *hsum, *rstd, *hx, *zb, *x0c, *mixin, *s5s, *ys5, *qr, *kr, *oret, *qs, *ks, *topg, *act;
    int* topi;
    px_t* px;
    bf16_t *hxb, *mixb, *ys5b, *xb, *actb, *abin_t, *cdin_t, *about_t, *cdout_t, *glu_t, *wgu_t, *wdn_t;
    bf16_t* yb;
    float *zT, *hT, *modp;
    float *slot_gate, *s5c, *rkv, *rsc, *hpart, *zf, *convT, *yd;
    int *cnt, *pos, *slot_of, *slot_tok;
};

struct RowInfo { int base, len, t, m, kind; };
DEV RowInfo row_info(int r) {
    RowInfo ri;
    if (r < NLAT) { const int b = r / SEQ; ri.base = b * SEQ; ri.len = SEQ; ri.t = r - ri.base; ri.m = b; ri.kind = 0; }
    else { const int rc = r - NLAT, b = rc / CTXL; ri.base = NLAT + b * CTXL; ri.len = CTXL; ri.t = rc - b * CTXL; ri.m = 2; ri.kind = 1; }
    return ri;
}
DEV float sigmoidf_(float x) { return frcp(1.0f + fexp(-x)); }
DEV float siluf_(float x) { return x * sigmoidf_(x); }
DEV float gelu_tanhf_(float x) { const float u = 0.7978845608028654f * (x + 0.044715f * x * x * x); return x * frcp(1.0f + fexp(-2.0f * u)); }

#ifdef CPU_SHIM
#define GSL(i, n) const long _n_##i = (long)(n); for (long i = _n_##i * gt / gs, _hi_##i = _n_##i * (gt + 1) / gs; i < _hi_##i; ++i)
#else
#define GSL(i, n) for (long i = gt; i < (long)(n); i += gs)
#endif

#if MFMA_DENSE
#define MIXST(idx, v) p.mixb[idx] = f2bf(v)
#else
#define MIXST(idx, v) p.mixin[idx] = (v)
#endif
DEV long filt_row0(int i, int kind) { return (long)i * (SEQ + CTXL) + (kind ? SEQ : 0); }

#ifdef CPU_SHIM
#define ROPE_COS(a) cosf(a)
#define ROPE_SIN(a) sinf(a)
#else
#define ROPE_COS(a) __builtin_amdgcn_cosf(__builtin_amdgcn_fractf((a) * 0.15915494309189535f))
#define ROPE_SIN(a) __builtin_amdgcn_sinf(__builtin_amdgcn_fractf((a) * 0.15915494309189535f))
#endif
DEV void ph_init(const P& p, long gt, long gs) {
    GSL(i, (long)NTOK * D) { p.xa[i] = i < (long)NLAT * D ? p.x[i] : p.ctx[i - (long)NLAT * D]; }
    GSL(j, 4 * NE) { p.cnt[j] = 0; }
    GSL(z, D) { p.hxb[(long)NTOK * D + z] = 0; }
}
DEV void ph_mod(const P& p, long gt, long gs) {
    GSL(i, 4L * 6 * D * 8) {
        const int j = (int)(i % (6 * D)), kq = (int)((i / (6 * D)) % 8), l = (int)(i / (6 * D * 8));
        const float* w = p.mod_w + (long)l * D * 6 * D + j;
        float a0 = 0.f, a1 = 0.f, a2 = 0.f;
        for (int k = kq * (D / 8); k < (kq + 1) * (D / 8); ++k) { const float wv = w[(long)k * 6 * D]; a0 += siluf_(p.c[k]) * wv; a1 += siluf_(p.c[D + k]) * wv; a2 += siluf_(p.c_ctx[k]) * wv; }
        float* o = p.modp + ((long)kq * 4 + l) * 3 * 6 * D + j;
        o[0] = a0; o[6 * D] = a1; o[12 * D] = a2;
    }
}
DEV void ph_mod2(const P& p, long gt, long gs) {
    GSL(i, 4L * 3 * 6 * D) {
        const int j = (int)(i % (6 * D)), l = (int)(i / (18 * D));
        float a = p.mod_b[l * 6 * D + j];
#pragma unroll
        for (int kq = 0; kq < 8; ++kq) a += p.modp[(long)kq * 4 * 3 * 6 * D + i];
        p.modv[i] = a;
    }
}
DEV void ph_filt1(const P& p, long gt, long gs) {
    GSL(idx, 2L * (SEQ + CTXL) * 64) {
        const int j = (int)(idx % 64); const long rr = idx / 64; const int i = (int)(rr / (SEQ + CTXL)); const int q = (int)(rr % (SEQ + CTXL));
        const int kind = q >= SEQ, pos = kind ? q - SEQ : q, L = kind ? CTXL : SEQ;
        const float* w1 = p.hy_f_w1 + i * 33 * 64;
        const float t = (float)pos / (float)L, w = 6.283185307179586f * (float)pos / (float)L;
        float acc = t * w1[j];
        for (int bi = 0; bi < 16; ++bi) {
            const float band = 1e-4f + (float)bi * ((15.0f - 1e-4f) / 15.0f);
            acc += ROPE_COS(band * w) * w1[(1 + bi) * 64 + j] - ROPE_SIN(band * w) * w1[(17 + bi) * 64 + j];
        }
        p.f1[idx] = ROPE_SIN(acc + p.hy_f_b1[i * 64 + j]);
    }
}
DEV void ph_filt2(const P& p, long gt, long gs) {
    GSL(idx, 2L * (SEQ + CTXL) * 64) {
        const int j = (int)(idx % 64); const long rr = idx / 64; const int i = (int)(rr / (SEQ + CTXL));
        const float* w2 = p.hy_f_w2 + i * 64 * 64; const float* h1 = p.f1 + rr * 64;
        float acc = 0.f;
        for (int k = 0; k < 64; ++k) acc += h1[k] * w2[k * 64 + j];
        p.f2[idx] = ROPE_SIN(acc + p.hy_f_b2[i * 64 + j]);
    }
}
DEV void ph_filt3(const P& p, long gt, long gs) {
    GSL(idx, 2L * (SEQ + CTXL) * HYW) {
        const int c = (int)(idx % HYW); const long rr = idx / HYW; const int i = (int)(rr / (SEQ + CTXL)); const int q = (int)(rr % (SEQ + CTXL));
        const int kind = q >= SEQ, pos = kind ? q - SEQ : q, L = kind ? CTXL : SEQ;
        const float* w3 = p.hy_f_w3 + (long)i * 64 * HYW; const float* h2 = p.f2 + rr * 64;
        float acc = 0.f;
        for (int k = 0; k < 64; ++k) acc += h2[k] * w3[k * HYW + c];
        const float lag = fabsf((float)(pos - L / 2)) / (float)(L / 2);
        const float fast = -15.350567286626973f, slow = -3.0701134573253946f;
        const float delta = fabsf(fast + (slow - fast) * (float)c / 511.0f);
        const float hv = acc * (expf(-lag * delta) + 0.05f);
        p.hraw[idx] = hv; if (!kind) p.hT[((long)i * HYW + c) * SEQ + pos] = hv;
    }
}
constexpr int FSEG = 64, FNSEG = (SEQ + CTXL) / FSEG;
DEV void ph_filt4a(const P& p, long gt, long gs) {
    GSL(idx, 2L * FNSEG * HYW) {
        const int c = (int)(idx % HYW); const long sg = idx / HYW; const float* h = p.hraw + sg * FSEG * HYW + c;
        float s = 0.f;
        for (int q = 0; q < FSEG; ++q) s += fabsf(h[(long)q * HYW]);
        p.hpart[idx] = s;
    }
}
DEV void ph_filt4(const P& p, long gt, long gs) {
    GSL(idx, 2 * 2 * HYW) {
        const int c = (int)(idx % HYW), kind = (int)((idx / HYW) % 2), i = (int)(idx / (2 * HYW));
        const int s0 = (int)(filt_row0(i, kind) / FSEG), ns = (kind ? CTXL : SEQ) / FSEG;
        float s = 0.f;
        for (int q = 0; q < ns; ++q) s += p.hpart[(long)(s0 + q) * HYW + c];
        p.hsum[idx] = s;
    }
}
DEV void ph_rstd(const P& p, int nrows, long gt, long gs) {
    GSL(r, nrows) {
        const float* xr = p.xa + r * D; float s = 0.f;
        for (int k = 0; k < D; ++k) s += xr[k] * xr[k];
        p.rstd[r] = rsqrtf(s * (1.0f / D) + EPS);
    }
}
DEV void ph_hx(const P& p, int layer, int which, int nrows, long gt, long gs) {
    const float* g = (which ? p.norm2_g : p.norm1_g) + layer * D;
    GSL(i, (long)nrows * D) {
        const int k = (int)(i % D), r = (int)(i / D); const RowInfo ri = row_info(r);
        const float* mv = p.modv + ((long)layer * 3 + ri.m) * 6 * D + which * 3 * D;
        const float v = p.xa[i] * p.rstd[r] * g[k] * (1.0f + mv[D + k]) + mv[k];
        p.hx[i] = v; p.hxb[i] = f2bf(v);
    }
}
DEV void ph_inproj(const P& p, const float* w, int nin, long gt, long gs) {
    GSL(i, (long)NTOK * nin) {
        const int n = (int)(i % nin), r = (int)(i / nin); const float* a = p.hx + (long)r * D; const float* b = w + n;
        float acc = 0.f;
        for (int k = 0; k < D; ++k) acc += a[k] * b[(long)k * nin];
        pxstore(&p.px[(long)r * PXLD + n], acc);
    }
}
DEV void ph_sconv(const P& p, int il, long gt, long gs) {
    const float* sw = p.hy_short_w + il * 3 * 1536; const float* sb = p.hy_short_b + il * 1536;
    GSL(i, (long)NTOK * HYW) {
        const int c = (int)(i % HYW), r = (int)(i / HYW); const RowInfo ri = row_info(r);
        float u[3];
#pragma unroll
        for (int s = 0; s < 3; ++s) {
            const int col = s * HYW + c; float acc = sb[col];
#pragma unroll
            for (int j = 0; j < 3; ++j) { const int tt = ri.t + j - 1; if (tt >= 0 && tt < ri.len) acc += sw[j * 1536 + col] * pxf(p.px[(long)(ri.base + tt) * PXLD + col]); }
            u[s] = acc;
        }
        p.x0c[i] = u[0]; p.zb[i] = u[2] * u[1]; if (r < NLAT) p.zT[(long)c * NLAT + r] = u[2] * u[1];
    }
}
DEV void ph_lconv(const P& p, int il, int r0, int r1, long gt, long gs) {
    GSL(i0, (long)(r1 - r0) * HYW) {
        const long i = i0 + (long)r0 * HYW;
        const int c = (int)(i % HYW), r = (int)(i / HYW); const RowInfo ri = row_info(r);
        const int L = ri.len, t = ri.t;
        const float* h = p.hraw + filt_row0(il, ri.kind) * HYW + c; const float* z = p.zb + (long)ri.base * HYW + c;
        int s0 = t + L / 2 - (L - 1); if (s0 < 0) s0 = 0; int s1 = t + L / 2; if (s1 > L - 1) s1 = L - 1;
        float acc = 0.f;
#pragma unroll 8
        for (int s = s0; s <= s1; ++s) acc += h[(long)(t - s + L / 2) * HYW] * z[(long)s * HYW];
        const float y = acc / p.hsum[(il * 2 + ri.kind) * HYW + c] + p.hy_bias[il * HYW + c] * p.zb[i];
        MIXST((long)r * D + c, p.x0c[i] * y);
    }
}
constexpr int FFTN = 2 * SEQ, FFT_NS = (SEQ == 8192 ? 7 : SEQ == 2048 ? 6 : SEQ == 512 ? 5 : SEQ == 128 ? 4 : -1);
static_assert(FFT_NS > 0 && (1 << (2 * FFT_NS)) == FFTN, "2*SEQ must be a power of 4");
struct CX { float x, y; };
#define PADX(n) ((n) + ((n) >> 5))
constexpr int FFT_ELEMS = FFTN + (FFTN >> 5);
#ifdef CPU_SHIM
#define COS2PI(f) cosf(6.283185307179586f * (f))
#define SIN2PI(f) sinf(6.283185307179586f * (f))
#define FFT_SYNC()
#else
#define COS2PI(f) __builtin_amdgcn_cosf(f)
#define SIN2PI(f) __builtin_amdgcn_sinf(f)
#define FFT_SYNC() __syncthreads()
#endif
template <class XP> DEV CX cx_ld(XP x, int i) { CX r; r.x = x[i].x; r.y = x[i].y; return r; }
template <class XP> DEV void cx_st(XP x, int i, CX v) { x[i].x = v.x; x[i].y = v.y; }
DEV CX cx_add(CX a, CX b) { return CX{a.x + b.x, a.y + b.y}; }
DEV CX cx_sub(CX a, CX b) { return CX{a.x - b.x, a.y - b.y}; }
DEV CX cx_mul(CX a, CX b) { return CX{a.x * b.x - a.y * b.y, a.x * b.y + a.y * b.x}; }
template <class XP> DEV void fft_pass(XP x, int s, bool inv, int tid, int nthr) {
    const int lq = 2 * (FFT_NS - 1 - s), Q = 1 << lq;
    const float invB = 1.0f / (float)(4 * Q);
    for (int t = tid; t < FFTN / 4; t += nthr) {
        const int i = t & (Q - 1), base = ((t >> lq) << (lq + 2)) + i;
        const float f = (float)i * invB, cs = COS2PI(f), sn = SIN2PI(f);
        const CX w1 = CX{cs, inv ? sn : -sn}, w2 = cx_mul(w1, w1), w3 = cx_mul(w2, w1);
        const int i0 = PADX(base), i1 = PADX(base + Q), i2 = PADX(base + 2 * Q), i3 = PADX(base + 3 * Q);
        const CX a = cx_ld(x, i0), b = cx_ld(x, i1), c = cx_ld(x, i2), d = cx_ld(x, i3);
        if (!inv) {
            const CX t0 = cx_add(a, c), t1 = cx_sub(a, c), t2 = cx_add(b, d), bd = cx_sub(b, d), t3 = CX{bd.y, -bd.x};
            cx_st(x, i0, cx_add(t0, t2)); cx_st(x, i1, cx_mul(cx_add(t1, t3), w1)); cx_st(x, i2, cx_mul(cx_sub(t0, t2), w2)); cx_st(x, i3, cx_mul(cx_sub(t1, t3), w3));
        } else {
            const CX y0 = a, y1 = cx_mul(b, w1), y2 = cx_mul(c, w2), y3 = cx_mul(d, w3);
            const CX u0 = cx_add(y0, y2), u1 = cx_sub(y0, y2), u2 = cx_add(y1, y3), yd = cx_sub(y1, y3), u3 = CX{-yd.y, yd.x};
            cx_st(x, i0, cx_add(u0, u2)); cx_st(x, i1, cx_add(u1, u3)); cx_st(x, i2, cx_sub(u0, u2)); cx_st(x, i3, cx_sub(u1, u3));
        }
    }
}
DEV void bfly4(CX& a, CX& b, CX& c, CX& d, CX w1, bool inv, bool tw) {
    const CX w2 = cx_mul(w1, w1), w3 = cx_mul(w2, w1);
    if (!inv) {
        const CX t0 = cx_add(a, c), t1 = cx_sub(a, c), t2 = cx_add(b, d), bd = cx_sub(b, d), t3 = CX{bd.y, -bd.x};
        a = cx_add(t0, t2); b = cx_add(t1, t3); c = cx_sub(t0, t2); d = cx_sub(t1, t3);
        if (tw) { b = cx_mul(b, w1); c = cx_mul(c, w2); d = cx_mul(d, w3); }
    } else {
        CX y1 = b, y2 = c, y3 = d;
        if (tw) { y1 = cx_mul(b, w1); y2 = cx_mul(c, w2); y3 = cx_mul(d, w3); }
        const CX u0 = cx_add(a, y2), u1 = cx_sub(a, y2), u2 = cx_add(y1, y3), yd = cx_sub(y1, y3), u3 = CX{-yd.y, yd.x};
        a = cx_add(u0, u2); b = cx_add(u1, u3); c = cx_sub(u0, u2); d = cx_sub(u1, u3);
    }
}
template <class XP> DEV void fft_pass16(XP x, int s, bool inv, int tid, int nthr) {
    const int lq2 = 2 * (FFT_NS - 2 - s), Q2 = 1 << lq2, Q = 4 * Q2;
    const float invB = 1.0f / (float)(16 * Q2);
    const float sg = inv ? 1.0f : -1.0f;
    const CX c1 = CX{0.9238795325112867f, sg * 0.3826834323650898f}, c2 = CX{0.7071067811865476f, sg * 0.7071067811865476f}, c3 = CX{0.3826834323650898f, sg * 0.9238795325112867f};
    for (int t = tid; t < FFTN / 16; t += nthr) {
        const int i = t & (Q2 - 1), base = ((t >> lq2) << (lq2 + 4)) + i;
        const float f = (float)i * invB, cs = COS2PI(f), sn = SIN2PI(f);
        const CX wA = CX{cs, sg * sn};
        CX wB = cx_mul(wA, wA); wB = cx_mul(wB, wB);
        CX v[4][4];
#pragma unroll
        for (int a = 0; a < 4; ++a)
#pragma unroll
            for (int b = 0; b < 4; ++b) v[a][b] = cx_ld(x, PADX(base + a * Q + b * Q2));
        if (!inv) {
            bfly4(v[0][0], v[1][0], v[2][0], v[3][0], wA, false, true);
            bfly4(v[0][1], v[1][1], v[2][1], v[3][1], cx_mul(wA, c1), false, true);
            bfly4(v[0][2], v[1][2], v[2][2], v[3][2], cx_mul(wA, c2), false, true);
            bfly4(v[0][3], v[1][3], v[2][3], v[3][3], cx_mul(wA, c3), false, true);
#pragma unroll
            for (int r = 0; r < 4; ++r) bfly4(v[r][0], v[r][1], v[r][2], v[r][3], wB, false, true);
        } else {
#pragma unroll
            for (int r = 0; r < 4; ++r) bfly4(v[r][0], v[r][1], v[r][2], v[r][3], wB, true, true);
            bfly4(v[0][0], v[1][0], v[2][0], v[3][0], wA, true, true);
            bfly4(v[0][1], v[1][1], v[2][1], v[3][1], cx_mul(wA, c1), true, true);
            bfly4(v[0][2], v[1][2], v[2][2], v[3][2], cx_mul(wA, c2), true, true);
            bfly4(v[0][3], v[1][3], v[2][3], v[3][3], cx_mul(wA, c3), true, true);
        }
#pragma unroll
        for (int a = 0; a < 4; ++a)
#pragma unroll
            for (int b = 0; b < 4; ++b) cx_st(x, PADX(base + a * Q + b * Q2), v[a][b]);
    }
}
template <class XP> DEV void fft_pass_last(XP x, bool inv, int tid, int nthr) {
    for (int t = tid; t < FFTN / 4; t += nthr) {
        const int base = 4 * t; CX a = cx_ld(x, PADX(base)), b = cx_ld(x, PADX(base + 1)), c = cx_ld(x, PADX(base + 2)), d = cx_ld(x, PADX(base + 3));
        bfly4(a, b, c, d, CX{1.f, 0.f}, inv, false);
        cx_st(x, PADX(base), a); cx_st(x, PADX(base + 1), b); cx_st(x, PADX(base + 2), c); cx_st(x, PADX(base + 3), d);
    }
}
static_assert(FFT_NS % 2 == 1, "pass schedule: (FFT_NS - 1) / 2 radix-16 passes + one radix-4 pass");
template <class XP> DEV void fft_forward(XP x, int tid, int nthr) {
    for (int s = 0; s + 1 < FFT_NS; s += 2) { fft_pass16(x, s, false, tid, nthr); FFT_SYNC(); }
    fft_pass_last(x, false, tid, nthr); FFT_SYNC();
}
template <class XP> DEV void fft_inverse(XP x, int tid, int nthr) {
    fft_pass_last(x, true, tid, nthr); FFT_SYNC();
    for (int s = FFT_NS - 3; s >= 0; s -= 2) { fft_pass16(x, s, true, tid, nthr); FFT_SYNC(); }
}
template <class XP> DEV void lconv_unit(const P& p, int il, int c, XP x, float* zf, int tid, int nthr) {
    constexpr int L = SEQ, N = FFTN;
    const float* zc = p.zT + (long)c * NLAT;
#pragma unroll 8
    for (int n = tid; n < L; n += nthr) { CX v; v.x = zc[n]; v.y = zc[SEQ + n]; cx_st(x, PADX(n), v); }
#pragma unroll 8
    for (int n = L + tid; n < N; n += nthr) cx_st(x, PADX(n), CX{0.f, 0.f});
    FFT_SYNC();
    fft_forward(x, tid, nthr);
    const float* h = p.hT + ((long)il * HYW + c) * SEQ;
#pragma unroll 8
    for (int n = tid; n < L; n += nthr) { const float hv = h[n]; const CX v = cx_ld(x, PADX(n)); zf[2 * n] = v.x; zf[2 * n + 1] = v.y; cx_st(x, PADX(n), CX{hv, 0.f}); }
#pragma unroll 8
    for (int n = L + tid; n < N; n += nthr) { const CX v = cx_ld(x, PADX(n)); zf[2 * n] = v.x; zf[2 * n + 1] = v.y; cx_st(x, PADX(n), CX{0.f, 0.f}); }
    FFT_SYNC();
    fft_forward(x, tid, nthr);
#ifndef CPU_SHIM
    asm volatile("s_waitcnt vmcnt(0)" ::: "memory");
#endif
#pragma unroll 8
    for (int n = tid; n < N; n += nthr) { const CX zv{zf[2 * n], zf[2 * n + 1]}; const CX hv = cx_ld(x, PADX(n)); cx_st(x, PADX(n), cx_mul(hv, zv)); }
    FFT_SYNC();
    fft_inverse(x, tid, nthr);
    const float scale = 1.0f / ((float)N * p.hsum[(il * 2 + 0) * HYW + c]);
    float* o = p.convT + (long)c * NLAT;
#pragma unroll 8
    for (int t = tid; t < L; t += nthr) { const CX v = cx_ld(x, PADX(t + L / 2)); o[t] = v.x * scale; o[L + t] = v.y * scale; }
    FFT_SYNC();
}
#ifdef CPU_SHIM
DEV void ph_lconv_fft(const P& p, int il, long gt, long gs) {
    CX* x = (CX*)malloc(sizeof(CX) * FFT_ELEMS);
    GSL(c, HYW) { lconv_unit(p, il, (int)c, x, p.zf + gt * 2 * FFTN, 0, 1); }
    free(x);
}
#endif
DEV void ph_hymix(const P& p, int il, long gt, long gs) {
    GSL(i, (long)NLAT * HYW) {
        const int c = (int)(i % HYW), r = (int)(i / HYW);
        const float y = p.convT[(long)c * NLAT + r] + p.hy_bias[il * HYW + c] * p.zb[i];
        MIXST((long)r * D + c, p.x0c[i] * y);
    }
}
DEV int scan_row(int dir, int b, int n) {
    if (n < CTXL) return NLAT + b * CTXL + (dir ? CTXL - 1 - n : n);
    const int m = n - CTXL; return b * SEQ + (dir ? SEQ - 1 - m : m);
}
constexpr int S5C = 64, S5NCH = (CTXL + SEQ) / S5C;
struct S5Par { float lbr, lbi; float bbr[GH], bbi[GH]; };
DEV void s5_par(const P& p, int il, int dir, int g, int pp, S5Par& q) {
    const int gi = (il * 2 + dir) * NG + g;
    const float lre = fminf(p.s5_lre[gi * NP + pp], -1e-4f), lim = p.s5_lim[gi * NP + pp], dt = expf(p.s5_ldt[gi]);
    const float mag = expf(lre * dt); q.lbr = mag * cosf(lim * dt); q.lbi = mag * sinf(lim * dt);
    const float nr = q.lbr - 1.0f, ni = q.lbi, den = lre * lre + lim * lim;
    const float fr = (nr * lre + ni * lim) / den, fi = (ni * lre - nr * lim) / den;
#pragma unroll
    for (int h = 0; h < GH; ++h) { const float br = p.s5_bre[((long)gi * NP + pp) * GH + h], bi = p.s5_bim[((long)gi * NP + pp) * GH + h]; q.bbr[h] = fr * br - fi * bi; q.bbi[h] = fr * bi + fi * br; }
}
DEV void ph_s5chunk(const P& p, int il, int fill, long gt, long gs) {
    GSL(i, 2L * 2 * S5NCH * NG * NP) {
        const int pp = (int)(i % NP), g = (int)((i / NP) % NG), ch = (int)((i / (NP * NG)) % S5NCH), b = (int)((i / ((long)NP * NG * S5NCH)) % 2), dir = (int)(i / ((long)NP * NG * S5NCH * 2));
        S5Par q; s5_par(p, il, dir, g, pp, q);
        float* ce = p.s5c + ((((long)dir * 2 + b) * S5NCH + ch) * NG + g) * NP * 2 + pp * 2;
        float sr = 0.f, si = 0.f;
        if (fill) { sr = ce[0]; si = ce[1]; }
        for (int k = 0; k < S5C; ++k) {
            const int row = scan_row(dir, b, ch * S5C + k); const px_t* u = p.px + (long)row * PXLD + 1536 + g * GH;
            float ar = 0.f, ai = 0.f;
#pragma unroll
            for (int h = 0; h < GH; ++h) { ar += q.bbr[h] * pxf(u[h]); ai += q.bbi[h] * pxf(u[h]); }
            const float tr = q.lbr * sr - q.lbi * si + ar, ti = q.lbr * si + q.lbi * sr + ai; sr = tr; si = ti;
            if (fill) { float* o = p.s5s + (((long)dir * NTOK + row) * NG + g) * NP * 2 + pp * 2; o[0] = sr; o[1] = si; }
        }
        if (!fill) { ce[0] = sr; ce[1] = si; }
    }
}
DEV void ph_s5carry(const P& p, int il, long gt, long gs) {
    GSL(i, 2 * 2 * NG * NP) {
        const int pp = (int)(i % NP), g = (int)((i / NP) % NG), b = (int)((i / (NP * NG)) % 2), dir = (int)(i / (NP * NG * 2));
        S5Par q; s5_par(p, il, dir, g, pp, q);
        float pr = q.lbr, pi = q.lbi;
#pragma unroll
        for (int t = 0; t < 6; ++t) { const float nr = pr * pr - pi * pi, ni = 2.0f * pr * pi; pr = nr; pi = ni; }
        float cr = 0.f, ci = 0.f;
        float* ce0 = p.s5c + ((((long)dir * 2 + b) * S5NCH) * NG + g) * NP * 2 + pp * 2;
        constexpr int CB = 12;
        for (int c0 = 0; c0 < S5NCH; c0 += CB) {
            float er[CB], ei[CB];
#pragma unroll
            for (int j = 0; j < CB; ++j) if (c0 + j < S5NCH) { const float* ce = ce0 + (long)(c0 + j) * NG * NP * 2; er[j] = ce[0]; ei[j] = ce[1]; }
#pragma unroll
            for (int j = 0; j < CB; ++j) if (c0 + j < S5NCH) { float* ce = ce0 + (long)(c0 + j) * NG * NP * 2; ce[0] = cr; ce[1] = ci;
                const float tr = pr * cr - pi * ci + er[j], ti = pr * ci + pi * cr + ei[j]; cr = tr; ci = ti; }
        }
    }
}
DEV void ph_s5out(const P& p, int il, long gt, long gs) {
    GSL(i, (long)NTOK * S5W) {
        const int ch = (int)(i % S5W), r = (int)(i / S5W), g = ch / GH, h = ch % GH;
        float y = p.s5_d[il * S5W + ch] * pxf(p.px[(long)r * PXLD + 1536 + ch]);
        for (int dir = 0; dir < 2; ++dir) {
            const long ci = (((long)(il * 2 + dir) * NG + g) * GH + h) * NP;
            const float* s = p.s5s + (((long)dir * NTOK + r) * NG + g) * NP * 2;
            for (int pp = 0; pp < NP; ++pp) y += p.s5_cre[ci + pp] * s[pp * 2] - p.s5_cim[ci + pp] * s[pp * 2 + 1];
        }
        { const float gy = gelu_tanhf_(y); p.ys5[i] = gy; p.ys5b[i] = f2bf(gy); }
    }
}
DEV void ph_s5fin(const P& p, int il, long gt, long gs) {
    GSL(i, (long)NTOK * S5W) {
        const int ch = (int)(i % S5W), r = (int)(i / S5W);
        const float y = p.s5_d[il * S5W + ch] * pxf(p.px[(long)r * PXLD + 1536 + ch]) + p.yd[i] + p.yd[(long)NTOK * S5W + i];
        const float gy = gelu_tanhf_(y); p.ys5b[i] = f2bf(gy);
#ifdef CPU_SHIM
        p.ys5[i] = gy;
#endif
    }
}
DEV void ph_glu(const P& p, int il, long gt, long gs) {
    const float* w = p.s5_glu_w + (long)il * S5W * S5W;
    GSL(i, (long)NTOK * S5W) {
        const int ch = (int)(i % S5W), r = (int)(i / S5W); const float* a = p.ys5 + (long)r * S5W;
        float acc = p.s5_glu_b[il * S5W + ch];
        for (int k = 0; k < S5W; ++k) acc += a[k] * w[(long)k * S5W + ch];
        MIXST((long)r * D + HYW + ch, a[ch] * sigmoidf_(acc));
    }
}
DEV void ph_rope(const P& p, long gt, long gs) {
    GSL(i, (long)NTOK * 576) {
        const int it = (int)(i % 576), r = (int)(i / 576); const RowInfo ri = row_info(r); const px_t* pr = p.px + (long)r * PXLD;
        if (it < 256) {
            const int isk = it >= 128, hd = it & 127, h = hd >> 5, d = hd & 31;
            const px_t* src = pr + (isk ? 256 : 0) + h * 64; float x1 = pxf(src[d]), x2 = pxf(src[d + 32]);
            if (ri.kind == 0) { const float inv = exp2f(-(float)d * (13.287712379549449f / 32.0f)), ang = (float)ri.t * inv, cs = ROPE_COS(ang), sn = ROPE_SIN(ang);
                const float y1 = x1 * cs - x2 * sn, y2 = x1 * sn + x2 * cs; x1 = y1; x2 = y2; }
            const float sc = isk ? 1.0f : 0.125f;
            float* dst = (isk ? p.kr : p.qr) + (long)r * 256 + h * 64; dst[d] = x1 * sc; dst[d + 32] = x2 * sc;
        } else {
            const int j = it - 256, isk = j >= 256, hd = isk ? j - 256 : j, h = hd >> 5, e = hd & 31, half = e >> 4, d = e & 15;
            const px_t* src = pr + (isk ? 2048 : 1536) + h * 64 + half * 32; float x1 = pxf(src[d]), x2 = pxf(src[d + 16]);
            if (ri.kind == 0) { const float pos = (float)(half ? (ri.t % 64) : (ri.t / 64)); const float inv = exp2f(-(float)d * (13.287712379549449f / 16.0f)), ang = pos * inv, cs = ROPE_COS(ang), sn = ROPE_SIN(ang);
                const float y1 = x1 * cs - x2 * sn, y2 = x1 * sn + x2 * cs; x1 = y1; x2 = y2; }
            const float sc = isk ? 1.0f : 0.125f;
            float* dst = (isk ? p.ks + (long)r * 128 : p.qs + (long)r * 512) + h * 64 + half * 32; dst[d] = x1 * sc; dst[d + 16] = x2 * sc;
        }
    }
}
constexpr int RC = 128, RNCH = (CTXL + SEQ) / RC;
DEV float ret_logg(const P& p, int il, int dir, int h) { const float dl = p.ret_decay[(il * 2 + dir) * 4 + h]; return -log1pf(expf(-dl)); }
DEV void ph_retkv(const P& p, int il, long gt, long gs) {
    GSL(i, 2L * 2 * RNCH * 4 * 64 * 128) {
        const int e = (int)(i % 128), d = (int)((i / 128) % 64), h = (int)((i / 8192) % 4), n = (int)((i / 32768) % RNCH), b = (int)((i / (32768L * RNCH)) % 2), dir = (int)(i / (32768L * RNCH * 2));
        const float lg = ret_logg(p, il, dir, h);
        float acc = 0.f;
        for (int j = 0; j < RC; ++j) { const int row = scan_row(dir, b, n * RC + j);
            acc += expf((float)(RC - 1 - j) * lg) * p.kr[(long)row * 256 + h * 64 + d] * pxf(p.px[(long)row * PXLD + 512 + h * 128 + e]); }
        p.rkv[i] = acc;
    }
}
DEV void ph_retcarry(const P& p, int il, long gt, long gs) {
    GSL(i, 2L * 2 * 4 * 64 * 128) {
        const int de = (int)(i % 8192), h = (int)((i / 8192) % 4), b = (int)((i / 32768) % 2), dir = (int)(i / 65536);
        const float gc = expf((float)RC * ret_logg(p, il, dir, h));
        float S = 0.f;
        float* q0 = p.rkv + ((((long)dir * 2 + b) * RNCH) * 4 + h) * 8192 + de;
        constexpr int CB = 11;
        for (int n0 = 0; n0 < RNCH; n0 += CB) {
            float kv[CB];
#pragma unroll
            for (int j = 0; j < CB; ++j) if (n0 + j < RNCH) kv[j] = q0[(long)(n0 + j) * 4 * 8192];
#pragma unroll
            for (int j = 0; j < CB; ++j) if (n0 + j < RNCH) { q0[(long)(n0 + j) * 4 * 8192] = S; S = gc * S + kv[j]; }
        }
    }
}
DEV void ph_retsc(const P& p, int il, long gt, long gs) {
    GSL(i, 2L * NTOK * 4 * RC) {
        const int j = (int)(i % RC), h = (int)((i / RC) % 4), r = (int)((i / (RC * 4)) % NTOK), dir = (int)(i / ((long)RC * 4 * NTOK)); const RowInfo ri = row_info(r);
        const int b = ri.kind ? (ri.base - NLAT) / CTXL : ri.base / SEQ;
        const int step = ri.kind ? (dir ? CTXL - 1 - ri.t : ri.t) : CTXL + (dir ? SEQ - 1 - ri.t : ri.t), ii = step % RC, n = step / RC;
        float sc = 0.f;
        if (j <= ii) { const int rj = scan_row(dir, b, n * RC + j); const float* q = p.qr + (long)r * 256 + h * 64; const float* k = p.kr + (long)rj * 256 + h * 64;
            float dot = 0.f;
            for (int d = 0; d < 64; ++d) dot += q[d] * k[d];
            sc = dot * expf((float)(ii - j) * ret_logg(p, il, dir, h)); }
        p.rsc[i] = sc;
    }
}
DEV void ph_reto(const P& p, int il, long gt, long gs) {
    GSL(i, 2L * NTOK * 512) {
        const int e = (int)(i % 128), h = (int)((i / 128) % 4), r = (int)((i / 512) % NTOK), dir = (int)(i / (512L * NTOK)); const RowInfo ri = row_info(r);
        const int b = ri.kind ? (ri.base - NLAT) / CTXL : ri.base / SEQ;
        const int step = ri.kind ? (dir ? CTXL - 1 - ri.t : ri.t) : CTXL + (dir ? SEQ - 1 - ri.t : ri.t), ii = step % RC, n = step / RC;
        const float* sc = p.rsc + (((long)dir * NTOK + r) * 4 + h) * RC;
        float acc = 0.f;
        for (int j = 0; j <= ii; ++j) { const int rj = scan_row(dir, b, n * RC + j); acc += sc[j] * pxf(p.px[(long)rj * PXLD + 512 + h * 128 + e]); }
        const float* S = p.rkv + ((((long)dir * 2 + b) * RNCH + n) * 4 + h) * 8192 + e; const float* q = p.qr + (long)r * 256 + h * 64;
        float cr = 0.f;
        for (int d = 0; d < 64; ++d) cr += q[d] * S[d * 128];
        p.oret[((long)dir * NTOK + r) * 512 + h * 128 + e] = acc + cr * expf((float)(ii + 1) * ret_logg(p, il, dir, h));
    }
}
DEV void ph_retout(const P& p, int nrows, long gt, long gs) {
    GSL(i, (long)nrows * 4) {
        const int h = (int)(i % 4), r = (int)(i / 4);
        const float* o0 = p.oret + (long)r * 512 + h * 128; const float* o1 = p.oret + ((long)NTOK + r) * 512 + h * 128;
        float ss = 0.f;
        for (int e = 0; e < 128; ++e) { const float o = o0[e] + o1[e]; ss += o * o; }
        const float rs = rsqrtf(ss * (1.0f / 128.0f) + EPS);
        for (int e = 0; e < 128; ++e) MIXST((long)r * D + h * 128 + e, (o0[e] + o1[e]) * rs * siluf_(pxf(p.px[(long)r * PXLD + 1024 + h * 128 + e])));
    }
}
DEV void ph_swa(const P& p, int il, int nrows, long gt, long gs) {
    GSL(i, (long)nrows * 8) {
        const int hq = (int)(i % 8), r = (int)(i / 8), kv = hq >> 2; const RowInfo ri = row_info(r);
        const int b = ri.kind ? (ri.base - NLAT) / CTXL : ri.base / SEQ;
        float q[64], acc[64];
#pragma unroll
        for (int d = 0; d < 64; ++d) { q[d] = p.qs[(long)r * 512 + hq * 64 + d]; acc[d] = 0.f; }
        float m = p.swa_sink[il * 8 + hq], l = 1.0f;
        for (int part = 0; part < 2; ++part) {
            int k0, k1;
            if (part == 0) { if (ri.kind) continue; k0 = ri.base + (ri.t - 128 < 0 ? 0 : ri.t - 128); k1 = ri.base + (ri.t + 128 > SEQ - 1 ? SEQ - 1 : ri.t + 128); }
            else { k0 = NLAT + b * CTXL; k1 = k0 + CTXL - 1; }
            for (int kr = k0; kr <= k1; ++kr) {
                const float* kk = p.ks + (long)kr * 128 + kv * 64; const px_t* vv = p.px + (long)kr * PXLD + 2176 + kv * 64;
                float s = 0.f;
#pragma unroll
                for (int d = 0; d < 64; ++d) s += q[d] * kk[d];
                const float mn = fmaxf(m, s), corr = expf(m - mn), pe = expf(s - mn);
                l = l * corr + pe; m = mn;
#pragma unroll
                for (int d = 0; d < 64; ++d) acc[d] = acc[d] * corr + pe * pxf(vv[d]);
            }
        }
        const float il_ = 1.0f / l;
#pragma unroll
        for (int d = 0; d < 64; ++d) MIXST((long)r * D + 512 + hq * 64 + d, acc[d] * il_);
    }
}
DEV void ph_outproj(const P& p, int layer, const float* w, int nrows, long gt, long gs) {
    GSL(i, (long)nrows * D) {
        const int n = (int)(i % D), r = (int)(i / D); const RowInfo ri = row_info(r);
        const float* a = p.mixin + (long)r * D; const float* b = w + n;
        float acc = 0.f;
        for (int k = 0; k < D; ++k) acc += a[k] * b[(long)k * D];
        p.xa[i] += p.modv[((long)layer * 3 + ri.m) * 6 * D + 2 * D + n] * acc;
    }
}
DEV int atomic_inc(int* q) {
#ifdef CPU_SHIM
    return __atomic_fetch_add(q, 1, __ATOMIC_RELAXED);
#else
    return atomicAdd(q, 1);
#endif
}
DEV void ph_router(const P& p, int layer, int nrows, long gt, long gs) {
    const float* rw = p.router_w + (long)layer * D * NE;
    GSL(j, NSLOT) { p.slot_tok[j] = -1; p.slot_gate[j] = 0.f; }
    GSL(r, nrows) {
        float lg[NE];
#pragma unroll
        for (int e = 0; e < NE; ++e) lg[e] = p.router_b[layer * NE + e];
        const float* a = p.hx + (long)r * D;
        for (int k = 0; k < D; ++k) { const float av = a[k];
#pragma unroll
            for (int e = 0; e < NE; ++e) lg[e] += av * rw[k * NE + e]; }
        int ti[4]; float tv[4];
#pragma unroll
        for (int s = 0; s < 4; ++s) { int best = 0; float bv = -3.0e38f;
#pragma unroll
            for (int e = 0; e < NE; ++e) { if (lg[e] > bv) { bv = lg[e]; best = e; } }
            ti[s] = best; tv[s] = bv;
#pragma unroll
            for (int e = 0; e < NE; ++e) if (e == best) lg[e] = -3.0e38f; }
        const float e1 = expf(tv[1] - tv[0]), e2 = expf(tv[2] - tv[0]), e3 = expf(tv[3] - tv[0]), inv = 1.0f / (1.0f + e1 + e2 + e3);
        p.topi[r * 4 + 0] = ti[0]; p.topi[r * 4 + 1] = ti[1]; p.topi[r * 4 + 2] = ti[2]; p.topi[r * 4 + 3] = ti[3];
        p.topg[r * 4 + 0] = inv; p.topg[r * 4 + 1] = e1 * inv; p.topg[r * 4 + 2] = e2 * inv; p.topg[r * 4 + 3] = e3 * inv;
#pragma unroll
        for (int s = 0; s < 4; ++s) p.pos[r * 4 + s] = atomic_inc(p.cnt + layer * NE + ti[s]);
    }
}
DEV int moe_tiles(const int* cnt) { int t = 0; for (int e = 0; e < NE; ++e) t += (cnt[e] + 255) >> 8; return t; }
DEV int tile_expert(const int* cnt, int pm) { int t = 0; for (int e = 0; e < NE; ++e) { t += (cnt[e] + 255) >> 8; if (pm < t) return e; } return NE - 1; }
DEV void ph_assign(const P& p, int layer, int nrows, long gt, long gs) {
    const int* cnt = p.cnt + layer * NE;
    GSL(i, (long)nrows * 4) {
        const int e = p.topi[i]; int off = 0;
        for (int q = 0; q < e; ++q) off += ((cnt[q] + 255) >> 8) << 8;
        const int slot = off + p.pos[i];
        p.slot_of[i] = slot; p.slot_tok[slot] = (int)(i >> 2); p.slot_gate[slot] = p.topg[i];
    }
}
DEV void ph_gather(const P& p, int layer, long gt, long gs) {
    const long used = (long)moe_tiles(p.cnt + layer * NE) * 256;
    GSL(i, used * D) { const int k = (int)(i % D); const long slot = i / D; const int tok = p.slot_tok[slot]; p.xb[i] = tok >= 0 ? p.hxb[(long)tok * D + k] : (bf16_t)0; }
}
DEV void ph_moe1s(const P& p, int layer, long gt, long gs) {
    const int* cnt = p.cnt + layer * NE; const long used = (long)moe_tiles(cnt) * 256;
    GSL(i, used * DFF) {
        const int j = (int)(i % DFF); const long slot = i / DFF; const int e = tile_expert(cnt, (int)(slot >> 8));
        const float* w = p.w_gu + ((long)layer * NE + e) * D * 2 * DFF + j; const bf16_t* a = p.xb + slot * D;
        const float* bb = p.b_gu + ((long)layer * NE + e) * 2 * DFF;
        float ga = bb[j], up = bb[DFF + j];
        for (int k = 0; k < D; ++k) { const float av = bf2f(a[k]); ga += av * w[(long)k * 2 * DFF]; up += av * w[(long)k * 2 * DFF + DFF]; }
        ga = fminf(ga, 7.0f); up = fminf(fmaxf(up, -7.0f), 7.0f);
        p.actb[i] = f2bf(ga * sigmoidf_(1.702f * ga) * (up + 1.0f));
    }
}
DEV void ph_moe2s(const P& p, int layer, long gt, long gs) {
    const int* cnt = p.cnt + layer * NE; const long used = (long)moe_tiles(cnt) * 256;
    GSL(i, used * D) {
        const int n = (int)(i % D); const long slot = i / D; const int e = tile_expert(cnt, (int)(slot >> 8));
        const float* w = p.w_dn + ((long)layer * NE + e) * DFF * D + n; const bf16_t* a = p.actb + slot * DFF;
        float acc = p.b_dn[((long)layer * NE + e) * D + n];
        for (int k = 0; k < DFF; ++k) acc += bf2f(a[k]) * w[(long)k * D];
        p.yb[i] = f2bf(acc * p.slot_gate[slot]);
    }
}
DEV void ph_combine(const P& p, int layer, int nrows, long gt, long gs) {
    GSL(i, (long)nrows * D) {
        const int n = (int)(i % D), r = (int)(i / D); const RowInfo ri = row_info(r);
        float y = 0.f;
#pragma unroll
        for (int s = 0; s < 4; ++s) y += bf2f(p.yb[(long)p.slot_of[r * 4 + s] * D + n]);
        p.xa[i] += p.modv[((long)layer * 3 + ri.m) * 6 * D + 5 * D + n] * y;
    }
}
DEV void ph_final(const P& p, long gt, long gs) {
    GSL(i, (long)NLAT * D) { const int k = (int)(i % D), r = (int)(i / D); p.out[i] = p.xa[i] * p.rstd[r] * p.final_g[k]; }
}

constexpr int N_SETUP = 6, N_SLOT = 18;
#ifdef CPU_SHIM
#define SWA_NAIVE ph_swa(p, il, nrows, gt, gs);
#define S5_NAIVE(x) x
#define S5_FIN ph_s5out(p, il, gt, gs);
#define RET_NAIVE_A ph_retkv(p, il, gt, gs); ph_retsc(p, il, gt, gs);
#define RET_NAIVE_C ph_reto(p, il, gt, gs);
#else
#define SWA_NAIVE
#define S5_NAIVE(x)
#define S5_FIN ph_s5fin(p, il, gt, gs);
#define RET_NAIVE_A
#define RET_NAIVE_C
#endif
#ifdef CPU_SHIM
#define LCONV_LAT(p, il, gt, gs) ph_lconv_fft(p, il, gt, gs)
#else
#define LCONV_LAT(p, il, gt, gs)
#endif
template <int S> DEV void setup_slot(const P& p, long gt, long gs) {
    if constexpr (S == 0) { ph_init(p, gt, gs); ph_mod(p, gt, gs); }
    if constexpr (S == 1) { ph_mod2(p, gt, gs); ph_filt1(p, gt, gs); }
    if constexpr (S == 2) ph_filt2(p, gt, gs);
    if constexpr (S == 3) ph_filt3(p, gt, gs);
    if constexpr (S == 4) ph_filt4a(p, gt, gs);
    if constexpr (S == 5) ph_filt4(p, gt, gs);
}
template <int S> DEV void layer_slot(const P& p, int layer, long gt, long gs) {
    const int il = layer >> 1; const bool ab = !(layer & 1);
    const int nrows = layer < 3 ? NTOK : NLAT;
    if constexpr (S == 0) ph_rstd(p, NTOK, gt, gs);
    if constexpr (S == 1) ph_hx(p, layer, 0, NTOK, gt, gs);
    if constexpr (S == 2) { if (ab) ph_inproj(p, p.ab_w_in + (long)il * D * AB_IN, AB_IN, gt, gs); else ph_inproj(p, p.cd_w_in + (long)il * D * CD_IN, CD_IN, gt, gs); }
    if constexpr (S == 3) { if (ab) { ph_sconv(p, il, gt, gs); S5_NAIVE(ph_s5chunk(p, il, 0, gt, gs);) } else ph_rope(p, gt, gs); }
    if constexpr (S == 4) { if (ab) { LCONV_LAT(p, il, gt, gs); ph_lconv(p, il, NLAT, NTOK, gt, gs); ph_s5carry(p, il, gt, gs); } else { RET_NAIVE_A } }
    if constexpr (S == 5) { if (ab) { ph_hymix(p, il, gt, gs); S5_NAIVE(ph_s5chunk(p, il, 1, gt, gs);) } else { ph_retcarry(p, il, gt, gs); SWA_NAIVE } }
    if constexpr (S == 6) { if (ab) { S5_FIN } else { RET_NAIVE_C } }
    if constexpr (S == 7) { if (ab) ph_glu(p, il, gt, gs); else ph_retout(p, nrows, gt, gs); }
    if constexpr (S == 8) ph_outproj(p, layer, (ab ? p.ab_w_out : p.cd_w_out) + (long)il * D * D, nrows, gt, gs);
    if constexpr (S == 9) ph_rstd(p, nrows, gt, gs);
    if constexpr (S == 10) ph_hx(p, layer, 1, nrows, gt, gs);
    if constexpr (S == 11) ph_router(p, layer, nrows, gt, gs);
    if constexpr (S == 12) ph_assign(p, layer, nrows, gt, gs);
    if constexpr (S == 13) ph_gather(p, layer, gt, gs);
    if constexpr (S == 14) ph_moe1s(p, layer, gt, gs);
    if constexpr (S == 15) ph_moe2s(p, layer, gt, gs);
    if constexpr (S == 16) ph_combine(p, layer, nrows, gt, gs);
}
template <int S> DEV void final_slot(const P& p, long gt, long gs) {
    if constexpr (S == 0) ph_rstd(p, NLAT, gt, gs);
    if constexpr (S == 1) ph_final(p, gt, gs);
}

struct WsMap { size_t off[56]; size_t total; };
static inline WsMap ws_map() {
    WsMap m; size_t o = 0; int n = 0;
    auto take = [&](size_t bytes) { m.off[n++] = o; o += (bytes + 255) & ~(size_t)255; };
    take(16384);
    take((size_t)NTOK * D * 4);
    take((size_t)4 * 3 * 6 * D * 4);
    take((size_t)2 * (SEQ + CTXL) * 64 * 4);
    take((size_t)2 * (SEQ + CTXL) * 64 * 4);
    take((size_t)2 * (SEQ + CTXL) * HYW * 4);
    take((size_t)2 * 2 * HYW * 4);
    take((size_t)NTOK * 4);
    take((size_t)NTOK * D * 4);
    take((size_t)NTOK * PXLD * 4);
    take((size_t)NTOK * HYW * 4);
    take((size_t)NTOK * HYW * 4);
    take((size_t)NTOK * D * 4);
    take((size_t)2 * NTOK * NG * NP * 2 * 4);
    take((size_t)NTOK * S5W * 4);
    take((size_t)NTOK * 256 * 4);
    take((size_t)NTOK * 256 * 4);
    take((size_t)2 * NTOK * 512 * 4);
    take((size_t)NTOK * 512 * 4);
    take((size_t)NTOK * 128 * 4);
    take((size_t)NTOK * 4 * 4);
    take((size_t)NTOK * 4 * 4);
    take(256);
    take((size_t)(NTOK + 1) * D * 2);
    take((size_t)NTOK * D * 2);
    take((size_t)NTOK * S5W * 2);
    take((size_t)NSLOT * D * 2);
    take((size_t)NSLOT * DFF * 2);
    take((size_t)NSLOT * D * 4);
    take((size_t)NSLOT * 4);
    take((size_t)4 * NE * 4);
    take((size_t)NTOK * 4 * 4);
    take((size_t)NTOK * 4 * 4);
    take((size_t)NSLOT * 4);
    take((size_t)2 * AB_IN * D * 2);
    take((size_t)2 * CD_IN * D * 2);
    take((size_t)2 * D * D * 2);
    take((size_t)2 * D * D * 2);
    take((size_t)2 * S5W * S5W * 2);
    take((size_t)4 * NE * 2 * DFF * D * 2);
    take((size_t)4 * NE * D * DFF * 2);
    take((size_t)2 * 2 * S5NCH * NG * NP * 2 * 4);
    take((size_t)2 * 2 * RNCH * 4 * 8192 * 4);
    take((size_t)2 * NTOK * 4 * RC * 4);
    take((size_t)2 * FNSEG * HYW * 4);
    take((size_t)256 * 2 * FFTN * 4);
    take((size_t)HYW * NLAT * 4);
    take((size_t)2 * NTOK * S5W * 4);
    take((size_t)HYW * NLAT * 4);
    take((size_t)2 * HYW * SEQ * 4);
    take((size_t)8 * 4 * 3 * 6 * D * 4);
    m.total = o; return m;
}
static inline void fill_params(P& p, void* const* d_in, void* d_out, void* d_ws) {
    const float* const* in = (const float* const*)d_in;
    p.x = in[0]; p.c = in[1]; p.ctx = in[2]; p.c_ctx = in[3]; p.mod_w = in[4]; p.mod_b = in[5]; p.norm1_g = in[6]; p.norm2_g = in[7];
    p.ab_w_in = in[8]; p.ab_w_out = in[9]; p.hy_short_w = in[10]; p.hy_short_b = in[11]; p.hy_f_w1 = in[12]; p.hy_f_b1 = in[13];
    p.hy_f_w2 = in[14]; p.hy_f_b2 = in[15]; p.hy_f_w3 = in[16]; p.hy_bias = in[17]; p.s5_lre = in[18]; p.s5_lim = in[19]; p.s5_ldt = in[20];
    p.s5_bre = in[21]; p.s5_bim = in[22]; p.s5_cre = in[23]; p.s5_cim = in[24]; p.s5_d = in[25]; p.s5_glu_w = in[26]; p.s5_glu_b = in[27];
    p.cd_w_in = in[28]; p.cd_w_out = in[29]; p.ret_decay = in[30]; p.swa_sink = in[31]; p.router_w = in[32]; p.router_b = in[33];
    p.w_gu = in[34]; p.b_gu = in[35]; p.w_dn = in[36]; p.b_dn = in[37]; p.final_g = in[38];
    p.out = (float*)d_out;
    const WsMap m = ws_map(); char* w = (char*)d_ws;
    p.bar = (unsigned*)(w + m.off[0]); p.xa = (float*)(w + m.off[1]); p.modv = (float*)(w + m.off[2]); p.f1 = (float*)(w + m.off[3]); p.f2 = (float*)(w + m.off[4]);
    p.hraw = (float*)(w + m.off[5]); p.hsum = (float*)(w + m.off[6]); p.rstd = (float*)(w + m.off[7]); p.hx = (float*)(w + m.off[8]); p.px = (px_t*)(w + m.off[9]);
    p.zb = (float*)(w + m.off[10]); p.x0c = (float*)(w + m.off[11]); p.mixin = (float*)(w + m.off[12]); p.s5s = (float*)(w + m.off[13]); p.ys5 = (float*)(w + m.off[14]);
    p.qr = (float*)(w + m.off[15]); p.kr = (float*)(w + m.off[16]); p.oret = (float*)(w + m.off[17]); p.qs = (float*)(w + m.off[18]); p.ks = (float*)(w + m.off[19]);
    p.topg = (float*)(w + m.off[20]); p.topi = (int*)(w + m.off[21]); p.act = nullptr;
    p.hxb = (bf16_t*)(w + m.off[23]); p.mixb = (bf16_t*)(w + m.off[24]); p.ys5b = (bf16_t*)(w + m.off[25]); p.xb = (bf16_t*)(w + m.off[26]); p.actb = (bf16_t*)(w + m.off[27]);
    p.yb = (bf16_t*)(w + m.off[28]); p.slot_gate = (float*)(w + m.off[29]); p.cnt = (int*)(w + m.off[30]); p.pos = (int*)(w + m.off[31]); p.slot_of = (int*)(w + m.off[32]);
    p.slot_tok = (int*)(w + m.off[33]); p.abin_t = (bf16_t*)(w + m.off[34]); p.cdin_t = (bf16_t*)(w + m.off[35]); p.about_t = (bf16_t*)(w + m.off[36]);
    p.cdout_t = (bf16_t*)(w + m.off[37]); p.glu_t = (bf16_t*)(w + m.off[38]); p.wgu_t = (bf16_t*)(w + m.off[39]); p.wdn_t = (bf16_t*)(w + m.off[40]);
    p.s5c = (float*)(w + m.off[41]); p.rkv = (float*)(w + m.off[42]); p.rsc = (float*)(w + m.off[43]); p.hpart = (float*)(w + m.off[44]);
    p.zf = (float*)(w + m.off[45]); p.convT = (float*)(w + m.off[46]); p.yd = (float*)(w + m.off[47]); p.zT = (float*)(w + m.off[48]); p.hT = (float*)(w + m.off[49]); p.modp = (float*)(w + m.off[50]);
}

#ifndef CPU_SHIM
namespace pg8 {
#define PG8_LAS __attribute__((address_space(3)))
typedef short bf16x8 __attribute__((ext_vector_type(8)));
typedef float f32x4 __attribute__((ext_vector_type(4)));
constexpr int BM = 256, BK = 64, HALF = 128, HTB = HALF * BK * 2, STAGE_BYTES = 8 * HTB, NXCD = 8, WGM = 8;
__host__ __device__ __forceinline__ int lds_byte(int r, int c) { const int st = (r >> 4) * 2 + (c >> 5), rr = r & 15, cc = c & 31, ob = rr * 64 + cc * 2; return st * 1024 + (ob ^ (((ob >> 9) & 1) << 5)); }
__host__ __device__ __forceinline__ void stage_rc(int b, int& R, int& C) { const int st = b / 1024, sb = b % 1024, swz = sb ^ (((sb >> 9) & 1) << 5); R = (st >> 1) * 16 + swz / 64; C = (st & 1) * 32 + (swz % 64) / 2; }
struct Unit { int pm, pn, e; };
struct Gemm { const bf16_t* A; const bf16_t* Bt; int M, N, K; size_t ebytes; };
struct StaticOrder {
    int nM, nN, nwg, G, c;
    __device__ void init(int M, int N, int G_, int c_) { nM = M / BM; nN = N / BM; nwg = nM * nN; G = G_; c = c_; }
    __device__ bool next(int i, Unit& u) const {
        const long L = (long)i * G + c; if (L >= nwg) return false;
        int wgid = (int)L; { const int q = nwg / NXCD, r = nwg % NXCD, xcd = wgid % NXCD, off = wgid / NXCD; wgid = (xcd < r ? xcd * (q + 1) : r * (q + 1) + (xcd - r) * q) + off; }
        const int nig = WGM * nN, gid = wgid / nig, fm = gid * WGM, gsz = (nM - fm) < WGM ? (nM - fm) : WGM;
        u.pm = fm + ((wgid % nig) % gsz); u.pn = (wgid % nig) / gsz; u.e = 0; return true;
    }
    __device__ int tok(int, int) const { return 0; }
};
struct MoeOrder {
    int nwg, nN, G, c; const volatile PG8_LAS unsigned char* ue; const volatile PG8_LAS int* tokt;
    __device__ int tok(int ui, int row) const { return tokt[ui * 256 + row]; }
    __device__ bool unit(int i, int& pm, int& pn) const {
        const int S = G >> 3;
        if ((G & 7) == 0 && S % nN == 0) { const int x = c & 7, slot = c >> 3, pmx = S / nN, T = nwg / nN, tpx = (T + 7) >> 3, lp = i * pmx + slot / nN;
            pm = x * tpx + lp; pn = slot % nN; return lp < tpx && pm < T; }
        const long L = (long)i * G + c; pm = (int)(L / nN); pn = (int)(L % nN); return L < nwg;
    }
    __device__ bool next(int i, Unit& u) const {
        int pm, pn; if (!unit(i, pm, pn)) return false;
        u.pm = pm; u.pn = pn; u.e = __builtin_amdgcn_readfirstlane((int)ue[pm]); return true;
    }
};
template <class Epi, class Sched, bool GATHER = false>
__device__ __forceinline__ void gemm_phase(PG8_LAS unsigned char* lds, const Gemm g, const Sched& S, const Epi& E) {
    int tid = threadIdx.x; asm volatile("" : "+v"(tid));
    const int wid = __builtin_amdgcn_readfirstlane(tid >> 6), lane = tid & 63, wr = wid >> 2, wc = wid & 3, fr = lane & 15, fq = lane >> 4;
    const int K = g.K, nt = K / BK;
    unsigned va[2][2], vn[2][2], voffB[2]; int Rr[2]; unsigned Cb[2];
#pragma unroll
    for (int i = 0; i < 2; ++i) { int R, C; stage_rc(tid * 16 + i * 8192, R, C); Rr[i] = R; Cb[i] = (unsigned)C * 2u; voffB[i] = (unsigned)(R * K + C) * 2u; }
    const size_t kstep = (size_t)(BK * 2);
    const size_t hstep = (size_t)HALF * K * 2;
    const size_t tstep = 2 * hstep;
#define PG8_SETOFF(v, ui_) do { _Pragma("unroll") for (int h_ = 0; h_ < 2; ++h_) _Pragma("unroll") for (int i_ = 0; i_ < 2; ++i_) \
        v[h_][i_] = GATHER ? (unsigned)S.tok(ui_, h_ * HALF + Rr[i_]) * (unsigned)(K * 2) + Cb[i_] : voffB[i_] + (unsigned)(h_ * hstep); } while (0)
    const unsigned ldsw = (unsigned)wid * 1024u;
    const int aoff = lds_byte(wr * 64 + fr, fq * 8), boff = lds_byte(wc * 32 + fr, fq * 8);
#define PG8_SA(b, h) (((b) * 2 + (h)) * HTB)
#define PG8_SB(b, h) ((4 + (b) * 2 + (h)) * HTB)
#define PG8_STAGE(bufoff, gbase, voff) do { _Pragma("unroll") for (int _i = 0; _i < 2; ++_i) \
        __builtin_amdgcn_global_load_lds((const unsigned*)((const char*)(gbase) + (voff)[_i]), (PG8_LAS unsigned*)(lds + (bufoff) + ldsw + _i * 8192), 16, 0, 0); } while (0)
#define PG8_LDA(dst, b, h) do { _Pragma("unroll") for (int m = 0; m < 4; ++m) _Pragma("unroll") for (int k = 0; k < 2; ++k) dst[m][k] = *(const PG8_LAS bf16x8*)(lds + PG8_SA(b, h) + aoff + m * 2048 + k * 1024); } while (0)
#define PG8_LDB(dst, b, h) do { _Pragma("unroll") for (int n = 0; n < 2; ++n) _Pragma("unroll") for (int k = 0; k < 2; ++k) dst[n][k] = *(const PG8_LAS bf16x8*)(lds + PG8_SB(b, h) + boff + n * 2048 + k * 1024); } while (0)
#define PG8_MMA(ai, bj, At, Bt) do { __builtin_amdgcn_s_setprio(1); _Pragma("unroll") for (int m = 0; m < 4; ++m) _Pragma("unroll") for (int n = 0; n < 2; ++n) _Pragma("unroll") for (int k = 0; k < 2; ++k) \
        acc[ai][bj][m][n] = __builtin_amdgcn_mfma_f32_16x16x32_bf16(Bt[n][k], At[m][k], acc[ai][bj][m][n], 0, 0, 0); __builtin_amdgcn_s_setprio(0); } while (0)
#define PG8_WAIT_V(n) asm volatile("s_waitcnt vmcnt(" #n ")" ::: "memory")
#define PG8_WAIT_L(n) asm volatile("s_waitcnt lgkmcnt(" #n ")" ::: "memory")
#define PG8_BAR __builtin_amdgcn_s_barrier()
#define PG8_SCHED __builtin_amdgcn_sched_barrier(0)
    Unit cur, nxt; int ui = 0;
    if (!S.next(0, cur)) return;
    f32x4 acc[2][2][4][2];
#pragma unroll
    for (int a = 0; a < 2; ++a)
#pragma unroll
        for (int b = 0; b < 2; ++b)
#pragma unroll
            for (int m = 0; m < 4; ++m)
#pragma unroll
                for (int n = 0; n < 2; ++n) acc[a][b][m][n] = (f32x4){0.f, 0.f, 0.f, 0.f};
    bf16x8 At[4][2], B0[2][2], B1[2][2];
    const char* cA = (const char*)g.A + (GATHER ? (size_t)0 : (size_t)cur.pm * tstep); const char* cB = (const char*)g.Bt + (size_t)cur.e * g.ebytes + (size_t)cur.pn * tstep;
    PG8_SETOFF(va, 0);
    PG8_STAGE(PG8_SB(0, 0), cB, voffB); PG8_STAGE(PG8_SB(0, 1), cB + hstep, voffB); PG8_STAGE(PG8_SA(0, 0), cA, va[0]); PG8_STAGE(PG8_SA(0, 1), cA, va[1]);
    if (wr == 1) PG8_BAR;
    PG8_WAIT_V(2); PG8_BAR;
    PG8_STAGE(PG8_SB(1, 0), cB + kstep, voffB); PG8_STAGE(PG8_SA(1, 0), cA + kstep, va[0]); PG8_STAGE(PG8_SB(1, 1), cB + hstep + kstep, voffB);
    PG8_WAIT_V(6); PG8_BAR;
    for (;;) {
        const bool has_next = S.next(ui + 1, nxt);
        const char* nA = has_next ? (const char*)g.A + (GATHER ? (size_t)0 : (size_t)nxt.pm * tstep) : cA; const char* nB = has_next ? (const char*)g.Bt + (size_t)nxt.e * g.ebytes + (size_t)nxt.pn * tstep : cB;
        if (GATHER && has_next) PG8_SETOFF(vn, ui + 1); else { _Pragma("unroll") for (int h_ = 0; h_ < 2; ++h_) _Pragma("unroll") for (int i_ = 0; i_ < 2; ++i_) vn[h_][i_] = va[h_][i_]; }
        for (int t = 0; t < nt; t += 2) {
            const bool last = (t == nt - 2);
            const char* a1 = cA + (size_t)(t + 1) * kstep;
            const char* a2 = last ? nA : cA + (size_t)(t + 2) * kstep; const char* b2 = last ? nB : cB + (size_t)(t + 2) * kstep;
            const char* a3 = a2 + kstep; const char* b3 = b2 + kstep;
            unsigned s0[2], s1[2];
#pragma unroll
            for (int i_ = 0; i_ < 2; ++i_) { s0[i_] = last ? vn[0][i_] : va[0][i_]; s1[i_] = last ? vn[1][i_] : va[1][i_]; }
            PG8_LDB(B0, 0, 0); PG8_LDB(B1, 0, 1); PG8_SCHED; PG8_LDA(At, 0, 0); PG8_STAGE(PG8_SA(1, 1), a1, va[1]);
            PG8_WAIT_V(8); PG8_WAIT_L(0); PG8_BAR; PG8_MMA(0, 0, At, B0); PG8_MMA(0, 1, At, B1); PG8_BAR; PG8_SCHED;
            PG8_LDA(At, 0, 1); PG8_STAGE(PG8_SB(0, 0), b2, voffB); PG8_STAGE(PG8_SB(0, 1), b2 + hstep, voffB); PG8_STAGE(PG8_SA(0, 0), a2, s0);
            PG8_WAIT_V(8); PG8_WAIT_L(0); PG8_BAR; PG8_MMA(1, 0, At, B0); PG8_MMA(1, 1, At, B1); PG8_BAR; PG8_SCHED;
            PG8_LDB(B0, 1, 0); PG8_LDB(B1, 1, 1); PG8_SCHED; PG8_LDA(At, 1, 0); PG8_STAGE(PG8_SA(0, 1), a2, s1);
            PG8_WAIT_V(8); PG8_WAIT_L(0); PG8_BAR; PG8_MMA(0, 0, At, B0); PG8_MMA(0, 1, At, B1); PG8_BAR; PG8_SCHED;
            PG8_LDA(At, 1, 1); PG8_STAGE(PG8_SB(1, 0), b3, voffB); PG8_STAGE(PG8_SB(1, 1), b3 + hstep, voffB); PG8_STAGE(PG8_SA(1, 0), a3, s0);
            PG8_WAIT_V(8); PG8_WAIT_L(0); PG8_BAR; PG8_MMA(1, 0, At, B0); PG8_MMA(1, 1, At, B1); PG8_BAR; PG8_SCHED;
        }
        if (wr == 0) PG8_BAR;
        E(acc, cur, wr, wc, fr, fq);
        if (!has_next) break;
#pragma unroll
        for (int a = 0; a < 2; ++a)
#pragma unroll
            for (int b = 0; b < 2; ++b)
#pragma unroll
                for (int m = 0; m < 4; ++m)
#pragma unroll
                    for (int n = 0; n < 2; ++n) acc[a][b][m][n] = (f32x4){0.f, 0.f, 0.f, 0.f};
        cur = nxt; cA = nA; cB = nB; ++ui;
#pragma unroll
        for (int h_ = 0; h_ < 2; ++h_)
#pragma unroll
            for (int i_ = 0; i_ < 2; ++i_) va[h_][i_] = vn[h_][i_];
        if (wr == 1) PG8_BAR;
    }
    PG8_WAIT_V(0);
    PG8_BAR;
#undef PG8_SA
#undef PG8_SB
#undef PG8_STAGE
#undef PG8_SETOFF
#undef PG8_LDA
#undef PG8_LDB
#undef PG8_MMA
#undef PG8_WAIT_V
#undef PG8_WAIT_L
#undef PG8_BAR
#undef PG8_SCHED
}
typedef float f32x2v __attribute__((ext_vector_type(2)));
typedef __bf16 bf16x2v __attribute__((ext_vector_type(2)));
__device__ __forceinline__ unsigned cvt_pk_bf16(float lo, float hi) { const bf16x2v r = __builtin_convertvector((f32x2v){lo, hi}, bf16x2v); return __builtin_bit_cast(unsigned, r); }
__device__ __forceinline__ float fast_sigmoid(float x) { return __builtin_amdgcn_rcpf(1.0f + __builtin_amdgcn_exp2f(-1.4426950408889634f * x)); }
#define EPI_LOOP(body) _Pragma("unroll") for (int ai = 0; ai < 2; ++ai) _Pragma("unroll") for (int m = 0; m < 4; ++m) { const int row = row0 + ai * HALF + m * 16; \
    _Pragma("unroll") for (int bj = 0; bj < 2; ++bj) _Pragma("unroll") for (int n = 0; n < 2; ++n) { const int col = col0 + bj * HALF + n * 16; const f32x4 a = acc[ai][bj][m][n]; body } }
struct EpiStoreF32 {
    float* C; int ldc;
    __device__ __forceinline__ void operator()(const f32x4 (&acc)[2][2][4][2], const Unit& u, int wr, int wc, int fr, int fq) const {
        const int row0 = u.pm * BM + wr * 64 + fr, col0 = u.pn * BM + wc * 32 + 4 * fq;
        EPI_LOOP( *(f32x4*)(C + (size_t)row * ldc + col) = a; )
    }
};
struct EpiStoreBf16 {
    bf16_t* C; int ldc;
    __device__ __forceinline__ void operator()(const f32x4 (&acc)[2][2][4][2], const Unit& u, int wr, int wc, int fr, int fq) const {
        const int row0 = u.pm * BM + wr * 64 + fr, col0 = u.pn * BM + wc * 32 + 4 * fq;
        EPI_LOOP( uint2 o; o.x = cvt_pk_bf16(a[0], a[1]); o.y = cvt_pk_bf16(a[2], a[3]); *(uint2*)(C + (size_t)row * ldc + col) = o; )
    }
};
struct EpiResid {
    float* X; const float* gv;
    __device__ __forceinline__ void operator()(const f32x4 (&acc)[2][2][4][2], const Unit& u, int wr, int wc, int fr, int fq) const {
        const int row0 = u.pm * BM + wr * 64 + fr, col0 = u.pn * BM + wc * 32 + 4 * fq;
        const int r0 = u.pm * BM, mrow = r0 < SEQ ? 0 : (r0 < NLAT ? 1 : 2); const float* g = gv + (size_t)mrow * 6 * D;
        EPI_LOOP( const f32x4 gg = *(const f32x4*)(g + col); f32x4* q = (f32x4*)(X + (size_t)row * D + col); *q = *q + gg * a; )
    }
};
struct EpiGlu {
    bf16_t* O; const bf16_t* Y; const float* bias;
    __device__ __forceinline__ void operator()(const f32x4 (&acc)[2][2][4][2], const Unit& u, int wr, int wc, int fr, int fq) const {
        const int row0 = u.pm * BM + wr * 64 + fr, col0 = u.pn * BM + wc * 32 + 4 * fq;
        EPI_LOOP( const f32x4 bb = *(const f32x4*)(bias + col); const ushort4 yv = *(const ushort4*)(Y + (size_t)row * S5W + col);
            uint2 o; o.x = cvt_pk_bf16(bf2f(yv.x) * fast_sigmoid(a[0] + bb[0]), bf2f(yv.y) * fast_sigmoid(a[1] + bb[1])); o.y = cvt_pk_bf16(bf2f(yv.z) * fast_sigmoid(a[2] + bb[2]), bf2f(yv.w) * fast_sigmoid(a[3] + bb[3]));
            *(uint2*)(O + (size_t)row * D + HYW + col) = o; )
    }
};
struct EpiSwiglu {
    bf16_t* O; const float* bgu;
    __device__ __forceinline__ void operator()(const f32x4 (&acc)[2][2][4][2], const Unit& u, int wr, int wc, int fr, int fq) const {
        const int row0 = u.pm * BM + wr * 64 + fr, colb = wc * 32 + 4 * fq; const float* bb = bgu + (size_t)u.e * 2 * DFF + u.pn * 128;
#pragma unroll
        for (int ai = 0; ai < 2; ++ai)
#pragma unroll
            for (int m = 0; m < 4; ++m) { const int row = row0 + ai * HALF + m * 16;
#pragma unroll
                for (int n = 0; n < 2; ++n) { const int cc = colb + n * 16; const f32x4 bg = *(const f32x4*)(bb + cc), bu = *(const f32x4*)(bb + DFF + cc);
                    const f32x4 ga = acc[ai][0][m][n] + bg, up = acc[ai][1][m][n] + bu; float av[4];
#pragma unroll
                    for (int j = 0; j < 4; ++j) { const float gg = fminf(ga[j], 7.0f), uu = fminf(fmaxf(up[j], -7.0f), 7.0f); av[j] = gg * fast_sigmoid(1.702f * gg) * (uu + 1.0f); }
                    uint2 o; o.x = cvt_pk_bf16(av[0], av[1]); o.y = cvt_pk_bf16(av[2], av[3]);
                    *(uint2*)(O + (size_t)row * DFF + u.pn * 128 + cc) = o; } }
    }
};
struct EpiDown {
    bf16_t* Y; const float* bdn; const float* gate;
    __device__ __forceinline__ void operator()(const f32x4 (&acc)[2][2][4][2], const Unit& u, int wr, int wc, int fr, int fq) const {
        const int row0 = u.pm * BM + wr * 64 + fr, col0 = u.pn * BM + wc * 32 + 4 * fq; const float* bb = bdn + (size_t)u.e * D;
        EPI_LOOP( const f32x4 bv = *(const f32x4*)(bb + col); const float gt_ = gate[row]; const f32x4 o = (a + bv) * gt_; uint2 ob; ob.x = cvt_pk_bf16(o[0], o[1]); ob.y = cvt_pk_bf16(o[2], o[3]); *(uint2*)(Y + (size_t)row * D + col) = ob; )
    }
};
}

constexpr int RING_BYTES = 131072, SCRATCH_BYTES = 135168, MISC_OFF = SCRATCH_BYTES, UE_OFF = MISC_OFF + 64, TOK_OFF = UE_OFF + 320, TOK_UNITS = 11, LDS_BYTES = 147456;
static_assert(FFT_ELEMS * 8 <= SCRATCH_BYTES && TOK_OFF + TOK_UNITS * 1024 <= LDS_BYTES && ((NSLOT / 256 + 7) / 8 + 3) / 4 <= TOK_UNITS, "LDS map");
#define LAS __attribute__((address_space(3)))

__device__ __forceinline__ void transpose_item(const float* W, int K, int N, bf16_t* WT, int gu_perm, LAS float* scr, int item, int lane) {
    const int nblk = N / 32, kb = item / nblk, nb = item % nblk, k0 = 64 * kb, n0 = 32 * nb;
    const int r0 = gu_perm ? (n0 < DFF ? (n0 / 128) * 256 + (n0 % 128) : ((n0 - DFF) / 128) * 256 + 128 + ((n0 - DFF) % 128)) : n0;
#pragma unroll 8
    for (int i = 0; i < 32; ++i) { const int kk = 2 * i + (lane >> 5); scr[kk * 33 + (lane & 31)] = W[(size_t)(k0 + kk) * N + n0 + (lane & 31)]; }
    asm volatile("s_waitcnt lgkmcnt(0)" ::: "memory");
    const int c = lane & 7;
#pragma unroll
    for (int j = 0; j < 4; ++j) { const int n = (lane >> 3) + 8 * j; const LAS float* s = scr + (8 * c) * 33 + n;
        uint4 o; o.x = f2bf(s[0 * 33]) | ((unsigned)f2bf(s[1 * 33]) << 16); o.y = f2bf(s[2 * 33]) | ((unsigned)f2bf(s[3 * 33]) << 16);
        o.z = f2bf(s[4 * 33]) | ((unsigned)f2bf(s[5 * 33]) << 16); o.w = f2bf(s[6 * 33]) | ((unsigned)f2bf(s[7 * 33]) << 16);
        *(uint4*)(WT + (size_t)(r0 + n) * K + k0 + 8 * c) = o; }
    asm volatile("s_waitcnt lgkmcnt(0)" ::: "memory");
}
constexpr int I_GU = (D / 64) * (2 * DFF / 32), I_DN = (DFF / 64) * (D / 32), EXP_ITEMS = NE * (I_GU + I_DN);
__device__ __forceinline__ void convert_expert_item(const P& p, int l, int q, LAS float* scr, int lane) {
    if (q < NE * I_GU) { const int e = q / I_GU; const size_t i = (size_t)l * NE + e; transpose_item(p.w_gu + i * D * 2 * DFF, D, 2 * DFF, p.wgu_t + i * 2 * DFF * D, 1, scr, q % I_GU, lane); }
    else { const int q2 = q - NE * I_GU, e = q2 / I_DN; const size_t i = (size_t)l * NE + e; transpose_item(p.w_dn + i * DFF * D, DFF, D, p.wdn_t + i * D * DFF, 0, scr, q2 % I_DN, lane); }
}
constexpr int DEFER_Q1 = 64, DEFER_Q2 = 140;
__device__ __forceinline__ int defer_idle(int units, int G) { const int rem = units % G; return rem ? G - rem : 0; }
__device__ __forceinline__ int defer_in_units(int layer) { return (NTOK / 256) * ((layer & 1) ? CD_IN / 256 : AB_IN / 256); }
__device__ __forceinline__ int defer_d1(int layer, int G) { const int n = defer_idle(defer_in_units(layer), G) * DEFER_Q1; return n < EXP_ITEMS ? n : EXP_ITEMS; }
__device__ __forceinline__ int defer_d2(int layer, int G) { const int d1 = defer_d1(layer, G), n = d1 + defer_idle((NTOK / 256) * (D / 256), G) * DEFER_Q2; return n < EXP_ITEMS ? n : EXP_ITEMS; }
__device__ __forceinline__ void convert_deferred(const P& p, LAS unsigned char* lds, int layer, int which) {
    int tid = threadIdx.x; asm volatile("" : "+v"(tid));
    int bx_ = (int)blockIdx.x, gx_ = (int)gridDim.x; asm volatile("" : "+s"(bx_), "+s"(gx_));
    const int units = which ? (NTOK / 256) * (D / 256) : defer_in_units(layer), rem = units % gx_;
    if (rem == 0 || bx_ < rem) return;
    const int lane = tid & 63, wave = tid >> 6; LAS float* scr = (LAS float*)(lds + wave * 16384);
    const int qn = which ? DEFER_Q2 : DEFER_Q1, q0 = (which ? defer_d1(layer, gx_) : 0) + (bx_ - rem) * qn, qend = which ? defer_d2(layer, gx_) : defer_d1(layer, gx_);
    for (int q = q0 + wave; q < q0 + qn && q < qend; q += 8) convert_expert_item(p, layer + 1, q, scr, lane);
}
__device__ __forceinline__ void ph_convert_weights(const P& p, LAS unsigned char* lds) {
    int tid = threadIdx.x; asm volatile("" : "+v"(tid));
    const int lane = tid & 63, wave = tid >> 6;
    LAS float* scr = (LAS float*)(lds + wave * 16384);
    const long gw = (long)blockIdx.x * 8 + wave, NGW = (long)gridDim.x * 8; const int G = (int)gridDim.x;
    constexpr long I_ABIN = (D / 64) * (AB_IN / 32), I_CDIN = (D / 64) * (CD_IN / 32), I_OUT = (D / 64) * (D / 32), I_GLU = (S5W / 64) * (S5W / 32);
    constexpr long T0 = 2 * I_ABIN, T1 = T0 + 2 * I_CDIN, T2 = T1 + 2 * I_OUT, T3 = T2 + 2 * I_OUT, T4 = T3 + 2 * I_GLU;
    for (long it = gw; it < T4; it += NGW) {
        if (it < T0) { const int i = (int)(it / I_ABIN); transpose_item(p.ab_w_in + (size_t)i * D * AB_IN, D, AB_IN, p.abin_t + (size_t)i * AB_IN * D, 0, scr, (int)(it % I_ABIN), lane); }
        else if (it < T1) { const long r = it - T0; const int i = (int)(r / I_CDIN); transpose_item(p.cd_w_in + (size_t)i * D * CD_IN, D, CD_IN, p.cdin_t + (size_t)i * CD_IN * D, 0, scr, (int)(r % I_CDIN), lane); }
        else if (it < T2) { const long r = it - T1; const int i = (int)(r / I_OUT); transpose_item(p.ab_w_out + (size_t)i * D * D, D, D, p.about_t + (size_t)i * D * D, 0, scr, (int)(r % I_OUT), lane); }
        else if (it < T3) { const long r = it - T2; const int i = (int)(r / I_OUT); transpose_item(p.cd_w_out + (size_t)i * D * D, D, D, p.cdout_t + (size_t)i * D * D, 0, scr, (int)(r % I_OUT), lane); }
        else { const long r = it - T3; const int i = (int)(r / I_GLU); transpose_item(p.s5_glu_w + (size_t)i * S5W * S5W, S5W, S5W, p.glu_t + (size_t)i * S5W * S5W, 0, scr, (int)(r % I_GLU), lane); }
    }
    for (int l = 0; l < 4; ++l) { const int qs = l ? defer_d2(l - 1, G) : 0;
        for (long q = qs + gw; q < EXP_ITEMS; q += NGW) convert_expert_item(p, l, (int)q, scr, lane); }
}
constexpr int NTHREADS = 512;
__device__ __forceinline__ float wave_sum(float v) {
#pragma unroll
    for (int o = 1; o < 64; o <<= 1) v += __shfl_xor(v, o);
    return v;
}
template <int CTRL> __device__ __forceinline__ float dppf(float v) { return __builtin_bit_cast(float, __builtin_amdgcn_update_dpp(0, __builtin_bit_cast(int, v), CTRL, 0xf, 0xf, false)); }
template <int CTRL> __device__ __forceinline__ int dppi(int v) { return __builtin_amdgcn_update_dpp(0, v, CTRL, 0xf, 0xf, false); }
__device__ __forceinline__ float row16_max(float x) { x = fmaxf(x, dppf<0xB1>(x)); x = fmaxf(x, dppf<0x4E>(x)); x = fmaxf(x, dppf<0x141>(x)); x = fmaxf(x, dppf<0x140>(x)); return x; }
__device__ __forceinline__ float row16_sum(float x) { x += dppf<0xB1>(x); x += dppf<0x4E>(x); x += dppf<0x141>(x); x += dppf<0x140>(x); return x; }
__device__ __forceinline__ int row16_min(int x) { x = min(x, dppi<0xB1>(x)); x = min(x, dppi<0x4E>(x)); x = min(x, dppi<0x141>(x)); x = min(x, dppi<0x140>(x)); return x; }
template <int L> __device__ __forceinline__ float rowb(float v) { return __builtin_bit_cast(float, __builtin_amdgcn_update_dpp(0, __builtin_bit_cast(int, v), 0x150 + L, 0xf, 0xf, false)); }
template <int L> __device__ __forceinline__ void route_steps(float val, const LAS float* wq, float& a0, float& a1) {
    const float xb = rowb<L>(val); const pg8::f32x2v w = *(const LAS pg8::f32x2v*)(wq + (4 * L) * 32);
    a0 += xb * w.x; a1 += xb * w.y;
    if constexpr (L + 1 < 16) route_steps<L + 1>(val, wq, a0, a1);
}
template <int MODE> __device__ __forceinline__ void mf_rownorm(const P& p, LAS unsigned char* lds, int layer, int nrows, int comb_layer) {
    constexpr bool ROUTE = MODE == 1; constexpr int which = MODE == 1 ? 1 : 0;
    int tid = threadIdx.x; asm volatile("" : "+v"(tid));
    int bx_ = (int)blockIdx.x, gx_ = (int)gridDim.x; asm volatile("" : "+s"(bx_), "+s"(gx_));
    const int lane = tid & 63, wave = tid >> 6;
    if (ROUTE) { for (int j = bx_ * NTHREADS + tid; j < NSLOT; j += gx_ * NTHREADS) { p.slot_tok[j] = -1; p.slot_gate[j] = 0.f; } }
    const float* gn = MODE == 2 ? p.final_g : (which ? p.norm2_g : p.norm1_g) + layer * D;
    LAS float* Wl = (LAS float*)lds;
    if (ROUTE) { const float* rw = p.router_w + (size_t)layer * D * NE;
        for (int i = tid; i < D * NE / 4; i += NTHREADS) { const float4 w4 = *(const float4*)(rw + 4 * i); const int k = i >> 3, e0 = (i & 7) * 4, kp = k ^ ((k >> 6) & 1);
            const float wv[4] = {w4.x, w4.y, w4.z, w4.w};
#pragma unroll
            for (int t = 0; t < 4; ++t) { const int e = e0 + t; Wl[kp * 32 + 2 * (e & 15) + (e >> 4)] = wv[t]; } }
        __syncthreads(); }
    volatile LAS int* lcnt = (volatile LAS int*)(lds + RING_BYTES);
    volatile LAS int* lbase = lcnt + NE; volatile LAS int* lrank = lcnt + 2 * NE;
    if (ROUTE) { if (tid < NE) lcnt[tid] = 0; __syncthreads(); }
    for (int r = bx_ * 8 + wave; r < nrows; r += gx_ * 8) {
        const int m = r < SEQ ? 0 : (r < NLAT ? 1 : 2);
        const float* mv = p.modv + ((size_t)layer * 3 + m) * 6 * D + which * 3 * D;
        float* xr = p.xa + (size_t)r * D;
        float4 v[4]; float ss = 0.f;
#pragma unroll
        for (int j = 0; j < 4; ++j) v[j] = *(const float4*)(xr + 256 * j + 4 * lane);
        if (comb_layer >= 0) {
            const float* g2 = p.modv + ((size_t)comb_layer * 3 + m) * 6 * D + 5 * D;
            const int4 so = *(const int4*)(p.slot_of + r * 4);
            const bf16_t* y0 = p.yb + (size_t)so.x * D; const bf16_t* y1 = p.yb + (size_t)so.y * D; const bf16_t* y2 = p.yb + (size_t)so.z * D; const bf16_t* y3 = p.yb + (size_t)so.w * D;
#pragma unroll
            for (int j = 0; j < 4; ++j) { const int k = 256 * j + 4 * lane; const ushort4 a = *(const ushort4*)(y0 + k), b = *(const ushort4*)(y1 + k), c = *(const ushort4*)(y2 + k), d = *(const ushort4*)(y3 + k); const float4 gg = *(const float4*)(g2 + k);
                v[j].x += gg.x * (bf2f(a.x) + bf2f(b.x) + bf2f(c.x) + bf2f(d.x)); v[j].y += gg.y * (bf2f(a.y) + bf2f(b.y) + bf2f(c.y) + bf2f(d.y));
                v[j].z += gg.z * (bf2f(a.z) + bf2f(b.z) + bf2f(c.z) + bf2f(d.z)); v[j].w += gg.w * (bf2f(a.w) + bf2f(b.w) + bf2f(c.w) + bf2f(d.w));
                if (MODE != 2) *(float4*)(xr + k) = v[j]; }
        }
#pragma unroll
        for (int j = 0; j < 4; ++j) ss += v[j].x * v[j].x + v[j].y * v[j].y + v[j].z * v[j].z + v[j].w * v[j].w;
        const float rstd = rsqrtf(wave_sum(ss) * (1.0f / D) + EPS);
        if (MODE == 2) {
#pragma unroll
            for (int j = 0; j < 4; ++j) { const int k = 256 * j + 4 * lane; const float4 g4 = *(const float4*)(gn + k);
                float4 o; o.x = v[j].x * rstd * g4.x; o.y = v[j].y * rstd * g4.y; o.z = v[j].z * rstd * g4.z; o.w = v[j].w * rstd * g4.w;
                *(float4*)(p.out + (size_t)r * D + k) = o; }
            continue;
        }
#pragma unroll
        for (int j = 0; j < 4; ++j) { const int k = 256 * j + 4 * lane; const float4 g4 = *(const float4*)(gn + k), sc = *(const float4*)(mv + D + k), sh = *(const float4*)(mv + k);
            v[j].x = v[j].x * rstd * g4.x * (1.0f + sc.x) + sh.x; v[j].y = v[j].y * rstd * g4.y * (1.0f + sc.y) + sh.y;
            v[j].z = v[j].z * rstd * g4.z * (1.0f + sc.z) + sh.z; v[j].w = v[j].w * rstd * g4.w * (1.0f + sc.w) + sh.w;
            ushort4 o; o.x = f2bf(v[j].x); o.y = f2bf(v[j].y); o.z = f2bf(v[j].z); o.w = f2bf(v[j].w);
            *(ushort4*)(p.hxb + (size_t)r * D + k) = o; }
        if (ROUTE) {
            const int cl = lane & 15, Rr = lane >> 4, r1 = Rr & 1;
            const LAS float* wbE = Wl + (64 * Rr) * 32 + 2 * cl + r1 * 32;
            const LAS float* wbO = Wl + (64 * Rr) * 32 + 2 * cl - r1 * 32;
            float acc0 = 0.f, acc1 = 0.f;
#pragma unroll
            for (int j = 0; j < 4; ++j) { const float vq[4] = {v[j].x, v[j].y, v[j].z, v[j].w};
#pragma unroll
                for (int q = 0; q < 4; ++q) { route_steps<0>(vq[q], ((q & 1) ? wbO : wbE) + (256 * j + q) * 32, acc0, acc1); __builtin_amdgcn_sched_barrier(0); } }
            acc0 += __shfl_xor(acc0, 16); acc0 += __shfl_xor(acc0, 32); acc1 += __shfl_xor(acc1, 16); acc1 += __shfl_xor(acc1, 32);
            acc0 += p.router_b[layer * NE + cl]; acc1 += p.router_b[layer * NE + 16 + cl];
            int ti[4]; float tv[4];
#pragma unroll
            for (int s = 0; s < 4; ++s) {
                const float vmax = row16_max(fmaxf(acc0, acc1));
                const int cand = acc0 == vmax ? cl : (acc1 == vmax ? cl + 16 : 64), best = row16_min(cand);
                ti[s] = best; tv[s] = vmax;
                if (best == cl) acc0 = -3.0e38f; if (best == cl + 16) acc1 = -3.0e38f;
            }
            if (lane == 0) {
                const float e1 = expf(tv[1] - tv[0]), e2 = expf(tv[2] - tv[0]), e3 = expf(tv[3] - tv[0]), inv = 1.0f / (1.0f + e1 + e2 + e3);
                p.topi[r * 4 + 0] = ti[0]; p.topi[r * 4 + 1] = ti[1]; p.topi[r * 4 + 2] = ti[2]; p.topi[r * 4 + 3] = ti[3];
                p.topg[r * 4 + 0] = inv; p.topg[r * 4 + 1] = e1 * inv; p.topg[r * 4 + 2] = e2 * inv; p.topg[r * 4 + 3] = e3 * inv;
                const int li = ((r - (bx_ * 8 + wave)) / (gx_ * 8)) * 8 + wave;
#pragma unroll
                for (int s = 0; s < 4; ++s) lrank[li * 4 + s] = __hip_atomic_fetch_add((LAS int*)(lcnt + ti[s]), 1, __ATOMIC_RELAXED, __HIP_MEMORY_SCOPE_WORKGROUP);
            }
        }
    }
    if (ROUTE) {
        __syncthreads();
        if (tid < NE) lbase[tid] = atomicAdd(p.cnt + layer * NE + tid, lcnt[tid]);
        __syncthreads();
        const int nmine = (nrows - bx_ * 8 + gx_ * 8 - 1) / (gx_ * 8) * 8;
        for (int i = tid; i < nmine * 4; i += NTHREADS) { const int li = i >> 2, r = bx_ * 8 + (li & 7) + (li >> 3) * gx_ * 8;
            if (r < nrows) p.pos[r * 4 + (i & 3)] = lbase[p.topi[i - li * 4 + r * 4]] + lrank[i]; }
    }
}
__device__ __forceinline__ float4 ld4px(const float* q) { return *(const float4*)q; }
__device__ __forceinline__ float4 ld4px(const bf16_t* q) { const ushort4 v = *(const ushort4*)q; return make_float4(bf2f(v.x), bf2f(v.y), bf2f(v.z), bf2f(v.w)); }
typedef unsigned short us4v __attribute__((ext_vector_type(4)));
__device__ __forceinline__ us4v pack4(float4 v) { return (us4v){f2bf(v.x), f2bf(v.y), f2bf(v.z), f2bf(v.w)}; }
template <int K> __device__ __forceinline__ pg8::f32x4 mma16(const LAS bf16_t* A, int lda, const LAS bf16_t* Bt, int ldb, pg8::f32x4 acc, int lane) {
    const int r = lane & 15, q = lane >> 4;
    const LAS bf16_t* ap = A + r * lda + 8 * q; const LAS bf16_t* bp = Bt + r * ldb + 8 * q;
#pragma unroll
    for (int k0 = 0; k0 < K; k0 += 32) acc = __builtin_amdgcn_mfma_f32_16x16x32_bf16(*(const LAS pg8::bf16x8*)(ap + k0), *(const LAS pg8::bf16x8*)(bp + k0), acc, 0, 0, 0);
    return acc;
}
constexpr int RLD = 136, RLQ = 72;
__device__ __forceinline__ void mf_retkv(const P& p, LAS unsigned char* lds, int il) {
    int tid = threadIdx.x; asm volatile("" : "+v"(tid));
    int bx_ = (int)blockIdx.x, gx_ = (int)gridDim.x; asm volatile("" : "+s"(bx_), "+s"(gx_));
    const int lane = tid & 63, wave = tid >> 6, r = lane & 15, q = lane >> 4;
    LAS bf16_t* KdT = (LAS bf16_t*)lds; LAS bf16_t* VT = KdT + 64 * RLD;
    for (int u = bx_; u < 16 * RNCH; u += gx_) {
        const int n = u % RNCH, h = (u / RNCH) & 3, b = (u / (RNCH * 4)) & 1, dir = u / (RNCH * 8);
        const float lg = ret_logg(p, il, dir, h);
        __syncthreads();
        for (int idx = tid; idx < 128 * 16; idx += NTHREADS) { const int j = idx >> 4, d4 = idx & 15, row = scan_row(dir, b, n * RC + j);
            const float4 kv = *(const float4*)(p.kr + (size_t)row * 256 + h * 64 + 4 * d4); const float dk = fexp((float)(RC - 1 - j) * lg);
            KdT[(4 * d4 + 0) * RLD + j] = f2bf(kv.x * dk); KdT[(4 * d4 + 1) * RLD + j] = f2bf(kv.y * dk); KdT[(4 * d4 + 2) * RLD + j] = f2bf(kv.z * dk); KdT[(4 * d4 + 3) * RLD + j] = f2bf(kv.w * dk); }
        for (int idx = tid; idx < 128 * 32; idx += NTHREADS) { const int j = idx >> 5, e4 = idx & 31, row = scan_row(dir, b, n * RC + j);
            const float4 vv = ld4px(p.px + (size_t)row * PXLD + 512 + h * 128 + 4 * e4);
            VT[(4 * e4 + 0) * RLD + j] = f2bf(vv.x); VT[(4 * e4 + 1) * RLD + j] = f2bf(vv.y); VT[(4 * e4 + 2) * RLD + j] = f2bf(vv.z); VT[(4 * e4 + 3) * RLD + j] = f2bf(vv.w); }
        __syncthreads();
        float* o = p.rkv + ((((size_t)dir * 2 + b) * RNCH + n) * 4 + h) * 8192;
#pragma unroll
        for (int td = 0; td < 4; ++td) { pg8::f32x4 acc = {0.f, 0.f, 0.f, 0.f};
            acc = mma16<128>(VT + (16 * wave) * RLD, RLD, KdT + (16 * td) * RLD, RLD, acc, lane);
#pragma unroll
            for (int g = 0; g < 4; ++g) o[(size_t)(16 * wave + 4 * q + g) * 64 + 16 * td + r] = acc[g]; }
    }
}
__device__ __forceinline__ void mf_reto(const P& p, LAS unsigned char* lds, int il) {
    int tid = threadIdx.x; asm volatile("" : "+v"(tid));
    int bx_ = (int)blockIdx.x, gx_ = (int)gridDim.x; asm volatile("" : "+s"(bx_), "+s"(gx_));
    const int lane = tid & 63, wave = tid >> 6, r = lane & 15, q = lane >> 4;
    LAS bf16_t* Qs = (LAS bf16_t*)lds; LAS bf16_t* Ks = Qs + 128 * RLQ; LAS bf16_t* ST = Ks + 128 * RLQ; LAS bf16_t* VT = ST + 128 * RLQ; LAS bf16_t* Ps = VT + 128 * RLD;
    for (int u = bx_; u < 16 * RNCH; u += gx_) {
        const int n = u % RNCH, h = (u / RNCH) & 3, b = (u / (RNCH * 4)) & 1, dir = u / (RNCH * 8);
        const float lg = ret_logg(p, il, dir, h);
        const float* Sg = p.rkv + ((((size_t)dir * 2 + b) * RNCH + n) * 4 + h) * 8192;
        __syncthreads();
        for (int idx = tid; idx < 128 * 16; idx += NTHREADS) { const int j = idx >> 4, d4 = idx & 15, row = scan_row(dir, b, n * RC + j);
            const float4 qv = *(const float4*)(p.qr + (size_t)row * 256 + h * 64 + 4 * d4), kv = *(const float4*)(p.kr + (size_t)row * 256 + h * 64 + 4 * d4), sv = *(const float4*)(Sg + (size_t)j * 64 + 4 * d4);
            *(LAS us4v*)(Qs + j * RLQ + 4 * d4) = pack4(qv); *(LAS us4v*)(Ks + j * RLQ + 4 * d4) = pack4(kv); *(LAS us4v*)(ST + j * RLQ + 4 * d4) = pack4(sv); }
        for (int idx = tid; idx < 128 * 32; idx += NTHREADS) { const int j = idx >> 5, e4 = idx & 31, row = scan_row(dir, b, n * RC + j);
            const float4 vv = ld4px(p.px + (size_t)row * PXLD + 512 + h * 128 + 4 * e4);
            VT[(4 * e4 + 0) * RLD + j] = f2bf(vv.x); VT[(4 * e4 + 1) * RLD + j] = f2bf(vv.y); VT[(4 * e4 + 2) * RLD + j] = f2bf(vv.z); VT[(4 * e4 + 3) * RLD + j] = f2bf(vv.w); }
        __syncthreads();
#pragma unroll
        for (int tj = 0; tj < 8; ++tj) { pg8::f32x4 acc = {0.f, 0.f, 0.f, 0.f};
            acc = mma16<64>(Qs + (16 * wave) * RLQ, RLQ, Ks + (16 * tj) * RLQ, RLQ, acc, lane);
            const int j = 16 * tj + r;
#pragma unroll
            for (int g = 0; g < 4; ++g) { const int i = 16 * wave + 4 * q + g; Ps[i * RLD + j] = f2bf(j <= i ? acc[g] * fexp((float)(i - j) * lg) : 0.f); } }
        __syncthreads();
        float dq[4];
#pragma unroll
        for (int g = 0; g < 4; ++g) dq[g] = fexp((float)(16 * wave + 4 * q + g + 1) * lg);
#pragma unroll
        for (int te = 0; te < 8; ++te) { pg8::f32x4 acc = {0.f, 0.f, 0.f, 0.f}, cr = {0.f, 0.f, 0.f, 0.f};
            acc = mma16<128>(Ps + (16 * wave) * RLD, RLD, VT + (16 * te) * RLD, RLD, acc, lane);
            cr = mma16<64>(Qs + (16 * wave) * RLQ, RLQ, ST + (16 * te) * RLQ, RLQ, cr, lane);
#pragma unroll
            for (int g = 0; g < 4; ++g) { const int i = 16 * wave + 4 * q + g, row = scan_row(dir, b, n * RC + i);
                p.oret[((size_t)dir * NTOK + row) * 512 + h * 128 + 16 * te + r] = acc[g] + dq[g] * cr[g]; } }
    }
}
template <bool FILL> __device__ __forceinline__ void mf_s5(const P& p, LAS unsigned char* lds, int il) {
    int tid = threadIdx.x; asm volatile("" : "+v"(tid));
    int bx_ = (int)blockIdx.x, gx_ = (int)gridDim.x; asm volatile("" : "+s"(bx_), "+s"(gx_));
    const int lane = tid & 63, wave = tid >> 6, r = lane & 15, q = lane >> 4;
    constexpr int LDU = 40, LDS_ = 132, LDB = 136;
    LAS bf16_t* Bt = (LAS bf16_t*)lds;
    LAS bf16_t* Ct = Bt + 128 * LDU;
    LAS unsigned char* wb = lds + 16384 + wave * 14336;
    LAS bf16_t* U = (LAS bf16_t*)wb;
    LAS float* SL = (LAS float*)(wb + 1280);
    LAS bf16_t* Sb = (LAS bf16_t*)(wb + 1280 + 8448);
    constexpr int GRP = (2 * S5NCH) / 8;
    static_assert((2 * S5NCH) % 8 == 0, "chunk count");
    for (int bu = bx_; bu < 64 * GRP; bu += gx_) {
        const int dg = bu / GRP, grp = bu % GRP, dir = dg >> 5, g = dg & 31;
        __syncthreads();
        if (tid < 64) { S5Par sp; s5_par(p, il, dir, g, tid, sp);
#pragma unroll
            for (int h = 0; h < 16; ++h) { Bt[(2 * tid) * LDU + h] = f2bf(sp.bbr[h]); Bt[(2 * tid + 1) * LDU + h] = f2bf(sp.bbi[h]); Bt[(2 * tid) * LDU + 16 + h] = 0; Bt[(2 * tid + 1) * LDU + 16 + h] = 0;
                const long ci = (((long)(il * 2 + dir) * NG + g) * GH + h) * NP + tid; Ct[h * LDB + 2 * tid] = f2bf(p.s5_cre[ci]); Ct[h * LDB + 2 * tid + 1] = f2bf(-p.s5_cim[ci]); } }
        float lbr, lbi; { const int gi = (il * 2 + dir) * NG + g; const float lre = fminf(p.s5_lre[gi * NP + lane], -1e-4f), lim = p.s5_lim[gi * NP + lane], dt = expf(p.s5_ldt[gi]);
            const float mag = expf(lre * dt); lbr = mag * cosf(lim * dt); lbi = mag * sinf(lim * dt); }
        __syncthreads();
        const int bc = grp * 8 + wave, b = bc / S5NCH, ch = bc % S5NCH;
        float* ce = p.s5c + ((((size_t)dir * 2 + b) * S5NCH + ch) * NG + g) * NP * 2 + lane * 2;
        float sr = 0.f, si = 0.f;
        if (FILL) { sr = ce[0]; si = ce[1]; }
        float4 uvs[S5C / 16];
#pragma unroll
        for (int sb = 0; sb < S5C / 16; ++sb) { const int k = lane >> 2, h4 = (lane & 3) * 4, row = scan_row(dir, b, ch * S5C + sb * 16 + k);
            uvs[sb] = ld4px(p.px + (size_t)row * PXLD + 1536 + g * GH + h4); }
#pragma unroll
        for (int sb = 0; sb < S5C / 16; ++sb) {
            { const int k = lane >> 2, h4 = (lane & 3) * 4;
              *(LAS us4v*)(U + k * LDU + h4) = pack4(uvs[sb]); *(LAS us4v*)(U + k * LDU + 16 + h4) = (us4v){0, 0, 0, 0}; }
            asm volatile("s_waitcnt lgkmcnt(0)" ::: "memory");
#pragma unroll
            for (int tc = 0; tc < 8; ++tc) { pg8::f32x4 acc = {0.f, 0.f, 0.f, 0.f};
                acc = mma16<32>(U, LDU, Bt + (16 * tc) * LDU, LDU, acc, lane);
#pragma unroll
                for (int gq = 0; gq < 4; ++gq) SL[(4 * q + gq) * LDS_ + 16 * tc + r] = acc[gq]; }
            asm volatile("s_waitcnt lgkmcnt(0)" ::: "memory");
#pragma unroll
            for (int k = 0; k < 16; ++k) { const float br = SL[k * LDS_ + 2 * lane], bi = SL[k * LDS_ + 2 * lane + 1];
                const float tr = lbr * sr - lbi * si + br, ti = lbr * si + lbi * sr + bi; sr = tr; si = ti;
                if (FILL) { Sb[k * LDB + 2 * lane] = f2bf(sr); Sb[k * LDB + 2 * lane + 1] = f2bf(si); } }
            if (FILL) {
                asm volatile("s_waitcnt lgkmcnt(0)" ::: "memory");
                pg8::f32x4 acc = {0.f, 0.f, 0.f, 0.f};
                acc = mma16<128>(Sb, LDB, Ct, LDB, acc, lane);
#pragma unroll
                for (int gq = 0; gq < 4; ++gq) { const int row = scan_row(dir, b, ch * S5C + sb * 16 + 4 * q + gq); p.yd[((size_t)dir * NTOK + row) * S5W + g * GH + r] = acc[gq]; }
            }
            asm volatile("s_waitcnt lgkmcnt(0)" ::: "memory");
        }
        if (!FILL) { ce[0] = sr; ce[1] = si; }
    }
}
__device__ __forceinline__ void mf_swa(const P& p, LAS unsigned char* lds, int il, bool with_ctx) {
    int tid = threadIdx.x; asm volatile("" : "+v"(tid));
    int bx_ = (int)blockIdx.x, gx_ = (int)gridDim.x; asm volatile("" : "+s"(bx_), "+s"(gx_));
    const int lane = tid & 63, wave = tid >> 6, r = lane & 15, q = lane >> 4;
    constexpr int LDK = 72;
    LAS bf16_t* Ks = (LAS bf16_t*)lds;
    LAS bf16_t* VT = Ks + 64 * LDK;
    LAS bf16_t* Pw = VT + 64 * LDK + wave * 64 * LDK;
    constexpr int NQB = SEQ / 128, NLATU = 4 * NQB, NCTXU = 4 * (CTXL / 128);
    const int nunits = NLATU + (with_ctx ? NCTXU : 0);
    for (int u = bx_; u < nunits; u += gx_) {
        int b, kv, qb, isctx;
        if (u < NLATU) { isctx = 0; qb = u % NQB; kv = (u / NQB) & 1; b = u / (NQB * 2); }
        else { const int v = u - NLATU; isctx = 1; qb = v % (CTXL / 128); kv = (v / (CTXL / 128)) & 1; b = v / ((CTXL / 128) * 2); }
        const int g = wave >> 1, hq = kv * 4 + g, i0 = (wave & 1) * 64;
        const int qrow0 = (isctx ? NLAT + b * CTXL : b * SEQ) + qb * 128 + i0;
        pg8::bf16x8 qf[4][2];
#pragma unroll
        for (int tq = 0; tq < 4; ++tq)
#pragma unroll
            for (int ks = 0; ks < 2; ++ks) { const float* src = p.qs + (size_t)(qrow0 + 16 * tq + r) * 512 + hq * 64 + 32 * ks + 8 * q;
                const float4 a = *(const float4*)src, c = *(const float4*)(src + 4);
                qf[tq][ks] = (pg8::bf16x8){(short)f2bf(a.x), (short)f2bf(a.y), (short)f2bf(a.z), (short)f2bf(a.w), (short)f2bf(c.x), (short)f2bf(c.y), (short)f2bf(c.z), (short)f2bf(c.w)}; }
        pg8::f32x4 oacc[4][4];
        float mrow[4][4], lrow[4][4];
        const float sink = p.swa_sink[il * 8 + hq];
#pragma unroll
        for (int tq = 0; tq < 4; ++tq)
#pragma unroll
            for (int x = 0; x < 4; ++x) { oacc[tq][x] = (pg8::f32x4){0.f, 0.f, 0.f, 0.f}; mrow[tq][x] = sink; lrow[tq][x] = 1.0f; }
        const int ntile = isctx ? 4 : 10;
        for (int t = 0; t < ntile; ++t) {
            const bool loc = !isctx && t < 6;
            const int kpos0 = loc ? 128 * (qb - 1) + 64 * t : 0;
            if (loc && (kpos0 < 0 || kpos0 >= SEQ)) continue;
            const int krow0 = loc ? b * SEQ + kpos0 : NLAT + b * CTXL + 64 * (isctx ? t : t - 6);
            __syncthreads();
            for (int idx = tid; idx < 64 * 16; idx += NTHREADS) { const int key = idx >> 4, d4 = idx & 15;
                const float4 kk = *(const float4*)(p.ks + (size_t)(krow0 + key) * 128 + kv * 64 + 4 * d4), vv = ld4px(p.px + (size_t)(krow0 + key) * PXLD + 2176 + kv * 64 + 4 * d4);
                *(LAS us4v*)(Ks + key * LDK + 4 * d4) = pack4(kk);
                VT[(4 * d4 + 0) * LDK + key] = f2bf(vv.x); VT[(4 * d4 + 1) * LDK + key] = f2bf(vv.y); VT[(4 * d4 + 2) * LDK + key] = f2bf(vv.z); VT[(4 * d4 + 3) * LDK + key] = f2bf(vv.w); }
            __syncthreads();
            pg8::f32x4 sc[4][4];
#pragma unroll
            for (int tk = 0; tk < 4; ++tk) { const LAS bf16_t* kp = Ks + (16 * tk + r) * LDK + 8 * q;
                const pg8::bf16x8 k0 = *(const LAS pg8::bf16x8*)kp, k1 = *(const LAS pg8::bf16x8*)(kp + 32);
#pragma unroll
                for (int tq = 0; tq < 4; ++tq) { pg8::f32x4 a = {0.f, 0.f, 0.f, 0.f};
                    a = __builtin_amdgcn_mfma_f32_16x16x32_bf16(qf[tq][0], k0, a, 0, 0, 0); a = __builtin_amdgcn_mfma_f32_16x16x32_bf16(qf[tq][1], k1, a, 0, 0, 0); sc[tq][tk] = a; } }
            if (loc) {
#pragma unroll
                for (int tq = 0; tq < 4; ++tq)
#pragma unroll
                    for (int tk = 0; tk < 4; ++tk)
#pragma unroll
                        for (int x = 0; x < 4; ++x) { const int dlt = (kpos0 + 16 * tk + r) - (128 * qb + i0 + 16 * tq + 4 * q + x); if (dlt > 128 || dlt < -128) sc[tq][tk][x] = -1e30f; }
            }
#pragma unroll
            for (int tq = 0; tq < 4; ++tq)
#pragma unroll
                for (int x = 0; x < 4; ++x) {
                    float mx = fmaxf(fmaxf(sc[tq][0][x], sc[tq][1][x]), fmaxf(sc[tq][2][x], sc[tq][3][x]));
                    mx = row16_max(mx);
                    const float mn = fmaxf(mrow[tq][x], mx), corr = __expf(mrow[tq][x] - mn);
                    float sum = 0.f;
#pragma unroll
                    for (int tk = 0; tk < 4; ++tk) { const float pe = __expf(sc[tq][tk][x] - mn); sum += pe; Pw[(16 * tq + 4 * q + x) * LDK + 16 * tk + r] = f2bf(pe); }
                    sum = row16_sum(sum);
                    lrow[tq][x] = lrow[tq][x] * corr + sum; mrow[tq][x] = mn;
#pragma unroll
                    for (int td = 0; td < 4; ++td) oacc[tq][td][x] *= corr;
                }
            asm volatile("s_waitcnt lgkmcnt(0)" ::: "memory");
#pragma unroll
            for (int td = 0; td < 4; ++td) { const LAS bf16_t* vp = VT + (16 * td + r) * LDK + 8 * q;
                const pg8::bf16x8 v0 = *(const LAS pg8::bf16x8*)vp, v1 = *(const LAS pg8::bf16x8*)(vp + 32);
#pragma unroll
                for (int tq = 0; tq < 4; ++tq) { const LAS bf16_t* pp = Pw + (16 * tq + r) * LDK + 8 * q;
                    oacc[tq][td] = __builtin_amdgcn_mfma_f32_16x16x32_bf16(*(const LAS pg8::bf16x8*)pp, v0, oacc[tq][td], 0, 0, 0);
                    oacc[tq][td] = __builtin_amdgcn_mfma_f32_16x16x32_bf16(*(const LAS pg8::bf16x8*)(pp + 32), v1, oacc[tq][td], 0, 0, 0); } }
        }
#pragma unroll
        for (int tq = 0; tq < 4; ++tq)
#pragma unroll
            for (int x = 0; x < 4; ++x) { const float inv = 1.0f / lrow[tq][x]; bf16_t* o = p.mixb + (size_t)(qrow0 + 16 * tq + 4 * q + x) * D + 512 + hq * 64 + r;
#pragma unroll
                for (int td = 0; td < 4; ++td) o[16 * td] = f2bf(oacc[tq][td][x] * inv); }
    }
}
__device__ __forceinline__ void mf_sconv(const P& p, LAS unsigned char* lds, int il) {
    int tid = threadIdx.x; asm volatile("" : "+v"(tid));
    int bx_ = (int)blockIdx.x, gx_ = (int)gridDim.x; asm volatile("" : "+s"(bx_), "+s"(gx_));
    LAS float* T = (LAS float*)lds;
    const float* sw = p.hy_short_w + il * 3 * 1536; const float* sb = p.hy_short_b + il * 1536;
    constexpr int NT = (NTOK / 64) * (HYW / 64);
    for (int t = bx_; t < NT; t += gx_) {
        const int r0 = (t / (HYW / 64)) * 64, c0 = (t % (HYW / 64)) * 64;
        const int rl = tid >> 3, cs = (tid & 7) * 8, r = r0 + rl; const RowInfo ri = row_info(r);
        float u[3][8];
#pragma unroll
        for (int g = 0; g < 3; ++g) { const int col = g * HYW + c0 + cs; const float4 b0 = *(const float4*)(sb + col), b1 = *(const float4*)(sb + col + 4);
            u[g][0] = b0.x; u[g][1] = b0.y; u[g][2] = b0.z; u[g][3] = b0.w; u[g][4] = b1.x; u[g][5] = b1.y; u[g][6] = b1.z; u[g][7] = b1.w;
#pragma unroll
            for (int j = 0; j < 3; ++j) { const int tt = ri.t + j - 1; if (tt >= 0 && tt < ri.len) { const px_t* px = p.px + (size_t)(ri.base + tt) * PXLD + col; const float* wj = sw + j * 1536 + col;
                const float4 x0 = ld4px(px), x1 = ld4px(px + 4), w0 = *(const float4*)wj, w1 = *(const float4*)(wj + 4);
                u[g][0] += w0.x * x0.x; u[g][1] += w0.y * x0.y; u[g][2] += w0.z * x0.z; u[g][3] += w0.w * x0.w; u[g][4] += w1.x * x1.x; u[g][5] += w1.y * x1.y; u[g][6] += w1.z * x1.z; u[g][7] += w1.w * x1.w; } } }
        float z[8];
#pragma unroll
        for (int k = 0; k < 8; ++k) z[k] = u[2][k] * u[1][k];
        const size_t i = (size_t)r * HYW + c0 + cs;
        *(float4*)(p.x0c + i) = make_float4(u[0][0], u[0][1], u[0][2], u[0][3]); *(float4*)(p.x0c + i + 4) = make_float4(u[0][4], u[0][5], u[0][6], u[0][7]);
        *(float4*)(p.zb + i) = make_float4(z[0], z[1], z[2], z[3]); *(float4*)(p.zb + i + 4) = make_float4(z[4], z[5], z[6], z[7]);
        if (r0 < NLAT) {
            __syncthreads();
#pragma unroll
            for (int k = 0; k < 8; ++k) T[(cs + k) * 65 + rl] = z[k];
            __syncthreads();
            const int cl = tid >> 3, rs = (tid & 7) * 8; const LAS float* src = T + cl * 65 + rs; float* dst = p.zT + (size_t)(c0 + cl) * NLAT + r0 + rs;
            *(float4*)dst = make_float4(src[0], src[1], src[2], src[3]); *(float4*)(dst + 4) = make_float4(src[4], src[5], src[6], src[7]);
        }
    }
}
__device__ __forceinline__ void mf_filter_tiles(const P& p, LAS unsigned char* lds) {
    int tid = threadIdx.x; asm volatile("" : "+v"(tid));
    int bx_ = (int)blockIdx.x, gx_ = (int)gridDim.x; asm volatile("" : "+s"(bx_), "+s"(gx_));
    LAS float* A1 = (LAS float*)lds; LAS float* A2 = A1 + 64 * 65; LAS float* T = A2 + 64 * 65;
    constexpr int RT = (SEQ + CTXL) / 64;
    const int rl = tid >> 3, cs = (tid & 7) * 8;
    constexpr int NLT = 2 * (SEQ / 64), NCT = 2 * (CTXL / 64), NITEM = NLT + NCT * (HYW / 64);
    for (int it = bx_; it < NITEM; it += gx_) {
        int t, ct0, ct1;
        if (it < NLT) { t = (it / (SEQ / 64)) * RT + it % (SEQ / 64); ct0 = 0; ct1 = HYW / 64; }
        else { const int v = it - NLT, tc = v / (HYW / 64); t = (tc / (CTXL / 64)) * RT + SEQ / 64 + tc % (CTXL / 64); ct0 = v % (HYW / 64); ct1 = ct0 + 1; }
        const int i = t / RT, rt = t % RT, q0 = rt * 64, kind = q0 >= SEQ, L = kind ? CTXL : SEQ, q = q0 + rl, pos = kind ? q - SEQ : q;
        const long rr = (long)i * (SEQ + CTXL) + q;
        __syncthreads();
        {
            const float* w1 = p.hy_f_w1 + i * 33 * 64 + cs; const float tt = (float)pos / (float)L, w = 6.283185307179586f * (float)pos / (float)L;
            float acc[8];
#pragma unroll
            for (int k = 0; k < 8; ++k) acc[k] = tt * w1[k];
            for (int bi = 0; bi < 16; ++bi) { const float band = 1e-4f + (float)bi * ((15.0f - 1e-4f) / 15.0f), cc = ROPE_COS(band * w), sn = ROPE_SIN(band * w);
                const float* wc = w1 + (1 + bi) * 64; const float* ws = w1 + (17 + bi) * 64;
#pragma unroll
                for (int k = 0; k < 8; ++k) acc[k] += cc * wc[k] - sn * ws[k]; }
#pragma unroll
            for (int k = 0; k < 8; ++k) A1[rl * 65 + cs + k] = ROPE_SIN(acc[k] + p.hy_f_b1[i * 64 + cs + k]);
        }
        __syncthreads();
        {
            const float* w2 = p.hy_f_w2 + i * 64 * 64 + cs; float acc[8];
#pragma unroll
            for (int k = 0; k < 8; ++k) acc[k] = 0.f;
            for (int kk = 0; kk < 64; ++kk) { const float hv = A1[rl * 65 + kk]; const float4 a = *(const float4*)(w2 + kk * 64), b4 = *(const float4*)(w2 + kk * 64 + 4);
                acc[0] += hv * a.x; acc[1] += hv * a.y; acc[2] += hv * a.z; acc[3] += hv * a.w; acc[4] += hv * b4.x; acc[5] += hv * b4.y; acc[6] += hv * b4.z; acc[7] += hv * b4.w; }
#pragma unroll
            for (int k = 0; k < 8; ++k) A2[rl * 65 + cs + k] = ROPE_SIN(acc[k] + p.hy_f_b2[i * 64 + cs + k]);
        }
        __syncthreads();
        const float lag = fabsf((float)(pos - L / 2)) / (float)(L / 2);
        for (int ct = ct0; ct < ct1; ++ct) {
            const int c0 = ct * 64; const float* w3 = p.hy_f_w3 + (size_t)i * 64 * HYW + c0 + cs;
            float acc[8];
#pragma unroll
            for (int k = 0; k < 8; ++k) acc[k] = 0.f;
            for (int kk = 0; kk < 64; ++kk) { const float hv = A2[rl * 65 + kk]; const float4 a = *(const float4*)(w3 + (size_t)kk * HYW), b4 = *(const float4*)(w3 + (size_t)kk * HYW + 4);
                acc[0] += hv * a.x; acc[1] += hv * a.y; acc[2] += hv * a.z; acc[3] += hv * a.w; acc[4] += hv * b4.x; acc[5] += hv * b4.y; acc[6] += hv * b4.z; acc[7] += hv * b4.w; }
            const float fast = -15.350567286626973f, slow = -3.0701134573253946f;
#pragma unroll
            for (int k = 0; k < 8; ++k) { const float delta = fabsf(fast + (slow - fast) * (float)(c0 + cs + k) / 511.0f); acc[k] *= fexp(-lag * delta) + 0.05f; }
            float* o = p.hraw + rr * HYW + c0 + cs;
            *(float4*)o = make_float4(acc[0], acc[1], acc[2], acc[3]); *(float4*)(o + 4) = make_float4(acc[4], acc[5], acc[6], acc[7]);
            __syncthreads();
#pragma unroll
            for (int k = 0; k < 8; ++k) T[(cs + k) * 65 + rl] = acc[k];
            __syncthreads();
            const int cl = tid >> 3, rs = (tid & 7) * 8; const LAS float* src = T + cl * 65 + rs;
            float v8[8];
#pragma unroll
            for (int k = 0; k < 8; ++k) v8[k] = src[k];
            if (!kind) { float* dst = p.hT + ((size_t)i * HYW + c0 + cl) * SEQ + q0 + rs;
                *(float4*)dst = make_float4(v8[0], v8[1], v8[2], v8[3]); *(float4*)(dst + 4) = make_float4(v8[4], v8[5], v8[6], v8[7]); }
            float sa = 0.f;
#pragma unroll
            for (int k = 0; k < 8; ++k) sa += fabsf(v8[k]);
            sa += __shfl_xor(sa, 1); sa += __shfl_xor(sa, 2); sa += __shfl_xor(sa, 4);
            if ((tid & 7) == 0) p.hpart[(size_t)t * HYW + c0 + cl] = sa;
        }
    }
}
__device__ __forceinline__ void mf_hymix(const P& p, LAS unsigned char* lds, int il) {
    int tid = threadIdx.x; asm volatile("" : "+v"(tid));
    int bx_ = (int)blockIdx.x, gx_ = (int)gridDim.x; asm volatile("" : "+s"(bx_), "+s"(gx_));
    LAS float* T = (LAS float*)lds;
    constexpr int NT = (NLAT / 64) * (HYW / 64);
    for (int t = bx_; t < NT; t += gx_) {
        const int r0 = (t / (HYW / 64)) * 64, c0 = (t % (HYW / 64)) * 64;
        __syncthreads();
        { const int cl = tid >> 3, rs = (tid & 7) * 8; const float* src = p.convT + (size_t)(c0 + cl) * NLAT + r0 + rs; const float4 a = *(const float4*)src, b = *(const float4*)(src + 4);
          LAS float* d = T + cl * 65 + rs; d[0] = a.x; d[1] = a.y; d[2] = a.z; d[3] = a.w; d[4] = b.x; d[5] = b.y; d[6] = b.z; d[7] = b.w; }
        __syncthreads();
        { const int rl = tid >> 3, cs = (tid & 7) * 8; const size_t i = (size_t)(r0 + rl) * HYW + c0 + cs;
          const float4 z0 = *(const float4*)(p.zb + i), z1 = *(const float4*)(p.zb + i + 4), x0 = *(const float4*)(p.x0c + i), x1 = *(const float4*)(p.x0c + i + 4);
          const float4 b0 = *(const float4*)(p.hy_bias + il * HYW + c0 + cs), b1 = *(const float4*)(p.hy_bias + il * HYW + c0 + cs + 4);
          const float zz[8] = {z0.x, z0.y, z0.z, z0.w, z1.x, z1.y, z1.z, z1.w}, xx[8] = {x0.x, x0.y, x0.z, x0.w, x1.x, x1.y, x1.z, x1.w}, bb[8] = {b0.x, b0.y, b0.z, b0.w, b1.x, b1.y, b1.z, b1.w};
          unsigned short o[8];
#pragma unroll
          for (int k = 0; k < 8; ++k) o[k] = f2bf(xx[k] * (T[(cs + k) * 65 + rl] + bb[k] * zz[k]));
          uint4 ov; ov.x = o[0] | ((unsigned)o[1] << 16); ov.y = o[2] | ((unsigned)o[3] << 16); ov.z = o[4] | ((unsigned)o[5] << 16); ov.w = o[6] | ((unsigned)o[7] << 16);
          *(uint4*)(p.mixb + (size_t)(r0 + rl) * D + c0 + cs) = ov; }
    }
}
__device__ __forceinline__ void mf_retout(const P& p, int nrows) {
    int tid = threadIdx.x; asm volatile("" : "+v"(tid));
    int bx_ = (int)blockIdx.x, gx_ = (int)gridDim.x; asm volatile("" : "+s"(bx_), "+s"(gx_));
    const int lane = tid & 63, wave = tid >> 6;
    for (int r = bx_ * 8 + wave; r < nrows; r += gx_ * 8) {
        const float* o0 = p.oret + (size_t)r * 512 + 8 * lane; const float* o1 = p.oret + ((size_t)NTOK + r) * 512 + 8 * lane; const px_t* gp = p.px + (size_t)r * PXLD + 1024 + 8 * lane;
        const float4 a0 = *(const float4*)o0, a1 = *(const float4*)(o0 + 4), b0 = *(const float4*)o1, b1 = *(const float4*)(o1 + 4), g0 = ld4px(gp), g1 = ld4px(gp + 4);
        const float o[8] = {a0.x + b0.x, a0.y + b0.y, a0.z + b0.z, a0.w + b0.w, a1.x + b1.x, a1.y + b1.y, a1.z + b1.z, a1.w + b1.w}, gg[8] = {g0.x, g0.y, g0.z, g0.w, g1.x, g1.y, g1.z, g1.w};
        float ss = 0.f;
#pragma unroll
        for (int k = 0; k < 8; ++k) ss += o[k] * o[k];
        ss = row16_sum(ss);
        const float rs = rsqrtf(ss * (1.0f / 128.0f) + EPS);
        unsigned short ob[8];
#pragma unroll
        for (int k = 0; k < 8; ++k) ob[k] = f2bf(o[k] * rs * siluf_(gg[k]));
        uint4 ov; ov.x = ob[0] | ((unsigned)ob[1] << 16); ov.y = ob[2] | ((unsigned)ob[3] << 16); ov.z = ob[4] | ((unsigned)ob[5] << 16); ov.w = ob[6] | ((unsigned)ob[7] << 16);
        *(uint4*)(p.mixb + (size_t)r * D + 8 * lane) = ov;
    }
}
__device__ __forceinline__ void mf_lconv(const P& p, LAS unsigned char* lds, int il) {
    int tid = threadIdx.x; asm volatile("" : "+v"(tid));
    int bx_ = (int)blockIdx.x, gx_ = (int)gridDim.x; asm volatile("" : "+s"(bx_), "+s"(gx_));
    for (int c = bx_; c < HYW; c += gx_) lconv_unit(p, il, c, (LAS CX*)lds, p.zf + (size_t)bx_ * 2 * FFTN, tid, NTHREADS);
}
__device__ __forceinline__ void mf_inproj(const P& p, LAS unsigned char* lds, int layer) {
    const int il = layer >> 1; const bool ab = !(layer & 1);
    pg8::Gemm g{p.hxb, ab ? p.abin_t + (size_t)il * AB_IN * D : p.cdin_t + (size_t)il * CD_IN * D, NTOK, ab ? AB_IN : CD_IN, D, 0};
    int gx_ = (int)gridDim.x, bx_ = (int)blockIdx.x; asm volatile("" : "+s"(gx_), "+s"(bx_));
    pg8::StaticOrder S; S.init(g.M, g.N, gx_, bx_);
    pg8::EpiStoreBf16 E{p.px, PXLD};
    pg8::gemm_phase(lds, g, S, E);
}
__device__ __forceinline__ void mf_outproj(const P& p, LAS unsigned char* lds, int layer, int nrows) {
    const int il = layer >> 1; const bool ab = !(layer & 1);
    pg8::Gemm g{p.mixb, (ab ? p.about_t : p.cdout_t) + (size_t)il * D * D, nrows, D, D, 0};
    int gx_ = (int)gridDim.x, bx_ = (int)blockIdx.x; asm volatile("" : "+s"(gx_), "+s"(bx_));
    pg8::StaticOrder S; S.init(g.M, g.N, gx_, bx_);
    pg8::EpiResid E{p.xa, p.modv + (size_t)layer * 3 * 6 * D + 2 * D};
    pg8::gemm_phase(lds, g, S, E);
}
__device__ __forceinline__ void mf_glu(const P& p, LAS unsigned char* lds, int il) {
    pg8::Gemm g{p.ys5b, p.glu_t + (size_t)il * S5W * S5W, NTOK, S5W, S5W, 0};
    int gx_ = (int)gridDim.x, bx_ = (int)blockIdx.x; asm volatile("" : "+s"(gx_), "+s"(bx_));
    pg8::StaticOrder S; S.init(g.M, g.N, gx_, bx_);
    pg8::EpiGlu E{p.mixb, p.ys5b, p.s5_glu_b + il * S5W};
    pg8::gemm_phase(lds, g, S, E);
}
__device__ __forceinline__ int build_ue(const P& p, LAS unsigned char* lds, int layer) {
    volatile LAS unsigned char* ue = (volatile LAS unsigned char*)(lds + UE_OFF); volatile LAS int* tot = (volatile LAS int*)(lds + MISC_OFF + 16);
    __syncthreads();
    if (threadIdx.x == 0) { const int* cnt = p.cnt + layer * NE; int t = 0;
        for (int e = 0; e < NE; ++e) { const int nt = (cnt[e] + 255) >> 8; for (int q = 0; q < nt; ++q) ue[t + q] = (unsigned char)e; t += nt; }
        *tot = t; }
    __syncthreads();
    return *tot;
}
__device__ __forceinline__ void mf_moe1(const P& p, LAS unsigned char* lds, int layer) {
    const int tiles = build_ue(p, lds, layer);
    int gx_ = (int)gridDim.x, bx_ = (int)blockIdx.x; asm volatile("" : "+s"(gx_), "+s"(bx_));
    pg8::MoeOrder S{tiles * 8, 8, gx_, bx_, (const volatile LAS unsigned char*)(lds + UE_OFF), (const volatile LAS int*)(lds + TOK_OFF)};
    volatile LAS int* tokt = (volatile LAS int*)(lds + TOK_OFF);
    { int tid = threadIdx.x; asm volatile("" : "+v"(tid));
      for (int i = 0; i < TOK_UNITS; ++i) { int pm, pn; if (!S.unit(i, pm, pn)) break;
          for (int t = tid; t < 256; t += NTHREADS) { const int tk = p.slot_tok[pm * 256 + t]; tokt[i * 256 + t] = tk < 0 ? NTOK : tk; } }
      __syncthreads(); }
    pg8::Gemm g{p.hxb, p.wgu_t + (size_t)layer * NE * 2 * DFF * D, tiles * 256, 2 * DFF, D, (size_t)2 * DFF * D * 2};
    pg8::EpiSwiglu E{p.actb, p.b_gu + (size_t)layer * NE * 2 * DFF};
    pg8::gemm_phase<pg8::EpiSwiglu, pg8::MoeOrder, true>(lds, g, S, E);
}
__device__ __forceinline__ void mf_moe2(const P& p, LAS unsigned char* lds, int layer) {
    const int tiles = build_ue(p, lds, layer);
    pg8::Gemm g{p.actb, p.wdn_t + (size_t)layer * NE * D * DFF, tiles * 256, D, DFF, (size_t)D * DFF * 2};
    int gx_ = (int)gridDim.x, bx_ = (int)blockIdx.x; asm volatile("" : "+s"(gx_), "+s"(bx_));
    pg8::MoeOrder S{tiles * 4, 4, gx_, bx_, (const volatile LAS unsigned char*)(lds + UE_OFF), nullptr};
    pg8::EpiDown E{p.yb, p.b_dn + (size_t)layer * NE * D, p.slot_gate};
    pg8::gemm_phase(lds, g, S, E);
}

#define XB_TMO      128
#define XB_XCNT(j)  (256  + 64 * (j))
#define XB_XSUB(j)  (1280 + 64 * (j))
#define XB_XGEN(j)  (2304 + 64 * (j))
#define XB_TOP      3328
#define XB_TOPGEN   3392
#define XCD_BAR_WORDS 3456
#define XB_SPIN_CAP (1u << 18)

__device__ __forceinline__ unsigned xb_ld(unsigned* p)              { return __hip_atomic_load(p, __ATOMIC_RELAXED, __HIP_MEMORY_SCOPE_AGENT); }
__device__ __forceinline__ unsigned xb_add(unsigned* p, unsigned v) { return __hip_atomic_fetch_add(p, v, __ATOMIC_RELAXED, __HIP_MEMORY_SCOPE_AGENT); }
__device__ __forceinline__ unsigned xb_xcc_id() { return (unsigned)__builtin_amdgcn_s_getreg((3 << 11) | 20) & 0xFu; }
#define XB_SPIN(cond, bar) do { unsigned _sp = 0; while (cond) { __builtin_amdgcn_s_sleep(1); \
    if ((++_sp & 255u) == 0u) { if (xb_ld(&(bar)[XB_TMO])) break; if (_sp > XB_SPIN_CAP) { atomicAdd(&(bar)[XB_TMO], 1u); break; } } } } while (0)

struct XcdBarrier { unsigned* bar; unsigned x; volatile LAS unsigned* st; };

__device__ __forceinline__ XcdBarrier xcd_barrier_post(unsigned* bar, volatile LAS unsigned* st) {
    XcdBarrier b; b.bar = bar; b.x = xb_xcc_id(); b.st = st;
    if (threadIdx.x == 0) (void)xb_add(&bar[XB_XCNT(b.x)], 1u);
    return b;
}
__device__ __forceinline__ void xcd_barrier_complete(unsigned* bar, unsigned x, unsigned& nloc, unsigned& nx) {
    const unsigned G = gridDim.x * gridDim.y * gridDim.z;
    unsigned sum, cnt, mine, sp = 0u;
    asm volatile("" : "+s"(x));
    for (;;) {
        sum = 0u; cnt = 0u; mine = 0u;
#pragma unroll
        for (unsigned j = 0; j < 16; ++j) { const unsigned c = xb_ld(&bar[XB_XCNT(j)]); sum += c; cnt += (c > 0u) ? 1u : 0u; mine = (j == x) ? c : mine; }
        if (sum == G) break;
        __builtin_amdgcn_s_sleep(1);
        if ((++sp & 255u) == 0u) { if (xb_ld(&bar[XB_TMO])) break; if (sp > XB_SPIN_CAP) { atomicAdd(&bar[XB_TMO], 1u); break; } }
    }
    nloc = mine > 0u ? mine : 1u; nx = cnt > 0u ? cnt : 1u;
}
__device__ __forceinline__ void xcd_barrier(const XcdBarrier& b) {
    asm volatile("s_waitcnt vmcnt(0)" ::: "memory");
    __syncthreads();
    if (threadIdx.x == 0) {
        unsigned* bar = b.bar; unsigned bx = b.x;
        asm volatile("" : "+s"(bar), "+s"(bx));
        __builtin_amdgcn_s_waitcnt(0);
        unsigned nloc = b.st[0], nx = b.st[1];
        if (nloc == 0u) { xcd_barrier_complete(bar, bx, nloc, nx); b.st[0] = nloc; b.st[1] = nx; }
        const unsigned old = xb_add(&bar[XB_XSUB(bx)], 1u);
        const unsigned gen = old / nloc;
        if (old + 1u == (gen + 1u) * nloc) {
            __builtin_amdgcn_fence(__ATOMIC_RELEASE, "agent");
            asm volatile("s_waitcnt vmcnt(0)" ::: "memory");
            const unsigned og = xb_add(&bar[XB_TOP], 1u);
            const unsigned tg = og / nx;
            if (og + 1u == (tg + 1u) * nx) xb_add(&bar[XB_TOPGEN], 1u);
            else XB_SPIN(xb_ld(&bar[XB_TOPGEN]) == tg, bar);
            __builtin_amdgcn_fence(__ATOMIC_ACQUIRE, "agent");
            xb_add(&bar[XB_XGEN(bx)], 1u);
            asm volatile("s_waitcnt vmcnt(0)" ::: "memory");
        } else {
            XB_SPIN(xb_ld(&bar[XB_XGEN(bx)]) == gen, bar);
            __builtin_amdgcn_fence(__ATOMIC_ACQUIRE, "agent");
            asm volatile("s_waitcnt vmcnt(0)" ::: "memory");
        }
    }
    __syncthreads();
}

typedef const __attribute__((address_space(4))) P* KP;
__global__ void __launch_bounds__(NTHREADS, 2) fwd_kernel(P p_arg) {
    (void)p_arg;
    const KP kp0 = (KP)__builtin_amdgcn_kernarg_segment_ptr();
#define p (*(const P*)({ KP q_ = kp0; asm volatile("" : "+s"(q_)); q_; }))
    extern __shared__ __attribute__((aligned(16))) unsigned char lds_raw[];
    LAS unsigned char* lds = (LAS unsigned char*)lds_raw;
    for (int u = threadIdx.x; u < (LDS_BYTES - MISC_OFF) / 4; u += NTHREADS) ((LAS unsigned*)(lds + MISC_OFF))[u] = 0u;
    __syncthreads();
    XcdBarrier bar = xcd_barrier_post(p.bar, (volatile LAS unsigned*)(lds + MISC_OFF));
    const long gs = (long)gridDim.x * NTHREADS;
#define gt ({ int b_ = (int)blockIdx.x; asm volatile("" : "+s"(b_)); long g_ = (long)b_ * NTHREADS + threadIdx.x; asm volatile("" : "+v"(g_)); g_; })
#define SETUP(S) setup_slot<S>(p, gt, gs); xcd_barrier(bar);
    for (int rep = 0; rep < REP_SETUP; ++rep) {
    setup_slot<0>(p, gt, gs); mf_filter_tiles(p, lds); __syncthreads(); ph_convert_weights(p, lds); xcd_barrier(bar);
    ph_mod2(p, gt, gs); ph_filt4(p, gt, gs); xcd_barrier(bar);
    }
#define SLOT(S) layer_slot<S>(p, layer, gt, gs); xcd_barrier(bar);
#if MFMA_DENSE
#define DENSE_IN  for (int rep = 0; rep < REP_IN; ++rep) { mf_inproj(p, lds, layer); if (layer < 3) convert_deferred(p, lds, layer, 0); xcd_barrier(bar); }
#define DENSE_OUT if (!(layer & 1)) mf_glu(p, lds, layer >> 1); else ph_retout(p, layer < 3 ? NTOK : NLAT, gt, gs); xcd_barrier(bar); \
                  mf_outproj(p, lds, layer, layer < 3 ? NTOK : NLAT); xcd_barrier(bar);
#else
#define DENSE_IN  SLOT(2)
#define DENSE_OUT SLOT(7) SLOT(8)
#endif
#if MFMA_MOE
#define MOE_GEMMS for (int rep = 0; rep < REP_MOE; ++rep) { mf_moe1(p, lds, layer); xcd_barrier(bar); } for (int rep = 0; rep < REP_MOE2; ++rep) { mf_moe2(p, lds, layer); xcd_barrier(bar); }
#else
#define MOE_GEMMS SLOT(14) SLOT(15)
#endif
#define REPF(n) for (int rep_ = 0; rep_ < (n); ++rep_)
#define LAYER(L) { constexpr int layer = L; constexpr bool AB = !(layer & 1); constexpr int il = layer >> 1; constexpr int nrows = layer < 3 ? NTOK : NLAT; \
    REPF(RN) mf_rownorm<0>(p, lds, layer, NTOK, layer - 1); xcd_barrier(bar); DENSE_IN \
    REPF(R3) { if (AB) { mf_s5<false>(p, lds, il); mf_sconv(p, lds, il); } else ph_rope(p, gt, gs); } xcd_barrier(bar); \
    REPF(R4) { if (AB) { mf_lconv(p, lds, il); ph_lconv(p, il, NLAT, NTOK, gt, gs); } else mf_retkv(p, lds, il); } if (AB) ph_s5carry(p, il, gt, gs); xcd_barrier(bar); \
    REPF(R5) { if (AB) { mf_s5<true>(p, lds, il); mf_hymix(p, lds, il); } else mf_swa(p, lds, il, layer < 3); } if (!AB) ph_retcarry(p, il, gt, gs); xcd_barrier(bar); \
    REPF(R6) { if (AB) ph_s5fin(p, il, gt, gs); else mf_reto(p, lds, il); } xcd_barrier(bar); \
    REPF(R7) { if (AB) mf_glu(p, lds, il); else mf_retout(p, nrows); } xcd_barrier(bar); \
    mf_outproj(p, lds, layer, nrows); if (layer < 3) convert_deferred(p, lds, layer, 1); xcd_barrier(bar); \
    mf_rownorm<1>(p, lds, layer, nrows, -1); xcd_barrier(bar); SLOT(12) MOE_GEMMS }
    LAYER(0) LAYER(1) LAYER(2) LAYER(3)
    mf_rownorm<2>(p, lds, 3, NLAT, 3);
#undef gt
#undef p
}

extern "C" void kernel_launch(void* const* d_in, const int* in_sizes, int n_in, void* d_out, int out_size, void* d_ws, size_t ws_size, hipStream_t stream) {
    (void)in_sizes; (void)n_in; (void)out_size;
    const WsMap m = ws_map();
    if (ws_size < m.total) { fprintf(stderr, "workspace too small: %zu < %zu\n", ws_size, m.total); return; }
    P p; memset(&p, 0, sizeof(p)); fill_params(p, d_in, d_out, d_ws);
    static int grid = 0;
    if (!grid) {
        int dev = 0, cus = 0, per_cu = 0;
        (void)hipGetDevice(&dev); (void)hipDeviceGetAttribute(&cus, hipDeviceAttributeMultiprocessorCount, dev);
        if (hipFuncSetAttribute((const void*)fwd_kernel, hipFuncAttributeMaxDynamicSharedMemorySize, LDS_BYTES) != hipSuccess) { fprintf(stderr, "hipFuncSetAttribute failed\n"); grid = -1; return; }
        (void)hipOccupancyMaxActiveBlocksPerMultiprocessor(&per_cu, (const void*)fwd_kernel, NTHREADS, LDS_BYTES);
        if (per_cu < 1) fprintf(stderr, "occupancy query reports %d blocks per CU\n", per_cu);
        grid = cus;
    }
    if (grid <= 0) return;
    (void)hipMemsetAsync(p.bar, 0, XCD_BAR_WORDS * sizeof(unsigned), stream);
    fwd_kernel<<<dim3(grid), dim3(NTHREADS), LDS_BYTES, stream>>>(p);
}
#endif
```

```cpp
#ifndef CPU_SHIM
#include <hip/hip_runtime.h>
#include <cstring>
#include <cstdio>
#include <cstdint>
#define DEV __device__ __forceinline__
#else
#include <cmath>
#include <cstdio>
#include <cstdint>
#include <cstring>
#include <cstdlib>
#define DEV static inline
static inline float rsqrtf(float x) { return 1.0f / sqrtf(x); }
#endif

#ifndef SEQ
#define SEQ 8192
#endif
#ifndef CTXL
#define CTXL 256
#endif
#ifndef N_LAUNCH_MODE
#define N_LAUNCH_MODE 1
#endif
#ifdef CPU_SHIM
#define MFMA_DENSE 0
#define MFMA_MOE 0
#endif
#ifndef R3
#define R3 1
#endif
#ifndef R4
#define R4 1
#endif
#ifndef R5
#define R5 1
#endif
#ifndef R6
#define R6 1
#endif
#ifndef R7
#define R7 1
#endif
#ifndef RG
#define RG 1
#endif
#ifndef RN
#define RN 1
#endif
#ifndef REP_SETUP
#define REP_SETUP 1
#endif
#ifndef REP_MOE
#define REP_MOE 1
#endif
#ifndef REP_MOE2
#define REP_MOE2 1
#endif
#ifndef REP_IN
#define REP_IN 1
#endif
#ifndef REP_RET
#define REP_RET 1
#endif
#ifndef REP_SWA
#define REP_SWA 1
#endif
#ifndef REP_S5
#define REP_S5 1
#endif
#ifndef MFMA_DENSE
#define MFMA_DENSE 1
#endif
#ifndef MFMA_MOE
#define MFMA_MOE 1
#endif
typedef unsigned short bf16_t;
#if MFMA_DENSE
typedef unsigned short px_t;
#else
typedef float px_t;
#endif

constexpr int D = 1024, NLAT = 2 * SEQ, NCTX = 2 * CTXL, NTOK = NLAT + NCTX;
constexpr int HYW = 512, S5W = 512, NG = 32, NP = 64, GH = 16;
constexpr int AB_IN = 2048, CD_IN = 2304, PXLD = 2304;
constexpr int NE = 32, DFF = 1024;
constexpr float EPS = 1e-6f;
constexpr int NSLOT = ((NTOK * 4 + 255) / 256 + NE) * 256;
#ifdef CPU_SHIM
DEV bf16_t f2bf(float f) { unsigned u; memcpy(&u, &f, 4); return (bf16_t)((u + 0x7fffu + ((u >> 16) & 1u)) >> 16); }
DEV float fexp(float x) { return expf(x); }
DEV float frcp(float x) { return 1.0f / x; }
#else
DEV bf16_t f2bf(float f) { const __bf16 b = (__bf16)f; return __builtin_bit_cast(unsigned short, b); }
DEV float fexp(float x) { return __builtin_amdgcn_exp2f(1.4426950408889634f * x); }
DEV float frcp(float x) { return __builtin_amdgcn_rcpf(x); }
#endif
DEV float bf2f(bf16_t b) { const unsigned u = (unsigned)b << 16; float f; memcpy(&f, &u, 4); return f; }
DEV float pxf(float v) { return v; }
DEV float pxf(bf16_t v) { return bf2f(v); }
DEV void pxstore(float* q, float v) { *q = v; }
DEV void pxstore(bf16_t* q, float v) { *q = f2bf(v); }

struct P {
    const float *x, *c, *ctx, *c_ctx, *mod_w, *mod_b, *norm1_g, *norm2_g, *ab_w_in, *ab_w_out, *hy_short_w, *hy_short_b,
        *hy_f_w1, *hy_f_b1, *hy_f_w2, *hy_f_b2, *hy_f_w3, *hy_bias, *s5_lre, *s5_lim, *s5_ldt, *s5_bre, *s5_bim, *s5_cre, *s5_cim,
        *s5_d, *s5_glu_w, *s5_glu_b, *cd_w_in, *cd_w_out, *ret_decay, *swa_sink, *router_w, *router_b, *w_gu, *b_gu, *w_dn, *b_dn, *final_g;
    float* out;
    unsigned* bar;
    float *xa, *modv, *f1, *f2, *hraw, *hsum, *rstd, *hx, *zb, *x0c, *mixin, *s5s, *ys5, *qr, *kr, *oret, *qs, *ks, *topg, *act;
    int* topi;
    px_t* px;
    bf16_t *hxb, *mixb, *ys5b, *xb, *actb, *abin_t, *cdin_t, *about_t, *cdout_t, *glu_t, *wgu_t, *wdn_t;
    bf16_t* yb;
    float *zT, *hT, *modp;
    float *slot_gate, *s5c, *rkv, *rsc, *hpart, *zf, *convT, *yd;
    int *cnt, *pos, *slot_of, *slot_tok;
};

struct RowInfo { int base, len, t, m, kind; };
DEV RowInfo row_info(int r) {
    RowInfo ri;
    if (r < NLAT) { const int b = r / SEQ; ri.base = b * SEQ; ri.len = SEQ; ri.t = r - ri.base; ri.m = b; ri.kind = 0; }
    else { const int rc = r - NLAT, b = rc / CTXL; ri.base = NLAT + b * CTXL; ri.len = CTXL; ri.t = rc - b * CTXL; ri.m = 2; ri.kind = 1; }
    return ri;
}
DEV float sigmoidf_(float x) { return frcp(1.0f + fexp(-x)); }
DEV float siluf_(float x) { return x * sigmoidf_(x); }
DEV float gelu_tanhf_(float x) { const float u = 0.7978845608028654f * (x + 0.044715f * x * x * x); return x * frcp(1.0f + fexp(-2.0f * u)); }

#ifdef CPU_SHIM
#define GSL(i, n) const long _n_##i = (long)(n); for (long i = _n_##i * gt / gs, _hi_##i = _n_##i * (gt + 1) / gs; i < _hi_##i; ++i)
#else
#define GSL(i, n) for (long i = gt; i < (long)(n); i += gs)
#endif

#if MFMA_DENSE
#define MIXST(idx, v) p.mixb[idx] = f2bf(v)
#else
#define MIXST(idx, v) p.mixin[idx] = (v)
#endif
DEV long filt_row0(int i, int kind) { return (long)i * (SEQ + CTXL) + (kind ? SEQ : 0); }

#ifdef CPU_SHIM
#define ROPE_COS(a) cosf(a)
#define ROPE_SIN(a) sinf(a)
#else
#define ROPE_COS(a) __builtin_amdgcn_cosf(__builtin_amdgcn_fractf((a) * 0.15915494309189535f))
#define ROPE_SIN(a) __builtin_amdgcn_sinf(__builtin_amdgcn_fractf((a) * 0.15915494309189535f))
#endif
DEV void ph_init(const P& p, long gt, long gs) {
    GSL(i, (long)NTOK * D) { p.xa[i] = i < (long)NLAT * D ? p.x[i] : p.ctx[i - (long)NLAT * D]; }
    GSL(j, 4 * NE) { p.cnt[j] = 0; }
    GSL(z, D) { p.hxb[(long)NTOK * D + z] = 0; }
}
DEV void ph_mod(const P& p, long gt, long gs) {
    GSL(i, 4L * 6 * D * 8) {
        const int j = (int)(i % (6 * D)), kq = (int)((i / (6 * D)) % 8), l = (int)(i / (6 * D * 8));
        const float* w = p.mod_w + (long)l * D * 6 * D + j;
        float a0 = 0.f, a1 = 0.f, a2 = 0.f;
        for (int k = kq * (D / 8); k < (kq + 1) * (D / 8); ++k) { const float wv = w[(long)k * 6 * D]; a0 += siluf_(p.c[k]) * wv; a1 += siluf_(p.c[D + k]) * wv; a2 += siluf_(p.c_ctx[k]) * wv; }
        float* o = p.modp + ((long)kq * 4 + l) * 3 * 6 * D + j;
        o[0] = a0; o[6 * D] = a1; o[12 * D] = a2;
    }
}
DEV void ph_mod2(const P& p, long gt, long gs) {
    GSL(i, 4L * 3 * 6 * D) {
        const int j = (int)(i % (6 * D)), l = (int)(i / (18 * D));
        float a = p.mod_b[l * 6 * D + j];
#pragma unroll
        for (int kq = 0; kq < 8; ++kq) a += p.modp[(long)kq * 4 * 3 * 6 * D + i];
        p.modv[i] = a;
    }
}
DEV void ph_filt1(const P& p, long gt, long gs) {
    GSL(idx, 2L * (SEQ + CTXL) * 64) {
        const int j = (int)(idx % 64); const long rr = idx / 64; const int i = (int)(rr / (SEQ + CTXL)); const int q = (int)(rr % (SEQ + CTXL));
        const int kind = q >= SEQ, pos = kind ? q - SEQ : q, L = kind ? CTXL : SEQ;
        const float* w1 = p.hy_f_w1 + i * 33 * 64;
        const float t = (float)pos / (float)L, w = 6.283185307179586f * (float)pos / (float)L;
        float acc = t * w1[j];
        for (int bi = 0; bi < 16; ++bi) {
            const float band = 1e-4f + (float)bi * ((15.0f - 1e-4f) / 15.0f);
            acc += ROPE_COS(band * w) * w1[(1 + bi) * 64 + j] - ROPE_SIN(band * w) * w1[(17 + bi) * 64 + j];
        }
        p.f1[idx] = ROPE_SIN(acc + p.hy_f_b1[i * 64 + j]);
    }
}
DEV void ph_filt2(const P& p, long gt, long gs) {
    GSL(idx, 2L * (SEQ + CTXL) * 64) {
        const int j = (int)(idx % 64); const long rr = idx / 64; const int i = (int)(rr / (SEQ + CTXL));
        const float* w2 = p.hy_f_w2 + i * 64 * 64; const float* h1 = p.f1 + rr * 64;
        float acc = 0.f;
        for (int k = 0; k < 64; ++k) acc += h1[k] * w2[k * 64 + j];
        p.f2[idx] = ROPE_SIN(acc + p.hy_f_b2[i * 64 + j]);
    }
}
DEV void ph_filt3(const P& p, long gt, long gs) {
    GSL(idx, 2L * (SEQ + CTXL) * HYW) {
        const int c = (int)(idx % HYW); const long rr = idx / HYW; const int i = (int)(rr / (SEQ + CTXL)); const int q = (int)(rr % (SEQ + CTXL));
        const int kind = q >= SEQ, pos = kind ? q - SEQ : q, L = kind ? CTXL : SEQ;
        const float* w3 = p.hy_f_w3 + (long)i * 64 * HYW; const float* h2 = p.f2 + rr * 64;
        float acc = 0.f;
        for (int k = 0; k < 64; ++k) acc += h2[k] * w3[k * HYW + c];
        const float lag = fabsf((float)(pos - L / 2)) / (float)(L / 2);
        const float fast = -15.350567286626973f, slow = -3.0701134573253946f;
        const float delta = fabsf(fast + (slow - fast) * (float)c / 511.0f);
        const float hv = acc * (expf(-lag * delta) + 0.05f);
        p.hraw[idx] = hv; if (!kind) p.hT[((long)i * HYW + c) * SEQ + pos] = hv;
    }
}
constexpr int FSEG = 64, FNSEG = (SEQ + CTXL) / FSEG;
DEV void ph_filt4a(const P& p, long gt, long gs) {
    GSL(idx, 2L * FNSEG * HYW) {
        const int c = (int)(idx % HYW); const long sg = idx / HYW; const float* h = p.hraw + sg * FSEG * HYW + c;
        float s = 0.f;
        for (int q = 0; q < FSEG; ++q) s += fabsf(h[(long)q * HYW]);
        p.hpart[idx] = s;
    }
}
DEV void ph_filt4(const P& p, long gt, long gs) {
    GSL(idx, 2 * 2 * HYW) {
        const int c = (int)(idx % HYW), kind = (int)((idx / HYW) % 2), i = (int)(idx / (2 * HYW));
        const int s0 = (int)(filt_row0(i, kind) / FSEG), ns = (kind ? CTXL : SEQ) / FSEG;
        float s = 0.f;
        for (int q = 0; q < ns; ++q) s += p.hpart[(long)(s0 + q) * HYW + c];
        p.hsum[idx] = s;
    }
}
DEV void ph_rstd(const P& p, int nrows, long gt, long gs) {
    GSL(r, nrows) {
        const float* xr = p.xa + r * D; float s = 0.f;
        for (int k = 0; k < D; ++k) s += xr[k] * xr[k];
        p.rstd[r] = rsqrtf(s * (1.0f / D) + EPS);
    }
}
DEV void ph_hx(const P& p, int layer, int which, int nrows, long gt, long gs) {
    const float* g = (which ? p.norm2_g : p.norm1_g) + layer * D;
    GSL(i, (long)nrows * D) {
        const int k = (int)(i % D), r = (int)(i / D); const RowInfo ri = row_info(r);
        const float* mv = p.modv + ((long)layer * 3 + ri.m) * 6 * D + which * 3 * D;
        const float v = p.xa[i] * p.rstd[r] * g[k] * (1.0f + mv[D + k]) + mv[k];
        p.hx[i] = v; p.hxb[i] = f2bf(v);
    }
}
DEV void ph_inproj(const P& p, const float* w, int nin, long gt, long gs) {
    GSL(i, (long)NTOK * nin) {
        const int n = (int)(i % nin), r = (int)(i / nin); const float* a = p.hx + (long)r * D; const float* b = w + n;
        float acc = 0.f;
        for (int k = 0; k < D; ++k) acc += a[k] * b[(long)k * nin];
        pxstore(&p.px[(long)r * PXLD + n], acc);
    }
}
DEV void ph_sconv(const P& p, int il, long gt, long gs) {
    const float* sw = p.hy_short_w + il * 3 * 1536; const float* sb = p.hy_short_b + il * 1536;
    GSL(i, (long)NTOK * HYW) {
        const int c = (int)(i % HYW), r = (int)(i / HYW); const RowInfo ri = row_info(r);
        float u[3];
#pragma unroll
        for (int s = 0; s < 3; ++s) {
            const int col = s * HYW + c; float acc = sb[col];
#pragma unroll
            for (int j = 0; j < 3; ++j) { const int tt = ri.t + j - 1; if (tt >= 0 && tt < ri.len) acc += sw[j * 1536 + col] * pxf(p.px[(long)(ri.base + tt) * PXLD + col]); }
            u[s] = acc;
        }
        p.x0c[i] = u[0]; p.zb[i] = u[2] * u[1]; if (r < NLAT) p.zT[(long)c * NLAT + r] = u[2] * u[1];
    }
}
DEV void ph_lconv(const P& p, int il, int r0, int r1, long gt, long gs) {
    GSL(i0, (long)(r1 - r0) * HYW) {
        const long i = i0 + (long)r0 * HYW;
        const int c = (int)(i % HYW), r = (int)(i / HYW); const RowInfo ri = row_info(r);
        const int L = ri.len, t = ri.t;
        const float* h = p.hraw + filt_row0(il, ri.kind) * HYW + c; const float* z = p.zb + (long)ri.base * HYW + c;
        int s0 = t + L / 2 - (L - 1); if (s0 < 0) s0 = 0; int s1 = t + L / 2; if (s1 > L - 1) s1 = L - 1;
        float acc = 0.f;
#pragma unroll 8
        for (int s = s0; s <= s1; ++s) acc += h[(long)(t - s + L / 2) * HYW] * z[(long)s * HYW];
        const float y = acc / p.hsum[(il * 2 + ri.kind) * HYW + c] + p.hy_bias[il * HYW + c] * p.zb[i];
        MIXST((long)r * D + c, p.x0c[i] * y);
    }
}
constexpr int FFTN = 2 * SEQ, FFT_NS = (SEQ == 8192 ? 7 : SEQ == 2048 ? 6 : SEQ == 512 ? 5 : SEQ == 128 ? 4 : -1);
static_assert(FFT_NS > 0 && (1 << (2 * FFT_NS)) == FFTN, "2*SEQ must be a power of 4");
struct CX { float x, y; };
#define PADX(n) ((n) + ((n) >> 5))
constexpr int FFT_ELEMS = FFTN + (FFTN >> 5);
#ifdef CPU_SHIM
#define COS2PI(f) cosf(6.283185307179586f * (f))
#define SIN2PI(f) sinf(6.283185307179586f * (f))
#define FFT_SYNC()
#else
#define COS2PI(f) __builtin_amdgcn_cosf(f)
#define SIN2PI(f) __builtin_amdgcn_sinf(f)
#define FFT_SYNC() __syncthreads()
#endif
template <class XP> DEV CX cx_ld(XP x, int i) { CX r; r.x = x[i].x; r.y = x[i].y; return r; }
template <class XP> DEV void cx_st(XP x, int i, CX v) { x[i].x = v.x; x[i].y = v.y; }
DEV CX cx_add(CX a, CX b) { return CX{a.x + b.x, a.y + b.y}; }
DEV CX cx_sub(CX a, CX b) { return CX{a.x - b.x, a.y - b.y}; }
DEV CX cx_mul(CX a, CX b) { return CX{a.x * b.x - a.y * b.y, a.x * b.y + a.y * b.x}; }
template <class XP> DEV void fft_pass(XP x, int s, bool inv, int tid, int nthr) {
    const int lq = 2 * (FFT_NS - 1 - s), Q = 1 << lq;
    const float invB = 1.0f / (float)(4 * Q);
    for (int t = tid; t < FFTN / 4; t += nthr) {
        const int i = t & (Q - 1), base = ((t >> lq) << (lq + 2)) + i;
        const float f = (float)i * invB, cs = COS2PI(f), sn = SIN2PI(f);
        const CX w1 = CX{cs, inv ? sn : -sn}, w2 = cx_mul(w1, w1), w3 = cx_mul(w2, w1);
        const int i0 = PADX(base), i1 = PADX(base + Q), i2 = PADX(base + 2 * Q), i3 = PADX(base + 3 * Q);
        const CX a = cx_ld(x, i0), b = cx_ld(x, i1), c = cx_ld(x, i2), d = cx_ld(x, i3);
        if (!inv) {
            const CX t0 = cx_add(a, c), t1 = cx_sub(a, c), t2 = cx_add(b, d), bd = cx_sub(b, d), t3 = CX{bd.y, -bd.x};
            cx_st(x, i0, cx_add(t0, t2)); cx_st(x, i1, cx_mul(cx_add(t1, t3), w1)); cx_st(x, i2, cx_mul(cx_sub(t0, t2), w2)); cx_st(x, i3, cx_mul(cx_sub(t1, t3), w3));
        } else {
            const CX y0 = a, y1 = cx_mul(b, w1), y2 = cx_mul(c, w2), y3 = cx_mul(d, w3);
            const CX u0 = cx_add(y0, y2), u1 = cx_sub(y0, y2), u2 = cx_add(y1, y3), yd = cx_sub(y1, y3), u3 = CX{-yd.y, yd.x};
            cx_st(x, i0, cx_add(u0, u2)); cx_st(x, i1, cx_add(u1, u3)); cx_st(x, i2, cx_sub(u0, u2)); cx_st(x, i3, cx_sub(u1, u3));
        }
    }
}
DEV void bfly4(CX& a, CX& b, CX& c, CX& d, CX w1, bool inv, bool tw) {
    const CX w2 = cx_mul(w1, w1), w3 = cx_mul(w2, w1);
    if (!inv) {
        const CX t0 = cx_add(a, c), t1 = cx_sub(a, c), t2 = cx_add(b, d), bd = cx_sub(b, d), t3 = CX{bd.y, -bd.x};
        a = cx_add(t0, t2); b = cx_add(t1, t3); c = cx_sub(t0, t2); d = cx_sub(t1, t3);
        if (tw) { b = cx_mul(b, w1); c = cx_mul(c, w2); d = cx_mul(d, w3); }
    } else {
        CX y1 = b, y2 = c, y3 = d;
        if (tw) { y1 = cx_mul(b, w1); y2 = cx_mul(c, w2); y3 = cx_mul(d, w3); }
        const CX u0 = cx_add(a, y2), u1 = cx_sub(a, y2), u2 = cx_add(y1, y3), yd = cx_sub(y1, y3), u3 = CX{-yd.y, yd.x};
        a = cx_add(u0, u2); b = cx_add(u1, u3); c = cx_sub(u0, u2); d = cx_sub(u1, u3);
    }
}
template <class XP> DEV void fft_pass16(XP x, int s, bool inv, int tid, int nthr) {
    const int lq2 = 2 * (FFT_NS - 2 - s), Q2 = 1 << lq2, Q = 4 * Q2;
    const float invB = 1.0f / (float)(16 * Q2);
    const float sg = inv ? 1.0f : -1.0f;
    const CX c1 = CX{0.9238795325112867f, sg * 0.3826834323650898f}, c2 = CX{0.7071067811865476f, sg * 0.7071067811865476f}, c3 = CX{0.3826834323650898f, sg * 0.9238795325112867f};
    for (int t = tid; t < FFTN / 16; t += nthr) {
        const int i = t & (Q2 - 1), base = ((t >> lq2) << (lq2 + 4)) + i;
        const float f = (float)i * invB, cs = COS2PI(f), sn = SIN2PI(f);
        const CX wA = CX{cs, sg * sn};
        CX wB = cx_mul(wA, wA); wB = cx_mul(wB, wB);
        CX v[4][4];
#pragma unroll
        for (int a = 0; a < 4; ++a)
#pragma unroll
            for (int b = 0; b < 4; ++b) v[a][b] = cx_ld(x, PADX(base + a * Q + b * Q2));
        if (!inv) {
            bfly4(v[0][0], v[1][0], v[2][0], v[3][0], wA, false, true);
            bfly4(v[0][1], v[1][1], v[2][1], v[3][1], cx_mul(wA, c1), false, true);
            bfly4(v[0][2], v[1][2], v[2][2], v[3][2], cx_mul(wA, c2), false, true);
            bfly4(v[0][3], v[1][3], v[2][3], v[3][3], cx_mul(wA, c3), false, true);
#pragma unroll
            for (int r = 0; r < 4; ++r) bfly4(v[r][0], v[r][1], v[r][2], v[r][3], wB, false, true);
        } else {
#pragma unroll
            for (int r = 0; r < 4; ++r) bfly4(v[r][0], v[r][1], v[r][2], v[r][3], wB, true, true);
            bfly4(v[0][0], v[1][0], v[2][0], v[3][0], wA, true, true);
            bfly4(v[0][1], v[1][1], v[2][1], v[3][1], cx_mul(wA, c1), true, true);
            bfly4(v[0][2], v[1][2], v[2][2], v[3][2], cx_mul(wA, c2), true, true);
            bfly4(v[0][3], v[1][3], v[2][3], v[3][3], cx_mul(wA, c3), true, true);
        }
#pragma unroll
        for (int a = 0; a < 4; ++a)
#pragma unroll
            for (int b = 0; b < 4; ++b) cx_st(x, PADX(base + a * Q + b * Q2), v[a][b]);
    }
}
template <class XP> DEV void fft_pass_last(XP x, bool inv, int tid, int nthr) {
    for (int t = tid; t < FFTN / 4; t += nthr) {
        const int base = 4 * t; CX a = cx_ld(x, PADX(base)), b = cx_ld(x, PADX(base + 1)), c = cx_ld(x, PADX(base + 2)), d = cx_ld(x, PADX(base + 3));
        bfly4(a, b, c, d, CX{1.f, 0.f}, inv, false);
        cx_st(x, PADX(base), a); cx_st(x, PADX(base + 1), b); cx_st(x, PADX(base + 2), c); cx_st(x, PADX(base + 3), d);
    }
}
static_assert(FFT_NS % 2 == 1, "pass schedule: (FFT_NS - 1) / 2 radix-16 passes + one radix-4 pass");
template <class XP> DEV void fft_forward(XP x, int tid, int nthr) {
    for (int s = 0; s + 1 < FFT_NS; s += 2) { fft_pass16(x, s, false, tid, nthr); FFT_SYNC(); }
    fft_pass_last(x, false, tid, nthr); FFT_SYNC();
}
template <class XP> DEV void fft_inverse(XP x, int tid, int nthr) {
    fft_pass_last(x, true, tid, nthr); FFT_SYNC();
    for (int s = FFT_NS - 3; s >= 0; s -= 2) { fft_pass16(x, s, true, tid, nthr); FFT_SYNC(); }
}
template <class XP> DEV void lconv_unit(const P& p, int il, int c, XP x, float* zf, int tid, int nthr) {
    constexpr int L = SEQ, N = FFTN;
    const float* zc = p.zT + (long)c * NLAT;
#pragma unroll 8
    for (int n = tid; n < L; n += nthr) { CX v; v.x = zc[n]; v.y = zc[SEQ + n]; cx_st(x, PADX(n), v); }
#pragma unroll 8
    for (int n = L + tid; n < N; n += nthr) cx_st(x, PADX(n), CX{0.f, 0.f});
    FFT_SYNC();
    fft_forward(x, tid, nthr);
    const float* h = p.hT + ((long)il * HYW + c) * SEQ;
#pragma unroll 8
    for (int n = tid; n < L; n += nthr) { const float hv = h[n]; const CX v = cx_ld(x, PADX(n)); zf[2 * n] = v.x; zf[2 * n + 1] = v.y; cx_st(x, PADX(n), CX{hv, 0.f}); }
#pragma unroll 8
    for (int n = L + tid; n < N; n += nthr) { const CX v = cx_ld(x, PADX(n)); zf[2 * n] = v.x; zf[2 * n + 1] = v.y; cx_st(x, PADX(n), CX{0.f, 0.f}); }
    FFT_SYNC();
    fft_forward(x, tid, nthr);
#ifndef CPU_SHIM
    asm volatile("s_waitcnt vmcnt(0)" ::: "memory");
#endif
#pragma unroll 8
    for (int n = tid; n < N; n += nthr) { const CX zv{zf[2 * n], zf[2 * n + 1]}; const CX hv = cx_ld(x, PADX(n)); cx_st(x, PADX(n), cx_mul(hv, zv)); }
    FFT_SYNC();
    fft_inverse(x, tid, nthr);
    const float scale = 1.0f / ((float)N * p.hsum[(il * 2 + 0) * HYW + c]);
    float* o = p.convT + (long)c * NLAT;
#pragma unroll 8
    for (int t = tid; t < L; t += nthr) { const CX v = cx_ld(x, PADX(t + L / 2)); o[t] = v.x * scale; o[L + t] = v.y * scale; }
    FFT_SYNC();
}
#ifdef CPU_SHIM
DEV void ph_lconv_fft(const P& p, int il, long gt, long gs) {
    CX* x = (CX*)malloc(sizeof(CX) * FFT_ELEMS);
    GSL(c, HYW) { lconv_unit(p, il, (int)c, x, p.zf + gt * 2 * FFTN, 0, 1); }
    free(x);
}
#endif
DEV void ph_hymix(const P& p, int il, long gt, long gs) {
    GSL(i, (long)NLAT * HYW) {
        const int c = (int)(i % HYW), r = (int)(i / HYW);
        const float y = p.convT[(long)c * NLAT + r] + p.hy_bias[il * HYW + c] * p.zb[i];
        MIXST((long)r * D + c, p.x0c[i] * y);
    }
}
DEV int scan_row(int dir, int b, int n) {
    if (n < CTXL) return NLAT + b * CTXL + (dir ? CTXL - 1 - n : n);
    const int m = n - CTXL; return b * SEQ + (dir ? SEQ - 1 - m : m);
}
constexpr int S5C = 64, S5NCH = (CTXL + SEQ) / S5C;
struct S5Par { float lbr, lbi; float bbr[GH], bbi[GH]; };
DEV void s5_par(const P& p, int il, int dir, int g, int pp, S5Par& q) {
    const int gi = (il * 2 + dir) * NG + g;
    const float lre = fminf(p.s5_lre[gi * NP + pp], -1e-4f), lim = p.s5_lim[gi * NP + pp], dt = expf(p.s5_ldt[gi]);
    const float mag = expf(lre * dt); q.lbr = mag * cosf(lim * dt); q.lbi = mag * sinf(lim * dt);
    const float nr = q.lbr - 1.0f, ni = q.lbi, den = lre * lre + lim * lim;
    const float fr = (nr * lre + ni * lim) / den, fi = (ni * lre - nr * lim) / den;
#pragma unroll
    for (int h = 0; h < GH; ++h) { const float br = p.s5_bre[((long)gi * NP + pp) * GH + h], bi = p.s5_bim[((long)gi * NP + pp) * GH + h]; q.bbr[h] = fr * br - fi * bi; q.bbi[h] = fr * bi + fi * br; }
}
DEV void ph_s5chunk(const P& p, int il, int fill, long gt, long gs) {
    GSL(i, 2L * 2 * S5NCH * NG * NP) {
        const int pp = (int)(i % NP), g = (int)((i / NP) % NG), ch = (int)((i / (NP * NG)) % S5NCH), b = (int)((i / ((long)NP * NG * S5NCH)) % 2), dir = (int)(i / ((long)NP * NG * S5NCH * 2));
        S5Par q; s5_par(p, il, dir, g, pp, q);
        float* ce = p.s5c + ((((long)dir * 2 + b) * S5NCH + ch) * NG + g) * NP * 2 + pp * 2;
        float sr = 0.f, si = 0.f;
        if (fill) { sr = ce[0]; si = ce[1]; }
        for (int k = 0; k < S5C; ++k) {
            const int row = scan_row(dir, b, ch * S5C + k); const px_t* u = p.px + (long)row * PXLD + 1536 + g * GH;
            float ar = 0.f, ai = 0.f;
#pragma unroll
            for (int h = 0; h < GH; ++h) { ar += q.bbr[h] * pxf(u[h]); ai += q.bbi[h] * pxf(u[h]); }
            const float tr = q.lbr * sr - q.lbi * si + ar, ti = q.lbr * si + q.lbi * sr + ai; sr = tr; si = ti;
            if (fill) { float* o = p.s5s + (((long)dir * NTOK + row) * NG + g) * NP * 2 + pp * 2; o[0] = sr; o[1] = si; }
        }
        if (!fill) { ce[0] = sr; ce[1] = si; }
    }
}
DEV void ph_s5carry(const P& p, int il, long gt, long gs) {
    GSL(i, 2 * 2 * NG * NP) {
        const int pp = (int)(i % NP), g = (int)((i / NP) % NG), b = (int)((i / (NP * NG)) % 2), dir = (int)(i / (NP * NG * 2));
        S5Par q; s5_par(p, il, dir, g, pp, q);
        float pr = q.lbr, pi = q.lbi;
#pragma unroll
        for (int t = 0; t < 6; ++t) { const float nr = pr * pr - pi * pi, ni = 2.0f * pr * pi; pr = nr; pi = ni; }
        float cr = 0.f, ci = 0.f;
        float* ce0 = p.s5c + ((((long)dir * 2 + b) * S5NCH) * NG + g) * NP * 2 + pp * 2;
        constexpr int CB = 12;
        for (int c0 = 0; c0 < S5NCH; c0 += CB) {
            float er[CB], ei[CB];
#pragma unroll
            for (int j = 0; j < CB; ++j) if (c0 + j < S5NCH) { const float* ce = ce0 + (long)(c0 + j) * NG * NP * 2; er[j] = ce[0]; ei[j] = ce[1]; }
#pragma unroll
            for (int j = 0; j < CB; ++j) if (c0 + j < S5NCH) { float* ce = ce0 + (long)(c0 + j) * NG * NP * 2; ce[0] = cr; ce[1] = ci;
                const float tr = pr * cr - pi * ci + er[j], ti = pr * ci + pi * cr + ei[j]; cr = tr; ci = ti; }
        }
    }
}
DEV void ph_s5out(const P& p, int il, long gt, long gs) {
    GSL(i, (long)NTOK * S5W) {
        const int ch = (int)(i % S5W), r = (int)(i / S5W), g = ch / GH, h = ch % GH;
        float y = p.s5_d[il * S5W + ch] * pxf(p.px[(long)r * PXLD + 1536 + ch]);
        for (int dir = 0; dir < 2; ++dir) {
            const long ci = (((long)(il * 2 + dir) * NG + g) * GH + h) * NP;
            const float* s = p.s5s + (((long)dir * NTOK + r) * NG + g) * NP * 2;
            for (int pp = 0; pp < NP; ++pp) y += p.s5_cre[ci + pp] * s[pp * 2] - p.s5_cim[ci + pp] * s[pp * 2 + 1];
        }
        { const float gy = gelu_tanhf_(y); p.ys5[i] = gy; p.ys5b[i] = f2bf(gy); }
    }
}
DEV void ph_s5fin(const P& p, int il, long gt, long gs) {
    GSL(i, (long)NTOK * S5W) {
        const int ch = (int)(i % S5W), r = (int)(i / S5W);
        const float y = p.s5_d[il * S5W + ch] * pxf(p.px[(long)r * PXLD + 1536 + ch]) + p.yd[i] + p.yd[(long)NTOK * S5W + i];
        const float gy = gelu_tanhf_(y); p.ys5b[i] = f2bf(gy);
#ifdef CPU_SHIM
        p.ys5[i] = gy;
#endif
    }
}
DEV void ph_glu(const P& p, int il, long gt, long gs) {
    const float* w = p.s5_glu_w + (long)il * S5W * S5W;
    GSL(i, (long)NTOK * S5W) {
        const int ch = (int)(i % S5W), r = (int)(i / S5W); const float* a = p.ys5 + (long)r * S5W;
        float acc = p.s5_glu_b[il * S5W + ch];
        for (int k = 0; k < S5W; ++k) acc += a[k] * w[(long)k * S5W + ch];
        MIXST((long)r * D + HYW + ch, a[ch] * sigmoidf_(acc));
    }
}
DEV void ph_rope(const P& p, long gt, long gs) {
    GSL(i, (long)NTOK * 576) {
        const int it = (int)(i % 576), r = (int)(i / 576); const RowInfo ri = row_info(r); const px_t* pr = p.px + (long)r * PXLD;
        if (it < 256) {
            const int isk = it >= 128, hd = it & 127, h = hd >> 5, d = hd & 31;
            const px_t* src = pr + (isk ? 256 : 0) + h * 64; float x1 = pxf(src[d]), x2 = pxf(src[d + 32]);
            if (ri.kind == 0) { const float inv = exp2f(-(float)d * (13.287712379549449f / 32.0f)), ang = (float)ri.t * inv, cs = ROPE_COS(ang), sn = ROPE_SIN(ang);
                const float y1 = x1 * cs - x2 * sn, y2 = x1 * sn + x2 * cs; x1 = y1; x2 = y2; }
            const float sc = isk ? 1.0f : 0.125f;
            float* dst = (isk ? p.kr : p.qr) + (long)r * 256 + h * 64; dst[d] = x1 * sc; dst[d + 32] = x2 * sc;
        } else {
            const int j = it - 256, isk = j >= 256, hd = isk ? j - 256 : j, h = hd >> 5, e = hd & 31, half = e >> 4, d = e & 15;
            const px_t* src = pr + (isk ? 2048 : 1536) + h * 64 + half * 32; float x1 = pxf(src[d]), x2 = pxf(src[d + 16]);
            if (ri.kind == 0) { const float pos = (float)(half ? (ri.t % 64) : (ri.t / 64)); const float inv = exp2f(-(float)d * (13.287712379549449f / 16.0f)), ang = pos * inv, cs = ROPE_COS(ang), sn = ROPE_SIN(ang);
                const float y1 = x1 * cs - x2 * sn, y2 = x1 * sn + x2 * cs; x1 = y1; x2 = y2; }
            const float sc = isk ? 1.0f : 0.125f;
            float* dst = (isk ? p.ks + (long)r * 128 : p.qs + (long)r * 512) + h * 64 + half * 32; dst[d] = x1 * sc; dst[d + 16] = x2 * sc;
        }
    }
}
constexpr int RC = 128, RNCH = (CTXL + SEQ) / RC;
DEV float ret_logg(const P& p, int il, int dir, int h) { const float dl = p.ret_decay[(il * 2 + dir) * 4 + h]; return -log1pf(expf(-dl)); }
DEV void ph_retkv(const P& p, int il, long gt, long gs) {
    GSL(i, 2L * 2 * RNCH * 4 * 64 * 128) {
        const int e = (int)(i % 128), d = (int)((i / 128) % 64), h = (int)((i / 8192) % 4), n = (int)((i / 32768) % RNCH), b = (int)((i / (32768L * RNCH)) % 2), dir = (int)(i / (32768L * RNCH * 2));
        const float lg = ret_logg(p, il, dir, h);
        float acc = 0.f;
        for (int j = 0; j < RC; ++j) { const int row = scan_row(dir, b, n * RC + j);
            acc += expf((float)(RC - 1 - j) * lg) * p.kr[(long)row * 256 + h * 64 + d] * pxf(p.px[(long)row * PXLD + 512 + h * 128 + e]); }
        p.rkv[i] = acc;
    }
}
DEV void ph_retcarry(const P& p, int il, long gt, long gs) {
    GSL(i, 2L * 2 * 4 * 64 * 128) {
        const int de = (int)(i % 8192), h = (int)((i / 8192) % 4), b = (int)((i / 32768) % 2), dir = (int)(i / 65536);
        const float gc = expf((float)RC * ret_logg(p, il, dir, h));
        float S = 0.f;
        float* q0 = p.rkv + ((((long)dir * 2 + b) * RNCH) * 4 + h) * 8192 + de;
        constexpr int CB = 11;
        for (int n0 = 0; n0 < RNCH; n0 += CB) {
            float kv[CB];
#pragma unroll
            for (int j = 0; j < CB; ++j) if (n0 + j < RNCH) kv[j] = q0[(long)(n0 + j) * 4 * 8192];
#pragma unroll
            for (int j = 0; j < CB; ++j) if (n0 + j < RNCH) { q0[(long)(n0 + j) * 4 * 8192] = S; S = gc * S + kv[j]; }
        }
    }
}
DEV void ph_retsc(const P& p, int il, long gt, long gs) {
    GSL(i, 2L * NTOK * 4 * RC) {
        const int j = (int)(i % RC), h = (int)((i / RC) % 4), r = (int)((i / (RC * 4)) % NTOK), dir = (int)(i / ((long)RC * 4 * NTOK)); const RowInfo ri = row_info(r);
        const int b = ri.kind ? (ri.base - NLAT) / CTXL : ri.base / SEQ;
        const int step = ri.kind ? (dir ? CTXL - 1 - ri.t : ri.t) : CTXL + (dir ? SEQ - 1 - ri.t : ri.t), ii = step % RC, n = step / RC;
        float sc = 0.f;
        if (j <= ii) { const int rj = scan_row(dir, b, n * RC + j); const float* q = p.qr + (long)r * 256 + h * 64; const float* k = p.kr + (long)rj * 256 + h * 64;
            float dot = 0.f;
            for (int d = 0; d < 64; ++d) dot += q[d] * k[d];
            sc = dot * expf((float)(ii - j) * ret_logg(p, il, dir, h)); }
        p.rsc[i] = sc;
    }
}
DEV void ph_reto(const P& p, int il, long gt, long gs) {
    GSL(i, 2L * NTOK * 512) {
        const int e = (int)(i % 128), h = (int)((i / 128) % 4), r = (int)((i / 512) % NTOK), dir = (int)(i / (512L * NTOK)); const RowInfo ri = row_info(r);
        const int b = ri.kind ? (ri.base - NLAT) / CTXL : ri.base / SEQ;
        const int step = ri.kind ? (dir ? CTXL - 1 - ri.t : ri.t) : CTXL + (dir ? SEQ - 1 - ri.t : ri.t), ii = step % RC, n = step / RC;
        const float* sc = p.rsc + (((long)dir * NTOK + r) * 4 + h) * RC;
        float acc = 0.f;
        for (int j = 0; j <= ii; ++j) { const int rj = scan_row(dir, b, n * RC + j); acc += sc[j] * pxf(p.px[(long)rj * PXLD + 512 + h * 128 + e]); }
        const float* S = p.rkv + ((((long)dir * 2 + b) * RNCH + n) * 4 + h) * 8192 + e; const float* q = p.qr + (long)r * 256 + h * 64;
        float cr = 0.f;
        for (int d = 0; d < 64; ++d) cr += q[d] * S[d * 128];
        p.oret[((long)dir * NTOK + r) * 512 + h * 128 + e] = acc + cr * expf((float)(ii + 1) * ret_logg(p, il, dir, h));
    }
}
DEV void ph_retout(const P& p, int nrows, long gt, long gs) {
    GSL(i, (long)nrows * 4) {
        const int h = (int)(i % 4), r = (int)(i / 4);
        const float* o0 = p.oret + (long)r * 512 + h * 128; const float* o1 = p.oret + ((long)NTOK + r) * 512 + h * 128;
        float ss = 0.f;
        for (int e = 0; e < 128; ++e) { const float o = o0[e] + o1[e]; ss += o * o; }
        const float rs = rsqrtf(ss * (1.0f / 128.0f) + EPS);
        for (int e = 0; e < 128; ++e) MIXST((long)r * D + h * 128 + e, (o0[e] + o1[e]) * rs * siluf_(pxf(p.px[(long)r * PXLD + 1024 + h * 128 + e])));
    }
}
DEV void ph_swa(const P& p, int il, int nrows, long gt, long gs) {
    GSL(i, (long)nrows * 8) {
        const int hq = (int)(i % 8), r = (int)(i / 8), kv = hq >> 2; const RowInfo ri = row_info(r);
        const int b = ri.kind ? (ri.base - NLAT) / CTXL : ri.base / SEQ;
        float q[64], acc[64];
#pragma unroll
        for (int d = 0; d < 64; ++d) { q[d] = p.qs[(long)r * 512 + hq * 64 + d]; acc[d] = 0.f; }
        float m = p.swa_sink[il * 8 + hq], l = 1.0f;
        for (int part = 0; part < 2; ++part) {
            int k0, k1;
            if (part == 0) { if (ri.kind) continue; k0 = ri.base + (ri.t - 128 < 0 ? 0 : ri.t - 128); k1 = ri.base + (ri.t + 128 > SEQ - 1 ? SEQ - 1 : ri.t + 128); }
            else { k0 = NLAT + b * CTXL; k1 = k0 + CTXL - 1; }
            for (int kr = k0; kr <= k1; ++kr) {
                const float* kk = p.ks + (long)kr * 128 + kv * 64; const px_t* vv = p.px + (long)kr * PXLD + 2176 + kv * 64;
                float s = 0.f;
#pragma unroll
                for (int d = 0; d < 64; ++d) s += q[d] * kk[d];
                const float mn = fmaxf(m, s), corr = expf(m - mn), pe = expf(s - mn);
                l = l * corr + pe; m = mn;
#pragma unroll
                for (int d = 0; d < 64; ++d) acc[d] = acc[d] * corr + pe * pxf(vv[d]);
            }
        }
        const float il_ = 1.0f / l;
#pragma unroll
        for (int d = 0; d < 64; ++d) MIXST((long)r * D + 512 + hq * 64 + d, acc[d] * il_);
    }
}
DEV void ph_outproj(const P& p, int layer, const float* w, int nrows, long gt, long gs) {
    GSL(i, (long)nrows * D) {
        const int n = (int)(i % D), r = (int)(i / D); const RowInfo ri = row_info(r);
        const float* a = p.mixin + (long)r * D; const float* b = w + n;
        float acc = 0.f;
        for (int k = 0; k < D; ++k) acc += a[k] * b[(long)k * D];
        p.xa[i] += p.modv[((long)layer * 3 + ri.m) * 6 * D + 2 * D + n] * acc;
    }
}
DEV int atomic_inc(int* q) {
#ifdef CPU_SHIM
    return __atomic_fetch_add(q, 1, __ATOMIC_RELAXED);
#else
    return atomicAdd(q, 1);
#endif
}
DEV void ph_router(const P& p, int layer, int nrows, long gt, long gs) {
    const float* rw = p.router_w + (long)layer * D * NE;
    GSL(j, NSLOT) { p.slot_tok[j] = -1; p.slot_gate[j] = 0.f; }
    GSL(r, nrows) {
        float lg[NE];
#pragma unroll
        for (int e = 0; e < NE; ++e) lg[e] = p.router_b[layer * NE + e];
        const float* a = p.hx + (long)r * D;
        for (int k = 0; k < D; ++k) { const float av = a[k];
#pragma unroll
            for (int e = 0; e < NE; ++e) lg[e] += av * rw[k * NE + e]; }
        int ti[4]; float tv[4];
#pragma unroll
        for (int s = 0; s < 4; ++s) { int best = 0; float bv = -3.0e38f;
#pragma unroll
            for (int e = 0; e < NE; ++e) { if (lg[e] > bv) { bv = lg[e]; best = e; } }
            ti[s] = best; tv[s] = bv;
#pragma unroll
            for (int e = 0; e < NE; ++e) if (e == best) lg[e] = -3.0e38f; }
        const float e1 = expf(tv[1] - tv[0]), e2 = expf(tv[2] - tv[0]), e3 = expf(tv[3] - tv[0]), inv = 1.0f / (1.0f + e1 + e2 + e3);
        p.topi[r * 4 + 0] = ti[0]; p.topi[r * 4 + 1] = ti[1]; p.topi[r * 4 + 2] = ti[2]; p.topi[r * 4 + 3] = ti[3];
        p.topg[r * 4 + 0] = inv; p.topg[r * 4 + 1] = e1 * inv; p.topg[r * 4 + 2] = e2 * inv; p.topg[r * 4 + 3] = e3 * inv;
#pragma unroll
        for (int s = 0; s < 4; ++s) p.pos[r * 4 + s] = atomic_inc(p.cnt + layer * NE + ti[s]);
    }
}
DEV int moe_tiles(const int* cnt) { int t = 0; for (int e = 0; e < NE; ++e) t += (cnt[e] + 255) >> 8; return t; }
DEV int tile_expert(const int* cnt, int pm) { int t = 0; for (int e = 0; e < NE; ++e) { t += (cnt[e] + 255) >> 8; if (pm < t) return e; } return NE - 1; }
DEV void ph_assign(const P& p, int layer, int nrows, long gt, long gs) {
    const int* cnt = p.cnt + layer * NE;
    GSL(i, (long)nrows * 4) {
        const int e = p.topi[i]; int off = 0;
#pragma unroll
        for (int q = 0; q < NE; ++q) { const int cq = cnt[q]; off += q < e ? ((cq + 255) >> 8) << 8 : 0; }
        const int slot = off + p.pos[i];
        p.slot_of[i] = slot; p.slot_tok[slot] = (int)(i >> 2); p.slot_gate[slot] = p.topg[i];
    }
}
DEV void ph_gather(const P& p, int layer, long gt, long gs) {
    const long used = (long)moe_tiles(p.cnt + layer * NE) * 256;
    GSL(i, used * D) { const int k = (int)(i % D); const long slot = i / D; const int tok = p.slot_tok[slot]; p.xb[i] = tok >= 0 ? p.hxb[(long)tok * D + k] : (bf16_t)0; }
}
DEV void ph_moe1s(const P& p, int layer, long gt, long gs) {
    const int* cnt = p.cnt + layer * NE; const long used = (long)moe_tiles(cnt) * 256;
    GSL(i, used * DFF) {
        const int j = (int)(i % DFF); const long slot = i / DFF; const int e = tile_expert(cnt, (int)(slot >> 8));
        const float* w = p.w_gu + ((long)layer * NE + e) * D * 2 * DFF + j; const bf16_t* a = p.xb + slot * D;
        const float* bb = p.b_gu + ((long)layer * NE + e) * 2 * DFF;
        float ga = bb[j], up = bb[DFF + j];
        for (int k = 0; k < D; ++k) { const float av = bf2f(a[k]); ga += av * w[(long)k * 2 * DFF]; up += av * w[(long)k * 2 * DFF + DFF]; }
        ga = fminf(ga, 7.0f); up = fminf(fmaxf(up, -7.0f), 7.0f);
        p.actb[i] = f2bf(ga * sigmoidf_(1.702f * ga) * (up + 1.0f));
    }
}
DEV void ph_moe2s(const P& p, int layer, long gt, long gs) {
    const int* cnt = p.cnt + layer * NE; const long used = (long)moe_tiles(cnt) * 256;
    GSL(i, used * D) {
        const int n = (int)(i % D); const long slot = i / D; const int e = tile_expert(cnt, (int)(slot >> 8));
        const float* w = p.w_dn + ((long)layer * NE + e) * DFF * D + n; const bf16_t* a = p.actb + slot * DFF;
        float acc = p.b_dn[((long)layer * NE + e) * D + n];
        for (int k = 0; k < DFF; ++k) acc += bf2f(a[k]) * w[(long)k * D];
        p.yb[i] = f2bf(acc * p.slot_gate[slot]);
    }
}
DEV void ph_combine(const P& p, int layer, int nrows, long gt, long gs) {
    GSL(i, (long)nrows * D) {
        const int n = (int)(i % D), r = (int)(i / D); const RowInfo ri = row_info(r);
        float y = 0.f;
#pragma unroll
        for (int s = 0; s < 4; ++s) y += bf2f(p.yb[(long)p.slot_of[r * 4 + s] * D + n]);
        p.xa[i] += p.modv[((long)layer * 3 + ri.m) * 6 * D + 5 * D + n] * y;
    }
}
DEV void ph_final(const P& p, long gt, long gs) {
    GSL(i, (long)NLAT * D) { const int k = (int)(i % D), r = (int)(i / D); p.out[i] = p.xa[i] * p.rstd[r] * p.final_g[k]; }
}

constexpr int N_SETUP = 6, N_SLOT = 18;
#ifdef CPU_SHIM
#define SWA_NAIVE ph_swa(p, il, nrows, gt, gs);
#define S5_NAIVE(x) x
#define S5_FIN ph_s5out(p, il, gt, gs);
#define RET_NAIVE_A ph_retkv(p, il, gt, gs); ph_retsc(p, il, gt, gs);
#define RET_NAIVE_C ph_reto(p, il, gt, gs);
#else
#define SWA_NAIVE
#define S5_NAIVE(x)
#define S5_FIN ph_s5fin(p, il, gt, gs);
#define RET_NAIVE_A
#define RET_NAIVE_C
#endif
#ifdef CPU_SHIM
#define LCONV_LAT(p, il, gt, gs) ph_lconv_fft(p, il, gt, gs)
#else
#define LCONV_LAT(p, il, gt, gs)
#endif
template <int S> DEV void setup_slot(const P& p, long gt, long gs) {
    if constexpr (S == 0) { ph_init(p, gt, gs); ph_mod(p, gt, gs); }
    if constexpr (S == 1) { ph_mod2(p, gt, gs); ph_filt1(p, gt, gs); }
    if constexpr (S == 2) ph_filt2(p, gt, gs);
    if constexpr (S == 3) ph_filt3(p, gt, gs);
    if constexpr (S == 4) ph_filt4a(p, gt, gs);
    if constexpr (S == 5) ph_filt4(p, gt, gs);
}
template <int S> DEV void layer_slot(const P& p, int layer, long gt, long gs) {
    const int il = layer >> 1; const bool ab = !(layer & 1);
    const int nrows = layer < 3 ? NTOK : NLAT;
    if constexpr (S == 0) ph_rstd(p, NTOK, gt, gs);
    if constexpr (S == 1) ph_hx(p, layer, 0, NTOK, gt, gs);
    if constexpr (S == 2) { if (ab) ph_inproj(p, p.ab_w_in + (long)il * D * AB_IN, AB_IN, gt, gs); else ph_inproj(p, p.cd_w_in + (long)il * D * CD_IN, CD_IN, gt, gs); }
    if constexpr (S == 3) { if (ab) { ph_sconv(p, il, gt, gs); S5_NAIVE(ph_s5chunk(p, il, 0, gt, gs);) } else ph_rope(p, gt, gs); }
    if constexpr (S == 4) { if (ab) { LCONV_LAT(p, il, gt, gs); ph_lconv(p, il, NLAT, NTOK, gt, gs); ph_s5carry(p, il, gt, gs); } else { RET_NAIVE_A } }
    if constexpr (S == 5) { if (ab) { ph_hymix(p, il, gt, gs); S5_NAIVE(ph_s5chunk(p, il, 1, gt, gs);) } else { ph_retcarry(p, il, gt, gs); SWA_NAIVE } }
    if constexpr (S == 6) { if (ab) { S5_FIN } else { RET_NAIVE_C } }
    if constexpr (S == 7) { if (ab) ph_glu(p, il, gt, gs); else ph_retout(p, nrows, gt, gs); }
    if constexpr (S == 8) ph_outproj(p, layer, (ab ? p.ab_w_out : p.cd_w_out) + (long)il * D * D, nrows, gt, gs);
    if constexpr (S == 9) ph_rstd(p, nrows, gt, gs);
    if constexpr (S == 10) ph_hx(p, layer, 1, nrows, gt, gs);
    if constexpr (S == 11) ph_router(p, layer, nrows, gt, gs);
    if constexpr (S == 12) ph_assign(p, layer, nrows, gt, gs);
    if constexpr (S == 13) ph_gather(p, layer, gt, gs);
    if constexpr (S == 14) ph_moe1s(p, layer, gt, gs);
    if constexpr (S == 15) ph_moe2s(p, layer, gt, gs);
    if constexpr (S == 16) ph_combine(p, layer, nrows, gt, gs);
}
template <int S> DEV void final_slot(const P& p, long gt, long gs) {
    if constexpr (S == 0) ph_rstd(p, NLAT, gt, gs);
    if constexpr (S == 1) ph_final(p, gt, gs);
}

struct WsMap { size_t off[56]; size_t total; };
static inline WsMap ws_map() {
    WsMap m; size_t o = 0; int n = 0;
    auto take = [&](size_t bytes) { m.off[n++] = o; o += (bytes + 255) & ~(size_t)255; };
    take(16384);
    take((size_t)NTOK * D * 4);
    take((size_t)4 * 3 * 6 * D * 4);
    take((size_t)2 * (SEQ + CTXL) * 64 * 4);
    take((size_t)2 * (SEQ + CTXL) * 64 * 4);
    take((size_t)2 * (SEQ + CTXL) * HYW * 4);
    take((size_t)2 * 2 * HYW * 4);
    take((size_t)NTOK * 4);
    take((size_t)NTOK * D * 4);
    take((size_t)NTOK * PXLD * 4);
    take((size_t)NTOK * HYW * 4);
    take((size_t)NTOK * HYW * 4);
    take((size_t)NTOK * D * 4);
    take((size_t)2 * NTOK * NG * NP * 2 * 4);
    take((size_t)NTOK * S5W * 4);
    take((size_t)NTOK * 256 * 4);
    take((size_t)NTOK * 256 * 4);
    take((size_t)2 * NTOK * 512 * 4);
    take((size_t)NTOK * 512 * 4);
    take((size_t)NTOK * 128 * 4);
    take((size_t)NTOK * 4 * 4);
    take((size_t)NTOK * 4 * 4);
    take(256);
    take((size_t)(NTOK + 1) * D * 2);
    take((size_t)NTOK * D * 2);
    take((size_t)NTOK * S5W * 2);
    take((size_t)NSLOT * D * 2);
    take((size_t)NSLOT * DFF * 2);
    take((size_t)NSLOT * D * 4);
    take((size_t)NSLOT * 4);
    take((size_t)4 * NE * 4);
    take((size_t)NTOK * 4 * 4);
    take((size_t)NTOK * 4 * 4);
    take((size_t)NSLOT * 4);
    take((size_t)2 * AB_IN * D * 2);
    take((size_t)2 * CD_IN * D * 2);
    take((size_t)2 * D * D * 2);
    take((size_t)2 * D * D * 2);
    take((size_t)2 * S5W * S5W * 2);
    take((size_t)4 * NE * 2 * DFF * D * 2);
    take((size_t)4 * NE * D * DFF * 2);
    take((size_t)2 * 2 * S5NCH * NG * NP * 2 * 4);
    take((size_t)2 * 2 * RNCH * 4 * 8192 * 4);
    take((size_t)2 * NTOK * 4 * RC * 4);
    take((size_t)2 * FNSEG * HYW * 4);
    take((size_t)256 * 2 * FFTN * 4);
    take((size_t)HYW * NLAT * 4);
    take((size_t)2 * NTOK * S5W * 4);
    take((size_t)HYW * NLAT * 4);
    take((size_t)2 * HYW * SEQ * 4);
    take((size_t)8 * 4 * 3 * 6 * D * 4);
    m.total = o; return m;
}
static inline void fill_params(P& p, void* const* d_in, void* d_out, void* d_ws) {
    const float* const* in = (const float* const*)d_in;
    p.x = in[0]; p.c = in[1]; p.ctx = in[2]; p.c_ctx = in[3]; p.mod_w = in[4]; p.mod_b = in[5]; p.norm1_g = in[6]; p.norm2_g = in[7];
    p.ab_w_in = in[8]; p.ab_w_out = in[9]; p.hy_short_w = in[10]; p.hy_short_b = in[11]; p.hy_f_w1 = in[12]; p.hy_f_b1 = in[13];
    p.hy_f_w2 = in[14]; p.hy_f_b2 = in[15]; p.hy_f_w3 = in[16]; p.hy_bias = in[17]; p.s5_lre = in[18]; p.s5_lim = in[19]; p.s5_ldt = in[20];
    p.s5_bre = in[21]; p.s5_bim = in[22]; p.s5_cre = in[23]; p.s5_cim = in[24]; p.s5_d = in[25]; p.s5_glu_w = in[26]; p.s5_glu_b = in[27];
    p.cd_w_in = in[28]; p.cd_w_out = in[29]; p.ret_decay = in[30]; p.swa_sink = in[31]; p.router_w = in[32]; p.router_b = in[33];
    p.w_gu = in[34]; p.b_gu = in[35]; p.w_dn = in[36]; p.b_dn = in[37]; p.final_g = in[38];
    p.out = (float*)d_out;
    const WsMap m = ws_map(); char* w = (char*)d_ws;
    p.bar = (unsigned*)(w + m.off[0]); p.xa = (float*)(w + m.off[1]); p.modv = (float*)(w + m.off[2]); p.f1 = (float*)(w + m.off[3]); p.f2 = (float*)(w + m.off[4]);
    p.hraw = (float*)(w + m.off[5]); p.hsum = (float*)(w + m.off[6]); p.rstd = (float*)(w + m.off[7]); p.hx = (float*)(w + m.off[8]); p.px = (px_t*)(w + m.off[9]);
    p.zb = (float*)(w + m.off[10]); p.x0c = (float*)(w + m.off[11]); p.mixin = (float*)(w + m.off[12]); p.s5s = (float*)(w + m.off[13]); p.ys5 = (float*)(w + m.off[14]);
    p.qr = (float*)(w + m.off[15]); p.kr = (float*)(w + m.off[16]); p.oret = (float*)(w + m.off[17]); p.qs = (float*)(w + m.off[18]); p.ks = (float*)(w + m.off[19]);
    p.topg = (float*)(w + m.off[20]); p.topi = (int*)(w + m.off[21]); p.act = nullptr;
    p.hxb = (bf16_t*)(w + m.off[23]); p.mixb = (bf16_t*)(w + m.off[24]); p.ys5b = (bf16_t*)(w + m.off[25]); p.xb = (bf16_t*)(w + m.off[26]); p.actb = (bf16_t*)(w + m.off[27]);
    p.yb = (bf16_t*)(w + m.off[28]); p.slot_gate = (float*)(w + m.off[29]); p.cnt = (int*)(w + m.off[30]); p.pos = (int*)(w + m.off[31]); p.slot_of = (int*)(w + m.off[32]);
    p.slot_tok = (int*)(w + m.off[33]); p.abin_t = (bf16_t*)(w + m.off[34]); p.cdin_t = (bf16_t*)(w + m.off[35]); p.about_t = (bf16_t*)(w + m.off[36]);
    p.cdout_t = (bf16_t*)(w + m.off[37]); p.glu_t = (bf16_t*)(w + m.off[38]); p.wgu_t = (bf16_t*)(w + m.off[39]); p.wdn_t = (bf16_t*)(w + m.off[40]);
    p.s5c = (float*)(w + m.off[41]); p.rkv = (float*)(w + m.off[42]); p.rsc = (float*)(w + m.off[43]); p.hpart = (float*)(w + m.off[44]);
    p.zf = (float*)(w + m.off[45]); p.convT = (float*)(w + m.off[46]); p.yd = (float*)(w + m.off[47]); p.zT = (float*)(w + m.off[48]); p.hT = (float*)(w + m.off[49]); p.modp = (float*)(w + m.off[50]);
}

#ifndef CPU_SHIM
namespace pg8 {
#define PG8_LAS __attribute__((address_space(3)))
typedef short bf16x8 __attribute__((ext_vector_type(8)));
typedef float f32x4 __attribute__((ext_vector_type(4)));
constexpr int BM = 256, BK = 64, HALF = 128, HTB = HALF * BK * 2, STAGE_BYTES = 8 * HTB, NXCD = 8, WGM = 8;
__host__ __device__ __forceinline__ int lds_byte(int r, int c) { const int st = (r >> 4) * 2 + (c >> 5), rr = r & 15, cc = c & 31, ob = rr * 64 + cc * 2; return st * 1024 + (ob ^ (((ob >> 9) & 1) << 5)); }
__host__ __device__ __forceinline__ void stage_rc(int b, int& R, int& C) { const int st = b / 1024, sb = b % 1024, swz = sb ^ (((sb >> 9) & 1) << 5); R = (st >> 1) * 16 + swz / 64; C = (st & 1) * 32 + (swz % 64) / 2; }
struct Unit { int pm, pn, e; };
struct Gemm { const bf16_t* A; const bf16_t* Bt; int M, N, K; size_t ebytes; };
struct StaticOrder {
    int nM, nN, nwg, G, c;
    __device__ void init(int M, int N, int G_, int c_) { nM = M / BM; nN = N / BM; nwg = nM * nN; G = G_; c = c_; }
    __device__ bool next(int i, Unit& u) const {
        const long L = (long)i * G + c; if (L >= nwg) return false;
        int wgid = (int)L; { const int q = nwg / NXCD, r = nwg % NXCD, xcd = wgid % NXCD, off = wgid / NXCD; wgid = (xcd < r ? xcd * (q + 1) : r * (q + 1) + (xcd - r) * q) + off; }
        const int nig = WGM * nN, gid = wgid / nig, fm = gid * WGM, gsz = (nM - fm) < WGM ? (nM - fm) : WGM;
        u.pm = fm + ((wgid % nig) % gsz); u.pn = (wgid % nig) / gsz; u.e = 0; return true;
    }
    __device__ int tok(int, int) const { return 0; }
};
struct MoeOrder {
    int nwg, nN, G, c; const volatile PG8_LAS unsigned char* ue; const volatile PG8_LAS int* tokt;
    __device__ int tok(int ui, int row) const { return tokt[ui * 256 + row]; }
    __device__ bool unit(int i, int& pm, int& pn) const {
        const int S = G >> 3;
        if ((G & 7) == 0 && S % nN == 0) { const int x = c & 7, slot = c >> 3, pmx = S / nN, T = nwg / nN, tpx = (T + 7) >> 3, lp = i * pmx + slot / nN;
            pm = x * tpx + lp; pn = slot % nN; return lp < tpx && pm < T; }
        const long L = (long)i * G + c; pm = (int)(L / nN); pn = (int)(L % nN); return L < nwg;
    }
    __device__ bool next(int i, Unit& u) const {
        int pm, pn; if (!unit(i, pm, pn)) return false;
        u.pm = pm; u.pn = pn; u.e = __builtin_amdgcn_readfirstlane((int)ue[pm]); return true;
    }
};
template <class Epi, class Sched, bool GATHER = false>
__device__ __forceinline__ void gemm_phase(PG8_LAS unsigned char* lds, const Gemm g, const Sched& S, const Epi& E) {
    int tid = threadIdx.x; asm volatile("" : "+v"(tid));
    const int wid = __builtin_amdgcn_readfirstlane(tid >> 6), lane = tid & 63, wr = wid >> 2, wc = wid & 3, fr = lane & 15, fq = lane >> 4;
    const int K = g.K, nt = K / BK;
    unsigned va[2][2], vn[2][2], voffB[2]; int Rr[2]; unsigned Cb[2];
#pragma unroll
    for (int i = 0; i < 2; ++i) { int R, C; stage_rc(tid * 16 + i * 8192, R, C); Rr[i] = R; Cb[i] = (unsigned)C * 2u; voffB[i] = (unsigned)(R * K + C) * 2u; }
    const size_t kstep = (size_t)(BK * 2);
    const size_t hstep = (size_t)HALF * K * 2;
    const size_t tstep = 2 * hstep;
#define PG8_SETOFF(v, ui_) do { _Pragma("unroll") for (int h_ = 0; h_ < 2; ++h_) _Pragma("unroll") for (int i_ = 0; i_ < 2; ++i_) \
        v[h_][i_] = GATHER ? (unsigned)S.tok(ui_, h_ * HALF + Rr[i_]) * (unsigned)(K * 2) + Cb[i_] : voffB[i_] + (unsigned)(h_ * hstep); } while (0)
    const unsigned ldsw = (unsigned)wid * 1024u;
    const int aoff = lds_byte(wr * 64 + fr, fq * 8), boff = lds_byte(wc * 32 + fr, fq * 8);
#define PG8_SA(b, h) (((b) * 2 + (h)) * HTB)
#define PG8_SB(b, h) ((4 + (b) * 2 + (h)) * HTB)
#define PG8_STAGE(bufoff, gbase, voff) do { _Pragma("unroll") for (int _i = 0; _i < 2; ++_i) \
        __builtin_amdgcn_global_load_lds((const unsigned*)((const char*)(gbase) + (voff)[_i]), (PG8_LAS unsigned*)(lds + (bufoff) + ldsw + _i * 8192), 16, 0, 0); } while (0)
#define PG8_LDA(dst, b, h) do { _Pragma("unroll") for (int m = 0; m < 4; ++m) _Pragma("unroll") for (int k = 0; k < 2; ++k) dst[m][k] = *(const PG8_LAS bf16x8*)(lds + PG8_SA(b, h) + aoff + m * 2048 + k * 1024); } while (0)
#define PG8_LDB(dst, b, h) do { _Pragma("unroll") for (int n = 0; n < 2; ++n) _Pragma("unroll") for (int k = 0; k < 2; ++k) dst[n][k] = *(const PG8_LAS bf16x8*)(lds + PG8_SB(b, h) + boff + n * 2048 + k * 1024); } while (0)
#define PG8_MMA(ai, bj, At, Bt) do { __builtin_amdgcn_s_setprio(1); _Pragma("unroll") for (int m = 0; m < 4; ++m) _Pragma("unroll") for (int n = 0; n < 2; ++n) _Pragma("unroll") for (int k = 0; k < 2; ++k) \
        acc[ai][bj][m][n] = __builtin_amdgcn_mfma_f32_16x16x32_bf16(Bt[n][k], At[m][k], acc[ai][bj][m][n], 0, 0, 0); __builtin_amdgcn_s_setprio(0); } while (0)
#define PG8_WAIT_V(n) asm volatile("s_waitcnt vmcnt(" #n ")" ::: "memory")
#define PG8_WAIT_L(n) asm volatile("s_waitcnt lgkmcnt(" #n ")" ::: "memory")
#define PG8_BAR __builtin_amdgcn_s_barrier()
#define PG8_SCHED __builtin_amdgcn_sched_barrier(0)
    Unit cur, nxt; int ui = 0;
    if (!S.next(0, cur)) return;
    f32x4 acc[2][2][4][2];
#pragma unroll
    for (int a = 0; a < 2; ++a)
#pragma unroll
        for (int b = 0; b < 2; ++b)
#pragma unroll
            for (int m = 0; m < 4; ++m)
#pragma unroll
                for (int n = 0; n < 2; ++n) acc[a][b][m][n] = (f32x4){0.f, 0.f, 0.f, 0.f};
    bf16x8 At[4][2], B0[2][2], B1[2][2];
    const char* cA = (const char*)g.A + (GATHER ? (size_t)0 : (size_t)cur.pm * tstep); const char* cB = (const char*)g.Bt + (size_t)cur.e * g.ebytes + (size_t)cur.pn * tstep;
    PG8_SETOFF(va, 0);
    PG8_STAGE(PG8_SB(0, 0), cB, voffB); PG8_STAGE(PG8_SB(0, 1), cB + hstep, voffB); PG8_STAGE(PG8_SA(0, 0), cA, va[0]); PG8_STAGE(PG8_SA(0, 1), cA, va[1]);
    if (wr == 1) PG8_BAR;
    PG8_WAIT_V(2); PG8_BAR;
    PG8_STAGE(PG8_SB(1, 0), cB + kstep, voffB); PG8_STAGE(PG8_SA(1, 0), cA + kstep, va[0]); PG8_STAGE(PG8_SB(1, 1), cB + hstep + kstep, voffB);
    PG8_WAIT_V(6); PG8_BAR;
    for (;;) {
        const bool has_next = S.next(ui + 1, nxt);
        const char* nA = has_next ? (const char*)g.A + (GATHER ? (size_t)0 : (size_t)nxt.pm * tstep) : cA; const char* nB = has_next ? (const char*)g.Bt + (size_t)nxt.e * g.ebytes + (size_t)nxt.pn * tstep : cB;
        if (GATHER && has_next) PG8_SETOFF(vn, ui + 1); else { _Pragma("unroll") for (int h_ = 0; h_ < 2; ++h_) _Pragma("unroll") for (int i_ = 0; i_ < 2; ++i_) vn[h_][i_] = va[h_][i_]; }
        for (int t = 0; t < nt; t += 2) {
            const bool last = (t == nt - 2);
            const char* a1 = cA + (size_t)(t + 1) * kstep;
            const char* a2 = last ? nA : cA + (size_t)(t + 2) * kstep; const char* b2 = last ? nB : cB + (size_t)(t + 2) * kstep;
            const char* a3 = a2 + kstep; const char* b3 = b2 + kstep;
            unsigned s0[2], s1[2];
#pragma unroll
            for (int i_ = 0; i_ < 2; ++i_) { s0[i_] = last ? vn[0][i_] : va[0][i_]; s1[i_] = last ? vn[1][i_] : va[1][i_]; }
            PG8_LDB(B0, 0, 0); PG8_LDB(B1, 0, 1); PG8_SCHED; PG8_LDA(At, 0, 0); PG8_STAGE(PG8_SA(1, 1), a1, va[1]);
            PG8_WAIT_V(8); PG8_WAIT_L(0); PG8_BAR; PG8_MMA(0, 0, At, B0); PG8_MMA(0, 1, At, B1); PG8_BAR; PG8_SCHED;
            PG8_LDA(At, 0, 1); PG8_STAGE(PG8_SB(0, 0), b2, voffB); PG8_STAGE(PG8_SB(0, 1), b2 + hstep, voffB); PG8_STAGE(PG8_SA(0, 0), a2, s0);
            PG8_WAIT_V(8); PG8_WAIT_L(0); PG8_BAR; PG8_MMA(1, 0, At, B0); PG8_MMA(1, 1, At, B1); PG8_BAR; PG8_SCHED;
            PG8_LDB(B0, 1, 0); PG8_LDB(B1, 1, 1); PG8_SCHED; PG8_LDA(At, 1, 0); PG8_STAGE(PG8_SA(0, 1), a2, s1);
            PG8_WAIT_V(8); PG8_WAIT_L(0); PG8_BAR; PG8_MMA(0, 0, At, B0); PG8_MMA(0, 1, At, B1); PG8_BAR; PG8_SCHED;
            PG8_LDA(At, 1, 1); PG8_STAGE(PG8_SB(1, 0), b3, voffB); PG8_STAGE(PG8_SB(1, 1), b3 + hstep, voffB); PG8_STAGE(PG8_SA(1, 0), a3, s0);
            PG8_WAIT_V(8); PG8_WAIT_L(0); PG8_BAR; PG8_MMA(1, 0, At, B0); PG8_MMA(1, 1, At, B1); PG8_BAR; PG8_SCHED;
        }
        if (wr == 0) PG8_BAR;
        E(acc, cur, wr, wc, fr, fq);
        if (!has_next) break;
#pragma unroll
        for (int a = 0; a < 2; ++a)
#pragma unroll
            for (int b = 0; b < 2; ++b)
#pragma unroll
                for (int m = 0; m < 4; ++m)
#pragma unroll
                    for (int n = 0; n < 2; ++n) acc[a][b][m][n] = (f32x4){0.f, 0.f, 0.f, 0.f};
        cur = nxt; cA = nA; cB = nB; ++ui;
#pragma unroll
        for (int h_ = 0; h_ < 2; ++h_)
#pragma unroll
            for (int i_ = 0; i_ < 2; ++i_) va[h_][i_] = vn[h_][i_];
        if (wr == 1) PG8_BAR;
    }
    PG8_WAIT_V(0);
    PG8_BAR;
#undef PG8_SA
#undef PG8_SB
#undef PG8_STAGE
#undef PG8_SETOFF
#undef PG8_LDA
#undef PG8_LDB
#undef PG8_MMA
#undef PG8_WAIT_V
#undef PG8_WAIT_L
#undef PG8_BAR
#undef PG8_SCHED
}
typedef float f32x2v __attribute__((ext_vector_type(2)));
typedef __bf16 bf16x2v __attribute__((ext_vector_type(2)));
__device__ __forceinline__ unsigned cvt_pk_bf16(float lo, float hi) { const bf16x2v r = __builtin_convertvector((f32x2v){lo, hi}, bf16x2v); return __builtin_bit_cast(unsigned, r); }
__device__ __forceinline__ float fast_sigmoid(float x) { return __builtin_amdgcn_rcpf(1.0f + __builtin_amdgcn_exp2f(-1.4426950408889634f * x)); }
#define EPI_LOOP(body) _Pragma("unroll") for (int ai = 0; ai < 2; ++ai) _Pragma("unroll") for (int m = 0; m < 4; ++m) { const int row = row0 + ai * HALF + m * 16; \
    _Pragma("unroll") for (int bj = 0; bj < 2; ++bj) _Pragma("unroll") for (int n = 0; n < 2; ++n) { const int col = col0 + bj * HALF + n * 16; const f32x4 a = acc[ai][bj][m][n]; body } }
struct EpiStoreF32 {
    float* C; int ldc;
    __device__ __forceinline__ void operator()(const f32x4 (&acc)[2][2][4][2], const Unit& u, int wr, int wc, int fr, int fq) const {
        const int row0 = u.pm * BM + wr * 64 + fr, col0 = u.pn * BM + wc * 32 + 4 * fq;
        EPI_LOOP( *(f32x4*)(C + (size_t)row * ldc + col) = a; )
    }
};
struct EpiStoreBf16 {
    bf16_t* C; int ldc;
    __device__ __forceinline__ void operator()(const f32x4 (&acc)[2][2][4][2], const Unit& u, int wr, int wc, int fr, int fq) const {
        const int row0 = u.pm * BM + wr * 64 + fr, col0 = u.pn * BM + wc * 32 + 4 * fq;
        EPI_LOOP( uint2 o; o.x = cvt_pk_bf16(a[0], a[1]); o.y = cvt_pk_bf16(a[2], a[3]); *(uint2*)(C + (size_t)row * ldc + col) = o; )
    }
};
struct EpiResid {
    float* X; const float* gv;
    __device__ __forceinline__ void operator()(const f32x4 (&acc)[2][2][4][2], const Unit& u, int wr, int wc, int fr, int fq) const {
        const int row0 = u.pm * BM + wr * 64 + fr, col0 = u.pn * BM + wc * 32 + 4 * fq;
        const int r0 = u.pm * BM, mrow = r0 < SEQ ? 0 : (r0 < NLAT ? 1 : 2); const float* g = gv + (size_t)mrow * 6 * D;
        EPI_LOOP( const f32x4 gg = *(const f32x4*)(g + col); f32x4* q = (f32x4*)(X + (size_t)row * D + col); *q = *q + gg * a; )
    }
};
struct EpiGlu {
    bf16_t* O; const bf16_t* Y; const float* bias;
    __device__ __forceinline__ void operator()(const f32x4 (&acc)[2][2][4][2], const Unit& u, int wr, int wc, int fr, int fq) const {
        const int row0 = u.pm * BM + wr * 64 + fr, col0 = u.pn * BM + wc * 32 + 4 * fq;
        EPI_LOOP( const f32x4 bb = *(const f32x4*)(bias + col); const ushort4 yv = *(const ushort4*)(Y + (size_t)row * S5W + col);
            uint2 o; o.x = cvt_pk_bf16(bf2f(yv.x) * fast_sigmoid(a[0] + bb[0]), bf2f(yv.y) * fast_sigmoid(a[1] + bb[1])); o.y = cvt_pk_bf16(bf2f(yv.z) * fast_sigmoid(a[2] + bb[2]), bf2f(yv.w) * fast_sigmoid(a[3] + bb[3]));
            *(uint2*)(O + (size_t)row * D + HYW + col) = o; )
    }
};
struct EpiSwiglu {
    bf16_t* O; const float* bgu;
    __device__ __forceinline__ void operator()(const f32x4 (&acc)[2][2][4][2], const Unit& u, int wr, int wc, int fr, int fq) const {
        const int row0 = u.pm * BM + wr * 64 + fr, colb = wc * 32 + 4 * fq; const float* bb = bgu + (size_t)u.e * 2 * DFF + u.pn * 128;
#pragma unroll
        for (int ai = 0; ai < 2; ++ai)
#pragma unroll
            for (int m = 0; m < 4; ++m) { const int row = row0 + ai * HALF + m * 16;
#pragma unroll
                for (int n = 0; n < 2; ++n) { const int cc = colb + n * 16; const f32x4 bg = *(const f32x4*)(bb + cc), bu = *(const f32x4*)(bb + DFF + cc);
                    const f32x4 ga = acc[ai][0][m][n] + bg, up = acc[ai][1][m][n] + bu; float av[4];
#pragma unroll
                    for (int j = 0; j < 4; ++j) { const float gg = fminf(ga[j], 7.0f), uu = fminf(fmaxf(up[j], -7.0f), 7.0f); av[j] = gg * fast_sigmoid(1.702f * gg) * (uu + 1.0f); }
                    uint2 o; o.x = cvt_pk_bf16(av[0], av[1]); o.y = cvt_pk_bf16(av[2], av[3]);
                    *(uint2*)(O + (size_t)row * DFF + u.pn * 128 + cc) = o; } }
    }
};
struct EpiDown {
    bf16_t* Y; const float* bdn; const float* gate;
    __device__ __forceinline__ void operator()(const f32x4 (&acc)[2][2][4][2], const Unit& u, int wr, int wc, int fr, int fq) const {
        const int row0 = u.pm * BM + wr * 64 + fr, col0 = u.pn * BM + wc * 32 + 4 * fq; const float* bb = bdn + (size_t)u.e * D;
        EPI_LOOP( const f32x4 bv = *(const f32x4*)(bb + col); const float gt_ = gate[row]; const f32x4 o = (a + bv) * gt_; uint2 ob; ob.x = cvt_pk_bf16(o[0], o[1]); ob.y = cvt_pk_bf16(o[2], o[3]); *(uint2*)(Y + (size_t)row * D + col) = ob; )
    }
};
}

constexpr int RING_BYTES = 131072, SCRATCH_BYTES = 135168, MISC_OFF = SCRATCH_BYTES, UE_OFF = MISC_OFF + 64, TOK_OFF = UE_OFF + 320, TOK_UNITS = 11, LDS_BYTES = 147456;
static_assert(FFT_ELEMS * 8 <= SCRATCH_BYTES && TOK_OFF + TOK_UNITS * 1024 <= LDS_BYTES && ((NSLOT / 256 + 7) / 8 + 3) / 4 <= TOK_UNITS, "LDS map");
#define LAS __attribute__((address_space(3)))

__device__ __forceinline__ void transpose_item(const float* W, int K, int N, bf16_t* WT, int gu_perm, LAS float* scr, int item, int lane) {
    const int nblk = N / 32, kb = item / nblk, nb = item % nblk, k0 = 64 * kb, n0 = 32 * nb;
    const int r0 = gu_perm ? (n0 < DFF ? (n0 / 128) * 256 + (n0 % 128) : ((n0 - DFF) / 128) * 256 + 128 + ((n0 - DFF) % 128)) : n0;
#pragma unroll 8
    for (int i = 0; i < 32; ++i) { const int kk = 2 * i + (lane >> 5); scr[kk * 33 + (lane & 31)] = W[(size_t)(k0 + kk) * N + n0 + (lane & 31)]; }
    asm volatile("s_waitcnt lgkmcnt(0)" ::: "memory");
    const int c = lane & 7;
#pragma unroll
    for (int j = 0; j < 4; ++j) { const int n = (lane >> 3) + 8 * j; const LAS float* s = scr + (8 * c) * 33 + n;
        uint4 o; o.x = f2bf(s[0 * 33]) | ((unsigned)f2bf(s[1 * 33]) << 16); o.y = f2bf(s[2 * 33]) | ((unsigned)f2bf(s[3 * 33]) << 16);
        o.z = f2bf(s[4 * 33]) | ((unsigned)f2bf(s[5 * 33]) << 16); o.w = f2bf(s[6 * 33]) | ((unsigned)f2bf(s[7 * 33]) << 16);
        *(uint4*)(WT + (size_t)(r0 + n) * K + k0 + 8 * c) = o; }
    asm volatile("s_waitcnt lgkmcnt(0)" ::: "memory");
}
constexpr int I_GU = (D / 64) * (2 * DFF / 32), I_DN = (DFF / 64) * (D / 32), EXP_ITEMS = NE * (I_GU + I_DN);
__device__ __forceinline__ void convert_expert_item(const P& p, int l, int q, LAS float* scr, int lane) {
    if (q < NE * I_GU) { const int e = q / I_GU; const size_t i = (size_t)l * NE + e; transpose_item(p.w_gu + i * D * 2 * DFF, D, 2 * DFF, p.wgu_t + i * 2 * DFF * D, 1, scr, q % I_GU, lane); }
    else { const int q2 = q - NE * I_GU, e = q2 / I_DN; const size_t i = (size_t)l * NE + e; transpose_item(p.w_dn + i * DFF * D, DFF, D, p.wdn_t + i * D * DFF, 0, scr, q2 % I_DN, lane); }
}
constexpr int DEFER_Q1 = 64, DEFER_Q2 = 140;
__device__ __forceinline__ int defer_idle(int units, int G) { const int rem = units % G; return rem ? G - rem : 0; }
__device__ __forceinline__ int defer_in_units(int layer) { return (NTOK / 256) * ((layer & 1) ? CD_IN / 256 : AB_IN / 256); }
__device__ __forceinline__ int defer_d1(int layer, int G) { const int n = defer_idle(defer_in_units(layer), G) * DEFER_Q1; return n < EXP_ITEMS ? n : EXP_ITEMS; }
__device__ __forceinline__ int defer_d2(int layer, int G) { const int d1 = defer_d1(layer, G), n = d1 + defer_idle((NTOK / 256) * (D / 256), G) * DEFER_Q2; return n < EXP_ITEMS ? n : EXP_ITEMS; }
__device__ __forceinline__ void convert_deferred(const P& p, LAS unsigned char* lds, int layer, int which) {
    int tid = threadIdx.x; asm volatile("" : "+v"(tid));
    int bx_ = (int)blockIdx.x, gx_ = (int)gridDim.x; asm volatile("" : "+s"(bx_), "+s"(gx_));
    const int units = which ? (NTOK / 256) * (D / 256) : defer_in_units(layer), rem = units % gx_;
    if (rem == 0 || bx_ < rem) return;
    const int lane = tid & 63, wave = tid >> 6; LAS float* scr = (LAS float*)(lds + wave * 16384);
    const int qn = which ? DEFER_Q2 : DEFER_Q1, q0 = (which ? defer_d1(layer, gx_) : 0) + (bx_ - rem) * qn, qend = which ? defer_d2(layer, gx_) : defer_d1(layer, gx_);
    for (int q = q0 + wave; q < q0 + qn && q < qend; q += 8) convert_expert_item(p, layer + 1, q, scr, lane);
}
__device__ __forceinline__ void ph_convert_weights(const P& p, LAS unsigned char* lds) {
    int tid = threadIdx.x; asm volatile("" : "+v"(tid));
    const int lane = tid & 63, wave = tid >> 6;
    LAS float* scr = (LAS float*)(lds + wave * 16384);
    const long gw = (long)blockIdx.x * 8 + wave, NGW = (long)gridDim.x * 8; const int G = (int)gridDim.x;
    constexpr long I_ABIN = (D / 64) * (AB_IN / 32), I_CDIN = (D / 64) * (CD_IN / 32), I_OUT = (D / 64) * (D / 32), I_GLU = (S5W / 64) * (S5W / 32);
    constexpr long T0 = 2 * I_ABIN, T1 = T0 + 2 * I_CDIN, T2 = T1 + 2 * I_OUT, T3 = T2 + 2 * I_OUT, T4 = T3 + 2 * I_GLU;
    for (long it = gw; it < T4; it += NGW) {
        if (it < T0) { const int i = (int)(it / I_ABIN); transpose_item(p.ab_w_in + (size_t)i * D * AB_IN, D, AB_IN, p.abin_t + (size_t)i * AB_IN * D, 0, scr, (int)(it % I_ABIN), lane); }
        else if (it < T1) { const long r = it - T0; const int i = (int)(r / I_CDIN); transpose_item(p.cd_w_in + (size_t)i * D * CD_IN, D, CD_IN, p.cdin_t + (size_t)i * CD_IN * D, 0, scr, (int)(r % I_CDIN), lane); }
        else if (it < T2) { const long r = it - T1; const int i = (int)(r / I_OUT); transpose_item(p.ab_w_out + (size_t)i * D * D, D, D, p.about_t + (size_t)i * D * D, 0, scr, (int)(r % I_OUT), lane); }
        else if (it < T3) { const long r = it - T2; const int i = (int)(r / I_OUT); transpose_item(p.cd_w_out + (size_t)i * D * D, D, D, p.cdout_t + (size_t)i * D * D, 0, scr, (int)(r % I_OUT), lane); }
        else { const long r = it - T3; const int i = (int)(r / I_GLU); transpose_item(p.s5_glu_w + (size_t)i * S5W * S5W, S5W, S5W, p.glu_t + (size_t)i * S5W * S5W, 0, scr, (int)(r % I_GLU), lane); }
    }
    for (int l = 0; l < 4; ++l) { const int qs = l ? defer_d2(l - 1, G) : 0;
        for (long q = qs + gw; q < EXP_ITEMS; q += NGW) convert_expert_item(p, l, (int)q, scr, lane); }
}
constexpr int NTHREADS = 512;
__device__ __forceinline__ float wave_sum(float v) {
#pragma unroll
    for (int o = 1; o < 64; o <<= 1) v += __shfl_xor(v, o);
    return v;
}
template <int CTRL> __device__ __forceinline__ float dppf(float v) { return __builtin_bit_cast(float, __builtin_amdgcn_update_dpp(0, __builtin_bit_cast(int, v), CTRL, 0xf, 0xf, false)); }
template <int CTRL> __device__ __forceinline__ int dppi(int v) { return __builtin_amdgcn_update_dpp(0, v, CTRL, 0xf, 0xf, false); }
__device__ __forceinline__ float row16_max(float x) { x = fmaxf(x, dppf<0xB1>(x)); x = fmaxf(x, dppf<0x4E>(x)); x = fmaxf(x, dppf<0x141>(x)); x = fmaxf(x, dppf<0x140>(x)); return x; }
__device__ __forceinline__ float row16_sum(float x) { x += dppf<0xB1>(x); x += dppf<0x4E>(x); x += dppf<0x141>(x); x += dppf<0x140>(x); return x; }
__device__ __forceinline__ int row16_min(int x) { x = min(x, dppi<0xB1>(x)); x = min(x, dppi<0x4E>(x)); x = min(x, dppi<0x141>(x)); x = min(x, dppi<0x140>(x)); return x; }
template <int L> __device__ __forceinline__ float rowb(float v) { return __builtin_bit_cast(float, __builtin_amdgcn_update_dpp(0, __builtin_bit_cast(int, v), 0x150 + L, 0xf, 0xf, false)); }
template <int L> __device__ __forceinline__ void route_steps(float val, const LAS float* wq, float& a0, float& a1) {
    const float xb = rowb<L>(val); const pg8::f32x2v w = *(const LAS pg8::f32x2v*)(wq + (4 * L) * 32);
    a0 += xb * w.x; a1 += xb * w.y;
    if constexpr (L + 1 < 16) route_steps<L + 1>(val, wq, a0, a1);
}
template <int MODE> __device__ __forceinline__ void mf_rownorm(const P& p, LAS unsigned char* lds, int layer, int nrows, int comb_layer) {
    constexpr bool ROUTE = MODE == 1; constexpr int which = MODE == 1 ? 1 : 0;
    int tid = threadIdx.x; asm volatile("" : "+v"(tid));
    int bx_ = (int)blockIdx.x, gx_ = (int)gridDim.x; asm volatile("" : "+s"(bx_), "+s"(gx_));
    const int lane = tid & 63, wave = tid >> 6;
    if (ROUTE) { for (int j = bx_ * NTHREADS + tid; j < NSLOT; j += gx_ * NTHREADS) { p.slot_tok[j] = -1; p.slot_gate[j] = 0.f; } }
    const float* gn = MODE == 2 ? p.final_g : (which ? p.norm2_g : p.norm1_g) + layer * D;
    LAS float* Wl = (LAS float*)lds;
    if (ROUTE) { const float* rw = p.router_w + (size_t)layer * D * NE;
        for (int i = tid; i < D * NE / 4; i += NTHREADS) { const float4 w4 = *(const float4*)(rw + 4 * i); const int k = i >> 3, e0 = (i & 7) * 4, kp = k ^ ((k >> 6) & 1);
            const float wv[4] = {w4.x, w4.y, w4.z, w4.w};
#pragma unroll
            for (int t = 0; t < 4; ++t) { const int e = e0 + t; Wl[kp * 32 + 2 * (e & 15) + (e >> 4)] = wv[t]; } }
        __syncthreads(); }
    volatile LAS int* lcnt = (volatile LAS int*)(lds + RING_BYTES);
    volatile LAS int* lbase = lcnt + NE; volatile LAS int* lrank = lcnt + 2 * NE;
    if (ROUTE) { if (tid < NE) lcnt[tid] = 0; __syncthreads(); }
    for (int r = bx_ * 8 + wave; r < nrows; r += gx_ * 8) {
        const int m = r < SEQ ? 0 : (r < NLAT ? 1 : 2);
        const float* mv = p.modv + ((size_t)layer * 3 + m) * 6 * D + which * 3 * D;
        float* xr = p.xa + (size_t)r * D;
        float4 v[4]; float ss = 0.f;
#pragma unroll
        for (int j = 0; j < 4; ++j) v[j] = *(const float4*)(xr + 256 * j + 4 * lane);
        if (comb_layer >= 0) {
            const float* g2 = p.modv + ((size_t)comb_layer * 3 + m) * 6 * D + 5 * D;
            const int4 so = *(const int4*)(p.slot_of + r * 4);
            const bf16_t* y0 = p.yb + (size_t)so.x * D; const bf16_t* y1 = p.yb + (size_t)so.y * D; const bf16_t* y2 = p.yb + (size_t)so.z * D; const bf16_t* y3 = p.yb + (size_t)so.w * D;
#pragma unroll
            for (int j = 0; j < 4; ++j) { const int k = 256 * j + 4 * lane; const ushort4 a = *(const ushort4*)(y0 + k), b = *(const ushort4*)(y1 + k), c = *(const ushort4*)(y2 + k), d = *(const ushort4*)(y3 + k); const float4 gg = *(const float4*)(g2 + k);
                v[j].x += gg.x * (bf2f(a.x) + bf2f(b.x) + bf2f(c.x) + bf2f(d.x)); v[j].y += gg.y * (bf2f(a.y) + bf2f(b.y) + bf2f(c.y) + bf2f(d.y));
                v[j].z += gg.z * (bf2f(a.z) + bf2f(b.z) + bf2f(c.z) + bf2f(d.z)); v[j].w += gg.w * (bf2f(a.w) + bf2f(b.w) + bf2f(c.w) + bf2f(d.w));
                if (MODE != 2) *(float4*)(xr + k) = v[j]; }
        }
#pragma unroll
        for (int j = 0; j < 4; ++j) ss += v[j].x * v[j].x + v[j].y * v[j].y + v[j].z * v[j].z + v[j].w * v[j].w;
        const float rstd = rsqrtf(wave_sum(ss) * (1.0f / D) + EPS);
        if (MODE == 2) {
#pragma unroll
            for (int j = 0; j < 4; ++j) { const int k = 256 * j + 4 * lane; const float4 g4 = *(const float4*)(gn + k);
                float4 o; o.x = v[j].x * rstd * g4.x; o.y = v[j].y * rstd * g4.y; o.z = v[j].z * rstd * g4.z; o.w = v[j].w * rstd * g4.w;
                *(float4*)(p.out + (size_t)r * D + k) = o; }
            continue;
        }
#pragma unroll
        for (int j = 0; j < 4; ++j) { const int k = 256 * j + 4 * lane; const float4 g4 = *(const float4*)(gn + k), sc = *(const float4*)(mv + D + k), sh = *(const float4*)(mv + k);
            v[j].x = v[j].x * rstd * g4.x * (1.0f + sc.x) + sh.x; v[j].y = v[j].y * rstd * g4.y * (1.0f + sc.y) + sh.y;
            v[j].z = v[j].z * rstd * g4.z * (1.0f + sc.z) + sh.z; v[j].w = v[j].w * rstd * g4.w * (1.0f + sc.w) + sh.w;
            ushort4 o; o.x = f2bf(v[j].x); o.y = f2bf(v[j].y); o.z = f2bf(v[j].z); o.w = f2bf(v[j].w);
            *(ushort4*)(p.hxb + (size_t)r * D + k) = o; }
        if (ROUTE) {
            const int cl = lane & 15, Rr = lane >> 4, r1 = Rr & 1;
            const LAS float* wbE = Wl + (64 * Rr) * 32 + 2 * cl + r1 * 32;
            const LAS float* wbO = Wl + (64 * Rr) * 32 + 2 * cl - r1 * 32;
            float acc0 = 0.f, acc1 = 0.f;
#pragma unroll
            for (int j = 0; j < 4; ++j) { const float vq[4] = {v[j].x, v[j].y, v[j].z, v[j].w};
#pragma unroll
                for (int q = 0; q < 4; ++q) { route_steps<0>(vq[q], ((q & 1) ? wbO : wbE) + (256 * j + q) * 32, acc0, acc1); __builtin_amdgcn_sched_barrier(0); } }
            acc0 += __shfl_xor(acc0, 16); acc0 += __shfl_xor(acc0, 32); acc1 += __shfl_xor(acc1, 16); acc1 += __shfl_xor(acc1, 32);
            acc0 += p.router_b[layer * NE + cl]; acc1 += p.router_b[layer * NE + 16 + cl];
            int ti[4]; float tv[4];
#pragma unroll
            for (int s = 0; s < 4; ++s) {
                const float vmax = row16_max(fmaxf(acc0, acc1));
                const int cand = acc0 == vmax ? cl : (acc1 == vmax ? cl + 16 : 64), best = row16_min(cand);
                ti[s] = best; tv[s] = vmax;
                if (best == cl) acc0 = -3.0e38f; if (best == cl + 16) acc1 = -3.0e38f;
            }
            if (lane == 0) {
                const float e1 = expf(tv[1] - tv[0]), e2 = expf(tv[2] - tv[0]), e3 = expf(tv[3] - tv[0]), inv = 1.0f / (1.0f + e1 + e2 + e3);
                p.topi[r * 4 + 0] = ti[0]; p.topi[r * 4 + 1] = ti[1]; p.topi[r * 4 + 2] = ti[2]; p.topi[r * 4 + 3] = ti[3];
                p.topg[r * 4 + 0] = inv; p.topg[r * 4 + 1] = e1 * inv; p.topg[r * 4 + 2] = e2 * inv; p.topg[r * 4 + 3] = e3 * inv;
                const int li = ((r - (bx_ * 8 + wave)) / (gx_ * 8)) * 8 + wave;
#pragma unroll
                for (int s = 0; s < 4; ++s) lrank[li * 4 + s] = __hip_atomic_fetch_add((LAS int*)(lcnt + ti[s]), 1, __ATOMIC_RELAXED, __HIP_MEMORY_SCOPE_WORKGROUP);
            }
        }
    }
    if (ROUTE) {
        __syncthreads();
        if (tid < NE) lbase[tid] = atomicAdd(p.cnt + layer * NE + tid, lcnt[tid]);
        __syncthreads();
        const int nmine = (nrows - bx_ * 8 + gx_ * 8 - 1) / (gx_ * 8) * 8;
        for (int i = tid; i < nmine * 4; i += NTHREADS) { const int li = i >> 2, r = bx_ * 8 + (li & 7) + (li >> 3) * gx_ * 8;
            if (r < nrows) p.pos[r * 4 + (i & 3)] = lbase[p.topi[i - li * 4 + r * 4]] + lrank[i]; }
    }
}
__device__ __forceinline__ float4 ld4px(const float* q) { return *(const float4*)q; }
__device__ __forceinline__ float4 ld4px(const bf16_t* q) { const ushort4 v = *(const ushort4*)q; return make_float4(bf2f(v.x), bf2f(v.y), bf2f(v.z), bf2f(v.w)); }
typedef unsigned short us4v __attribute__((ext_vector_type(4)));
__device__ __forceinline__ us4v pack4(float4 v) { return (us4v){f2bf(v.x), f2bf(v.y), f2bf(v.z), f2bf(v.w)}; }
template <int K> __device__ __forceinline__ pg8::f32x4 mma16(const LAS bf16_t* A, int lda, const LAS bf16_t* Bt, int ldb, pg8::f32x4 acc, int lane) {
    const int r = lane & 15, q = lane >> 4;
    const LAS bf16_t* ap = A + r * lda + 8 * q; const LAS bf16_t* bp = Bt + r * ldb + 8 * q;
#pragma unroll
    for (int k0 = 0; k0 < K; k0 += 32) acc = __builtin_amdgcn_mfma_f32_16x16x32_bf16(*(const LAS pg8::bf16x8*)(ap + k0), *(const LAS pg8::bf16x8*)(bp + k0), acc, 0, 0, 0);
    return acc;
}
constexpr int RLD = 136, RLQ = 72;
__device__ __forceinline__ void mf_retkv(const P& p, LAS unsigned char* lds, int il) {
    int tid = threadIdx.x; asm volatile("" : "+v"(tid));
    int bx_ = (int)blockIdx.x, gx_ = (int)gridDim.x; asm volatile("" : "+s"(bx_), "+s"(gx_));
    const int lane = tid & 63, wave = tid >> 6, r = lane & 15, q = lane >> 4;
    LAS bf16_t* KdT = (LAS bf16_t*)lds; LAS bf16_t* VT = KdT + 64 * RLD;
    for (int u = bx_; u < 16 * RNCH; u += gx_) {
        const int n = u % RNCH, h = (u / RNCH) & 3, b = (u / (RNCH * 4)) & 1, dir = u / (RNCH * 8);
        const float lg = ret_logg(p, il, dir, h);
        __syncthreads();
        for (int idx = tid; idx < 128 * 16; idx += NTHREADS) { const int j = idx >> 4, d4 = idx & 15, row = scan_row(dir, b, n * RC + j);
            const float4 kv = *(const float4*)(p.kr + (size_t)row * 256 + h * 64 + 4 * d4); const float dk = fexp((float)(RC - 1 - j) * lg);
            KdT[(4 * d4 + 0) * RLD + j] = f2bf(kv.x * dk); KdT[(4 * d4 + 1) * RLD + j] = f2bf(kv.y * dk); KdT[(4 * d4 + 2) * RLD + j] = f2bf(kv.z * dk); KdT[(4 * d4 + 3) * RLD + j] = f2bf(kv.w * dk); }
        for (int idx = tid; idx < 128 * 32; idx += NTHREADS) { const int j = idx >> 5, e4 = idx & 31, row = scan_row(dir, b, n * RC + j);
            const float4 vv = ld4px(p.px + (size_t)row * PXLD + 512 + h * 128 + 4 * e4);
            VT[(4 * e4 + 0) * RLD + j] = f2bf(vv.x); VT[(4 * e4 + 1) * RLD + j] = f2bf(vv.y); VT[(4 * e4 + 2) * RLD + j] = f2bf(vv.z); VT[(4 * e4 + 3) * RLD + j] = f2bf(vv.w); }
        __syncthreads();
        float* o = p.rkv + ((((size_t)dir * 2 + b) * RNCH + n) * 4 + h) * 8192;
#pragma unroll
        for (int td = 0; td < 4; ++td) { pg8::f32x4 acc = {0.f, 0.f, 0.f, 0.f};
            acc = mma16<128>(VT + (16 * wave) * RLD, RLD, KdT + (16 * td) * RLD, RLD, acc, lane);
#pragma unroll
            for (int g = 0; g < 4; ++g) o[(size_t)(16 * wave + 4 * q + g) * 64 + 16 * td + r] = acc[g]; }
    }
}
__device__ __forceinline__ void mf_reto(const P& p, LAS unsigned char* lds, int il) {
    int tid = threadIdx.x; asm volatile("" : "+v"(tid));
    int bx_ = (int)blockIdx.x, gx_ = (int)gridDim.x; asm volatile("" : "+s"(bx_), "+s"(gx_));
    const int lane = tid & 63, wave = tid >> 6, r = lane & 15, q = lane >> 4;
    LAS bf16_t* Qs = (LAS bf16_t*)lds; LAS bf16_t* Ks = Qs + 128 * RLQ; LAS bf16_t* ST = Ks + 128 * RLQ; LAS bf16_t* VT = ST + 128 * RLQ; LAS bf16_t* Ps = VT + 128 * RLD;
    for (int u = bx_; u < 16 * RNCH; u += gx_) {
        const int n = u % RNCH, h = (u / RNCH) & 3, b = (u / (RNCH * 4)) & 1, dir = u / (RNCH * 8);
        const float lg = ret_logg(p, il, dir, h);
        const float* Sg = p.rkv + ((((size_t)dir * 2 + b) * RNCH + n) * 4 + h) * 8192;
        __syncthreads();
        for (int idx = tid; idx < 128 * 16; idx += NTHREADS) { const int j = idx >> 4, d4 = idx & 15, row = scan_row(dir, b, n * RC + j);
            const float4 qv = *(const float4*)(p.qr + (size_t)row * 256 + h * 64 + 4 * d4), kv = *(const float4*)(p.kr + (size_t)row * 256 + h * 64 + 4 * d4), sv = *(const float4*)(Sg + (size_t)j * 64 + 4 * d4);
            *(LAS us4v*)(Qs + j * RLQ + 4 * d4) = pack4(qv); *(LAS us4v*)(Ks + j * RLQ + 4 * d4) = pack4(kv); *(LAS us4v*)(ST + j * RLQ + 4 * d4) = pack4(sv); }
        for (int idx = tid; idx < 128 * 32; idx += NTHREADS) { const int j = idx >> 5, e4 = idx & 31, row = scan_row(dir, b, n * RC + j);
            const float4 vv = ld4px(p.px + (size_t)row * PXLD + 512 + h * 128 + 4 * e4);
            VT[(4 * e4 + 0) * RLD + j] = f2bf(vv.x); VT[(4 * e4 + 1) * RLD + j] = f2bf(vv.y); VT[(4 * e4 + 2) * RLD + j] = f2bf(vv.z); VT[(4 * e4 + 3) * RLD + j] = f2bf(vv.w); }
        __syncthreads();
#pragma unroll
        for (int tj = 0; tj < 8; ++tj) { pg8::f32x4 acc = {0.f, 0.f, 0.f, 0.f};
            acc = mma16<64>(Qs + (16 * wave) * RLQ, RLQ, Ks + (16 * tj) * RLQ, RLQ, acc, lane);
            const int j = 16 * tj + r;
#pragma unroll
            for (int g = 0; g < 4; ++g) { const int i = 16 * wave + 4 * q + g; Ps[i * RLD + j] = f2bf(j <= i ? acc[g] * fexp((float)(i - j) * lg) : 0.f); } }
        __syncthreads();
        float dq[4];
#pragma unroll
        for (int g = 0; g < 4; ++g) dq[g] = fexp((float)(16 * wave + 4 * q + g + 1) * lg);
#pragma unroll
        for (int te = 0; te < 8; ++te) { pg8::f32x4 acc = {0.f, 0.f, 0.f, 0.f}, cr = {0.f, 0.f, 0.f, 0.f};
            acc = mma16<128>(Ps + (16 * wave) * RLD, RLD, VT + (16 * te) * RLD, RLD, acc, lane);
            cr = mma16<64>(Qs + (16 * wave) * RLQ, RLQ, ST + (16 * te) * RLQ, RLQ, cr, lane);
#pragma unroll
            for (int g = 0; g < 4; ++g) { const int i = 16 * wave + 4 * q + g, row = scan_row(dir, b, n * RC + i);
                p.oret[((size_t)dir * NTOK + row) * 512 + h * 128 + 16 * te + r] = acc[g] + dq[g] * cr[g]; } }
    }
}
template <bool FILL> __device__ __forceinline__ void mf_s5(const P& p, LAS unsigned char* lds, int il) {
    int tid = threadIdx.x; asm volatile("" : "+v"(tid));
    int bx_ = (int)blockIdx.x, gx_ = (int)gridDim.x; asm volatile("" : "+s"(bx_), "+s"(gx_));
    const int lane = tid & 63, wave = tid >> 6, r = lane & 15, q = lane >> 4;
    constexpr int LDU = 40, LDS_ = 132, LDB = 136;
    LAS bf16_t* Bt = (LAS bf16_t*)lds;
    LAS bf16_t* Ct = Bt + 128 * LDU;
    LAS unsigned char* wb = lds + 16384 + wave * 14336;
    LAS bf16_t* U = (LAS bf16_t*)wb;
    LAS float* SL = (LAS float*)(wb + 1280);
    LAS bf16_t* Sb = (LAS bf16_t*)(wb + 1280 + 8448);
    constexpr int GRP = (2 * S5NCH) / 8;
    static_assert((2 * S5NCH) % 8 == 0, "chunk count");
    for (int bu = bx_; bu < 64 * GRP; bu += gx_) {
        const int dg = bu / GRP, grp = bu % GRP, dir = dg >> 5, g = dg & 31;
        __syncthreads();
        if (tid < 64) { S5Par sp; s5_par(p, il, dir, g, tid, sp);
#pragma unroll
            for (int h = 0; h < 16; ++h) { Bt[(2 * tid) * LDU + h] = f2bf(sp.bbr[h]); Bt[(2 * tid + 1) * LDU + h] = f2bf(sp.bbi[h]); Bt[(2 * tid) * LDU + 16 + h] = 0; Bt[(2 * tid + 1) * LDU + 16 + h] = 0;
                const long ci = (((long)(il * 2 + dir) * NG + g) * GH + h) * NP + tid; Ct[h * LDB + 2 * tid] = f2bf(p.s5_cre[ci]); Ct[h * LDB + 2 * tid + 1] = f2bf(-p.s5_cim[ci]); } }
        float lbr, lbi; { const int gi = (il * 2 + dir) * NG + g; const float lre = fminf(p.s5_lre[gi * NP + lane], -1e-4f), lim = p.s5_lim[gi * NP + lane], dt = expf(p.s5_ldt[gi]);
            const float mag = expf(lre * dt); lbr = mag * cosf(lim * dt); lbi = mag * sinf(lim * dt); }
        __syncthreads();
        const int bc = grp * 8 + wave, b = bc / S5NCH, ch = bc % S5NCH;
        float* ce = p.s5c + ((((size_t)dir * 2 + b) * S5NCH + ch) * NG + g) * NP * 2 + lane * 2;
        float sr = 0.f, si = 0.f;
        if (FILL) { sr = ce[0]; si = ce[1]; }
        float4 uvs[S5C / 16];
#pragma unroll
        for (int sb = 0; sb < S5C / 16; ++sb) { const int k = lane >> 2, h4 = (lane & 3) * 4, row = scan_row(dir, b, ch * S5C + sb * 16 + k);
            uvs[sb] = ld4px(p.px + (size_t)row * PXLD + 1536 + g * GH + h4); }
#pragma unroll
        for (int sb = 0; sb < S5C / 16; ++sb) {
            { const int k = lane >> 2, h4 = (lane & 3) * 4;
              *(LAS us4v*)(U + k * LDU + h4) = pack4(uvs[sb]); *(LAS us4v*)(U + k * LDU + 16 + h4) = (us4v){0, 0, 0, 0}; }
            asm volatile("s_waitcnt lgkmcnt(0)" ::: "memory");
#pragma unroll
            for (int tc = 0; tc < 8; ++tc) { pg8::f32x4 acc = {0.f, 0.f, 0.f, 0.f};
                acc = mma16<32>(U, LDU, Bt + (16 * tc) * LDU, LDU, acc, lane);
#pragma unroll
                for (int gq = 0; gq < 4; ++gq) SL[(4 * q + gq) * LDS_ + 16 * tc + r] = acc[gq]; }
            asm volatile("s_waitcnt lgkmcnt(0)" ::: "memory");
#pragma unroll
            for (int k = 0; k < 16; ++k) { const float br = SL[k * LDS_ + 2 * lane], bi = SL[k * LDS_ + 2 * lane + 1];
                const float tr = lbr * sr - lbi * si + br, ti = lbr * si + lbi * sr + bi; sr = tr; si = ti;
                if (FILL) { Sb[k * LDB + 2 * lane] = f2bf(sr); Sb[k * LDB + 2 * lane + 1] = f2bf(si); } }
            if (FILL) {
                asm volatile("s_waitcnt lgkmcnt(0)" ::: "memory");
                pg8::f32x4 acc = {0.f, 0.f, 0.f, 0.f};
                acc = mma16<128>(Sb, LDB, Ct, LDB, acc, lane);
#pragma unroll
                for (int gq = 0; gq < 4; ++gq) { const int row = scan_row(dir, b, ch * S5C + sb * 16 + 4 * q + gq); p.yd[((size_t)dir * NTOK + row) * S5W + g * GH + r] = acc[gq]; }
            }
            asm volatile("s_waitcnt lgkmcnt(0)" ::: "memory");
        }
        if (!FILL) { ce[0] = sr; ce[1] = si; }
    }
}
__device__ __forceinline__ void mf_swa(const P& p, LAS unsigned char* lds, int il, bool with_ctx) {
    int tid = threadIdx.x; asm volatile("" : "+v"(tid));
    int bx_ = (int)blockIdx.x, gx_ = (int)gridDim.x; asm volatile("" : "+s"(bx_), "+s"(gx_));
    const int lane = tid & 63, wave = tid >> 6, r = lane & 15, q = lane >> 4;
    constexpr int LDK = 72;
    LAS bf16_t* Ks = (LAS bf16_t*)lds;
    LAS bf16_t* VT = Ks + 64 * LDK;
    LAS bf16_t* Pw = VT + 64 * LDK + wave * 64 * LDK;
    constexpr int NQB = SEQ / 128, NLATU = 4 * NQB, NCTXU = 4 * (CTXL / 128);
    const int nunits = NLATU + (with_ctx ? NCTXU : 0);
    for (int u = bx_; u < nunits; u += gx_) {
        int b, kv, qb, isctx;
        if (u < NLATU) { isctx = 0; qb = u % NQB; kv = (u / NQB) & 1; b = u / (NQB * 2); }
        else { const int v = u - NLATU; isctx = 1; qb = v % (CTXL / 128); kv = (v / (CTXL / 128)) & 1; b = v / ((CTXL / 128) * 2); }
        const int g = wave >> 1, hq = kv * 4 + g, i0 = (wave & 1) * 64;
        const int qrow0 = (isctx ? NLAT + b * CTXL : b * SEQ) + qb * 128 + i0;
        pg8::bf16x8 qf[4][2];
#pragma unroll
        for (int tq = 0; tq < 4; ++tq)
#pragma unroll
            for (int ks = 0; ks < 2; ++ks) { const float* src = p.qs + (size_t)(qrow0 + 16 * tq + r) * 512 + hq * 64 + 32 * ks + 8 * q;
                const float4 a = *(const float4*)src, c = *(const float4*)(src + 4);
                qf[tq][ks] = (pg8::bf16x8){(short)f2bf(a.x), (short)f2bf(a.y), (short)f2bf(a.z), (short)f2bf(a.w), (short)f2bf(c.x), (short)f2bf(c.y), (short)f2bf(c.z), (short)f2bf(c.w)}; }
        pg8::f32x4 oacc[4][4];
        float mrow[4][4], lrow[4][4];
        const float sink = p.swa_sink[il * 8 + hq];
#pragma unroll
        for (int tq = 0; tq < 4; ++tq)
#pragma unroll
            for (int x = 0; x < 4; ++x) { oacc[tq][x] = (pg8::f32x4){0.f, 0.f, 0.f, 0.f}; mrow[tq][x] = sink; lrow[tq][x] = 1.0f; }
        const int ntile = isctx ? 4 : 10;
        for (int t = 0; t < ntile; ++t) {
            const bool loc = !isctx && t < 6;
            const int kpos0 = loc ? 128 * (qb - 1) + 64 * t : 0;
            if (loc && (kpos0 < 0 || kpos0 >= SEQ)) continue;
            const int krow0 = loc ? b * SEQ + kpos0 : NLAT + b * CTXL + 64 * (isctx ? t : t - 6);
            __syncthreads();
            for (int idx = tid; idx < 64 * 16; idx += NTHREADS) { const int key = idx >> 4, d4 = idx & 15;
                const float4 kk = *(const float4*)(p.ks + (size_t)(krow0 + key) * 128 + kv * 64 + 4 * d4), vv = ld4px(p.px + (size_t)(krow0 + key) * PXLD + 2176 + kv * 64 + 4 * d4);
                *(LAS us4v*)(Ks + key * LDK + 4 * d4) = pack4(kk);
                VT[(4 * d4 + 0) * LDK + key] = f2bf(vv.x); VT[(4 * d4 + 1) * LDK + key] = f2bf(vv.y); VT[(4 * d4 + 2) * LDK + key] = f2bf(vv.z); VT[(4 * d4 + 3) * LDK + key] = f2bf(vv.w); }
            __syncthreads();
            pg8::f32x4 sc[4][4];
#pragma unroll
            for (int tk = 0; tk < 4; ++tk) { const LAS bf16_t* kp = Ks + (16 * tk + r) * LDK + 8 * q;
                const pg8::bf16x8 k0 = *(const LAS pg8::bf16x8*)kp, k1 = *(const LAS pg8::bf16x8*)(kp + 32);
#pragma unroll
                for (int tq = 0; tq < 4; ++tq) { pg8::f32x4 a = {0.f, 0.f, 0.f, 0.f};
                    a = __builtin_amdgcn_mfma_f32_16x16x32_bf16(qf[tq][0], k0, a, 0, 0, 0); a = __builtin_amdgcn_mfma_f32_16x16x32_bf16(qf[tq][1], k1, a, 0, 0, 0); sc[tq][tk] = a; } }
            if (loc) {
#pragma unroll
                for (int tq = 0; tq < 4; ++tq)
#pragma unroll
                    for (int tk = 0; tk < 4; ++tk)
#pragma unroll
                        for (int x = 0; x < 4; ++x) { const int dlt = (kpos0 + 16 * tk + r) - (128 * qb + i0 + 16 * tq + 4 * q + x); if (dlt > 128 || dlt < -128) sc[tq][tk][x] = -1e30f; }
            }
#pragma unroll
            for (int tq = 0; tq < 4; ++tq)
#pragma unroll
                for (int x = 0; x < 4; ++x) {
                    float mx = fmaxf(fmaxf(sc[tq][0][x], sc[tq][1][x]), fmaxf(sc[tq][2][x], sc[tq][3][x]));
                    mx = row16_max(mx);
                    const float mn = fmaxf(mrow[tq][x], mx), corr = __expf(mrow[tq][x] - mn);
                    float sum = 0.f;
#pragma unroll
                    for (int tk = 0; tk < 4; ++tk) { const float pe = __expf(sc[tq][tk][x] - mn); sum += pe; Pw[(16 * tq + 4 * q + x) * LDK + 16 * tk + r] = f2bf(pe); }
                    sum = row16_sum(sum);
                    lrow[tq][x] = lrow[tq][x] * corr + sum; mrow[tq][x] = mn;
#pragma unroll
                    for (int td = 0; td < 4; ++td) oacc[tq][td][x] *= corr;
                }
            asm volatile("s_waitcnt lgkmcnt(0)" ::: "memory");
#pragma unroll
            for (int td = 0; td < 4; ++td) { const LAS bf16_t* vp = VT + (16 * td + r) * LDK + 8 * q;
                const pg8::bf16x8 v0 = *(const LAS pg8::bf16x8*)vp, v1 = *(const LAS pg8::bf16x8*)(vp + 32);
#pragma unroll
                for (int tq = 0; tq < 4; ++tq) { const LAS bf16_t* pp = Pw + (16 * tq + r) * LDK + 8 * q;
                    oacc[tq][td] = __builtin_amdgcn_mfma_f32_16x16x32_bf16(*(const LAS pg8::bf16x8*)pp, v0, oacc[tq][td], 0, 0, 0);
                    oacc[tq][td] = __builtin_amdgcn_mfma_f32_16x16x32_bf16(*(const LAS pg8::bf16x8*)(pp + 32), v1, oacc[tq][td], 0, 0, 0); } }
        }
#pragma unroll
        for (int tq = 0; tq < 4; ++tq)
#pragma unroll
            for (int x = 0; x < 4; ++x) { const float inv = 1.0f / lrow[tq][x]; bf16_t* o = p.mixb + (size_t)(qrow0 + 16 * tq + 4 * q + x) * D + 512 + hq * 64 + r;
#pragma unroll
                for (int td = 0; td < 4; ++td) o[16 * td] = f2bf(oacc[tq][td][x] * inv); }
    }
}
__device__ __forceinline__ void mf_sconv(const P& p, LAS unsigned char* lds, int il) {
    int tid = threadIdx.x; asm volatile("" : "+v"(tid));
    int bx_ = (int)blockIdx.x, gx_ = (int)gridDim.x; asm volatile("" : "+s"(bx_), "+s"(gx_));
    LAS float* T = (LAS float*)lds;
    const float* sw = p.hy_short_w + il * 3 * 1536; const float* sb = p.hy_short_b + il * 1536;
    constexpr int NT = (NTOK / 64) * (HYW / 64);
    for (int t = bx_; t < NT; t += gx_) {
        const int r0 = (t / (HYW / 64)) * 64, c0 = (t % (HYW / 64)) * 64;
        const int rl = tid >> 3, cs = (tid & 7) * 8, r = r0 + rl; const RowInfo ri = row_info(r);
        float u[3][8];
#pragma unroll
        for (int g = 0; g < 3; ++g) { const int col = g * HYW + c0 + cs; const float4 b0 = *(const float4*)(sb + col), b1 = *(const float4*)(sb + col + 4);
            u[g][0] = b0.x; u[g][1] = b0.y; u[g][2] = b0.z; u[g][3] = b0.w; u[g][4] = b1.x; u[g][5] = b1.y; u[g][6] = b1.z; u[g][7] = b1.w;
#pragma unroll
            for (int j = 0; j < 3; ++j) { const int tt = ri.t + j - 1; if (tt >= 0 && tt < ri.len) { const px_t* px = p.px + (size_t)(ri.base + tt) * PXLD + col; const float* wj = sw + j * 1536 + col;
                const float4 x0 = ld4px(px), x1 = ld4px(px + 4), w0 = *(const float4*)wj, w1 = *(const float4*)(wj + 4);
                u[g][0] += w0.x * x0.x; u[g][1] += w0.y * x0.y; u[g][2] += w0.z * x0.z; u[g][3] += w0.w * x0.w; u[g][4] += w1.x * x1.x; u[g][5] += w1.y * x1.y; u[g][6] += w1.z * x1.z; u[g][7] += w1.w * x1.w; } } }
        float z[8];
#pragma unroll
        for (int k = 0; k < 8; ++k) z[k] = u[2][k] * u[1][k];
        const size_t i = (size_t)r * HYW + c0 + cs;
        *(float4*)(p.x0c + i) = make_float4(u[0][0], u[0][1], u[0][2], u[0][3]); *(float4*)(p.x0c + i + 4) = make_float4(u[0][4], u[0][5], u[0][6], u[0][7]);
        *(float4*)(p.zb + i) = make_float4(z[0], z[1], z[2], z[3]); *(float4*)(p.zb + i + 4) = make_float4(z[4], z[5], z[6], z[7]);
        if (r0 < NLAT) {
            __syncthreads();
#pragma unroll
            for (int k = 0; k < 8; ++k) T[(cs + k) * 65 + rl] = z[k];
            __syncthreads();
            const int cl = tid >> 3, rs = (tid & 7) * 8; const LAS float* src = T + cl * 65 + rs; float* dst = p.zT + (size_t)(c0 + cl) * NLAT + r0 + rs;
            *(float4*)dst = make_float4(src[0], src[1], src[2], src[3]); *(float4*)(dst + 4) = make_float4(src[4], src[5], src[6], src[7]);
        }
    }
}
__device__ __forceinline__ void mf_filter_tiles(const P& p, LAS unsigned char* lds) {
    int tid = threadIdx.x; asm volatile("" : "+v"(tid));
    int bx_ = (int)blockIdx.x, gx_ = (int)gridDim.x; asm volatile("" : "+s"(bx_), "+s"(gx_));
    LAS float* A1 = (LAS float*)lds; LAS float* A2 = A1 + 64 * 65; LAS float* T = A2 + 64 * 65;
    constexpr int RT = (SEQ + CTXL) / 64;
    const int rl = tid >> 3, cs = (tid & 7) * 8;
    constexpr int NLT = 2 * (SEQ / 64), NCT = 2 * (CTXL / 64), NITEM = NLT + NCT * (HYW / 64);
    for (int it = bx_; it < NITEM; it += gx_) {
        int t, ct0, ct1;
        if (it < NLT) { t = (it / (SEQ / 64)) * RT + it % (SEQ / 64); ct0 = 0; ct1 = HYW / 64; }
        else { const int v = it - NLT, tc = v / (HYW / 64); t = (tc / (CTXL / 64)) * RT + SEQ / 64 + tc % (CTXL / 64); ct0 = v % (HYW / 64); ct1 = ct0 + 1; }
        const int i = t / RT, rt = t % RT, q0 = rt * 64, kind = q0 >= SEQ, L = kind ? CTXL : SEQ, q = q0 + rl, pos = kind ? q - SEQ : q;
        const long rr = (long)i * (SEQ + CTXL) + q;
        __syncthreads();
        {
            const float* w1 = p.hy_f_w1 + i * 33 * 64 + cs; const float tt = (float)pos / (float)L, w = 6.283185307179586f * (float)pos / (float)L;
            float acc[8];
#pragma unroll
            for (int k = 0; k < 8; ++k) acc[k] = tt * w1[k];
            for (int bi = 0; bi < 16; ++bi) { const float band = 1e-4f + (float)bi * ((15.0f - 1e-4f) / 15.0f), cc = ROPE_COS(band * w), sn = ROPE_SIN(band * w);
                const float* wc = w1 + (1 + bi) * 64; const float* ws = w1 + (17 + bi) * 64;
#pragma unroll
                for (int k = 0; k < 8; ++k) acc[k] += cc * wc[k] - sn * ws[k]; }
#pragma unroll
            for (int k = 0; k < 8; ++k) A1[rl * 65 + cs + k] = ROPE_SIN(acc[k] + p.hy_f_b1[i * 64 + cs + k]);
        }
        __syncthreads();
        {
            const float* w2 = p.hy_f_w2 + i * 64 * 64 + cs; float acc[8];
#pragma unroll
            for (int k = 0; k < 8; ++k) acc[k] = 0.f;
            for (int kk = 0; kk < 64; ++kk) { const float hv = A1[rl * 65 + kk]; const float4 a = *(const float4*)(w2 + kk * 64), b4 = *(const float4*)(w2 + kk * 64 + 4);
                acc[0] += hv * a.x; acc[1] += hv * a.y; acc[2] += hv * a.z; acc[3] += hv * a.w; acc[4] += hv * b4.x; acc[5] += hv * b4.y; acc[6] += hv * b4.z; acc[7] += hv * b4.w; }
#pragma unroll
            for (int k = 0; k < 8; ++k) A2[rl * 65 + cs + k] = ROPE_SIN(acc[k] + p.hy_f_b2[i * 64 + cs + k]);
        }
        __syncthreads();
        const float lag = fabsf((float)(pos - L / 2)) / (float)(L / 2);
        for (int ct = ct0; ct < ct1; ++ct) {
            const int c0 = ct * 64; const float* w3 = p.hy_f_w3 + (size_t)i * 64 * HYW + c0 + cs;
            float acc[8];
#pragma unroll
            for (int k = 0; k < 8; ++k) acc[k] = 0.f;
            for (int kk = 0; kk < 64; ++kk) { const float hv = A2[rl * 65 + kk]; const float4 a = *(const float4*)(w3 + (size_t)kk * HYW), b4 = *(const float4*)(w3 + (size_t)kk * HYW + 4);
                acc[0] += hv * a.x; acc[1] += hv * a.y; acc[2] += hv * a.z; acc[3] += hv * a.w; acc[4] += hv * b4.x; acc[5] += hv * b4.y; acc[6] += hv * b4.z; acc[7] += hv * b4.w; }
            const float fast = -15.350567286626973f, slow = -3.0701134573253946f;
#pragma unroll
            for (int k = 0; k < 8; ++k) { const float delta = fabsf(fast + (slow - fast) * (float)(c0 + cs + k) / 511.0f); acc[k] *= fexp(-lag * delta) + 0.05f; }
            float* o = p.hraw + rr * HYW + c0 + cs;
            *(float4*)o = make_float4(acc[0], acc[1], acc[2], acc[3]); *(float4*)(o + 4) = make_float4(acc[4], acc[5], acc[6], acc[7]);
            __syncthreads();
#pragma unroll
            for (int k = 0; k < 8; ++k) T[(cs + k) * 65 + rl] = acc[k];
            __syncthreads();
            const int cl = tid >> 3, rs = (tid & 7) * 8; const LAS float* src = T + cl * 65 + rs;
            float v8[8];
#pragma unroll
            for (int k = 0; k < 8; ++k) v8[k] = src[k];
            if (!kind) { float* dst = p.hT + ((size_t)i * HYW + c0 + cl) * SEQ + q0 + rs;
                *(float4*)dst = make_float4(v8[0], v8[1], v8[2], v8[3]); *(float4*)(dst + 4) = make_float4(v8[4], v8[5], v8[6], v8[7]); }
            float sa = 0.f;
#pragma unroll
            for (int k = 0; k < 8; ++k) sa += fabsf(v8[k]);
            sa += __shfl_xor(sa, 1); sa += __shfl_xor(sa, 2); sa += __shfl_xor(sa, 4);
            if ((tid & 7) == 0) p.hpart[(size_t)t * HYW + c0 + cl] = sa;
        }
    }
}
__device__ __forceinline__ void mf_hymix(const P& p, LAS unsigned char* lds, int il) {
    int tid = threadIdx.x; asm volatile("" : "+v"(tid));
    int bx_ = (int)blockIdx.x, gx_ = (int)gridDim.x; asm volatile("" : "+s"(bx_), "+s"(gx_));
    LAS float* T = (LAS float*)lds;
    constexpr int NT = (NLAT / 64) * (HYW / 64);
    for (int t = bx_; t < NT; t += gx_) {
        const int r0 = (t / (HYW / 64)) * 64, c0 = (t % (HYW / 64)) * 64;
        __syncthreads();
        { const int cl = tid >> 3, rs = (tid & 7) * 8; const float* src = p.convT + (size_t)(c0 + cl) * NLAT + r0 + rs; const float4 a = *(const float4*)src, b = *(const float4*)(src + 4);
          LAS float* d = T + cl * 65 + rs; d[0] = a.x; d[1] = a.y; d[2] = a.z; d[3] = a.w; d[4] = b.x; d[5] = b.y; d[6] = b.z; d[7] = b.w; }
        __syncthreads();
        { const int rl = tid >> 3, cs = (tid & 7) * 8; const size_t i = (size_t)(r0 + rl) * HYW + c0 + cs;
          const float4 z0 = *(const float4*)(p.zb + i), z1 = *(const float4*)(p.zb + i + 4), x0 = *(const float4*)(p.x0c + i), x1 = *(const float4*)(p.x0c + i + 4);
          const float4 b0 = *(const float4*)(p.hy_bias + il * HYW + c0 + cs), b1 = *(const float4*)(p.hy_bias + il * HYW + c0 + cs + 4);
          const float zz[8] = {z0.x, z0.y, z0.z, z0.w, z1.x, z1.y, z1.z, z1.w}, xx[8] = {x0.x, x0.y, x0.z, x0.w, x1.x, x1.y, x1.z, x1.w}, bb[8] = {b0.x, b0.y, b0.z, b0.w, b1.x, b1.y, b1.z, b1.w};
          unsigned short o[8];
#pragma unroll
          for (int k = 0; k < 8; ++k) o[k] = f2bf(xx[k] * (T[(cs + k) * 65 + rl] + bb[k] * zz[k]));
          uint4 ov; ov.x = o[0] | ((unsigned)o[1] << 16); ov.y = o[2] | ((unsigned)o[3] << 16); ov.z = o[4] | ((unsigned)o[5] << 16); ov.w = o[6] | ((unsigned)o[7] << 16);
          *(uint4*)(p.mixb + (size_t)(r0 + rl) * D + c0 + cs) = ov; }
    }
}
__device__ __forceinline__ void mf_retout(const P& p, int nrows) {
    int tid = threadIdx.x; asm volatile("" : "+v"(tid));
    int bx_ = (int)blockIdx.x, gx_ = (int)gridDim.x; asm volatile("" : "+s"(bx_), "+s"(gx_));
    const int lane = tid & 63, wave = tid >> 6;
    for (int r = bx_ * 8 + wave; r < nrows; r += gx_ * 8) {
        const float* o0 = p.oret + (size_t)r * 512 + 8 * lane; const float* o1 = p.oret + ((size_t)NTOK + r) * 512 + 8 * lane; const px_t* gp = p.px + (size_t)r * PXLD + 1024 + 8 * lane;
        const float4 a0 = *(const float4*)o0, a1 = *(const float4*)(o0 + 4), b0 = *(const float4*)o1, b1 = *(const float4*)(o1 + 4), g0 = ld4px(gp), g1 = ld4px(gp + 4);
        const float o[8] = {a0.x + b0.x, a0.y + b0.y, a0.z + b0.z, a0.w + b0.w, a1.x + b1.x, a1.y + b1.y, a1.z + b1.z, a1.w + b1.w}, gg[8] = {g0.x, g0.y, g0.z, g0.w, g1.x, g1.y, g1.z, g1.w};
        float ss = 0.f;
#pragma unroll
        for (int k = 0; k < 8; ++k) ss += o[k] * o[k];
        ss = row16_sum(ss);
        const float rs = rsqrtf(ss * (1.0f / 128.0f) + EPS);
        unsigned short ob[8];
#pragma unroll
        for (int k = 0; k < 8; ++k) ob[k] = f2bf(o[k] * rs * siluf_(gg[k]));
        uint4 ov; ov.x = ob[0] | ((unsigned)ob[1] << 16); ov.y = ob[2] | ((unsigned)ob[3] << 16); ov.z = ob[4] | ((unsigned)ob[5] << 16); ov.w = ob[6] | ((unsigned)ob[7] << 16);
        *(uint4*)(p.mixb + (size_t)r * D + 8 * lane) = ov;
    }
}
__device__ __forceinline__ void mf_lconv(const P& p, LAS unsigned char* lds, int il) {
    int tid = threadIdx.x; asm volatile("" : "+v"(tid));
    int bx_ = (int)blockIdx.x, gx_ = (int)gridDim.x; asm volatile("" : "+s"(bx_), "+s"(gx_));
    for (int c = bx_; c < HYW; c += gx_) lconv_unit(p, il, c, (LAS CX*)lds, p.zf + (size_t)bx_ * 2 * FFTN, tid, NTHREADS);
}
__device__ __forceinline__ void mf_inproj(const P& p, LAS unsigned char* lds, int layer) {
    const int il = layer >> 1; const bool ab = !(layer & 1);
    pg8::Gemm g{p.hxb, ab ? p.abin_t + (size_t)il * AB_IN * D : p.cdin_t + (size_t)il * CD_IN * D, NTOK, ab ? AB_IN : CD_IN, D, 0};
    int gx_ = (int)gridDim.x, bx_ = (int)blockIdx.x; asm volatile("" : "+s"(gx_), "+s"(bx_));
    pg8::StaticOrder S; S.init(g.M, g.N, gx_, bx_);
    pg8::EpiStoreBf16 E{p.px, PXLD};
    pg8::gemm_phase(lds, g, S, E);
}
__device__ __forceinline__ void mf_outproj(const P& p, LAS unsigned char* lds, int layer, int nrows) {
    const int il = layer >> 1; const bool ab = !(layer & 1);
    pg8::Gemm g{p.mixb, (ab ? p.about_t : p.cdout_t) + (size_t)il * D * D, nrows, D, D, 0};
    int gx_ = (int)gridDim.x, bx_ = (int)blockIdx.x; asm volatile("" : "+s"(gx_), "+s"(bx_));
    pg8::StaticOrder S; S.init(g.M, g.N, gx_, bx_);
    pg8::EpiResid E{p.xa, p.modv + (size_t)layer * 3 * 6 * D + 2 * D};
    pg8::gemm_phase(lds, g, S, E);
}
__device__ __forceinline__ void mf_glu(const P& p, LAS unsigned char* lds, int il) {
    pg8::Gemm g{p.ys5b, p.glu_t + (size_t)il * S5W * S5W, NTOK, S5W, S5W, 0};
    int gx_ = (int)gridDim.x, bx_ = (int)blockIdx.x; asm volatile("" : "+s"(gx_), "+s"(bx_));
    pg8::StaticOrder S; S.init(g.M, g.N, gx_, bx_);
    pg8::EpiGlu E{p.mixb, p.ys5b, p.s5_glu_b + il * S5W};
    pg8::gemm_phase(lds, g, S, E);
}
__device__ __forceinline__ int build_ue(const P& p, LAS unsigned char* lds, int layer) {
    volatile LAS unsigned char* ue = (volatile LAS unsigned char*)(lds + UE_OFF); volatile LAS int* tot = (volatile LAS int*)(lds + MISC_OFF + 16);
    __syncthreads();
    if (threadIdx.x == 0) { const int* cnt = p.cnt + layer * NE; int t = 0;
        for (int e = 0; e < NE; ++e) { const int nt = (cnt[e] + 255) >> 8; for (int q = 0; q < nt; ++q) ue[t + q] = (unsigned char)e; t += nt; }
        *tot = t; }
    __syncthreads();
    return *tot;
}
__device__ __forceinline__ void mf_moe1(const P& p, LAS unsigned char* lds, int layer) {
    const int tiles = build_ue(p, lds, layer);
    int gx_ = (int)gridDim.x, bx_ = (int)blockIdx.x; asm volatile("" : "+s"(gx_), "+s"(bx_));
    pg8::MoeOrder S{tiles * 8, 8, gx_, bx_, (const volatile LAS unsigned char*)(lds + UE_OFF), (const volatile LAS int*)(lds + TOK_OFF)};
    volatile LAS int* tokt = (volatile LAS int*)(lds + TOK_OFF);
    { int tid = threadIdx.x; asm volatile("" : "+v"(tid));
      for (int i = 0; i < TOK_UNITS; ++i) { int pm, pn; if (!S.unit(i, pm, pn)) break;
          for (int t = tid; t < 256; t += NTHREADS) { const int tk = p.slot_tok[pm * 256 + t]; tokt[i * 256 + t] = tk < 0 ? NTOK : tk; } }
      __syncthreads(); }
    pg8::Gemm g{p.hxb, p.wgu_t + (size_t)layer * NE * 2 * DFF * D, tiles * 256, 2 * DFF, D, (size_t)2 * DFF * D * 2};
    pg8::EpiSwiglu E{p.actb, p.b_gu + (size_t)layer * NE * 2 * DFF};
    pg8::gemm_phase<pg8::EpiSwiglu, pg8::MoeOrder, true>(lds, g, S, E);
}
__device__ __forceinline__ void mf_moe2(const P& p, LAS unsigned char* lds, int layer) {
    const int tiles = build_ue(p, lds, layer);
    pg8::Gemm g{p.actb, p.wdn_t + (size_t)layer * NE * D * DFF, tiles * 256, D, DFF, (size_t)D * DFF * 2};
    int gx_ = (int)gridDim.x, bx_ = (int)blockIdx.x; asm volatile("" : "+s"(gx_), "+s"(bx_));
    pg8::MoeOrder S{tiles * 4, 4, gx_, bx_, (const volatile LAS unsigned char*)(lds + UE_OFF), nullptr};
    pg8::EpiDown E{p.yb, p.b_dn + (size_t)layer * NE * D, p.slot_gate};
    pg8::gemm_phase(lds, g, S, E);
}

#define XB_TMO      128
#define XB_XCNT(j)  (256  + 64 * (j))
#define XB_XSUB(j)  (1280 + 64 * (j))
#define XB_XGEN(j)  (2304 + 64 * (j))
#define XB_TOP      3328
#define XB_TOPGEN   3392
#define XCD_BAR_WORDS 3456
#define XB_SPIN_CAP (1u << 18)

__device__ __forceinline__ unsigned xb_ld(unsigned* p)              { return __hip_atomic_load(p, __ATOMIC_RELAXED, __HIP_MEMORY_SCOPE_AGENT); }
__device__ __forceinline__ unsigned xb_add(unsigned* p, unsigned v) { return __hip_atomic_fetch_add(p, v, __ATOMIC_RELAXED, __HIP_MEMORY_SCOPE_AGENT); }
__device__ __forceinline__ unsigned xb_xcc_id() { return (unsigned)__builtin_amdgcn_s_getreg((3 << 11) | 20) & 0xFu; }
#define XB_SPIN(cond, bar) do { unsigned _sp = 0; while (cond) { __builtin_amdgcn_s_sleep(1); \
    if ((++_sp & 255u) == 0u) { if (xb_ld(&(bar)[XB_TMO])) break; if (_sp > XB_SPIN_CAP) { atomicAdd(&(bar)[XB_TMO], 1u); break; } } } } while (0)

struct XcdBarrier { unsigned* bar; unsigned x; volatile LAS unsigned* st; };

__device__ __forceinline__ XcdBarrier xcd_barrier_post(unsigned* bar, volatile LAS unsigned* st) {
    XcdBarrier b; b.bar = bar; b.x = xb_xcc_id(); b.st = st;
    if (threadIdx.x == 0) (void)xb_add(&bar[XB_XCNT(b.x)], 1u);
    return b;
}
__device__ __forceinline__ void xcd_barrier_complete(unsigned* bar, unsigned x, unsigned& nloc, unsigned& nx) {
    const unsigned G = gridDim.x * gridDim.y * gridDim.z;
    unsigned sum, cnt, mine, sp = 0u;
    asm volatile("" : "+s"(x));
    for (;;) {
        sum = 0u; cnt = 0u; mine = 0u;
#pragma unroll
        for (unsigned j = 0; j < 16; ++j) { const unsigned c = xb_ld(&bar[XB_XCNT(j)]); sum += c; cnt += (c > 0u) ? 1u : 0u; mine = (j == x) ? c : mine; }
        if (sum == G) break;
        __builtin_amdgcn_s_sleep(1);
        if ((++sp & 255u) == 0u) { if (xb_ld(&bar[XB_TMO])) break; if (sp > XB_SPIN_CAP) { atomicAdd(&bar[XB_TMO], 1u); break; } }
    }
    nloc = mine > 0u ? mine : 1u; nx = cnt > 0u ? cnt : 1u;
}
__device__ __forceinline__ void xcd_barrier(const XcdBarrier& b) {
    asm volatile("s_waitcnt vmcnt(0)" ::: "memory");
    __syncthreads();
    if (threadIdx.x == 0) {
        unsigned* bar = b.bar; unsigned bx = b.x;
        asm volatile("" : "+s"(bar), "+s"(bx));
        __builtin_amdgcn_s_waitcnt(0);
        unsigned nloc = b.st[0], nx = b.st[1];
        if (nloc == 0u) { xcd_barrier_complete(bar, bx, nloc, nx); b.st[0] = nloc; b.st[1] = nx; }
        const unsigned old = xb_add(&bar[XB_XSUB(bx)], 1u);
        const unsigned gen = old / nloc;
        if (old + 1u == (gen + 1u) * nloc) {
            __builtin_amdgcn_fence(__ATOMIC_RELEASE, "agent");
            asm volatile("s_waitcnt vmcnt(0)" ::: "memory");
            const unsigned og = xb_add(&bar[XB_TOP], 1u);
            const unsigned tg = og / nx;
            if (og + 1u == (tg + 1u) * nx) xb_add(&bar[XB_TOPGEN], 1u);
            else XB_SPIN(xb_ld(&bar[XB_TOPGEN]) == tg, bar);
            __builtin_amdgcn_fence(__ATOMIC_ACQUIRE, "agent");
            xb_add(&bar[XB_XGEN(bx)], 1u);
            asm volatile("s_waitcnt vmcnt(0)" ::: "memory");
        } else {
            XB_SPIN(xb_ld(&bar[XB_XGEN(bx)]) == gen, bar);
            __builtin_amdgcn_fence(__ATOMIC_ACQUIRE, "agent");
            asm volatile("s_waitcnt vmcnt(0)" ::: "memory");
        }
    }
    __syncthreads();
}

typedef const __attribute__((address_space(4))) P* KP;
__global__ void __launch_bounds__(NTHREADS, 2) fwd_kernel(P p_arg) {
    (void)p_arg;
    const KP kp0 = (KP)__builtin_amdgcn_kernarg_segment_ptr();
#define p (*(const P*)({ KP q_ = kp0; asm volatile("" : "+s"(q_)); q_; }))
    extern __shared__ __attribute__((aligned(16))) unsigned char lds_raw[];
    LAS unsigned char* lds = (LAS unsigned char*)lds_raw;
    for (int u = threadIdx.x; u < (LDS_BYTES - MISC_OFF) / 4; u += NTHREADS) ((LAS unsigned*)(lds + MISC_OFF))[u] = 0u;
    __syncthreads();
    XcdBarrier bar = xcd_barrier_post(p.bar, (volatile LAS unsigned*)(lds + MISC_OFF));
    const long gs = (long)gridDim.x * NTHREADS;
#define gt ({ int b_ = (int)blockIdx.x; asm volatile("" : "+s"(b_)); long g_ = (long)b_ * NTHREADS + threadIdx.x; asm volatile("" : "+v"(g_)); g_; })
#define SETUP(S) setup_slot<S>(p, gt, gs); xcd_barrier(bar);
    for (int rep = 0; rep < REP_SETUP; ++rep) {
    setup_slot<0>(p, gt, gs); mf_filter_tiles(p, lds); __syncthreads(); ph_convert_weights(p, lds); xcd_barrier(bar);
    ph_mod2(p, gt, gs); ph_filt4(p, gt, gs); xcd_barrier(bar);
    }
#define SLOT(S) layer_slot<S>(p, layer, gt, gs); xcd_barrier(bar);
#if MFMA_DENSE
#define DENSE_IN  for (int rep = 0; rep < REP_IN; ++rep) { mf_inproj(p, lds, layer); if (layer < 3) convert_deferred(p, lds, layer, 0); xcd_barrier(bar); }
#define DENSE_OUT if (!(layer & 1)) mf_glu(p, lds, layer >> 1); else ph_retout(p, layer < 3 ? NTOK : NLAT, gt, gs); xcd_barrier(bar); \
                  mf_outproj(p, lds, layer, layer < 3 ? NTOK : NLAT); xcd_barrier(bar);
#else
#define DENSE_IN  SLOT(2)
#define DENSE_OUT SLOT(7) SLOT(8)
#endif
#if MFMA_MOE
#define MOE_GEMMS for (int rep = 0; rep < REP_MOE; ++rep) { mf_moe1(p, lds, layer); xcd_barrier(bar); } for (int rep = 0; rep < REP_MOE2; ++rep) { mf_moe2(p, lds, layer); xcd_barrier(bar); }
#else
#define MOE_GEMMS SLOT(14) SLOT(15)
#endif
#define REPF(n) for (int rep_ = 0; rep_ < (n); ++rep_)
#define LAYER(L) { constexpr int layer = L; constexpr bool AB = !(layer & 1); constexpr int il = layer >> 1; constexpr int nrows = layer < 3 ? NTOK : NLAT; \
    REPF(RN) mf_rownorm<0>(p, lds, layer, NTOK, layer - 1); xcd_barrier(bar); DENSE_IN \
    REPF(R3) { if (AB) { mf_s5<false>(p, lds, il); mf_sconv(p, lds, il); } else ph_rope(p, gt, gs); } xcd_barrier(bar); \
    REPF(R4) { if (AB) { mf_lconv(p, lds, il); ph_lconv(p, il, NLAT, NTOK, gt, gs); } else mf_retkv(p, lds, il); } if (AB) ph_s5carry(p, il, gt, gs); xcd_barrier(bar); \
    REPF(R5) { if (AB) { mf_s5<true>(p, lds, il); mf_hymix(p, lds, il); } else mf_swa(p, lds, il, layer < 3); } if (!AB) ph_retcarry(p, il, gt, gs); xcd_barrier(bar); \
    REPF(R6) { if (AB) ph_s5fin(p, il, gt, gs); else mf_reto(p, lds, il); } xcd_barrier(bar); \
    REPF(R7) { if (AB) mf_glu(p, lds, il); else mf_retout(p, nrows); } xcd_barrier(bar); \
    mf_outproj(p, lds, layer, nrows); if (layer < 3) convert_deferred(p, lds, layer, 1); xcd_barrier(bar); \
    mf_rownorm<1>(p, lds, layer, nrows, -1); xcd_barrier(bar); SLOT(12) MOE_GEMMS }
    LAYER(0) LAYER(1) LAYER(2) LAYER(3)
    mf_rownorm<2>(p, lds, 3, NLAT, 3);
#undef gt
#undef p
}

extern "C" void kernel_launch(void* const* d_in, const int* in_sizes, int n_in, void* d_out, int out_size, void* d_ws, size_t ws_size, hipStream_t stream) {
    (void)in_sizes; (void)n_in; (void)out_size;
    const WsMap m = ws_map();
    if (ws_size < m.total) { fprintf(stderr, "workspace too small: %zu < %zu\n", ws_size, m.total); return; }
    P p; memset(&p, 0, sizeof(p)); fill_params(p, d_in, d_out, d_ws);
    static int grid = 0;
    if (!grid) {
        int dev = 0, cus = 0, per_cu = 0;
        (void)hipGetDevice(&dev); (void)hipDeviceGetAttribute(&cus, hipDeviceAttributeMultiprocessorCount, dev);
        if (hipFuncSetAttribute((const void*)fwd_kernel, hipFuncAttributeMaxDynamicSharedMemorySize, LDS_BYTES) != hipSuccess) { fprintf(stderr, "hipFuncSetAttribute failed\n"); grid = -1; return; }
        (void)hipOccupancyMaxActiveBlocksPerMultiprocessor(&per_cu, (const void*)fwd_kernel, NTHREADS, LDS_BYTES);
        if (per_cu < 1) fprintf(stderr, "occupancy query reports %d blocks per CU\n", per_cu);
        grid = cus;
    }
    if (grid <= 0) return;
    (void)hipMemsetAsync(p.bar, 0, XCD_BAR_WORDS * sizeof(unsigned), stream);
    fwd_kernel<<<dim3(grid), dim3(NTHREADS), LDS_BYTES, stream>>>(p);
}
#endif
```

```cpp
#ifndef CPU_SHIM
#include <hip/hip_runtime.h>
#include <cstring>
#include <cstdio>
#include <cstdint>
#define DEV __device__ __forceinline__
#else
#include <cmath>
#include <cstdio>
#include <cstdint>
#include <cstring>
#include <cstdlib>
#define DEV static inline
static inline float rsqrtf(float x) { return 1.0f / sqrtf(x); }
#endif

#ifndef SEQ
#define SEQ 8192
#endif
#ifndef CTXL
#define CTXL 256
#endif
#ifndef N_LAUNCH_MODE
#define N_LAUNCH_MODE 1
#endif
#ifdef CPU_SHIM
#define MFMA_DENSE 0
#define MFMA_MOE 0
#endif
#ifndef R3
#define R3 1
#endif
#ifndef R4
#define R4 1
#endif
#ifndef R5
#define R5 1
#endif
#ifndef R6
#define R6 1
#endif
#ifndef R7
#define R7 1
#endif
#ifndef RG
#define RG 1
#endif
#ifndef RN
#define RN 1
#endif
#ifndef REP_SETUP
#define REP_SETUP 1
#endif
#ifndef REP_MOE
#define REP_MOE 1
#endif
#ifndef REP_MOE2
#define REP_MOE2 1
#endif
#ifndef REP_IN
#define REP_IN 1
#endif
#ifndef REP_RET
#define REP_RET 1
#endif
#ifndef REP_SWA
#define REP_SWA 1
#endif
#ifndef REP_S5
#define REP_S5 1
#endif
#ifndef MFMA_DENSE
#define MFMA_DENSE 1
#endif
#ifndef MFMA_MOE
#define MFMA_MOE 1
#endif
typedef unsigned short bf16_t;
#if MFMA_DENSE
typedef unsigned short px_t;
#else
typedef float px_t;
#endif

constexpr int D = 1024, NLAT = 2 * SEQ, NCTX = 2 * CTXL, NTOK = NLAT + NCTX;
constexpr int HYW = 512, S5W = 512, NG = 32, NP = 64, GH = 16;
constexpr int AB_IN = 2048, CD_IN = 2304, PXLD = 2304;
constexpr int NE = 32, DFF = 1024;
constexpr float EPS = 1e-6f;
constexpr int NSLOT = ((NTOK * 4 + 255) / 256 + NE) * 256;
#ifdef CPU_SHIM
DEV bf16_t f2bf(float f) { unsigned u; memcpy(&u, &f, 4); return (bf16_t)((u + 0x7fffu + ((u >> 16) & 1u)) >> 16); }
DEV float fexp(float x) { return expf(x); }
DEV float frcp(float x) { return 1.0f / x; }
#else
DEV bf16_t f2bf(float f) { const __bf16 b = (__bf16)f; return __builtin_bit_cast(unsigned short, b); }
DEV float fexp(float x) { return __builtin_amdgcn_exp2f(1.4426950408889634f * x); }
DEV float frcp(float x) { return __builtin_amdgcn_rcpf(x); }
#endif
DEV float bf2f(bf16_t b) { const unsigned u = (unsigned)b << 16; float f; memcpy(&f, &u, 4); return f; }
DEV float pxf(float v) { return v; }
DEV float pxf(bf16_t v) { return bf2f(v); }
DEV void pxstore(float* q, float v) { *q = v; }
DEV void pxstore(bf16_t* q, float v) { *q = f2bf(v); }

struct P {
    const float *x, *c, *ctx, *c_ctx, *mod_w, *mod_b, *norm1_g, *norm2_g, *ab_w_in, *ab_w_out, *hy_short_w, *hy_short_b,
        *hy_f_w1, *hy_f_b1, *hy_f_w2, *hy_f_b2, *hy_f_w3, *hy_bias, *s5_lre, *s5_lim, *s5_ldt, *s5_bre, *s5_bim, *s5_cre, *s5_cim,
        *s5_d, *s5_glu_w, *s5_glu_b, *cd_w_in, *cd_w_out, *ret_decay, *swa_sink, *router_w, *router_b, *w_gu, *b_gu, *w_dn, *b_dn, *final_g;
    float* out;
    unsigned* bar;
    float *xa, *modv, *f1, *f2, *hraw, *hsum, *rstd, *hx, *zb, *x0c, *mixin, *s5s, *ys5, *qr, *kr, *oret, *qs, *ks, *topg, *act;
    int* topi;
    px_t* px;
    bf16_t *hxb, *mixb, *ys5b, *xb, *actb, *abin_t, *cdin_t, *about_t, *cdout_t, *glu_t, *wgu_t, *wdn_t;
    bf16_t* yb;
    float *zT, *hT, *modp;
    float *slot_gate, *s5c, *rkv, *rsc, *hpart, *zf, *convT, *yd;
    int *cnt, *pos, *slot_of, *slot_tok;
};

struct RowInfo { int base, len, t, m, kind; };
DEV RowInfo row_info(int r) {
    RowInfo ri;
    if (r < NLAT) { const int b = r / SEQ; ri.base = b * SEQ; ri.len = SEQ; ri.t = r - ri.base; ri.m = b; ri.kind = 0; }
    else { const int rc = r - NLAT, b = rc / CTXL; ri.base = NLAT + b * CTXL; ri.len = CTXL; ri.t = rc - b * CTXL; ri.m = 2; ri.kind = 1; }
    return ri;
}
DEV float sigmoidf_(float x) { return frcp(1.0f + fexp(-x)); }
DEV float siluf_(float x) { return x * sigmoidf_(x); }
DEV float gelu_tanhf_(float x) { const float u = 0.7978845608028654f * (x + 0.044715f * x * x * x); return x * frcp(1.0f + fexp(-2.0f * u)); }

#ifdef CPU_SHIM
#define GSL(i, n) const long _n_##i = (long)(n); for (long i = _n_##i * gt / gs, _hi_##i = _n_##i * (gt + 1) / gs; i < _hi_##i; ++i)
#else
#define GSL(i, n) for (long i = gt; i < (long)(n); i += gs)
#endif

#if MFMA_DENSE
#define MIXST(idx, v) p.mixb[idx] = f2bf(v)
#else
#define MIXST(idx, v) p.mixin[idx] = (v)
#endif
DEV long filt_row0(int i, int kind) { return (long)i * (SEQ + CTXL) + (kind ? SEQ : 0); }

#ifdef CPU_SHIM
#define ROPE_COS(a) cosf(a)
#define ROPE_SIN(a) sinf(a)
#else
#define ROPE_COS(a) __builtin_amdgcn_cosf(__builtin_amdgcn_fractf((a) * 0.15915494309189535f))
#define ROPE_SIN(a) __builtin_amdgcn_sinf(__builtin_amdgcn_fractf((a) * 0.15915494309189535f))
#endif
DEV void ph_init(const P& p, long gt, long gs) {
    GSL(i, (long)NTOK * D) { p.xa[i] = i < (long)NLAT * D ? p.x[i] : p.ctx[i - (long)NLAT * D]; }
    GSL(j, 4 * NE) { p.cnt[j] = 0; }
    GSL(z, D) { p.hxb[(long)NTOK * D + z] = 0; }
}
DEV void ph_mod(const P& p, long gt, long gs) {
    GSL(i, 4L * 6 * D * 8) {
        const int j = (int)(i % (6 * D)), kq = (int)((i / (6 * D)) % 8), l = (int)(i / (6 * D * 8));
        const float* w = p.mod_w + (long)l * D * 6 * D + j;
        float a0 = 0.f, a1 = 0.f, a2 = 0.f;
        for (int k = kq * (D / 8); k < (kq + 1) * (D / 8); ++k) { const float wv = w[(long)k * 6 * D]; a0 += siluf_(p.c[k]) * wv; a1 += siluf_(p.c[D + k]) * wv; a2 += siluf_(p.c_ctx[k]) * wv; }
        float* o = p.modp + ((long)kq * 4 + l) * 3 * 6 * D + j;
        o[0] = a0; o[6 * D] = a1; o[12 * D] = a2;
    }
}
DEV void ph_mod2(const P& p, long gt, long gs) {
    GSL(i, 4L * 3 * 6 * D) {
        const int j = (int)(i % (6 * D)), l = (int)(i / (18 * D));
        float a = p.mod_b[l * 6 * D + j];
#pragma unroll
        for (int kq = 0; kq < 8; ++kq) a += p.modp[(long)kq * 4 * 3 * 6 * D + i];
        p.modv[i] = a;
    }
}
DEV void ph_filt1(const P& p, long gt, long gs) {
    GSL(idx, 2L * (SEQ + CTXL) * 64) {
        const int j = (int)(idx % 64); const long rr = idx / 64; const int i = (int)(rr / (SEQ + CTXL)); const int q = (int)(rr % (SEQ + CTXL));
        const int kind = q >= SEQ, pos = kind ? q - SEQ : q, L = kind ? CTXL : SEQ;
        const float* w1 = p.hy_f_w1 + i * 33 * 64;
        const float t = (float)pos / (float)L, w = 6.283185307179586f * (float)pos / (float)L;
        float acc = t * w1[j];
        for (int bi = 0; bi < 16; ++bi) {
            const float band = 1e-4f + (float)bi * ((15.0f - 1e-4f) / 15.0f);
            acc += ROPE_COS(band * w) * w1[(1 + bi) * 64 + j] - ROPE_SIN(band * w) * w1[(17 + bi) * 64 + j];
        }
        p.f1[idx] = ROPE_SIN(acc + p.hy_f_b1[i * 64 + j]);
    }
}
DEV void ph_filt2(const P& p, long gt, long gs) {
    GSL(idx, 2L * (SEQ + CTXL) * 64) {
        const int j = (int)(idx % 64); const long rr = idx / 64; const int i = (int)(rr / (SEQ + CTXL));
        const float* w2 = p.hy_f_w2 + i * 64 * 64; const float* h1 = p.f1 + rr * 64;
        float acc = 0.f;
        for (int k = 0; k < 64; ++k) acc += h1[k] * w2[k * 64 + j];
        p.f2[idx] = ROPE_SIN(acc + p.hy_f_b2[i * 64 + j]);
    }
}
DEV void ph_filt3(const P& p, long gt, long gs) {
    GSL(idx, 2L * (SEQ + CTXL) * HYW) {
        const int c = (int)(idx % HYW); const long rr = idx / HYW; const int i = (int)(rr / (SEQ + CTXL)); const int q = (int)(rr % (SEQ + CTXL));
        const int kind = q >= SEQ, pos = kind ? q - SEQ : q, L = kind ? CTXL : SEQ;
        const float* w3 = p.hy_f_w3 + (long)i * 64 * HYW; const float* h2 = p.f2 + rr * 64;
        float acc = 0.f;
        for (int k = 0; k < 64; ++k) acc += h2[k] * w3[k * HYW + c];
        const float lag = fabsf((float)(pos - L / 2)) / (float)(L / 2);
        const float fast = -15.350567286626973f, slow = -3.0701134573253946f;
        const float delta = fabsf(fast + (slow - fast) * (float)c / 511.0f);
        const float hv = acc * (expf(-lag * delta) + 0.05f);
        p.hraw[idx] = hv; if (!kind) p.hT[((long)i * HYW + c) * SEQ + pos] = hv;
    }
}
constexpr int FSEG = 64, FNSEG = (SEQ + CTXL) / FSEG;
DEV void ph_filt4a(const P& p, long gt, long gs) {
    GSL(idx, 2L * FNSEG * HYW) {
        const int c = (int)(idx % HYW); const long sg = idx / HYW; const float* h = p.hraw + sg * FSEG * HYW + c;
        float s = 0.f;
        for (int q = 0; q < FSEG; ++q) s += fabsf(h[(long)q * HYW]);
        p.hpart[idx] = s;
    }
}
DEV void ph_filt4(const P& p, long gt, long gs) {
    GSL(idx, 2 * 2 * HYW) {
        const int c = (int)(idx % HYW), kind = (int)((idx / HYW) % 2), i = (int)(idx / (2 * HYW));
        const int s0 = (int)(filt_row0(i, kind) / FSEG), ns = (kind ? CTXL : SEQ) / FSEG;
        float s = 0.f;
        for (int q = 0; q < ns; ++q) s += p.hpart[(long)(s0 + q) * HYW + c];
        p.hsum[idx] = s;
    }
}
DEV void ph_rstd(const P& p, int nrows, long gt, long gs) {
    GSL(r, nrows) {
        const float* xr = p.xa + r * D; float s = 0.f;
        for (int k = 0; k < D; ++k) s += xr[k] * xr[k];
        p.rstd[r] = rsqrtf(s * (1.0f / D) + EPS);
    }
}
DEV void ph_hx(const P& p, int layer, int which, int nrows, long gt, long gs) {
    const float* g = (which ? p.norm2_g : p.norm1_g) + layer * D;
    GSL(i, (long)nrows * D) {
        const int k = (int)(i % D), r = (int)(i / D); const RowInfo ri = row_info(r);
        const float* mv = p.modv + ((long)layer * 3 + ri.m) * 6 * D + which * 3 * D;
        const float v = p.xa[i] * p.rstd[r] * g[k] * (1.0f + mv[D + k]) + mv[k];
        p.hx[i] = v; p.hxb[i] = f2bf(v);
    }
}
DEV void ph_inproj(const P& p, const float* w, int nin, long gt, long gs) {
    GSL(i, (long)NTOK * nin) {
        const int n = (int)(i % nin), r = (int)(i / nin); const float* a = p.hx + (long)r * D; const float* b = w + n;
        float acc = 0.f;
        for (int k = 0; k < D; ++k) acc += a[k] * b[(long)k * nin];
        pxstore(&p.px[(long)r * PXLD + n], acc);
    }
}
DEV void ph_sconv(const P& p, int il, long gt, long gs) {
    const float* sw = p.hy_short_w + il * 3 * 1536; const float* sb = p.hy_short_b + il * 1536;
    GSL(i, (long)NTOK * HYW) {
        const int c = (int)(i % HYW), r = (int)(i / HYW); const RowInfo ri = row_info(r);
        float u[3];
#pragma unroll
        for (int s = 0; s < 3; ++s) {
            const int col = s * HYW + c; float acc = sb[col];
#pragma unroll
            for (int j = 0; j < 3; ++j) { const int tt = ri.t + j - 1; if (tt >= 0 && tt < ri.len) acc += sw[j * 1536 + col] * pxf(p.px[(long)(ri.base + tt) * PXLD + col]); }
            u[s] = acc;
        }
        p.x0c[i] = u[0]; p.zb[i] = u[2] * u[1]; if (r < NLAT) p.zT[(long)c * NLAT + r] = u[2] * u[1];
    }
}
DEV void ph_lconv(const P& p, int il, int r0, int r1, long gt, long gs) {
    GSL(i0, (long)(r1 - r0) * HYW) {
        const long i = i0 + (long)r0 * HYW;
        const int c = (int)(i % HYW), r = (int)(i / HYW); const RowInfo ri = row_info(r);
        const int L = ri.len, t = ri.t;
        const float* h = p.hraw + filt_row0(il, ri.kind) * HYW + c; const float* z = p.zb + (long)ri.base * HYW + c;
        int s0 = t + L / 2 - (L - 1); if (s0 < 0) s0 = 0; int s1 = t + L / 2; if (s1 > L - 1) s1 = L - 1;
        float acc = 0.f;
#pragma unroll 8
        for (int s = s0; s <= s1; ++s) acc += h[(long)(t - s + L / 2) * HYW] * z[(long)s * HYW];
        const float y = acc / p.hsum[(il * 2 + ri.kind) * HYW + c] + p.hy_bias[il * HYW + c] * p.zb[i];
        MIXST((long)r * D + c, p.x0c[i] * y);
    }
}
constexpr int FFTN = 2 * SEQ, FFT_NS = (SEQ == 8192 ? 7 : SEQ == 2048 ? 6 : SEQ == 512 ? 5 : SEQ == 128 ? 4 : -1);
static_assert(FFT_NS > 0 && (1 << (2 * FFT_NS)) == FFTN, "2*SEQ must be a power of 4");
struct CX { float x, y; };
#define PADX(n) ((n) + ((n) >> 5))
constexpr int FFT_ELEMS = FFTN + (FFTN >> 5);
#ifdef CPU_SHIM
#define COS2PI(f) cosf(6.283185307179586f * (f))
#define SIN2PI(f) sinf(6.283185307179586f * (f))
#define FFT_SYNC()
#else
#define COS2PI(f) __builtin_amdgcn_cosf(f)
#define SIN2PI(f) __builtin_amdgcn_sinf(f)
#define FFT_SYNC() __syncthreads()
#endif
template <class XP> DEV CX cx_ld(XP x, int i) { CX r; r.x = x[i].x; r.y = x[i].y; return r; }
template <class XP> DEV void cx_st(XP x, int i, CX v) { x[i].x = v.x; x[i].y = v.y; }
DEV CX cx_add(CX a, CX b) { return CX{a.x + b.x, a.y + b.y}; }
DEV CX cx_sub(CX a, CX b) { return CX{a.x - b.x, a.y - b.y}; }
DEV CX cx_mul(CX a, CX b) { return CX{a.x * b.x - a.y * b.y, a.x * b.y + a.y * b.x}; }
template <class XP> DEV void fft_pass(XP x, int s, bool inv, int tid, int nthr) {
    const int lq = 2 * (FFT_NS - 1 - s), Q = 1 << lq;
    const float invB = 1.0f / (float)(4 * Q);
    for (int t = tid; t < FFTN / 4; t += nthr) {
        const int i = t & (Q - 1), base = ((t >> lq) << (lq + 2)) + i;
        const float f = (float)i * invB, cs = COS2PI(f), sn = SIN2PI(f);
        const CX w1 = CX{cs, inv ? sn : -sn}, w2 = cx_mul(w1, w1), w3 = cx_mul(w2, w1);
        const int i0 = PADX(base), i1 = PADX(base + Q), i2 = PADX(base + 2 * Q), i3 = PADX(base + 3 * Q);
        const CX a = cx_ld(x, i0), b = cx_ld(x, i1), c = cx_ld(x, i2), d = cx_ld(x, i3);
        if (!inv) {
            const CX t0 = cx_add(a, c), t1 = cx_sub(a, c), t2 = cx_add(b, d), bd = cx_sub(b, d), t3 = CX{bd.y, -bd.x};
            cx_st(x, i0, cx_add(t0, t2)); cx_st(x, i1, cx_mul(cx_add(t1, t3), w1)); cx_st(x, i2, cx_mul(cx_sub(t0, t2), w2)); cx_st(x, i3, cx_mul(cx_sub(t1, t3), w3));
        } else {
            const CX y0 = a, y1 = cx_mul(b, w1), y2 = cx_mul(c, w2), y3 = cx_mul(d, w3);
            const CX u0 = cx_add(y0, y2), u1 = cx_sub(y0, y2), u2 = cx_add(y1, y3), yd = cx_sub(y1, y3), u3 = CX{-yd.y, yd.x};
            cx_st(x, i0, cx_add(u0, u2)); cx_st(x, i1, cx_add(u1, u3)); cx_st(x, i2, cx_sub(u0, u2)); cx_st(x, i3, cx_sub(u1, u3));
        }
    }
}
DEV void bfly4(CX& a, CX& b, CX& c, CX& d, CX w1, bool inv, bool tw) {
    const CX w2 = cx_mul(w1, w1), w3 = cx_mul(w2, w1);
    if (!inv) {
        const CX t0 = cx_add(a, c), t1 = cx_sub(a, c), t2 = cx_add(b, d), bd = cx_sub(b, d), t3 = CX{bd.y, -bd.x};
        a = cx_add(t0, t2); b = cx_add(t1, t3); c = cx_sub(t0, t2); d = cx_sub(t1, t3);
        if (tw) { b = cx_mul(b, w1); c = cx_mul(c, w2); d = cx_mul(d, w3); }
    } else {
        CX y1 = b, y2 = c, y3 = d;
        if (tw) { y1 = cx_mul(b, w1); y2 = cx_mul(c, w2); y3 = cx_mul(d, w3); }
        const CX u0 = cx_add(a, y2), u1 = cx_sub(a, y2), u2 = cx_add(y1, y3), yd = cx_sub(y1, y3), u3 = CX{-yd.y, yd.x};
        a = cx_add(u0, u2); b = cx_add(u1, u3); c = cx_sub(u0, u2); d = cx_sub(u1, u3);
    }
}
template <class XP> DEV void fft_pass16(XP x, int s, bool inv, int tid, int nthr) {
    const int lq2 = 2 * (FFT_NS - 2 - s), Q2 = 1 << lq2, Q = 4 * Q2;
    const float invB = 1.0f / (float)(16 * Q2);
    const float sg = inv ? 1.0f : -1.0f;
    const CX c1 = CX{0.9238795325112867f, sg * 0.3826834323650898f}, c2 = CX{0.7071067811865476f, sg * 0.7071067811865476f}, c3 = CX{0.3826834323650898f, sg * 0.9238795325112867f};
    for (int t = tid; t < FFTN / 16; t += nthr) {
        const int i = t & (Q2 - 1), base = ((t >> lq2) << (lq2 + 4)) + i;
        const float f = (float)i * invB, cs = COS2PI(f), sn = SIN2PI(f);
        const CX wA = CX{cs, sg * sn};
        CX wB = cx_mul(wA, wA); wB = cx_mul(wB, wB);
        CX v[4][4];
#pragma unroll
        for (int a = 0; a < 4; ++a)
#pragma unroll
            for (int b = 0; b < 4; ++b) v[a][b] = cx_ld(x, PADX(base + a * Q + b * Q2));
        if (!inv) {
            bfly4(v[0][0], v[1][0], v[2][0], v[3][0], wA, false, true);
            bfly4(v[0][1], v[1][1], v[2][1], v[3][1], cx_mul(wA, c1), false, true);
            bfly4(v[0][2], v[1][2], v[2][2], v[3][2], cx_mul(wA, c2), false, true);
            bfly4(v[0][3], v[1][3], v[2][3], v[3][3], cx_mul(wA, c3), false, true);
#pragma unroll
            for (int r = 0; r < 4; ++r) bfly4(v[r][0], v[r][1], v[r][2], v[r][3], wB, false, true);
        } else {
#pragma unroll
            for (int r = 0; r < 4; ++r) bfly4(v[r][0], v[r][1], v[r][2], v[r][3], wB, true, true);
            bfly4(v[0][0], v[1][0], v[2][0], v[3][0], wA, true, true);
            bfly4(v[0][1], v[1][1], v[2][1], v[3][1], cx_mul(wA, c1), true, true);
            bfly4(v[0][2], v[1][2], v[2][2], v[3][2], cx_mul(wA, c2), true, true);
            bfly4(v[0][3], v[1][3], v[2][3], v[3][3], cx_mul(wA, c3), true, true);
        }
#pragma unroll
        for (int a = 0; a < 4; ++a)
#pragma unroll
            for (int b = 0; b < 4; ++b) cx_st(x, PADX(base + a * Q + b * Q2), v[a][b]);
    }
}
template <class XP> DEV void fft_pass_last(XP x, bool inv, int tid, int nthr) {
    for (int t = tid; t < FFTN / 4; t += nthr) {
        const int base = 4 * t; CX a = cx_ld(x, PADX(base)), b = cx_ld(x, PADX(base + 1)), c = cx_ld(x, PADX(base + 2)), d = cx_ld(x, PADX(base + 3));
        bfly4(a, b, c, d, CX{1.f, 0.f}, inv, false);
        cx_st(x, PADX(base), a); cx_st(x, PADX(base + 1), b); cx_st(x, PADX(base + 2), c); cx_st(x, PADX(base + 3), d);
    }
}
static_assert(FFT_NS % 2 == 1, "pass schedule: (FFT_NS - 1) / 2 radix-16 passes + one radix-4 pass");
template <class XP> DEV void fft_forward(XP x, int tid, int nthr) {
    for (int s = 0; s + 1 < FFT_NS; s += 2) { fft_pass16(x, s, false, tid, nthr); FFT_SYNC(); }
    fft_pass_last(x, false, tid, nthr); FFT_SYNC();
}
template <class XP> DEV void fft_inverse(XP x, int tid, int nthr) {
    fft_pass_last(x, true, tid, nthr); FFT_SYNC();
    for (int s = FFT_NS - 3; s >= 0; s -= 2) { fft_pass16(x, s, true, tid, nthr); FFT_SYNC(); }
}
template <class XP> DEV void lconv_unit(const P& p, int il, int c, XP x, float* zf, int tid, int nthr) {
    constexpr int L = SEQ, N = FFTN;
    const float* zc = p.zT + (long)c * NLAT;
#pragma unroll 8
    for (int n = tid; n < L; n += nthr) { CX v; v.x = zc[n]; v.y = zc[SEQ + n]; cx_st(x, PADX(n), v); }
#pragma unroll 8
    for (int n = L + tid; n < N; n += nthr) cx_st(x, PADX(n), CX{0.f, 0.f});
    FFT_SYNC();
    fft_forward(x, tid, nthr);
    const float* h = p.hT + ((long)il * HYW + c) * SEQ;
#pragma unroll 8
    for (int n = tid; n < L; n += nthr) { const float hv = h[n]; const CX v = cx_ld(x, PADX(n)); zf[2 * n] = v.x; zf[2 * n + 1] = v.y; cx_st(x, PADX(n), CX{hv, 0.f}); }
#pragma unroll 8
    for (int n = L + tid; n < N; n += nthr) { const CX v = cx_ld(x, PADX(n)); zf[2 * n] = v.x; zf[2 * n + 1] = v.y; cx_st(x, PADX(n), CX{0.f, 0.f}); }
    FFT_SYNC();
    fft_forward(x, tid, nthr);
#ifndef CPU_SHIM
    asm volatile("s_waitcnt vmcnt(0)" ::: "memory");
#endif
#pragma unroll 8
    for (int n = tid; n < N; n += nthr) { const CX zv{zf[2 * n], zf[2 * n + 1]}; const CX hv = cx_ld(x, PADX(n)); cx_st(x, PADX(n), cx_mul(hv, zv)); }
    FFT_SYNC();
    fft_inverse(x, tid, nthr);
    const float scale = 1.0f / ((float)N * p.hsum[(il * 2 + 0) * HYW + c]);
    float* o = p.convT + (long)c * NLAT;
#pragma unroll 8
    for (int t = tid; t < L; t += nthr) { const CX v = cx_ld(x, PADX(t + L / 2)); o[t] = v.x * scale; o[L + t] = v.y * scale; }
    FFT_SYNC();
}
#ifdef CPU_SHIM
DEV void ph_lconv_fft(const P& p, int il, long gt, long gs) {
    CX* x = (CX*)malloc(sizeof(CX) * FFT_ELEMS);
    GSL(c, HYW) { lconv_unit(p, il, (int)c, x, p.zf + gt * 2 * FFTN, 0, 1); }
    free(x);
}
#endif
DEV void ph_hymix(const P& p, int il, long gt, long gs) {
    GSL(i, (long)NLAT * HYW) {
        const int c = (int)(i % HYW), r = (int)(i / HYW);
        const float y = p.convT[(long)c * NLAT + r] + p.hy_bias[il * HYW + c] * p.zb[i];
        MIXST((long)r * D + c, p.x0c[i] * y);
    }
}
DEV int scan_row(int dir, int b, int n) {
    if (n < CTXL) return NLAT + b * CTXL + (dir ? CTXL - 1 - n : n);
    const int m = n - CTXL; return b * SEQ + (dir ? SEQ - 1 - m : m);
}
constexpr int S5C = 64, S5NCH = (CTXL + SEQ) / S5C;
struct S5Par { float lbr, lbi; float bbr[GH], bbi[GH]; };
DEV void s5_par(const P& p, int il, int dir, int g, int pp, S5Par& q) {
    const int gi = (il * 2 + dir) * NG + g;
    const float lre = fminf(p.s5_lre[gi * NP + pp], -1e-4f), lim = p.s5_lim[gi * NP + pp], dt = expf(p.s5_ldt[gi]);
    const float mag = expf(lre * dt); q.lbr = mag * cosf(lim * dt); q.lbi = mag * sinf(lim * dt);
    const float nr = q.lbr - 1.0f, ni = q.lbi, den = lre * lre + lim * lim;
    const float fr = (nr * lre + ni * lim) / den, fi = (ni * lre - nr * lim) / den;
#pragma unroll
    for (int h = 0; h < GH; ++h) { const float br = p.s5_bre[((long)gi * NP + pp) * GH + h], bi = p.s5_bim[((long)gi * NP + pp) * GH + h]; q.bbr[h] = fr * br - fi * bi; q.bbi[h] = fr * bi + fi * br; }
}
DEV void ph_s5chunk(const P& p, int il, int fill, long gt, long gs) {
    GSL(i, 2L * 2 * S5NCH * NG * NP) {
        const int pp = (int)(i % NP), g = (int)((i / NP) % NG), ch = (int)((i / (NP * NG)) % S5NCH), b = (int)((i / ((long)NP * NG * S5NCH)) % 2), dir = (int)(i / ((long)NP * NG * S5NCH * 2));
        S5Par q; s5_par(p, il, dir, g, pp, q);
        float* ce = p.s5c + ((((long)dir * 2 + b) * S5NCH + ch) * NG + g) * NP * 2 + pp * 2;
        float sr = 0.f, si = 0.f;
        if (fill) { sr = ce[0]; si = ce[1]; }
        for (int k = 0; k < S5C; ++k) {
            const int row = scan_row(dir, b, ch * S5C + k); const px_t* u = p.px + (long)row * PXLD + 1536 + g * GH;
            float ar = 0.f, ai = 0.f;
#pragma unroll
            for (int h = 0; h < GH; ++h) { ar += q.bbr[h] * pxf(u[h]); ai += q.bbi[h] * pxf(u[h]); }
            const float tr = q.lbr * sr - q.lbi * si + ar, ti = q.lbr * si + q.lbi * sr + ai; sr = tr; si = ti;
            if (fill) { float* o = p.s5s + (((long)dir * NTOK + row) * NG + g) * NP * 2 + pp * 2; o[0] = sr; o[1] = si; }
        }
        if (!fill) { ce[0] = sr; ce[1] = si; }
    }
}
DEV void ph_s5carry(const P& p, int il, long gt, long gs) {
    GSL(i, 2 * 2 * NG * NP) {
        const int pp = (int)(i % NP), g = (int)((i / NP) % NG), b = (int)((i / (NP * NG)) % 2), dir = (int)(i / (NP * NG * 2));
        S5Par q; s5_par(p, il, dir, g, pp, q);
        float pr = q.lbr, pi = q.lbi;
#pragma unroll
        for (int t = 0; t < 6; ++t) { const float nr = pr * pr - pi * pi, ni = 2.0f * pr * pi; pr = nr; pi = ni; }
        float cr = 0.f, ci = 0.f;
        float* ce0 = p.s5c + ((((long)dir * 2 + b) * S5NCH) * NG + g) * NP * 2 + pp * 2;
        constexpr int CB = 12;
        for (int c0 = 0; c0 < S5NCH; c0 += CB) {
            float er[CB], ei[CB];
#pragma unroll
            for (int j = 0; j < CB; ++j) if (c0 + j < S5NCH) { const float* ce = ce0 + (long)(c0 + j) * NG * NP * 2; er[j] = ce[0]; ei[j] = ce[1]; }
#pragma unroll
            for (int j = 0; j < CB; ++j) if (c0 + j < S5NCH) { float* ce = ce0 + (long)(c0 + j) * NG * NP * 2; ce[0] = cr; ce[1] = ci;
                const float tr = pr * cr - pi * ci + er[j], ti = pr * ci + pi * cr + ei[j]; cr = tr; ci = ti; }
        }
    }
}
DEV void ph_s5out(const P& p, int il, long gt, long gs) {
    GSL(i, (long)NTOK * S5W) {
        const int ch = (int)(i % S5W), r = (int)(i / S5W), g = ch / GH, h = ch % GH;
        float y = p.s5_d[il * S5W + ch] * pxf(p.px[(long)r * PXLD + 1536 + ch]);
        for (int dir = 0; dir < 2; ++dir) {
            const long ci = (((long)(il * 2 + dir) * NG + g) * GH + h) * NP;
            const float* s = p.s5s + (((long)dir * NTOK + r) * NG + g) * NP * 2;
            for (int pp = 0; pp < NP; ++pp) y += p.s5_cre[ci + pp] * s[pp * 2] - p.s5_cim[ci + pp] * s[pp * 2 + 1];
        }
        { const float gy = gelu_tanhf_(y); p.ys5[i] = gy; p.ys5b[i] = f2bf(gy); }
    }
}
DEV void ph_s5fin(const P& p, int il, long gt, long gs) {
    GSL(i, (long)NTOK * S5W) {
        const int ch = (int)(i % S5W), r = (int)(i / S5W);
        const float y = p.s5_d[il * S5W + ch] * pxf(p.px[(long)r * PXLD + 1536 + ch]) + p.yd[i] + p.yd[(long)NTOK * S5W + i];
        const float gy = gelu_tanhf_(y); p.ys5b[i] = f2bf(gy);
#ifdef CPU_SHIM
        p.ys5[i] = gy;
#endif
    }
}
DEV void ph_glu(const P& p, int il, long gt, long gs) {
    const float* w = p.s5_glu_w + (long)il * S5W * S5W;
    GSL(i, (long)NTOK * S5W) {
        const int ch = (int)(i % S5W), r = (int)(i / S5W); const float* a = p.ys5 + (long)r * S5W;
        float acc = p.s5_glu_b[il * S5W + ch];
        for (int k = 0; k < S5W; ++k) acc += a[k] * w[(long)k * S5W + ch];
        MIXST((long)r * D + HYW + ch, a[ch] * sigmoidf_(acc));
    }
}
DEV void ph_rope(const P& p, long gt, long gs) {
    GSL(i, (long)NTOK * 576) {
        const int it = (int)(i % 576), r = (int)(i / 576); const RowInfo ri = row_info(r); const px_t* pr = p.px + (long)r * PXLD;
        if (it < 256) {
            const int isk = it >= 128, hd = it & 127, h = hd >> 5, d = hd & 31;
            const px_t* src = pr + (isk ? 256 : 0) + h * 64; float x1 = pxf(src[d]), x2 = pxf(src[d + 32]);
            if (ri.kind == 0) { const float inv = exp2f(-(float)d * (13.287712379549449f / 32.0f)), ang = (float)ri.t * inv, cs = ROPE_COS(ang), sn = ROPE_SIN(ang);
                const float y1 = x1 * cs - x2 * sn, y2 = x1 * sn + x2 * cs; x1 = y1; x2 = y2; }
            const float sc = isk ? 1.0f : 0.125f;
            float* dst = (isk ? p.kr : p.qr) + (long)r * 256 + h * 64; dst[d] = x1 * sc; dst[d + 32] = x2 * sc;
        } else {
            const int j = it - 256, isk = j >= 256, hd = isk ? j - 256 : j, h = hd >> 5, e = hd & 31, half = e >> 4, d = e & 15;
            const px_t* src = pr + (isk ? 2048 : 1536) + h * 64 + half * 32; float x1 = pxf(src[d]), x2 = pxf(src[d + 16]);
            if (ri.kind == 0) { const float pos = (float)(half ? (ri.t % 64) : (ri.t / 64)); const float inv = exp2f(-(float)d * (13.287712379549449f / 16.0f)), ang = pos * inv, cs = ROPE_COS(ang), sn = ROPE_SIN(ang);
                const float y1 = x1 * cs - x2 * sn, y2 = x1 * sn + x2 * cs; x1 = y1; x2 = y2; }
            const float sc = isk ? 1.0f : 0.125f;
            float* dst = (isk ? p.ks + (long)r * 128 : p.qs + (long)r * 512) + h * 64 + half * 32; dst[d] = x1 * sc; dst[d + 16] = x2 * sc;
        }
    }
}
constexpr int RC = 128, RNCH = (CTXL + SEQ) / RC;
DEV float ret_logg(const P& p, int il, int dir, int h) { const float dl = p.ret_decay[(il * 2 + dir) * 4 + h]; return -log1pf(expf(-dl)); }
DEV void ph_retkv(const P& p, int il, long gt, long gs) {
    GSL(i, 2L * 2 * RNCH * 4 * 64 * 128) {
        const int e = (int)(i % 128), d = (int)((i / 128) % 64), h = (int)((i / 8192) % 4), n = (int)((i / 32768) % RNCH), b = (int)((i / (32768L * RNCH)) % 2), dir = (int)(i / (32768L * RNCH * 2));
        const float lg = ret_logg(p, il, dir, h);
        float acc = 0.f;
        for (int j = 0; j < RC; ++j) { const int row = scan_row(dir, b, n * RC + j);
            acc += expf((float)(RC - 1 - j) * lg) * p.kr[(long)row * 256 + h * 64 + d] * pxf(p.px[(long)row * PXLD + 512 + h * 128 + e]); }
        p.rkv[i] = acc;
    }
}
DEV void ph_retcarry(const P& p, int il, long gt, long gs) {
    GSL(i, 2L * 2 * 4 * 64 * 128) {
        const int de = (int)(i % 8192), h = (int)((i / 8192) % 4), b = (int)((i / 32768) % 2), dir = (int)(i / 65536);
        const float gc = expf((float)RC * ret_logg(p, il, dir, h));
        float S = 0.f;
        float* q0 = p.rkv + ((((long)dir * 2 + b) * RNCH) * 4 + h) * 8192 + de;
        constexpr int CB = 11;
        for (int n0 = 0; n0 < RNCH; n0 += CB) {
            float kv[CB];
#pragma unroll
            for (int j = 0; j < CB; ++j) if (n0 + j < RNCH) kv[j] = q0[(long)(n0 + j) * 4 * 8192];
#pragma unroll
            for (int j = 0; j < CB; ++j) if (n0 + j < RNCH) { q0[(long)(n0 + j) * 4 * 8192] = S; S = gc * S + kv[j]; }
        }
    }
}
DEV void ph_retsc(const P& p, int il, long gt, long gs) {
    GSL(i, 2L * NTOK * 4 * RC) {
        const int j = (int)(i % RC), h = (int)((i / RC) % 4), r = (int)((i / (RC * 4)) % NTOK), dir = (int)(i / ((long)RC * 4 * NTOK)); const RowInfo ri = row_info(r);
        const int b = ri.kind ? (ri.base - NLAT) / CTXL : ri.base / SEQ;
        const int step = ri.kind ? (dir ? CTXL - 1 - ri.t : ri.t) : CTXL + (dir ? SEQ - 1 - ri.t : ri.t), ii = step % RC, n = step / RC;
        float sc = 0.f;
        if (j <= ii) { const int rj = scan_row(dir, b, n * RC + j); const float* q = p.qr + (long)r * 256 + h * 64; const float* k = p.kr + (long)rj * 256 + h * 64;
            float dot = 0.f;
            for (int d = 0; d < 64; ++d) dot += q[d] * k[d];
            sc = dot * expf((float)(ii - j) * ret_logg(p, il, dir, h)); }
        p.rsc[i] = sc;
    }
}
DEV void ph_reto(const P& p, int il, long gt, long gs) {
    GSL(i, 2L * NTOK * 512) {
        const int e = (int)(i % 128), h = (int)((i / 128) % 4), r = (int)((i / 512) % NTOK), dir = (int)(i / (512L * NTOK)); const RowInfo ri = row_info(r);
        const int b = ri.kind ? (ri.base - NLAT) / CTXL : ri.base / SEQ;
        const int step = ri.kind ? (dir ? CTXL - 1 - ri.t : ri.t) : CTXL + (dir ? SEQ - 1 - ri.t : ri.t), ii = step % RC, n = step / RC;
        const float* sc = p.rsc + (((long)dir * NTOK + r) * 4 + h) * RC;
        float acc = 0.f;
        for (int j = 0; j <= ii; ++j) { const int rj = scan_row(dir, b, n * RC + j); acc += sc[j] * pxf(p.px[(long)rj * PXLD + 512 + h * 128 + e]); }
        const float* S = p.rkv + ((((long)dir * 2 + b) * RNCH + n) * 4 + h) * 8192 + e; const float* q = p.qr + (long)r * 256 + h * 64;
        float cr = 0.f;
        for (int d = 0; d < 64; ++d) cr += q[d] * S[d * 128];
        p.oret[((long)dir * NTOK + r) * 512 + h * 128 + e] = acc + cr * expf((float)(ii + 1) * ret_logg(p, il, dir, h));
    }
}
DEV void ph_retout(const P& p, int nrows, long gt, long gs) {
    GSL(i, (long)nrows * 4) {
        const int h = (int)(i % 4), r = (int)(i / 4);
        const float* o0 = p.oret + (long)r * 512 + h * 128; const float* o1 = p.oret + ((long)NTOK + r) * 512 + h * 128;
        float ss = 0.f;
        for (int e = 0; e < 128; ++e) { const float o = o0[e] + o1[e]; ss += o * o; }
        const float rs = rsqrtf(ss * (1.0f / 128.0f) + EPS);
        for (int e = 0; e < 128; ++e) MIXST((long)r * D + h * 128 + e, (o0[e] + o1[e]) * rs * siluf_(pxf(p.px[(long)r * PXLD + 1024 + h * 128 + e])));
    }
}
DEV void ph_swa(const P& p, int il, int nrows, long gt, long gs) {
    GSL(i, (long)nrows * 8) {
        const int hq = (int)(i % 8), r = (int)(i / 8), kv = hq >> 2; const RowInfo ri = row_info(r);
        const int b = ri.kind ? (ri.base - NLAT) / CTXL : ri.base / SEQ;
        float q[64], acc[64];
#pragma unroll
        for (int d = 0; d < 64; ++d) { q[d] = p.qs[(long)r * 512 + hq * 64 + d]; acc[d] = 0.f; }
        float m = p.swa_sink[il * 8 + hq], l = 1.0f;
        for (int part = 0; part < 2; ++part) {
            int k0, k1;
            if (part == 0) { if (ri.kind) continue; k0 = ri.base + (ri.t - 128 < 0 ? 0 : ri.t - 128); k1 = ri.base + (ri.t + 128 > SEQ - 1 ? SEQ - 1 : ri.t + 128); }
            else { k0 = NLAT + b * CTXL; k1 = k0 + CTXL - 1; }
            for (int kr = k0; kr <= k1; ++kr) {
                const float* kk = p.ks + (long)kr * 128 + kv * 64; const px_t* vv = p.px + (long)kr * PXLD + 2176 + kv * 64;
                float s = 0.f;
#pragma unroll
                for (int d = 0; d < 64; ++d) s += q[d] * kk[d];
                const float mn = fmaxf(m, s), corr = expf(m - mn), pe = expf(s - mn);
                l = l * corr + pe; m = mn;
#pragma unroll
                for (int d = 0; d < 64; ++d) acc[d] = acc[d] * corr + pe * pxf(vv[d]);
            }
        }
        const float il_ = 1.0f / l;
#pragma unroll
        for (int d = 0; d < 64; ++d) MIXST((long)r * D + 512 + hq * 64 + d, acc[d] * il_);
    }
}
DEV void ph_outproj(const P& p, int layer, const float* w, int nrows, long gt, long gs) {
    GSL(i, (long)nrows * D) {
        const int n = (int)(i % D), r = (int)(i / D); const RowInfo ri = row_info(r);
        const float* a = p.mixin + (long)r * D; const float* b = w + n;
        float acc = 0.f;
        for (int k = 0; k < D; ++k) acc += a[k] * b[(long)k * D];
        p.xa[i] += p.modv[((long)layer * 3 + ri.m) * 6 * D + 2 * D + n] * acc;
    }
}
DEV int atomic_inc(int* q) {
#ifdef CPU_SHIM
    return __atomic_fetch_add(q, 1, __ATOMIC_RELAXED);
#else
    return atomicAdd(q, 1);
#endif
}
DEV void ph_router(const P& p, int layer, int nrows, long gt, long gs) {
    const float* rw = p.router_w + (long)layer * D * NE;
    GSL(j, NSLOT) { p.slot_tok[j] = -1; p.slot_gate[j] = 0.f; }
    GSL(r, nrows) {
        float lg[NE];
#pragma unroll
        for (int e = 0; e < NE; ++e) lg[e] = p.router_b[layer * NE + e];
        const float* a = p.hx + (long)r * D;
        for (int k = 0; k < D; ++k) { const float av = a[k];
#pragma unroll
            for (int e = 0; e < NE; ++e) lg[e] += av * rw[k * NE + e]; }
        int ti[4]; float tv[4];
#pragma unroll
        for (int s = 0; s < 4; ++s) { int best = 0; float bv = -3.0e38f;
#pragma unroll
            for (int e = 0; e < NE; ++e) { if (lg[e] > bv) { bv = lg[e]; best = e; } }
            ti[s] = best; tv[s] = bv;
#pragma unroll
            for (int e = 0; e < NE; ++e) if (e == best) lg[e] = -3.0e38f; }
        const float e1 = expf(tv[1] - tv[0]), e2 = expf(tv[2] - tv[0]), e3 = expf(tv[3] - tv[0]), inv = 1.0f / (1.0f + e1 + e2 + e3);
        p.topi[r * 4 + 0] = ti[0]; p.topi[r * 4 + 1] = ti[1]; p.topi[r * 4 + 2] = ti[2]; p.topi[r * 4 + 3] = ti[3];
        p.topg[r * 4 + 0] = inv; p.topg[r * 4 + 1] = e1 * inv; p.topg[r * 4 + 2] = e2 * inv; p.topg[r * 4 + 3] = e3 * inv;
#pragma unroll
        for (int s = 0; s < 4; ++s) p.pos[r * 4 + s] = atomic_inc(p.cnt + layer * NE + ti[s]);
    }
}
DEV int moe_tiles(const int* cnt) { int t = 0; for (int e = 0; e < NE; ++e) t += (cnt[e] + 255) >> 8; return t; }
DEV int tile_expert(const int* cnt, int pm) { int t = 0; for (int e = 0; e < NE; ++e) { t += (cnt[e] + 255) >> 8; if (pm < t) return e; } return NE - 1; }
DEV void ph_assign(const P& p, int layer, int nrows, long gt, long gs) {
    const int* cnt = p.cnt + layer * NE;
    GSL(i, (long)nrows * 4) {
        const int e = p.topi[i]; int off = 0;
#pragma unroll
        for (int q = 0; q < NE; ++q) { const int cq = cnt[q]; off += q < e ? ((cq + 255) >> 8) << 8 : 0; }
        const int slot = off + p.pos[i];
        p.slot_of[i] = slot; p.slot_tok[slot] = (int)(i >> 2); p.slot_gate[slot] = p.topg[i];
    }
}
DEV void ph_gather(const P& p, int layer, long gt, long gs) {
    const long used = (long)moe_tiles(p.cnt + layer * NE) * 256;
    GSL(i, used * D) { const int k = (int)(i % D); const long slot = i / D; const int tok = p.slot_tok[slot]; p.xb[i] = tok >= 0 ? p.hxb[(long)tok * D + k] : (bf16_t)0; }
}
DEV void ph_moe1s(const P& p, int layer, long gt, long gs) {
    const int* cnt = p.cnt + layer * NE; const long used = (long)moe_tiles(cnt) * 256;
    GSL(i, used * DFF) {
        const int j = (int)(i % DFF); const long slot = i / DFF; const int e = tile_expert(cnt, (int)(slot >> 8));
        const float* w = p.w_gu + ((long)layer * NE + e) * D * 2 * DFF + j; const bf16_t* a = p.xb + slot * D;
        const float* bb = p.b_gu + ((long)layer * NE + e) * 2 * DFF;
        float ga = bb[j], up = bb[DFF + j];
        for (int k = 0; k < D; ++k) { const float av = bf2f(a[k]); ga += av * w[(long)k * 2 * DFF]; up += av * w[(long)k * 2 * DFF + DFF]; }
        ga = fminf(ga, 7.0f); up = fminf(fmaxf(up, -7.0f), 7.0f);
        p.actb[i] = f2bf(ga * sigmoidf_(1.702f * ga) * (up + 1.0f));
    }
}
DEV void ph_moe2s(const P& p, int layer, long gt, long gs) {
    const int* cnt = p.cnt + layer * NE; const long used = (long)moe_tiles(cnt) * 256;
    GSL(i, used * D) {
        const int n = (int)(i % D); const long slot = i / D; const int e = tile_expert(cnt, (int)(slot >> 8));
        const float* w = p.w_dn + ((long)layer * NE + e) * DFF * D + n; const bf16_t* a = p.actb + slot * DFF;
        float acc = p.b_dn[((long)layer * NE + e) * D + n];
        for (int k = 0; k < DFF; ++k) acc += bf2f(a[k]) * w[(long)k * D];
        p.yb[i] = f2bf(acc * p.slot_gate[slot]);
    }
}
DEV void ph_combine(const P& p, int layer, int nrows, long gt, long gs) {
    GSL(i, (long)nrows * D) {
        const int n = (int)(i % D), r = (int)(i / D); const RowInfo ri = row_info(r);
        float y = 0.f;
#pragma unroll
        for (int s = 0; s < 4; ++s) y += bf2f(p.yb[(long)p.slot_of[r * 4 + s] * D + n]);
        p.xa[i] += p.modv[((long)layer * 3 + ri.m) * 6 * D + 5 * D + n] * y;
    }
}
DEV void ph_final(const P& p, long gt, long gs) {
    GSL(i, (long)NLAT * D) { const int k = (int)(i % D), r = (int)(i / D); p.out[i] = p.xa[i] * p.rstd[r] * p.final_g[k]; }
}

constexpr int N_SETUP = 6, N_SLOT = 18;
#ifdef CPU_SHIM
#define SWA_NAIVE ph_swa(p, il, nrows, gt, gs);
#define S5_NAIVE(x) x
#define S5_FIN ph_s5out(p, il, gt, gs);
#define RET_NAIVE_A ph_retkv(p, il, gt, gs); ph_retsc(p, il, gt, gs);
#define RET_NAIVE_C ph_reto(p, il, gt, gs);
#else
#define SWA_NAIVE
#define S5_NAIVE(x)
#define S5_FIN ph_s5fin(p, il, gt, gs);
#define RET_NAIVE_A
#define RET_NAIVE_C
#endif
#ifdef CPU_SHIM
#define LCONV_LAT(p, il, gt, gs) ph_lconv_fft(p, il, gt, gs)
#else
#define LCONV_LAT(p, il, gt, gs)
#endif
template <int S> DEV void setup_slot(const P& p, long gt, long gs) {
    if constexpr (S == 0) { ph_init(p, gt, gs); ph_mod(p, gt, gs); }
    if constexpr (S == 1) { ph_mod2(p, gt, gs); ph_filt1(p, gt, gs); }
    if constexpr (S == 2) ph_filt2(p, gt, gs);
    if constexpr (S == 3) ph_filt3(p, gt, gs);
    if constexpr (S == 4) ph_filt4a(p, gt, gs);
    if constexpr (S == 5) ph_filt4(p, gt, gs);
}
template <int S> DEV void layer_slot(const P& p, int layer, long gt, long gs) {
    const int il = layer >> 1; const bool ab = !(layer & 1);
    const int nrows = layer < 3 ? NTOK : NLAT;
    if constexpr (S == 0) ph_rstd(p, NTOK, gt, gs);
    if constexpr (S == 1) ph_hx(p, layer, 0, NTOK, gt, gs);
    if constexpr (S == 2) { if (ab) ph_inproj(p, p.ab_w_in + (long)il * D * AB_IN, AB_IN, gt, gs); else ph_inproj(p, p.cd_w_in + (long)il * D * CD_IN, CD_IN, gt, gs); }
    if constexpr (S == 3) { if (ab) { ph_sconv(p, il, gt, gs); S5_NAIVE(ph_s5chunk(p, il, 0, gt, gs);) } else ph_rope(p, gt, gs); }
    if constexpr (S == 4) { if (ab) { LCONV_LAT(p, il, gt, gs); ph_lconv(p, il, NLAT, NTOK, gt, gs); ph_s5carry(p, il, gt, gs); } else { RET_NAIVE_A } }
    if constexpr (S == 5) { if (ab) { ph_hymix(p, il, gt, gs); S5_NAIVE(ph_s5chunk(p, il, 1, gt, gs);) } else { ph_retcarry(p, il, gt, gs); SWA_NAIVE } }
    if constexpr (S == 6) { if (ab) { S5_FIN } else { RET_NAIVE_C } }
    if constexpr (S == 7) { if (ab) ph_glu(p, il, gt, gs); else ph_retout(p, nrows, gt, gs); }
    if constexpr (S == 8) ph_outproj(p, layer, (ab ? p.ab_w_out : p.cd_w_out) + (long)il * D * D, nrows, gt, gs);
    if constexpr (S == 9) ph_rstd(p, nrows, gt, gs);
    if constexpr (S == 10) ph_hx(p, layer, 1, nrows, gt, gs);
    if constexpr (S == 11) ph_router(p, layer, nrows, gt, gs);
    if constexpr (S == 12) ph_assign(p, layer, nrows, gt, gs);
    if constexpr (S == 13) ph_gather(p, layer, gt, gs);
    if constexpr (S == 14) ph_moe1s(p, layer, gt, gs);
    if constexpr (S == 15) ph_moe2s(p, layer, gt, gs);
    if constexpr (S == 16) ph_combine(p, layer, nrows, gt, gs);
}
template <int S> DEV void final_slot(const P& p, long gt, long gs) {
    if constexpr (S == 0) ph_rstd(p, NLAT, gt, gs);
    if constexpr (S == 1) ph_final(p, gt, gs);
}

struct WsMap { size_t off[56]; size_t total; };
static inline WsMap ws_map() {
    WsMap m; size_t o = 0; int n = 0;
    auto take = [&](size_t bytes) { m.off[n++] = o; o += (bytes + 255) & ~(size_t)255; };
    take(16384);
    take((size_t)NTOK * D * 4);
    take((size_t)4 * 3 * 6 * D * 4);
    take((size_t)2 * (SEQ + CTXL) * 64 * 4);
    take((size_t)2 * (SEQ + CTXL) * 64 * 4);
    take((size_t)2 * (SEQ + CTXL) * HYW * 4);
    take((size_t)2 * 2 * HYW * 4);
    take((size_t)NTOK * 4);
    take((size_t)NTOK * D * 4);
    take((size_t)NTOK * PXLD * 4);
    take((size_t)NTOK * HYW * 4);
    take((size_t)NTOK * HYW * 4);
    take((size_t)NTOK * D * 4);
    take((size_t)2 * NTOK * NG * NP * 2 * 4);
    take((size_t)NTOK * S5W * 4);
    take((size_t)NTOK * 256 * 4);
    take((size_t)NTOK * 256 * 4);
    take((size_t)2 * NTOK * 512 * 4);
    take((size_t)NTOK * 512 * 4);
    take((size_t)NTOK * 128 * 4);
    take((size_t)NTOK * 4 * 4);
    take((size_t)NTOK * 4 * 4);
    take(256);
    take((size_t)(NTOK + 1) * D * 2);
    take((size_t)NTOK * D * 2);
    take((size_t)NTOK * S5W * 2);
    take((size_t)NSLOT * D * 2);
    take((size_t)NSLOT * DFF * 2);
    take((size_t)NSLOT * D * 4);
    take((size_t)NSLOT * 4);
    take((size_t)4 * NE * 4);
    take((size_t)NTOK * 4 * 4);
    take((size_t)NTOK * 4 * 4);
    take((size_t)NSLOT * 4);
    take((size_t)2 * AB_IN * D * 2);
    take((size_t)2 * CD_IN * D * 2);
    take((size_t)2 * D * D * 2);
    take((size_t)2 * D * D * 2);
    take((size_t)2 * S5W * S5W * 2);
    take((size_t)4 * NE * 2 * DFF * D * 2);
    take((size_t)4 * NE * D * DFF * 2);
    take((size_t)2 * 2 * S5NCH * NG * NP * 2 * 4);
    take((size_t)2 * 2 * RNCH * 4 * 8192 * 4);
    take((size_t)2 * NTOK * 4 * RC * 4);
    take((size_t)2 * FNSEG * HYW * 4);
    take((size_t)256 * 2 * FFTN * 4);
    take((size_t)HYW * NLAT * 4);
    take((size_t)2 * NTOK * S5W * 4);
    take((size_t)HYW * NLAT * 4);
    take((size_t)2 * HYW * SEQ * 4);
    take((size_t)8 * 4 * 3 * 6 * D * 4);
    m.total = o; return m;
}
static inline void fill_params(P& p, void* const* d_in, void* d_out, void* d_ws) {
    const float* const* in = (const float* const*)d_in;
    p.x = in[0]; p.c = in[1]; p.ctx = in[2]; p.c_ctx = in[3]; p.mod_w = in[4]; p.mod_b = in[5]; p.norm1_g = in[6]; p.norm2_g = in[7];
    p.ab_w_in = in[8]; p.ab_w_out = in[9]; p.hy_short_w = in[10]; p.hy_short_b = in[11]; p.hy_f_w1 = in[12]; p.hy_f_b1 = in[13];
    p.hy_f_w2 = in[14]; p.hy_f_b2 = in[15]; p.hy_f_w3 = in[16]; p.hy_bias = in[17]; p.s5_lre = in[18]; p.s5_lim = in[19]; p.s5_ldt = in[20];
    p.s5_bre = in[21]; p.s5_bim = in[22]; p.s5_cre = in[23]; p.s5_cim = in[24]; p.s5_d = in[25]; p.s5_glu_w = in[26]; p.s5_glu_b = in[27];
    p.cd_w_in = in[28]; p.cd_w_out = in[29]; p.ret_decay = in[30]; p.swa_sink = in[31]; p.router_w = in[32]; p.router_b = in[33];
    p.w_gu = in[34]; p.b_gu = in[35]; p.w_dn = in[36]; p.b_dn = in[37]; p.final_g = in[38];
    p.out = (float*)d_out;
    const WsMap m = ws_map(); char* w = (char*)d_ws;
    p.bar = (unsigned*)(w + m.off[0]); p.xa = (float*)(w + m.off[1]); p.modv = (float*)(w + m.off[2]); p.f1 = (float*)(w + m.off[3]); p.f2 = (float*)(w + m.off[4]);
    p.hraw = (float*)(w + m.off[5]); p.hsum = (float*)(w + m.off[6]); p.rstd = (float*)(w + m.off[7]); p.hx = (float*)(w + m.off[8]); p.px = (px_t*)(w + m.off[9]);
    p.zb = (float*)(w + m.off[10]); p.x0c = (float*)(w + m.off[11]); p.mixin = (float*)(w + m.off[12]); p.s5s = (float*)(w + m.off[13]); p.ys5 = (float*)(w + m.off[14]);
    p.qr = (float*)(w + m.off[15]); p.kr = (float*)(w + m.off[16]); p.oret = (float*)(w + m.off[17]); p.qs = (float*)(w + m.off[18]); p.ks = (float*)(w + m.off[19]);
    p.topg = (float*)(w + m.off[20]); p.topi = (int*)(w + m.off[21]); p.act = nullptr;
    p.hxb = (bf16_t*)(w + m.off[23]); p.mixb = (bf16_t*)(w + m.off[24]); p.ys5b = (bf16_t*)(w + m.off[25]); p.xb = (bf16_t*)(w + m.off[26]); p.actb = (bf16_t*)(w + m.off[27]);
    p.yb = (bf16_t*)(w + m.off[28]); p.slot_gate = (float*)(w + m.off[29]); p.cnt = (int*)(w + m.off[30]); p.pos = (int*)(w + m.off[31]); p.slot_of = (int*)(w + m.off[32]);
    p.slot_tok = (int*)(w + m.off[33]); p.abin_t = (bf16_t*)(w + m.off[34]); p.cdin_t = (bf16_t*)(w + m.off[35]); p.about_t = (bf16_t*)(w + m.off[36]);
    p.cdout_t = (bf16_t*)(w + m.off[37]); p.glu_t = (bf16_t*)(w + m.off[38]); p.wgu_t = (bf16_t*)(w + m.off[39]); p.wdn_t = (bf16_t*)(w + m.off[40]);
    p.s5c = (float*)(w + m.off[41]); p.rkv = (float*)(w + m.off[42]); p.rsc = (float*)(w + m.off[43]); p.hpart = (float*)(w + m.off[44]);
    p.zf = (float*)(w + m.off[45]); p.convT = (float*)(w + m.off[46]); p.yd = (float*)(w + m.off[47]); p.zT = (float*)(w + m.off[48]); p.hT = (float*)(w + m.off[49]); p.modp = (float*)(w + m.off[50]);
}

#ifndef CPU_SHIM
namespace pg8 {
#define PG8_LAS __attribute__((address_space(3)))
typedef short bf16x8 __attribute__((ext_vector_type(8)));
typedef float f32x4 __attribute__((ext_vector_type(4)));
constexpr int BM = 256, BK = 64, HALF = 128, HTB = HALF * BK * 2, STAGE_BYTES = 8 * HTB, NXCD = 8, WGM = 8;
__host__ __device__ __forceinline__ int lds_byte(int r, int c) { const int st = (r >> 4) * 2 + (c >> 5), rr = r & 15, cc = c & 31, ob = rr * 64 + cc * 2; return st * 1024 + (ob ^ (((ob >> 9) & 1) << 5)); }
__host__ __device__ __forceinline__ void stage_rc(int b, int& R, int& C) { const int st = b / 1024, sb = b % 1024, swz = sb ^ (((sb >> 9) & 1) << 5); R = (st >> 1) * 16 + swz / 64; C = (st & 1) * 32 + (swz % 64) / 2; }
struct Unit { int pm, pn, e; };
struct Gemm { const bf16_t* A; const bf16_t* Bt; int M, N, K; size_t ebytes; };
struct StaticOrder {
    int nM, nN, nwg, G, c;
    __device__ void init(int M, int N, int G_, int c_) { nM = M / BM; nN = N / BM; nwg = nM * nN; G = G_; c = c_; }
    __device__ bool next(int i, Unit& u) const {
        const long L = (long)i * G + c; if (L >= nwg) return false;
        int wgid = (int)L; { const int q = nwg / NXCD, r = nwg % NXCD, xcd = wgid % NXCD, off = wgid / NXCD; wgid = (xcd < r ? xcd * (q + 1) : r * (q + 1) + (xcd - r) * q) + off; }
        const int nig = WGM * nN, gid = wgid / nig, fm = gid * WGM, gsz = (nM - fm) < WGM ? (nM - fm) : WGM;
        u.pm = fm + ((wgid % nig) % gsz); u.pn = (wgid % nig) / gsz; u.e = 0; return true;
    }
    __device__ int tok(int, int) const { return 0; }
};
struct MoeOrder {
    int nwg, nN, G, c; const volatile PG8_LAS unsigned char* ue; const volatile PG8_LAS int* tokt;
    __device__ int tok(int ui, int row) const { return tokt[ui * 256 + row]; }
    __device__ bool unit(int i, int& pm, int& pn) const {
        const int S = G >> 3;
        if ((G & 7) == 0 && S % nN == 0) { const int x = c & 7, slot = c >> 3, pmx = S / nN, T = nwg / nN, tpx = (T + 7) >> 3, lp = i * pmx + slot / nN;
            pm = x * tpx + lp; pn = slot % nN; return lp < tpx && pm < T; }
        const long L = (long)i * G + c; pm = (int)(L / nN); pn = (int)(L % nN); return L < nwg;
    }
    __device__ bool next(int i, Unit& u) const {
        int pm, pn; if (!unit(i, pm, pn)) return false;
        u.pm = pm; u.pn = pn; u.e = __builtin_amdgcn_readfirstlane((int)ue[pm]); return true;
    }
};
template <class Epi, class Sched, bool GATHER = false>
__device__ __forceinline__ void gemm_phase(PG8_LAS unsigned char* lds, const Gemm g, const Sched& S, const Epi& E) {
    int tid = threadIdx.x; asm volatile("" : "+v"(tid));
    const int wid = __builtin_amdgcn_readfirstlane(tid >> 6), lane = tid & 63, wr = wid >> 2, wc = wid & 3, fr = lane & 15, fq = lane >> 4;
    const int K = g.K, nt = K / BK;
    unsigned va[2][2], vn[2][2], voffB[2]; int Rr[2]; unsigned Cb[2];
#pragma unroll
    for (int i = 0; i < 2; ++i) { int R, C; stage_rc(tid * 16 + i * 8192, R, C); Rr[i] = R; Cb[i] = (unsigned)C * 2u; voffB[i] = (unsigned)(R * K + C) * 2u; }
    const size_t kstep = (size_t)(BK * 2);
    const size_t hstep = (size_t)HALF * K * 2;
    const size_t tstep = 2 * hstep;
#define PG8_SETOFF(v, ui_) do { _Pragma("unroll") for (int h_ = 0; h_ < 2; ++h_) _Pragma("unroll") for (int i_ = 0; i_ < 2; ++i_) \
        v[h_][i_] = GATHER ? (unsigned)S.tok(ui_, h_ * HALF + Rr[i_]) * (unsigned)(K * 2) + Cb[i_] : voffB[i_] + (unsigned)(h_ * hstep); } while (0)
    const unsigned ldsw = (unsigned)wid * 1024u;
    const int aoff = lds_byte(wr * 64 + fr, fq * 8), boff = lds_byte(wc * 32 + fr, fq * 8);
#define PG8_SA(b, h) (((b) * 2 + (h)) * HTB)
#define PG8_SB(b, h) ((4 + (b) * 2 + (h)) * HTB)
#define PG8_STAGE(bufoff, gbase, voff) do { _Pragma("unroll") for (int _i = 0; _i < 2; ++_i) \
        __builtin_amdgcn_global_load_lds((const unsigned*)((const char*)(gbase) + (voff)[_i]), (PG8_LAS unsigned*)(lds + (bufoff) + ldsw + _i * 8192), 16, 0, 0); } while (0)
#define PG8_LDA(dst, b, h) do { _Pragma("unroll") for (int m = 0; m < 4; ++m) _Pragma("unroll") for (int k = 0; k < 2; ++k) dst[m][k] = *(const PG8_LAS bf16x8*)(lds + PG8_SA(b, h) + aoff + m * 2048 + k * 1024); } while (0)
#define PG8_LDB(dst, b, h) do { _Pragma("unroll") for (int n = 0; n < 2; ++n) _Pragma("unroll") for (int k = 0; k < 2; ++k) dst[n][k] = *(const PG8_LAS bf16x8*)(lds + PG8_SB(b, h) + boff + n * 2048 + k * 1024); } while (0)
#define PG8_MMA(ai, bj, At, Bt) do { __builtin_amdgcn_s_setprio(1); _Pragma("unroll") for (int m = 0; m < 4; ++m) _Pragma("unroll") for (int n = 0; n < 2; ++n) _Pragma("unroll") for (int k = 0; k < 2; ++k) \
        acc[ai][bj][m][n] = __builtin_amdgcn_mfma_f32_16x16x32_bf16(Bt[n][k], At[m][k], acc[ai][bj][m][n], 0, 0, 0); __builtin_amdgcn_s_setprio(0); } while (0)
#define PG8_WAIT_V(n) asm volatile("s_waitcnt vmcnt(" #n ")" ::: "memory")
#define PG8_WAIT_L(n) asm volatile("s_waitcnt lgkmcnt(" #n ")" ::: "memory")
#define PG8_BAR __builtin_amdgcn_s_barrier()
#define PG8_SCHED __builtin_amdgcn_sched_barrier(0)
    Unit cur, nxt; int ui = 0;
    if (!S.next(0, cur)) return;
    f32x4 acc[2][2][4][2];
#pragma unroll
    for (int a = 0; a < 2; ++a)
#pragma unroll
        for (int b = 0; b < 2; ++b)
#pragma unroll
            for (int m = 0; m < 4; ++m)
#pragma unroll
                for (int n = 0; n < 2; ++n) acc[a][b][m][n] = (f32x4){0.f, 0.f, 0.f, 0.f};
    bf16x8 At[4][2], B0[2][2], B1[2][2];
    const char* cA = (const char*)g.A + (GATHER ? (size_t)0 : (size_t)cur.pm * tstep); const char* cB = (const char*)g.Bt + (size_t)cur.e * g.ebytes + (size_t)cur.pn * tstep;
    PG8_SETOFF(va, 0);
    PG8_STAGE(PG8_SB(0, 0), cB, voffB); PG8_STAGE(PG8_SB(0, 1), cB + hstep, voffB); PG8_STAGE(PG8_SA(0, 0), cA, va[0]); PG8_STAGE(PG8_SA(0, 1), cA, va[1]);
    if (wr == 1) PG8_BAR;
    PG8_WAIT_V(2); PG8_BAR;
    PG8_STAGE(PG8_SB(1, 0), cB + kstep, voffB); PG8_STAGE(PG8_SA(1, 0), cA + kstep, va[0]); PG8_STAGE(PG8_SB(1, 1), cB + hstep + kstep, voffB);
    PG8_WAIT_V(6); PG8_BAR;
    for (;;) {
        const bool has_next = S.next(ui + 1, nxt);
        const char* nA = has_next ? (const char*)g.A + (GATHER ? (size_t)0 : (size_t)nxt.pm * tstep) : cA; const char* nB = has_next ? (const char*)g.Bt + (size_t)nxt.e * g.ebytes + (size_t)nxt.pn * tstep : cB;
        if (GATHER && has_next) PG8_SETOFF(vn, ui + 1); else { _Pragma("unroll") for (int h_ = 0; h_ < 2; ++h_) _Pragma("unroll") for (int i_ = 0; i_ < 2; ++i_) vn[h_][i_] = va[h_][i_]; }
        for (int t = 0; t < nt; t += 2) {
            const bool last = (t == nt - 2);
            const char* a1 = cA + (size_t)(t + 1) * kstep;
            const char* a2 = last ? nA : cA + (size_t)(t + 2) * kstep; const char* b2 = last ? nB : cB + (size_t)(t + 2) * kstep;
            const char* a3 = a2 + kstep; const char* b3 = b2 + kstep;
            unsigned s0[2], s1[2];
#pragma unroll
            for (int i_ = 0; i_ < 2; ++i_) { s0[i_] = last ? vn[0][i_] : va[0][i_]; s1[i_] = last ? vn[1][i_] : va[1][i_]; }
            PG8_LDB(B0, 0, 0); PG8_LDB(B1, 0, 1); PG8_SCHED; PG8_LDA(At, 0, 0); PG8_STAGE(PG8_SA(1, 1), a1, va[1]);
            PG8_WAIT_V(8); PG8_WAIT_L(0); PG8_BAR; PG8_MMA(0, 0, At, B0); PG8_MMA(0, 1, At, B1); PG8_BAR; PG8_SCHED;
            PG8_LDA(At, 0, 1); PG8_STAGE(PG8_SB(0, 0), b2, voffB); PG8_STAGE(PG8_SB(0, 1), b2 + hstep, voffB); PG8_STAGE(PG8_SA(0, 0), a2, s0);
            PG8_WAIT_V(8); PG8_WAIT_L(0); PG8_BAR; PG8_MMA(1, 0, At, B0); PG8_MMA(1, 1, At, B1); PG8_BAR; PG8_SCHED;
            PG8_LDB(B0, 1, 0); PG8_LDB(B1, 1, 1); PG8_SCHED; PG8_LDA(At, 1, 0); PG8_STAGE(PG8_SA(0, 1), a2, s1);
            PG8_WAIT_V(8); PG8_WAIT_L(0); PG8_BAR; PG8_MMA(0, 0, At, B0); PG8_MMA(0, 1, At, B1); PG8_BAR; PG8_SCHED;
            PG8_LDA(At, 1, 1); PG8_STAGE(PG8_SB(1, 0), b3, voffB); PG8_STAGE(PG8_SB(1, 1), b3 + hstep, voffB); PG8_STAGE(PG8_SA(1, 0), a3, s0);
            PG8_WAIT_V(8); PG8_WAIT_L(0); PG8_BAR; PG8_MMA(1, 0, At, B0); PG8_MMA(1, 1, At, B1); PG8_BAR; PG8_SCHED;
        }
        if (wr == 0) PG8_BAR;
        E(acc, cur, wr, wc, fr, fq);
        if (!has_next) break;
#pragma unroll
        for (int a = 0; a < 2; ++a)
#pragma unroll
            for (int b = 0; b < 2; ++b)
#pragma unroll
                for (int m = 0; m < 4; ++m)
#pragma unroll
                    for (int n = 0; n < 2; ++n) acc[a][b][m][n] = (f32x4){0.f, 0.f, 0.f, 0.f};
        cur = nxt; cA = nA; cB = nB; ++ui;
#pragma unroll
        for (int h_ = 0; h_ < 2; ++h_)
#pragma unroll
            for (int i_ = 0; i_ < 2; ++i_) va[h_][i_] = vn[h_][i_];
        if (wr == 1) PG8_BAR;
    }
    PG8_WAIT_V(0);
    PG8_BAR;
#undef PG8_SA
#undef PG8_SB
#undef PG8_STAGE
#undef PG8_SETOFF
#undef PG8_LDA
#undef PG8_LDB
#undef PG8_MMA
#undef PG8_WAIT_V
#undef PG8_WAIT_L
#undef PG8_BAR
#undef PG8_SCHED
}
typedef float f32x2v __attribute__((ext_vector_type(2)));
typedef __bf16 bf16x2v __attribute__((ext_vector_type(2)));
__device__ __forceinline__ unsigned cvt_pk_bf16(float lo, float hi) { const bf16x2v r = __builtin_convertvector((f32x2v){lo, hi}, bf16x2v); return __builtin_bit_cast(unsigned, r); }
__device__ __forceinline__ float fast_sigmoid(float x) { return __builtin_amdgcn_rcpf(1.0f + __builtin_amdgcn_exp2f(-1.4426950408889634f * x)); }
#define EPI_LOOP(body) _Pragma("unroll") for (int ai = 0; ai < 2; ++ai) _Pragma("unroll") for (int m = 0; m < 4; ++m) { const int row = row0 + ai * HALF + m * 16; \
    _Pragma("unroll") for (int bj = 0; bj < 2; ++bj) _Pragma("unroll") for (int n = 0; n < 2; ++n) { const int col = col0 + bj * HALF + n * 16; const f32x4 a = acc[ai][bj][m][n]; body } }
struct EpiStoreF32 {
    float* C; int ldc;
    __device__ __forceinline__ void operator()(const f32x4 (&acc)[2][2][4][2], const Unit& u, int wr, int wc, int fr, int fq) const {
        const int row0 = u.pm * BM + wr * 64 + fr, col0 = u.pn * BM + wc * 32 + 4 * fq;
        EPI_LOOP( *(f32x4*)(C + (size_t)row * ldc + col) = a; )
    }
};
struct EpiStoreBf16 {
    bf16_t* C; int ldc;
    __device__ __forceinline__ void operator()(const f32x4 (&acc)[2][2][4][2], const Unit& u, int wr, int wc, int fr, int fq) const {
        const int row0 = u.pm * BM + wr * 64 + fr, col0 = u.pn * BM + wc * 32 + 4 * fq;
        EPI_LOOP( uint2 o; o.x = cvt_pk_bf16(a[0], a[1]); o.y = cvt_pk_bf16(a[2], a[3]); *(uint2*)(C + (size_t)row * ldc + col) = o; )
    }
};
struct EpiResid {
    float* X; const float* gv;
    __device__ __forceinline__ void operator()(const f32x4 (&acc)[2][2][4][2], const Unit& u, int wr, int wc, int fr, int fq) const {
        const int row0 = u.pm * BM + wr * 64 + fr, col0 = u.pn * BM + wc * 32 + 4 * fq;
        const int r0 = u.pm * BM, mrow = r0 < SEQ ? 0 : (r0 < NLAT ? 1 : 2); const float* g = gv + (size_t)mrow * 6 * D;
        EPI_LOOP( const f32x4 gg = *(const f32x4*)(g + col); f32x4* q = (f32x4*)(X + (size_t)row * D + col); *q = *q + gg * a; )
    }
};
struct EpiGlu {
    bf16_t* O; const bf16_t* Y; const float* bias;
    __device__ __forceinline__ void operator()(const f32x4 (&acc)[2][2][4][2], const Unit& u, int wr, int wc, int fr, int fq) const {
        const int row0 = u.pm * BM + wr * 64 + fr, col0 = u.pn * BM + wc * 32 + 4 * fq;
        EPI_LOOP( const f32x4 bb = *(const f32x4*)(bias + col); const ushort4 yv = *(const ushort4*)(Y + (size_t)row * S5W + col);
            uint2 o; o.x = cvt_pk_bf16(bf2f(yv.x) * fast_sigmoid(a[0] + bb[0]), bf2f(yv.y) * fast_sigmoid(a[1] + bb[1])); o.y = cvt_pk_bf16(bf2f(yv.z) * fast_sigmoid(a[2] + bb[2]), bf2f(yv.w) * fast_sigmoid(a[3] + bb[3]));
            *(uint2*)(O + (size_t)row * D + HYW + col) = o; )
    }
};
struct EpiSwiglu {
    bf16_t* O; const float* bgu;
    __device__ __forceinline__ void operator()(const f32x4 (&acc)[2][2][4][2], const Unit& u, int wr, int wc, int fr, int fq) const {
        const int row0 = u.pm * BM + wr * 64 + fr, colb = wc * 32 + 4 * fq; const float* bb = bgu + (size_t)u.e * 2 * DFF + u.pn * 128;
#pragma unroll
        for (int ai = 0; ai < 2; ++ai)
#pragma unroll
            for (int m = 0; m < 4; ++m) { const int row = row0 + ai * HALF + m * 16;
#pragma unroll
                for (int n = 0; n < 2; ++n) { const int cc = colb + n * 16; const f32x4 bg = *(const f32x4*)(bb + cc), bu = *(const f32x4*)(bb + DFF + cc);
                    const f32x4 ga = acc[ai][0][m][n] + bg, up = acc[ai][1][m][n] + bu; float av[4];
#pragma unroll
                    for (int j = 0; j < 4; ++j) { const float gg = fminf(ga[j], 7.0f), uu = fminf(fmaxf(up[j], -7.0f), 7.0f); av[j] = gg * fast_sigmoid(1.702f * gg) * (uu + 1.0f); }
                    uint2 o; o.x = cvt_pk_bf16(av[0], av[1]); o.y = cvt_pk_bf16(av[2], av[3]);
                    *(uint2*)(O + (size_t)row * DFF + u.pn * 128 + cc) = o; } }
    }
};
struct EpiDown {
    bf16_t* Y; const float* bdn; const float* gate;
    __device__ __forceinline__ void operator()(const f32x4 (&acc)[2][2][4][2], const Unit& u, int wr, int wc, int fr, int fq) const {
        const int row0 = u.pm * BM + wr * 64 + fr, col0 = u.pn * BM + wc * 32 + 4 * fq; const float* bb = bdn + (size_t)u.e * D;
        EPI_LOOP( const f32x4 bv = *(const f32x4*)(bb + col); const float gt_ = gate[row]; const f32x4 o = (a + bv) * gt_; uint2 ob; ob.x = cvt_pk_bf16(o[0], o[1]); ob.y = cvt_pk_bf16(o[2], o[3]); *(uint2*)(Y + (size_t)row * D + col) = ob; )
    }
};
}

constexpr int RING_BYTES = 131072, SCRATCH_BYTES = 135168, MISC_OFF = SCRATCH_BYTES, UE_OFF = MISC_OFF + 64, TOK_OFF = UE_OFF + 320, TOK_UNITS = 11, LDS_BYTES = 147456;
static_assert(FFT_ELEMS * 8 <= SCRATCH_BYTES && TOK_OFF + TOK_UNITS * 1024 <= LDS_BYTES && ((NSLOT / 256 + 7) / 8 + 3) / 4 <= TOK_UNITS, "LDS map");
#define LAS __attribute__((address_space(3)))

__device__ __forceinline__ void transpose_item(const float* W, int K, int N, bf16_t* WT, int gu_perm, LAS float* scr, int item, int lane) {
    const int nblk = N / 32, kb = item / nblk, nb = item % nblk, k0 = 64 * kb, n0 = 32 * nb;
    const int r0 = gu_perm ? (n0 < DFF ? (n0 / 128) * 256 + (n0 % 128) : ((n0 - DFF) / 128) * 256 + 128 + ((n0 - DFF) % 128)) : n0;
#pragma unroll 8
    for (int i = 0; i < 32; ++i) { const int kk = 2 * i + (lane >> 5); scr[kk * 33 + (lane & 31)] = W[(size_t)(k0 + kk) * N + n0 + (lane & 31)]; }
    asm volatile("s_waitcnt lgkmcnt(0)" ::: "memory");
    const int c = lane & 7;
#pragma unroll
    for (int j = 0; j < 4; ++j) { const int n = (lane >> 3) + 8 * j; const LAS float* s = scr + (8 * c) * 33 + n;
        uint4 o; o.x = f2bf(s[0 * 33]) | ((unsigned)f2bf(s[1 * 33]) << 16); o.y = f2bf(s[2 * 33]) | ((unsigned)f2bf(s[3 * 33]) << 16);
        o.z = f2bf(s[4 * 33]) | ((unsigned)f2bf(s[5 * 33]) << 16); o.w = f2bf(s[6 * 33]) | ((unsigned)f2bf(s[7 * 33]) << 16);
        *(uint4*)(WT + (size_t)(r0 + n) * K + k0 + 8 * c) = o; }
    asm volatile("s_waitcnt lgkmcnt(0)" ::: "memory");
}
constexpr int I_GU = (D / 64) * (2 * DFF / 32), I_DN = (DFF / 64) * (D / 32), EXP_ITEMS = NE * (I_GU + I_DN);
__device__ __forceinline__ void convert_expert_item(const P& p, int l, int q, LAS float* scr, int lane) {
    if (q < NE * I_GU) { const int e = q / I_GU; const size_t i = (size_t)l * NE + e; transpose_item(p.w_gu + i * D * 2 * DFF, D, 2 * DFF, p.wgu_t + i * 2 * DFF * D, 1, scr, q % I_GU, lane); }
    else { const int q2 = q - NE * I_GU, e = q2 / I_DN; const size_t i = (size_t)l * NE + e; transpose_item(p.w_dn + i * DFF * D, DFF, D, p.wdn_t + i * D * DFF, 0, scr, q2 % I_DN, lane); }
}
constexpr int DEFER_Q1 = 64, DEFER_Q2 = 140;
__device__ __forceinline__ int defer_idle(int units, int G) { const int rem = units % G; return rem ? G - rem : 0; }
__device__ __forceinline__ int defer_in_units(int layer) { return (NTOK / 256) * ((layer & 1) ? CD_IN / 256 : AB_IN / 256); }
__device__ __forceinline__ int defer_d1(int layer, int G) { const int n = defer_idle(defer_in_units(layer), G) * DEFER_Q1; return n < EXP_ITEMS ? n : EXP_ITEMS; }
__device__ __forceinline__ int defer_d2(int layer, int G) { const int d1 = defer_d1(layer, G), n = d1 + defer_idle((NTOK / 256) * (D / 256), G) * DEFER_Q2; return n < EXP_ITEMS ? n : EXP_ITEMS; }
__device__ __forceinline__ void convert_deferred(const P& p, LAS unsigned char* lds, int layer, int which) {
    int tid = threadIdx.x; asm volatile("" : "+v"(tid));
    int bx_ = (int)blockIdx.x, gx_ = (int)gridDim.x; asm volatile("" : "+s"(bx_), "+s"(gx_));
    const int units = which ? (NTOK / 256) * (D / 256) : defer_in_units(layer), rem = units % gx_;
    if (rem == 0 || bx_ < rem) return;
    const int lane = tid & 63, wave = tid >> 6; LAS float* scr = (LAS float*)(lds + wave * 16384);
    const int qn = which ? DEFER_Q2 : DEFER_Q1, q0 = (which ? defer_d1(layer, gx_) : 0) + (bx_ - rem) * qn, qend = which ? defer_d2(layer, gx_) : defer_d1(layer, gx_);
    for (int q = q0 + wave; q < q0 + qn && q < qend; q += 8) convert_expert_item(p, layer + 1, q, scr, lane);
}
__device__ __forceinline__ void ph_convert_weights(const P& p, LAS unsigned char* lds) {
    int tid = threadIdx.x; asm volatile("" : "+v"(tid));
    const int lane = tid & 63, wave = tid >> 6;
    LAS float* scr = (LAS float*)(lds + wave * 16384);
    const long gw = (long)blockIdx.x * 8 + wave, NGW = (long)gridDim.x * 8; const int G = (int)gridDim.x;
    constexpr long I_ABIN = (D / 64) * (AB_IN / 32), I_CDIN = (D / 64) * (CD_IN / 32), I_OUT = (D / 64) * (D / 32), I_GLU = (S5W / 64) * (S5W / 32);
    constexpr long T0 = 2 * I_ABIN, T1 = T0 + 2 * I_CDIN, T2 = T1 + 2 * I_OUT, T3 = T2 + 2 * I_OUT, T4 = T3 + 2 * I_GLU;
    for (long it = gw; it < T4; it += NGW) {
        if (it < T0) { const int i = (int)(it / I_ABIN); transpose_item(p.ab_w_in + (size_t)i * D * AB_IN, D, AB_IN, p.abin_t + (size_t)i * AB_IN * D, 0, scr, (int)(it % I_ABIN), lane); }
        else if (it < T1) { const long r = it - T0; const int i = (int)(r / I_CDIN); transpose_item(p.cd_w_in + (size_t)i * D * CD_IN, D, CD_IN, p.cdin_t + (size_t)i * CD_IN * D, 0, scr, (int)(r % I_CDIN), lane); }
        else if (it < T2) { const long r = it - T1; const int i = (int)(r / I_OUT); transpose_item(p.ab_w_out + (size_t)i * D * D, D, D, p.about_t + (size_t)i * D * D, 0, scr, (int)(r % I_OUT), lane); }
        else if (it < T3) { const long r = it - T2; const int i = (int)(r / I_OUT); transpose_item(p.cd_w_out + (size_t)i * D * D, D, D, p.cdout_t + (size_t)i * D * D, 0, scr, (int)(r % I_OUT), lane); }
        else { const long r = it - T3; const int i = (int)(r / I_GLU); transpose_item(p.s5_glu_w + (size_t)i * S5W * S5W, S5W, S5W, p.glu_t + (size_t)i * S5W * S5W, 0, scr, (int)(r % I_GLU), lane); }
    }
    for (int l = 0; l < 4; ++l) { const int qs = l ? defer_d2(l - 1, G) : 0;
        for (long q = qs + gw; q < EXP_ITEMS; q += NGW) convert_expert_item(p, l, (int)q, scr, lane); }
}
constexpr int NTHREADS = 512;
__device__ __forceinline__ float wave_sum(float v) {
#pragma unroll
    for (int o = 1; o < 64; o <<= 1) v += __shfl_xor(v, o);
    return v;
}
template <int CTRL> __device__ __forceinline__ float dppf(float v) { return __builtin_bit_cast(float, __builtin_amdgcn_update_dpp(0, __builtin_bit_cast(int, v), CTRL, 0xf, 0xf, false)); }
template <int CTRL> __device__ __forceinline__ int dppi(int v) { return __builtin_amdgcn_update_dpp(0, v, CTRL, 0xf, 0xf, false); }
__device__ __forceinline__ float row16_max(float x) { x = fmaxf(x, dppf<0xB1>(x)); x = fmaxf(x, dppf<0x4E>(x)); x = fmaxf(x, dppf<0x141>(x)); x = fmaxf(x, dppf<0x140>(x)); return x; }
__device__ __forceinline__ float row16_sum(float x) { x += dppf<0xB1>(x); x += dppf<0x4E>(x); x += dppf<0x141>(x); x += dppf<0x140>(x); return x; }
__device__ __forceinline__ int row16_min(int x) { x = min(x, dppi<0xB1>(x)); x = min(x, dppi<0x4E>(x)); x = min(x, dppi<0x141>(x)); x = min(x, dppi<0x140>(x)); return x; }
template <int L> __device__ __forceinline__ float rowb(float v) { return __builtin_bit_cast(float, __builtin_amdgcn_update_dpp(0, __builtin_bit_cast(int, v), 0x150 + L, 0xf, 0xf, false)); }
template <int L> __device__ __forceinline__ void route_steps(float val, const LAS float* wq, float& a0, float& a1) {
    const float xb = rowb<L>(val); const pg8::f32x2v w = *(const LAS pg8::f32x2v*)(wq + (4 * L) * 32);
    a0 += xb * w.x; a1 += xb * w.y;
    if constexpr (L + 1 < 16) route_steps<L + 1>(val, wq, a0, a1);
}
template <int MODE> __device__ __forceinline__ void mf_rownorm(const P& p, LAS unsigned char* lds, int layer, int nrows, int comb_layer) {
    constexpr bool ROUTE = MODE == 1; constexpr int which = MODE == 1 ? 1 : 0;
    int tid = threadIdx.x; asm volatile("" : "+v"(tid));
    int bx_ = (int)blockIdx.x, gx_ = (int)gridDim.x; asm volatile("" : "+s"(bx_), "+s"(gx_));
    const int lane = tid & 63, wave = tid >> 6;
    if (ROUTE) { for (int j = bx_ * NTHREADS + tid; j < NSLOT; j += gx_ * NTHREADS) { p.slot_tok[j] = -1; p.slot_gate[j] = 0.f; } }
    const float* gn = MODE == 2 ? p.final_g : (which ? p.norm2_g : p.norm1_g) + layer * D;
    LAS float* Wl = (LAS float*)lds;
    if (ROUTE) { const float* rw = p.router_w + (size_t)layer * D * NE;
        for (int i = tid; i < D * NE / 4; i += NTHREADS) { const float4 w4 = *(const float4*)(rw + 4 * i); const int k = i >> 3, e0 = (i & 7) * 4, kp = k ^ ((k >> 6) & 1);
            const float wv[4] = {w4.x, w4.y, w4.z, w4.w};
#pragma unroll
            for (int t = 0; t < 4; ++t) { const int e = e0 + t; Wl[kp * 32 + 2 * (e & 15) + (e >> 4)] = wv[t]; } }
        __syncthreads(); }
    volatile LAS int* lcnt = (volatile LAS int*)(lds + RING_BYTES);
    volatile LAS int* lbase = lcnt + NE; volatile LAS int* lrank = lcnt + 2 * NE;
    if (ROUTE) { if (tid < NE) lcnt[tid] = 0; __syncthreads(); }
    for (int r = bx_ * 8 + wave; r < nrows; r += gx_ * 8) {
        const int m = r < SEQ ? 0 : (r < NLAT ? 1 : 2);
        const float* mv = p.modv + ((size_t)layer * 3 + m) * 6 * D + which * 3 * D;
        float* xr = p.xa + (size_t)r * D;
        float4 v[4]; float ss = 0.f;
#pragma unroll
        for (int j = 0; j < 4; ++j) v[j] = *(const float4*)(xr + 256 * j + 4 * lane);
        if (comb_layer >= 0) {
            const float* g2 = p.modv + ((size_t)comb_layer * 3 + m) * 6 * D + 5 * D;
            const int4 so = *(const int4*)(p.slot_of + r * 4);
            const bf16_t* y0 = p.yb + (size_t)so.x * D; const bf16_t* y1 = p.yb + (size_t)so.y * D; const bf16_t* y2 = p.yb + (size_t)so.z * D; const bf16_t* y3 = p.yb + (size_t)so.w * D;
#pragma unroll
            for (int j = 0; j < 4; ++j) { const int k = 256 * j + 4 * lane; const ushort4 a = *(const ushort4*)(y0 + k), b = *(const ushort4*)(y1 + k), c = *(const ushort4*)(y2 + k), d = *(const ushort4*)(y3 + k); const float4 gg = *(const float4*)(g2 + k);
                v[j].x += gg.x * (bf2f(a.x) + bf2f(b.x) + bf2f(c.x) + bf2f(d.x)); v[j].y += gg.y * (bf2f(a.y) + bf2f(b.y) + bf2f(c.y) + bf2f(d.y));
                v[j].z += gg.z * (bf2f(a.z) + bf2f(b.z) + bf2f(c.z) + bf2f(d.z)); v[j].w += gg.w * (bf2f(a.w) + bf2f(b.w) + bf2f(c.w) + bf2f(d.w));
                if (MODE != 2) *(float4*)(xr + k) = v[j]; }
        }
#pragma unroll
        for (int j = 0; j < 4; ++j) ss += v[j].x * v[j].x + v[j].y * v[j].y + v[j].z * v[j].z + v[j].w * v[j].w;
        const float rstd = rsqrtf(wave_sum(ss) * (1.0f / D) + EPS);
        if (MODE == 2) {
#pragma unroll
            for (int j = 0; j < 4; ++j) { const int k = 256 * j + 4 * lane; const float4 g4 = *(const float4*)(gn + k);
                float4 o; o.x = v[j].x * rstd * g4.x; o.y = v[j].y * rstd * g4.y; o.z = v[j].z * rstd * g4.z; o.w = v[j].w * rstd * g4.w;
                *(float4*)(p.out + (size_t)r * D + k) = o; }
            continue;
        }
#pragma unroll
        for (int j = 0; j < 4; ++j) { const int k = 256 * j + 4 * lane; const float4 g4 = *(const float4*)(gn + k), sc = *(const float4*)(mv + D + k), sh = *(const float4*)(mv + k);
            v[j].x = v[j].x * rstd * g4.x * (1.0f + sc.x) + sh.x; v[j].y = v[j].y * rstd * g4.y * (1.0f + sc.y) + sh.y;
            v[j].z = v[j].z * rstd * g4.z * (1.0f + sc.z) + sh.z; v[j].w = v[j].w * rstd * g4.w * (1.0f + sc.w) + sh.w;
            ushort4 o; o.x = f2bf(v[j].x); o.y = f2bf(v[j].y); o.z = f2bf(v[j].z); o.w = f2bf(v[j].w);
            *(ushort4*)(p.hxb + (size_t)r * D + k) = o; }
        if (ROUTE) {
            const int cl = lane & 15, Rr = lane >> 4, r1 = Rr & 1;
            const LAS float* wbE = Wl + (64 * Rr) * 32 + 2 * cl + r1 * 32;
            const LAS float* wbO = Wl + (64 * Rr) * 32 + 2 * cl - r1 * 32;
            float acc0 = 0.f, acc1 = 0.f;
#pragma unroll
            for (int j = 0; j < 4; ++j) { const float vq[4] = {v[j].x, v[j].y, v[j].z, v[j].w};
#pragma unroll
                for (int q = 0; q < 4; ++q) { route_steps<0>(vq[q], ((q & 1) ? wbO : wbE) + (256 * j + q) * 32, acc0, acc1); __builtin_amdgcn_sched_barrier(0); } }
            acc0 += __shfl_xor(acc0, 16); acc0 += __shfl_xor(acc0, 32); acc1 += __shfl_xor(acc1, 16); acc1 += __shfl_xor(acc1, 32);
            acc0 += p.router_b[layer * NE + cl]; acc1 += p.router_b[layer * NE + 16 + cl];
            int ti[4]; float tv[4];
#pragma unroll
            for (int s = 0; s < 4; ++s) {
                const float vmax = row16_max(fmaxf(acc0, acc1));
                const int cand = acc0 == vmax ? cl : (acc1 == vmax ? cl + 16 : 64), best = row16_min(cand);
                ti[s] = best; tv[s] = vmax;
                if (best == cl) acc0 = -3.0e38f; if (best == cl + 16) acc1 = -3.0e38f;
            }
            if (lane == 0) {
                const float e1 = expf(tv[1] - tv[0]), e2 = expf(tv[2] - tv[0]), e3 = expf(tv[3] - tv[0]), inv = 1.0f / (1.0f + e1 + e2 + e3);
                p.topi[r * 4 + 0] = ti[0]; p.topi[r * 4 + 1] = ti[1]; p.topi[r * 4 + 2] = ti[2]; p.topi[r * 4 + 3] = ti[3];
                p.topg[r * 4 + 0] = inv; p.topg[r * 4 + 1] = e1 * inv; p.topg[r * 4 + 2] = e2 * inv; p.topg[r * 4 + 3] = e3 * inv;
                const int li = ((r - (bx_ * 8 + wave)) / (gx_ * 8)) * 8 + wave;
#pragma unroll
                for (int s = 0; s < 4; ++s) lrank[li * 4 + s] = __hip_atomic_fetch_add((LAS int*)(lcnt + ti[s]), 1, __ATOMIC_RELAXED, __HIP_MEMORY_SCOPE_WORKGROUP);
            }
        }
    }
    if (ROUTE) {
        __syncthreads();
        if (tid < NE) lbase[tid] = atomicAdd(p.cnt + layer * NE + tid, lcnt[tid]);
        __syncthreads();
        const int nmine = (nrows - bx_ * 8 + gx_ * 8 - 1) / (gx_ * 8) * 8;
        for (int i = tid; i < nmine * 4; i += NTHREADS) { const int li = i >> 2, r = bx_ * 8 + (li & 7) + (li >> 3) * gx_ * 8;
            if (r < nrows) p.pos[r * 4 + (i & 3)] = lbase[p.topi[i - li * 4 + r * 4]] + lrank[i]; }
    }
}
__device__ __forceinline__ float4 ld4px(const float* q) { return *(const float4*)q; }
__device__ __forceinline__ float4 ld4px(const bf16_t* q) { const ushort4 v = *(const ushort4*)q; return make_float4(bf2f(v.x), bf2f(v.y), bf2f(v.z), bf2f(v.w)); }
typedef unsigned short us4v __attribute__((ext_vector_type(4)));
__device__ __forceinline__ us4v pack4(float4 v) { return (us4v){f2bf(v.x), f2bf(v.y), f2bf(v.z), f2bf(v.w)}; }
template <int K> __device__ __forceinline__ pg8::f32x4 mma16(const LAS bf16_t* A, int lda, const LAS bf16_t* Bt, int ldb, pg8::f32x4 acc, int lane) {
    const int r = lane & 15, q = lane >> 4;
    const LAS bf16_t* ap = A + r * lda + 8 * q; const LAS bf16_t* bp = Bt + r * ldb + 8 * q;
#pragma unroll
    for (int k0 = 0; k0 < K; k0 += 32) acc = __builtin_amdgcn_mfma_f32_16x16x32_bf16(*(const LAS pg8::bf16x8*)(ap + k0), *(const LAS pg8::bf16x8*)(bp + k0), acc, 0, 0, 0);
    return acc;
}
constexpr int RLD = 136, RLQ = 72;
__device__ __forceinline__ void mf_retkv(const P& p, LAS unsigned char* lds, int il) {
    int tid = threadIdx.x; asm volatile("" : "+v"(tid));
    int bx_ = (int)blockIdx.x, gx_ = (int)gridDim.x; asm volatile("" : "+s"(bx_), "+s"(gx_));
    const int lane = tid & 63, wave = tid >> 6, r = lane & 15, q = lane >> 4;
    LAS bf16_t* KdT = (LAS bf16_t*)lds; LAS bf16_t* VT = KdT + 64 * RLD;
    for (int u = bx_; u < 16 * RNCH; u += gx_) {
        const int n = u % RNCH, h = (u / RNCH) & 3, b = (u / (RNCH * 4)) & 1, dir = u / (RNCH * 8);
        const float lg = ret_logg(p, il, dir, h);
        __syncthreads();
        for (int idx = tid; idx < 128 * 16; idx += NTHREADS) { const int j = idx >> 4, d4 = idx & 15, row = scan_row(dir, b, n * RC + j);
            const float4 kv = *(const float4*)(p.kr + (size_t)row * 256 + h * 64 + 4 * d4); const float dk = fexp((float)(RC - 1 - j) * lg);
            KdT[(4 * d4 + 0) * RLD + j] = f2bf(kv.x * dk); KdT[(4 * d4 + 1) * RLD + j] = f2bf(kv.y * dk); KdT[(4 * d4 + 2) * RLD + j] = f2bf(kv.z * dk); KdT[(4 * d4 + 3) * RLD + j] = f2bf(kv.w * dk); }
        for (int idx = tid; idx < 128 * 32; idx += NTHREADS) { const int j = idx >> 5, e4 = idx & 31, row = scan_row(dir, b, n * RC + j);
            const float4 vv = ld4px(p.px + (size_t)row * PXLD + 512 + h * 128 + 4 * e4);
            VT[(4 * e4 + 0) * RLD + j] = f2bf(vv.x); VT[(4 * e4 + 1) * RLD + j] = f2bf(vv.y); VT[(4 * e4 + 2) * RLD + j] = f2bf(vv.z); VT[(4 * e4 + 3) * RLD + j] = f2bf(vv.w); }
        __syncthreads();
        float* o = p.rkv + ((((size_t)dir * 2 + b) * RNCH + n) * 4 + h) * 8192;
#pragma unroll
        for (int td = 0; td < 4; ++td) { pg8::f32x4 acc = {0.f, 0.f, 0.f, 0.f};
            acc = mma16<128>(VT + (16 * wave) * RLD, RLD, KdT + (16 * td) * RLD, RLD, acc, lane);
#pragma unroll
            for (int g = 0; g < 4; ++g) o[(size_t)(16 * wave + 4 * q + g) * 64 + 16 * td + r] = acc[g]; }
    }
}
__device__ __forceinline__ void mf_reto(const P& p, LAS unsigned char* lds, int il) {
    int tid = threadIdx.x; asm volatile("" : "+v"(tid));
    int bx_ = (int)blockIdx.x, gx_ = (int)gridDim.x; asm volatile("" : "+s"(bx_), "+s"(gx_));
    const int lane = tid & 63, wave = tid >> 6, r = lane & 15, q = lane >> 4;
    LAS bf16_t* Qs = (LAS bf16_t*)lds; LAS bf16_t* Ks = Qs + 128 * RLQ; LAS bf16_t* ST = Ks + 128 * RLQ; LAS bf16_t* VT = ST + 128 * RLQ; LAS bf16_t* Ps = VT + 128 * RLD;
    for (int u = bx_; u < 16 * RNCH; u += gx_) {
        const int n = u % RNCH, h = (u / RNCH) & 3, b = (u / (RNCH * 4)) & 1, dir = u / (RNCH * 8);
        const float lg = ret_logg(p, il, dir, h);
        const float* Sg = p.rkv + ((((size_t)dir * 2 + b) * RNCH + n) * 4 + h) * 8192;
        __syncthreads();
        for (int idx = tid; idx < 128 * 16; idx += NTHREADS) { const int j = idx >> 4, d4 = idx & 15, row = scan_row(dir, b, n * RC + j);
            const float4 qv = *(const float4*)(p.qr + (size_t)row * 256 + h * 64 + 4 * d4), kv = *(const float4*)(p.kr + (size_t)row * 256 + h * 64 + 4 * d4), sv = *(const float4*)(Sg + (size_t)j * 64 + 4 * d4);
            *(LAS us4v*)(Qs + j * RLQ + 4 * d4) = pack4(qv); *(LAS us4v*)(Ks + j * RLQ + 4 * d4) = pack4(kv); *(LAS us4v*)(ST + j * RLQ + 4 * d4) = pack4(sv); }
        for (int idx = tid; idx < 128 * 32; idx += NTHREADS) { const int j = idx >> 5, e4 = idx & 31, row = scan_row(dir, b, n * RC + j);
            const float4 vv = ld4px(p.px + (size_t)row * PXLD + 512 + h * 128 + 4 * e4);
            VT[(4 * e4 + 0) * RLD + j] = f2bf(vv.x); VT[(4 * e4 + 1) * RLD + j] = f2bf(vv.y); VT[(4 * e4 + 2) * RLD + j] = f2bf(vv.z); VT[(4 * e4 + 3) * RLD + j] = f2bf(vv.w); }
        __syncthreads();
#pragma unroll
        for (int tj = 0; tj < 8; ++tj) { pg8::f32x4 acc = {0.f, 0.f, 0.f, 0.f};
            acc = mma16<64>(Qs + (16 * wave) * RLQ, RLQ, Ks + (16 * tj) * RLQ, RLQ, acc, lane);
            const int j = 16 * tj + r;
#pragma unroll
            for (int g = 0; g < 4; ++g) { const int i = 16 * wave + 4 * q + g; Ps[i * RLD + j] = f2bf(j <= i ? acc[g] * fexp((float)(i - j) * lg) : 0.f); } }
        __syncthreads();
        float dq[4];
#pragma unroll
        for (int g = 0; g < 4; ++g) dq[g] = fexp((float)(16 * wave + 4 * q + g + 1) * lg);
#pragma unroll
        for (int te = 0; te < 8; ++te) { pg8::f32x4 acc = {0.f, 0.f, 0.f, 0.f}, cr = {0.f, 0.f, 0.f, 0.f};
            acc = mma16<128>(Ps + (16 * wave) * RLD, RLD, VT + (16 * te) * RLD, RLD, acc, lane);
            cr = mma16<64>(Qs + (16 * wave) * RLQ, RLQ, ST + (16 * te) * RLQ, RLQ, cr, lane);
#pragma unroll
            for (int g = 0; g < 4; ++g) { const int i = 16 * wave + 4 * q + g, row = scan_row(dir, b, n * RC + i);
                p.oret[((size_t)dir * NTOK + row) * 512 + h * 128 + 16 * te + r] = acc[g] + dq[g] * cr[g]; } }
    }
}
template <bool FILL> __device__ __forceinline__ void mf_s5(const P& p, LAS unsigned char* lds, int il) {
    int tid = threadIdx.x; asm volatile("" : "+v"(tid));
    int bx_ = (int)blockIdx.x, gx_ = (int)gridDim.x; asm volatile("" : "+s"(bx_), "+s"(gx_));
    const int lane = tid & 63, wave = tid >> 6, r = lane & 15, q = lane >> 4;
    constexpr int LDU = 40, LDS_ = 132, LDB = 136;
    LAS bf16_t* Bt = (LAS bf16_t*)lds;
    LAS bf16_t* Ct = Bt + 128 * LDU;
    LAS unsigned char* wb = lds + 16384 + wave * 14336;
    LAS bf16_t* U = (LAS bf16_t*)wb;
    LAS float* SL = (LAS float*)(wb + 1280);
    LAS bf16_t* Sb = (LAS bf16_t*)(wb + 1280 + 8448);
    constexpr int GRP = (2 * S5NCH) / 8;
    static_assert((2 * S5NCH) % 8 == 0, "chunk count");
    for (int bu = bx_; bu < 64 * GRP; bu += gx_) {
        const int dg = bu / GRP, grp = bu % GRP, dir = dg >> 5, g = dg & 31;
        __syncthreads();
        if (tid < 64) { S5Par sp; s5_par(p, il, dir, g, tid, sp);
#pragma unroll
            for (int h = 0; h < 16; ++h) { Bt[(2 * tid) * LDU + h] = f2bf(sp.bbr[h]); Bt[(2 * tid + 1) * LDU + h] = f2bf(sp.bbi[h]); Bt[(2 * tid) * LDU + 16 + h] = 0; Bt[(2 * tid + 1) * LDU + 16 + h] = 0;
                const long ci = (((long)(il * 2 + dir) * NG + g) * GH + h) * NP + tid; Ct[h * LDB + 2 * tid] = f2bf(p.s5_cre[ci]); Ct[h * LDB + 2 * tid + 1] = f2bf(-p.s5_cim[ci]); } }
        float lbr, lbi; { const int gi = (il * 2 + dir) * NG + g; const float lre = fminf(p.s5_lre[gi * NP + lane], -1e-4f), lim = p.s5_lim[gi * NP + lane], dt = expf(p.s5_ldt[gi]);
            const float mag = expf(lre * dt); lbr = mag * cosf(lim * dt); lbi = mag * sinf(lim * dt); }
        __syncthreads();
        const int bc = grp * 8 + wave, b = bc / S5NCH, ch = bc % S5NCH;
        float* ce = p.s5c + ((((size_t)dir * 2 + b) * S5NCH + ch) * NG + g) * NP * 2 + lane * 2;
        float sr = 0.f, si = 0.f;
        if (FILL) { sr = ce[0]; si = ce[1]; }
        float4 uvs[S5C / 16];
#pragma unroll
        for (int sb = 0; sb < S5C / 16; ++sb) { const int k = lane >> 2, h4 = (lane & 3) * 4, row = scan_row(dir, b, ch * S5C + sb * 16 + k);
            uvs[sb] = ld4px(p.px + (size_t)row * PXLD + 1536 + g * GH + h4); }
#pragma unroll
        for (int sb = 0; sb < S5C / 16; ++sb) {
            { const int k = lane >> 2, h4 = (lane & 3) * 4;
              *(LAS us4v*)(U + k * LDU + h4) = pack4(uvs[sb]); *(LAS us4v*)(U + k * LDU + 16 + h4) = (us4v){0, 0, 0, 0}; }
            asm volatile("s_waitcnt lgkmcnt(0)" ::: "memory");
#pragma unroll
            for (int tc = 0; tc < 8; ++tc) { pg8::f32x4 acc = {0.f, 0.f, 0.f, 0.f};
                acc = mma16<32>(U, LDU, Bt + (16 * tc) * LDU, LDU, acc, lane);
#pragma unroll
                for (int gq = 0; gq < 4; ++gq) SL[(4 * q + gq) * LDS_ + 16 * tc + r] = acc[gq]; }
            asm volatile("s_waitcnt lgkmcnt(0)" ::: "memory");
#pragma unroll
            for (int k = 0; k < 16; ++k) { const float br = SL[k * LDS_ + 2 * lane], bi = SL[k * LDS_ + 2 * lane + 1];
                const float tr = lbr * sr - lbi * si + br, ti = lbr * si + lbi * sr + bi; sr = tr; si = ti;
                if (FILL) { Sb[k * LDB + 2 * lane] = f2bf(sr); Sb[k * LDB + 2 * lane + 1] = f2bf(si); } }
            if (FILL) {
                asm volatile("s_waitcnt lgkmcnt(0)" ::: "memory");
                pg8::f32x4 acc = {0.f, 0.f, 0.f, 0.f};
                acc = mma16<128>(Sb, LDB, Ct, LDB, acc, lane);
#pragma unroll
                for (int gq = 0; gq < 4; ++gq) { const int row = scan_row(dir, b, ch * S5C + sb * 16 + 4 * q + gq); p.yd[((size_t)dir * NTOK + row) * S5W + g * GH + r] = acc[gq]; }
            }
            asm volatile("s_waitcnt lgkmcnt(0)" ::: "memory");
        }
        if (!FILL) { ce[0] = sr; ce[1] = si; }
    }
}
__device__ __forceinline__ void mf_swa(const P& p, LAS unsigned char* lds, int il, bool with_ctx) {
    int tid = threadIdx.x; asm volatile("" : "+v"(tid));
    int bx_ = (int)blockIdx.x, gx_ = (int)gridDim.x; asm volatile("" : "+s"(bx_), "+s"(gx_));
    const int lane = tid & 63, wave = tid >> 6, r = lane & 15, q = lane >> 4;
    constexpr int LDK = 72;
    LAS bf16_t* Ks = (LAS bf16_t*)lds;
    LAS bf16_t* VT = Ks + 64 * LDK;
    LAS bf16_t* Pw = VT + 64 * LDK + wave * 64 * LDK;
    constexpr int NQB = SEQ / 128, NLATU = 4 * NQB, NCTXU = 4 * (CTXL / 128);
    const int nunits = NLATU + (with_ctx ? NCTXU : 0);
    for (int u = bx_; u < nunits; u += gx_) {
        int b, kv, qb, isctx;
        if (u < NLATU) { isctx = 0; qb = u % NQB; kv = (u / NQB) & 1; b = u / (NQB * 2); }
        else { const int v = u - NLATU; isctx = 1; qb = v % (CTXL / 128); kv = (v / (CTXL / 128)) & 1; b = v / ((CTXL / 128) * 2); }
        const int g = wave >> 1, hq = kv * 4 + g, i0 = (wave & 1) * 64;
        const int qrow0 = (isctx ? NLAT + b * CTXL : b * SEQ) + qb * 128 + i0;
        pg8::bf16x8 qf[4][2];
#pragma unroll
        for (int tq = 0; tq < 4; ++tq)
#pragma unroll
            for (int ks = 0; ks < 2; ++ks) { const float* src = p.qs + (size_t)(qrow0 + 16 * tq + r) * 512 + hq * 64 + 32 * ks + 8 * q;
                const float4 a = *(const float4*)src, c = *(const float4*)(src + 4);
                qf[tq][ks] = (pg8::bf16x8){(short)f2bf(a.x), (short)f2bf(a.y), (short)f2bf(a.z), (short)f2bf(a.w), (short)f2bf(c.x), (short)f2bf(c.y), (short)f2bf(c.z), (short)f2bf(c.w)}; }
        pg8::f32x4 oacc[4][4];
        float mrow[4][4], lrow[4][4];
        const float sink = p.swa_sink[il * 8 + hq];
#pragma unroll
        for (int tq = 0; tq < 4; ++tq)
#pragma unroll
            for (int x = 0; x < 4; ++x) { oacc[tq][x] = (pg8::f32x4){0.f, 0.f, 0.f, 0.f}; mrow[tq][x] = sink; lrow[tq][x] = 1.0f; }
        const int ntile = isctx ? 4 : 10;
        for (int t = 0; t < ntile; ++t) {
            const bool loc = !isctx && t < 6;
            const int kpos0 = loc ? 128 * (qb - 1) + 64 * t : 0;
            if (loc && (kpos0 < 0 || kpos0 >= SEQ)) continue;
            const int krow0 = loc ? b * SEQ + kpos0 : NLAT + b * CTXL + 64 * (isctx ? t : t - 6);
            __syncthreads();
            for (int idx = tid; idx < 64 * 16; idx += NTHREADS) { const int key = idx >> 4, d4 = idx & 15;
                const float4 kk = *(const float4*)(p.ks + (size_t)(krow0 + key) * 128 + kv * 64 + 4 * d4), vv = ld4px(p.px + (size_t)(krow0 + key) * PXLD + 2176 + kv * 64 + 4 * d4);
                *(LAS us4v*)(Ks + key * LDK + 4 * d4) = pack4(kk);
                VT[(4 * d4 + 0) * LDK + key] = f2bf(vv.x); VT[(4 * d4 + 1) * LDK + key] = f2bf(vv.y); VT[(4 * d4 + 2) * LDK + key] = f2bf(vv.z); VT[(4 * d4 + 3) * LDK + key] = f2bf(vv.w); }
            __syncthreads();
            pg8::f32x4 sc[4][4];
#pragma unroll
            for (int tk = 0; tk < 4; ++tk) { const LAS bf16_t* kp = Ks + (16 * tk + r) * LDK + 8 * q;
                const pg8::bf16x8 k0 = *(const LAS pg8::bf16x8*)kp, k1 = *(const LAS pg8::bf16x8*)(kp + 32);
#pragma unroll
                for (int tq = 0; tq < 4; ++tq) { pg8::f32x4 a = {0.f, 0.f, 0.f, 0.f};
                    a = __builtin_amdgcn_mfma_f32_16x16x32_bf16(qf[tq][0], k0, a, 0, 0, 0); a = __builtin_amdgcn_mfma_f32_16x16x32_bf16(qf[tq][1], k1, a, 0, 0, 0); sc[tq][tk] = a; } }
            if (loc) {
#pragma unroll
                for (int tq = 0; tq < 4; ++tq)
#pragma unroll
                    for (int tk = 0; tk < 4; ++tk)
#pragma unroll
                        for (int x = 0; x < 4; ++x) { const int dlt = (kpos0 + 16 * tk + r) - (128 * qb + i0 + 16 * tq + 4 * q + x); if (dlt > 128 || dlt < -128) sc[tq][tk][x] = -1e30f; }
            }
#pragma unroll
            for (int tq = 0; tq < 4; ++tq)
#pragma unroll
                for (int x = 0; x < 4; ++x) {
                    float mx = fmaxf(fmaxf(sc[tq][0][x], sc[tq][1][x]), fmaxf(sc[tq][2][x], sc[tq][3][x]));
                    mx = row16_max(mx);
                    const float mn = fmaxf(mrow[tq][x], mx), corr = __expf(mrow[tq][x] - mn);
                    float sum = 0.f;
#pragma unroll
                    for (int tk = 0; tk < 4; ++tk) { const float pe = __expf(sc[tq][tk][x] - mn); sum += pe; Pw[(16 * tq + 4 * q + x) * LDK + 16 * tk + r] = f2bf(pe); }
                    sum = row16_sum(sum);
                    lrow[tq][x] = lrow[tq][x] * corr + sum; mrow[tq][x] = mn;
#pragma unroll
                    for (int td = 0; td < 4; ++td) oacc[tq][td][x] *= corr;
                }
            asm volatile("s_waitcnt lgkmcnt(0)" ::: "memory");
#pragma unroll
            for (int td = 0; td < 4; ++td) { const LAS bf16_t* vp = VT + (16 * td + r) * LDK + 8 * q;
                const pg8::bf16x8 v0 = *(const LAS pg8::bf16x8*)vp, v1 = *(const LAS pg8::bf16x8*)(vp + 32);
#pragma unroll
                for (int tq = 0; tq < 4; ++tq) { const LAS bf16_t* pp = Pw + (16 * tq + r) * LDK + 8 * q;
                    oacc[tq][td] = __builtin_amdgcn_mfma_f32_16x16x32_bf16(*(const LAS pg8::bf16x8*)pp, v0, oacc[tq][td], 0, 0, 0);
                    oacc[tq][td] = __builtin_amdgcn_mfma_f32_16x16x32_bf16(*(const LAS pg8::bf16x8*)(pp + 32), v1, oacc[tq][td], 0, 0, 0); } }
        }
#pragma unroll
        for (int tq = 0; tq < 4; ++tq)
#pragma unroll
            for (int x = 0; x < 4; ++x) { const float inv = 1.0f / lrow[tq][x]; bf16_t* o = p.mixb + (size_t)(qrow0 + 16 * tq + 4 * q + x) * D + 512 + hq * 64 + r;
#pragma unroll
                for (int td = 0; td < 4; ++td) o[16 * td] = f2bf(oacc[tq][td][x] * inv); }
    }
}
__device__ __forceinline__ void mf_sconv(const P& p, LAS unsigned char* lds, int il) {
    int tid = threadIdx.x; asm volatile("" : "+v"(tid));
    int bx_ = (int)blockIdx.x, gx_ = (int)gridDim.x; asm volatile("" : "+s"(bx_), "+s"(gx_));
    LAS float* T = (LAS float*)lds;
    const float* sw = p.hy_short_w + il * 3 * 1536; const float* sb = p.hy_short_b + il * 1536;
    constexpr int NT = (NTOK / 64) * (HYW / 64);
    for (int t = bx_; t < NT; t += gx_) {
        const int r0 = (t / (HYW / 64)) * 64, c0 = (t % (HYW / 64)) * 64;
        const int rl = tid >> 3, cs = (tid & 7) * 8, r = r0 + rl; const RowInfo ri = row_info(r);
        float u[3][8];
#pragma unroll
        for (int g = 0; g < 3; ++g) { const int col = g * HYW + c0 + cs; const float4 b0 = *(const float4*)(sb + col), b1 = *(const float4*)(sb + col + 4);
            u[g][0] = b0.x; u[g][1] = b0.y; u[g][2] = b0.z; u[g][3] = b0.w; u[g][4] = b1.x; u[g][5] = b1.y; u[g][6] = b1.z; u[g][7] = b1.w;
#pragma unroll
            for (int j = 0; j < 3; ++j) { const int tt = ri.t + j - 1; if (tt >= 0 && tt < ri.len) { const px_t* px = p.px + (size_t)(ri.base + tt) * PXLD + col; const float* wj = sw + j * 1536 + col;
                const float4 x0 = ld4px(px), x1 = ld4px(px + 4), w0 = *(const float4*)wj, w1 = *(const float4*)(wj + 4);
                u[g][0] += w0.x * x0.x; u[g][1] += w0.y * x0.y; u[g][2] += w0.z * x0.z; u[g][3] += w0.w * x0.w; u[g][4] += w1.x * x1.x; u[g][5] += w1.y * x1.y; u[g][6] += w1.z * x1.z; u[g][7] += w1.w * x1.w; } } }
        float z[8];
#pragma unroll
        for (int k = 0; k < 8; ++k) z[k] = u[2][k] * u[1][k];
        const size_t i = (size_t)r * HYW + c0 + cs;
        *(float4*)(p.x0c + i) = make_float4(u[0][0], u[0][1], u[0][2], u[0][3]); *(float4*)(p.x0c + i + 4) = make_float4(u[0][4], u[0][5], u[0][6], u[0][7]);
        *(float4*)(p.zb + i) = make_float4(z[0], z[1], z[2], z[3]); *(float4*)(p.zb + i + 4) = make_float4(z[4], z[5], z[6], z[7]);
        if (r0 < NLAT) {
            __syncthreads();
#pragma unroll
            for (int k = 0; k < 8; ++k) T[(cs + k) * 65 + rl] = z[k];
            __syncthreads();
            const int cl = tid >> 3, rs = (tid & 7) * 8; const LAS float* src = T + cl * 65 + rs; float* dst = p.zT + (size_t)(c0 + cl) * NLAT + r0 + rs;
            *(float4*)dst = make_float4(src[0], src[1], src[2], src[3]); *(float4*)(dst + 4) = make_float4(src[4], src[5], src[6], src[7]);
        }
    }
}
__device__ __forceinline__ void mf_filter_tiles(const P& p, LAS unsigned char* lds) {
    int tid = threadIdx.x; asm volatile("" : "+v"(tid));
    int bx_ = (int)blockIdx.x, gx_ = (int)gridDim.x; asm volatile("" : "+s"(bx_), "+s"(gx_));
    LAS float* A1 = (LAS float*)lds; LAS float* A2 = A1 + 64 * 65; LAS float* T = A2 + 64 * 65;
    constexpr int RT = (SEQ + CTXL) / 64;
    const int rl = tid >> 3, cs = (tid & 7) * 8;
    constexpr int NLT = 2 * (SEQ / 64), NCT = 2 * (CTXL / 64), NITEM = NLT + NCT * (HYW / 64);
    for (int it = bx_; it < NITEM; it += gx_) {
        int t, ct0, ct1;
        if (it < NLT) { t = (it / (SEQ / 64)) * RT + it % (SEQ / 64); ct0 = 0; ct1 = HYW / 64; }
        else { const int v = it - NLT, tc = v / (HYW / 64); t = (tc / (CTXL / 64)) * RT + SEQ / 64 + tc % (CTXL / 64); ct0 = v % (HYW / 64); ct1 = ct0 + 1; }
        const int i = t / RT, rt = t % RT, q0 = rt * 64, kind = q0 >= SEQ, L = kind ? CTXL : SEQ, q = q0 + rl, pos = kind ? q - SEQ : q;
        const long rr = (long)i * (SEQ + CTXL) + q;
        __syncthreads();
        {
            const float* w1 = p.hy_f_w1 + i * 33 * 64 + cs; const float tt = (float)pos / (float)L, w = 6.283185307179586f * (float)pos / (float)L;
            float acc[8];
#pragma unroll
            for (int k = 0; k < 8; ++k) acc[k] = tt * w1[k];
            for (int bi = 0; bi < 16; ++bi) { const float band = 1e-4f + (float)bi * ((15.0f - 1e-4f) / 15.0f), cc = ROPE_COS(band * w), sn = ROPE_SIN(band * w);
                const float* wc = w1 + (1 + bi) * 64; const float* ws = w1 + (17 + bi) * 64;
#pragma unroll
                for (int k = 0; k < 8; ++k) acc[k] += cc * wc[k] - sn * ws[k]; }
#pragma unroll
            for (int k = 0; k < 8; ++k) A1[rl * 65 + cs + k] = ROPE_SIN(acc[k] + p.hy_f_b1[i * 64 + cs + k]);
        }
        __syncthreads();
        {
            const float* w2 = p.hy_f_w2 + i * 64 * 64 + cs; float acc[8];
#pragma unroll
            for (int k = 0; k < 8; ++k) acc[k] = 0.f;
            for (int kk = 0; kk < 64; ++kk) { const float hv = A1[rl * 65 + kk]; const float4 a = *(const float4*)(w2 + kk * 64), b4 = *(const float4*)(w2 + kk * 64 + 4);
                acc[0] += hv * a.x; acc[1] += hv * a.y; acc[2] += hv * a.z; acc[3] += hv * a.w; acc[4] += hv * b4.x; acc[5] += hv * b4.y; acc[6] += hv * b4.z; acc[7] += hv * b4.w; }
#pragma unroll
            for (int k = 0; k < 8; ++k) A2[rl * 65 + cs + k] = ROPE_SIN(acc[k] + p.hy_f_b2[i * 64 + cs + k]);
        }
        __syncthreads();
        const float lag = fabsf((float)(pos - L / 2)) / (float)(L / 2);
        for (int ct = ct0; ct < ct1; ++ct) {
            const int c0 = ct * 64; const float* w3 = p.hy_f_w3 + (size_t)i * 64 * HYW + c0 + cs;
            float acc[8];
#pragma unroll
            for (int k = 0; k < 8; ++k) acc[k] = 0.f;
            for (int kk = 0; kk < 64; ++kk) { const float hv = A2[rl * 65 + kk]; const float4 a = *(const float4*)(w3 + (size_t)kk * HYW), b4 = *(const float4*)(w3 + (size_t)kk * HYW + 4);
                acc[0] += hv * a.x; acc[1] += hv * a.y; acc[2] += hv * a.z; acc[3] += hv * a.w; acc[4] += hv * b4.x; acc[5] += hv * b4.y; acc[6] += hv * b4.z; acc[7] += hv * b4.w; }
            const float fast = -15.350567286626973f, slow = -3.0701134573253946f;
#pragma unroll
            for (int k = 0; k < 8; ++k) { const float delta = fabsf(fast + (slow - fast) * (float)(c0 + cs + k) / 511.0f); acc[k] *= fexp(-lag * delta) + 0.05f; }
            float* o = p.hraw + rr * HYW + c0 + cs;
            *(float4*)o = make_float4(acc[0], acc[1], acc[2], acc[3]); *(float4*)(o + 4) = make_float4(acc[4], acc[5], acc[6], acc[7]);
            __syncthreads();
#pragma unroll
            for (int k = 0; k < 8; ++k) T[(cs + k) * 65 + rl] = acc[k];
            __syncthreads();
            const int cl = tid >> 3, rs = (tid & 7) * 8; const LAS float* src = T + cl * 65 + rs;
            float v8[8];
#pragma unroll
            for (int k = 0; k < 8; ++k) v8[k] = src[k];
            if (!kind) { float* dst = p.hT + ((size_t)i * HYW + c0 + cl) * SEQ + q0 + rs;
                *(float4*)dst = make_float4(v8[0], v8[1], v8[2], v8[3]); *(float4*)(dst + 4) = make_float4(v8[4], v8[5], v8[6], v8[7]); }
            float sa = 0.f;
#pragma unroll
            for (int k = 0; k < 8; ++k) sa += fabsf(v8[k]);
            sa += __shfl_xor(sa, 1); sa += __shfl_xor(sa, 2); sa += __shfl_xor(sa, 4);
            if ((tid & 7) == 0) p.hpart[(size_t)t * HYW + c0 + cl] = sa;
        }
    }
}
__device__ __forceinline__ void mf_hymix(const P& p, LAS unsigned char* lds, int il) {
    int tid = threadIdx.x; asm volatile("" : "+v"(tid));
    int bx_ = (int)blockIdx.x, gx_ = (int)gridDim.x; asm volatile("" : "+s"(bx_), "+s"(gx_));
    LAS float* T = (LAS float*)lds;
    constexpr int NT = (NLAT / 64) * (HYW / 64);
    for (int t = bx_; t < NT; t += gx_) {
        const int r0 = (t / (HYW / 64)) * 64, c0 = (t % (HYW / 64)) * 64;
        __syncthreads();
        { const int cl = tid >> 3, rs = (tid & 7) * 8; const float* src = p.convT + (size_t)(c0 + cl) * NLAT + r0 + rs; const float4 a = *(const float4*)src, b = *(const float4*)(src + 4);
          LAS float* d = T + cl * 65 + rs; d[0] = a.x; d[1] = a.y; d[2] = a.z; d[3] = a.w; d[4] = b.x; d[5] = b.y; d[6] = b.z; d[7] = b.w; }
        __syncthreads();
        { const int rl = tid >> 3, cs = (tid & 7) * 8; const size_t i = (size_t)(r0 + rl) * HYW + c0 + cs;
          const float4 z0 = *(const float4*)(p.zb + i), z1 = *(const float4*)(p.zb + i + 4), x0 = *(const float4*)(p.x0c + i), x1 = *(const float4*)(p.x0c + i + 4);
          const float4 b0 = *(const float4*)(p.hy_bias + il * HYW + c0 + cs), b1 = *(const float4*)(p.hy_bias + il * HYW + c0 + cs + 4);
          const float zz[8] = {z0.x, z0.y, z0.z, z0.w, z1.x, z1.y, z1.z, z1.w}, xx[8] = {x0.x, x0.y, x0.z, x0.w, x1.x, x1.y, x1.z, x1.w}, bb[8] = {b0.x, b0.y, b0.z, b0.w, b1.x, b1.y, b1.z, b1.w};
          unsigned short o[8];
#pragma unroll
          for (int k = 0; k < 8; ++k) o[k] = f2bf(xx[k] * (T[(cs + k) * 65 + rl] + bb[k] * zz[k]));
          uint4 ov; ov.x = o[0] | ((unsigned)o[1] << 16); ov.y = o[2] | ((unsigned)o[3] << 16); ov.z = o[4] | ((unsigned)o[5] << 16); ov.w = o[6] | ((unsigned)o[7] << 16);
          *(uint4*)(p.mixb + (size_t)(r0 + rl) * D + c0 + cs) = ov; }
    }
}
__device__ __forceinline__ void mf_retout(const P& p, int nrows) {
    int tid = threadIdx.x; asm volatile("" : "+v"(tid));
    int bx_ = (int)blockIdx.x, gx_ = (int)gridDim.x; asm volatile("" : "+s"(bx_), "+s"(gx_));
    const int lane = tid & 63, wave = tid >> 6;
    for (int r = bx_ * 8 + wave; r < nrows; r += gx_ * 8) {
        const float* o0 = p.oret + (size_t)r * 512 + 8 * lane; const float* o1 = p.oret + ((size_t)NTOK + r) * 512 + 8 * lane; const px_t* gp = p.px + (size_t)r * PXLD + 1024 + 8 * lane;
        const float4 a0 = *(const float4*)o0, a1 = *(const float4*)(o0 + 4), b0 = *(const float4*)o1, b1 = *(const float4*)(o1 + 4), g0 = ld4px(gp), g1 = ld4px(gp + 4);
        const float o[8] = {a0.x + b0.x, a0.y + b0.y, a0.z + b0.z, a0.w + b0.w, a1.x + b1.x, a1.y + b1.y, a1.z + b1.z, a1.w + b1.w}, gg[8] = {g0.x, g0.y, g0.z, g0.w, g1.x, g1.y, g1.z, g1.w};
        float ss = 0.f;
#pragma unroll
        for (int k = 0; k < 8; ++k) ss += o[k] * o[k];
        ss = row16_sum(ss);
        const float rs = rsqrtf(ss * (1.0f / 128.0f) + EPS);
        unsigned short ob[8];
#pragma unroll
        for (int k = 0; k < 8; ++k) ob[k] = f2bf(o[k] * rs * siluf_(gg[k]));
        uint4 ov; ov.x = ob[0] | ((unsigned)ob[1] << 16); ov.y = ob[2] | ((unsigned)ob[3] << 16); ov.z = ob[4] | ((unsigned)ob[5] << 16); ov.w = ob[6] | ((unsigned)ob[7] << 16);
        *(uint4*)(p.mixb + (size_t)r * D + 8 * lane) = ov;
    }
}
__device__ __forceinline__ void mf_lconv(const P& p, LAS unsigned char* lds, int il) {
    int tid = threadIdx.x; asm volatile("" : "+v"(tid));
    int bx_ = (int)blockIdx.x, gx_ = (int)gridDim.x; asm volatile("" : "+s"(bx_), "+s"(gx_));
    for (int c = bx_; c < HYW; c += gx_) lconv_unit(p, il, c, (LAS CX*)lds, p.zf + (size_t)bx_ * 2 * FFTN, tid, NTHREADS);
}
__device__ __forceinline__ void mf_inproj(const P& p, LAS unsigned char* lds, int layer) {
    const int il = layer >> 1; const bool ab = !(layer & 1);
    pg8::Gemm g{p.hxb, ab ? p.abin_t + (size_t)il * AB_IN * D : p.cdin_t + (size_t)il * CD_IN * D, NTOK, ab ? AB_IN : CD_IN, D, 0};
    int gx_ = (int)gridDim.x, bx_ = (int)blockIdx.x; asm volatile("" : "+s"(gx_), "+s"(bx_));
    pg8::StaticOrder S; S.init(g.M, g.N, gx_, bx_);
    pg8::EpiStoreBf16 E{p.px, PXLD};
    pg8::gemm_phase(lds, g, S, E);
}
__device__ __forceinline__ void mf_outproj(const P& p, LAS unsigned char* lds, int layer, int nrows) {
    const int il = layer >> 1; const bool ab = !(layer & 1);
    pg8::Gemm g{p.mixb, (ab ? p.about_t : p.cdout_t) + (size_t)il * D * D, nrows, D, D, 0};
    int gx_ = (int)gridDim.x, bx_ = (int)blockIdx.x; asm volatile("" : "+s"(gx_), "+s"(bx_));
    pg8::StaticOrder S; S.init(g.M, g.N, gx_, bx_);
    pg8::EpiResid E{p.xa, p.modv + (size_t)layer * 3 * 6 * D + 2 * D};
    pg8::gemm_phase(lds, g, S, E);
}
__device__ __forceinline__ void mf_glu(const P& p, LAS unsigned char* lds, int il) {
    pg8::Gemm g{p.ys5b, p.glu_t + (size_t)il * S5W * S5W, NTOK, S5W, S5W, 0};
    int gx_ = (int)gridDim.x, bx_ = (int)blockIdx.x; asm volatile("" : "+s"(gx_), "+s"(bx_));
    pg8::StaticOrder S; S.init(g.M, g.N, gx_, bx_);
    pg8::EpiGlu E{p.mixb, p.ys5b, p.s5_glu_b + il * S5W};
    pg8::gemm_phase(lds, g, S, E);
}
__device__ __forceinline__ int build_ue(const P& p, LAS unsigned char* lds, int layer) {
    volatile LAS unsigned char* ue = (volatile LAS unsigned char*)(lds + UE_OFF); volatile LAS int* tot = (volatile LAS int*)(lds + MISC_OFF + 16);
    __syncthreads();
    if (threadIdx.x == 0) { const int* cnt = p.cnt + layer * NE; int t = 0;
        for (int e = 0; e < NE; ++e) { const int nt = (cnt[e] + 255) >> 8; for (int q = 0; q < nt; ++q) ue[t + q] = (unsigned char)e; t += nt; }
        *tot = t; }
    __syncthreads();
    return *tot;
}
__device__ __forceinline__ void mf_moe1(const P& p, LAS unsigned char* lds, int layer) {
    const int tiles = build_ue(p, lds, layer);
    int gx_ = (int)gridDim.x, bx_ = (int)blockIdx.x; asm volatile("" : "+s"(gx_), "+s"(bx_));
    pg8::MoeOrder S{tiles * 8, 8, gx_, bx_, (const volatile LAS unsigned char*)(lds + UE_OFF), (const volatile LAS int*)(lds + TOK_OFF)};
    volatile LAS int* tokt = (volatile LAS int*)(lds + TOK_OFF);
    { int tid = threadIdx.x; asm volatile("" : "+v"(tid));
      int tkv[(TOK_UNITS + 1) / 2];
#pragma unroll
      for (int ps = 0; ps < (TOK_UNITS + 1) / 2; ++ps) { const int i = 2 * ps + (tid >> 8); int pm, pn; tkv[ps] = (i < TOK_UNITS && S.unit(i, pm, pn)) ? p.slot_tok[pm * 256 + (tid & 255)] : -1; }
#pragma unroll
      for (int ps = 0; ps < (TOK_UNITS + 1) / 2; ++ps) { const int i = 2 * ps + (tid >> 8); if (i < TOK_UNITS) tokt[i * 256 + (tid & 255)] = tkv[ps] < 0 ? NTOK : tkv[ps]; }
      __syncthreads(); }
    pg8::Gemm g{p.hxb, p.wgu_t + (size_t)layer * NE * 2 * DFF * D, tiles * 256, 2 * DFF, D, (size_t)2 * DFF * D * 2};
    pg8::EpiSwiglu E{p.actb, p.b_gu + (size_t)layer * NE * 2 * DFF};
    pg8::gemm_phase<pg8::EpiSwiglu, pg8::MoeOrder, true>(lds, g, S, E);
}
__device__ __forceinline__ void mf_moe2(const P& p, LAS unsigned char* lds, int layer) {
    const int tiles = build_ue(p, lds, layer);
    pg8::Gemm g{p.actb, p.wdn_t + (size_t)layer * NE * D * DFF, tiles * 256, D, DFF, (size_t)D * DFF * 2};
    int gx_ = (int)gridDim.x, bx_ = (int)blockIdx.x; asm volatile("" : "+s"(gx_), "+s"(bx_));
    pg8::MoeOrder S{tiles * 4, 4, gx_, bx_, (const volatile LAS unsigned char*)(lds + UE_OFF), nullptr};
    pg8::EpiDown E{p.yb, p.b_dn + (size_t)layer * NE * D, p.slot_gate};
    pg8::gemm_phase(lds, g, S, E);
}

#define XB_TMO      128
#define XB_XCNT(j)  (256  + 64 * (j))
#define XB_XSUB(j)  (1280 + 64 * (j))
#define XB_XGEN(j)  (2304 + 64 * (j))
#define XB_TOP      3328
#define XB_TOPGEN   3392
#define XCD_BAR_WORDS 3456
#define XB_SPIN_CAP (1u << 18)

__device__ __forceinline__ unsigned xb_ld(unsigned* p)              { return __hip_atomic_load(p, __ATOMIC_RELAXED, __HIP_MEMORY_SCOPE_AGENT); }
__device__ __forceinline__ unsigned xb_add(unsigned* p, unsigned v) { return __hip_atomic_fetch_add(p, v, __ATOMIC_RELAXED, __HIP_MEMORY_SCOPE_AGENT); }
__device__ __forceinline__ unsigned xb_xcc_id() { return (unsigned)__builtin_amdgcn_s_getreg((3 << 11) | 20) & 0xFu; }
#define XB_SPIN(cond, bar) do { unsigned _sp = 0; while (cond) { __builtin_amdgcn_s_sleep(1); \
    if ((++_sp & 255u) == 0u) { if (xb_ld(&(bar)[XB_TMO])) break; if (_sp > XB_SPIN_CAP) { atomicAdd(&(bar)[XB_TMO], 1u); break; } } } } while (0)

struct XcdBarrier { unsigned* bar; unsigned x; volatile LAS unsigned* st; };

__device__ __forceinline__ XcdBarrier xcd_barrier_post(unsigned* bar, volatile LAS unsigned* st) {
    XcdBarrier b; b.bar = bar; b.x = xb_xcc_id(); b.st = st;
    if (threadIdx.x == 0) (void)xb_add(&bar[XB_XCNT(b.x)], 1u);
    return b;
}
__device__ __forceinline__ void xcd_barrier_complete(unsigned* bar, unsigned x, unsigned& nloc, unsigned& nx) {
    const unsigned G = gridDim.x * gridDim.y * gridDim.z;
    unsigned sum, cnt, mine, sp = 0u;
    asm volatile("" : "+s"(x));
    for (;;) {
        sum = 0u; cnt = 0u; mine = 0u;
#pragma unroll
        for (unsigned j = 0; j < 16; ++j) { const unsigned c = xb_ld(&bar[XB_XCNT(j)]); sum += c; cnt += (c > 0u) ? 1u : 0u; mine = (j == x) ? c : mine; }
        if (sum == G) break;
        __builtin_amdgcn_s_sleep(1);
        if ((++sp & 255u) == 0u) { if (xb_ld(&bar[XB_TMO])) break; if (sp > XB_SPIN_CAP) { atomicAdd(&bar[XB_TMO], 1u); break; } }
    }
    nloc = mine > 0u ? mine : 1u; nx = cnt > 0u ? cnt : 1u;
}
__device__ __forceinline__ void xcd_barrier(const XcdBarrier& b) {
    asm volatile("s_waitcnt vmcnt(0)" ::: "memory");
    __syncthreads();
    if (threadIdx.x == 0) {
        unsigned* bar = b.bar; unsigned bx = b.x;
        asm volatile("" : "+s"(bar), "+s"(bx));
        __builtin_amdgcn_s_waitcnt(0);
        unsigned nloc = b.st[0], nx = b.st[1];
        if (nloc == 0u) { xcd_barrier_complete(bar, bx, nloc, nx); b.st[0] = nloc; b.st[1] = nx; }
        const unsigned old = xb_add(&bar[XB_XSUB(bx)], 1u);
        const unsigned gen = old / nloc;
        if (old + 1u == (gen + 1u) * nloc) {
            __builtin_amdgcn_fence(__ATOMIC_RELEASE, "agent");
            asm volatile("s_waitcnt vmcnt(0)" ::: "memory");
            const unsigned og = xb_add(&bar[XB_TOP], 1u);
            const unsigned tg = og / nx;
            if (og + 1u == (tg + 1u) * nx) xb_add(&bar[XB_TOPGEN], 1u);
            else XB_SPIN(xb_ld(&bar[XB_TOPGEN]) == tg, bar);
            __builtin_amdgcn_fence(__ATOMIC_ACQUIRE, "agent");
            xb_add(&bar[XB_XGEN(bx)], 1u);
            asm volatile("s_waitcnt vmcnt(0)" ::: "memory");
        } else {
            XB_SPIN(xb_ld(&bar[XB_XGEN(bx)]) == gen, bar);
            __builtin_amdgcn_fence(__ATOMIC_ACQUIRE, "agent");
            asm volatile("s_waitcnt vmcnt(0)" ::: "memory");
        }
    }
    __syncthreads();
}

typedef const __attribute__((address_space(4))) P* KP;
__global__ void __launch_bounds__(NTHREADS, 2) fwd_kernel(P p_arg) {
    (void)p_arg;
    const KP kp0 = (KP)__builtin_amdgcn_kernarg_segment_ptr();
#define p (*(const P*)({ KP q_ = kp0; asm volatile("" : "+s"(q_)); q_; }))
    extern __shared__ __attribute__((aligned(16))) unsigned char lds_raw[];
    LAS unsigned char* lds = (LAS unsigned char*)lds_raw;
    for (int u = threadIdx.x; u < (LDS_BYTES - MISC_OFF) / 4; u += NTHREADS) ((LAS unsigned*)(lds + MISC_OFF))[u] = 0u;
    __syncthreads();
    XcdBarrier bar = xcd_barrier_post(p.bar, (volatile LAS unsigned*)(lds + MISC_OFF));
    const long gs = (long)gridDim.x * NTHREADS;
#define gt ({ int b_ = (int)blockIdx.x; asm volatile("" : "+s"(b_)); long g_ = (long)b_ * NTHREADS + threadIdx.x; asm volatile("" : "+v"(g_)); g_; })
#define SETUP(S) setup_slot<S>(p, gt, gs); xcd_barrier(bar);
    for (int rep = 0; rep < REP_SETUP; ++rep) {
    setup_slot<0>(p, gt, gs); mf_filter_tiles(p, lds); __syncthreads(); ph_convert_weights(p, lds); xcd_barrier(bar);
    ph_mod2(p, gt, gs); ph_filt4(p, gt, gs); xcd_barrier(bar);
    }
#define SLOT(S) layer_slot<S>(p, layer, gt, gs); xcd_barrier(bar);
#if MFMA_DENSE
#define DENSE_IN  for (int rep = 0; rep < REP_IN; ++rep) { mf_inproj(p, lds, layer); if (layer < 3) convert_deferred(p, lds, layer, 0); xcd_barrier(bar); }
#define DENSE_OUT if (!(layer & 1)) mf_glu(p, lds, layer >> 1); else ph_retout(p, layer < 3 ? NTOK : NLAT, gt, gs); xcd_barrier(bar); \
                  mf_outproj(p, lds, layer, layer < 3 ? NTOK : NLAT); xcd_barrier(bar);
#else
#define DENSE_IN  SLOT(2)
#define DENSE_OUT SLOT(7) SLOT(8)
#endif
#if MFMA_MOE
#define MOE_GEMMS for (int rep = 0; rep < REP_MOE; ++rep) { mf_moe1(p, lds, layer); xcd_barrier(bar); } for (int rep = 0; rep < REP_MOE2; ++rep) { mf_moe2(p, lds, layer); xcd_barrier(bar); }
#else
#define MOE_GEMMS SLOT(14) SLOT(15)
#endif
#define REPF(n) for (int rep_ = 0; rep_ < (n); ++rep_)
#define LAYER(L) { constexpr int layer = L; constexpr bool AB = !(layer & 1); constexpr int il = layer >> 1; constexpr int nrows = layer < 3 ? NTOK : NLAT; \
    REPF(RN) mf_rownorm<0>(p, lds, layer, NTOK, layer - 1); xcd_barrier(bar); DENSE_IN \
    REPF(R3) { if (AB) { mf_s5<false>(p, lds, il); mf_sconv(p, lds, il); } else ph_rope(p, gt, gs); } xcd_barrier(bar); \
    REPF(R4) { if (AB) { mf_lconv(p, lds, il); ph_lconv(p, il, NLAT, NTOK, gt, gs); } else mf_retkv(p, lds, il); } if (AB) ph_s5carry(p, il, gt, gs); xcd_barrier(bar); \
    REPF(R5) { if (AB) { mf_s5<true>(p, lds, il); mf_hymix(p, lds, il); } else mf_swa(p, lds, il, layer < 3); } if (!AB) ph_retcarry(p, il, gt, gs); xcd_barrier(bar); \
    REPF(R6) { if (AB) ph_s5fin(p, il, gt, gs); else mf_reto(p, lds, il); } xcd_barrier(bar); \
    REPF(R7) { if (AB) mf_glu(p, lds, il); else mf_retout(p, nrows); } xcd_barrier(bar); \
    mf_outproj(p, lds, layer, nrows); if (layer < 3) convert_deferred(p, lds, layer, 1); xcd_barrier(bar); \
    mf_rownorm<1>(p, lds, layer, nrows, -1); xcd_barrier(bar); SLOT(12) MOE_GEMMS }
    LAYER(0) LAYER(1) LAYER(2) LAYER(3)
    mf_rownorm<2>(p, lds, 3, NLAT, 3);
#undef gt
#undef p
}

extern "C" void kernel_launch(void* const* d_in, const int* in_sizes, int n_in, void* d_out, int out_size, void* d_ws, size_t ws_size, hipStream_t stream) {
    (void)in_sizes; (void)n_in; (void)out_size;
    const WsMap m = ws_map();
    if (ws_size < m.total) { fprintf(stderr, "workspace too small: %zu < %zu\n", ws_size, m.total); return; }
    P p; memset(&p, 0, sizeof(p)); fill_params(p, d_in, d_out, d_ws);
    static int grid = 0;
    if (!grid) {
        int dev = 0, cus = 0, per_cu = 0;
        (void)hipGetDevice(&dev); (void)hipDeviceGetAttribute(&cus, hipDeviceAttributeMultiprocessorCount, dev);
        if (hipFuncSetAttribute((const void*)fwd_kernel, hipFuncAttributeMaxDynamicSharedMemorySize, LDS_BYTES) != hipSuccess) { fprintf(stderr, "hipFuncSetAttribute failed\n"); grid = -1; return; }
        (void)hipOccupancyMaxActiveBlocksPerMultiprocessor(&per_cu, (const void*)fwd_kernel, NTHREADS, LDS_BYTES);
        if (per_cu < 1) fprintf(stderr, "occupancy query reports %d blocks per CU\n", per_cu);
        grid = cus;
    }
    if (grid <= 0) return;
    (void)hipMemsetAsync(p.bar, 0, XCD_BAR_WORDS * sizeof(unsigned), stream);
    fwd_kernel<<<dim3(grid), dim3(NTHREADS), LDS_BYTES, stream>>>(p);
}
#endif
```

```cpp
#ifndef CPU_SHIM
#include <hip/hip_runtime.h>
#include <cstring>
#include <cstdio>
#include <cstdint>
#define DEV __device__ __forceinline__
#else
#include <cmath>
#include <cstdio>
#include <cstdint>
#include <cstring>
#include <cstdlib>
#define DEV static inline
static inline float rsqrtf(float x) { return 1.0f / sqrtf(x); }
#endif

#ifndef SEQ
#define SEQ 8192
#endif
#ifndef CTXL
#define CTXL 256
#endif
#ifndef N_LAUNCH_MODE
#define N_LAUNCH_MODE 1
#endif
#ifdef CPU_SHIM
#define MFMA_DENSE 0
#define MFMA_MOE 0
#endif
#ifndef R3
#define R3 1
#endif
#ifndef R4
#define R4 1
#endif
#ifndef R5
#define R5 1
#endif
#ifndef R6
#define R6 1
#endif
#ifndef R7
#define R7 1
#endif
#ifndef RG
#define RG 1
#endif
#ifndef RN
#define RN 1
#endif
#ifndef REP_SETUP
#define REP_SETUP 1
#endif
#ifndef REP_MOE
#define REP_MOE 1
#endif
#ifndef REP_MOE2
#define REP_MOE2 1
#endif
#ifndef REP_IN
#define REP_IN 1
#endif
#ifndef REP_RET
#define REP_RET 1
#endif
#ifndef REP_SWA
#define REP_SWA 1
#endif
#ifndef REP_S5
#define REP_S5 1
#endif
#ifndef MFMA_DENSE
#define MFMA_DENSE 1
#endif
#ifndef MFMA_MOE
#define MFMA_MOE 1
#endif
typedef unsigned short bf16_t;
#if MFMA_DENSE
typedef unsigned short px_t;
#else
typedef float px_t;
#endif

constexpr int D = 1024, NLAT = 2 * SEQ, NCTX = 2 * CTXL, NTOK = NLAT + NCTX;
constexpr int HYW = 512, S5W = 512, NG = 32, NP = 64, GH = 16;
constexpr int AB_IN = 2048, CD_IN = 2304, PXLD = 2304;
constexpr int NE = 32, DFF = 1024;
constexpr float EPS = 1e-6f;
constexpr int NSLOT = ((NTOK * 4 + 255) / 256 + NE) * 256;
#ifdef CPU_SHIM
DEV bf16_t f2bf(float f) { unsigned u; memcpy(&u, &f, 4); return (bf16_t)((u + 0x7fffu + ((u >> 16) & 1u)) >> 16); }
DEV float fexp(float x) { return expf(x); }
DEV float frcp(float x) { return 1.0f / x; }
#else
DEV bf16_t f2bf(float f) { const __bf16 b = (__bf16)f; return __builtin_bit_cast(unsigned short, b); }
DEV float fexp(float x) { return __builtin_amdgcn_exp2f(1.4426950408889634f * x); }
DEV float frcp(float x) { return __builtin_amdgcn_rcpf(x); }
#endif
DEV float bf2f(bf16_t b) { const unsigned u = (unsigned)b << 16; float f; memcpy(&f, &u, 4); return f; }
DEV float pxf(float v) { return v; }
DEV float pxf(bf16_t v) { return bf2f(v); }
DEV void pxstore(float* q, float v) { *q = v; }
DEV void pxstore(bf16_t* q, float v) { *q = f2bf(v); }

struct P {
    const float *x, *c, *ctx, *c_ctx, *mod_w, *mod_b, *norm1_g, *norm2_g, *ab_w_in, *ab_w_out, *hy_short_w, *hy_short_b,
        *hy_f_w1, *hy_f_b1, *hy_f_w2, *hy_f_b2, *hy_f_w3, *hy_bias, *s5_lre, *s5_lim, *s5_ldt, *s5_bre, *s5_bim, *s5_cre, *s5_cim,
        *s5_d, *s5_glu_w, *s5_glu_b, *cd_w_in, *cd_w_out, *ret_decay, *swa_sink, *router_w, *router_b, *w_gu, *b_gu, *w_dn, *b_dn, *final_g;
    float* out;
    unsigned* bar;
    float *xa, *modv, *f1, *f2, *hraw, *hsum, *rstd, *hx, *zb, *x0c, *mixin, *s5s, *ys5, *qr, *kr, *oret, *qs, *ks, *topg, *act;
    int* topi;
    px_t* px;
    bf16_t *hxb, *mixb, *ys5b, *xb, *actb, *abin_t, *cdin_t, *about_t, *cdout_t, *glu_t, *wgu_t, *wdn_t;
    bf16_t* yb;
    float *zT, *hT, *modp;
    float *slot_gate, *s5c, *rkv, *rsc, *hpart, *zf, *convT, *yd;
    int *cnt, *pos, *slot_of, *slot_tok;
};

struct RowInfo { int base, len, t, m, kind; };
DEV RowInfo row_info(int r) {
    RowInfo ri;
    if (r < NLAT) { const int b = r / SEQ; ri.base = b * SEQ; ri.len = SEQ; ri.t = r - ri.base; ri.m = b; ri.kind = 0; }
    else { const int rc = r - NLAT, b = rc / CTXL; ri.base = NLAT + b * CTXL; ri.len = CTXL; ri.t = rc - b * CTXL; ri.m = 2; ri.kind = 1; }
    return ri;
}
DEV float sigmoidf_(float x) { return frcp(1.0f + fexp(-x)); }
DEV float siluf_(float x) { return x * sigmoidf_(x); }
DEV float gelu_tanhf_(float x) { const float u = 0.7978845608028654f * (x + 0.044715f * x * x * x); return x * frcp(1.0f + fexp(-2.0f * u)); }

#ifdef CPU_SHIM
#define GSL(i, n) const long _n_##i = (long)(n); for (long i = _n_##i * gt / gs, _hi_##i = _n_##i * (gt + 1) / gs; i < _hi_##i; ++i)
#else
#define GSL(i, n) for (long i = gt; i < (long)(n); i += gs)
#endif

#if MFMA_DENSE
#define MIXST(idx, v) p.mixb[idx] = f2bf(v)
#else
#define MIXST(idx, v) p.mixin[idx] = (v)
#endif
DEV long filt_row0(int i, int kind) { return (long)i * (SEQ + CTXL) + (kind ? SEQ : 0); }

#ifdef CPU_SHIM
#define ROPE_COS(a) cosf(a)
#define ROPE_SIN(a) sinf(a)
#else
#define ROPE_COS(a) __builtin_amdgcn_cosf(__builtin_amdgcn_fractf((a) * 0.15915494309189535f))
#define ROPE_SIN(a) __builtin_amdgcn_sinf(__builtin_amdgcn_fractf((a) * 0.15915494309189535f))
#endif
DEV void ph_init(const P& p, long gt, long gs) {
    GSL(i, (long)NTOK * D) { p.xa[i] = i < (long)NLAT * D ? p.x[i] : p.ctx[i - (long)NLAT * D]; }
    GSL(j, 4 * NE) { p.cnt[j] = 0; }
    GSL(z, D) { p.hxb[(long)NTOK * D + z] = 0; }
}
DEV void ph_mod(const P& p, long gt, long gs) {
    GSL(i, 4L * 6 * D * 8) {
        const int j = (int)(i % (6 * D)), kq = (int)((i / (6 * D)) % 8), l = (int)(i / (6 * D * 8));
        const float* w = p.mod_w + (long)l * D * 6 * D + j;
        float a0 = 0.f, a1 = 0.f, a2 = 0.f;
        for (int k = kq * (D / 8); k < (kq + 1) * (D / 8); ++k) { const float wv = w[(long)k * 6 * D]; a0 += siluf_(p.c[k]) * wv; a1 += siluf_(p.c[D + k]) * wv; a2 += siluf_(p.c_ctx[k]) * wv; }
        float* o = p.modp + ((long)kq * 4 + l) * 3 * 6 * D + j;
        o[0] = a0; o[6 * D] = a1; o[12 * D] = a2;
    }
}
DEV void ph_mod2(const P& p, long gt, long gs) {
    GSL(i, 4L * 3 * 6 * D) {
        const int j = (int)(i % (6 * D)), l = (int)(i / (18 * D));
        float a = p.mod_b[l * 6 * D + j];
#pragma unroll
        for (int kq = 0; kq < 8; ++kq) a += p.modp[(long)kq * 4 * 3 * 6 * D + i];
        p.modv[i] = a;
    }
}
DEV void ph_filt1(const P& p, long gt, long gs) {
    GSL(idx, 2L * (SEQ + CTXL) * 64) {
        const int j = (int)(idx % 64); const long rr = idx / 64; const int i = (int)(rr / (SEQ + CTXL)); const int q = (int)(rr % (SEQ + CTXL));
        const int kind = q >= SEQ, pos = kind ? q - SEQ : q, L = kind ? CTXL : SEQ;
        const float* w1 = p.hy_f_w1 + i * 33 * 64;
        const float t = (float)pos / (float)L, w = 6.283185307179586f * (float)pos / (float)L;
        float acc = t * w1[j];
        for (int bi = 0; bi < 16; ++bi) {
            const float band = 1e-4f + (float)bi * ((15.0f - 1e-4f) / 15.0f);
            acc += ROPE_COS(band * w) * w1[(1 + bi) * 64 + j] - ROPE_SIN(band * w) * w1[(17 + bi) * 64 + j];
        }
        p.f1[idx] = ROPE_SIN(acc + p.hy_f_b1[i * 64 + j]);
    }
}
DEV void ph_filt2(const P& p, long gt, long gs) {
    GSL(idx, 2L * (SEQ + CTXL) * 64) {
        const int j = (int)(idx % 64); const long rr = idx / 64; const int i = (int)(rr / (SEQ + CTXL));
        const float* w2 = p.hy_f_w2 + i * 64 * 64; const float* h1 = p.f1 + rr * 64;
        float acc = 0.f;
        for (int k = 0; k < 64; ++k) acc += h1[k] * w2[k * 64 + j];
        p.f2[idx] = ROPE_SIN(acc + p.hy_f_b2[i * 64 + j]);
    }
}
DEV void ph_filt3(const P& p, long gt, long gs) {
    GSL(idx, 2L * (SEQ + CTXL) * HYW) {
        const int c = (int)(idx % HYW); const long rr = idx / HYW; const int i = (int)(rr / (SEQ + CTXL)); const int q = (int)(rr % (SEQ + CTXL));
        const int kind = q >= SEQ, pos = kind ? q - SEQ : q, L = kind ? CTXL : SEQ;
        const float* w3 = p.hy_f_w3 + (long)i * 64 * HYW; const float* h2 = p.f2 + rr * 64;
        float acc = 0.f;
        for (int k = 0; k < 64; ++k) acc += h2[k] * w3[k * HYW + c];
        const float lag = fabsf((float)(pos - L / 2)) / (float)(L / 2);
        const float fast = -15.350567286626973f, slow = -3.0701134573253946f;
        const float delta = fabsf(fast + (slow - fast) * (float)c / 511.0f);
        const float hv = acc * (expf(-lag * delta) + 0.05f);
        p.hraw[idx] = hv; if (!kind) p.hT[((long)i * HYW + c) * SEQ + pos] = hv;
    }
}
constexpr int FSEG = 64, FNSEG = (SEQ + CTXL) / FSEG;
DEV void ph_filt4a(const P& p, long gt, long gs) {
    GSL(idx, 2L * FNSEG * HYW) {
        const int c = (int)(idx % HYW); const long sg = idx / HYW; const float* h = p.hraw + sg * FSEG * HYW + c;
        float s = 0.f;
        for (int q = 0; q < FSEG; ++q) s += fabsf(h[(long)q * HYW]);
        p.hpart[idx] = s;
    }
}
DEV void ph_filt4(const P& p, long gt, long gs) {
    GSL(idx, 2 * 2 * HYW) {
        const int c = (int)(idx % HYW), kind = (int)((idx / HYW) % 2), i = (int)(idx / (2 * HYW));
        const int s0 = (int)(filt_row0(i, kind) / FSEG), ns = (kind ? CTXL : SEQ) / FSEG;
        float s = 0.f;
        for (int q = 0; q < ns; ++q) s += p.hpart[(long)(s0 + q) * HYW + c];
        p.hsum[idx] = s;
    }
}
DEV void ph_rstd(const P& p, int nrows, long gt, long gs) {
    GSL(r, nrows) {
        const float* xr = p.xa + r * D; float s = 0.f;
        for (int k = 0; k < D; ++k) s += xr[k] * xr[k];
        p.rstd[r] = rsqrtf(s * (1.0f / D) + EPS);
    }
}
DEV void ph_hx(const P& p, int layer, int which, int nrows, long gt, long gs) {
    const float* g = (which ? p.norm2_g : p.norm1_g) + layer * D;
    GSL(i, (long)nrows * D) {
        const int k = (int)(i % D), r = (int)(i / D); const RowInfo ri = row_info(r);
        const float* mv = p.modv + ((long)layer * 3 + ri.m) * 6 * D + which * 3 * D;
        const float v = p.xa[i] * p.rstd[r] * g[k] * (1.0f + mv[D + k]) + mv[k];
        p.hx[i] = v; p.hxb[i] = f2bf(v);
    }
}
DEV void ph_inproj(const P& p, const float* w, int nin, long gt, long gs) {
    GSL(i, (long)NTOK * nin) {
        const int n = (int)(i % nin), r = (int)(i / nin); const float* a = p.hx + (long)r * D; const float* b = w + n;
        float acc = 0.f;
        for (int k = 0; k < D; ++k) acc += a[k] * b[(long)k * nin];
        pxstore(&p.px[(long)r * PXLD + n], acc);
    }
}
DEV void ph_sconv(const P& p, int il, long gt, long gs) {
    const float* sw = p.hy_short_w + il * 3 * 1536; const float* sb = p.hy_short_b + il * 1536;
    GSL(i, (long)NTOK * HYW) {
        const int c = (int)(i % HYW), r = (int)(i / HYW); const RowInfo ri = row_info(r);
        float u[3];
#pragma unroll
        for (int s = 0; s < 3; ++s) {
            const int col = s * HYW + c; float acc = sb[col];
#pragma unroll
            for (int j = 0; j < 3; ++j) { const int tt = ri.t + j - 1; if (tt >= 0 && tt < ri.len) acc += sw[j * 1536 + col] * pxf(p.px[(long)(ri.base + tt) * PXLD + col]); }
            u[s] = acc;
        }
        p.x0c[i] = u[0]; p.zb[i] = u[2] * u[1]; if (r < NLAT) p.zT[(long)c * NLAT + r] = u[2] * u[1];
    }
}
DEV void ph_lconv(const P& p, int il, int r0, int r1, long gt, long gs) {
    GSL(i0, (long)(r1 - r0) * HYW) {
        const long i = i0 + (long)r0 * HYW;
        const int c = (int)(i % HYW), r = (int)(i / HYW); const RowInfo ri = row_info(r);
        const int L = ri.len, t = ri.t;
        const float* h = p.hraw + filt_row0(il, ri.kind) * HYW + c; const float* z = p.zb + (long)ri.base * HYW + c;
        int s0 = t + L / 2 - (L - 1); if (s0 < 0) s0 = 0; int s1 = t + L / 2; if (s1 > L - 1) s1 = L - 1;
        float acc = 0.f;
#pragma unroll 8
        for (int s = s0; s <= s1; ++s) acc += h[(long)(t - s + L / 2) * HYW] * z[(long)s * HYW];
        const float y = acc / p.hsum[(il * 2 + ri.kind) * HYW + c] + p.hy_bias[il * HYW + c] * p.zb[i];
        MIXST((long)r * D + c, p.x0c[i] * y);
    }
}
constexpr int FFTN = 2 * SEQ, FFT_NS = (SEQ == 8192 ? 7 : SEQ == 2048 ? 6 : SEQ == 512 ? 5 : SEQ == 128 ? 4 : -1);
static_assert(FFT_NS > 0 && (1 << (2 * FFT_NS)) == FFTN, "2*SEQ must be a power of 4");
struct CX { float x, y; };
#define PADX(n) ((n) + ((n) >> 5))
constexpr int FFT_ELEMS = FFTN + (FFTN >> 5);
#ifdef CPU_SHIM
#define COS2PI(f) cosf(6.283185307179586f * (f))
#define SIN2PI(f) sinf(6.283185307179586f * (f))
#define FFT_SYNC()
#else
#define COS2PI(f) __builtin_amdgcn_cosf(f)
#define SIN2PI(f) __builtin_amdgcn_sinf(f)
#define FFT_SYNC() __syncthreads()
#endif
template <class XP> DEV CX cx_ld(XP x, int i) { CX r; r.x = x[i].x; r.y = x[i].y; return r; }
template <class XP> DEV void cx_st(XP x, int i, CX v) { x[i].x = v.x; x[i].y = v.y; }
DEV CX cx_add(CX a, CX b) { return CX{a.x + b.x, a.y + b.y}; }
DEV CX cx_sub(CX a, CX b) { return CX{a.x - b.x, a.y - b.y}; }
DEV CX cx_mul(CX a, CX b) { return CX{a.x * b.x - a.y * b.y, a.x * b.y + a.y * b.x}; }
template <class XP> DEV void fft_pass(XP x, int s, bool inv, int tid, int nthr) {
    const int lq = 2 * (FFT_NS - 1 - s), Q = 1 << lq;
    const float invB = 1.0f / (float)(4 * Q);
    for (int t = tid; t < FFTN / 4; t += nthr) {
        const int i = t & (Q - 1), base = ((t >> lq) << (lq + 2)) + i;
        const float f = (float)i * invB, cs = COS2PI(f), sn = SIN2PI(f);
        const CX w1 = CX{cs, inv ? sn : -sn}, w2 = cx_mul(w1, w1), w3 = cx_mul(w2, w1);
        const int i0 = PADX(base), i1 = PADX(base + Q), i2 = PADX(base + 2 * Q), i3 = PADX(base + 3 * Q);
        const CX a = cx_ld(x, i0), b = cx_ld(x, i1), c = cx_ld(x, i2), d = cx_ld(x, i3);
        if (!inv) {
            const CX t0 = cx_add(a, c), t1 = cx_sub(a, c), t2 = cx_add(b, d), bd = cx_sub(b, d), t3 = CX{bd.y, -bd.x};
            cx_st(x, i0, cx_add(t0, t2)); cx_st(x, i1, cx_mul(cx_add(t1, t3), w1)); cx_st(x, i2, cx_mul(cx_sub(t0, t2), w2)); cx_st(x, i3, cx_mul(cx_sub(t1, t3), w3));
        } else {
            const CX y0 = a, y1 = cx_mul(b, w1), y2 = cx_mul(c, w2), y3 = cx_mul(d, w3);
            const CX u0 = cx_add(y0, y2), u1 = cx_sub(y0, y2), u2 = cx_add(y1, y3), yd = cx_sub(y1, y3), u3 = CX{-yd.y, yd.x};
            cx_st(x, i0, cx_add(u0, u2)); cx_st(x, i1, cx_add(u1, u3)); cx_st(x, i2, cx_sub(u0, u2)); cx_st(x, i3, cx_sub(u1, u3));
        }
    }
}
DEV void bfly4(CX& a, CX& b, CX& c, CX& d, CX w1, bool inv, bool tw) {
    const CX w2 = cx_mul(w1, w1), w3 = cx_mul(w2, w1);
    if (!inv) {
        const CX t0 = cx_add(a, c), t1 = cx_sub(a, c), t2 = cx_add(b, d), bd = cx_sub(b, d), t3 = CX{bd.y, -bd.x};
        a = cx_add(t0, t2); b = cx_add(t1, t3); c = cx_sub(t0, t2); d = cx_sub(t1, t3);
        if (tw) { b = cx_mul(b, w1); c = cx_mul(c, w2); d = cx_mul(d, w3); }
    } else {
        CX y1 = b, y2 = c, y3 = d;
        if (tw) { y1 = cx_mul(b, w1); y2 = cx_mul(c, w2); y3 = cx_mul(d, w3); }
        const CX u0 = cx_add(a, y2), u1 = cx_sub(a, y2), u2 = cx_add(y1, y3), yd = cx_sub(y1, y3), u3 = CX{-yd.y, yd.x};
        a = cx_add(u0, u2); b = cx_add(u1, u3); c = cx_sub(u0, u2); d = cx_sub(u1, u3);
    }
}
template <class XP> DEV void fft_pass16(XP x, int s, bool inv, int tid, int nthr) {
    const int lq2 = 2 * (FFT_NS - 2 - s), Q2 = 1 << lq2, Q = 4 * Q2;
    const float invB = 1.0f / (float)(16 * Q2);
    const float sg = inv ? 1.0f : -1.0f;
    const CX c1 = CX{0.9238795325112867f, sg * 0.3826834323650898f}, c2 = CX{0.7071067811865476f, sg * 0.7071067811865476f}, c3 = CX{0.3826834323650898f, sg * 0.9238795325112867f};
    for (int t = tid; t < FFTN / 16; t += nthr) {
        const int i = t & (Q2 - 1), base = ((t >> lq2) << (lq2 + 4)) + i;
        const float f = (float)i * invB, cs = COS2PI(f), sn = SIN2PI(f);
        const CX wA = CX{cs, sg * sn};
        CX wB = cx_mul(wA, wA); wB = cx_mul(wB, wB);
        CX v[4][4];
#pragma unroll
        for (int a = 0; a < 4; ++a)
#pragma unroll
            for (int b = 0; b < 4; ++b) v[a][b] = cx_ld(x, PADX(base + a * Q + b * Q2));
        if (!inv) {
            bfly4(v[0][0], v[1][0], v[2][0], v[3][0], wA, false, true);
            bfly4(v[0][1], v[1][1], v[2][1], v[3][1], cx_mul(wA, c1), false, true);
            bfly4(v[0][2], v[1][2], v[2][2], v[3][2], cx_mul(wA, c2), false, true);
            bfly4(v[0][3], v[1][3], v[2][3], v[3][3], cx_mul(wA, c3), false, true);
#pragma unroll
            for (int r = 0; r < 4; ++r) bfly4(v[r][0], v[r][1], v[r][2], v[r][3], wB, false, true);
        } else {
#pragma unroll
            for (int r = 0; r < 4; ++r) bfly4(v[r][0], v[r][1], v[r][2], v[r][3], wB, true, true);
            bfly4(v[0][0], v[1][0], v[2][0], v[3][0], wA, true, true);
            bfly4(v[0][1], v[1][1], v[2][1], v[3][1], cx_mul(wA, c1), true, true);
            bfly4(v[0][2], v[1][2], v[2][2], v[3][2], cx_mul(wA, c2), true, true);
            bfly4(v[0][3], v[1][3], v[2][3], v[3][3], cx_mul(wA, c3), true, true);
        }
#pragma unroll
        for (int a = 0; a < 4; ++a)
#pragma unroll
            for (int b = 0; b < 4; ++b) cx_st(x, PADX(base + a * Q + b * Q2), v[a][b]);
    }
}
template <class XP> DEV void fft_pass_last(XP x, bool inv, int tid, int nthr) {
    for (int t = tid; t < FFTN / 4; t += nthr) {
        const int base = 4 * t; CX a = cx_ld(x, PADX(base)), b = cx_ld(x, PADX(base + 1)), c = cx_ld(x, PADX(base + 2)), d = cx_ld(x, PADX(base + 3));
        bfly4(a, b, c, d, CX{1.f, 0.f}, inv, false);
        cx_st(x, PADX(base), a); cx_st(x, PADX(base + 1), b); cx_st(x, PADX(base + 2), c); cx_st(x, PADX(base + 3), d);
    }
}
static_assert(FFT_NS % 2 == 1, "pass schedule: (FFT_NS - 1) / 2 radix-16 passes + one radix-4 pass");
template <class XP> DEV void fft_forward(XP x, int tid, int nthr) {
    for (int s = 0; s + 1 < FFT_NS; s += 2) { fft_pass16(x, s, false, tid, nthr); FFT_SYNC(); }
    fft_pass_last(x, false, tid, nthr); FFT_SYNC();
}
template <class XP> DEV void fft_inverse(XP x, int tid, int nthr) {
    fft_pass_last(x, true, tid, nthr); FFT_SYNC();
    for (int s = FFT_NS - 3; s >= 0; s -= 2) { fft_pass16(x, s, true, tid, nthr); FFT_SYNC(); }
}
template <class XP> DEV void lconv_unit(const P& p, int il, int c, XP x, float* zf, int tid, int nthr) {
    constexpr int L = SEQ, N = FFTN;
    const float* zc = p.zT + (long)c * NLAT;
#pragma unroll 8
    for (int n = tid; n < L; n += nthr) { CX v; v.x = zc[n]; v.y = zc[SEQ + n]; cx_st(x, PADX(n), v); }
#pragma unroll 8
    for (int n = L + tid; n < N; n += nthr) cx_st(x, PADX(n), CX{0.f, 0.f});
    FFT_SYNC();
    fft_forward(x, tid, nthr);
    const float* h = p.hT + ((long)il * HYW + c) * SEQ;
#pragma unroll 8
    for (int n = tid; n < L; n += nthr) { const float hv = h[n]; const CX v = cx_ld(x, PADX(n)); zf[2 * n] = v.x; zf[2 * n + 1] = v.y; cx_st(x, PADX(n), CX{hv, 0.f}); }
#pragma unroll 8
    for (int n = L + tid; n < N; n += nthr) { const CX v = cx_ld(x, PADX(n)); zf[2 * n] = v.x; zf[2 * n + 1] = v.y; cx_st(x, PADX(n), CX{0.f, 0.f}); }
    FFT_SYNC();
    fft_forward(x, tid, nthr);
#ifndef CPU_SHIM
    asm volatile("s_waitcnt vmcnt(0)" ::: "memory");
#endif
#pragma unroll 8
    for (int n = tid; n < N; n += nthr) { const CX zv{zf[2 * n], zf[2 * n + 1]}; const CX hv = cx_ld(x, PADX(n)); cx_st(x, PADX(n), cx_mul(hv, zv)); }
    FFT_SYNC();
    fft_inverse(x, tid, nthr);
    const float scale = 1.0f / ((float)N * p.hsum[(il * 2 + 0) * HYW + c]);
    float* o = p.convT + (long)c * NLAT;
#pragma unroll 8
    for (int t = tid; t < L; t += nthr) { const CX v = cx_ld(x, PADX(t + L / 2)); o[t] = v.x * scale; o[L + t] = v.y * scale; }
    FFT_SYNC();
}
#ifdef CPU_SHIM
DEV void ph_lconv_fft(const P& p, int il, long gt, long gs) {
    CX* x = (CX*)malloc(sizeof(CX) * FFT_ELEMS);
    GSL(c, HYW) { lconv_unit(p, il, (int)c, x, p.zf + gt * 2 * FFTN, 0, 1); }
    free(x);
}
#endif
DEV void ph_hymix(const P& p, int il, long gt, long gs) {
    GSL(i, (long)NLAT * HYW) {
        const int c = (int)(i % HYW), r = (int)(i / HYW);
        const float y = p.convT[(long)c * NLAT + r] + p.hy_bias[il * HYW + c] * p.zb[i];
        MIXST((long)r * D + c, p.x0c[i] * y);
    }
}
DEV int scan_row(int dir, int b, int n) {
    if (n < CTXL) return NLAT + b * CTXL + (dir ? CTXL - 1 - n : n);
    const int m = n - CTXL; return b * SEQ + (dir ? SEQ - 1 - m : m);
}
constexpr int S5C = 64, S5NCH = (CTXL + SEQ) / S5C;
struct S5Par { float lbr, lbi; float bbr[GH], bbi[GH]; };
DEV void s5_par(const P& p, int il, int dir, int g, int pp, S5Par& q) {
    const int gi = (il * 2 + dir) * NG + g;
    const float lre = fminf(p.s5_lre[gi * NP + pp], -1e-4f), lim = p.s5_lim[gi * NP + pp], dt = expf(p.s5_ldt[gi]);
    const float mag = expf(lre * dt); q.lbr = mag * cosf(lim * dt); q.lbi = mag * sinf(lim * dt);
    const float nr = q.lbr - 1.0f, ni = q.lbi, den = lre * lre + lim * lim;
    const float fr = (nr * lre + ni * lim) / den, fi = (ni * lre - nr * lim) / den;
#pragma unroll
    for (int h = 0; h < GH; ++h) { const float br = p.s5_bre[((long)gi * NP + pp) * GH + h], bi = p.s5_bim[((long)gi * NP + pp) * GH + h]; q.bbr[h] = fr * br - fi * bi; q.bbi[h] = fr * bi + fi * br; }
}
DEV void ph_s5chunk(const P& p, int il, int fill, long gt, long gs) {
    GSL(i, 2L * 2 * S5NCH * NG * NP) {
        const int pp = (int)(i % NP), g = (int)((i / NP) % NG), ch = (int)((i / (NP * NG)) % S5NCH), b = (int)((i / ((long)NP * NG * S5NCH)) % 2), dir = (int)(i / ((long)NP * NG * S5NCH * 2));
        S5Par q; s5_par(p, il, dir, g, pp, q);
        float* ce = p.s5c + ((((long)dir * 2 + b) * S5NCH + ch) * NG + g) * NP * 2 + pp * 2;
        float sr = 0.f, si = 0.f;
        if (fill) { sr = ce[0]; si = ce[1]; }
        for (int k = 0; k < S5C; ++k) {
            const int row = scan_row(dir, b, ch * S5C + k); const px_t* u = p.px + (long)row * PXLD + 1536 + g * GH;
            float ar = 0.f, ai = 0.f;
#pragma unroll
            for (int h = 0; h < GH; ++h) { ar += q.bbr[h] * pxf(u[h]); ai += q.bbi[h] * pxf(u[h]); }
            const float tr = q.lbr * sr - q.lbi * si + ar, ti = q.lbr * si + q.lbi * sr + ai; sr = tr; si = ti;
            if (fill) { float* o = p.s5s + (((long)dir * NTOK + row) * NG + g) * NP * 2 + pp * 2; o[0] = sr; o[1] = si; }
        }
        if (!fill) { ce[0] = sr; ce[1] = si; }
    }
}
DEV void ph_s5carry(const P& p, int il, long gt, long gs) {
    GSL(i, 2 * 2 * NG * NP) {
        const int pp = (int)(i % NP), g = (int)((i / NP) % NG), b = (int)((i / (NP * NG)) % 2), dir = (int)(i / (NP * NG * 2));
        S5Par q; s5_par(p, il, dir, g, pp, q);
        float pr = q.lbr, pi = q.lbi;
#pragma unroll
        for (int t = 0; t < 6; ++t) { const float nr = pr * pr - pi * pi, ni = 2.0f * pr * pi; pr = nr; pi = ni; }
        float cr = 0.f, ci = 0.f;
        float* ce0 = p.s5c + ((((long)dir * 2 + b) * S5NCH) * NG + g) * NP * 2 + pp * 2;
        constexpr int CB = 12;
        for (int c0 = 0; c0 < S5NCH; c0 += CB) {
            float er[CB], ei[CB];
#pragma unroll
            for (int j = 0; j < CB; ++j) if (c0 + j < S5NCH) { const float* ce = ce0 + (long)(c0 + j) * NG * NP * 2; er[j] = ce[0]; ei[j] = ce[1]; }
#pragma unroll
            for (int j = 0; j < CB; ++j) if (c0 + j < S5NCH) { float* ce = ce0 + (long)(c0 + j) * NG * NP * 2; ce[0] = cr; ce[1] = ci;
                const float tr = pr * cr - pi * ci + er[j], ti = pr * ci + pi * cr + ei[j]; cr = tr; ci = ti; }
        }
    }
}
DEV void ph_s5out(const P& p, int il, long gt, long gs) {
    GSL(i, (long)NTOK * S5W) {
        const int ch = (int)(i % S5W), r = (int)(i / S5W), g = ch / GH, h = ch % GH;
        float y = p.s5_d[il * S5W + ch] * pxf(p.px[(long)r * PXLD + 1536 + ch]);
        for (int dir = 0; dir < 2; ++dir) {
            const long ci = (((long)(il * 2 + dir) * NG + g) * GH + h) * NP;
            const float* s = p.s5s + (((long)dir * NTOK + r) * NG + g) * NP * 2;
            for (int pp = 0; pp < NP; ++pp) y += p.s5_cre[ci + pp] * s[pp * 2] - p.s5_cim[ci + pp] * s[pp * 2 + 1];
        }
        { const float gy = gelu_tanhf_(y); p.ys5[i] = gy; p.ys5b[i] = f2bf(gy); }
    }
}
DEV void ph_s5fin(const P& p, int il, long gt, long gs) {
    GSL(i, (long)NTOK * S5W) {
        const int ch = (int)(i % S5W), r = (int)(i / S5W);
        const float y = p.s5_d[il * S5W + ch] * pxf(p.px[(long)r * PXLD + 1536 + ch]) + p.yd[i] + p.yd[(long)NTOK * S5W + i];
        const float gy = gelu_tanhf_(y); p.ys5b[i] = f2bf(gy);
#ifdef CPU_SHIM
        p.ys5[i] = gy;
#endif
    }
}
DEV void ph_glu(const P& p, int il, long gt, long gs) {
    const float* w = p.s5_glu_w + (long)il * S5W * S5W;
    GSL(i, (long)NTOK * S5W) {
        const int ch = (int)(i % S5W), r = (int)(i / S5W); const float* a = p.ys5 + (long)r * S5W;
        float acc = p.s5_glu_b[il * S5W + ch];
        for (int k = 0; k < S5W; ++k) acc += a[k] * w[(long)k * S5W + ch];
        MIXST((long)r * D + HYW + ch, a[ch] * sigmoidf_(acc));
    }
}
DEV void ph_rope(const P& p, long gt, long gs) {
    GSL(i, (long)NTOK * 576) {
        const int it = (int)(i % 576), r = (int)(i / 576); const RowInfo ri = row_info(r); const px_t* pr = p.px + (long)r * PXLD;
        if (it < 256) {
            const int isk = it >= 128, hd = it & 127, h = hd >> 5, d = hd & 31;
            const px_t* src = pr + (isk ? 256 : 0) + h * 64; float x1 = pxf(src[d]), x2 = pxf(src[d + 32]);
            if (ri.kind == 0) { const float inv = exp2f(-(float)d * (13.287712379549449f / 32.0f)), ang = (float)ri.t * inv, cs = ROPE_COS(ang), sn = ROPE_SIN(ang);
                const float y1 = x1 * cs - x2 * sn, y2 = x1 * sn + x2 * cs; x1 = y1; x2 = y2; }
            const float sc = isk ? 1.0f : 0.125f;
            float* dst = (isk ? p.kr : p.qr) + (long)r * 256 + h * 64; dst[d] = x1 * sc; dst[d + 32] = x2 * sc;
        } else {
            const int j = it - 256, isk = j >= 256, hd = isk ? j - 256 : j, h = hd >> 5, e = hd & 31, half = e >> 4, d = e & 15;
            const px_t* src = pr + (isk ? 2048 : 1536) + h * 64 + half * 32; float x1 = pxf(src[d]), x2 = pxf(src[d + 16]);
            if (ri.kind == 0) { const float pos = (float)(half ? (ri.t % 64) : (ri.t / 64)); const float inv = exp2f(-(float)d * (13.287712379549449f / 16.0f)), ang = pos * inv, cs = ROPE_COS(ang), sn = ROPE_SIN(ang);
                const float y1 = x1 * cs - x2 * sn, y2 = x1 * sn + x2 * cs; x1 = y1; x2 = y2; }
            const float sc = isk ? 1.0f : 0.125f;
            float* dst = (isk ? p.ks + (long)r * 128 : p.qs + (long)r * 512) + h * 64 + half * 32; dst[d] = x1 * sc; dst[d + 16] = x2 * sc;
        }
    }
}
constexpr int RC = 128, RNCH = (CTXL + SEQ) / RC;
DEV float ret_logg(const P& p, int il, int dir, int h) { const float dl = p.ret_decay[(il * 2 + dir) * 4 + h]; return -log1pf(expf(-dl)); }
DEV void ph_retkv(const P& p, int il, long gt, long gs) {
    GSL(i, 2L * 2 * RNCH * 4 * 64 * 128) {
        const int e = (int)(i % 128), d = (int)((i / 128) % 64), h = (int)((i / 8192) % 4), n = (int)((i / 32768) % RNCH), b = (int)((i / (32768L * RNCH)) % 2), dir = (int)(i / (32768L * RNCH * 2));
        const float lg = ret_logg(p, il, dir, h);
        float acc = 0.f;
        for (int j = 0; j < RC; ++j) { const int row = scan_row(dir, b, n * RC + j);
            acc += expf((float)(RC - 1 - j) * lg) * p.kr[(long)row * 256 + h * 64 + d] * pxf(p.px[(long)row * PXLD + 512 + h * 128 + e]); }
        p.rkv[i] = acc;
    }
}
DEV void ph_retcarry(const P& p, int il, long gt, long gs) {
    GSL(i, 2L * 2 * 4 * 64 * 128) {
        const int de = (int)(i % 8192), h = (int)((i / 8192) % 4), b = (int)((i / 32768) % 2), dir = (int)(i / 65536);
        const float gc = expf((float)RC * ret_logg(p, il, dir, h));
        float S = 0.f;
        float* q0 = p.rkv + ((((long)dir * 2 + b) * RNCH) * 4 + h) * 8192 + de;
        constexpr int CB = 11;
        for (int n0 = 0; n0 < RNCH; n0 += CB) {
            float kv[CB];
#pragma unroll
            for (int j = 0; j < CB; ++j) if (n0 + j < RNCH) kv[j] = q0[(long)(n0 + j) * 4 * 8192];
#pragma unroll
            for (int j = 0; j < CB; ++j) if (n0 + j < RNCH) { q0[(long)(n0 + j) * 4 * 8192] = S; S = gc * S + kv[j]; }
        }
    }
}
DEV void ph_retsc(const P& p, int il, long gt, long gs) {
    GSL(i, 2L * NTOK * 4 * RC) {
        const int j = (int)(i % RC), h = (int)((i / RC) % 4), r = (int)((i / (RC * 4)) % NTOK), dir = (int)(i / ((long)RC * 4 * NTOK)); const RowInfo ri = row_info(r);
        const int b = ri.kind ? (ri.base - NLAT) / CTXL : ri.base / SEQ;
        const int step = ri.kind ? (dir ? CTXL - 1 - ri.t : ri.t) : CTXL + (dir ? SEQ - 1 - ri.t : ri.t), ii = step % RC, n = step / RC;
        float sc = 0.f;
        if (j <= ii) { const int rj = scan_row(dir, b, n * RC + j); const float* q = p.qr + (long)r * 256 + h * 64; const float* k = p.kr + (long)rj * 256 + h * 64;
            float dot = 0.f;
            for (int d = 0; d < 64; ++d) dot += q[d] * k[d];
            sc = dot * expf((float)(ii - j) * ret_logg(p, il, dir, h)); }
        p.rsc[i] = sc;
    }
}
DEV void ph_reto(const P& p, int il, long gt, long gs) {
    GSL(i, 2L * NTOK * 512) {
        const int e = (int)(i % 128), h = (int)((i / 128) % 4), r = (int)((i / 512) % NTOK), dir = (int)(i / (512L * NTOK)); const RowInfo ri = row_info(r);
        const int b = ri.kind ? (ri.base - NLAT) / CTXL : ri.base / SEQ;
        const int step = ri.kind ? (dir ? CTXL - 1 - ri.t : ri.t) : CTXL + (dir ? SEQ - 1 - ri.t : ri.t), ii = step % RC, n = step / RC;
        const float* sc = p.rsc + (((long)dir * NTOK + r) * 4 + h) * RC;
        float acc = 0.f;
        for (int j = 0; j <= ii; ++j) { const int rj = scan_row(dir, b, n * RC + j); acc += sc[j] * pxf(p.px[(long)rj * PXLD + 512 + h * 128 + e]); }
        const float* S = p.rkv + ((((long)dir * 2 + b) * RNCH + n) * 4 + h) * 8192 + e; const float* q = p.qr + (long)r * 256 + h * 64;
        float cr = 0.f;
        for (int d = 0; d < 64; ++d) cr += q[d] * S[d * 128];
        p.oret[((long)dir * NTOK + r) * 512 + h * 128 + e] = acc + cr * expf((float)(ii + 1) * ret_logg(p, il, dir, h));
    }
}
DEV void ph_retout(const P& p, int nrows, long gt, long gs) {
    GSL(i, (long)nrows * 4) {
        const int h = (int)(i % 4), r = (int)(i / 4);
        const float* o0 = p.oret + (long)r * 512 + h * 128; const float* o1 = p.oret + ((long)NTOK + r) * 512 + h * 128;
        float ss = 0.f;
        for (int e = 0; e < 128; ++e) { const float o = o0[e] + o1[e]; ss += o * o; }
        const float rs = rsqrtf(ss * (1.0f / 128.0f) + EPS);
        for (int e = 0; e < 128; ++e) MIXST((long)r * D + h * 128 + e, (o0[e] + o1[e]) * rs * siluf_(pxf(p.px[(long)r * PXLD + 1024 + h * 128 + e])));
    }
}
DEV void ph_swa(const P& p, int il, int nrows, long gt, long gs) {
    GSL(i, (long)nrows * 8) {
        const int hq = (int)(i % 8), r = (int)(i / 8), kv = hq >> 2; const RowInfo ri = row_info(r);
        const int b = ri.kind ? (ri.base - NLAT) / CTXL : ri.base / SEQ;
        float q[64], acc[64];
#pragma unroll
        for (int d = 0; d < 64; ++d) { q[d] = p.qs[(long)r * 512 + hq * 64 + d]; acc[d] = 0.f; }
        float m = p.swa_sink[il * 8 + hq], l = 1.0f;
        for (int part = 0; part < 2; ++part) {
            int k0, k1;
            if (part == 0) { if (ri.kind) continue; k0 = ri.base + (ri.t - 128 < 0 ? 0 : ri.t - 128); k1 = ri.base + (ri.t + 128 > SEQ - 1 ? SEQ - 1 : ri.t + 128); }
            else { k0 = NLAT + b * CTXL; k1 = k0 + CTXL - 1; }
            for (int kr = k0; kr <= k1; ++kr) {
                const float* kk = p.ks + (long)kr * 128 + kv * 64; const px_t* vv = p.px + (long)kr * PXLD + 2176 + kv * 64;
                float s = 0.f;
#pragma unroll
                for (int d = 0; d < 64; ++d) s += q[d] * kk[d];
                const float mn = fmaxf(m, s), corr = expf(m - mn), pe = expf(s - mn);
                l = l * corr + pe; m = mn;
#pragma unroll
                for (int d = 0; d < 64; ++d) acc[d] = acc[d] * corr + pe * pxf(vv[d]);
            }
        }
        const float il_ = 1.0f / l;
#pragma unroll
        for (int d = 0; d < 64; ++d) MIXST((long)r * D + 512 + hq * 64 + d, acc[d] * il_);
    }
}
DEV void ph_outproj(const P& p, int layer, const float* w, int nrows, long gt, long gs) {
    GSL(i, (long)nrows * D) {
        const int n = (int)(i % D), r = (int)(i / D); const RowInfo ri = row_info(r);
        const float* a = p.mixin + (long)r * D; const float* b = w + n;
        float acc = 0.f;
        for (int k = 0; k < D; ++k) acc += a[k] * b[(long)k * D];
        p.xa[i] += p.modv[((long)layer * 3 + ri.m) * 6 * D + 2 * D + n] * acc;
    }
}
DEV int atomic_inc(int* q) {
#ifdef CPU_SHIM
    return __atomic_fetch_add(q, 1, __ATOMIC_RELAXED);
#else
    return atomicAdd(q, 1);
#endif
}
DEV void ph_router(const P& p, int layer, int nrows, long gt, long gs) {
    const float* rw = p.router_w + (long)layer * D * NE;
    GSL(j, NSLOT) { p.slot_tok[j] = -1; p.slot_gate[j] = 0.f; }
    GSL(r, nrows) {
        float lg[NE];
#pragma unroll
        for (int e = 0; e < NE; ++e) lg[e] = p.router_b[layer * NE + e];
        const float* a = p.hx + (long)r * D;
        for (int k = 0; k < D; ++k) { const float av = a[k];
#pragma unroll
            for (int e = 0; e < NE; ++e) lg[e] += av * rw[k * NE + e]; }
        int ti[4]; float tv[4];
#pragma unroll
        for (int s = 0; s < 4; ++s) { int best = 0; float bv = -3.0e38f;
#pragma unroll
            for (int e = 0; e < NE; ++e) { if (lg[e] > bv) { bv = lg[e]; best = e; } }
            ti[s] = best; tv[s] = bv;
#pragma unroll
            for (int e = 0; e < NE; ++e) if (e == best) lg[e] = -3.0e38f; }
        const float e1 = expf(tv[1] - tv[0]), e2 = expf(tv[2] - tv[0]), e3 = expf(tv[3] - tv[0]), inv = 1.0f / (1.0f + e1 + e2 + e3);
        p.topi[r * 4 + 0] = ti[0]; p.topi[r * 4 + 1] = ti[1]; p.topi[r * 4 + 2] = ti[2]; p.topi[r * 4 + 3] = ti[3];
        p.topg[r * 4 + 0] = inv; p.topg[r * 4 + 1] = e1 * inv; p.topg[r * 4 + 2] = e2 * inv; p.topg[r * 4 + 3] = e3 * inv;
#pragma unroll
        for (int s = 0; s < 4; ++s) p.pos[r * 4 + s] = atomic_inc(p.cnt + layer * NE + ti[s]);
    }
}
DEV int moe_tiles(const int* cnt) { int t = 0; for (int e = 0; e < NE; ++e) t += (cnt[e] + 255) >> 8; return t; }
DEV int tile_expert(const int* cnt, int pm) { int t = 0; for (int e = 0; e < NE; ++e) { t += (cnt[e] + 255) >> 8; if (pm < t) return e; } return NE - 1; }
DEV void ph_assign(const P& p, int layer, int nrows, long gt, long gs) {
    const int* cnt = p.cnt + layer * NE;
    GSL(i, (long)nrows * 4) {
        const int e = p.topi[i]; int off = 0;
#pragma unroll
        for (int q = 0; q < NE; ++q) { const int cq = cnt[q]; off += q < e ? ((cq + 255) >> 8) << 8 : 0; }
        const int slot = off + p.pos[i];
        p.slot_of[i] = slot; p.slot_tok[slot] = (int)(i >> 2); p.slot_gate[slot] = p.topg[i];
    }
}
DEV void ph_gather(const P& p, int layer, long gt, long gs) {
    const long used = (long)moe_tiles(p.cnt + layer * NE) * 256;
    GSL(i, used * D) { const int k = (int)(i % D); const long slot = i / D; const int tok = p.slot_tok[slot]; p.xb[i] = tok >= 0 ? p.hxb[(long)tok * D + k] : (bf16_t)0; }
}
DEV void ph_moe1s(const P& p, int layer, long gt, long gs) {
    const int* cnt = p.cnt + layer * NE; const long used = (long)moe_tiles(cnt) * 256;
    GSL(i, used * DFF) {
        const int j = (int)(i % DFF); const long slot = i / DFF; const int e = tile_expert(cnt, (int)(slot >> 8));
        const float* w = p.w_gu + ((long)layer * NE + e) * D * 2 * DFF + j; const bf16_t* a = p.xb + slot * D;
        const float* bb = p.b_gu + ((long)layer * NE + e) * 2 * DFF;
        float ga = bb[j], up = bb[DFF + j];
        for (int k = 0; k < D; ++k) { const float av = bf2f(a[k]); ga += av * w[(long)k * 2 * DFF]; up += av * w[(long)k * 2 * DFF + DFF]; }
        ga = fminf(ga, 7.0f); up = fminf(fmaxf(up, -7.0f), 7.0f);
        p.actb[i] = f2bf(ga * sigmoidf_(1.702f * ga) * (up + 1.0f));
    }
}
DEV void ph_moe2s(const P& p, int layer, long gt, long gs) {
    const int* cnt = p.cnt + layer * NE; const long used = (long)moe_tiles(cnt) * 256;
    GSL(i, used * D) {
        const int n = (int)(i % D); const long slot = i / D; const int e = tile_expert(cnt, (int)(slot >> 8));
        const float* w = p.w_dn + ((long)layer * NE + e) * DFF * D + n; const bf16_t* a = p.actb + slot * DFF;
        float acc = p.b_dn[((long)layer * NE + e) * D + n];
        for (int k = 0; k < DFF; ++k) acc += bf2f(a[k]) * w[(long)k * D];
        p.yb[i] = f2bf(acc * p.slot_gate[slot]);
    }
}
DEV void ph_combine(const P& p, int layer, int nrows, long gt, long gs) {
    GSL(i, (long)nrows * D) {
        const int n = (int)(i % D), r = (int)(i / D); const RowInfo ri = row_info(r);
        float y = 0.f;
#pragma unroll
        for (int s = 0; s < 4; ++s) y += bf2f(p.yb[(long)p.slot_of[r * 4 + s] * D + n]);
        p.xa[i] += p.modv[((long)layer * 3 + ri.m) * 6 * D + 5 * D + n] * y;
    }
}
DEV void ph_final(const P& p, long gt, long gs) {
    GSL(i, (long)NLAT * D) { const int k = (int)(i % D), r = (int)(i / D); p.out[i] = p.xa[i] * p.rstd[r] * p.final_g[k]; }
}

constexpr int N_SETUP = 6, N_SLOT = 18;
#ifdef CPU_SHIM
#define SWA_NAIVE ph_swa(p, il, nrows, gt, gs);
#define S5_NAIVE(x) x
#define S5_FIN ph_s5out(p, il, gt, gs);
#define RET_NAIVE_A ph_retkv(p, il, gt, gs); ph_retsc(p, il, gt, gs);
#define RET_NAIVE_C ph_reto(p, il, gt, gs);
#else
#define SWA_NAIVE
#define S5_NAIVE(x)
#define S5_FIN ph_s5fin(p, il, gt, gs);
#define RET_NAIVE_A
#define RET_NAIVE_C
#endif
#ifdef CPU_SHIM
#define LCONV_LAT(p, il, gt, gs) ph_lconv_fft(p, il, gt, gs)
#else
#define LCONV_LAT(p, il, gt, gs)
#endif
template <int S> DEV void setup_slot(const P& p, long gt, long gs) {
    if constexpr (S == 0) { ph_init(p, gt, gs); ph_mod(p, gt, gs); }
    if constexpr (S == 1) { ph_mod2(p, gt, gs); ph_filt1(p, gt, gs); }
    if constexpr (S == 2) ph_filt2(p, gt, gs);
    if constexpr (S == 3) ph_filt3(p, gt, gs);
    if constexpr (S == 4) ph_filt4a(p, gt, gs);
    if constexpr (S == 5) ph_filt4(p, gt, gs);
}
template <int S> DEV void layer_slot(const P& p, int layer, long gt, long gs) {
    const int il = layer >> 1; const bool ab = !(layer & 1);
    const int nrows = layer < 3 ? NTOK : NLAT;
    if constexpr (S == 0) ph_rstd(p, NTOK, gt, gs);
    if constexpr (S == 1) ph_hx(p, layer, 0, NTOK, gt, gs);
    if constexpr (S == 2) { if (ab) ph_inproj(p, p.ab_w_in + (long)il * D * AB_IN, AB_IN, gt, gs); else ph_inproj(p, p.cd_w_in + (long)il * D * CD_IN, CD_IN, gt, gs); }
    if constexpr (S == 3) { if (ab) { ph_sconv(p, il, gt, gs); S5_NAIVE(ph_s5chunk(p, il, 0, gt, gs);) } else ph_rope(p, gt, gs); }
    if constexpr (S == 4) { if (ab) { LCONV_LAT(p, il, gt, gs); ph_lconv(p, il, NLAT, NTOK, gt, gs); ph_s5carry(p, il, gt, gs); } else { RET_NAIVE_A } }
    if constexpr (S == 5) { if (ab) { ph_hymix(p, il, gt, gs); S5_NAIVE(ph_s5chunk(p, il, 1, gt, gs);) } else { ph_retcarry(p, il, gt, gs); SWA_NAIVE } }
    if constexpr (S == 6) { if (ab) { S5_FIN } else { RET_NAIVE_C } }
    if constexpr (S == 7) { if (ab) ph_glu(p, il, gt, gs); else ph_retout(p, nrows, gt, gs); }
    if constexpr (S == 8) ph_outproj(p, layer, (ab ? p.ab_w_out : p.cd_w_out) + (long)il * D * D, nrows, gt, gs);
    if constexpr (S == 9) ph_rstd(p, nrows, gt, gs);
    if constexpr (S == 10) ph_hx(p, layer, 1, nrows, gt, gs);
    if constexpr (S == 11) ph_router(p, layer, nrows, gt, gs);
    if constexpr (S == 12) ph_assign(p, layer, nrows, gt, gs);
    if constexpr (S == 13) ph_gather(p, layer, gt, gs);
    if constexpr (S == 14) ph_moe1s(p, layer, gt, gs);
    if constexpr (S == 15) ph_moe2s(p, layer, gt, gs);
    if constexpr (S == 16) ph_combine(p, layer, nrows, gt, gs);
}
template <int S> DEV void final_slot(const P& p, long gt, long gs) {
    if constexpr (S == 0) ph_rstd(p, NLAT, gt, gs);
    if constexpr (S == 1) ph_final(p, gt, gs);
}

struct WsMap { size_t off[56]; size_t total; };
static inline WsMap ws_map() {
    WsMap m; size_t o = 0; int n = 0;
    auto take = [&](size_t bytes) { m.off[n++] = o; o += (bytes + 255) & ~(size_t)255; };
    take(16384);
    take((size_t)NTOK * D * 4);
    take((size_t)4 * 3 * 6 * D * 4);
    take((size_t)2 * (SEQ + CTXL) * 64 * 4);
    take((size_t)2 * (SEQ + CTXL) * 64 * 4);
    take((size_t)2 * (SEQ + CTXL) * HYW * 4);
    take((size_t)2 * 2 * HYW * 4);
    take((size_t)NTOK * 4);
    take((size_t)NTOK * D * 4);
    take((size_t)NTOK * PXLD * 4);
    take((size_t)NTOK * HYW * 4);
    take((size_t)NTOK * HYW * 4);
    take((size_t)NTOK * D * 4);
    take((size_t)2 * NTOK * NG * NP * 2 * 4);
    take((size_t)NTOK * S5W * 4);
    take((size_t)NTOK * 256 * 4);
    take((size_t)NTOK * 256 * 4);
    take((size_t)2 * NTOK * 512 * 4);
    take((size_t)NTOK * 512 * 4);
    take((size_t)NTOK * 128 * 4);
    take((size_t)NTOK * 4 * 4);
    take((size_t)NTOK * 4 * 4);
    take(256);
    take((size_t)(NTOK + 1) * D * 2);
    take((size_t)NTOK * D * 2);
    take((size_t)NTOK * S5W * 2);
    take((size_t)NSLOT * D * 2);
    take((size_t)NSLOT * DFF * 2);
    take((size_t)NSLOT * D * 4);
    take((size_t)NSLOT * 4);
    take((size_t)4 * NE * 4);
    take((size_t)NTOK * 4 * 4);
    take((size_t)NTOK * 4 * 4);
    take((size_t)NSLOT * 4);
    take((size_t)2 * AB_IN * D * 2);
    take((size_t)2 * CD_IN * D * 2);
    take((size_t)2 * D * D * 2);
    take((size_t)2 * D * D * 2);
    take((size_t)2 * S5W * S5W * 2);
    take((size_t)4 * NE * 2 * DFF * D * 2);
    take((size_t)4 * NE * D * DFF * 2);
    take((size_t)2 * 2 * S5NCH * NG * NP * 2 * 4);
    take((size_t)2 * 2 * RNCH * 4 * 8192 * 4);
    take((size_t)2 * NTOK * 4 * RC * 4);
    take((size_t)2 * FNSEG * HYW * 4);
    take((size_t)256 * 2 * FFTN * 4);
    take((size_t)HYW * NLAT * 4);
    take((size_t)2 * NTOK * S5W * 4);
    take((size_t)HYW * NLAT * 4);
    take((size_t)2 * HYW * SEQ * 4);
    take((size_t)8 * 4 * 3 * 6 * D * 4);
    m.total = o; return m;
}
static inline void fill_params(P& p, void* const* d_in, void* d_out, void* d_ws) {
    const float* const* in = (const float* const*)d_in;
    p.x = in[0]; p.c = in[1]; p.ctx = in[2]; p.c_ctx = in[3]; p.mod_w = in[4]; p.mod_b = in[5]; p.norm1_g = in[6]; p.norm2_g = in[7];
    p.ab_w_in = in[8]; p.ab_w_out = in[9]; p.hy_short_w = in[10]; p.hy_short_b = in[11]; p.hy_f_w1 = in[12]; p.hy_f_b1 = in[13];
    p.hy_f_w2 = in[14]; p.hy_f_b2 = in[15]; p.hy_f_w3 = in[16]; p.hy_bias = in[17]; p.s5_lre = in[18]; p.s5_lim = in[19]; p.s5_ldt = in[20];
    p.s5_bre = in[21]; p.s5_bim = in[22]; p.s5_cre = in[23]; p.s5_cim = in[24]; p.s5_d = in[25]; p.s5_glu_w = in[26]; p.s5_glu_b = in[27];
    p.cd_w_in = in[28]; p.cd_w_out = in[29]; p.ret_decay = in[30]; p.swa_sink = in[31]; p.router_w = in[32]; p.router_b = in[33];
    p.w_gu = in[34]; p.b_gu = in[35]; p.w_dn = in[36]; p.b_dn = in[37]; p.final_g = in[38];
    p.out = (float*)d_out;
    const WsMap m = ws_map(); char* w = (char*)d_ws;
    p.bar = (unsigned*)(w + m.off[0]); p.xa = (float*)(w + m.off[1]); p.modv = (float*)(w + m.off[2]); p.f1 = (float*)(w + m.off[3]); p.f2 = (float*)(w + m.off[4]);
    p.hraw = (float*)(w + m.off[5]); p.hsum = (float*)(w + m.off[6]); p.rstd = (float*)(w + m.off[7]); p.hx = (float*)(w + m.off[8]); p.px = (px_t*)(w + m.off[9]);
    p.zb = (float*)(w + m.off[10]); p.x0c = (float*)(w + m.off[11]); p.mixin = (float*)(w + m.off[12]); p.s5s = (float*)(w + m.off[13]); p.ys5 = (float*)(w + m.off[14]);
    p.qr = (float*)(w + m.off[15]); p.kr = (float*)(w + m.off[16]); p.oret = (float*)(w + m.off[17]); p.qs = (float*)(w + m.off[18]); p.ks = (float*)(w + m.off[19]);
    p.topg = (float*)(w + m.off[20]); p.topi = (int*)(w + m.off[21]); p.act = nullptr;
    p.hxb = (bf16_t*)(w + m.off[23]); p.mixb = (bf16_t*)(w + m.off[24]); p.ys5b = (bf16_t*)(w + m.off[25]); p.xb = (bf16_t*)(w + m.off[26]); p.actb = (bf16_t*)(w + m.off[27]);
    p.yb = (bf16_t*)(w + m.off[28]); p.slot_gate = (float*)(w + m.off[29]); p.cnt = (int*)(w + m.off[30]); p.pos = (int*)(w + m.off[31]); p.slot_of = (int*)(w + m.off[32]);
    p.slot_tok = (int*)(w + m.off[33]); p.abin_t = (bf16_t*)(w + m.off[34]); p.cdin_t = (bf16_t*)(w + m.off[35]); p.about_t = (bf16_t*)(w + m.off[36]);
    p.cdout_t = (bf16_t*)(w + m.off[37]); p.glu_t = (bf16_t*)(w + m.off[38]); p.wgu_t = (bf16_t*)(w + m.off[39]); p.wdn_t = (bf16_t*)(w + m.off[40]);
    p.s5c = (float*)(w + m.off[41]); p.rkv = (float*)(w + m.off[42]); p.rsc = (float*)(w + m.off[43]); p.hpart = (float*)(w + m.off[44]);
    p.zf = (float*)(w + m.off[45]); p.convT = (float*)(w + m.off[46]); p.yd = (float*)(w + m.off[47]); p.zT = (float*)(w + m.off[48]); p.hT = (float*)(w + m.off[49]); p.modp = (float*)(w + m.off[50]);
}

#ifndef CPU_SHIM
namespace pg8 {
#define PG8_LAS __attribute__((address_space(3)))
typedef short bf16x8 __attribute__((ext_vector_type(8)));
typedef float f32x4 __attribute__((ext_vector_type(4)));
constexpr int BM = 256, BK = 64, HALF = 128, HTB = HALF * BK * 2, STAGE_BYTES = 8 * HTB, NXCD = 8, WGM = 8;
__host__ __device__ __forceinline__ int lds_byte(int r, int c) { const int st = (r >> 4) * 2 + (c >> 5), rr = r & 15, cc = c & 31, ob = rr * 64 + cc * 2; return st * 1024 + (ob ^ (((ob >> 9) & 1) << 5)); }
__host__ __device__ __forceinline__ void stage_rc(int b, int& R, int& C) { const int st = b / 1024, sb = b % 1024, swz = sb ^ (((sb >> 9) & 1) << 5); R = (st >> 1) * 16 + swz / 64; C = (st & 1) * 32 + (swz % 64) / 2; }
__host__ __device__ __forceinline__ int perm32(int rho) { const int n = rho >> 4, i = rho & 15; return 8 * (i >> 2) + 4 * n + (i & 3); }
struct Unit { int pm, pn, e; };
struct Gemm { const bf16_t* A; const bf16_t* Bt; int M, N, K; size_t ebytes; };
struct StaticOrder {
    int nM, nN, nwg, G, c;
    __device__ void init(int M, int N, int G_, int c_) { nM = M / BM; nN = N / BM; nwg = nM * nN; G = G_; c = c_; }
    __device__ bool next(int i, Unit& u) const {
        const long L = (long)i * G + c; if (L >= nwg) return false;
        int wgid = (int)L; { const int q = nwg / NXCD, r = nwg % NXCD, xcd = wgid % NXCD, off = wgid / NXCD; wgid = (xcd < r ? xcd * (q + 1) : r * (q + 1) + (xcd - r) * q) + off; }
        const int nig = WGM * nN, gid = wgid / nig, fm = gid * WGM, gsz = (nM - fm) < WGM ? (nM - fm) : WGM;
        u.pm = fm + ((wgid % nig) % gsz); u.pn = (wgid % nig) / gsz; u.e = 0; return true;
    }
    __device__ int tok(int, int) const { return 0; }
};
struct MoeOrder {
    int nwg, nN, G, c; const volatile PG8_LAS unsigned char* ue; const volatile PG8_LAS int* tokt;
    __device__ int tok(int ui, int row) const { return tokt[ui * 256 + row]; }
    __device__ bool unit(int i, int& pm, int& pn) const {
        const int S = G >> 3;
        if ((G & 7) == 0 && S % nN == 0) { const int x = c & 7, slot = c >> 3, pmx = S / nN, T = nwg / nN, tpx = (T + 7) >> 3, lp = i * pmx + slot / nN;
            pm = x * tpx + lp; pn = slot % nN; return lp < tpx && pm < T; }
        const long L = (long)i * G + c; pm = (int)(L / nN); pn = (int)(L % nN); return L < nwg;
    }
    __device__ bool next(int i, Unit& u) const {
        int pm, pn; if (!unit(i, pm, pn)) return false;
        u.pm = pm; u.pn = pn; u.e = __builtin_amdgcn_readfirstlane((int)ue[pm]); return true;
    }
};
template <class Epi, class Sched, bool GATHER = false>
__device__ __forceinline__ void gemm_phase(PG8_LAS unsigned char* lds, const Gemm g, const Sched& S, const Epi& E) {
    int tid = threadIdx.x; asm volatile("" : "+v"(tid));
    const int wid = __builtin_amdgcn_readfirstlane(tid >> 6), lane = tid & 63, wr = wid >> 2, wc = wid & 3, fr = lane & 15, fq = lane >> 4;
    const int K = g.K, nt = K / BK;
    unsigned va[2][2], vn[2][2], voffB[2], voffA0[2]; int Rr[2]; unsigned Cb[2];
#pragma unroll
    for (int i = 0; i < 2; ++i) { int R, C; stage_rc(tid * 16 + i * 8192, R, C); Rr[i] = R; Cb[i] = (unsigned)C * 2u; const int Rb = Epi::PERM ? ((R & ~31) + perm32(R & 31)) : R; voffB[i] = (unsigned)(Rb * K + C) * 2u; voffA0[i] = (unsigned)(R * K + C) * 2u; }
    const size_t kstep = (size_t)(BK * 2);
    const size_t hstep = (size_t)HALF * K * 2;
    const size_t tstep = 2 * hstep;
#define PG8_SETOFF(v, ui_) do { _Pragma("unroll") for (int h_ = 0; h_ < 2; ++h_) _Pragma("unroll") for (int i_ = 0; i_ < 2; ++i_) \
        v[h_][i_] = GATHER ? (unsigned)S.tok(ui_, h_ * HALF + Rr[i_]) * (unsigned)(K * 2) + Cb[i_] : voffA0[i_] + (unsigned)(h_ * hstep); } while (0)
    const unsigned ldsw = (unsigned)wid * 1024u;
    const int aoff = lds_byte(wr * 64 + fr, fq * 8), boff = lds_byte(wc * 32 + fr, fq * 8);
#define PG8_SA(b, h) (((b) * 2 + (h)) * HTB)
#define PG8_SB(b, h) ((4 + (b) * 2 + (h)) * HTB)
#define PG8_STAGE(bufoff, gbase, voff) do { _Pragma("unroll") for (int _i = 0; _i < 2; ++_i) \
        __builtin_amdgcn_global_load_lds((const unsigned*)((const char*)(gbase) + (voff)[_i]), (PG8_LAS unsigned*)(lds + (bufoff) + ldsw + _i * 8192), 16, 0, 0); } while (0)
#define PG8_LDA(dst, b, h) do { _Pragma("unroll") for (int m = 0; m < 4; ++m) _Pragma("unroll") for (int k = 0; k < 2; ++k) dst[m][k] = *(const PG8_LAS bf16x8*)(lds + PG8_SA(b, h) + aoff + m * 2048 + k * 1024); } while (0)
#define PG8_LDB(dst, b, h) do { _Pragma("unroll") for (int n = 0; n < 2; ++n) _Pragma("unroll") for (int k = 0; k < 2; ++k) dst[n][k] = *(const PG8_LAS bf16x8*)(lds + PG8_SB(b, h) + boff + n * 2048 + k * 1024); } while (0)
#define PG8_MMA(ai, bj, At, Bt) do { __builtin_amdgcn_s_setprio(1); _Pragma("unroll") for (int m = 0; m < 4; ++m) _Pragma("unroll") for (int n = 0; n < 2; ++n) _Pragma("unroll") for (int k = 0; k < 2; ++k) \
        acc[ai][bj][m][n] = __builtin_amdgcn_mfma_f32_16x16x32_bf16(Bt[n][k], At[m][k], acc[ai][bj][m][n], 0, 0, 0); __builtin_amdgcn_s_setprio(0); } while (0)
#define PG8_WAIT_V(n) asm volatile("s_waitcnt vmcnt(" #n ")" ::: "memory")
#define PG8_WAIT_L(n) asm volatile("s_waitcnt lgkmcnt(" #n ")" ::: "memory")
#define PG8_BAR __builtin_amdgcn_s_barrier()
#define PG8_SCHED __builtin_amdgcn_sched_barrier(0)
    Unit cur, nxt; int ui = 0;
    if (!S.next(0, cur)) return;
    f32x4 acc[2][2][4][2];
#pragma unroll
    for (int a = 0; a < 2; ++a)
#pragma unroll
        for (int b = 0; b < 2; ++b)
#pragma unroll
            for (int m = 0; m < 4; ++m)
#pragma unroll
                for (int n = 0; n < 2; ++n) acc[a][b][m][n] = (f32x4){0.f, 0.f, 0.f, 0.f};
    bf16x8 At[4][2], B0[2][2], B1[2][2];
    const char* cA = (const char*)g.A + (GATHER ? (size_t)0 : (size_t)cur.pm * tstep); const char* cB = (const char*)g.Bt + (size_t)cur.e * g.ebytes + (size_t)cur.pn * tstep;
    PG8_SETOFF(va, 0);
    PG8_STAGE(PG8_SB(0, 0), cB, voffB); PG8_STAGE(PG8_SB(0, 1), cB + hstep, voffB); PG8_STAGE(PG8_SA(0, 0), cA, va[0]); PG8_STAGE(PG8_SA(0, 1), cA, va[1]);
    if (wr == 1) PG8_BAR;
    PG8_WAIT_V(2); PG8_BAR;
    PG8_STAGE(PG8_SB(1, 0), cB + kstep, voffB); PG8_STAGE(PG8_SA(1, 0), cA + kstep, va[0]); PG8_STAGE(PG8_SB(1, 1), cB + hstep + kstep, voffB);
    PG8_WAIT_V(6); PG8_BAR;
    for (;;) {
        const bool has_next = S.next(ui + 1, nxt);
        const char* nA = has_next ? (const char*)g.A + (GATHER ? (size_t)0 : (size_t)nxt.pm * tstep) : cA; const char* nB = has_next ? (const char*)g.Bt + (size_t)nxt.e * g.ebytes + (size_t)nxt.pn * tstep : cB;
        if (GATHER && has_next) PG8_SETOFF(vn, ui + 1); else { _Pragma("unroll") for (int h_ = 0; h_ < 2; ++h_) _Pragma("unroll") for (int i_ = 0; i_ < 2; ++i_) vn[h_][i_] = va[h_][i_]; }
        for (int t = 0; t < nt; t += 2) {
            const bool last = (t == nt - 2);
            const char* a1 = cA + (size_t)(t + 1) * kstep;
            const char* a2 = last ? nA : cA + (size_t)(t + 2) * kstep; const char* b2 = last ? nB : cB + (size_t)(t + 2) * kstep;
            const char* a3 = a2 + kstep; const char* b3 = b2 + kstep;
            unsigned s0[2], s1[2];
#pragma unroll
            for (int i_ = 0; i_ < 2; ++i_) { s0[i_] = last ? vn[0][i_] : va[0][i_]; s1[i_] = last ? vn[1][i_] : va[1][i_]; }
            PG8_LDB(B0, 0, 0); PG8_LDB(B1, 0, 1); PG8_SCHED; PG8_LDA(At, 0, 0); PG8_STAGE(PG8_SA(1, 1), a1, va[1]);
            PG8_WAIT_V(8); PG8_WAIT_L(0); PG8_BAR; PG8_MMA(0, 0, At, B0); PG8_MMA(0, 1, At, B1); PG8_BAR; PG8_SCHED;
            PG8_LDA(At, 0, 1); PG8_STAGE(PG8_SB(0, 0), b2, voffB); PG8_STAGE(PG8_SB(0, 1), b2 + hstep, voffB); PG8_STAGE(PG8_SA(0, 0), a2, s0);
            PG8_WAIT_V(8); PG8_WAIT_L(0); PG8_BAR; PG8_MMA(1, 0, At, B0); PG8_MMA(1, 1, At, B1); PG8_BAR; PG8_SCHED;
            PG8_LDB(B0, 1, 0); PG8_LDB(B1, 1, 1); PG8_SCHED; PG8_LDA(At, 1, 0); PG8_STAGE(PG8_SA(0, 1), a2, s1);
            PG8_WAIT_V(8); PG8_WAIT_L(0); PG8_BAR; PG8_MMA(0, 0, At, B0); PG8_MMA(0, 1, At, B1); PG8_BAR; PG8_SCHED;
            PG8_LDA(At, 1, 1); PG8_STAGE(PG8_SB(1, 0), b3, voffB); PG8_STAGE(PG8_SB(1, 1), b3 + hstep, voffB); PG8_STAGE(PG8_SA(1, 0), a3, s0);
            PG8_WAIT_V(8); PG8_WAIT_L(0); PG8_BAR; PG8_MMA(1, 0, At, B0); PG8_MMA(1, 1, At, B1); PG8_BAR; PG8_SCHED;
        }
        if (wr == 0) PG8_BAR;
        E(acc, cur, wr, wc, fr, fq);
        if (!has_next) break;
#pragma unroll
        for (int a = 0; a < 2; ++a)
#pragma unroll
            for (int b = 0; b < 2; ++b)
#pragma unroll
                for (int m = 0; m < 4; ++m)
#pragma unroll
                    for (int n = 0; n < 2; ++n) acc[a][b][m][n] = (f32x4){0.f, 0.f, 0.f, 0.f};
        cur = nxt; cA = nA; cB = nB; ++ui;
#pragma unroll
        for (int h_ = 0; h_ < 2; ++h_)
#pragma unroll
            for (int i_ = 0; i_ < 2; ++i_) va[h_][i_] = vn[h_][i_];
        if (wr == 1) PG8_BAR;
    }
    PG8_WAIT_V(0);
    PG8_BAR;
#undef PG8_SA
#undef PG8_SB
#undef PG8_STAGE
#undef PG8_SETOFF
#undef PG8_LDA
#undef PG8_LDB
#undef PG8_MMA
#undef PG8_WAIT_V
#undef PG8_WAIT_L
#undef PG8_BAR
#undef PG8_SCHED
}
typedef float f32x2v __attribute__((ext_vector_type(2)));
typedef __bf16 bf16x2v __attribute__((ext_vector_type(2)));
__device__ __forceinline__ unsigned cvt_pk_bf16(float lo, float hi) { const bf16x2v r = __builtin_convertvector((f32x2v){lo, hi}, bf16x2v); return __builtin_bit_cast(unsigned, r); }
__device__ __forceinline__ float fast_sigmoid(float x) { return __builtin_amdgcn_rcpf(1.0f + __builtin_amdgcn_exp2f(-1.4426950408889634f * x)); }
#define EPI_LOOP(body) _Pragma("unroll") for (int ai = 0; ai < 2; ++ai) _Pragma("unroll") for (int m = 0; m < 4; ++m) { const int row = row0 + ai * HALF + m * 16; \
    _Pragma("unroll") for (int bj = 0; bj < 2; ++bj) _Pragma("unroll") for (int n = 0; n < 2; ++n) { const int col = col0 + bj * HALF + n * 16; const f32x4 a = acc[ai][bj][m][n]; body } }
#define EPI_LOOP_P(body) _Pragma("unroll") for (int ai = 0; ai < 2; ++ai) _Pragma("unroll") for (int m = 0; m < 4; ++m) { const int row = row0 + ai * HALF + m * 16; \
    _Pragma("unroll") for (int bj = 0; bj < 2; ++bj) _Pragma("unroll") for (int n = 0; n < 2; ++n) { const int col = col0 + bj * HALF + n * 4; const f32x4 a = acc[ai][bj][m][n]; body } }
struct EpiStoreF32 {
    static constexpr bool PERM = false;
    float* C; int ldc;
    __device__ __forceinline__ void operator()(const f32x4 (&acc)[2][2][4][2], const Unit& u, int wr, int wc, int fr, int fq) const {
        const int row0 = u.pm * BM + wr * 64 + fr, col0 = u.pn * BM + wc * 32 + 4 * fq;
        EPI_LOOP( *(f32x4*)(C + (size_t)row * ldc + col) = a; )
    }
};
struct EpiStoreBf16 {
    static constexpr bool PERM = true;
    bf16_t* C; int ldc;
    __device__ __forceinline__ void operator()(const f32x4 (&acc)[2][2][4][2], const Unit& u, int wr, int wc, int fr, int fq) const {
        const int row0 = u.pm * BM + wr * 64 + fr, col0 = u.pn * BM + wc * 32 + 8 * fq;
        EPI_LOOP_P( uint2 o; o.x = cvt_pk_bf16(a[0], a[1]); o.y = cvt_pk_bf16(a[2], a[3]); *(uint2*)(C + (size_t)row * ldc + col) = o; )
    }
};
struct EpiResid {
    static constexpr bool PERM = false;
    float* X; const float* gv;
    __device__ __forceinline__ void operator()(const f32x4 (&acc)[2][2][4][2], const Unit& u, int wr, int wc, int fr, int fq) const {
        const int row0 = u.pm * BM + wr * 64 + fr, col0 = u.pn * BM + wc * 32 + 4 * fq;
        const int r0 = u.pm * BM, mrow = r0 < SEQ ? 0 : (r0 < NLAT ? 1 : 2); const float* g = gv + (size_t)mrow * 6 * D;
        EPI_LOOP( const f32x4 gg = *(const f32x4*)(g + col); f32x4* q = (f32x4*)(X + (size_t)row * D + col); *q = *q + gg * a; )
    }
};
struct EpiGlu {
    static constexpr bool PERM = true;
    bf16_t* O; const bf16_t* Y; const float* bias;
    __device__ __forceinline__ void operator()(const f32x4 (&acc)[2][2][4][2], const Unit& u, int wr, int wc, int fr, int fq) const {
        const int row0 = u.pm * BM + wr * 64 + fr, col0 = u.pn * BM + wc * 32 + 8 * fq;
        EPI_LOOP_P( const f32x4 bb = *(const f32x4*)(bias + col); const ushort4 yv = *(const ushort4*)(Y + (size_t)row * S5W + col);
            uint2 o; o.x = cvt_pk_bf16(bf2f(yv.x) * fast_sigmoid(a[0] + bb[0]), bf2f(yv.y) * fast_sigmoid(a[1] + bb[1])); o.y = cvt_pk_bf16(bf2f(yv.z) * fast_sigmoid(a[2] + bb[2]), bf2f(yv.w) * fast_sigmoid(a[3] + bb[3]));
            *(uint2*)(O + (size_t)row * D + HYW + col) = o; )
    }
};
struct EpiSwiglu {
    static constexpr bool PERM = true;
    bf16_t* O; const float* bgu;
    __device__ __forceinline__ void operator()(const f32x4 (&acc)[2][2][4][2], const Unit& u, int wr, int wc, int fr, int fq) const {
        const int row0 = u.pm * BM + wr * 64 + fr, colb = wc * 32 + 8 * fq; const float* bb = bgu + (size_t)u.e * 2 * DFF + u.pn * 128;
#pragma unroll
        for (int ai = 0; ai < 2; ++ai)
#pragma unroll
            for (int m = 0; m < 4; ++m) { const int row = row0 + ai * HALF + m * 16;
#pragma unroll
                for (int n = 0; n < 2; ++n) { const int cc = colb + n * 4; const f32x4 bg = *(const f32x4*)(bb + cc), bu = *(const f32x4*)(bb + DFF + cc);
                    const f32x4 ga = acc[ai][0][m][n] + bg, up = acc[ai][1][m][n] + bu; float av[4];
#pragma unroll
                    for (int j = 0; j < 4; ++j) { const float gg = fminf(ga[j], 7.0f), uu = fminf(fmaxf(up[j], -7.0f), 7.0f); av[j] = gg * fast_sigmoid(1.702f * gg) * (uu + 1.0f); }
                    uint2 o; o.x = cvt_pk_bf16(av[0], av[1]); o.y = cvt_pk_bf16(av[2], av[3]);
                    *(uint2*)(O + (size_t)row * DFF + u.pn * 128 + cc) = o; } }
    }
};
struct EpiDown {
    static constexpr bool PERM = true;
    bf16_t* Y; const float* bdn; const float* gate;
    __device__ __forceinline__ void operator()(const f32x4 (&acc)[2][2][4][2], const Unit& u, int wr, int wc, int fr, int fq) const {
        const int row0 = u.pm * BM + wr * 64 + fr, col0 = u.pn * BM + wc * 32 + 8 * fq; const float* bb = bdn + (size_t)u.e * D;
        EPI_LOOP_P( const f32x4 bv = *(const f32x4*)(bb + col); const float gt_ = gate[row]; const f32x4 o = (a + bv) * gt_; uint2 ob; ob.x = cvt_pk_bf16(o[0], o[1]); ob.y = cvt_pk_bf16(o[2], o[3]); *(uint2*)(Y + (size_t)row * D + col) = ob; )
    }
};
}

constexpr int RING_BYTES = 131072, SCRATCH_BYTES = 135168, MISC_OFF = SCRATCH_BYTES, UE_OFF = MISC_OFF + 64, TOK_OFF = UE_OFF + 320, TOK_UNITS = 11, LDS_BYTES = 147456;
static_assert(FFT_ELEMS * 8 <= SCRATCH_BYTES && TOK_OFF + TOK_UNITS * 1024 <= LDS_BYTES && ((NSLOT / 256 + 7) / 8 + 3) / 4 <= TOK_UNITS, "LDS map");
#define LAS __attribute__((address_space(3)))

__device__ __forceinline__ void transpose_item(const float* W, int K, int N, bf16_t* WT, int gu_perm, LAS float* scr, int item, int lane) {
    const int nblk = N / 32, kb = item / nblk, nb = item % nblk, k0 = 64 * kb, n0 = 32 * nb;
    const int r0 = gu_perm ? (n0 < DFF ? (n0 / 128) * 256 + (n0 % 128) : ((n0 - DFF) / 128) * 256 + 128 + ((n0 - DFF) % 128)) : n0;
#pragma unroll 8
    for (int i = 0; i < 32; ++i) { const int kk = 2 * i + (lane >> 5); scr[kk * 33 + (lane & 31)] = W[(size_t)(k0 + kk) * N + n0 + (lane & 31)]; }
    asm volatile("s_waitcnt lgkmcnt(0)" ::: "memory");
    const int c = lane & 7;
#pragma unroll
    for (int j = 0; j < 4; ++j) { const int n = (lane >> 3) + 8 * j; const LAS float* s = scr + (8 * c) * 33 + n;
        uint4 o; o.x = f2bf(s[0 * 33]) | ((unsigned)f2bf(s[1 * 33]) << 16); o.y = f2bf(s[2 * 33]) | ((unsigned)f2bf(s[3 * 33]) << 16);
        o.z = f2bf(s[4 * 33]) | ((unsigned)f2bf(s[5 * 33]) << 16); o.w = f2bf(s[6 * 33]) | ((unsigned)f2bf(s[7 * 33]) << 16);
        *(uint4*)(WT + (size_t)(r0 + n) * K + k0 + 8 * c) = o; }
    asm volatile("s_waitcnt lgkmcnt(0)" ::: "memory");
}
constexpr int I_GU = (D / 64) * (2 * DFF / 32), I_DN = (DFF / 64) * (D / 32), EXP_ITEMS = NE * (I_GU + I_DN);
__device__ __forceinline__ void convert_expert_item(const P& p, int l, int q, LAS float* scr, int lane) {
    if (q < NE * I_GU) { const int e = q / I_GU; const size_t i = (size_t)l * NE + e; transpose_item(p.w_gu + i * D * 2 * DFF, D, 2 * DFF, p.wgu_t + i * 2 * DFF * D, 1, scr, q % I_GU, lane); }
    else { const int q2 = q - NE * I_GU, e = q2 / I_DN; const size_t i = (size_t)l * NE + e; transpose_item(p.w_dn + i * DFF * D, DFF, D, p.wdn_t + i * D * DFF, 0, scr, q2 % I_DN, lane); }
}
constexpr int DEFER_Q1 = 64, DEFER_Q2 = 140;
__device__ __forceinline__ int defer_idle(int units, int G) { const int rem = units % G; return rem ? G - rem : 0; }
__device__ __forceinline__ int defer_in_units(int layer) { return (NTOK / 256) * ((layer & 1) ? CD_IN / 256 : AB_IN / 256); }
__device__ __forceinline__ int defer_d1(int layer, int G) { const int n = defer_idle(defer_in_units(layer), G) * DEFER_Q1; return n < EXP_ITEMS ? n : EXP_ITEMS; }
__device__ __forceinline__ int defer_d2(int layer, int G) { const int d1 = defer_d1(layer, G), n = d1 + defer_idle((NTOK / 256) * (D / 256), G) * DEFER_Q2; return n < EXP_ITEMS ? n : EXP_ITEMS; }
__device__ __forceinline__ void convert_deferred(const P& p, LAS unsigned char* lds, int layer, int which) {
    int tid = threadIdx.x; asm volatile("" : "+v"(tid));
    int bx_ = (int)blockIdx.x, gx_ = (int)gridDim.x; asm volatile("" : "+s"(bx_), "+s"(gx_));
    const int units = which ? (NTOK / 256) * (D / 256) : defer_in_units(layer), rem = units % gx_;
    if (rem == 0 || bx_ < rem) return;
    const int lane = tid & 63, wave = tid >> 6; LAS float* scr = (LAS float*)(lds + wave * 16384);
    const int qn = which ? DEFER_Q2 : DEFER_Q1, q0 = (which ? defer_d1(layer, gx_) : 0) + (bx_ - rem) * qn, qend = which ? defer_d2(layer, gx_) : defer_d1(layer, gx_);
    for (int q = q0 + wave; q < q0 + qn && q < qend; q += 8) convert_expert_item(p, layer + 1, q, scr, lane);
}
__device__ __forceinline__ void ph_convert_weights(const P& p, LAS unsigned char* lds) {
    int tid = threadIdx.x; asm volatile("" : "+v"(tid));
    const int lane = tid & 63, wave = tid >> 6;
    LAS float* scr = (LAS float*)(lds + wave * 16384);
    const long gw = (long)blockIdx.x * 8 + wave, NGW = (long)gridDim.x * 8; const int G = (int)gridDim.x;
    constexpr long I_ABIN = (D / 64) * (AB_IN / 32), I_CDIN = (D / 64) * (CD_IN / 32), I_OUT = (D / 64) * (D / 32), I_GLU = (S5W / 64) * (S5W / 32);
    constexpr long T0 = 2 * I_ABIN, T1 = T0 + 2 * I_CDIN, T2 = T1 + 2 * I_OUT, T3 = T2 + 2 * I_OUT, T4 = T3 + 2 * I_GLU;
    for (long it = gw; it < T4; it += NGW) {
        if (it < T0) { const int i = (int)(it / I_ABIN); transpose_item(p.ab_w_in + (size_t)i * D * AB_IN, D, AB_IN, p.abin_t + (size_t)i * AB_IN * D, 0, scr, (int)(it % I_ABIN), lane); }
        else if (it < T1) { const long r = it - T0; const int i = (int)(r / I_CDIN); transpose_item(p.cd_w_in + (size_t)i * D * CD_IN, D, CD_IN, p.cdin_t + (size_t)i * CD_IN * D, 0, scr, (int)(r % I_CDIN), lane); }
        else if (it < T2) { const long r = it - T1; const int i = (int)(r / I_OUT); transpose_item(p.ab_w_out + (size_t)i * D * D, D, D, p.about_t + (size_t)i * D * D, 0, scr, (int)(r % I_OUT), lane); }
        else if (it < T3) { const long r = it - T2; const int i = (int)(r / I_OUT); transpose_item(p.cd_w_out + (size_t)i * D * D, D, D, p.cdout_t + (size_t)i * D * D, 0, scr, (int)(r % I_OUT), lane); }
        else { const long r = it - T3; const int i = (int)(r / I_GLU); transpose_item(p.s5_glu_w + (size_t)i * S5W * S5W, S5W, S5W, p.glu_t + (size_t)i * S5W * S5W, 0, scr, (int)(r % I_GLU), lane); }
    }
    for (int l = 0; l < 4; ++l) { const int qs = l ? defer_d2(l - 1, G) : 0;
        for (long q = qs + gw; q < EXP_ITEMS; q += NGW) convert_expert_item(p, l, (int)q, scr, lane); }
}
constexpr int NTHREADS = 512;
__device__ __forceinline__ float wave_sum(float v) {
#pragma unroll
    for (int o = 1; o < 64; o <<= 1) v += __shfl_xor(v, o);
    return v;
}
template <int CTRL> __device__ __forceinline__ float dppf(float v) { return __builtin_bit_cast(float, __builtin_amdgcn_update_dpp(0, __builtin_bit_cast(int, v), CTRL, 0xf, 0xf, false)); }
template <int CTRL> __device__ __forceinline__ int dppi(int v) { return __builtin_amdgcn_update_dpp(0, v, CTRL, 0xf, 0xf, false); }
__device__ __forceinline__ float row16_max(float x) { x = fmaxf(x, dppf<0xB1>(x)); x = fmaxf(x, dppf<0x4E>(x)); x = fmaxf(x, dppf<0x141>(x)); x = fmaxf(x, dppf<0x140>(x)); return x; }
__device__ __forceinline__ float row16_sum(float x) { x += dppf<0xB1>(x); x += dppf<0x4E>(x); x += dppf<0x141>(x); x += dppf<0x140>(x); return x; }
__device__ __forceinline__ int row16_min(int x) { x = min(x, dppi<0xB1>(x)); x = min(x, dppi<0x4E>(x)); x = min(x, dppi<0x141>(x)); x = min(x, dppi<0x140>(x)); return x; }
template <int L> __device__ __forceinline__ float rowb(float v) { return __builtin_bit_cast(float, __builtin_amdgcn_update_dpp(0, __builtin_bit_cast(int, v), 0x150 + L, 0xf, 0xf, false)); }
template <int L> __device__ __forceinline__ void route_steps(float val, const LAS float* wq, float& a0, float& a1) {
    const float xb = rowb<L>(val); const pg8::f32x2v w = *(const LAS pg8::f32x2v*)(wq + (4 * L) * 32);
    a0 += xb * w.x; a1 += xb * w.y;
    if constexpr (L + 1 < 16) route_steps<L + 1>(val, wq, a0, a1);
}
template <int MODE> __device__ __forceinline__ void mf_rownorm(const P& p, LAS unsigned char* lds, int layer, int nrows, int comb_layer) {
    constexpr bool ROUTE = MODE == 1; constexpr int which = MODE == 1 ? 1 : 0;
    int tid = threadIdx.x; asm volatile("" : "+v"(tid));
    int bx_ = (int)blockIdx.x, gx_ = (int)gridDim.x; asm volatile("" : "+s"(bx_), "+s"(gx_));
    const int lane = tid & 63, wave = tid >> 6;
    if (ROUTE) { for (int j = bx_ * NTHREADS + tid; j < NSLOT; j += gx_ * NTHREADS) { p.slot_tok[j] = -1; p.slot_gate[j] = 0.f; } }
    const float* gn = MODE == 2 ? p.final_g : (which ? p.norm2_g : p.norm1_g) + layer * D;
    LAS float* Wl = (LAS float*)lds;
    if (ROUTE) { const float* rw = p.router_w + (size_t)layer * D * NE;
        for (int i = tid; i < D * NE / 4; i += NTHREADS) { const float4 w4 = *(const float4*)(rw + 4 * i); const int k = i >> 3, e0 = (i & 7) * 4, kp = k ^ ((k >> 6) & 1);
            const float wv[4] = {w4.x, w4.y, w4.z, w4.w};
#pragma unroll
            for (int t = 0; t < 4; ++t) { const int e = e0 + t; Wl[kp * 32 + 2 * (e & 15) + (e >> 4)] = wv[t]; } }
        __syncthreads(); }
    volatile LAS int* lcnt = (volatile LAS int*)(lds + RING_BYTES);
    volatile LAS int* lbase = lcnt + NE; volatile LAS int* lrank = lcnt + 2 * NE;
    if (ROUTE) { if (tid < NE) lcnt[tid] = 0; __syncthreads(); }
    for (int r = bx_ * 8 + wave; r < nrows; r += gx_ * 8) {
        const int m = r < SEQ ? 0 : (r < NLAT ? 1 : 2);
        const float* mv = p.modv + ((size_t)layer * 3 + m) * 6 * D + which * 3 * D;
        float* xr = p.xa + (size_t)r * D;
        float4 v[4]; float ss = 0.f;
#pragma unroll
        for (int j = 0; j < 4; ++j) v[j] = *(const float4*)(xr + 256 * j + 4 * lane);
        if (comb_layer >= 0) {
            const float* g2 = p.modv + ((size_t)comb_layer * 3 + m) * 6 * D + 5 * D;
            const int4 so = *(const int4*)(p.slot_of + r * 4);
            const bf16_t* y0 = p.yb + (size_t)so.x * D; const bf16_t* y1 = p.yb + (size_t)so.y * D; const bf16_t* y2 = p.yb + (size_t)so.z * D; const bf16_t* y3 = p.yb + (size_t)so.w * D;
#pragma unroll
            for (int j = 0; j < 4; ++j) { const int k = 256 * j + 4 * lane; const ushort4 a = *(const ushort4*)(y0 + k), b = *(const ushort4*)(y1 + k), c = *(const ushort4*)(y2 + k), d = *(const ushort4*)(y3 + k); const float4 gg = *(const float4*)(g2 + k);
                v[j].x += gg.x * (bf2f(a.x) + bf2f(b.x) + bf2f(c.x) + bf2f(d.x)); v[j].y += gg.y * (bf2f(a.y) + bf2f(b.y) + bf2f(c.y) + bf2f(d.y));
                v[j].z += gg.z * (bf2f(a.z) + bf2f(b.z) + bf2f(c.z) + bf2f(d.z)); v[j].w += gg.w * (bf2f(a.w) + bf2f(b.w) + bf2f(c.w) + bf2f(d.w));
                if (MODE != 2) *(float4*)(xr + k) = v[j]; }
        }
#pragma unroll
        for (int j = 0; j < 4; ++j) ss += v[j].x * v[j].x + v[j].y * v[j].y + v[j].z * v[j].z + v[j].w * v[j].w;
        const float rstd = rsqrtf(wave_sum(ss) * (1.0f / D) + EPS);
        if (MODE == 2) {
#pragma unroll
            for (int j = 0; j < 4; ++j) { const int k = 256 * j + 4 * lane; const float4 g4 = *(const float4*)(gn + k);
                float4 o; o.x = v[j].x * rstd * g4.x; o.y = v[j].y * rstd * g4.y; o.z = v[j].z * rstd * g4.z; o.w = v[j].w * rstd * g4.w;
                *(float4*)(p.out + (size_t)r * D + k) = o; }
            continue;
        }
#pragma unroll
        for (int j = 0; j < 4; ++j) { const int k = 256 * j + 4 * lane; const float4 g4 = *(const float4*)(gn + k), sc = *(const float4*)(mv + D + k), sh = *(const float4*)(mv + k);
            v[j].x = v[j].x * rstd * g4.x * (1.0f + sc.x) + sh.x; v[j].y = v[j].y * rstd * g4.y * (1.0f + sc.y) + sh.y;
            v[j].z = v[j].z * rstd * g4.z * (1.0f + sc.z) + sh.z; v[j].w = v[j].w * rstd * g4.w * (1.0f + sc.w) + sh.w;
            ushort4 o; o.x = f2bf(v[j].x); o.y = f2bf(v[j].y); o.z = f2bf(v[j].z); o.w = f2bf(v[j].w);
            *(ushort4*)(p.hxb + (size_t)r * D + k) = o; }
        if (ROUTE) {
            const int cl = lane & 15, Rr = lane >> 4, r1 = Rr & 1;
            const LAS float* wbE = Wl + (64 * Rr) * 32 + 2 * cl + r1 * 32;
            const LAS float* wbO = Wl + (64 * Rr) * 32 + 2 * cl - r1 * 32;
            float acc0 = 0.f, acc1 = 0.f;
#pragma unroll
            for (int j = 0; j < 4; ++j) { const float vq[4] = {v[j].x, v[j].y, v[j].z, v[j].w};
#pragma unroll
                for (int q = 0; q < 4; ++q) { route_steps<0>(vq[q], ((q & 1) ? wbO : wbE) + (256 * j + q) * 32, acc0, acc1); __builtin_amdgcn_sched_barrier(0); } }
            acc0 += __shfl_xor(acc0, 16); acc0 += __shfl_xor(acc0, 32); acc1 += __shfl_xor(acc1, 16); acc1 += __shfl_xor(acc1, 32);
            acc0 += p.router_b[layer * NE + cl]; acc1 += p.router_b[layer * NE + 16 + cl];
            int ti[4]; float tv[4];
#pragma unroll
            for (int s = 0; s < 4; ++s) {
                const float vmax = row16_max(fmaxf(acc0, acc1));
                const int cand = acc0 == vmax ? cl : (acc1 == vmax ? cl + 16 : 64), best = row16_min(cand);
                ti[s] = best; tv[s] = vmax;
                if (best == cl) acc0 = -3.0e38f; if (best == cl + 16) acc1 = -3.0e38f;
            }
            if (lane == 0) {
                const float e1 = expf(tv[1] - tv[0]), e2 = expf(tv[2] - tv[0]), e3 = expf(tv[3] - tv[0]), inv = 1.0f / (1.0f + e1 + e2 + e3);
                p.topi[r * 4 + 0] = ti[0]; p.topi[r * 4 + 1] = ti[1]; p.topi[r * 4 + 2] = ti[2]; p.topi[r * 4 + 3] = ti[3];
                p.topg[r * 4 + 0] = inv; p.topg[r * 4 + 1] = e1 * inv; p.topg[r * 4 + 2] = e2 * inv; p.topg[r * 4 + 3] = e3 * inv;
                const int li = ((r - (bx_ * 8 + wave)) / (gx_ * 8)) * 8 + wave;
#pragma unroll
                for (int s = 0; s < 4; ++s) lrank[li * 4 + s] = __hip_atomic_fetch_add((LAS int*)(lcnt + ti[s]), 1, __ATOMIC_RELAXED, __HIP_MEMORY_SCOPE_WORKGROUP);
            }
        }
    }
    if (ROUTE) {
        __syncthreads();
        if (tid < NE) lbase[tid] = atomicAdd(p.cnt + layer * NE + tid, lcnt[tid]);
        __syncthreads();
        const int nmine = (nrows - bx_ * 8 + gx_ * 8 - 1) / (gx_ * 8) * 8;
        for (int i = tid; i < nmine * 4; i += NTHREADS) { const int li = i >> 2, r = bx_ * 8 + (li & 7) + (li >> 3) * gx_ * 8;
            if (r < nrows) p.pos[r * 4 + (i & 3)] = lbase[p.topi[i - li * 4 + r * 4]] + lrank[i]; }
    }
}
__device__ __forceinline__ float4 ld4px(const float* q) { return *(const float4*)q; }
__device__ __forceinline__ float4 ld4px(const bf16_t* q) { const ushort4 v = *(const ushort4*)q; return make_float4(bf2f(v.x), bf2f(v.y), bf2f(v.z), bf2f(v.w)); }
typedef unsigned short us4v __attribute__((ext_vector_type(4)));
__device__ __forceinline__ us4v pack4(float4 v) { return (us4v){f2bf(v.x), f2bf(v.y), f2bf(v.z), f2bf(v.w)}; }
template <int K> __device__ __forceinline__ pg8::f32x4 mma16(const LAS bf16_t* A, int lda, const LAS bf16_t* Bt, int ldb, pg8::f32x4 acc, int lane) {
    const int r = lane & 15, q = lane >> 4;
    const LAS bf16_t* ap = A + r * lda + 8 * q; const LAS bf16_t* bp = Bt + r * ldb + 8 * q;
#pragma unroll
    for (int k0 = 0; k0 < K; k0 += 32) acc = __builtin_amdgcn_mfma_f32_16x16x32_bf16(*(const LAS pg8::bf16x8*)(ap + k0), *(const LAS pg8::bf16x8*)(bp + k0), acc, 0, 0, 0);
    return acc;
}
constexpr int RLD = 136, RLQ = 72;
__device__ __forceinline__ void mf_retkv(const P& p, LAS unsigned char* lds, int il) {
    int tid = threadIdx.x; asm volatile("" : "+v"(tid));
    int bx_ = (int)blockIdx.x, gx_ = (int)gridDim.x; asm volatile("" : "+s"(bx_), "+s"(gx_));
    const int lane = tid & 63, wave = tid >> 6, r = lane & 15, q = lane >> 4;
    LAS bf16_t* KdT = (LAS bf16_t*)lds; LAS bf16_t* VT = KdT + 64 * RLD;
    for (int u = bx_; u < 16 * RNCH; u += gx_) {
        const int n = u % RNCH, h = (u / RNCH) & 3, b = (u / (RNCH * 4)) & 1, dir = u / (RNCH * 8);
        const float lg = ret_logg(p, il, dir, h);
        __syncthreads();
        for (int idx = tid; idx < 128 * 16; idx += NTHREADS) { const int j = idx >> 4, d4 = idx & 15, row = scan_row(dir, b, n * RC + j);
            const float4 kv = *(const float4*)(p.kr + (size_t)row * 256 + h * 64 + 4 * d4); const float dk = fexp((float)(RC - 1 - j) * lg);
            KdT[(4 * d4 + 0) * RLD + j] = f2bf(kv.x * dk); KdT[(4 * d4 + 1) * RLD + j] = f2bf(kv.y * dk); KdT[(4 * d4 + 2) * RLD + j] = f2bf(kv.z * dk); KdT[(4 * d4 + 3) * RLD + j] = f2bf(kv.w * dk); }
        for (int idx = tid; idx < 128 * 32; idx += NTHREADS) { const int j = idx >> 5, e4 = idx & 31, row = scan_row(dir, b, n * RC + j);
            const float4 vv = ld4px(p.px + (size_t)row * PXLD + 512 + h * 128 + 4 * e4);
            VT[(4 * e4 + 0) * RLD + j] = f2bf(vv.x); VT[(4 * e4 + 1) * RLD + j] = f2bf(vv.y); VT[(4 * e4 + 2) * RLD + j] = f2bf(vv.z); VT[(4 * e4 + 3) * RLD + j] = f2bf(vv.w); }
        __syncthreads();
        float* o = p.rkv + ((((size_t)dir * 2 + b) * RNCH + n) * 4 + h) * 8192;
#pragma unroll
        for (int td = 0; td < 4; ++td) { pg8::f32x4 acc = {0.f, 0.f, 0.f, 0.f};
            acc = mma16<128>(VT + (16 * wave) * RLD, RLD, KdT + (16 * td) * RLD, RLD, acc, lane);
#pragma unroll
            for (int g = 0; g < 4; ++g) o[(size_t)(16 * wave + 4 * q + g) * 64 + 16 * td + r] = acc[g]; }
    }
}
__device__ __forceinline__ void mf_reto(const P& p, LAS unsigned char* lds, int il) {
    int tid = threadIdx.x; asm volatile("" : "+v"(tid));
    int bx_ = (int)blockIdx.x, gx_ = (int)gridDim.x; asm volatile("" : "+s"(bx_), "+s"(gx_));
    const int lane = tid & 63, wave = tid >> 6, r = lane & 15, q = lane >> 4;
    LAS bf16_t* Qs = (LAS bf16_t*)lds; LAS bf16_t* Ks = Qs + 128 * RLQ; LAS bf16_t* ST = Ks + 128 * RLQ; LAS bf16_t* VT = ST + 128 * RLQ; LAS bf16_t* Ps = VT + 128 * RLD;
    for (int u = bx_; u < 16 * RNCH; u += gx_) {
        const int n = u % RNCH, h = (u / RNCH) & 3, b = (u / (RNCH * 4)) & 1, dir = u / (RNCH * 8);
        const float lg = ret_logg(p, il, dir, h);
        const float* Sg = p.rkv + ((((size_t)dir * 2 + b) * RNCH + n) * 4 + h) * 8192;
        __syncthreads();
        for (int idx = tid; idx < 128 * 16; idx += NTHREADS) { const int j = idx >> 4, d4 = idx & 15, row = scan_row(dir, b, n * RC + j);
            const float4 qv = *(const float4*)(p.qr + (size_t)row * 256 + h * 64 + 4 * d4), kv = *(const float4*)(p.kr + (size_t)row * 256 + h * 64 + 4 * d4), sv = *(const float4*)(Sg + (size_t)j * 64 + 4 * d4);
            *(LAS us4v*)(Qs + j * RLQ + 4 * d4) = pack4(qv); *(LAS us4v*)(Ks + j * RLQ + 4 * d4) = pack4(kv); *(LAS us4v*)(ST + j * RLQ + 4 * d4) = pack4(sv); }
        for (int idx = tid; idx < 128 * 32; idx += NTHREADS) { const int j = idx >> 5, e4 = idx & 31, row = scan_row(dir, b, n * RC + j);
            const float4 vv = ld4px(p.px + (size_t)row * PXLD + 512 + h * 128 + 4 * e4);
            VT[(4 * e4 + 0) * RLD + j] = f2bf(vv.x); VT[(4 * e4 + 1) * RLD + j] = f2bf(vv.y); VT[(4 * e4 + 2) * RLD + j] = f2bf(vv.z); VT[(4 * e4 + 3) * RLD + j] = f2bf(vv.w); }
        __syncthreads();
#pragma unroll
        for (int tj = 0; tj < 8; ++tj) { pg8::f32x4 acc = {0.f, 0.f, 0.f, 0.f};
            acc = mma16<64>(Qs + (16 * wave) * RLQ, RLQ, Ks + (16 * tj) * RLQ, RLQ, acc, lane);
            const int j = 16 * tj + r;
#pragma unroll
            for (int g = 0; g < 4; ++g) { const int i = 16 * wave + 4 * q + g; Ps[i * RLD + j] = f2bf(j <= i ? acc[g] * fexp((float)(i - j) * lg) : 0.f); } }
        __syncthreads();
        float dq[4];
#pragma unroll
        for (int g = 0; g < 4; ++g) dq[g] = fexp((float)(16 * wave + 4 * q + g + 1) * lg);
#pragma unroll
        for (int te = 0; te < 8; ++te) { pg8::f32x4 acc = {0.f, 0.f, 0.f, 0.f}, cr = {0.f, 0.f, 0.f, 0.f};
            acc = mma16<128>(Ps + (16 * wave) * RLD, RLD, VT + (16 * te) * RLD, RLD, acc, lane);
            cr = mma16<64>(Qs + (16 * wave) * RLQ, RLQ, ST + (16 * te) * RLQ, RLQ, cr, lane);
#pragma unroll
            for (int g = 0; g < 4; ++g) { const int i = 16 * wave + 4 * q + g, row = scan_row(dir, b, n * RC + i);
                p.oret[((size_t)dir * NTOK + row) * 512 + h * 128 + 16 * te + r] = acc[g] + dq[g] * cr[g]; } }
    }
}
template <bool FILL> __device__ __forceinline__ void mf_s5(const P& p, LAS unsigned char* lds, int il) {
    int tid = threadIdx.x; asm volatile("" : "+v"(tid));
    int bx_ = (int)blockIdx.x, gx_ = (int)gridDim.x; asm volatile("" : "+s"(bx_), "+s"(gx_));
    const int lane = tid & 63, wave = tid >> 6, r = lane & 15, q = lane >> 4;
    constexpr int LDU = 40, LDS_ = 132, LDB = 136;
    LAS bf16_t* Bt = (LAS bf16_t*)lds;
    LAS bf16_t* Ct = Bt + 128 * LDU;
    LAS unsigned char* wb = lds + 16384 + wave * 14336;
    LAS bf16_t* U = (LAS bf16_t*)wb;
    LAS float* SL = (LAS float*)(wb + 1280);
    LAS bf16_t* Sb = (LAS bf16_t*)(wb + 1280 + 8448);
    constexpr int GRP = (2 * S5NCH) / 8;
    static_assert((2 * S5NCH) % 8 == 0, "chunk count");
    for (int bu = bx_; bu < 64 * GRP; bu += gx_) {
        const int dg = bu / GRP, grp = bu % GRP, dir = dg >> 5, g = dg & 31;
        __syncthreads();
        if (tid < 64) { S5Par sp; s5_par(p, il, dir, g, tid, sp);
#pragma unroll
            for (int h = 0; h < 16; ++h) { Bt[(2 * tid) * LDU + h] = f2bf(sp.bbr[h]); Bt[(2 * tid + 1) * LDU + h] = f2bf(sp.bbi[h]); Bt[(2 * tid) * LDU + 16 + h] = 0; Bt[(2 * tid + 1) * LDU + 16 + h] = 0;
                const long ci = (((long)(il * 2 + dir) * NG + g) * GH + h) * NP + tid; Ct[h * LDB + 2 * tid] = f2bf(p.s5_cre[ci]); Ct[h * LDB + 2 * tid + 1] = f2bf(-p.s5_cim[ci]); } }
        float lbr, lbi; { const int gi = (il * 2 + dir) * NG + g; const float lre = fminf(p.s5_lre[gi * NP + lane], -1e-4f), lim = p.s5_lim[gi * NP + lane], dt = expf(p.s5_ldt[gi]);
            const float mag = expf(lre * dt); lbr = mag * cosf(lim * dt); lbi = mag * sinf(lim * dt); }
        __syncthreads();
        const int bc = grp * 8 + wave, b = bc / S5NCH, ch = bc % S5NCH;
        float* ce = p.s5c + ((((size_t)dir * 2 + b) * S5NCH + ch) * NG + g) * NP * 2 + lane * 2;
        float sr = 0.f, si = 0.f;
        if (FILL) { sr = ce[0]; si = ce[1]; }
        float4 uvs[S5C / 16];
#pragma unroll
        for (int sb = 0; sb < S5C / 16; ++sb) { const int k = lane >> 2, h4 = (lane & 3) * 4, row = scan_row(dir, b, ch * S5C + sb * 16 + k);
            uvs[sb] = ld4px(p.px + (size_t)row * PXLD + 1536 + g * GH + h4); }
#pragma unroll
        for (int sb = 0; sb < S5C / 16; ++sb) {
            { const int k = lane >> 2, h4 = (lane & 3) * 4;
              *(LAS us4v*)(U + k * LDU + h4) = pack4(uvs[sb]); *(LAS us4v*)(U + k * LDU + 16 + h4) = (us4v){0, 0, 0, 0}; }
            asm volatile("s_waitcnt lgkmcnt(0)" ::: "memory");
#pragma unroll
            for (int tc = 0; tc < 8; ++tc) { pg8::f32x4 acc = {0.f, 0.f, 0.f, 0.f};
                acc = mma16<32>(U, LDU, Bt + (16 * tc) * LDU, LDU, acc, lane);
#pragma unroll
                for (int gq = 0; gq < 4; ++gq) SL[(4 * q + gq) * LDS_ + 16 * tc + r] = acc[gq]; }
            asm volatile("s_waitcnt lgkmcnt(0)" ::: "memory");
#pragma unroll
            for (int k = 0; k < 16; ++k) { const float br = SL[k * LDS_ + 2 * lane], bi = SL[k * LDS_ + 2 * lane + 1];
                const float tr = lbr * sr - lbi * si + br, ti = lbr * si + lbi * sr + bi; sr = tr; si = ti;
                if (FILL) { Sb[k * LDB + 2 * lane] = f2bf(sr); Sb[k * LDB + 2 * lane + 1] = f2bf(si); } }
            if (FILL) {
                asm volatile("s_waitcnt lgkmcnt(0)" ::: "memory");
                pg8::f32x4 acc = {0.f, 0.f, 0.f, 0.f};
                acc = mma16<128>(Sb, LDB, Ct, LDB, acc, lane);
#pragma unroll
                for (int gq = 0; gq < 4; ++gq) { const int row = scan_row(dir, b, ch * S5C + sb * 16 + 4 * q + gq); p.yd[((size_t)dir * NTOK + row) * S5W + g * GH + r] = acc[gq]; }
            }
            asm volatile("s_waitcnt lgkmcnt(0)" ::: "memory");
        }
        if (!FILL) { ce[0] = sr; ce[1] = si; }
    }
}
__device__ __forceinline__ void mf_swa(const P& p, LAS unsigned char* lds, int il, bool with_ctx) {
    int tid = threadIdx.x; asm volatile("" : "+v"(tid));
    int bx_ = (int)blockIdx.x, gx_ = (int)gridDim.x; asm volatile("" : "+s"(bx_), "+s"(gx_));
    const int lane = tid & 63, wave = tid >> 6, r = lane & 15, q = lane >> 4;
    constexpr int LDK = 72;
    LAS bf16_t* Ks = (LAS bf16_t*)lds;
    LAS bf16_t* VT = Ks + 64 * LDK;
    LAS bf16_t* Pw = VT + 64 * LDK + wave * 64 * LDK;
    constexpr int NQB = SEQ / 128, NLATU = 4 * NQB, NCTXU = 4 * (CTXL / 128);
    const int nunits = NLATU + (with_ctx ? NCTXU : 0);
    for (int u = bx_; u < nunits; u += gx_) {
        int b, kv, qb, isctx;
        if (u < NLATU) { isctx = 0; qb = u % NQB; kv = (u / NQB) & 1; b = u / (NQB * 2); }
        else { const int v = u - NLATU; isctx = 1; qb = v % (CTXL / 128); kv = (v / (CTXL / 128)) & 1; b = v / ((CTXL / 128) * 2); }
        const int g = wave >> 1, hq = kv * 4 + g, i0 = (wave & 1) * 64;
        const int qrow0 = (isctx ? NLAT + b * CTXL : b * SEQ) + qb * 128 + i0;
        pg8::bf16x8 qf[4][2];
#pragma unroll
        for (int tq = 0; tq < 4; ++tq)
#pragma unroll
            for (int ks = 0; ks < 2; ++ks) { const float* src = p.qs + (size_t)(qrow0 + 16 * tq + r) * 512 + hq * 64 + 32 * ks + 8 * q;
                const float4 a = *(const float4*)src, c = *(const float4*)(src + 4);
                qf[tq][ks] = (pg8::bf16x8){(short)f2bf(a.x), (short)f2bf(a.y), (short)f2bf(a.z), (short)f2bf(a.w), (short)f2bf(c.x), (short)f2bf(c.y), (short)f2bf(c.z), (short)f2bf(c.w)}; }
        pg8::f32x4 oacc[4][4];
        float mrow[4][4], lrow[4][4];
        const float sink = p.swa_sink[il * 8 + hq];
#pragma unroll
        for (int tq = 0; tq < 4; ++tq)
#pragma unroll
            for (int x = 0; x < 4; ++x) { oacc[tq][x] = (pg8::f32x4){0.f, 0.f, 0.f, 0.f}; mrow[tq][x] = sink; lrow[tq][x] = 1.0f; }
        const int ntile = isctx ? 4 : 10;
        for (int t = 0; t < ntile; ++t) {
            const bool loc = !isctx && t < 6;
            const int kpos0 = loc ? 128 * (qb - 1) + 64 * t : 0;
            if (loc && (kpos0 < 0 || kpos0 >= SEQ)) continue;
            const int krow0 = loc ? b * SEQ + kpos0 : NLAT + b * CTXL + 64 * (isctx ? t : t - 6);
            __syncthreads();
            for (int idx = tid; idx < 64 * 16; idx += NTHREADS) { const int key = idx >> 4, d4 = idx & 15;
                const float4 kk = *(const float4*)(p.ks + (size_t)(krow0 + key) * 128 + kv * 64 + 4 * d4), vv = ld4px(p.px + (size_t)(krow0 + key) * PXLD + 2176 + kv * 64 + 4 * d4);
                *(LAS us4v*)(Ks + key * LDK + 4 * d4) = pack4(kk);
                VT[(4 * d4 + 0) * LDK + key] = f2bf(vv.x); VT[(4 * d4 + 1) * LDK + key] = f2bf(vv.y); VT[(4 * d4 + 2) * LDK + key] = f2bf(vv.z); VT[(4 * d4 + 3) * LDK + key] = f2bf(vv.w); }
            __syncthreads();
            pg8::f32x4 sc[4][4];
#pragma unroll
            for (int tk = 0; tk < 4; ++tk) { const LAS bf16_t* kp = Ks + (16 * tk + r) * LDK + 8 * q;
                const pg8::bf16x8 k0 = *(const LAS pg8::bf16x8*)kp, k1 = *(const LAS pg8::bf16x8*)(kp + 32);
#pragma unroll
                for (int tq = 0; tq < 4; ++tq) { pg8::f32x4 a = {0.f, 0.f, 0.f, 0.f};
                    a = __builtin_amdgcn_mfma_f32_16x16x32_bf16(qf[tq][0], k0, a, 0, 0, 0); a = __builtin_amdgcn_mfma_f32_16x16x32_bf16(qf[tq][1], k1, a, 0, 0, 0); sc[tq][tk] = a; } }
            if (loc) {
#pragma unroll
                for (int tq = 0; tq < 4; ++tq)
#pragma unroll
                    for (int tk = 0; tk < 4; ++tk)
#pragma unroll
                        for (int x = 0; x < 4; ++x) { const int dlt = (kpos0 + 16 * tk + r) - (128 * qb + i0 + 16 * tq + 4 * q + x); if (dlt > 128 || dlt < -128) sc[tq][tk][x] = -1e30f; }
            }
#pragma unroll
            for (int tq = 0; tq < 4; ++tq)
#pragma unroll
                for (int x = 0; x < 4; ++x) {
                    float mx = fmaxf(fmaxf(sc[tq][0][x], sc[tq][1][x]), fmaxf(sc[tq][2][x], sc[tq][3][x]));
                    mx = row16_max(mx);
                    const float mn = fmaxf(mrow[tq][x], mx), corr = __expf(mrow[tq][x] - mn);
                    float sum = 0.f;
#pragma unroll
                    for (int tk = 0; tk < 4; ++tk) { const float pe = __expf(sc[tq][tk][x] - mn); sum += pe; Pw[(16 * tq + 4 * q + x) * LDK + 16 * tk + r] = f2bf(pe); }
                    sum = row16_sum(sum);
                    lrow[tq][x] = lrow[tq][x] * corr + sum; mrow[tq][x] = mn;
#pragma unroll
                    for (int td = 0; td < 4; ++td) oacc[tq][td][x] *= corr;
                }
            asm volatile("s_waitcnt lgkmcnt(0)" ::: "memory");
#pragma unroll
            for (int td = 0; td < 4; ++td) { const LAS bf16_t* vp = VT + (16 * td + r) * LDK + 8 * q;
                const pg8::bf16x8 v0 = *(const LAS pg8::bf16x8*)vp, v1 = *(const LAS pg8::bf16x8*)(vp + 32);
#pragma unroll
                for (int tq = 0; tq < 4; ++tq) { const LAS bf16_t* pp = Pw + (16 * tq + r) * LDK + 8 * q;
                    oacc[tq][td] = __builtin_amdgcn_mfma_f32_16x16x32_bf16(*(const LAS pg8::bf16x8*)pp, v0, oacc[tq][td], 0, 0, 0);
                    oacc[tq][td] = __builtin_amdgcn_mfma_f32_16x16x32_bf16(*(const LAS pg8::bf16x8*)(pp + 32), v1, oacc[tq][td], 0, 0, 0); } }
        }
#pragma unroll
        for (int tq = 0; tq < 4; ++tq)
#pragma unroll
            for (int x = 0; x < 4; ++x) { const float inv = 1.0f / lrow[tq][x]; bf16_t* o = p.mixb + (size_t)(qrow0 + 16 * tq + 4 * q + x) * D + 512 + hq * 64 + r;
#pragma unroll
                for (int td = 0; td < 4; ++td) o[16 * td] = f2bf(oacc[tq][td][x] * inv); }
    }
}
__device__ __forceinline__ void mf_sconv(const P& p, LAS unsigned char* lds, int il) {
    int tid = threadIdx.x; asm volatile("" : "+v"(tid));
    int bx_ = (int)blockIdx.x, gx_ = (int)gridDim.x; asm volatile("" : "+s"(bx_), "+s"(gx_));
    LAS float* T = (LAS float*)lds;
    const float* sw = p.hy_short_w + il * 3 * 1536; const float* sb = p.hy_short_b + il * 1536;
    constexpr int NT = (NTOK / 64) * (HYW / 64);
    for (int t = bx_; t < NT; t += gx_) {
        const int r0 = (t / (HYW / 64)) * 64, c0 = (t % (HYW / 64)) * 64;
        const int rl = tid >> 3, cs = (tid & 7) * 8, r = r0 + rl; const RowInfo ri = row_info(r);
        float u[3][8];
#pragma unroll
        for (int g = 0; g < 3; ++g) { const int col = g * HYW + c0 + cs; const float4 b0 = *(const float4*)(sb + col), b1 = *(const float4*)(sb + col + 4);
            u[g][0] = b0.x; u[g][1] = b0.y; u[g][2] = b0.z; u[g][3] = b0.w; u[g][4] = b1.x; u[g][5] = b1.y; u[g][6] = b1.z; u[g][7] = b1.w;
#pragma unroll
            for (int j = 0; j < 3; ++j) { const int tt = ri.t + j - 1; if (tt >= 0 && tt < ri.len) { const px_t* px = p.px + (size_t)(ri.base + tt) * PXLD + col; const float* wj = sw + j * 1536 + col;
                const float4 x0 = ld4px(px), x1 = ld4px(px + 4), w0 = *(const float4*)wj, w1 = *(const float4*)(wj + 4);
                u[g][0] += w0.x * x0.x; u[g][1] += w0.y * x0.y; u[g][2] += w0.z * x0.z; u[g][3] += w0.w * x0.w; u[g][4] += w1.x * x1.x; u[g][5] += w1.y * x1.y; u[g][6] += w1.z * x1.z; u[g][7] += w1.w * x1.w; } } }
        float z[8];
#pragma unroll
        for (int k = 0; k < 8; ++k) z[k] = u[2][k] * u[1][k];
        const size_t i = (size_t)r * HYW + c0 + cs;
        *(float4*)(p.x0c + i) = make_float4(u[0][0], u[0][1], u[0][2], u[0][3]); *(float4*)(p.x0c + i + 4) = make_float4(u[0][4], u[0][5], u[0][6], u[0][7]);
        *(float4*)(p.zb + i) = make_float4(z[0], z[1], z[2], z[3]); *(float4*)(p.zb + i + 4) = make_float4(z[4], z[5], z[6], z[7]);
        if (r0 < NLAT) {
            __syncthreads();
#pragma unroll
            for (int k = 0; k < 8; ++k) T[(cs + k) * 65 + rl] = z[k];
            __syncthreads();
            const int cl = tid >> 3, rs = (tid & 7) * 8; const LAS float* src = T + cl * 65 + rs; float* dst = p.zT + (size_t)(c0 + cl) * NLAT + r0 + rs;
            *(float4*)dst = make_float4(src[0], src[1], src[2], src[3]); *(float4*)(dst + 4) = make_float4(src[4], src[5], src[6], src[7]);
        }
    }
}
__device__ __forceinline__ void mf_filter_tiles(const P& p, LAS unsigned char* lds) {
    int tid = threadIdx.x; asm volatile("" : "+v"(tid));
    int bx_ = (int)blockIdx.x, gx_ = (int)gridDim.x; asm volatile("" : "+s"(bx_), "+s"(gx_));
    LAS float* A1 = (LAS float*)lds; LAS float* A2 = A1 + 64 * 65; LAS float* T = A2 + 64 * 65;
    constexpr int RT = (SEQ + CTXL) / 64;
    const int rl = tid >> 3, cs = (tid & 7) * 8;
    constexpr int NLT = 2 * (SEQ / 64), NCT = 2 * (CTXL / 64), NITEM = NLT + NCT * (HYW / 64);
    for (int it = bx_; it < NITEM; it += gx_) {
        int t, ct0, ct1;
        if (it < NLT) { t = (it / (SEQ / 64)) * RT + it % (SEQ / 64); ct0 = 0; ct1 = HYW / 64; }
        else { const int v = it - NLT, tc = v / (HYW / 64); t = (tc / (CTXL / 64)) * RT + SEQ / 64 + tc % (CTXL / 64); ct0 = v % (HYW / 64); ct1 = ct0 + 1; }
        const int i = t / RT, rt = t % RT, q0 = rt * 64, kind = q0 >= SEQ, L = kind ? CTXL : SEQ, q = q0 + rl, pos = kind ? q - SEQ : q;
        const long rr = (long)i * (SEQ + CTXL) + q;
        __syncthreads();
        {
            const float* w1 = p.hy_f_w1 + i * 33 * 64 + cs; const float tt = (float)pos / (float)L, w = 6.283185307179586f * (float)pos / (float)L;
            float acc[8];
#pragma unroll
            for (int k = 0; k < 8; ++k) acc[k] = tt * w1[k];
            for (int bi = 0; bi < 16; ++bi) { const float band = 1e-4f + (float)bi * ((15.0f - 1e-4f) / 15.0f), cc = ROPE_COS(band * w), sn = ROPE_SIN(band * w);
                const float* wc = w1 + (1 + bi) * 64; const float* ws = w1 + (17 + bi) * 64;
#pragma unroll
                for (int k = 0; k < 8; ++k) acc[k] += cc * wc[k] - sn * ws[k]; }
#pragma unroll
            for (int k = 0; k < 8; ++k) A1[rl * 65 + cs + k] = ROPE_SIN(acc[k] + p.hy_f_b1[i * 64 + cs + k]);
        }
        __syncthreads();
        {
            const float* w2 = p.hy_f_w2 + i * 64 * 64 + cs; float acc[8];
#pragma unroll
            for (int k = 0; k < 8; ++k) acc[k] = 0.f;
            for (int kk = 0; kk < 64; ++kk) { const float hv = A1[rl * 65 + kk]; const float4 a = *(const float4*)(w2 + kk * 64), b4 = *(const float4*)(w2 + kk * 64 + 4);
                acc[0] += hv * a.x; acc[1] += hv * a.y; acc[2] += hv * a.z; acc[3] += hv * a.w; acc[4] += hv * b4.x; acc[5] += hv * b4.y; acc[6] += hv * b4.z; acc[7] += hv * b4.w; }
#pragma unroll
            for (int k = 0; k < 8; ++k) A2[rl * 65 + cs + k] = ROPE_SIN(acc[k] + p.hy_f_b2[i * 64 + cs + k]);
        }
        __syncthreads();
        const float lag = fabsf((float)(pos - L / 2)) / (float)(L / 2);
        for (int ct = ct0; ct < ct1; ++ct) {
            const int c0 = ct * 64; const float* w3 = p.hy_f_w3 + (size_t)i * 64 * HYW + c0 + cs;
            float acc[8];
#pragma unroll
            for (int k = 0; k < 8; ++k) acc[k] = 0.f;
            for (int kk = 0; kk < 64; ++kk) { const float hv = A2[rl * 65 + kk]; const float4 a = *(const float4*)(w3 + (size_t)kk * HYW), b4 = *(const float4*)(w3 + (size_t)kk * HYW + 4);
                acc[0] += hv * a.x; acc[1] += hv * a.y; acc[2] += hv * a.z; acc[3] += hv * a.w; acc[4] += hv * b4.x; acc[5] += hv * b4.y; acc[6] += hv * b4.z; acc[7] += hv * b4.w; }
            const float fast = -15.350567286626973f, slow = -3.0701134573253946f;
#pragma unroll
            for (int k = 0; k < 8; ++k) { const float delta = fabsf(fast + (slow - fast) * (float)(c0 + cs + k) / 511.0f); acc[k] *= fexp(-lag * delta) + 0.05f; }
            float* o = p.hraw + rr * HYW + c0 + cs;
            *(float4*)o = make_float4(acc[0], acc[1], acc[2], acc[3]); *(float4*)(o + 4) = make_float4(acc[4], acc[5], acc[6], acc[7]);
            __syncthreads();
#pragma unroll
            for (int k = 0; k < 8; ++k) T[(cs + k) * 65 + rl] = acc[k];
            __syncthreads();
            const int cl = tid >> 3, rs = (tid & 7) * 8; const LAS float* src = T + cl * 65 + rs;
            float v8[8];
#pragma unroll
            for (int k = 0; k < 8; ++k) v8[k] = src[k];
            if (!kind) { float* dst = p.hT + ((size_t)i * HYW + c0 + cl) * SEQ + q0 + rs;
                *(float4*)dst = make_float4(v8[0], v8[1], v8[2], v8[3]); *(float4*)(dst + 4) = make_float4(v8[4], v8[5], v8[6], v8[7]); }
            float sa = 0.f;
#pragma unroll
            for (int k = 0; k < 8; ++k) sa += fabsf(v8[k]);
            sa += __shfl_xor(sa, 1); sa += __shfl_xor(sa, 2); sa += __shfl_xor(sa, 4);
            if ((tid & 7) == 0) p.hpart[(size_t)t * HYW + c0 + cl] = sa;
        }
    }
}
__device__ __forceinline__ void mf_hymix(const P& p, LAS unsigned char* lds, int il) {
    int tid = threadIdx.x; asm volatile("" : "+v"(tid));
    int bx_ = (int)blockIdx.x, gx_ = (int)gridDim.x; asm volatile("" : "+s"(bx_), "+s"(gx_));
    LAS float* T = (LAS float*)lds;
    constexpr int NT = (NLAT / 64) * (HYW / 64);
    for (int t = bx_; t < NT; t += gx_) {
        const int r0 = (t / (HYW / 64)) * 64, c0 = (t % (HYW / 64)) * 64;
        __syncthreads();
        { const int cl = tid >> 3, rs = (tid & 7) * 8; const float* src = p.convT + (size_t)(c0 + cl) * NLAT + r0 + rs; const float4 a = *(const float4*)src, b = *(const float4*)(src + 4);
          LAS float* d = T + cl * 65 + rs; d[0] = a.x; d[1] = a.y; d[2] = a.z; d[3] = a.w; d[4] = b.x; d[5] = b.y; d[6] = b.z; d[7] = b.w; }
        __syncthreads();
        { const int rl = tid >> 3, cs = (tid & 7) * 8; const size_t i = (size_t)(r0 + rl) * HYW + c0 + cs;
          const float4 z0 = *(const float4*)(p.zb + i), z1 = *(const float4*)(p.zb + i + 4), x0 = *(const float4*)(p.x0c + i), x1 = *(const float4*)(p.x0c + i + 4);
          const float4 b0 = *(const float4*)(p.hy_bias + il * HYW + c0 + cs), b1 = *(const float4*)(p.hy_bias + il * HYW + c0 + cs + 4);
          const float zz[8] = {z0.x, z0.y, z0.z, z0.w, z1.x, z1.y, z1.z, z1.w}, xx[8] = {x0.x, x0.y, x0.z, x0.w, x1.x, x1.y, x1.z, x1.w}, bb[8] = {b0.x, b0.y, b0.z, b0.w, b1.x, b1.y, b1.z, b1.w};
          unsigned short o[8];
#pragma unroll
          for (int k = 0; k < 8; ++k) o[k] = f2bf(xx[k] * (T[(cs + k) * 65 + rl] + bb[k] * zz[k]));
          uint4 ov; ov.x = o[0] | ((unsigned)o[1] << 16); ov.y = o[2] | ((unsigned)o[3] << 16); ov.z = o[4] | ((unsigned)o[5] << 16); ov.w = o[6] | ((unsigned)o[7] << 16);
          *(uint4*)(p.mixb + (size_t)(r0 + rl) * D + c0 + cs) = ov; }
    }
}
__device__ __forceinline__ void mf_retout(const P& p, int nrows) {
    int tid = threadIdx.x; asm volatile("" : "+v"(tid));
    int bx_ = (int)blockIdx.x, gx_ = (int)gridDim.x; asm volatile("" : "+s"(bx_), "+s"(gx_));
    const int lane = tid & 63, wave = tid >> 6;
    for (int r = bx_ * 8 + wave; r < nrows; r += gx_ * 8) {
        const float* o0 = p.oret + (size_t)r * 512 + 8 * lane; const float* o1 = p.oret + ((size_t)NTOK + r) * 512 + 8 * lane; const px_t* gp = p.px + (size_t)r * PXLD + 1024 + 8 * lane;
        const float4 a0 = *(const float4*)o0, a1 = *(const float4*)(o0 + 4), b0 = *(const float4*)o1, b1 = *(const float4*)(o1 + 4), g0 = ld4px(gp), g1 = ld4px(gp + 4);
        const float o[8] = {a0.x + b0.x, a0.y + b0.y, a0.z + b0.z, a0.w + b0.w, a1.x + b1.x, a1.y + b1.y, a1.z + b1.z, a1.w + b1.w}, gg[8] = {g0.x, g0.y, g0.z, g0.w, g1.x, g1.y, g1.z, g1.w};
        float ss = 0.f;
#pragma unroll
        for (int k = 0; k < 8; ++k) ss += o[k] * o[k];
        ss = row16_sum(ss);
        const float rs = rsqrtf(ss * (1.0f / 128.0f) + EPS);
        unsigned short ob[8];
#pragma unroll
        for (int k = 0; k < 8; ++k) ob[k] = f2bf(o[k] * rs * siluf_(gg[k]));
        uint4 ov; ov.x = ob[0] | ((unsigned)ob[1] << 16); ov.y = ob[2] | ((unsigned)ob[3] << 16); ov.z = ob[4] | ((unsigned)ob[5] << 16); ov.w = ob[6] | ((unsigned)ob[7] << 16);
        *(uint4*)(p.mixb + (size_t)r * D + 8 * lane) = ov;
    }
}
__device__ __forceinline__ void mf_lconv(const P& p, LAS unsigned char* lds, int il) {
    int tid = threadIdx.x; asm volatile("" : "+v"(tid));
    int bx_ = (int)blockIdx.x, gx_ = (int)gridDim.x; asm volatile("" : "+s"(bx_), "+s"(gx_));
    for (int c = bx_; c < HYW; c += gx_) lconv_unit(p, il, c, (LAS CX*)lds, p.zf + (size_t)bx_ * 2 * FFTN, tid, NTHREADS);
}
__device__ __forceinline__ void mf_inproj(const P& p, LAS unsigned char* lds, int layer) {
    const int il = layer >> 1; const bool ab = !(layer & 1);
    pg8::Gemm g{p.hxb, ab ? p.abin_t + (size_t)il * AB_IN * D : p.cdin_t + (size_t)il * CD_IN * D, NTOK, ab ? AB_IN : CD_IN, D, 0};
    int gx_ = (int)gridDim.x, bx_ = (int)blockIdx.x; asm volatile("" : "+s"(gx_), "+s"(bx_));
    pg8::StaticOrder S; S.init(g.M, g.N, gx_, bx_);
    pg8::EpiStoreBf16 E{p.px, PXLD};
    pg8::gemm_phase(lds, g, S, E);
}
__device__ __forceinline__ void mf_outproj(const P& p, LAS unsigned char* lds, int layer, int nrows) {
    const int il = layer >> 1; const bool ab = !(layer & 1);
    pg8::Gemm g{p.mixb, (ab ? p.about_t : p.cdout_t) + (size_t)il * D * D, nrows, D, D, 0};
    int gx_ = (int)gridDim.x, bx_ = (int)blockIdx.x; asm volatile("" : "+s"(gx_), "+s"(bx_));
    pg8::StaticOrder S; S.init(g.M, g.N, gx_, bx_);
    pg8::EpiResid E{p.xa, p.modv + (size_t)layer * 3 * 6 * D + 2 * D};
    pg8::gemm_phase(lds, g, S, E);
}
__device__ __forceinline__ void mf_glu(const P& p, LAS unsigned char* lds, int il) {
    pg8::Gemm g{p.ys5b, p.glu_t + (size_t)il * S5W * S5W, NTOK, S5W, S5W, 0};
    int gx_ = (int)gridDim.x, bx_ = (int)blockIdx.x; asm volatile("" : "+s"(gx_), "+s"(bx_));
    pg8::StaticOrder S; S.init(g.M, g.N, gx_, bx_);
    pg8::EpiGlu E{p.mixb, p.ys5b, p.s5_glu_b + il * S5W};
    pg8::gemm_phase(lds, g, S, E);
}
__device__ __forceinline__ int build_ue(const P& p, LAS unsigned char* lds, int layer) {
    volatile LAS unsigned char* ue = (volatile LAS unsigned char*)(lds + UE_OFF); volatile LAS int* tot = (volatile LAS int*)(lds + MISC_OFF + 16);
    __syncthreads();
    if (threadIdx.x == 0) { const int* cnt = p.cnt + layer * NE; int t = 0;
        for (int e = 0; e < NE; ++e) { const int nt = (cnt[e] + 255) >> 8; for (int q = 0; q < nt; ++q) ue[t + q] = (unsigned char)e; t += nt; }
        *tot = t; }
    __syncthreads();
    return *tot;
}
__device__ __forceinline__ void mf_moe1(const P& p, LAS unsigned char* lds, int layer) {
    const int tiles = build_ue(p, lds, layer);
    int gx_ = (int)gridDim.x, bx_ = (int)blockIdx.x; asm volatile("" : "+s"(gx_), "+s"(bx_));
    pg8::MoeOrder S{tiles * 8, 8, gx_, bx_, (const volatile LAS unsigned char*)(lds + UE_OFF), (const volatile LAS int*)(lds + TOK_OFF)};
    volatile LAS int* tokt = (volatile LAS int*)(lds + TOK_OFF);
    { int tid = threadIdx.x; asm volatile("" : "+v"(tid));
      int tkv[(TOK_UNITS + 1) / 2];
#pragma unroll
      for (int ps = 0; ps < (TOK_UNITS + 1) / 2; ++ps) { const int i = 2 * ps + (tid >> 8); int pm, pn; tkv[ps] = (i < TOK_UNITS && S.unit(i, pm, pn)) ? p.slot_tok[pm * 256 + (tid & 255)] : -1; }
#pragma unroll
      for (int ps = 0; ps < (TOK_UNITS + 1) / 2; ++ps) { const int i = 2 * ps + (tid >> 8); if (i < TOK_UNITS) tokt[i * 256 + (tid & 255)] = tkv[ps] < 0 ? NTOK : tkv[ps]; }
      __syncthreads(); }
    pg8::Gemm g{p.hxb, p.wgu_t + (size_t)layer * NE * 2 * DFF * D, tiles * 256, 2 * DFF, D, (size_t)2 * DFF * D * 2};
    pg8::EpiSwiglu E{p.actb, p.b_gu + (size_t)layer * NE * 2 * DFF};
    pg8::gemm_phase<pg8::EpiSwiglu, pg8::MoeOrder, true>(lds, g, S, E);
}
__device__ __forceinline__ void mf_moe2(const P& p, LAS unsigned char* lds, int layer) {
    const int tiles = build_ue(p, lds, layer);
    pg8::Gemm g{p.actb, p.wdn_t + (size_t)layer * NE * D * DFF, tiles * 256, D, DFF, (size_t)D * DFF * 2};
    int gx_ = (int)gridDim.x, bx_ = (int)blockIdx.x; asm volatile("" : "+s"(gx_), "+s"(bx_));
    pg8::MoeOrder S{tiles * 4, 4, gx_, bx_, (const volatile LAS unsigned char*)(lds + UE_OFF), nullptr};
    pg8::EpiDown E{p.yb, p.b_dn + (size_t)layer * NE * D, p.slot_gate};
    pg8::gemm_phase(lds, g, S, E);
}

#define XB_TMO      128
#define XB_XCNT(j)  (256  + 64 * (j))
#define XB_XSUB(j)  (1280 + 64 * (j))
#define XB_XGEN(j)  (2304 + 64 * (j))
#define XB_TOP      3328
#define XB_TOPGEN   3392
#define XCD_BAR_WORDS 3456
#define XB_SPIN_CAP (1u << 18)

__device__ __forceinline__ unsigned xb_ld(unsigned* p)              { return __hip_atomic_load(p, __ATOMIC_RELAXED, __HIP_MEMORY_SCOPE_AGENT); }
__device__ __forceinline__ unsigned xb_add(unsigned* p, unsigned v) { return __hip_atomic_fetch_add(p, v, __ATOMIC_RELAXED, __HIP_MEMORY_SCOPE_AGENT); }
__device__ __forceinline__ unsigned xb_xcc_id() { return (unsigned)__builtin_amdgcn_s_getreg((3 << 11) | 20) & 0xFu; }
#define XB_SPIN(cond, bar) do { unsigned _sp = 0; while (cond) { __builtin_amdgcn_s_sleep(1); \
    if ((++_sp & 255u) == 0u) { if (xb_ld(&(bar)[XB_TMO])) break; if (_sp > XB_SPIN_CAP) { atomicAdd(&(bar)[XB_TMO], 1u); break; } } } } while (0)

struct XcdBarrier { unsigned* bar; unsigned x; volatile LAS unsigned* st; };

__device__ __forceinline__ XcdBarrier xcd_barrier_post(unsigned* bar, volatile LAS unsigned* st) {
    XcdBarrier b; b.bar = bar; b.x = xb_xcc_id(); b.st = st;
    if (threadIdx.x == 0) (void)xb_add(&bar[XB_XCNT(b.x)], 1u);
    return b;
}
__device__ __forceinline__ void xcd_barrier_complete(unsigned* bar, unsigned x, unsigned& nloc, unsigned& nx) {
    const unsigned G = gridDim.x * gridDim.y * gridDim.z;
    unsigned sum, cnt, mine, sp = 0u;
    asm volatile("" : "+s"(x));
    for (;;) {
        sum = 0u; cnt = 0u; mine = 0u;
#pragma unroll
        for (unsigned j = 0; j < 16; ++j) { const unsigned c = xb_ld(&bar[XB_XCNT(j)]); sum += c; cnt += (c > 0u) ? 1u : 0u; mine = (j == x) ? c : mine; }
        if (sum == G) break;
        __builtin_amdgcn_s_sleep(1);
        if ((++sp & 255u) == 0u) { if (xb_ld(&bar[XB_TMO])) break; if (sp > XB_SPIN_CAP) { atomicAdd(&bar[XB_TMO], 1u); break; } }
    }
    nloc = mine > 0u ? mine : 1u; nx = cnt > 0u ? cnt : 1u;
}
__device__ __forceinline__ void xcd_barrier(const XcdBarrier& b) {
    asm volatile("s_waitcnt vmcnt(0)" ::: "memory");
    __syncthreads();
    if (threadIdx.x == 0) {
        unsigned* bar = b.bar; unsigned bx = b.x;
        asm volatile("" : "+s"(bar), "+s"(bx));
        __builtin_amdgcn_s_waitcnt(0);
        unsigned nloc = b.st[0], nx = b.st[1];
        if (nloc == 0u) { xcd_barrier_complete(bar, bx, nloc, nx); b.st[0] = nloc; b.st[1] = nx; }
        const unsigned old = xb_add(&bar[XB_XSUB(bx)], 1u);
        const unsigned gen = old / nloc;
        if (old + 1u == (gen + 1u) * nloc) {
            __builtin_amdgcn_fence(__ATOMIC_RELEASE, "agent");
            asm volatile("s_waitcnt vmcnt(0)" ::: "memory");
            const unsigned og = xb_add(&bar[XB_TOP], 1u);
            const unsigned tg = og / nx;
            if (og + 1u == (tg + 1u) * nx) xb_add(&bar[XB_TOPGEN], 1u);
            else XB_SPIN(xb_ld(&bar[XB_TOPGEN]) == tg, bar);
            __builtin_amdgcn_fence(__ATOMIC_ACQUIRE, "agent");
            xb_add(&bar[XB_XGEN(bx)], 1u);
            asm volatile("s_waitcnt vmcnt(0)" ::: "memory");
        } else {
            XB_SPIN(xb_ld(&bar[XB_XGEN(bx)]) == gen, bar);
            __builtin_amdgcn_fence(__ATOMIC_ACQUIRE, "agent");
            asm volatile("s_waitcnt vmcnt(0)" ::: "memory");
        }
    }
    __syncthreads();
}

typedef const __attribute__((address_space(4))) P* KP;
__global__ void __launch_bounds__(NTHREADS, 2) fwd_kernel(P p_arg) {
    (void)p_arg;
    const KP kp0 = (KP)__builtin_amdgcn_kernarg_segment_ptr();
#define p (*(const P*)({ KP q_ = kp0; asm volatile("" : "+s"(q_)); q_; }))
    extern __shared__ __attribute__((aligned(16))) unsigned char lds_raw[];
    LAS unsigned char* lds = (LAS unsigned char*)lds_raw;
    for (int u = threadIdx.x; u < (LDS_BYTES - MISC_OFF) / 4; u += NTHREADS) ((LAS unsigned*)(lds + MISC_OFF))[u] = 0u;
    __syncthreads();
    XcdBarrier bar = xcd_barrier_post(p.bar, (volatile LAS unsigned*)(lds + MISC_OFF));
    const long gs = (long)gridDim.x * NTHREADS;
#define gt ({ int b_ = (int)blockIdx.x; asm volatile("" : "+s"(b_)); long g_ = (long)b_ * NTHREADS + threadIdx.x; asm volatile("" : "+v"(g_)); g_; })
#define SETUP(S) setup_slot<S>(p, gt, gs); xcd_barrier(bar);
    for (int rep = 0; rep < REP_SETUP; ++rep) {
    setup_slot<0>(p, gt, gs); mf_filter_tiles(p, lds); __syncthreads(); ph_convert_weights(p, lds); xcd_barrier(bar);
    ph_mod2(p, gt, gs); ph_filt4(p, gt, gs); xcd_barrier(bar);
    }
#define SLOT(S) layer_slot<S>(p, layer, gt, gs); xcd_barrier(bar);
#if MFMA_DENSE
#define DENSE_IN  for (int rep = 0; rep < REP_IN; ++rep) { mf_inproj(p, lds, layer); if (layer < 3) convert_deferred(p, lds, layer, 0); xcd_barrier(bar); }
#define DENSE_OUT if (!(layer & 1)) mf_glu(p, lds, layer >> 1); else ph_retout(p, layer < 3 ? NTOK : NLAT, gt, gs); xcd_barrier(bar); \
                  mf_outproj(p, lds, layer, layer < 3 ? NTOK : NLAT); xcd_barrier(bar);
#else
#define DENSE_IN  SLOT(2)
#define DENSE_OUT SLOT(7) SLOT(8)
#endif
#if MFMA_MOE
#define MOE_GEMMS for (int rep = 0; rep < REP_MOE; ++rep) { mf_moe1(p, lds, layer); xcd_barrier(bar); } for (int rep = 0; rep < REP_MOE2; ++rep) { mf_moe2(p, lds, layer); xcd_barrier(bar); }
#else
#define MOE_GEMMS SLOT(14) SLOT(15)
#endif
#define REPF(n) for (int rep_ = 0; rep_ < (n); ++rep_)
#define LAYER(L) { constexpr int layer = L; constexpr bool AB = !(layer & 1); constexpr int il = layer >> 1; constexpr int nrows = layer < 3 ? NTOK : NLAT; \
    REPF(RN) mf_rownorm<0>(p, lds, layer, NTOK, layer - 1); xcd_barrier(bar); DENSE_IN \
    REPF(R3) { if (AB) { mf_s5<false>(p, lds, il); mf_sconv(p, lds, il); } else ph_rope(p, gt, gs); } xcd_barrier(bar); \
    REPF(R4) { if (AB) { mf_lconv(p, lds, il); ph_lconv(p, il, NLAT, NTOK, gt, gs); } else mf_retkv(p, lds, il); } if (AB) ph_s5carry(p, il, gt, gs); xcd_barrier(bar); \
    REPF(R5) { if (AB) { mf_s5<true>(p, lds, il); mf_hymix(p, lds, il); } else mf_swa(p, lds, il, layer < 3); } if (!AB) ph_retcarry(p, il, gt, gs); xcd_barrier(bar); \
    REPF(R6) { if (AB) ph_s5fin(p, il, gt, gs); else mf_reto(p, lds, il); } xcd_barrier(bar); \
    REPF(R7) { if (AB) mf_glu(p, lds, il); else mf_retout(p, nrows); } xcd_barrier(bar); \
    mf_outproj(p, lds, layer, nrows); if (layer < 3) convert_deferred(p, lds, layer, 1); xcd_barrier(bar); \
    mf_rownorm<1>(p, lds, layer, nrows, -1); xcd_barrier(bar); SLOT(12) MOE_GEMMS }
    LAYER(0) LAYER(1) LAYER(2) LAYER(3)
    mf_rownorm<2>(p, lds, 3, NLAT, 3);
#undef gt
#undef p
}

extern "C" void kernel_launch(void* const* d_in, const int* in_sizes, int n_in, void* d_out, int out_size, void* d_ws, size_t ws_size, hipStream_t stream) {
    (void)in_sizes; (void)n_in; (void)out_size;
    const WsMap m = ws_map();
    if (ws_size < m.total) { fprintf(stderr, "workspace too small: %zu < %zu\n", ws_size, m.total); return; }
    P p; memset(&p, 0, sizeof(p)); fill_params(p, d_in, d_out, d_ws);
    static int grid = 0;
    if (!grid) {
        int dev = 0, cus = 0, per_cu = 0;
        (void)hipGetDevice(&dev); (void)hipDeviceGetAttribute(&cus, hipDeviceAttributeMultiprocessorCount, dev);
        if (hipFuncSetAttribute((const void*)fwd_kernel, hipFuncAttributeMaxDynamicSharedMemorySize, LDS_BYTES) != hipSuccess) { fprintf(stderr, "hipFuncSetAttribute failed\n"); grid = -1; return; }
        (void)hipOccupancyMaxActiveBlocksPerMultiprocessor(&per_cu, (const void*)fwd_kernel, NTHREADS, LDS_BYTES);
        if (per_cu < 1) fprintf(stderr, "occupancy query reports %d blocks per CU\n", per_cu);
        grid = cus;
    }
    if (grid <= 0) return;
    (void)hipMemsetAsync(p.bar, 0, XCD_BAR_WORDS * sizeof(unsigned), stream);
    fwd_kernel<<<dim3(grid), dim3(NTHREADS), LDS_BYTES, stream>>>(p);
}
#endif
```

```cpp
#ifndef CPU_SHIM
#include <hip/hip_runtime.h>
#include <cstring>
#include <cstdio>
#include <cstdint>
#define DEV __device__ __forceinline__
#else
#include <cmath>
#include <cstdio>
#include <cstdint>
#include <cstring>
#include <cstdlib>
#define DEV static inline
static inline float rsqrtf(float x) { return 1.0f / sqrtf(x); }
#endif

#ifndef SEQ
#define SEQ 8192
#endif
#ifndef CTXL
#define CTXL 256
#endif
#ifndef N_LAUNCH_MODE
#define N_LAUNCH_MODE 1
#endif
#ifdef CPU_SHIM
#define MFMA_DENSE 0
#define MFMA_MOE 0
#endif
#ifndef R3
#define R3 1
#endif
#ifndef R4
#define R4 1
#endif
#ifndef R5
#define R5 1
#endif
#ifndef R6
#define R6 1
#endif
#ifndef R7
#define R7 1
#endif
#ifndef RG
#define RG 1
#endif
#ifndef RN
#define RN 1
#endif
#ifndef REP_SETUP
#define REP_SETUP 1
#endif
#ifndef REP_MOE
#define REP_MOE 1
#endif
#ifndef REP_MOE2
#define REP_MOE2 1
#endif
#ifndef REP_IN
#define REP_IN 1
#endif
#ifndef REP_RET
#define REP_RET 1
#endif
#ifndef REP_SWA
#define REP_SWA 1
#endif
#ifndef REP_S5
#define REP_S5 1
#endif
#ifndef MFMA_DENSE
#define MFMA_DENSE 1
#endif
#ifndef MFMA_MOE
#define MFMA_MOE 1
#endif
typedef unsigned short bf16_t;
#if MFMA_DENSE
typedef unsigned short px_t;
#else
typedef float px_t;
#endif

constexpr int D = 1024, NLAT = 2 * SEQ, NCTX = 2 * CTXL, NTOK = NLAT + NCTX;
constexpr int HYW = 512, S5W = 512, NG = 32, NP = 64, GH = 16;
constexpr int AB_IN = 2048, CD_IN = 2304, PXLD = 2304;
constexpr int NE = 32, DFF = 1024;
constexpr float EPS = 1e-6f;
constexpr int NSLOT = ((NTOK * 4 + 255) / 256 + NE) * 256;
#ifdef CPU_SHIM
DEV bf16_t f2bf(float f) { unsigned u; memcpy(&u, &f, 4); return (bf16_t)((u + 0x7fffu + ((u >> 16) & 1u)) >> 16); }
DEV float fexp(float x) { return expf(x); }
DEV float frcp(float x) { return 1.0f / x; }
#else
DEV bf16_t f2bf(float f) { const __bf16 b = (__bf16)f; return __builtin_bit_cast(unsigned short, b); }
DEV float fexp(float x) { return __builtin_amdgcn_exp2f(1.4426950408889634f * x); }
DEV float frcp(float x) { return __builtin_amdgcn_rcpf(x); }
#endif
DEV float bf2f(bf16_t b) { const unsigned u = (unsigned)b << 16; float f; memcpy(&f, &u, 4); return f; }
DEV float pxf(float v) { return v; }
DEV float pxf(bf16_t v) { return bf2f(v); }
DEV void pxstore(float* q, float v) { *q = v; }
DEV void pxstore(bf16_t* q, float v) { *q = f2bf(v); }

struct P {
    const float *x, *c, *ctx, *c_ctx, *mod_w, *mod_b, *norm1_g, *norm2_g, *ab_w_in, *ab_w_out, *hy_short_w, *hy_short_b,
        *hy_f_w1, *hy_f_b1, *hy_f_w2, *hy_f_b2, *hy_f_w3, *hy_bias, *s5_lre, *s5_lim, *s5_ldt, *s5_bre, *s5_bim, *s5_cre, *s5_cim,
        *s5_d, *s5_glu_w, *s5_glu_b, *cd_w_in, *cd_w_out, *ret_decay, *swa_sink, *router_w, *router_b, *w_gu, *b_gu, *w_dn, *b_dn, *final_g;
    float* out;
    unsigned* bar;
    float *xa, *modv, *f1, *f2, *hraw, *hsum, *rstd, *hx, *zb, *x0c, *mixin, *s5s, *ys5, *qr, *kr, *oret, *qs, *ks, *topg, *act;
    int* topi;
    px_t* px;
    bf16_t *hxb, *mixb, *ys5b, *xb, *actb, *abin_t, *cdin_t, *about_t, *cdout_t, *glu_t, *wgu_t, *wdn_t;
    bf16_t* yb;
    float *zT, *hT, *modp;
    float *slot_gate, *s5c, *rkv, *rsc, *hpart, *zf, *convT, *yd;
    int *cnt, *pos, *slot_of, *slot_tok;
};

struct RowInfo { int base, len, t, m, kind; };
DEV RowInfo row_info(int r) {
    RowInfo ri;
    if (r < NLAT) { const int b = r / SEQ; ri.base = b * SEQ; ri.len = SEQ; ri.t = r - ri.base; ri.m = b; ri.kind = 0; }
    else { const int rc = r - NLAT, b = rc / CTXL; ri.base = NLAT + b * CTXL; ri.len = CTXL; ri.t = rc - b * CTXL; ri.m = 2; ri.kind = 1; }
    return ri;
}
DEV float sigmoidf_(float x) { return frcp(1.0f + fexp(-x)); }
DEV float siluf_(float x) { return x * sigmoidf_(x); }
DEV float gelu_tanhf_(float x) { const float u = 0.7978845608028654f * (x + 0.044715f * x * x * x); return x * frcp(1.0f + fexp(-2.0f * u)); }

#ifdef CPU_SHIM
#define GSL(i, n) const long _n_##i = (long)(n); for (long i = _n_##i * gt / gs, _hi_##i = _n_##i * (gt + 1) / gs; i < _hi_##i; ++i)
#else
#define GSL(i, n) for (long i = gt; i < (long)(n); i += gs)
#endif

#if MFMA_DENSE
#define MIXST(idx, v) p.mixb[idx] = f2bf(v)
#else
#define MIXST(idx, v) p.mixin[idx] = (v)
#endif
DEV long filt_row0(int i, int kind) { return (long)i * (SEQ + CTXL) + (kind ? SEQ : 0); }

#ifdef CPU_SHIM
#define ROPE_COS(a) cosf(a)
#define ROPE_SIN(a) sinf(a)
#else
#define ROPE_COS(a) __builtin_amdgcn_cosf(__builtin_amdgcn_fractf((a) * 0.15915494309189535f))
#define ROPE_SIN(a) __builtin_amdgcn_sinf(__builtin_amdgcn_fractf((a) * 0.15915494309189535f))
#endif
DEV void ph_init(const P& p, long gt, long gs) {
    GSL(i, (long)NTOK * D) { p.xa[i] = i < (long)NLAT * D ? p.x[i] : p.ctx[i - (long)NLAT * D]; }
    GSL(j, 4 * NE) { p.cnt[j] = 0; }
    GSL(z, D) { p.hxb[(long)NTOK * D + z] = 0; }
}
DEV void ph_mod(const P& p, long gt, long gs) {
    GSL(i, 4L * 6 * D * 8) {
        const int j = (int)(i % (6 * D)), kq = (int)((i / (6 * D)) % 8), l = (int)(i / (6 * D * 8));
        const float* w = p.mod_w + (long)l * D * 6 * D + j;
        float a0 = 0.f, a1 = 0.f, a2 = 0.f;
        for (int k = kq * (D / 8); k < (kq + 1) * (D / 8); ++k) { const float wv = w[(long)k * 6 * D]; a0 += siluf_(p.c[k]) * wv; a1 += siluf_(p.c[D + k]) * wv; a2 += siluf_(p.c_ctx[k]) * wv; }
        float* o = p.modp + ((long)kq * 4 + l) * 3 * 6 * D + j;
        o[0] = a0; o[6 * D] = a1; o[12 * D] = a2;
    }
}
DEV void ph_mod2(const P& p, long gt, long gs) {
    GSL(i, 4L * 3 * 6 * D) {
        const int j = (int)(i % (6 * D)), l = (int)(i / (18 * D));
        float a = p.mod_b[l * 6 * D + j];
#pragma unroll
        for (int kq = 0; kq < 8; ++kq) a += p.modp[(long)kq * 4 * 3 * 6 * D + i];
        p.modv[i] = a;
    }
}
DEV void ph_filt1(const P& p, long gt, long gs) {
    GSL(idx, 2L * (SEQ + CTXL) * 64) {
        const int j = (int)(idx % 64); const long rr = idx / 64; const int i = (int)(rr / (SEQ + CTXL)); const int q = (int)(rr % (SEQ + CTXL));
        const int kind = q >= SEQ, pos = kind ? q - SEQ : q, L = kind ? CTXL : SEQ;
        const float* w1 = p.hy_f_w1 + i * 33 * 64;
        const float t = (float)pos / (float)L, w = 6.283185307179586f * (float)pos / (float)L;
        float acc = t * w1[j];
        for (int bi = 0; bi < 16; ++bi) {
            const float band = 1e-4f + (float)bi * ((15.0f - 1e-4f) / 15.0f);
            acc += ROPE_COS(band * w) * w1[(1 + bi) * 64 + j] - ROPE_SIN(band * w) * w1[(17 + bi) * 64 + j];
        }
        p.f1[idx] = ROPE_SIN(acc + p.hy_f_b1[i * 64 + j]);
    }
}
DEV void ph_filt2(const P& p, long gt, long gs) {
    GSL(idx, 2L * (SEQ + CTXL) * 64) {
        const int j = (int)(idx % 64); const long rr = idx / 64; const int i = (int)(rr / (SEQ + CTXL));
        const float* w2 = p.hy_f_w2 + i * 64 * 64; const float* h1 = p.f1 + rr * 64;
        float acc = 0.f;
        for (int k = 0; k < 64; ++k) acc += h1[k] * w2[k * 64 + j];
        p.f2[idx] = ROPE_SIN(acc + p.hy_f_b2[i * 64 + j]);
    }
}
DEV void ph_filt3(const P& p, long gt, long gs) {
    GSL(idx, 2L * (SEQ + CTXL) * HYW) {
        const int c = (int)(idx % HYW); const long rr = idx / HYW; const int i = (int)(rr / (SEQ + CTXL)); const int q = (int)(rr % (SEQ + CTXL));
        const int kind = q >= SEQ, pos = kind ? q - SEQ : q, L = kind ? CTXL : SEQ;
        const float* w3 = p.hy_f_w3 + (long)i * 64 * HYW; const float* h2 = p.f2 + rr * 64;
        float acc = 0.f;
        for (int k = 0; k < 64; ++k) acc += h2[k] * w3[k * HYW + c];
        const float lag = fabsf((float)(pos - L / 2)) / (float)(L / 2);
        const float fast = -15.350567286626973f, slow = -3.0701134573253946f;
        const float delta = fabsf(fast + (slow - fast) * (float)c / 511.0f);
        const float hv = acc * (expf(-lag * delta) + 0.05f);
        p.hraw[idx] = hv; if (!kind) p.hT[((long)i * HYW + c) * SEQ + pos] = hv;
    }
}
constexpr int FSEG = 64, FNSEG = (SEQ + CTXL) / FSEG;
DEV void ph_filt4a(const P& p, long gt, long gs) {
    GSL(idx, 2L * FNSEG * HYW) {
        const int c = (int)(idx % HYW); const long sg = idx / HYW; const float* h = p.hraw + sg * FSEG * HYW + c;
        float s = 0.f;
        for (int q = 0; q < FSEG; ++q) s += fabsf(h[(long)q * HYW]);
        p.hpart[idx] = s;
    }
}
DEV void ph_filt4(const P& p, long gt, long gs) {
    GSL(idx, 2 * 2 * HYW) {
        const int c = (int)(idx % HYW), kind = (int)((idx / HYW) % 2), i = (int)(idx / (2 * HYW));
        const int s0 = (int)(filt_row0(i, kind) / FSEG), ns = (kind ? CTXL : SEQ) / FSEG;
        float s = 0.f;
        for (int q = 0; q < ns; ++q) s += p.hpart[(long)(s0 + q) * HYW + c];
        p.hsum[idx] = s;
    }
}
DEV void ph_rstd(const P& p, int nrows, long gt, long gs) {
    GSL(r, nrows) {
        const float* xr = p.xa + r * D; float s = 0.f;
        for (int k = 0; k < D; ++k) s += xr[k] * xr[k];
        p.rstd[r] = rsqrtf(s * (1.0f / D) + EPS);
    }
}
DEV void ph_hx(const P& p, int layer, int which, int nrows, long gt, long gs) {
    const float* g = (which ? p.norm2_g : p.norm1_g) + layer * D;
    GSL(i, (long)nrows * D) {
        const int k = (int)(i % D), r = (int)(i / D); const RowInfo ri = row_info(r);
        const float* mv = p.modv + ((long)layer * 3 + ri.m) * 6 * D + which * 3 * D;
        const float v = p.xa[i] * p.rstd[r] * g[k] * (1.0f + mv[D + k]) + mv[k];
        p.hx[i] = v; p.hxb[i] = f2bf(v);
    }
}
DEV void ph_inproj(const P& p, const float* w, int nin, long gt, long gs) {
    GSL(i, (long)NTOK * nin) {
        const int n = (int)(i % nin), r = (int)(i / nin); const float* a = p.hx + (long)r * D; const float* b = w + n;
        float acc = 0.f;
        for (int k = 0; k < D; ++k) acc += a[k] * b[(long)k * nin];
        pxstore(&p.px[(long)r * PXLD + n], acc);
    }
}
DEV void ph_sconv(const P& p, int il, long gt, long gs) {
    const float* sw = p.hy_short_w + il * 3 * 1536; const float* sb = p.hy_short_b + il * 1536;
    GSL(i, (long)NTOK * HYW) {
        const int c = (int)(i % HYW), r = (int)(i / HYW); const RowInfo ri = row_info(r);
        float u[3];
#pragma unroll
        for (int s = 0; s < 3; ++s) {
            const int col = s * HYW + c; float acc = sb[col];
#pragma unroll
            for (int j = 0; j < 3; ++j) { const int tt = ri.t + j - 1; if (tt >= 0 && tt < ri.len) acc += sw[j * 1536 + col] * pxf(p.px[(long)(ri.base + tt) * PXLD + col]); }
            u[s] = acc;
        }
        p.x0c[i] = u[0]; p.zb[i] = u[2] * u[1]; if (r < NLAT) p.zT[(long)c * NLAT + r] = u[2] * u[1];
    }
}
DEV void ph_lconv(const P& p, int il, int r0, int r1, long gt, long gs) {
    GSL(i0, (long)(r1 - r0) * HYW) {
        const long i = i0 + (long)r0 * HYW;
        const int c = (int)(i % HYW), r = (int)(i / HYW); const RowInfo ri = row_info(r);
        const int L = ri.len, t = ri.t;
        const float* h = p.hraw + filt_row0(il, ri.kind) * HYW + c; const float* z = p.zb + (long)ri.base * HYW + c;
        int s0 = t + L / 2 - (L - 1); if (s0 < 0) s0 = 0; int s1 = t + L / 2; if (s1 > L - 1) s1 = L - 1;
        float acc = 0.f;
#pragma unroll 8
        for (int s = s0; s <= s1; ++s) acc += h[(long)(t - s + L / 2) * HYW] * z[(long)s * HYW];
        const float y = acc / p.hsum[(il * 2 + ri.kind) * HYW + c] + p.hy_bias[il * HYW + c] * p.zb[i];
        MIXST((long)r * D + c, p.x0c[i] * y);
    }
}
constexpr int FFTN = 2 * SEQ, FFT_NS = (SEQ == 8192 ? 7 : SEQ == 2048 ? 6 : SEQ == 512 ? 5 : SEQ == 128 ? 4 : -1);
static_assert(FFT_NS > 0 && (1 << (2 * FFT_NS)) == FFTN, "2*SEQ must be a power of 4");
struct CX { float x, y; };
#define PADX(n) ((n) + ((n) >> 5))
constexpr int FFT_ELEMS = FFTN + (FFTN >> 5);
#ifdef CPU_SHIM
#define COS2PI(f) cosf(6.283185307179586f * (f))
#define SIN2PI(f) sinf(6.283185307179586f * (f))
#define FFT_SYNC()
#else
#define COS2PI(f) __builtin_amdgcn_cosf(f)
#define SIN2PI(f) __builtin_amdgcn_sinf(f)
#define FFT_SYNC() __syncthreads()
#endif
template <class XP> DEV CX cx_ld(XP x, int i) { CX r; r.x = x[i].x; r.y = x[i].y; return r; }
template <class XP> DEV void cx_st(XP x, int i, CX v) { x[i].x = v.x; x[i].y = v.y; }
DEV CX cx_add(CX a, CX b) { return CX{a.x + b.x, a.y + b.y}; }
DEV CX cx_sub(CX a, CX b) { return CX{a.x - b.x, a.y - b.y}; }
DEV CX cx_mul(CX a, CX b) { return CX{a.x * b.x - a.y * b.y, a.x * b.y + a.y * b.x}; }
template <class XP> DEV void fft_pass(XP x, int s, bool inv, int tid, int nthr) {
    const int lq = 2 * (FFT_NS - 1 - s), Q = 1 << lq;
    const float invB = 1.0f / (float)(4 * Q);
    for (int t = tid; t < FFTN / 4; t += nthr) {
        const int i = t & (Q - 1), base = ((t >> lq) << (lq + 2)) + i;
        const float f = (float)i * invB, cs = COS2PI(f), sn = SIN2PI(f);
        const CX w1 = CX{cs, inv ? sn : -sn}, w2 = cx_mul(w1, w1), w3 = cx_mul(w2, w1);
        const int i0 = PADX(base), i1 = PADX(base + Q), i2 = PADX(base + 2 * Q), i3 = PADX(base + 3 * Q);
        const CX a = cx_ld(x, i0), b = cx_ld(x, i1), c = cx_ld(x, i2), d = cx_ld(x, i3);
        if (!inv) {
            const CX t0 = cx_add(a, c), t1 = cx_sub(a, c), t2 = cx_add(b, d), bd = cx_sub(b, d), t3 = CX{bd.y, -bd.x};
            cx_st(x, i0, cx_add(t0, t2)); cx_st(x, i1, cx_mul(cx_add(t1, t3), w1)); cx_st(x, i2, cx_mul(cx_sub(t0, t2), w2)); cx_st(x, i3, cx_mul(cx_sub(t1, t3), w3));
        } else {
            const CX y0 = a, y1 = cx_mul(b, w1), y2 = cx_mul(c, w2), y3 = cx_mul(d, w3);
            const CX u0 = cx_add(y0, y2), u1 = cx_sub(y0, y2), u2 = cx_add(y1, y3), yd = cx_sub(y1, y3), u3 = CX{-yd.y, yd.x};
            cx_st(x, i0, cx_add(u0, u2)); cx_st(x, i1, cx_add(u1, u3)); cx_st(x, i2, cx_sub(u0, u2)); cx_st(x, i3, cx_sub(u1, u3));
        }
    }
}
DEV void bfly4(CX& a, CX& b, CX& c, CX& d, CX w1, bool inv, bool tw) {
    const CX w2 = cx_mul(w1, w1), w3 = cx_mul(w2, w1);
    if (!inv) {
        const CX t0 = cx_add(a, c), t1 = cx_sub(a, c), t2 = cx_add(b, d), bd = cx_sub(b, d), t3 = CX{bd.y, -bd.x};
        a = cx_add(t0, t2); b = cx_add(t1, t3); c = cx_sub(t0, t2); d = cx_sub(t1, t3);
        if (tw) { b = cx_mul(b, w1); c = cx_mul(c, w2); d = cx_mul(d, w3); }
    } else {
        CX y1 = b, y2 = c, y3 = d;
        if (tw) { y1 = cx_mul(b, w1); y2 = cx_mul(c, w2); y3 = cx_mul(d, w3); }
        const CX u0 = cx_add(a, y2), u1 = cx_sub(a, y2), u2 = cx_add(y1, y3), yd = cx_sub(y1, y3), u3 = CX{-yd.y, yd.x};
        a = cx_add(u0, u2); b = cx_add(u1, u3); c = cx_sub(u0, u2); d = cx_sub(u1, u3);
    }
}
template <class XP> DEV void fft_pass16(XP x, int s, bool inv, int tid, int nthr) {
    const int lq2 = 2 * (FFT_NS - 2 - s), Q2 = 1 << lq2, Q = 4 * Q2;
    const float invB = 1.0f / (float)(16 * Q2);
    const float sg = inv ? 1.0f : -1.0f;
    const CX c1 = CX{0.9238795325112867f, sg * 0.3826834323650898f}, c2 = CX{0.7071067811865476f, sg * 0.7071067811865476f}, c3 = CX{0.3826834323650898f, sg * 0.9238795325112867f};
    for (int t = tid; t < FFTN / 16; t += nthr) {
        const int i = t & (Q2 - 1), base = ((t >> lq2) << (lq2 + 4)) + i;
        const float f = (float)i * invB, cs = COS2PI(f), sn = SIN2PI(f);
        const CX wA = CX{cs, sg * sn};
        CX wB = cx_mul(wA, wA); wB = cx_mul(wB, wB);
        CX v[4][4];
#pragma unroll
        for (int a = 0; a < 4; ++a)
#pragma unroll
            for (int b = 0; b < 4; ++b) v[a][b] = cx_ld(x, PADX(base + a * Q + b * Q2));
        if (!inv) {
            bfly4(v[0][0], v[1][0], v[2][0], v[3][0], wA, false, true);
            bfly4(v[0][1], v[1][1], v[2][1], v[3][1], cx_mul(wA, c1), false, true);
            bfly4(v[0][2], v[1][2], v[2][2], v[3][2], cx_mul(wA, c2), false, true);
            bfly4(v[0][3], v[1][3], v[2][3], v[3][3], cx_mul(wA, c3), false, true);
#pragma unroll
            for (int r = 0; r < 4; ++r) bfly4(v[r][0], v[r][1], v[r][2], v[r][3], wB, false, true);
        } else {
#pragma unroll
            for (int r = 0; r < 4; ++r) bfly4(v[r][0], v[r][1], v[r][2], v[r][3], wB, true, true);
            bfly4(v[0][0], v[1][0], v[2][0], v[3][0], wA, true, true);
            bfly4(v[0][1], v[1][1], v[2][1], v[3][1], cx_mul(wA, c1), true, true);
            bfly4(v[0][2], v[1][2], v[2][2], v[3][2], cx_mul(wA, c2), true, true);
            bfly4(v[0][3], v[1][3], v[2][3], v[3][3], cx_mul(wA, c3), true, true);
        }
#pragma unroll
        for (int a = 0; a < 4; ++a)
#pragma unroll
            for (int b = 0; b < 4; ++b) cx_st(x, PADX(base + a * Q + b * Q2), v[a][b]);
    }
}
template <class XP> DEV void fft_pass_last(XP x, bool inv, int tid, int nthr) {
    for (int t = tid; t < FFTN / 4; t += nthr) {
        const int base = 4 * t; CX a = cx_ld(x, PADX(base)), b = cx_ld(x, PADX(base + 1)), c = cx_ld(x, PADX(base + 2)), d = cx_ld(x, PADX(base + 3));
        bfly4(a, b, c, d, CX{1.f, 0.f}, inv, false);
        cx_st(x, PADX(base), a); cx_st(x, PADX(base + 1), b); cx_st(x, PADX(base + 2), c); cx_st(x, PADX(base + 3), d);
    }
}
static_assert(FFT_NS % 2 == 1, "pass schedule: (FFT_NS - 1) / 2 radix-16 passes + one radix-4 pass");
template <class XP> DEV void fft_forward(XP x, int tid, int nthr) {
    for (int s = 0; s + 1 < FFT_NS; s += 2) { fft_pass16(x, s, false, tid, nthr); FFT_SYNC(); }
    fft_pass_last(x, false, tid, nthr); FFT_SYNC();
}
template <class XP> DEV void fft_inverse(XP x, int tid, int nthr) {
    fft_pass_last(x, true, tid, nthr); FFT_SYNC();
    for (int s = FFT_NS - 3; s >= 0; s -= 2) { fft_pass16(x, s, true, tid, nthr); FFT_SYNC(); }
}
template <class XP> DEV void lconv_unit(const P& p, int il, int c, XP x, float* zf, int tid, int nthr) {
    constexpr int L = SEQ, N = FFTN;
    const float* zc = p.zT + (long)c * NLAT;
#pragma unroll 8
    for (int n = tid; n < L; n += nthr) { CX v; v.x = zc[n]; v.y = zc[SEQ + n]; cx_st(x, PADX(n), v); }
#pragma unroll 8
    for (int n = L + tid; n < N; n += nthr) cx_st(x, PADX(n), CX{0.f, 0.f});
    FFT_SYNC();
    fft_forward(x, tid, nthr);
    const float* h = p.hT + ((long)il * HYW + c) * SEQ;
#pragma unroll 8
    for (int n = tid; n < L; n += nthr) { const float hv = h[n]; const CX v = cx_ld(x, PADX(n)); zf[2 * n] = v.x; zf[2 * n + 1] = v.y; cx_st(x, PADX(n), CX{hv, 0.f}); }
#pragma unroll 8
    for (int n = L + tid; n < N; n += nthr) { const CX v = cx_ld(x, PADX(n)); zf[2 * n] = v.x; zf[2 * n + 1] = v.y; cx_st(x, PADX(n), CX{0.f, 0.f}); }
    FFT_SYNC();
    fft_forward(x, tid, nthr);
#ifndef CPU_SHIM
    asm volatile("s_waitcnt vmcnt(0)" ::: "memory");
#endif
#pragma unroll 8
    for (int n = tid; n < N; n += nthr) { const CX zv{zf[2 * n], zf[2 * n + 1]}; const CX hv = cx_ld(x, PADX(n)); cx_st(x, PADX(n), cx_mul(hv, zv)); }
    FFT_SYNC();
    fft_inverse(x, tid, nthr);
    const float scale = 1.0f / ((float)N * p.hsum[(il * 2 + 0) * HYW + c]);
    float* o = p.convT + (long)c * NLAT;
#pragma unroll 8
    for (int t = tid; t < L; t += nthr) { const CX v = cx_ld(x, PADX(t + L / 2)); o[t] = v.x * scale; o[L + t] = v.y * scale; }
    FFT_SYNC();
}
#ifdef CPU_SHIM
DEV void ph_lconv_fft(const P& p, int il, long gt, long gs) {
    CX* x = (CX*)malloc(sizeof(CX) * FFT_ELEMS);
    GSL(c, HYW) { lconv_unit(p, il, (int)c, x, p.zf + gt * 2 * FFTN, 0, 1); }
    free(x);
}
#endif
DEV void ph_hymix(const P& p, int il, long gt, long gs) {
    GSL(i, (long)NLAT * HYW) {
        const int c = (int)(i % HYW), r = (int)(i / HYW);
        const float y = p.convT[(long)c * NLAT + r] + p.hy_bias[il * HYW + c] * p.zb[i];
        MIXST((long)r * D + c, p.x0c[i] * y);
    }
}
DEV int scan_row(int dir, int b, int n) {
    if (n < CTXL) return NLAT + b * CTXL + (dir ? CTXL - 1 - n : n);
    const int m = n - CTXL; return b * SEQ + (dir ? SEQ - 1 - m : m);
}
constexpr int S5C = 64, S5NCH = (CTXL + SEQ) / S5C;
struct S5Par { float lbr, lbi; float bbr[GH], bbi[GH]; };
DEV void s5_par(const P& p, int il, int dir, int g, int pp, S5Par& q) {
    const int gi = (il * 2 + dir) * NG + g;
    const float lre = fminf(p.s5_lre[gi * NP + pp], -1e-4f), lim = p.s5_lim[gi * NP + pp], dt = expf(p.s5_ldt[gi]);
    const float mag = expf(lre * dt); q.lbr = mag * cosf(lim * dt); q.lbi = mag * sinf(lim * dt);
    const float nr = q.lbr - 1.0f, ni = q.lbi, den = lre * lre + lim * lim;
    const float fr = (nr * lre + ni * lim) / den, fi = (ni * lre - nr * lim) / den;
#pragma unroll
    for (int h = 0; h < GH; ++h) { const float br = p.s5_bre[((long)gi * NP + pp) * GH + h], bi = p.s5_bim[((long)gi * NP + pp) * GH + h]; q.bbr[h] = fr * br - fi * bi; q.bbi[h] = fr * bi + fi * br; }
}
DEV void ph_s5chunk(const P& p, int il, int fill, long gt, long gs) {
    GSL(i, 2L * 2 * S5NCH * NG * NP) {
        const int pp = (int)(i % NP), g = (int)((i / NP) % NG), ch = (int)((i / (NP * NG)) % S5NCH), b = (int)((i / ((long)NP * NG * S5NCH)) % 2), dir = (int)(i / ((long)NP * NG * S5NCH * 2));
        S5Par q; s5_par(p, il, dir, g, pp, q);
        float* ce = p.s5c + ((((long)dir * 2 + b) * S5NCH + ch) * NG + g) * NP * 2 + pp * 2;
        float sr = 0.f, si = 0.f;
        if (fill) { sr = ce[0]; si = ce[1]; }
        for (int k = 0; k < S5C; ++k) {
            const int row = scan_row(dir, b, ch * S5C + k); const px_t* u = p.px + (long)row * PXLD + 1536 + g * GH;
            float ar = 0.f, ai = 0.f;
#pragma unroll
            for (int h = 0; h < GH; ++h) { ar += q.bbr[h] * pxf(u[h]); ai += q.bbi[h] * pxf(u[h]); }
            const float tr = q.lbr * sr - q.lbi * si + ar, ti = q.lbr * si + q.lbi * sr + ai; sr = tr; si = ti;
            if (fill) { float* o = p.s5s + (((long)dir * NTOK + row) * NG + g) * NP * 2 + pp * 2; o[0] = sr; o[1] = si; }
        }
        if (!fill) { ce[0] = sr; ce[1] = si; }
    }
}
DEV void ph_s5carry(const P& p, int il, long gt, long gs) {
    GSL(i, 2 * 2 * NG * NP) {
        const int pp = (int)(i % NP), g = (int)((i / NP) % NG), b = (int)((i / (NP * NG)) % 2), dir = (int)(i / (NP * NG * 2));
        S5Par q; s5_par(p, il, dir, g, pp, q);
        float pr = q.lbr, pi = q.lbi;
#pragma unroll
        for (int t = 0; t < 6; ++t) { const float nr = pr * pr - pi * pi, ni = 2.0f * pr * pi; pr = nr; pi = ni; }
        float cr = 0.f, ci = 0.f;
        float* ce0 = p.s5c + ((((long)dir * 2 + b) * S5NCH) * NG + g) * NP * 2 + pp * 2;
        constexpr int CB = 12;
        for (int c0 = 0; c0 < S5NCH; c0 += CB) {
            float er[CB], ei[CB];
#pragma unroll
            for (int j = 0; j < CB; ++j) if (c0 + j < S5NCH) { const float* ce = ce0 + (long)(c0 + j) * NG * NP * 2; er[j] = ce[0]; ei[j] = ce[1]; }
#pragma unroll
            for (int j = 0; j < CB; ++j) if (c0 + j < S5NCH) { float* ce = ce0 + (long)(c0 + j) * NG * NP * 2; ce[0] = cr; ce[1] = ci;
                const float tr = pr * cr - pi * ci + er[j], ti = pr * ci + pi * cr + ei[j]; cr = tr; ci = ti; }
        }
    }
}
DEV void ph_s5out(const P& p, int il, long gt, long gs) {
    GSL(i, (long)NTOK * S5W) {
        const int ch = (int)(i % S5W), r = (int)(i / S5W), g = ch / GH, h = ch % GH;
        float y = p.s5_d[il * S5W + ch] * pxf(p.px[(long)r * PXLD + 1536 + ch]);
        for (int dir = 0; dir < 2; ++dir) {
            const long ci = (((long)(il * 2 + dir) * NG + g) * GH + h) * NP;
            const float* s = p.s5s + (((long)dir * NTOK + r) * NG + g) * NP * 2;
            for (int pp = 0; pp < NP; ++pp) y += p.s5_cre[ci + pp] * s[pp * 2] - p.s5_cim[ci + pp] * s[pp * 2 + 1];
        }
        { const float gy = gelu_tanhf_(y); p.ys5[i] = gy; p.ys5b[i] = f2bf(gy); }
    }
}
DEV void ph_s5fin(const P& p, int il, long gt, long gs) {
    GSL(i, (long)NTOK * S5W) {
        const int ch = (int)(i % S5W), r = (int)(i / S5W);
        const float y = p.s5_d[il * S5W + ch] * pxf(p.px[(long)r * PXLD + 1536 + ch]) + p.yd[i] + p.yd[(long)NTOK * S5W + i];
        const float gy = gelu_tanhf_(y); p.ys5b[i] = f2bf(gy);
#ifdef CPU_SHIM
        p.ys5[i] = gy;
#endif
    }
}
DEV void ph_glu(const P& p, int il, long gt, long gs) {
    const float* w = p.s5_glu_w + (long)il * S5W * S5W;
    GSL(i, (long)NTOK * S5W) {
        const int ch = (int)(i % S5W), r = (int)(i / S5W); const float* a = p.ys5 + (long)r * S5W;
        float acc = p.s5_glu_b[il * S5W + ch];
        for (int k = 0; k < S5W; ++k) acc += a[k] * w[(long)k * S5W + ch];
        MIXST((long)r * D + HYW + ch, a[ch] * sigmoidf_(acc));
    }
}
DEV void ph_rope(const P& p, long gt, long gs) {
    GSL(i, (long)NTOK * 576) {
        const int it = (int)(i % 576), r = (int)(i / 576); const RowInfo ri = row_info(r); const px_t* pr = p.px + (long)r * PXLD;
        if (it < 256) {
            const int isk = it >= 128, hd = it & 127, h = hd >> 5, d = hd & 31;
            const px_t* src = pr + (isk ? 256 : 0) + h * 64; float x1 = pxf(src[d]), x2 = pxf(src[d + 32]);
            if (ri.kind == 0) { const float inv = exp2f(-(float)d * (13.287712379549449f / 32.0f)), ang = (float)ri.t * inv, cs = ROPE_COS(ang), sn = ROPE_SIN(ang);
                const float y1 = x1 * cs - x2 * sn, y2 = x1 * sn + x2 * cs; x1 = y1; x2 = y2; }
            const float sc = isk ? 1.0f : 0.125f;
            float* dst = (isk ? p.kr : p.qr) + (long)r * 256 + h * 64; dst[d] = x1 * sc; dst[d + 32] = x2 * sc;
        } else {
            const int j = it - 256, isk = j >= 256, hd = isk ? j - 256 : j, h = hd >> 5, e = hd & 31, half = e >> 4, d = e & 15;
            const px_t* src = pr + (isk ? 2048 : 1536) + h * 64 + half * 32; float x1 = pxf(src[d]), x2 = pxf(src[d + 16]);
            if (ri.kind == 0) { const float pos = (float)(half ? (ri.t % 64) : (ri.t / 64)); const float inv = exp2f(-(float)d * (13.287712379549449f / 16.0f)), ang = pos * inv, cs = ROPE_COS(ang), sn = ROPE_SIN(ang);
                const float y1 = x1 * cs - x2 * sn, y2 = x1 * sn + x2 * cs; x1 = y1; x2 = y2; }
            const float sc = isk ? 1.0f : 0.125f;
            float* dst = (isk ? p.ks + (long)r * 128 : p.qs + (long)r * 512) + h * 64 + half * 32; dst[d] = x1 * sc; dst[d + 16] = x2 * sc;
        }
    }
}
constexpr int RC = 128, RNCH = (CTXL + SEQ) / RC;
DEV float ret_logg(const P& p, int il, int dir, int h) { const float dl = p.ret_decay[(il * 2 + dir) * 4 + h]; return -log1pf(expf(-dl)); }
DEV void ph_retkv(const P& p, int il, long gt, long gs) {
    GSL(i, 2L * 2 * RNCH * 4 * 64 * 128) {
        const int e = (int)(i % 128), d = (int)((i / 128) % 64), h = (int)((i / 8192) % 4), n = (int)((i / 32768) % RNCH), b = (int)((i / (32768L * RNCH)) % 2), dir = (int)(i / (32768L * RNCH * 2));
        const float lg = ret_logg(p, il, dir, h);
        float acc = 0.f;
        for (int j = 0; j < RC; ++j) { const int row = scan_row(dir, b, n * RC + j);
            acc += expf((float)(RC - 1 - j) * lg) * p.kr[(long)row * 256 + h * 64 + d] * pxf(p.px[(long)row * PXLD + 512 + h * 128 + e]); }
        p.rkv[i] = acc;
    }
}
DEV void ph_retcarry(const P& p, int il, long gt, long gs) {
    GSL(i, 2L * 2 * 4 * 64 * 128) {
        const int de = (int)(i % 8192), h = (int)((i / 8192) % 4), b = (int)((i / 32768) % 2), dir = (int)(i / 65536);
        const float gc = expf((float)RC * ret_logg(p, il, dir, h));
        float S = 0.f;
        float* q0 = p.rkv + ((((long)dir * 2 + b) * RNCH) * 4 + h) * 8192 + de;
        constexpr int CB = 11;
        for (int n0 = 0; n0 < RNCH; n0 += CB) {
            float kv[CB];
#pragma unroll
            for (int j = 0; j < CB; ++j) if (n0 + j < RNCH) kv[j] = q0[(long)(n0 + j) * 4 * 8192];
#pragma unroll
            for (int j = 0; j < CB; ++j) if (n0 + j < RNCH) { q0[(long)(n0 + j) * 4 * 8192] = S; S = gc * S + kv[j]; }
        }
    }
}
DEV void ph_retsc(const P& p, int il, long gt, long gs) {
    GSL(i, 2L * NTOK * 4 * RC) {
        const int j = (int)(i % RC), h = (int)((i / RC) % 4), r = (int)((i / (RC * 4)) % NTOK), dir = (int)(i / ((long)RC * 4 * NTOK)); const RowInfo ri = row_info(r);
        const int b = ri.kind ? (ri.base - NLAT) / CTXL : ri.base / SEQ;
        const int step = ri.kind ? (dir ? CTXL - 1 - ri.t : ri.t) : CTXL + (dir ? SEQ - 1 - ri.t : ri.t), ii = step % RC, n = step / RC;
        float sc = 0.f;
        if (j <= ii) { const int rj = scan_row(dir, b, n * RC + j); const float* q = p.qr + (long)r * 256 + h * 64; const float* k = p.kr + (long)rj * 256 + h * 64;
            float dot = 0.f;
            for (int d = 0; d < 64; ++d) dot += q[d] * k[d];
            sc = dot * expf((float)(ii - j) * ret_logg(p, il, dir, h)); }
        p.rsc[i] = sc;
    }
}
DEV void ph_reto(const P& p, int il, long gt, long gs) {
    GSL(i, 2L * NTOK * 512) {
        const int e = (int)(i % 128), h = (int)((i / 128) % 4), r = (int)((i / 512) % NTOK), dir = (int)(i / (512L * NTOK)); const RowInfo ri = row_info(r);
        const int b = ri.kind ? (ri.base - NLAT) / CTXL : ri.base / SEQ;
        const int step = ri.kind ? (dir ? CTXL - 1 - ri.t : ri.t) : CTXL + (dir ? SEQ - 1 - ri.t : ri.t), ii = step % RC, n = step / RC;
        const float* sc = p.rsc + (((long)dir * NTOK + r) * 4 + h) * RC;
        float acc = 0.f;
        for (int j = 0; j <= ii; ++j) { const int rj = scan_row(dir, b, n * RC + j); acc += sc[j] * pxf(p.px[(long)rj * PXLD + 512 + h * 128 + e]); }
        const float* S = p.rkv + ((((long)dir * 2 + b) * RNCH + n) * 4 + h) * 8192 + e; const float* q = p.qr + (long)r * 256 + h * 64;
        float cr = 0.f;
        for (int d = 0; d < 64; ++d) cr += q[d] * S[d * 128];
        p.oret[((long)dir * NTOK + r) * 512 + h * 128 + e] = acc + cr * expf((float)(ii + 1) * ret_logg(p, il, dir, h));
    }
}
DEV void ph_retout(const P& p, int nrows, long gt, long gs) {
    GSL(i, (long)nrows * 4) {
        const int h = (int)(i % 4), r = (int)(i / 4);
        const float* o0 = p.oret + (long)r * 512 + h * 128; const float* o1 = p.oret + ((long)NTOK + r) * 512 + h * 128;
        float ss = 0.f;
        for (int e = 0; e < 128; ++e) { const float o = o0[e] + o1[e]; ss += o * o; }
        const float rs = rsqrtf(ss * (1.0f / 128.0f) + EPS);
        for (int e = 0; e < 128; ++e) MIXST((long)r * D + h * 128 + e, (o0[e] + o1[e]) * rs * siluf_(pxf(p.px[(long)r * PXLD + 1024 + h * 128 + e])));
    }
}
DEV void ph_swa(const P& p, int il, int nrows, long gt, long gs) {
    GSL(i, (long)nrows * 8) {
        const int hq = (int)(i % 8), r = (int)(i / 8), kv = hq >> 2; const RowInfo ri = row_info(r);
        const int b = ri.kind ? (ri.base - NLAT) / CTXL : ri.base / SEQ;
        float q[64], acc[64];
#pragma unroll
        for (int d = 0; d < 64; ++d) { q[d] = p.qs[(long)r * 512 + hq * 64 + d]; acc[d] = 0.f; }
        float m = p.swa_sink[il * 8 + hq], l = 1.0f;
        for (int part = 0; part < 2; ++part) {
            int k0, k1;
            if (part == 0) { if (ri.kind) continue; k0 = ri.base + (ri.t - 128 < 0 ? 0 : ri.t - 128); k1 = ri.base + (ri.t + 128 > SEQ - 1 ? SEQ - 1 : ri.t + 128); }
            else { k0 = NLAT + b * CTXL; k1 = k0 + CTXL - 1; }
            for (int kr = k0; kr <= k1; ++kr) {
                const float* kk = p.ks + (long)kr * 128 + kv * 64; const px_t* vv = p.px + (long)kr * PXLD + 2176 + kv * 64;
                float s = 0.f;
#pragma unroll
                for (int d = 0; d < 64; ++d) s += q[d] * kk[d];
                const float mn = fmaxf(m, s), corr = expf(m - mn), pe = expf(s - mn);
                l = l * corr + pe; m = mn;
#pragma unroll
                for (int d = 0; d < 64; ++d) acc[d] = acc[d] * corr + pe * pxf(vv[d]);
            }
        }
        const float il_ = 1.0f / l;
#pragma unroll
        for (int d = 0; d < 64; ++d) MIXST((long)r * D + 512 + hq * 64 + d, acc[d] * il_);
    }
}
DEV void ph_outproj(const P& p, int layer, const float* w, int nrows, long gt, long gs) {
    GSL(i, (long)nrows * D) {
        const int n = (int)(i % D), r = (int)(i / D); const RowInfo ri = row_info(r);
        const float* a = p.mixin + (long)r * D; const float* b = w + n;
        float acc = 0.f;
        for (int k = 0; k < D; ++k) acc += a[k] * b[(long)k * D];
        p.xa[i] += p.modv[((long)layer * 3 + ri.m) * 6 * D + 2 * D + n] * acc;
    }
}
DEV int atomic_inc(int* q) {
#ifdef CPU_SHIM
    return __atomic_fetch_add(q, 1, __ATOMIC_RELAXED);
#else
    return atomicAdd(q, 1);
#endif
}
DEV void ph_router(const P& p, int layer, int nrows, long gt, long gs) {
    const float* rw = p.router_w + (long)layer * D * NE;
    GSL(j, NSLOT) { p.slot_tok[j] = -1; p.slot_gate[j] = 0.f; }
    GSL(r, nrows) {
        float lg[NE];
#pragma unroll
        for (int e = 0; e < NE; ++e) lg[e] = p.router_b[layer * NE + e];
        const float* a = p.hx + (long)r * D;
        for (int k = 0; k < D; ++k) { const float av = a[k];
#pragma unroll
            for (int e = 0; e < NE; ++e) lg[e] += av * rw[k * NE + e]; }
        int ti[4]; float tv[4];
#pragma unroll
        for (int s = 0; s < 4; ++s) { int best = 0; float bv = -3.0e38f;
#pragma unroll
            for (int e = 0; e < NE; ++e) { if (lg[e] > bv) { bv = lg[e]; best = e; } }
            ti[s] = best; tv[s] = bv;
#pragma unroll
            for (int e = 0; e < NE; ++e) if (e == best) lg[e] = -3.0e38f; }
        const float e1 = expf(tv[1] - tv[0]), e2 = expf(tv[2] - tv[0]), e3 = expf(tv[3] - tv[0]), inv = 1.0f / (1.0f + e1 + e2 + e3);
        p.topi[r * 4 + 0] = ti[0]; p.topi[r * 4 + 1] = ti[1]; p.topi[r * 4 + 2] = ti[2]; p.topi[r * 4 + 3] = ti[3];
        p.topg[r * 4 + 0] = inv; p.topg[r * 4 + 1] = e1 * inv; p.topg[r * 4 + 2] = e2 * inv; p.topg[r * 4 + 3] = e3 * inv;
#pragma unroll
        for (int s = 0; s < 4; ++s) p.pos[r * 4 + s] = atomic_inc(p.cnt + layer * NE + ti[s]);
    }
}
DEV int moe_tiles(const int* cnt) { int t = 0; for (int e = 0; e < NE; ++e) t += (cnt[e] + 255) >> 8; return t; }
DEV int tile_expert(const int* cnt, int pm) { int t = 0; for (int e = 0; e < NE; ++e) { t += (cnt[e] + 255) >> 8; if (pm < t) return e; } return NE - 1; }
DEV void ph_assign(const P& p, int layer, int nrows, long gt, long gs) {
    const int* cnt = p.cnt + layer * NE;
    GSL(i, (long)nrows * 4) {
        const int e = p.topi[i]; int off = 0;
#pragma unroll
        for (int q = 0; q < NE; ++q) { const int cq = cnt[q]; off += q < e ? ((cq + 255) >> 8) << 8 : 0; }
        const int slot = off + p.pos[i];
        p.slot_of[i] = slot; p.slot_tok[slot] = (int)(i >> 2); p.slot_gate[slot] = p.topg[i];
    }
}
DEV void ph_gather(const P& p, int layer, long gt, long gs) {
    const long used = (long)moe_tiles(p.cnt + layer * NE) * 256;
    GSL(i, used * D) { const int k = (int)(i % D); const long slot = i / D; const int tok = p.slot_tok[slot]; p.xb[i] = tok >= 0 ? p.hxb[(long)tok * D + k] : (bf16_t)0; }
}
DEV void ph_moe1s(const P& p, int layer, long gt, long gs) {
    const int* cnt = p.cnt + layer * NE; const long used = (long)moe_tiles(cnt) * 256;
    GSL(i, used * DFF) {
        const int j = (int)(i % DFF); const long slot = i / DFF; const int e = tile_expert(cnt, (int)(slot >> 8));
        const float* w = p.w_gu + ((long)layer * NE + e) * D * 2 * DFF + j; const bf16_t* a = p.xb + slot * D;
        const float* bb = p.b_gu + ((long)layer * NE + e) * 2 * DFF;
        float ga = bb[j], up = bb[DFF + j];
        for (int k = 0; k < D; ++k) { const float av = bf2f(a[k]); ga += av * w[(long)k * 2 * DFF]; up += av * w[(long)k * 2 * DFF + DFF]; }
        ga = fminf(ga, 7.0f); up = fminf(fmaxf(up, -7.0f), 7.0f);
        p.actb[i] = f2bf(ga * sigmoidf_(1.702f * ga) * (up + 1.0f));
    }
}
DEV void ph_moe2s(const P& p, int layer, long gt, long gs) {
    const int* cnt = p.cnt + layer * NE; const long used = (long)moe_tiles(cnt) * 256;
    GSL(i, used * D) {
        const int n = (int)(i % D); const long slot = i / D; const int e = tile_expert(cnt, (int)(slot >> 8));
        const float* w = p.w_dn + ((long)layer * NE + e) * DFF * D + n; const bf16_t* a = p.actb + slot * DFF;
        float acc = p.b_dn[((long)layer * NE + e) * D + n];
        for (int k = 0; k < DFF; ++k) acc += bf2f(a[k]) * w[(long)k * D];
        p.yb[i] = f2bf(acc * p.slot_gate[slot]);
    }
}
DEV void ph_combine(const P& p, int layer, int nrows, long gt, long gs) {
    GSL(i, (long)nrows * D) {
        const int n = (int)(i % D), r = (int)(i / D); const RowInfo ri = row_info(r);
        float y = 0.f;
#pragma unroll
        for (int s = 0; s < 4; ++s) y += bf2f(p.yb[(long)p.slot_of[r * 4 + s] * D + n]);
        p.xa[i] += p.modv[((long)layer * 3 + ri.m) * 6 * D + 5 * D + n] * y;
    }
}
DEV void ph_final(const P& p, long gt, long gs) {
    GSL(i, (long)NLAT * D) { const int k = (int)(i % D), r = (int)(i / D); p.out[i] = p.xa[i] * p.rstd[r] * p.final_g[k]; }
}

constexpr int N_SETUP = 6, N_SLOT = 18;
#ifdef CPU_SHIM
#define SWA_NAIVE ph_swa(p, il, nrows, gt, gs);
#define S5_NAIVE(x) x
#define S5_FIN ph_s5out(p, il, gt, gs);
#define RET_NAIVE_A ph_retkv(p, il, gt, gs); ph_retsc(p, il, gt, gs);
#define RET_NAIVE_C ph_reto(p, il, gt, gs);
#else
#define SWA_NAIVE
#define S5_NAIVE(x)
#define S5_FIN ph_s5fin(p, il, gt, gs);
#define RET_NAIVE_A
#define RET_NAIVE_C
#endif
#ifdef CPU_SHIM
#define LCONV_LAT(p, il, gt, gs) ph_lconv_fft(p, il, gt, gs)
#else
#define LCONV_LAT(p, il, gt, gs)
#endif
template <int S> DEV void setup_slot(const P& p, long gt, long gs) {
    if constexpr (S == 0) { ph_init(p, gt, gs); ph_mod(p, gt, gs); }
    if constexpr (S == 1) { ph_mod2(p, gt, gs); ph_filt1(p, gt, gs); }
    if constexpr (S == 2) ph_filt2(p, gt, gs);
    if constexpr (S == 3) ph_filt3(p, gt, gs);
    if constexpr (S == 4) ph_filt4a(p, gt, gs);
    if constexpr (S == 5) ph_filt4(p, gt, gs);
}
template <int S> DEV void layer_slot(const P& p, int layer, long gt, long gs) {
    const int il = layer >> 1; const bool ab = !(layer & 1);
    const int nrows = layer < 3 ? NTOK : NLAT;
    if constexpr (S == 0) ph_rstd(p, NTOK, gt, gs);
    if constexpr (S == 1) ph_hx(p, layer, 0, NTOK, gt, gs);
    if constexpr (S == 2) { if (ab) ph_inproj(p, p.ab_w_in + (long)il * D * AB_IN, AB_IN, gt, gs); else ph_inproj(p, p.cd_w_in + (long)il * D * CD_IN, CD_IN, gt, gs); }
    if constexpr (S == 3) { if (ab) { ph_sconv(p, il, gt, gs); S5_NAIVE(ph_s5chunk(p, il, 0, gt, gs);) } else ph_rope(p, gt, gs); }
    if constexpr (S == 4) { if (ab) { LCONV_LAT(p, il, gt, gs); ph_lconv(p, il, NLAT, NTOK, gt, gs); ph_s5carry(p, il, gt, gs); } else { RET_NAIVE_A } }
    if constexpr (S == 5) { if (ab) { ph_hymix(p, il, gt, gs); S5_NAIVE(ph_s5chunk(p, il, 1, gt, gs);) } else { ph_retcarry(p, il, gt, gs); SWA_NAIVE } }
    if constexpr (S == 6) { if (ab) { S5_FIN } else { RET_NAIVE_C } }
    if constexpr (S == 7) { if (ab) ph_glu(p, il, gt, gs); else ph_retout(p, nrows, gt, gs); }
    if constexpr (S == 8) ph_outproj(p, layer, (ab ? p.ab_w_out : p.cd_w_out) + (long)il * D * D, nrows, gt, gs);
    if constexpr (S == 9) ph_rstd(p, nrows, gt, gs);
    if constexpr (S == 10) ph_hx(p, layer, 1, nrows, gt, gs);
    if constexpr (S == 11) ph_router(p, layer, nrows, gt, gs);
    if constexpr (S == 12) ph_assign(p, layer, nrows, gt, gs);
    if constexpr (S == 13) ph_gather(p, layer, gt, gs);
    if constexpr (S == 14) ph_moe1s(p, layer, gt, gs);
    if constexpr (S == 15) ph_moe2s(p, layer, gt, gs);
    if constexpr (S == 16) ph_combine(p, layer, nrows, gt, gs);
}
template <int S> DEV void final_slot(const P& p, long gt, long gs) {
    if constexpr (S == 0) ph_rstd(p, NLAT, gt, gs);
    if constexpr (S == 1) ph_final(p, gt, gs);
}

struct WsMap { size_t off[56]; size_t total; };
static inline WsMap ws_map() {
    WsMap m; size_t o = 0; int n = 0;
    auto take = [&](size_t bytes) { m.off[n++] = o; o += (bytes + 255) & ~(size_t)255; };
    take(16384);
    take((size_t)NTOK * D * 4);
    take((size_t)4 * 3 * 6 * D * 4);
    take((size_t)2 * (SEQ + CTXL) * 64 * 4);
    take((size_t)2 * (SEQ + CTXL) * 64 * 4);
    take((size_t)2 * (SEQ + CTXL) * HYW * 4);
    take((size_t)2 * 2 * HYW * 4);
    take((size_t)NTOK * 4);
    take((size_t)NTOK * D * 4);
    take((size_t)NTOK * PXLD * 4);
    take((size_t)NTOK * HYW * 4);
    take((size_t)NTOK * HYW * 4);
    take((size_t)NTOK * D * 4);
    take((size_t)2 * NTOK * NG * NP * 2 * 4);
    take((size_t)NTOK * S5W * 4);
    take((size_t)NTOK * 256 * 4);
    take((size_t)NTOK * 256 * 4);
    take((size_t)2 * NTOK * 512 * 4);
    take((size_t)NTOK * 512 * 4);
    take((size_t)NTOK * 128 * 4);
    take((size_t)NTOK * 4 * 4);
    take((size_t)NTOK * 4 * 4);
    take(256);
    take((size_t)(NTOK + 1) * D * 2);
    take((size_t)NTOK * D * 2);
    take((size_t)NTOK * S5W * 2);
    take((size_t)NSLOT * D * 2);
    take((size_t)NSLOT * DFF * 2);
    take((size_t)NSLOT * D * 4);
    take((size_t)NSLOT * 4);
    take((size_t)4 * NE * 4);
    take((size_t)NTOK * 4 * 4);
    take((size_t)NTOK * 4 * 4);
    take((size_t)NSLOT * 4);
    take((size_t)2 * AB_IN * D * 2);
    take((size_t)2 * CD_IN * D * 2);
    take((size_t)2 * D * D * 2);
    take((size_t)2 * D * D * 2);
    take((size_t)2 * S5W * S5W * 2);
    take((size_t)4 * NE * 2 * DFF * D * 2);
    take((size_t)4 * NE * D * DFF * 2);
    take((size_t)2 * 2 * S5NCH * NG * NP * 2 * 4);
    take((size_t)2 * 2 * RNCH * 4 * 8192 * 4);
    take((size_t)2 * NTOK * 4 * RC * 4);
    take((size_t)2 * FNSEG * HYW * 4);
    take((size_t)256 * 2 * FFTN * 4);
    take((size_t)HYW * NLAT * 4);
    take((size_t)2 * NTOK * S5W * 4);
    take((size_t)HYW * NLAT * 4);
    take((size_t)2 * HYW * SEQ * 4);
    take((size_t)8 * 4 * 3 * 6 * D * 4);
    m.total = o; return m;
}
static inline void fill_params(P& p, void* const* d_in, void* d_out, void* d_ws) {
    const float* const* in = (const float* const*)d_in;
    p.x = in[0]; p.c = in[1]; p.ctx = in[2]; p.c_ctx = in[3]; p.mod_w = in[4]; p.mod_b = in[5]; p.norm1_g = in[6]; p.norm2_g = in[7];
    p.ab_w_in = in[8]; p.ab_w_out = in[9]; p.hy_short_w = in[10]; p.hy_short_b = in[11]; p.hy_f_w1 = in[12]; p.hy_f_b1 = in[13];
    p.hy_f_w2 = in[14]; p.hy_f_b2 = in[15]; p.hy_f_w3 = in[16]; p.hy_bias = in[17]; p.s5_lre = in[18]; p.s5_lim = in[19]; p.s5_ldt = in[20];
    p.s5_bre = in[21]; p.s5_bim = in[22]; p.s5_cre = in[23]; p.s5_cim = in[24]; p.s5_d = in[25]; p.s5_glu_w = in[26]; p.s5_glu_b = in[27];
    p.cd_w_in = in[28]; p.cd_w_out = in[29]; p.ret_decay = in[30]; p.swa_sink = in[31]; p.router_w = in[32]; p.router_b = in[33];
    p.w_gu = in[34]; p.b_gu = in[35]; p.w_dn = in[36]; p.b_dn = in[37]; p.final_g = in[38];
    p.out = (float*)d_out;
    const WsMap m = ws_map(); char* w = (char*)d_ws;
    p.bar = (unsigned*)(w + m.off[0]); p.xa = (float*)(w + m.off[1]); p.modv = (float*)(w + m.off[2]); p.f1 = (float*)(w + m.off[3]); p.f2 = (float*)(w + m.off[4]);
    p.hraw = (float*)(w + m.off[5]); p.hsum = (float*)(w + m.off[6]); p.rstd = (float*)(w + m.off[7]); p.hx = (float*)(w + m.off[8]); p.px = (px_t*)(w + m.off[9]);
    p.zb = (float*)(w + m.off[10]); p.x0c = (float*)(w + m.off[11]); p.mixin = (float*)(w + m.off[12]); p.s5s = (float*)(w + m.off[13]); p.ys5 = (float*)(w + m.off[14]);
    p.qr = (float*)(w + m.off[15]); p.kr = (float*)(w + m.off[16]); p.oret = (float*)(w + m.off[17]); p.qs = (float*)(w + m.off[18]); p.ks = (float*)(w + m.off[19]);
    p.topg = (float*)(w + m.off[20]); p.topi = (int*)(w + m.off[21]); p.act = nullptr;
    p.hxb = (bf16_t*)(w + m.off[23]); p.mixb = (bf16_t*)(w + m.off[24]); p.ys5b = (bf16_t*)(w + m.off[25]); p.xb = (bf16_t*)(w + m.off[26]); p.actb = (bf16_t*)(w + m.off[27]);
    p.yb = (bf16_t*)(w + m.off[28]); p.slot_gate = (float*)(w + m.off[29]); p.cnt = (int*)(w + m.off[30]); p.pos = (int*)(w + m.off[31]); p.slot_of = (int*)(w + m.off[32]);
    p.slot_tok = (int*)(w + m.off[33]); p.abin_t = (bf16_t*)(w + m.off[34]); p.cdin_t = (bf16_t*)(w + m.off[35]); p.about_t = (bf16_t*)(w + m.off[36]);
    p.cdout_t = (bf16_t*)(w + m.off[37]); p.glu_t = (bf16_t*)(w + m.off[38]); p.wgu_t = (bf16_t*)(w + m.off[39]); p.wdn_t = (bf16_t*)(w + m.off[40]);
    p.s5c = (float*)(w + m.off[41]); p.rkv = (float*)(w + m.off[42]); p.rsc = (float*)(w + m.off[43]); p.hpart = (float*)(w + m.off[44]);
    p.zf = (float*)(w + m.off[45]); p.convT = (float*)(w + m.off[46]); p.yd = (float*)(w + m.off[47]); p.zT = (float*)(w + m.off[48]); p.hT = (float*)(w + m.off[49]); p.modp = (float*)(w + m.off[50]);
}

#ifndef CPU_SHIM
namespace pg8 {
#define PG8_LAS __attribute__((address_space(3)))
typedef short bf16x8 __attribute__((ext_vector_type(8)));
typedef float f32x4 __attribute__((ext_vector_type(4)));
constexpr int BM = 256, BK = 64, HALF = 128, HTB = HALF * BK * 2, STAGE_BYTES = 8 * HTB, NXCD = 8, WGM = 8;
__host__ __device__ __forceinline__ int lds_byte(int r, int c) { const int st = (r >> 4) * 2 + (c >> 5), rr = r & 15, cc = c & 31, ob = rr * 64 + cc * 2; return st * 1024 + (ob ^ (((ob >> 9) & 1) << 5)); }
__host__ __device__ __forceinline__ void stage_rc(int b, int& R, int& C) { const int st = b / 1024, sb = b % 1024, swz = sb ^ (((sb >> 9) & 1) << 5); R = (st >> 1) * 16 + swz / 64; C = (st & 1) * 32 + (swz % 64) / 2; }
__host__ __device__ __forceinline__ int perm32(int rho) { const int n = rho >> 4, i = rho & 15; return 8 * (i >> 2) + 4 * n + (i & 3); }
struct Unit { int pm, pn, e; };
struct Gemm { const bf16_t* A; const bf16_t* Bt; int M, N, K; size_t ebytes; };
struct StaticOrder {
    int nM, nN, nwg, G, c;
    __device__ void init(int M, int N, int G_, int c_) { nM = M / BM; nN = N / BM; nwg = nM * nN; G = G_; c = c_; }
    __device__ bool next(int i, Unit& u) const {
        const long L = (long)i * G + c; if (L >= nwg) return false;
        int wgid = (int)L; { const int q = nwg / NXCD, r = nwg % NXCD, xcd = wgid % NXCD, off = wgid / NXCD; wgid = (xcd < r ? xcd * (q + 1) : r * (q + 1) + (xcd - r) * q) + off; }
        const int nig = WGM * nN, gid = wgid / nig, fm = gid * WGM, gsz = (nM - fm) < WGM ? (nM - fm) : WGM;
        u.pm = fm + ((wgid % nig) % gsz); u.pn = (wgid % nig) / gsz; u.e = 0; return true;
    }
    __device__ int tok(int, int) const { return 0; }
};
struct MoeOrder {
    int nwg, nN, G, c; const volatile PG8_LAS unsigned char* ue; const volatile PG8_LAS int* tokt;
    __device__ int tok(int ui, int row) const { return tokt[ui * 256 + row]; }
    __device__ bool unit(int i, int& pm, int& pn) const {
        const int S = G >> 3;
        if ((G & 7) == 0 && S % nN == 0) { const int x = c & 7, slot = c >> 3, pmx = S / nN, T = nwg / nN, tpx = (T + 7) >> 3, lp = i * pmx + slot / nN;
            pm = x * tpx + lp; pn = slot % nN; return lp < tpx && pm < T; }
        const long L = (long)i * G + c; pm = (int)(L / nN); pn = (int)(L % nN); return L < nwg;
    }
    __device__ bool next(int i, Unit& u) const {
        int pm, pn; if (!unit(i, pm, pn)) return false;
        u.pm = pm; u.pn = pn; u.e = __builtin_amdgcn_readfirstlane((int)ue[pm]); return true;
    }
};
template <class Epi, class Sched, bool GATHER = false>
__device__ __forceinline__ void gemm_phase(PG8_LAS unsigned char* lds, const Gemm g, const Sched& S, const Epi& E) {
    int tid = threadIdx.x; asm volatile("" : "+v"(tid));
    const int wid = __builtin_amdgcn_readfirstlane(tid >> 6), lane = tid & 63, wr = wid >> 2, wc = wid & 3, fr = lane & 15, fq = lane >> 4;
    const int K = g.K, nt = K / BK;
    unsigned va[2][2], vn[2][2], voffB[2], voffA0[2]; int Rr[2]; unsigned Cb[2];
#pragma unroll
    for (int i = 0; i < 2; ++i) { int R, C; stage_rc(tid * 16 + i * 8192, R, C); Rr[i] = R; Cb[i] = (unsigned)C * 2u; const int Rb = Epi::PERM ? ((R & ~31) + perm32(R & 31)) : R; voffB[i] = (unsigned)(Rb * K + C) * 2u; voffA0[i] = (unsigned)(R * K + C) * 2u; }
    const size_t kstep = (size_t)(BK * 2);
    const size_t hstep = (size_t)HALF * K * 2;
    const size_t tstep = 2 * hstep;
#define PG8_SETOFF(v, ui_) do { _Pragma("unroll") for (int h_ = 0; h_ < 2; ++h_) _Pragma("unroll") for (int i_ = 0; i_ < 2; ++i_) \
        v[h_][i_] = GATHER ? (unsigned)S.tok(ui_, h_ * HALF + Rr[i_]) * (unsigned)(K * 2) + Cb[i_] : voffA0[i_] + (unsigned)(h_ * hstep); } while (0)
    const unsigned ldsw = (unsigned)wid * 1024u;
    const int aoff = lds_byte(wr * 64 + fr, fq * 8), boff = lds_byte(wc * 32 + fr, fq * 8);
#define PG8_SA(b, h) (((b) * 2 + (h)) * HTB)
#define PG8_SB(b, h) ((4 + (b) * 2 + (h)) * HTB)
#define PG8_STAGE(bufoff, gbase, voff) do { _Pragma("unroll") for (int _i = 0; _i < 2; ++_i) \
        __builtin_amdgcn_global_load_lds((const unsigned*)((const char*)(gbase) + (voff)[_i]), (PG8_LAS unsigned*)(lds + (bufoff) + ldsw + _i * 8192), 16, 0, 0); } while (0)
#define PG8_LDA(dst, b, h) do { _Pragma("unroll") for (int m = 0; m < 4; ++m) _Pragma("unroll") for (int k = 0; k < 2; ++k) dst[m][k] = *(const PG8_LAS bf16x8*)(lds + PG8_SA(b, h) + aoff + m * 2048 + k * 1024); } while (0)
#define PG8_LDB(dst, b, h) do { _Pragma("unroll") for (int n = 0; n < 2; ++n) _Pragma("unroll") for (int k = 0; k < 2; ++k) dst[n][k] = *(const PG8_LAS bf16x8*)(lds + PG8_SB(b, h) + boff + n * 2048 + k * 1024); } while (0)
#define PG8_MMA(ai, bj, At, Bt) do { __builtin_amdgcn_s_setprio(1); _Pragma("unroll") for (int m = 0; m < 4; ++m) _Pragma("unroll") for (int n = 0; n < 2; ++n) _Pragma("unroll") for (int k = 0; k < 2; ++k) \
        acc[ai][bj][m][n] = __builtin_amdgcn_mfma_f32_16x16x32_bf16(Bt[n][k], At[m][k], acc[ai][bj][m][n], 0, 0, 0); __builtin_amdgcn_s_setprio(0); } while (0)
#define PG8_WAIT_V(n) asm volatile("s_waitcnt vmcnt(" #n ")" ::: "memory")
#define PG8_WAIT_L(n) asm volatile("s_waitcnt lgkmcnt(" #n ")" ::: "memory")
#define PG8_BAR __builtin_amdgcn_s_barrier()
#define PG8_SCHED __builtin_amdgcn_sched_barrier(0)
    Unit cur, nxt; int ui = 0;
    if (!S.next(0, cur)) return;
    f32x4 acc[2][2][4][2];
#pragma unroll
    for (int a = 0; a < 2; ++a)
#pragma unroll
        for (int b = 0; b < 2; ++b)
#pragma unroll
            for (int m = 0; m < 4; ++m)
#pragma unroll
                for (int n = 0; n < 2; ++n) acc[a][b][m][n] = (f32x4){0.f, 0.f, 0.f, 0.f};
    bf16x8 At[4][2], B0[2][2], B1[2][2];
    const char* cA = (const char*)g.A + (GATHER ? (size_t)0 : (size_t)cur.pm * tstep); const char* cB = (const char*)g.Bt + (size_t)cur.e * g.ebytes + (size_t)cur.pn * tstep;
    PG8_SETOFF(va, 0);
    PG8_STAGE(PG8_SB(0, 0), cB, voffB); PG8_STAGE(PG8_SB(0, 1), cB + hstep, voffB); PG8_STAGE(PG8_SA(0, 0), cA, va[0]); PG8_STAGE(PG8_SA(0, 1), cA, va[1]);
    if (wr == 1) PG8_BAR;
    PG8_WAIT_V(2); PG8_BAR;
    PG8_STAGE(PG8_SB(1, 0), cB + kstep, voffB); PG8_STAGE(PG8_SA(1, 0), cA + kstep, va[0]); PG8_STAGE(PG8_SB(1, 1), cB + hstep + kstep, voffB);
    PG8_WAIT_V(6); PG8_BAR;
    for (;;) {
        const bool has_next = S.next(ui + 1, nxt);
        const char* nA = has_next ? (const char*)g.A + (GATHER ? (size_t)0 : (size_t)nxt.pm * tstep) : cA; const char* nB = has_next ? (const char*)g.Bt + (size_t)nxt.e * g.ebytes + (size_t)nxt.pn * tstep : cB;
        if (GATHER && has_next) PG8_SETOFF(vn, ui + 1); else { _Pragma("unroll") for (int h_ = 0; h_ < 2; ++h_) _Pragma("unroll") for (int i_ = 0; i_ < 2; ++i_) vn[h_][i_] = va[h_][i_]; }
        for (int t = 0; t < nt; t += 2) {
            const bool last = (t == nt - 2);
            const char* a1 = cA + (size_t)(t + 1) * kstep;
            const char* a2 = last ? nA : cA + (size_t)(t + 2) * kstep; const char* b2 = last ? nB : cB + (size_t)(t + 2) * kstep;
            const char* a3 = a2 + kstep; const char* b3 = b2 + kstep;
            unsigned s0[2], s1[2];
#pragma unroll
            for (int i_ = 0; i_ < 2; ++i_) { s0[i_] = last ? vn[0][i_] : va[0][i_]; s1[i_] = last ? vn[1][i_] : va[1][i_]; }
            PG8_LDB(B0, 0, 0); PG8_LDB(B1, 0, 1); PG8_SCHED; PG8_LDA(At, 0, 0); PG8_STAGE(PG8_SA(1, 1), a1, va[1]);
            PG8_WAIT_V(8); PG8_WAIT_L(0); PG8_BAR; PG8_MMA(0, 0, At, B0); PG8_MMA(0, 1, At, B1); PG8_BAR; PG8_SCHED;
            PG8_LDA(At, 0, 1); PG8_STAGE(PG8_SB(0, 0), b2, voffB); PG8_STAGE(PG8_SB(0, 1), b2 + hstep, voffB); PG8_STAGE(PG8_SA(0, 0), a2, s0);
            PG8_WAIT_V(8); PG8_WAIT_L(0); PG8_BAR; PG8_MMA(1, 0, At, B0); PG8_MMA(1, 1, At, B1); PG8_BAR; PG8_SCHED;
            PG8_LDB(B0, 1, 0); PG8_LDB(B1, 1, 1); PG8_SCHED; PG8_LDA(At, 1, 0); PG8_STAGE(PG8_SA(0, 1), a2, s1);
            PG8_WAIT_V(8); PG8_WAIT_L(0); PG8_BAR; PG8_MMA(0, 0, At, B0); PG8_MMA(0, 1, At, B1); PG8_BAR; PG8_SCHED;
            PG8_LDA(At, 1, 1); PG8_STAGE(PG8_SB(1, 0), b3, voffB); PG8_STAGE(PG8_SB(1, 1), b3 + hstep, voffB); PG8_STAGE(PG8_SA(1, 0), a3, s0);
            PG8_WAIT_V(8); PG8_WAIT_L(0); PG8_BAR; PG8_MMA(1, 0, At, B0); PG8_MMA(1, 1, At, B1); PG8_BAR; PG8_SCHED;
        }
        if (wr == 0) PG8_BAR;
        E(acc, cur, wr, wc, fr, fq);
        if (!has_next) break;
#pragma unroll
        for (int a = 0; a < 2; ++a)
#pragma unroll
            for (int b = 0; b < 2; ++b)
#pragma unroll
                for (int m = 0; m < 4; ++m)
#pragma unroll
                    for (int n = 0; n < 2; ++n) acc[a][b][m][n] = (f32x4){0.f, 0.f, 0.f, 0.f};
        cur = nxt; cA = nA; cB = nB; ++ui;
#pragma unroll
        for (int h_ = 0; h_ < 2; ++h_)
#pragma unroll
            for (int i_ = 0; i_ < 2; ++i_) va[h_][i_] = vn[h_][i_];
        if (wr == 1) PG8_BAR;
    }
    PG8_WAIT_V(0);
    PG8_BAR;
#undef PG8_SA
#undef PG8_SB
#undef PG8_STAGE
#undef PG8_SETOFF
#undef PG8_LDA
#undef PG8_LDB
#undef PG8_MMA
#undef PG8_WAIT_V
#undef PG8_WAIT_L
#undef PG8_BAR
#undef PG8_SCHED
}
typedef float f32x2v __attribute__((ext_vector_type(2)));
typedef __bf16 bf16x2v __attribute__((ext_vector_type(2)));
__device__ __forceinline__ unsigned cvt_pk_bf16(float lo, float hi) { const bf16x2v r = __builtin_convertvector((f32x2v){lo, hi}, bf16x2v); return __builtin_bit_cast(unsigned, r); }
__device__ __forceinline__ float fast_sigmoid(float x) { return __builtin_amdgcn_rcpf(1.0f + __builtin_amdgcn_exp2f(-1.4426950408889634f * x)); }
#define EPI_LOOP(body) _Pragma("unroll") for (int ai = 0; ai < 2; ++ai) _Pragma("unroll") for (int m = 0; m < 4; ++m) { const int row = row0 + ai * HALF + m * 16; \
    _Pragma("unroll") for (int bj = 0; bj < 2; ++bj) _Pragma("unroll") for (int n = 0; n < 2; ++n) { const int col = col0 + bj * HALF + n * 16; const f32x4 a = acc[ai][bj][m][n]; body } }
#define EPI_LOOP_P(body) _Pragma("unroll") for (int ai = 0; ai < 2; ++ai) _Pragma("unroll") for (int m = 0; m < 4; ++m) { const int row = row0 + ai * HALF + m * 16; \
    _Pragma("unroll") for (int bj = 0; bj < 2; ++bj) _Pragma("unroll") for (int n = 0; n < 2; ++n) { const int col = col0 + bj * HALF + n * 4; const f32x4 a = acc[ai][bj][m][n]; body } }
#define EPI_LOOP_P2(body) _Pragma("unroll") for (int ai = 0; ai < 2; ++ai) _Pragma("unroll") for (int m = 0; m < 4; ++m) { const int row = row0 + ai * HALF + m * 16; \
    _Pragma("unroll") for (int bj = 0; bj < 2; ++bj) { const int col = col0 + bj * HALF; const f32x4 a0 = acc[ai][bj][m][0], a1 = acc[ai][bj][m][1]; body } }
struct EpiStoreF32 {
    static constexpr bool PERM = false;
    float* C; int ldc;
    __device__ __forceinline__ void operator()(const f32x4 (&acc)[2][2][4][2], const Unit& u, int wr, int wc, int fr, int fq) const {
        const int row0 = u.pm * BM + wr * 64 + fr, col0 = u.pn * BM + wc * 32 + 4 * fq;
        EPI_LOOP( *(f32x4*)(C + (size_t)row * ldc + col) = a; )
    }
};
struct EpiStoreBf16 {
    static constexpr bool PERM = true;
    bf16_t* C; int ldc;
    __device__ __forceinline__ void operator()(const f32x4 (&acc)[2][2][4][2], const Unit& u, int wr, int wc, int fr, int fq) const {
        const int row0 = u.pm * BM + wr * 64 + fr, col0 = u.pn * BM + wc * 32 + 8 * fq;
        EPI_LOOP_P2( uint4 o; o.x = cvt_pk_bf16(a0[0], a0[1]); o.y = cvt_pk_bf16(a0[2], a0[3]); o.z = cvt_pk_bf16(a1[0], a1[1]); o.w = cvt_pk_bf16(a1[2], a1[3]); *(uint4*)(C + (size_t)row * ldc + col) = o; )
    }
};
struct EpiResid {
    static constexpr bool PERM = false;
    float* X; const float* gv;
    __device__ __forceinline__ void operator()(const f32x4 (&acc)[2][2][4][2], const Unit& u, int wr, int wc, int fr, int fq) const {
        const int row0 = u.pm * BM + wr * 64 + fr, col0 = u.pn * BM + wc * 32 + 4 * fq;
        const int r0 = u.pm * BM, mrow = r0 < SEQ ? 0 : (r0 < NLAT ? 1 : 2); const float* g = gv + (size_t)mrow * 6 * D;
        EPI_LOOP( const f32x4 gg = *(const f32x4*)(g + col); f32x4* q = (f32x4*)(X + (size_t)row * D + col); *q = *q + gg * a; )
    }
};
struct EpiGlu {
    static constexpr bool PERM = true;
    bf16_t* O; const bf16_t* Y; const float* bias;
    __device__ __forceinline__ void operator()(const f32x4 (&acc)[2][2][4][2], const Unit& u, int wr, int wc, int fr, int fq) const {
        const int row0 = u.pm * BM + wr * 64 + fr, col0 = u.pn * BM + wc * 32 + 8 * fq;
        EPI_LOOP_P( const f32x4 bb = *(const f32x4*)(bias + col); const ushort4 yv = *(const ushort4*)(Y + (size_t)row * S5W + col);
            uint2 o; o.x = cvt_pk_bf16(bf2f(yv.x) * fast_sigmoid(a[0] + bb[0]), bf2f(yv.y) * fast_sigmoid(a[1] + bb[1])); o.y = cvt_pk_bf16(bf2f(yv.z) * fast_sigmoid(a[2] + bb[2]), bf2f(yv.w) * fast_sigmoid(a[3] + bb[3]));
            *(uint2*)(O + (size_t)row * D + HYW + col) = o; )
    }
};
struct EpiSwiglu {
    static constexpr bool PERM = true;
    bf16_t* O; const float* bgu;
    __device__ __forceinline__ void operator()(const f32x4 (&acc)[2][2][4][2], const Unit& u, int wr, int wc, int fr, int fq) const {
        const int row0 = u.pm * BM + wr * 64 + fr, colb = wc * 32 + 8 * fq; const float* bb = bgu + (size_t)u.e * 2 * DFF + u.pn * 128;
#pragma unroll
        for (int ai = 0; ai < 2; ++ai)
#pragma unroll
            for (int m = 0; m < 4; ++m) { const int row = row0 + ai * HALF + m * 16;
                { unsigned pk[4];
#pragma unroll
                  for (int n = 0; n < 2; ++n) { const int cc = colb + n * 4; const f32x4 bg = *(const f32x4*)(bb + cc), bu = *(const f32x4*)(bb + DFF + cc);
                    const f32x4 ga = acc[ai][0][m][n] + bg, up = acc[ai][1][m][n] + bu; float av[4];
#pragma unroll
                    for (int j = 0; j < 4; ++j) { const float gg = fminf(ga[j], 7.0f), uu = fminf(fmaxf(up[j], -7.0f), 7.0f); av[j] = gg * fast_sigmoid(1.702f * gg) * (uu + 1.0f); }
                    pk[2 * n] = cvt_pk_bf16(av[0], av[1]); pk[2 * n + 1] = cvt_pk_bf16(av[2], av[3]); }
                  uint4 o; o.x = pk[0]; o.y = pk[1]; o.z = pk[2]; o.w = pk[3];
                  *(uint4*)(O + (size_t)row * DFF + u.pn * 128 + colb) = o; } }
    }
};
struct EpiDown {
    static constexpr bool PERM = true;
    bf16_t* Y; const float* bdn; const float* gate;
    __device__ __forceinline__ void operator()(const f32x4 (&acc)[2][2][4][2], const Unit& u, int wr, int wc, int fr, int fq) const {
        const int row0 = u.pm * BM + wr * 64 + fr, col0 = u.pn * BM + wc * 32 + 8 * fq; const float* bb = bdn + (size_t)u.e * D;
        EPI_LOOP_P2( const f32x4 bv0 = *(const f32x4*)(bb + col); const f32x4 bv1 = *(const f32x4*)(bb + col + 4); const float gt_ = gate[row]; const f32x4 o0 = (a0 + bv0) * gt_; const f32x4 o1 = (a1 + bv1) * gt_;
            uint4 ob; ob.x = cvt_pk_bf16(o0[0], o0[1]); ob.y = cvt_pk_bf16(o0[2], o0[3]); ob.z = cvt_pk_bf16(o1[0], o1[1]); ob.w = cvt_pk_bf16(o1[2], o1[3]); *(uint4*)(Y + (size_t)row * D + col) = ob; )
    }
};
}

constexpr int RING_BYTES = 131072, SCRATCH_BYTES = 135168, MISC_OFF = SCRATCH_BYTES, UE_OFF = MISC_OFF + 64, TOK_OFF = UE_OFF + 320, TOK_UNITS = 11, LDS_BYTES = 147456;
static_assert(FFT_ELEMS * 8 <= SCRATCH_BYTES && TOK_OFF + TOK_UNITS * 1024 <= LDS_BYTES && ((NSLOT / 256 + 7) / 8 + 3) / 4 <= TOK_UNITS, "LDS map");
#define LAS __attribute__((address_space(3)))

__device__ __forceinline__ void transpose_item(const float* W, int K, int N, bf16_t* WT, int gu_perm, LAS float* scr, int item, int lane) {
    const int nblk = N / 32, kb = item / nblk, nb = item % nblk, k0 = 64 * kb, n0 = 32 * nb;
    const int r0 = gu_perm ? (n0 < DFF ? (n0 / 128) * 256 + (n0 % 128) : ((n0 - DFF) / 128) * 256 + 128 + ((n0 - DFF) % 128)) : n0;
#pragma unroll 8
    for (int i = 0; i < 32; ++i) { const int kk = 2 * i + (lane >> 5); scr[kk * 33 + (lane & 31)] = W[(size_t)(k0 + kk) * N + n0 + (lane & 31)]; }
    asm volatile("s_waitcnt lgkmcnt(0)" ::: "memory");
    const int c = lane & 7;
#pragma unroll
    for (int j = 0; j < 4; ++j) { const int n = (lane >> 3) + 8 * j; const LAS float* s = scr + (8 * c) * 33 + n;
        uint4 o; o.x = f2bf(s[0 * 33]) | ((unsigned)f2bf(s[1 * 33]) << 16); o.y = f2bf(s[2 * 33]) | ((unsigned)f2bf(s[3 * 33]) << 16);
        o.z = f2bf(s[4 * 33]) | ((unsigned)f2bf(s[5 * 33]) << 16); o.w = f2bf(s[6 * 33]) | ((unsigned)f2bf(s[7 * 33]) << 16);
        *(uint4*)(WT + (size_t)(r0 + n) * K + k0 + 8 * c) = o; }
    asm volatile("s_waitcnt lgkmcnt(0)" ::: "memory");
}
constexpr int I_GU = (D / 64) * (2 * DFF / 32), I_DN = (DFF / 64) * (D / 32), EXP_ITEMS = NE * (I_GU + I_DN);
__device__ __forceinline__ void convert_expert_item(const P& p, int l, int q, LAS float* scr, int lane) {
    if (q < NE * I_GU) { const int e = q / I_GU; const size_t i = (size_t)l * NE + e; transpose_item(p.w_gu + i * D * 2 * DFF, D, 2 * DFF, p.wgu_t + i * 2 * DFF * D, 1, scr, q % I_GU, lane); }
    else { const int q2 = q - NE * I_GU, e = q2 / I_DN; const size_t i = (size_t)l * NE + e; transpose_item(p.w_dn + i * DFF * D, DFF, D, p.wdn_t + i * D * DFF, 0, scr, q2 % I_DN, lane); }
}
constexpr int DEFER_Q1 = 64, DEFER_Q2 = 140;
__device__ __forceinline__ int defer_idle(int units, int G) { const int rem = units % G; return rem ? G - rem : 0; }
__device__ __forceinline__ int defer_in_units(int layer) { return (NTOK / 256) * ((layer & 1) ? CD_IN / 256 : AB_IN / 256); }
__device__ __forceinline__ int defer_d1(int layer, int G) { const int n = defer_idle(defer_in_units(layer), G) * DEFER_Q1; return n < EXP_ITEMS ? n : EXP_ITEMS; }
__device__ __forceinline__ int defer_d2(int layer, int G) { const int d1 = defer_d1(layer, G), n = d1 + defer_idle((NTOK / 256) * (D / 256), G) * DEFER_Q2; return n < EXP_ITEMS ? n : EXP_ITEMS; }
__device__ __forceinline__ void convert_deferred(const P& p, LAS unsigned char* lds, int layer, int which) {
    int tid = threadIdx.x; asm volatile("" : "+v"(tid));
    int bx_ = (int)blockIdx.x, gx_ = (int)gridDim.x; asm volatile("" : "+s"(bx_), "+s"(gx_));
    const int units = which ? (NTOK / 256) * (D / 256) : defer_in_units(layer), rem = units % gx_;
    if (rem == 0 || bx_ < rem) return;
    const int lane = tid & 63, wave = tid >> 6; LAS float* scr = (LAS float*)(lds + wave * 16384);
    const int qn = which ? DEFER_Q2 : DEFER_Q1, q0 = (which ? defer_d1(layer, gx_) : 0) + (bx_ - rem) * qn, qend = which ? defer_d2(layer, gx_) : defer_d1(layer, gx_);
    for (int q = q0 + wave; q < q0 + qn && q < qend; q += 8) convert_expert_item(p, layer + 1, q, scr, lane);
}
__device__ __forceinline__ void ph_convert_weights(const P& p, LAS unsigned char* lds) {
    int tid = threadIdx.x; asm volatile("" : "+v"(tid));
    const int lane = tid & 63, wave = tid >> 6;
    LAS float* scr = (LAS float*)(lds + wave * 16384);
    const long gw = (long)blockIdx.x * 8 + wave, NGW = (long)gridDim.x * 8; const int G = (int)gridDim.x;
    constexpr long I_ABIN = (D / 64) * (AB_IN / 32), I_CDIN = (D / 64) * (CD_IN / 32), I_OUT = (D / 64) * (D / 32), I_GLU = (S5W / 64) * (S5W / 32);
    constexpr long T0 = 2 * I_ABIN, T1 = T0 + 2 * I_CDIN, T2 = T1 + 2 * I_OUT, T3 = T2 + 2 * I_OUT, T4 = T3 + 2 * I_GLU;
    for (long it = gw; it < T4; it += NGW) {
        if (it < T0) { const int i = (int)(it / I_ABIN); transpose_item(p.ab_w_in + (size_t)i * D * AB_IN, D, AB_IN, p.abin_t + (size_t)i * AB_IN * D, 0, scr, (int)(it % I_ABIN), lane); }
        else if (it < T1) { const long r = it - T0; const int i = (int)(r / I_CDIN); transpose_item(p.cd_w_in + (size_t)i * D * CD_IN, D, CD_IN, p.cdin_t + (size_t)i * CD_IN * D, 0, scr, (int)(r % I_CDIN), lane); }
        else if (it < T2) { const long r = it - T1; const int i = (int)(r / I_OUT); transpose_item(p.ab_w_out + (size_t)i * D * D, D, D, p.about_t + (size_t)i * D * D, 0, scr, (int)(r % I_OUT), lane); }
        else if (it < T3) { const long r = it - T2; const int i = (int)(r / I_OUT); transpose_item(p.cd_w_out + (size_t)i * D * D, D, D, p.cdout_t + (size_t)i * D * D, 0, scr, (int)(r % I_OUT), lane); }
        else { const long r = it - T3; const int i = (int)(r / I_GLU); transpose_item(p.s5_glu_w + (size_t)i * S5W * S5W, S5W, S5W, p.glu_t + (size_t)i * S5W * S5W, 0, scr, (int)(r % I_GLU), lane); }
    }
    for (int l = 0; l < 4; ++l) { const int qs = l ? defer_d2(l - 1, G) : 0;
        for (long q = qs + gw; q < EXP_ITEMS; q += NGW) convert_expert_item(p, l, (int)q, scr, lane); }
}
constexpr int NTHREADS = 512;
__device__ __forceinline__ float wave_sum(float v) {
#pragma unroll
    for (int o = 1; o < 64; o <<= 1) v += __shfl_xor(v, o);
    return v;
}
template <int CTRL> __device__ __forceinline__ float dppf(float v) { return __builtin_bit_cast(float, __builtin_amdgcn_update_dpp(0, __builtin_bit_cast(int, v), CTRL, 0xf, 0xf, false)); }
template <int CTRL> __device__ __forceinline__ int dppi(int v) { return __builtin_amdgcn_update_dpp(0, v, CTRL, 0xf, 0xf, false); }
__device__ __forceinline__ float row16_max(float x) { x = fmaxf(x, dppf<0xB1>(x)); x = fmaxf(x, dppf<0x4E>(x)); x = fmaxf(x, dppf<0x141>(x)); x = fmaxf(x, dppf<0x140>(x)); return x; }
__device__ __forceinline__ float row16_sum(float x) { x += dppf<0xB1>(x); x += dppf<0x4E>(x); x += dppf<0x141>(x); x += dppf<0x140>(x); return x; }
__device__ __forceinline__ int row16_min(int x) { x = min(x, dppi<0xB1>(x)); x = min(x, dppi<0x4E>(x)); x = min(x, dppi<0x141>(x)); x = min(x, dppi<0x140>(x)); return x; }
template <int L> __device__ __forceinline__ float rowb(float v) { return __builtin_bit_cast(float, __builtin_amdgcn_update_dpp(0, __builtin_bit_cast(int, v), 0x150 + L, 0xf, 0xf, false)); }
template <int L> __device__ __forceinline__ void route_steps(float val, const LAS float* wq, float& a0, float& a1) {
    const float xb = rowb<L>(val); const pg8::f32x2v w = *(const LAS pg8::f32x2v*)(wq + (4 * L) * 32);
    a0 += xb * w.x; a1 += xb * w.y;
    if constexpr (L + 1 < 16) route_steps<L + 1>(val, wq, a0, a1);
}
template <int MODE> __device__ __forceinline__ void mf_rownorm(const P& p, LAS unsigned char* lds, int layer, int nrows, int comb_layer) {
    constexpr bool ROUTE = MODE == 1; constexpr int which = MODE == 1 ? 1 : 0;
    int tid = threadIdx.x; asm volatile("" : "+v"(tid));
    int bx_ = (int)blockIdx.x, gx_ = (int)gridDim.x; asm volatile("" : "+s"(bx_), "+s"(gx_));
    const int lane = tid & 63, wave = tid >> 6;
    if (ROUTE) { for (int j = bx_ * NTHREADS + tid; j < NSLOT; j += gx_ * NTHREADS) { p.slot_tok[j] = -1; p.slot_gate[j] = 0.f; } }
    const float* gn = MODE == 2 ? p.final_g : (which ? p.norm2_g : p.norm1_g) + layer * D;
    LAS float* Wl = (LAS float*)lds;
    if (ROUTE) { const float* rw = p.router_w + (size_t)layer * D * NE;
        for (int i = tid; i < D * NE / 4; i += NTHREADS) { const float4 w4 = *(const float4*)(rw + 4 * i); const int k = i >> 3, e0 = (i & 7) * 4, kp = k ^ ((k >> 6) & 1);
            const float wv[4] = {w4.x, w4.y, w4.z, w4.w};
#pragma unroll
            for (int t = 0; t < 4; ++t) { const int e = e0 + t; Wl[kp * 32 + 2 * (e & 15) + (e >> 4)] = wv[t]; } }
        __syncthreads(); }
    volatile LAS int* lcnt = (volatile LAS int*)(lds + RING_BYTES);
    volatile LAS int* lbase = lcnt + NE; volatile LAS int* lrank = lcnt + 2 * NE;
    if (ROUTE) { if (tid < NE) lcnt[tid] = 0; __syncthreads(); }
    for (int r = bx_ * 8 + wave; r < nrows; r += gx_ * 8) {
        const int m = r < SEQ ? 0 : (r < NLAT ? 1 : 2);
        const float* mv = p.modv + ((size_t)layer * 3 + m) * 6 * D + which * 3 * D;
        float* xr = p.xa + (size_t)r * D;
        float4 v[4]; float ss = 0.f;
#pragma unroll
        for (int j = 0; j < 4; ++j) v[j] = *(const float4*)(xr + 256 * j + 4 * lane);
        if (comb_layer >= 0) {
            const float* g2 = p.modv + ((size_t)comb_layer * 3 + m) * 6 * D + 5 * D;
            const int4 so = *(const int4*)(p.slot_of + r * 4);
            const bf16_t* y0 = p.yb + (size_t)so.x * D; const bf16_t* y1 = p.yb + (size_t)so.y * D; const bf16_t* y2 = p.yb + (size_t)so.z * D; const bf16_t* y3 = p.yb + (size_t)so.w * D;
#pragma unroll
            for (int j = 0; j < 4; ++j) { const int k = 256 * j + 4 * lane; const ushort4 a = *(const ushort4*)(y0 + k), b = *(const ushort4*)(y1 + k), c = *(const ushort4*)(y2 + k), d = *(const ushort4*)(y3 + k); const float4 gg = *(const float4*)(g2 + k);
                v[j].x += gg.x * (bf2f(a.x) + bf2f(b.x) + bf2f(c.x) + bf2f(d.x)); v[j].y += gg.y * (bf2f(a.y) + bf2f(b.y) + bf2f(c.y) + bf2f(d.y));
                v[j].z += gg.z * (bf2f(a.z) + bf2f(b.z) + bf2f(c.z) + bf2f(d.z)); v[j].w += gg.w * (bf2f(a.w) + bf2f(b.w) + bf2f(c.w) + bf2f(d.w));
                if (MODE != 2) *(float4*)(xr + k) = v[j]; }
        }
#pragma unroll
        for (int j = 0; j < 4; ++j) ss += v[j].x * v[j].x + v[j].y * v[j].y + v[j].z * v[j].z + v[j].w * v[j].w;
        const float rstd = rsqrtf(wave_sum(ss) * (1.0f / D) + EPS);
        if (MODE == 2) {
#pragma unroll
            for (int j = 0; j < 4; ++j) { const int k = 256 * j + 4 * lane; const float4 g4 = *(const float4*)(gn + k);
                float4 o; o.x = v[j].x * rstd * g4.x; o.y = v[j].y * rstd * g4.y; o.z = v[j].z * rstd * g4.z; o.w = v[j].w * rstd * g4.w;
                *(float4*)(p.out + (size_t)r * D + k) = o; }
            continue;
        }
#pragma unroll
        for (int j = 0; j < 4; ++j) { const int k = 256 * j + 4 * lane; const float4 g4 = *(const float4*)(gn + k), sc = *(const float4*)(mv + D + k), sh = *(const float4*)(mv + k);
            v[j].x = v[j].x * rstd * g4.x * (1.0f + sc.x) + sh.x; v[j].y = v[j].y * rstd * g4.y * (1.0f + sc.y) + sh.y;
            v[j].z = v[j].z * rstd * g4.z * (1.0f + sc.z) + sh.z; v[j].w = v[j].w * rstd * g4.w * (1.0f + sc.w) + sh.w;
            ushort4 o; o.x = f2bf(v[j].x); o.y = f2bf(v[j].y); o.z = f2bf(v[j].z); o.w = f2bf(v[j].w);
            *(ushort4*)(p.hxb + (size_t)r * D + k) = o; }
        if (ROUTE) {
            const int cl = lane & 15, Rr = lane >> 4, r1 = Rr & 1;
            const LAS float* wbE = Wl + (64 * Rr) * 32 + 2 * cl + r1 * 32;
            const LAS float* wbO = Wl + (64 * Rr) * 32 + 2 * cl - r1 * 32;
            float acc0 = 0.f, acc1 = 0.f;
#pragma unroll
            for (int j = 0; j < 4; ++j) { const float vq[4] = {v[j].x, v[j].y, v[j].z, v[j].w};
#pragma unroll
                for (int q = 0; q < 4; ++q) { route_steps<0>(vq[q], ((q & 1) ? wbO : wbE) + (256 * j + q) * 32, acc0, acc1); __builtin_amdgcn_sched_barrier(0); } }
            acc0 += __shfl_xor(acc0, 16); acc0 += __shfl_xor(acc0, 32); acc1 += __shfl_xor(acc1, 16); acc1 += __shfl_xor(acc1, 32);
            acc0 += p.router_b[layer * NE + cl]; acc1 += p.router_b[layer * NE + 16 + cl];
            int ti[4]; float tv[4];
#pragma unroll
            for (int s = 0; s < 4; ++s) {
                const float vmax = row16_max(fmaxf(acc0, acc1));
                const int cand = acc0 == vmax ? cl : (acc1 == vmax ? cl + 16 : 64), best = row16_min(cand);
                ti[s] = best; tv[s] = vmax;
                if (best == cl) acc0 = -3.0e38f; if (best == cl + 16) acc1 = -3.0e38f;
            }
            if (lane == 0) {
                const float e1 = expf(tv[1] - tv[0]), e2 = expf(tv[2] - tv[0]), e3 = expf(tv[3] - tv[0]), inv = 1.0f / (1.0f + e1 + e2 + e3);
                p.topi[r * 4 + 0] = ti[0]; p.topi[r * 4 + 1] = ti[1]; p.topi[r * 4 + 2] = ti[2]; p.topi[r * 4 + 3] = ti[3];
                p.topg[r * 4 + 0] = inv; p.topg[r * 4 + 1] = e1 * inv; p.topg[r * 4 + 2] = e2 * inv; p.topg[r * 4 + 3] = e3 * inv;
                const int li = ((r - (bx_ * 8 + wave)) / (gx_ * 8)) * 8 + wave;
#pragma unroll
                for (int s = 0; s < 4; ++s) lrank[li * 4 + s] = __hip_atomic_fetch_add((LAS int*)(lcnt + ti[s]), 1, __ATOMIC_RELAXED, __HIP_MEMORY_SCOPE_WORKGROUP);
            }
        }
    }
    if (ROUTE) {
        __syncthreads();
        if (tid < NE) lbase[tid] = atomicAdd(p.cnt + layer * NE + tid, lcnt[tid]);
        __syncthreads();
        const int nmine = (nrows - bx_ * 8 + gx_ * 8 - 1) / (gx_ * 8) * 8;
        for (int i = tid; i < nmine * 4; i += NTHREADS) { const int li = i >> 2, r = bx_ * 8 + (li & 7) + (li >> 3) * gx_ * 8;
            if (r < nrows) p.pos[r * 4 + (i & 3)] = lbase[p.topi[i - li * 4 + r * 4]] + lrank[i]; }
    }
}
__device__ __forceinline__ float4 ld4px(const float* q) { return *(const float4*)q; }
__device__ __forceinline__ float4 ld4px(const bf16_t* q) { const ushort4 v = *(const ushort4*)q; return make_float4(bf2f(v.x), bf2f(v.y), bf2f(v.z), bf2f(v.w)); }
typedef unsigned short us4v __attribute__((ext_vector_type(4)));
__device__ __forceinline__ us4v pack4(float4 v) { return (us4v){f2bf(v.x), f2bf(v.y), f2bf(v.z), f2bf(v.w)}; }
template <int K> __device__ __forceinline__ pg8::f32x4 mma16(const LAS bf16_t* A, int lda, const LAS bf16_t* Bt, int ldb, pg8::f32x4 acc, int lane) {
    const int r = lane & 15, q = lane >> 4;
    const LAS bf16_t* ap = A + r * lda + 8 * q; const LAS bf16_t* bp = Bt + r * ldb + 8 * q;
#pragma unroll
    for (int k0 = 0; k0 < K; k0 += 32) acc = __builtin_amdgcn_mfma_f32_16x16x32_bf16(*(const LAS pg8::bf16x8*)(ap + k0), *(const LAS pg8::bf16x8*)(bp + k0), acc, 0, 0, 0);
    return acc;
}
constexpr int RLD = 136, RLQ = 72;
__device__ __forceinline__ void mf_retkv(const P& p, LAS unsigned char* lds, int il) {
    int tid = threadIdx.x; asm volatile("" : "+v"(tid));
    int bx_ = (int)blockIdx.x, gx_ = (int)gridDim.x; asm volatile("" : "+s"(bx_), "+s"(gx_));
    const int lane = tid & 63, wave = tid >> 6, r = lane & 15, q = lane >> 4;
    LAS bf16_t* KdT = (LAS bf16_t*)lds; LAS bf16_t* VT = KdT + 64 * RLD;
    for (int u = bx_; u < 16 * RNCH; u += gx_) {
        const int n = u % RNCH, h = (u / RNCH) & 3, b = (u / (RNCH * 4)) & 1, dir = u / (RNCH * 8);
        const float lg = ret_logg(p, il, dir, h);
        __syncthreads();
        for (int idx = tid; idx < 128 * 16; idx += NTHREADS) { const int j = idx >> 4, d4 = idx & 15, row = scan_row(dir, b, n * RC + j);
            const float4 kv = *(const float4*)(p.kr + (size_t)row * 256 + h * 64 + 4 * d4); const float dk = fexp((float)(RC - 1 - j) * lg);
            KdT[(4 * d4 + 0) * RLD + j] = f2bf(kv.x * dk); KdT[(4 * d4 + 1) * RLD + j] = f2bf(kv.y * dk); KdT[(4 * d4 + 2) * RLD + j] = f2bf(kv.z * dk); KdT[(4 * d4 + 3) * RLD + j] = f2bf(kv.w * dk); }
        for (int idx = tid; idx < 128 * 32; idx += NTHREADS) { const int j = idx >> 5, e4 = idx & 31, row = scan_row(dir, b, n * RC + j);
            const float4 vv = ld4px(p.px + (size_t)row * PXLD + 512 + h * 128 + 4 * e4);
            VT[(4 * e4 + 0) * RLD + j] = f2bf(vv.x); VT[(4 * e4 + 1) * RLD + j] = f2bf(vv.y); VT[(4 * e4 + 2) * RLD + j] = f2bf(vv.z); VT[(4 * e4 + 3) * RLD + j] = f2bf(vv.w); }
        __syncthreads();
        float* o = p.rkv + ((((size_t)dir * 2 + b) * RNCH + n) * 4 + h) * 8192;
#pragma unroll
        for (int td = 0; td < 4; ++td) { pg8::f32x4 acc = {0.f, 0.f, 0.f, 0.f};
            acc = mma16<128>(VT + (16 * wave) * RLD, RLD, KdT + (16 * td) * RLD, RLD, acc, lane);
#pragma unroll
            for (int g = 0; g < 4; ++g) o[(size_t)(16 * wave + 4 * q + g) * 64 + 16 * td + r] = acc[g]; }
    }
}
__device__ __forceinline__ void mf_reto(const P& p, LAS unsigned char* lds, int il) {
    int tid = threadIdx.x; asm volatile("" : "+v"(tid));
    int bx_ = (int)blockIdx.x, gx_ = (int)gridDim.x; asm volatile("" : "+s"(bx_), "+s"(gx_));
    const int lane = tid & 63, wave = tid >> 6, r = lane & 15, q = lane >> 4;
    LAS bf16_t* Qs = (LAS bf16_t*)lds; LAS bf16_t* Ks = Qs + 128 * RLQ; LAS bf16_t* ST = Ks + 128 * RLQ; LAS bf16_t* VT = ST + 128 * RLQ; LAS bf16_t* Ps = VT + 128 * RLD;
    for (int u = bx_; u < 16 * RNCH; u += gx_) {
        const int n = u % RNCH, h = (u / RNCH) & 3, b = (u / (RNCH * 4)) & 1, dir = u / (RNCH * 8);
        const float lg = ret_logg(p, il, dir, h);
        const float* Sg = p.rkv + ((((size_t)dir * 2 + b) * RNCH + n) * 4 + h) * 8192;
        __syncthreads();
        for (int idx = tid; idx < 128 * 16; idx += NTHREADS) { const int j = idx >> 4, d4 = idx & 15, row = scan_row(dir, b, n * RC + j);
            const float4 qv = *(const float4*)(p.qr + (size_t)row * 256 + h * 64 + 4 * d4), kv = *(const float4*)(p.kr + (size_t)row * 256 + h * 64 + 4 * d4), sv = *(const float4*)(Sg + (size_t)j * 64 + 4 * d4);
            *(LAS us4v*)(Qs + j * RLQ + 4 * d4) = pack4(qv); *(LAS us4v*)(Ks + j * RLQ + 4 * d4) = pack4(kv); *(LAS us4v*)(ST + j * RLQ + 4 * d4) = pack4(sv); }
        for (int idx = tid; idx < 128 * 32; idx += NTHREADS) { const int j = idx >> 5, e4 = idx & 31, row = scan_row(dir, b, n * RC + j);
            const float4 vv = ld4px(p.px + (size_t)row * PXLD + 512 + h * 128 + 4 * e4);
            VT[(4 * e4 + 0) * RLD + j] = f2bf(vv.x); VT[(4 * e4 + 1) * RLD + j] = f2bf(vv.y); VT[(4 * e4 + 2) * RLD + j] = f2bf(vv.z); VT[(4 * e4 + 3) * RLD + j] = f2bf(vv.w); }
        __syncthreads();
#pragma unroll
        for (int tj = 0; tj < 8; ++tj) { pg8::f32x4 acc = {0.f, 0.f, 0.f, 0.f};
            acc = mma16<64>(Qs + (16 * wave) * RLQ, RLQ, Ks + (16 * tj) * RLQ, RLQ, acc, lane);
            const int j = 16 * tj + r;
#pragma unroll
            for (int g = 0; g < 4; ++g) { const int i = 16 * wave + 4 * q + g; Ps[i * RLD + j] = f2bf(j <= i ? acc[g] * fexp((float)(i - j) * lg) : 0.f); } }
        __syncthreads();
        float dq[4];
#pragma unroll
        for (int g = 0; g < 4; ++g) dq[g] = fexp((float)(16 * wave + 4 * q + g + 1) * lg);
#pragma unroll
        for (int te = 0; te < 8; ++te) { pg8::f32x4 acc = {0.f, 0.f, 0.f, 0.f}, cr = {0.f, 0.f, 0.f, 0.f};
            acc = mma16<128>(Ps + (16 * wave) * RLD, RLD, VT + (16 * te) * RLD, RLD, acc, lane);
            cr = mma16<64>(Qs + (16 * wave) * RLQ, RLQ, ST + (16 * te) * RLQ, RLQ, cr, lane);
#pragma unroll
            for (int g = 0; g < 4; ++g) { const int i = 16 * wave + 4 * q + g, row = scan_row(dir, b, n * RC + i);
                p.oret[((size_t)dir * NTOK + row) * 512 + h * 128 + 16 * te + r] = acc[g] + dq[g] * cr[g]; } }
    }
}
template <bool FILL> __device__ __forceinline__ void mf_s5(const P& p, LAS unsigned char* lds, int il) {
    int tid = threadIdx.x; asm volatile("" : "+v"(tid));
    int bx_ = (int)blockIdx.x, gx_ = (int)gridDim.x; asm volatile("" : "+s"(bx_), "+s"(gx_));
    const int lane = tid & 63, wave = tid >> 6, r = lane & 15, q = lane >> 4;
    constexpr int LDU = 40, LDS_ = 132, LDB = 136;
    LAS bf16_t* Bt = (LAS bf16_t*)lds;
    LAS bf16_t* Ct = Bt + 128 * LDU;
    LAS unsigned char* wb = lds + 16384 + wave * 14336;
    LAS bf16_t* U = (LAS bf16_t*)wb;
    LAS float* SL = (LAS float*)(wb + 1280);
    LAS bf16_t* Sb = (LAS bf16_t*)(wb + 1280 + 8448);
    constexpr int GRP = (2 * S5NCH) / 8;
    static_assert((2 * S5NCH) % 8 == 0, "chunk count");
    for (int bu = bx_; bu < 64 * GRP; bu += gx_) {
        const int dg = bu / GRP, grp = bu % GRP, dir = dg >> 5, g = dg & 31;
        __syncthreads();
        if (tid < 64) { S5Par sp; s5_par(p, il, dir, g, tid, sp);
#pragma unroll
            for (int h = 0; h < 16; ++h) { Bt[(2 * tid) * LDU + h] = f2bf(sp.bbr[h]); Bt[(2 * tid + 1) * LDU + h] = f2bf(sp.bbi[h]); Bt[(2 * tid) * LDU + 16 + h] = 0; Bt[(2 * tid + 1) * LDU + 16 + h] = 0;
                const long ci = (((long)(il * 2 + dir) * NG + g) * GH + h) * NP + tid; Ct[h * LDB + 2 * tid] = f2bf(p.s5_cre[ci]); Ct[h * LDB + 2 * tid + 1] = f2bf(-p.s5_cim[ci]); } }
        float lbr, lbi; { const int gi = (il * 2 + dir) * NG + g; const float lre = fminf(p.s5_lre[gi * NP + lane], -1e-4f), lim = p.s5_lim[gi * NP + lane], dt = expf(p.s5_ldt[gi]);
            const float mag = expf(lre * dt); lbr = mag * cosf(lim * dt); lbi = mag * sinf(lim * dt); }
        __syncthreads();
        const int bc = grp * 8 + wave, b = bc / S5NCH, ch = bc % S5NCH;
        float* ce = p.s5c + ((((size_t)dir * 2 + b) * S5NCH + ch) * NG + g) * NP * 2 + lane * 2;
        float sr = 0.f, si = 0.f;
        if (FILL) { sr = ce[0]; si = ce[1]; }
        float4 uvs[S5C / 16];
#pragma unroll
        for (int sb = 0; sb < S5C / 16; ++sb) { const int k = lane >> 2, h4 = (lane & 3) * 4, row = scan_row(dir, b, ch * S5C + sb * 16 + k);
            uvs[sb] = ld4px(p.px + (size_t)row * PXLD + 1536 + g * GH + h4); }
#pragma unroll
        for (int sb = 0; sb < S5C / 16; ++sb) {
            { const int k = lane >> 2, h4 = (lane & 3) * 4;
              *(LAS us4v*)(U + k * LDU + h4) = pack4(uvs[sb]); *(LAS us4v*)(U + k * LDU + 16 + h4) = (us4v){0, 0, 0, 0}; }
            asm volatile("s_waitcnt lgkmcnt(0)" ::: "memory");
#pragma unroll
            for (int tc = 0; tc < 8; ++tc) { pg8::f32x4 acc = {0.f, 0.f, 0.f, 0.f};
                acc = mma16<32>(U, LDU, Bt + (16 * tc) * LDU, LDU, acc, lane);
#pragma unroll
                for (int gq = 0; gq < 4; ++gq) SL[(4 * q + gq) * LDS_ + 16 * tc + r] = acc[gq]; }
            asm volatile("s_waitcnt lgkmcnt(0)" ::: "memory");
#pragma unroll
            for (int k = 0; k < 16; ++k) { const float br = SL[k * LDS_ + 2 * lane], bi = SL[k * LDS_ + 2 * lane + 1];
                const float tr = lbr * sr - lbi * si + br, ti = lbr * si + lbi * sr + bi; sr = tr; si = ti;
                if (FILL) { Sb[k * LDB + 2 * lane] = f2bf(sr); Sb[k * LDB + 2 * lane + 1] = f2bf(si); } }
            if (FILL) {
                asm volatile("s_waitcnt lgkmcnt(0)" ::: "memory");
                pg8::f32x4 acc = {0.f, 0.f, 0.f, 0.f};
                acc = mma16<128>(Sb, LDB, Ct, LDB, acc, lane);
#pragma unroll
                for (int gq = 0; gq < 4; ++gq) { const int row = scan_row(dir, b, ch * S5C + sb * 16 + 4 * q + gq); p.yd[((size_t)dir * NTOK + row) * S5W + g * GH + r] = acc[gq]; }
            }
            asm volatile("s_waitcnt lgkmcnt(0)" ::: "memory");
        }
        if (!FILL) { ce[0] = sr; ce[1] = si; }
    }
}
__device__ __forceinline__ void mf_swa(const P& p, LAS unsigned char* lds, int il, bool with_ctx) {
    int tid = threadIdx.x; asm volatile("" : "+v"(tid));
    int bx_ = (int)blockIdx.x, gx_ = (int)gridDim.x; asm volatile("" : "+s"(bx_), "+s"(gx_));
    const int lane = tid & 63, wave = tid >> 6, r = lane & 15, q = lane >> 4;
    constexpr int LDK = 72;
    LAS bf16_t* Ks = (LAS bf16_t*)lds;
    LAS bf16_t* VT = Ks + 64 * LDK;
    LAS bf16_t* Pw = VT + 64 * LDK + wave * 64 * LDK;
    constexpr int NQB = SEQ / 128, NLATU = 4 * NQB, NCTXU = 4 * (CTXL / 128);
    const int nunits = NLATU + (with_ctx ? NCTXU : 0);
    for (int u = bx_; u < nunits; u += gx_) {
        int b, kv, qb, isctx;
        if (u < NLATU) { isctx = 0; qb = u % NQB; kv = (u / NQB) & 1; b = u / (NQB * 2); }
        else { const int v = u - NLATU; isctx = 1; qb = v % (CTXL / 128); kv = (v / (CTXL / 128)) & 1; b = v / ((CTXL / 128) * 2); }
        const int g = wave >> 1, hq = kv * 4 + g, i0 = (wave & 1) * 64;
        const int qrow0 = (isctx ? NLAT + b * CTXL : b * SEQ) + qb * 128 + i0;
        pg8::bf16x8 qf[4][2];
#pragma unroll
        for (int tq = 0; tq < 4; ++tq)
#pragma unroll
            for (int ks = 0; ks < 2; ++ks) { const float* src = p.qs + (size_t)(qrow0 + 16 * tq + r) * 512 + hq * 64 + 32 * ks + 8 * q;
                const float4 a = *(const float4*)src, c = *(const float4*)(src + 4);
                qf[tq][ks] = (pg8::bf16x8){(short)f2bf(a.x), (short)f2bf(a.y), (short)f2bf(a.z), (short)f2bf(a.w), (short)f2bf(c.x), (short)f2bf(c.y), (short)f2bf(c.z), (short)f2bf(c.w)}; }
        pg8::f32x4 oacc[4][4];
        float mrow[4][4], lrow[4][4];
        const float sink = p.swa_sink[il * 8 + hq];
#pragma unroll
        for (int tq = 0; tq < 4; ++tq)
#pragma unroll
            for (int x = 0; x < 4; ++x) { oacc[tq][x] = (pg8::f32x4){0.f, 0.f, 0.f, 0.f}; mrow[tq][x] = sink; lrow[tq][x] = 1.0f; }
        const int ntile = isctx ? 4 : 10;
        for (int t = 0; t < ntile; ++t) {
            const bool loc = !isctx && t < 6;
            const int kpos0 = loc ? 128 * (qb - 1) + 64 * t : 0;
            if (loc && (kpos0 < 0 || kpos0 >= SEQ)) continue;
            const int krow0 = loc ? b * SEQ + kpos0 : NLAT + b * CTXL + 64 * (isctx ? t : t - 6);
            __syncthreads();
            for (int idx = tid; idx < 64 * 16; idx += NTHREADS) { const int key = idx >> 4, d4 = idx & 15;
                const float4 kk = *(const float4*)(p.ks + (size_t)(krow0 + key) * 128 + kv * 64 + 4 * d4), vv = ld4px(p.px + (size_t)(krow0 + key) * PXLD + 2176 + kv * 64 + 4 * d4);
                *(LAS us4v*)(Ks + key * LDK + 4 * d4) = pack4(kk);
                VT[(4 * d4 + 0) * LDK + key] = f2bf(vv.x); VT[(4 * d4 + 1) * LDK + key] = f2bf(vv.y); VT[(4 * d4 + 2) * LDK + key] = f2bf(vv.z); VT[(4 * d4 + 3) * LDK + key] = f2bf(vv.w); }
            __syncthreads();
            pg8::f32x4 sc[4][4];
#pragma unroll
            for (int tk = 0; tk < 4; ++tk) { const LAS bf16_t* kp = Ks + (16 * tk + r) * LDK + 8 * q;
                const pg8::bf16x8 k0 = *(const LAS pg8::bf16x8*)kp, k1 = *(const LAS pg8::bf16x8*)(kp + 32);
#pragma unroll
                for (int tq = 0; tq < 4; ++tq) { pg8::f32x4 a = {0.f, 0.f, 0.f, 0.f};
                    a = __builtin_amdgcn_mfma_f32_16x16x32_bf16(qf[tq][0], k0, a, 0, 0, 0); a = __builtin_amdgcn_mfma_f32_16x16x32_bf16(qf[tq][1], k1, a, 0, 0, 0); sc[tq][tk] = a; } }
            if (loc) {
#pragma unroll
                for (int tq = 0; tq < 4; ++tq)
#pragma unroll
                    for (int tk = 0; tk < 4; ++tk)
#pragma unroll
                        for (int x = 0; x < 4; ++x) { const int dlt = (kpos0 + 16 * tk + r) - (128 * qb + i0 + 16 * tq + 4 * q + x); if (dlt > 128 || dlt < -128) sc[tq][tk][x] = -1e30f; }
            }
#pragma unroll
            for (int tq = 0; tq < 4; ++tq)
#pragma unroll
                for (int x = 0; x < 4; ++x) {
                    float mx = fmaxf(fmaxf(sc[tq][0][x], sc[tq][1][x]), fmaxf(sc[tq][2][x], sc[tq][3][x]));
                    mx = row16_max(mx);
                    const float mn = fmaxf(mrow[tq][x], mx), corr = __expf(mrow[tq][x] - mn);
                    float sum = 0.f;
#pragma unroll
                    for (int tk = 0; tk < 4; ++tk) { const float pe = __expf(sc[tq][tk][x] - mn); sum += pe; Pw[(16 * tq + 4 * q + x) * LDK + 16 * tk + r] = f2bf(pe); }
                    sum = row16_sum(sum);
                    lrow[tq][x] = lrow[tq][x] * corr + sum; mrow[tq][x] = mn;
#pragma unroll
                    for (int td = 0; td < 4; ++td) oacc[tq][td][x] *= corr;
                }
            asm volatile("s_waitcnt lgkmcnt(0)" ::: "memory");
#pragma unroll
            for (int td = 0; td < 4; ++td) { const LAS bf16_t* vp = VT + (16 * td + r) * LDK + 8 * q;
                const pg8::bf16x8 v0 = *(const LAS pg8::bf16x8*)vp, v1 = *(const LAS pg8::bf16x8*)(vp + 32);
#pragma unroll
                for (int tq = 0; tq < 4; ++tq) { const LAS bf16_t* pp = Pw + (16 * tq + r) * LDK + 8 * q;
                    oacc[tq][td] = __builtin_amdgcn_mfma_f32_16x16x32_bf16(*(const LAS pg8::bf16x8*)pp, v0, oacc[tq][td], 0, 0, 0);
                    oacc[tq][td] = __builtin_amdgcn_mfma_f32_16x16x32_bf16(*(const LAS pg8::bf16x8*)(pp + 32), v1, oacc[tq][td], 0, 0, 0); } }
        }
#pragma unroll
        for (int tq = 0; tq < 4; ++tq)
#pragma unroll
            for (int x = 0; x < 4; ++x) { const float inv = 1.0f / lrow[tq][x]; bf16_t* o = p.mixb + (size_t)(qrow0 + 16 * tq + 4 * q + x) * D + 512 + hq * 64 + r;
#pragma unroll
                for (int td = 0; td < 4; ++td) o[16 * td] = f2bf(oacc[tq][td][x] * inv); }
    }
}
__device__ __forceinline__ void mf_sconv(const P& p, LAS unsigned char* lds, int il) {
    int tid = threadIdx.x; asm volatile("" : "+v"(tid));
    int bx_ = (int)blockIdx.x, gx_ = (int)gridDim.x; asm volatile("" : "+s"(bx_), "+s"(gx_));
    LAS float* T = (LAS float*)lds;
    const float* sw = p.hy_short_w + il * 3 * 1536; const float* sb = p.hy_short_b + il * 1536;
    constexpr int NT = (NTOK / 64) * (HYW / 64);
    for (int t = bx_; t < NT; t += gx_) {
        const int r0 = (t / (HYW / 64)) * 64, c0 = (t % (HYW / 64)) * 64;
        const int rl = tid >> 3, cs = (tid & 7) * 8, r = r0 + rl; const RowInfo ri = row_info(r);
        float u[3][8];
#pragma unroll
        for (int g = 0; g < 3; ++g) { const int col = g * HYW + c0 + cs; const float4 b0 = *(const float4*)(sb + col), b1 = *(const float4*)(sb + col + 4);
            u[g][0] = b0.x; u[g][1] = b0.y; u[g][2] = b0.z; u[g][3] = b0.w; u[g][4] = b1.x; u[g][5] = b1.y; u[g][6] = b1.z; u[g][7] = b1.w;
#pragma unroll
            for (int j = 0; j < 3; ++j) { const int tt = ri.t + j - 1; if (tt >= 0 && tt < ri.len) { const px_t* px = p.px + (size_t)(ri.base + tt) * PXLD + col; const float* wj = sw + j * 1536 + col;
                const float4 x0 = ld4px(px), x1 = ld4px(px + 4), w0 = *(const float4*)wj, w1 = *(const float4*)(wj + 4);
                u[g][0] += w0.x * x0.x; u[g][1] += w0.y * x0.y; u[g][2] += w0.z * x0.z; u[g][3] += w0.w * x0.w; u[g][4] += w1.x * x1.x; u[g][5] += w1.y * x1.y; u[g][6] += w1.z * x1.z; u[g][7] += w1.w * x1.w; } } }
        float z[8];
#pragma unroll
        for (int k = 0; k < 8; ++k) z[k] = u[2][k] * u[1][k];
        const size_t i = (size_t)r * HYW + c0 + cs;
        *(float4*)(p.x0c + i) = make_float4(u[0][0], u[0][1], u[0][2], u[0][3]); *(float4*)(p.x0c + i + 4) = make_float4(u[0][4], u[0][5], u[0][6], u[0][7]);
        *(float4*)(p.zb + i) = make_float4(z[0], z[1], z[2], z[3]); *(float4*)(p.zb + i + 4) = make_float4(z[4], z[5], z[6], z[7]);
        if (r0 < NLAT) {
            __syncthreads();
#pragma unroll
            for (int k = 0; k < 8; ++k) T[(cs + k) * 65 + rl] = z[k];
            __syncthreads();
            const int cl = tid >> 3, rs = (tid & 7) * 8; const LAS float* src = T + cl * 65 + rs; float* dst = p.zT + (size_t)(c0 + cl) * NLAT + r0 + rs;
            *(float4*)dst = make_float4(src[0], src[1], src[2], src[3]); *(float4*)(dst + 4) = make_float4(src[4], src[5], src[6], src[7]);
        }
    }
}
__device__ __forceinline__ void mf_filter_tiles(const P& p, LAS unsigned char* lds) {
    int tid = threadIdx.x; asm volatile("" : "+v"(tid));
    int bx_ = (int)blockIdx.x, gx_ = (int)gridDim.x; asm volatile("" : "+s"(bx_), "+s"(gx_));
    LAS float* A1 = (LAS float*)lds; LAS float* A2 = A1 + 64 * 65; LAS float* T = A2 + 64 * 65;
    constexpr int RT = (SEQ + CTXL) / 64;
    const int rl = tid >> 3, cs = (tid & 7) * 8;
    constexpr int NLT = 2 * (SEQ / 64), NCT = 2 * (CTXL / 64), NITEM = NLT + NCT * (HYW / 64);
    for (int it = bx_; it < NITEM; it += gx_) {
        int t, ct0, ct1;
        if (it < NLT) { t = (it / (SEQ / 64)) * RT + it % (SEQ / 64); ct0 = 0; ct1 = HYW / 64; }
        else { const int v = it - NLT, tc = v / (HYW / 64); t = (tc / (CTXL / 64)) * RT + SEQ / 64 + tc % (CTXL / 64); ct0 = v % (HYW / 64); ct1 = ct0 + 1; }
        const int i = t / RT, rt = t % RT, q0 = rt * 64, kind = q0 >= SEQ, L = kind ? CTXL : SEQ, q = q0 + rl, pos = kind ? q - SEQ : q;
        const long rr = (long)i * (SEQ + CTXL) + q;
        __syncthreads();
        {
            const float* w1 = p.hy_f_w1 + i * 33 * 64 + cs; const float tt = (float)pos / (float)L, w = 6.283185307179586f * (float)pos / (float)L;
            float acc[8];
#pragma unroll
            for (int k = 0; k < 8; ++k) acc[k] = tt * w1[k];
            for (int bi = 0; bi < 16; ++bi) { const float band = 1e-4f + (float)bi * ((15.0f - 1e-4f) / 15.0f), cc = ROPE_COS(band * w), sn = ROPE_SIN(band * w);
                const float* wc = w1 + (1 + bi) * 64; const float* ws = w1 + (17 + bi) * 64;
#pragma unroll
                for (int k = 0; k < 8; ++k) acc[k] += cc * wc[k] - sn * ws[k]; }
#pragma unroll
            for (int k = 0; k < 8; ++k) A1[rl * 65 + cs + k] = ROPE_SIN(acc[k] + p.hy_f_b1[i * 64 + cs + k]);
        }
        __syncthreads();
        {
            const float* w2 = p.hy_f_w2 + i * 64 * 64 + cs; float acc[8];
#pragma unroll
            for (int k = 0; k < 8; ++k) acc[k] = 0.f;
            for (int kk = 0; kk < 64; ++kk) { const float hv = A1[rl * 65 + kk]; const float4 a = *(const float4*)(w2 + kk * 64), b4 = *(const float4*)(w2 + kk * 64 + 4);
                acc[0] += hv * a.x; acc[1] += hv * a.y; acc[2] += hv * a.z; acc[3] += hv * a.w; acc[4] += hv * b4.x; acc[5] += hv * b4.y; acc[6] += hv * b4.z; acc[7] += hv * b4.w; }
#pragma unroll
            for (int k = 0; k < 8; ++k) A2[rl * 65 + cs + k] = ROPE_SIN(acc[k] + p.hy_f_b2[i * 64 + cs + k]);
        }
        __syncthreads();
        const float lag = fabsf((float)(pos - L / 2)) / (float)(L / 2);
        for (int ct = ct0; ct < ct1; ++ct) {
            const int c0 = ct * 64; const float* w3 = p.hy_f_w3 + (size_t)i * 64 * HYW + c0 + cs;
            float acc[8];
#pragma unroll
            for (int k = 0; k < 8; ++k) acc[k] = 0.f;
            for (int kk = 0; kk < 64; ++kk) { const float hv = A2[rl * 65 + kk]; const float4 a = *(const float4*)(w3 + (size_t)kk * HYW), b4 = *(const float4*)(w3 + (size_t)kk * HYW + 4);
                acc[0] += hv * a.x; acc[1] += hv * a.y; acc[2] += hv * a.z; acc[3] += hv * a.w; acc[4] += hv * b4.x; acc[5] += hv * b4.y; acc[6] += hv * b4.z; acc[7] += hv * b4.w; }
            const float fast = -15.350567286626973f, slow = -3.0701134573253946f;
#pragma unroll
            for (int k = 0; k < 8; ++k) { const float delta = fabsf(fast + (slow - fast) * (float)(c0 + cs + k) / 511.0f); acc[k] *= fexp(-lag * delta) + 0.05f; }
            float* o = p.hraw + rr * HYW + c0 + cs;
            *(float4*)o = make_float4(acc[0], acc[1], acc[2], acc[3]); *(float4*)(o + 4) = make_float4(acc[4], acc[5], acc[6], acc[7]);
            __syncthreads();
#pragma unroll
            for (int k = 0; k < 8; ++k) T[(cs + k) * 65 + rl] = acc[k];
            __syncthreads();
            const int cl = tid >> 3, rs = (tid & 7) * 8; const LAS float* src = T + cl * 65 + rs;
            float v8[8];
#pragma unroll
            for (int k = 0; k < 8; ++k) v8[k] = src[k];
            if (!kind) { float* dst = p.hT + ((size_t)i * HYW + c0 + cl) * SEQ + q0 + rs;
                *(float4*)dst = make_float4(v8[0], v8[1], v8[2], v8[3]); *(float4*)(dst + 4) = make_float4(v8[4], v8[5], v8[6], v8[7]); }
            float sa = 0.f;
#pragma unroll
            for (int k = 0; k < 8; ++k) sa += fabsf(v8[k]);
            sa += __shfl_xor(sa, 1); sa += __shfl_xor(sa, 2); sa += __shfl_xor(sa, 4);
            if ((tid & 7) == 0) p.hpart[(size_t)t * HYW + c0 + cl] = sa;
        }
    }
}
__device__ __forceinline__ void mf_hymix(const P& p, LAS unsigned char* lds, int il) {
    int tid = threadIdx.x; asm volatile("" : "+v"(tid));
    int bx_ = (int)blockIdx.x, gx_ = (int)gridDim.x; asm volatile("" : "+s"(bx_), "+s"(gx_));
    LAS float* T = (LAS float*)lds;
    constexpr int NT = (NLAT / 64) * (HYW / 64);
    for (int t = bx_; t < NT; t += gx_) {
        const int r0 = (t / (HYW / 64)) * 64, c0 = (t % (HYW / 64)) * 64;
        __syncthreads();
        { const int cl = tid >> 3, rs = (tid & 7) * 8; const float* src = p.convT + (size_t)(c0 + cl) * NLAT + r0 + rs; const float4 a = *(const float4*)src, b = *(const float4*)(src + 4);
          LAS float* d = T + cl * 65 + rs; d[0] = a.x; d[1] = a.y; d[2] = a.z; d[3] = a.w; d[4] = b.x; d[5] = b.y; d[6] = b.z; d[7] = b.w; }
        __syncthreads();
        { const int rl = tid >> 3, cs = (tid & 7) * 8; const size_t i = (size_t)(r0 + rl) * HYW + c0 + cs;
          const float4 z0 = *(const float4*)(p.zb + i), z1 = *(const float4*)(p.zb + i + 4), x0 = *(const float4*)(p.x0c + i), x1 = *(const float4*)(p.x0c + i + 4);
          const float4 b0 = *(const float4*)(p.hy_bias + il * HYW + c0 + cs), b1 = *(const float4*)(p.hy_bias + il * HYW + c0 + cs + 4);
          const float zz[8] = {z0.x, z0.y, z0.z, z0.w, z1.x, z1.y, z1.z, z1.w}, xx[8] = {x0.x, x0.y, x0.z, x0.w, x1.x, x1.y, x1.z, x1.w}, bb[8] = {b0.x, b0.y, b0.z, b0.w, b1.x, b1.y, b1.z, b1.w};
          unsigned short o[8];
#pragma unroll
          for (int k = 0; k < 8; ++k) o[k] = f2bf(xx[k] * (T[(cs + k) * 65 + rl] + bb[k] * zz[k]));
          uint4 ov; ov.x = o[0] | ((unsigned)o[1] << 16); ov.y = o[2] | ((unsigned)o[3] << 16); ov.z = o[4] | ((unsigned)o[5] << 16); ov.w = o[6] | ((unsigned)o[7] << 16);
          *(uint4*)(p.mixb + (size_t)(r0 + rl) * D + c0 + cs) = ov; }
    }
}
__device__ __forceinline__ void mf_retout(const P& p, int nrows) {
    int tid = threadIdx.x; asm volatile("" : "+v"(tid));
    int bx_ = (int)blockIdx.x, gx_ = (int)gridDim.x; asm volatile("" : "+s"(bx_), "+s"(gx_));
    const int lane = tid & 63, wave = tid >> 6;
    for (int r = bx_ * 8 + wave; r < nrows; r += gx_ * 8) {
        const float* o0 = p.oret + (size_t)r * 512 + 8 * lane; const float* o1 = p.oret + ((size_t)NTOK + r) * 512 + 8 * lane; const px_t* gp = p.px + (size_t)r * PXLD + 1024 + 8 * lane;
        const float4 a0 = *(const float4*)o0, a1 = *(const float4*)(o0 + 4), b0 = *(const float4*)o1, b1 = *(const float4*)(o1 + 4), g0 = ld4px(gp), g1 = ld4px(gp + 4);
        const float o[8] = {a0.x + b0.x, a0.y + b0.y, a0.z + b0.z, a0.w + b0.w, a1.x + b1.x, a1.y + b1.y, a1.z + b1.z, a1.w + b1.w}, gg[8] = {g0.x, g0.y, g0.z, g0.w, g1.x, g1.y, g1.z, g1.w};
        float ss = 0.f;
#pragma unroll
        for (int k = 0; k < 8; ++k) ss += o[k] * o[k];
        ss = row16_sum(ss);
        const float rs = rsqrtf(ss * (1.0f / 128.0f) + EPS);
        unsigned short ob[8];
#pragma unroll
        for (int k = 0; k < 8; ++k) ob[k] = f2bf(o[k] * rs * siluf_(gg[k]));
        uint4 ov; ov.x = ob[0] | ((unsigned)ob[1] << 16); ov.y = ob[2] | ((unsigned)ob[3] << 16); ov.z = ob[4] | ((unsigned)ob[5] << 16); ov.w = ob[6] | ((unsigned)ob[7] << 16);
        *(uint4*)(p.mixb + (size_t)r * D + 8 * lane) = ov;
    }
}
__device__ __forceinline__ void mf_lconv(const P& p, LAS unsigned char* lds, int il) {
    int tid = threadIdx.x; asm volatile("" : "+v"(tid));
    int bx_ = (int)blockIdx.x, gx_ = (int)gridDim.x; asm volatile("" : "+s"(bx_), "+s"(gx_));
    for (int c = bx_; c < HYW; c += gx_) lconv_unit(p, il, c, (LAS CX*)lds, p.zf + (size_t)bx_ * 2 * FFTN, tid, NTHREADS);
}
__device__ __forceinline__ void mf_inproj(const P& p, LAS unsigned char* lds, int layer) {
    const int il = layer >> 1; const bool ab = !(layer & 1);
    pg8::Gemm g{p.hxb, ab ? p.abin_t + (size_t)il * AB_IN * D : p.cdin_t + (size_t)il * CD_IN * D, NTOK, ab ? AB_IN : CD_IN, D, 0};
    int gx_ = (int)gridDim.x, bx_ = (int)blockIdx.x; asm volatile("" : "+s"(gx_), "+s"(bx_));
    pg8::StaticOrder S; S.init(g.M, g.N, gx_, bx_);
    pg8::EpiStoreBf16 E{p.px, PXLD};
    pg8::gemm_phase(lds, g, S, E);
}
__device__ __forceinline__ void mf_outproj(const P& p, LAS unsigned char* lds, int layer, int nrows) {
    const int il = layer >> 1; const bool ab = !(layer & 1);
    pg8::Gemm g{p.mixb, (ab ? p.about_t : p.cdout_t) + (size_t)il * D * D, nrows, D, D, 0};
    int gx_ = (int)gridDim.x, bx_ = (int)blockIdx.x; asm volatile("" : "+s"(gx_), "+s"(bx_));
    pg8::StaticOrder S; S.init(g.M, g.N, gx_, bx_);
    pg8::EpiResid E{p.xa, p.modv + (size_t)layer * 3 * 6 * D + 2 * D};
    pg8::gemm_phase(lds, g, S, E);
}
__device__ __forceinline__ void mf_glu(const P& p, LAS unsigned char* lds, int il) {
    pg8::Gemm g{p.ys5b, p.glu_t + (size_t)il * S5W * S5W, NTOK, S5W, S5W, 0};
    int gx_ = (int)gridDim.x, bx_ = (int)blockIdx.x; asm volatile("" : "+s"(gx_), "+s"(bx_));
    pg8::StaticOrder S; S.init(g.M, g.N, gx_, bx_);
    pg8::EpiGlu E{p.mixb, p.ys5b, p.s5_glu_b + il * S5W};
    pg8::gemm_phase(lds, g, S, E);
}
__device__ __forceinline__ int build_ue(const P& p, LAS unsigned char* lds, int layer) {
    volatile LAS unsigned char* ue = (volatile LAS unsigned char*)(lds + UE_OFF); volatile LAS int* tot = (volatile LAS int*)(lds + MISC_OFF + 16);
    __syncthreads();
    if (threadIdx.x == 0) { const int* cnt = p.cnt + layer * NE; int t = 0;
        for (int e = 0; e < NE; ++e) { const int nt = (cnt[e] + 255) >> 8; for (int q = 0; q < nt; ++q) ue[t + q] = (unsigned char)e; t += nt; }
        *tot = t; }
    __syncthreads();
    return *tot;
}
__device__ __forceinline__ void mf_moe1(const P& p, LAS unsigned char* lds, int layer) {
    const int tiles = build_ue(p, lds, layer);
    int gx_ = (int)gridDim.x, bx_ = (int)blockIdx.x; asm volatile("" : "+s"(gx_), "+s"(bx_));
    pg8::MoeOrder S{tiles * 8, 8, gx_, bx_, (const volatile LAS unsigned char*)(lds + UE_OFF), (const volatile LAS int*)(lds + TOK_OFF)};
    volatile LAS int* tokt = (volatile LAS int*)(lds + TOK_OFF);
    { int tid = threadIdx.x; asm volatile("" : "+v"(tid));
      int tkv[(TOK_UNITS + 1) / 2];
#pragma unroll
      for (int ps = 0; ps < (TOK_UNITS + 1) / 2; ++ps) { const int i = 2 * ps + (tid >> 8); int pm, pn; tkv[ps] = (i < TOK_UNITS && S.unit(i, pm, pn)) ? p.slot_tok[pm * 256 + (tid & 255)] : -1; }
#pragma unroll
      for (int ps = 0; ps < (TOK_UNITS + 1) / 2; ++ps) { const int i = 2 * ps + (tid >> 8); if (i < TOK_UNITS) tokt[i * 256 + (tid & 255)] = tkv[ps] < 0 ? NTOK : tkv[ps]; }
      __syncthreads(); }
    pg8::Gemm g{p.hxb, p.wgu_t + (size_t)layer * NE * 2 * DFF * D, tiles * 256, 2 * DFF, D, (size_t)2 * DFF * D * 2};
    pg8::EpiSwiglu E{p.actb, p.b_gu + (size_t)layer * NE * 2 * DFF};
    pg8::gemm_phase<pg8::EpiSwiglu, pg8::MoeOrder, true>(lds, g, S, E);
}
__device__ __forceinline__ void mf_moe2(const P& p, LAS unsigned char* lds, int layer) {
    const int tiles = build_ue(p, lds, layer);
    pg8::Gemm g{p.actb, p.wdn_t + (size_t)layer * NE * D * DFF, tiles * 256, D, DFF, (size_t)D * DFF * 2};
    int gx_ = (int)gridDim.x, bx_ = (int)blockIdx.x; asm volatile("" : "+s"(gx_), "+s"(bx_));
    pg8::MoeOrder S{tiles * 4, 4, gx_, bx_, (const volatile LAS unsigned char*)(lds + UE_OFF), nullptr};
    pg8::EpiDown E{p.yb, p.b_dn + (size_t)layer * NE * D, p.slot_gate};
    pg8::gemm_phase(lds, g, S, E);
}

#define XB_TMO      128
#define XB_XCNT(j)  (256  + 64 * (j))
#define XB_XSUB(j)  (1280 + 64 * (j))
#define XB_XGEN(j)  (2304 + 64 * (j))
#define XB_TOP      3328
#define XB_TOPGEN   3392
#define XCD_BAR_WORDS 3456
#define XB_SPIN_CAP (1u << 18)

__device__ __forceinline__ unsigned xb_ld(unsigned* p)              { return __hip_atomic_load(p, __ATOMIC_RELAXED, __HIP_MEMORY_SCOPE_AGENT); }
__device__ __forceinline__ unsigned xb_add(unsigned* p, unsigned v) { return __hip_atomic_fetch_add(p, v, __ATOMIC_RELAXED, __HIP_MEMORY_SCOPE_AGENT); }
__device__ __forceinline__ unsigned xb_xcc_id() { return (unsigned)__builtin_amdgcn_s_getreg((3 << 11) | 20) & 0xFu; }
#define XB_SPIN(cond, bar) do { unsigned _sp = 0; while (cond) { __builtin_amdgcn_s_sleep(1); \
    if ((++_sp & 255u) == 0u) { if (xb_ld(&(bar)[XB_TMO])) break; if (_sp > XB_SPIN_CAP) { atomicAdd(&(bar)[XB_TMO], 1u); break; } } } } while (0)

struct XcdBarrier { unsigned* bar; unsigned x; volatile LAS unsigned* st; };

__device__ __forceinline__ XcdBarrier xcd_barrier_post(unsigned* bar, volatile LAS unsigned* st) {
    XcdBarrier b; b.bar = bar; b.x = xb_xcc_id(); b.st = st;
    if (threadIdx.x == 0) (void)xb_add(&bar[XB_XCNT(b.x)], 1u);
    return b;
}
__device__ __forceinline__ void xcd_barrier_complete(unsigned* bar, unsigned x, unsigned& nloc, unsigned& nx) {
    const unsigned G = gridDim.x * gridDim.y * gridDim.z;
    unsigned sum, cnt, mine, sp = 0u;
    asm volatile("" : "+s"(x));
    for (;;) {
        sum = 0u; cnt = 0u; mine = 0u;
#pragma unroll
        for (unsigned j = 0; j < 16; ++j) { const unsigned c = xb_ld(&bar[XB_XCNT(j)]); sum += c; cnt += (c > 0u) ? 1u : 0u; mine = (j == x) ? c : mine; }
        if (sum == G) break;
        __builtin_amdgcn_s_sleep(1);
        if ((++sp & 255u) == 0u) { if (xb_ld(&bar[XB_TMO])) break; if (sp > XB_SPIN_CAP) { atomicAdd(&bar[XB_TMO], 1u); break; } }
    }
    nloc = mine > 0u ? mine : 1u; nx = cnt > 0u ? cnt : 1u;
}
__device__ __forceinline__ void xcd_barrier(const XcdBarrier& b) {
    asm volatile("s_waitcnt vmcnt(0)" ::: "memory");
    __syncthreads();
    if (threadIdx.x == 0) {
        unsigned* bar = b.bar; unsigned bx = b.x;
        asm volatile("" : "+s"(bar), "+s"(bx));
        __builtin_amdgcn_s_waitcnt(0);
        unsigned nloc = b.st[0], nx = b.st[1];
        if (nloc == 0u) { xcd_barrier_complete(bar, bx, nloc, nx); b.st[0] = nloc; b.st[1] = nx; }
        const unsigned old = xb_add(&bar[XB_XSUB(bx)], 1u);
        const unsigned gen = old / nloc;
        if (old + 1u == (gen + 1u) * nloc) {
            __builtin_amdgcn_fence(__ATOMIC_RELEASE, "agent");
            asm volatile("s_waitcnt vmcnt(0)" ::: "memory");
            const unsigned og = xb_add(&bar[XB_TOP], 1u);
            const unsigned tg = og / nx;
            if (og + 1u == (tg + 1u) * nx) xb_add(&bar[XB_TOPGEN], 1u);
            else XB_SPIN(xb_ld(&bar[XB_TOPGEN]) == tg, bar);
            __builtin_amdgcn_fence(__ATOMIC_ACQUIRE, "agent");
            xb_add(&bar[XB_XGEN(bx)], 1u);
            asm volatile("s_waitcnt vmcnt(0)" ::: "memory");
        } else {
            XB_SPIN(xb_ld(&bar[XB_XGEN(bx)]) == gen, bar);
            __builtin_amdgcn_fence(__ATOMIC_ACQUIRE, "agent");
            asm volatile("s_waitcnt vmcnt(0)" ::: "memory");
        }
    }
    __syncthreads();
}

typedef const __attribute__((address_space(4))) P* KP;
__global__ void __launch_bounds__(NTHREADS, 2) fwd_kernel(P p_arg) {
    (void)p_arg;
    const KP kp0 = (KP)__builtin_amdgcn_kernarg_segment_ptr();
#define p (*(const P*)({ KP q_ = kp0; asm volatile("" : "+s"(q_)); q_; }))
    extern __shared__ __attribute__((aligned(16))) unsigned char lds_raw[];
    LAS unsigned char* lds = (LAS unsigned char*)lds_raw;
    for (int u = threadIdx.x; u < (LDS_BYTES - MISC_OFF) / 4; u += NTHREADS) ((LAS unsigned*)(lds + MISC_OFF))[u] = 0u;
    __syncthreads();
    XcdBarrier bar = xcd_barrier_post(p.bar, (volatile LAS unsigned*)(lds + MISC_OFF));
    const long gs = (long)gridDim.x * NTHREADS;
#define gt ({ int b_ = (int)blockIdx.x; asm volatile("" : "+s"(b_)); long g_ = (long)b_ * NTHREADS + threadIdx.x; asm volatile("" : "+v"(g_)); g_; })
#define SETUP(S) setup_slot<S>(p, gt, gs); xcd_barrier(bar);
    for (int rep = 0; rep < REP_SETUP; ++rep) {
    setup_slot<0>(p, gt, gs); mf_filter_tiles(p, lds); __syncthreads(); ph_convert_weights(p, lds); xcd_barrier(bar);
    ph_mod2(p, gt, gs); ph_filt4(p, gt, gs); xcd_barrier(bar);
    }
#define SLOT(S) layer_slot<S>(p, layer, gt, gs); xcd_barrier(bar);
#if MFMA_DENSE
#define DENSE_IN  for (int rep = 0; rep < REP_IN; ++rep) { mf_inproj(p, lds, layer); if (layer < 3) convert_deferred(p, lds, layer, 0); xcd_barrier(bar); }
#define DENSE_OUT if (!(layer & 1)) mf_glu(p, lds, layer >> 1); else ph_retout(p, layer < 3 ? NTOK : NLAT, gt, gs); xcd_barrier(bar); \
                  mf_outproj(p, lds, layer, layer < 3 ? NTOK : NLAT); xcd_barrier(bar);
#else
#define DENSE_IN  SLOT(2)
#define DENSE_OUT SLOT(7) SLOT(8)
#endif
#if MFMA_MOE
#define MOE_GEMMS for (int rep = 0; rep < REP_MOE; ++rep) { mf_moe1(p, lds, layer); xcd_barrier(bar); } for (int rep = 0; rep < REP_MOE2; ++rep) { mf_moe2(p, lds, layer); xcd_barrier(bar); }
#else
#define MOE_GEMMS SLOT(14) SLOT(15)
#endif
#define REPF(n) for (int rep_ = 0; rep_ < (n); ++rep_)
#define LAYER(L) { constexpr int layer = L; constexpr bool AB = !(layer & 1); constexpr int il = layer >> 1; constexpr int nrows = layer < 3 ? NTOK : NLAT; \
    REPF(RN) mf_rownorm<0>(p, lds, layer, NTOK, layer - 1); xcd_barrier(bar); DENSE_IN \
    REPF(R3) { if (AB) { mf_s5<false>(p, lds, il); mf_sconv(p, lds, il); } else ph_rope(p, gt, gs); } xcd_barrier(bar); \
    REPF(R4) { if (AB) { mf_lconv(p, lds, il); ph_lconv(p, il, NLAT, NTOK, gt, gs); } else mf_retkv(p, lds, il); } if (AB) ph_s5carry(p, il, gt, gs); xcd_barrier(bar); \
    REPF(R5) { if (AB) { mf_s5<true>(p, lds, il); mf_hymix(p, lds, il); } else mf_swa(p, lds, il, layer < 3); } if (!AB) ph_retcarry(p, il, gt, gs); xcd_barrier(bar); \
    REPF(R6) { if (AB) ph_s5fin(p, il, gt, gs); else mf_reto(p, lds, il); } xcd_barrier(bar); \
    REPF(R7) { if (AB) mf_glu(p, lds, il); else mf_retout(p, nrows); } xcd_barrier(bar); \
    mf_outproj(p, lds, layer, nrows); if (layer < 3) convert_deferred(p, lds, layer, 1); xcd_barrier(bar); \
    mf_rownorm<1>(p, lds, layer, nrows, -1); xcd_barrier(bar); SLOT(12) MOE_GEMMS }
    LAYER(0) LAYER(1) LAYER(2) LAYER(3)
    mf_rownorm<2>(p, lds, 3, NLAT, 3);
#undef gt
#undef p
}

extern "C" void kernel_launch(void* const* d_in, const int* in_sizes, int n_in, void* d_out, int out_size, void* d_ws, size_t ws_size, hipStream_t stream) {
    (void)in_sizes; (void)n_in; (void)out_size;
    const WsMap m = ws_map();
    if (ws_size < m.total) { fprintf(stderr, "workspace too small: %zu < %zu\n", ws_size, m.total); return; }
    P p; memset(&p, 0, sizeof(p)); fill_params(p, d_in, d_out, d_ws);
    static int grid = 0;
    if (!grid) {
        int dev = 0, cus = 0, per_cu = 0;
        (void)hipGetDevice(&dev); (void)hipDeviceGetAttribute(&cus, hipDeviceAttributeMultiprocessorCount, dev);
        if (hipFuncSetAttribute((const void*)fwd_kernel, hipFuncAttributeMaxDynamicSharedMemorySize, LDS_BYTES) != hipSuccess) { fprintf(stderr, "hipFuncSetAttribute failed\n"); grid = -1; return; }
        (void)hipOccupancyMaxActiveBlocksPerMultiprocessor(&per_cu, (const void*)fwd_kernel, NTHREADS, LDS_BYTES);
        if (per_cu < 1) fprintf(stderr, "occupancy query reports %d blocks per CU\n", per_cu);
        grid = cus;
    }
    if (grid <= 0) return;
    (void)hipMemsetAsync(p.bar, 0, XCD_BAR_WORDS * sizeof(unsigned), stream);
    fwd_kernel<<<dim3(grid), dim3(NTHREADS), LDS_BYTES, stream>>>(p);
}
#endif
```
